# Optimizing an MI355X kernel written in HIP

```python
import jax, jax.numpy as jnp
from jax import lax
import numpy as np

D_MODEL = 1024
BATCH = 4
SEQ = 4096
DEPTH = 1

PLE_DIM = 256
EPS = 1e-6
NEG = -1e30

NSA_HEADS = 8
NSA_KV = 2
NSA_HPG = NSA_HEADS // NSA_KV
NSA_HD = 64
CMP_LEN = 32
CMP_STRIDE = 16
CMP_HIDDEN = 256
SEL_BLOCK = 64
SEL_TOPK = 16
SEL_FORCE = 1000.0
WINDOW = 512
Q_BLOCK = 128
ROPE_THETA = 500000.0
ROPE_DIM = NSA_HD // 4

ML_HEADS = 4
ML_HD = 128
ML_WIDTH = ML_HEADS * ML_HD
ML_CHUNK = 64
CONV_W = 4

N_GROUPS = 4
EXP_PER_GROUP = 4
N_EXPERTS = N_GROUPS * EXP_PER_GROUP
TOPK_IN_GROUP = 2
D_EXPERT = 256

NSA_QW = NSA_HEADS * NSA_HD
NSA_KVW = NSA_KV * NSA_HD
IN_SIZES = (NSA_QW, NSA_KVW, NSA_KVW, NSA_KVW, NSA_KVW, NSA_KVW, NSA_KVW, 3 * NSA_HEADS, 2 * ML_WIDTH, ML_WIDTH, ML_WIDTH, 2 * ML_HEADS, 2 * D_MODEL)
D_IN = sum(IN_SIZES)

kernel_name = 'hybrid_nsa_mlstm_hmoe'


def rmsnorm(x, g):
    xf = x.astype(jnp.float32)
    y = xf * lax.rsqrt(jnp.mean(xf * xf, axis=-1, keepdims=True) + EPS)
    return (y * g.astype(jnp.float32)).astype(x.dtype)


def rope_tables(positions):
    inv = ROPE_THETA ** (-jnp.arange(0, ROPE_DIM, 2, dtype=jnp.float32) / ROPE_DIM)
    ang = positions.astype(jnp.float32)[:, :, None] * inv
    return jnp.cos(ang)[:, :, None, :], jnp.sin(ang)[:, :, None, :]


def partial_rope(t, cos, sin):
    half = ROPE_DIM // 2
    tf = t.astype(jnp.float32)
    t1, t2, rest = tf[..., :half], tf[..., half:ROPE_DIM], tf[..., ROPE_DIM:]
    out = jnp.concatenate([t1 * cos - t2 * sin, t2 * cos + t1 * sin, rest], axis=-1)
    return out.astype(t.dtype)


def compress_blocks(tok_g, w1, w2, pe):
    b, g, s, d = tok_g.shape
    n_cmp = (s - CMP_LEN) // CMP_STRIDE + 1
    idx = CMP_STRIDE * jnp.arange(n_cmp)[:, None] + jnp.arange(CMP_LEN)[None, :]
    blk = tok_g[:, :, idx] + pe
    flat = blk.reshape(b, g, n_cmp, CMP_LEN * d)
    return jax.nn.gelu(flat @ w1) @ w2


def nsa_attention(q, kc_tok, vc_tok, ks_tok, vs_tok, kw_tok, vw_tok, gates, w_ck1, w_ck2, pe_ck, w_cv1, w_cv2, pe_cv):
    b, s = q.shape[:2]
    dt = q.dtype
    n_sel = s // SEL_BLOCK
    sel_k = min(SEL_TOPK, n_sel)
    scale = NSA_HD ** -0.5
    qg = q.reshape(b, s, NSA_KV, NSA_HPG, NSA_HD).transpose(0, 2, 3, 1, 4)
    gg = gates.reshape(b, s, NSA_KV, NSA_HPG, 3).transpose(0, 2, 3, 1, 4)

    def to_g(t):
        return t.transpose(0, 2, 1, 3)

    kc = compress_blocks(to_g(kc_tok), w_ck1, w_ck2, pe_ck)
    vc = compress_blocks(to_g(vc_tok), w_cv1, w_cv2, pe_cv)
    n_cmp = kc.shape[2]
    ks = to_g(ks_tok).reshape(b, NSA_KV, n_sel, SEL_BLOCK, NSA_HD)
    vs = to_g(vs_tok).reshape(b, NSA_KV, n_sel, SEL_BLOCK, NSA_HD)
    pad = ((0, 0), (0, 0), (WINDOW, 0), (0, 0))
    kw = jnp.pad(to_g(kw_tok), pad)
    vw = jnp.pad(to_g(vw_tok), pad)
    c_start = CMP_STRIDE * jnp.arange(n_cmp)
    c_end = c_start + CMP_LEN - 1
    s_start = SEL_BLOCK * jnp.arange(n_sel)
    overlap = ((c_start[:, None] < s_start[None, :] + SEL_BLOCK) & (c_end[:, None] >= s_start[None, :])).astype(jnp.float32)
    bi = jnp.arange(b)[:, None, None, None]
    gi = jnp.arange(NSA_KV)[None, :, None, None]
    sel_ids = jnp.arange(n_sel)

    def query_block(c):
        t0 = c * Q_BLOCK
        t = t0 + jnp.arange(Q_BLOCK)
        qc = lax.dynamic_slice_in_dim(qg, t0, Q_BLOCK, axis=3)
        gc = lax.dynamic_slice_in_dim(gg, t0, Q_BLOCK, axis=3).astype(jnp.float32)
        cmask = c_end[None, :] <= t[:, None]
        sc = jnp.einsum('bghqd,bgnd->bghqn', qc, kc).astype(jnp.float32) * scale
        p_cmp = jax.nn.softmax(jnp.where(cmask, sc, NEG), axis=-1)
        p_cmp = p_cmp * jnp.any(cmask, axis=-1, keepdims=True).astype(jnp.float32)
        o_cmp = jnp.einsum('bghqn,bgnd->bghqd', p_cmp.astype(dt), vc)
        imp = jnp.einsum('bghqn,ns->bgqs', p_cmp, overlap)
        cur = t // SEL_BLOCK
        forced = (sel_ids[None, :] == 0) | (sel_ids[None, :] == cur[:, None]) | (sel_ids[None, :] == cur[:, None] - 1)
        imp = jnp.where(forced, imp + SEL_FORCE, imp)
        imp = jnp.where(s_start[None, :] <= t[:, None], imp, NEG)
        _, idx = lax.top_k(imp, sel_k)
        k_sel = ks[bi, gi, idx]
        v_sel = vs[bi, gi, idx]
        kpos = idx[..., None] * SEL_BLOCK + jnp.arange(SEL_BLOCK)
        smask = (kpos <= t[:, None, None])[:, :, None]
        ss = jnp.einsum('bghqd,bgqkrd->bghqkr', qc, k_sel).astype(jnp.float32) * scale
        ss = jnp.where(smask, ss, NEG).reshape(b, NSA_KV, NSA_HPG, Q_BLOCK, sel_k * SEL_BLOCK)
        p_sel = jax.nn.softmax(ss, axis=-1).reshape(b, NSA_KV, NSA_HPG, Q_BLOCK, sel_k, SEL_BLOCK)
        o_sel = jnp.einsum('bghqkr,bgqkrd->bghqd', p_sel.astype(dt), v_sel)
        kwc = lax.dynamic_slice_in_dim(kw, t0, Q_BLOCK + WINDOW, axis=2)
        vwc = lax.dynamic_slice_in_dim(vw, t0, Q_BLOCK + WINDOW, axis=2)
        wpos = t0 - WINDOW + jnp.arange(Q_BLOCK + WINDOW)
        wmask = (wpos[None, :] <= t[:, None]) & (wpos[None, :] > t[:, None] - WINDOW) & (wpos[None, :] >= 0)
        sw = jnp.einsum('bghqd,bgkd->bghqk', qc, kwc).astype(jnp.float32) * scale
        p_win = jax.nn.softmax(jnp.where(wmask, sw, NEG), axis=-1)
        o_win = jnp.einsum('bghqk,bgkd->bghqd', p_win.astype(dt), vwc)
        o = gc[..., 0:1] * o_cmp + gc[..., 1:2] * o_sel + gc[..., 2:3] * o_win
        return o.astype(dt)

    out = lax.map(query_block, jnp.arange(s // Q_BLOCK))
    return out.transpose(1, 0, 4, 2, 3, 5).reshape(b, s, NSA_HEADS * NSA_HD)


def causal_conv_silu(u, w, bias):
    s = u.shape[1]
    up = jnp.pad(u, ((0, 0), (CONV_W - 1, 0), (0, 0)))
    y = bias
    for j in range(CONV_W):
        y = y + w[j] * up[:, j:j + s]
    return jax.nn.silu(y)


def mlstm_chunkwise(q, k, v, i_pre, f_pre):
    b, s, nh, d = q.shape
    nc = s // ML_CHUNK
    lc = ML_CHUNK

    def seq_chunks(t):
        return t.astype(jnp.float32).reshape(b, nc, lc, nh, d).transpose(1, 0, 3, 2, 4)

    def gate_chunks(t):
        return t.astype(jnp.float32).reshape(b, nc, lc, nh).transpose(1, 0, 3, 2)

    qc = seq_chunks(q)
    kc = seq_chunks(k) * (d ** -0.5)
    vc = seq_chunks(v)
    ic = gate_chunks(i_pre)
    lfc = gate_chunks(jax.nn.log_sigmoid(f_pre.astype(jnp.float32)))
    causal = jnp.tril(jnp.ones((lc, lc), dtype=bool))

    def step(carry, inp):
        C, n, m = carry
        qt, kt, vt, it, lft = inp
        bcum = jnp.cumsum(lft, axis=-1)
        dmat = jnp.where(causal, bcum[..., :, None] - bcum[..., None, :] + it[..., None, :], -jnp.inf)
        inter = bcum + m[..., None]
        m_t = jnp.maximum(jnp.max(dmat, axis=-1), inter)
        a = jnp.exp(dmat - m_t[..., None]) * jnp.einsum('bhtd,bhsd->bhts', qt, kt)
        dec = jnp.exp(inter - m_t)
        num = jnp.einsum('bhts,bhsd->bhtd', a, vt) + dec[..., None] * jnp.einsum('bhvk,bhtk->bhtv', C, qt)
        den = jnp.sum(a, axis=-1) + dec * jnp.einsum('bhk,bhtk->bht', n, qt)
        h = num / jnp.maximum(jnp.abs(den), jnp.exp(-m_t))[..., None]
        b_last = bcum[..., -1]
        g_s = b_last[..., None] - bcum + it
        m_new = jnp.maximum(b_last + m, jnp.max(g_s, axis=-1))
        w_prev = jnp.exp(b_last + m - m_new)
        w_s = jnp.exp(g_s - m_new[..., None])
        C = w_prev[..., None, None] * C + jnp.einsum('bhs,bhsv,bhsk->bhvk', w_s, vt, kt)
        n = w_prev[..., None] * n + jnp.einsum('bhs,bhsk->bhk', w_s, kt)
        return (C, n, m_new), h

    init = (jnp.zeros((b, nh, d, d), jnp.float32), jnp.zeros((b, nh, d), jnp.float32), jnp.zeros((b, nh), jnp.float32))
    _, hs = lax.scan(step, init, (qc, kc, vc, ic, lfc))
    return hs.transpose(1, 0, 3, 2, 4).reshape(b, s, nh, d)


def hier_moe(h, w_rg, b_rg, w_re, b_re, w_e13, w_e2):
    b, s, dm = h.shape
    t = h.reshape(b * s, dm)
    n_tok = t.shape[0]
    gl = (t @ w_rg).astype(jnp.float32) + b_rg.astype(jnp.float32)
    pg = jax.nn.softmax(gl, axis=-1)
    _, gsel = lax.top_k(gl, 1)
    el = ((t @ w_re).astype(jnp.float32) + b_re.astype(jnp.float32)).reshape(n_tok, N_GROUPS, EXP_PER_GROUP)
    gidx = jnp.broadcast_to(gsel[:, :, None], (n_tok, 1, EXP_PER_GROUP))
    elg = jnp.take_along_axis(el, gidx, axis=1)[:, 0]
    ev, ei = lax.top_k(elg, TOPK_IN_GROUP)
    wts = jnp.take_along_axis(pg, gsel, axis=1) * jax.nn.softmax(ev, axis=-1)
    eid = gsel * EXP_PER_GROUP + ei
    gate = jnp.sum(jax.nn.one_hot(eid, N_EXPERTS, dtype=jnp.float32) * wts[..., None], axis=1)
    a = jnp.einsum('td,edf->tef', t, w_e13)
    g_, u = jnp.split(a, 2, axis=-1)
    act = jax.nn.silu(g_) * u * gate[:, :, None].astype(t.dtype)
    y = jnp.einsum('tef,efd->td', act, w_e2)
    return y.reshape(b, s, dm).astype(h.dtype)


def setup_inputs(seed: int = 0) -> dict:
    key = jax.random.key(seed)
    ks = jax.random.split(key, 32)
    L, D = DEPTH, D_MODEL
    f32 = jnp.float32

    def nrm(k, shape, fan_in):
        return jax.random.normal(k, shape, f32) * (fan_in ** -0.5)

    def gain(k, shape):
        return 1.0 + 0.02 * jax.random.normal(k, shape, f32)

    x = jax.random.normal(ks[0], (BATCH, SEQ, D), f32)
    p = jax.random.normal(ks[1], (DEPTH, BATCH, SEQ, PLE_DIM), f32)
    positions = jax.random.randint(ks[2], (BATCH, 1), 0, 1024, dtype=jnp.int32) + jnp.arange(SEQ, dtype=jnp.int32)[None, :]
    b_i = 0.1 * jax.random.normal(ks[5], (L, ML_HEADS), f32)
    b_f = jnp.linspace(3.0, 6.0, ML_HEADS, dtype=f32)[None, :] + 0.1 * jax.random.normal(ks[6], (L, ML_HEADS), f32)
    return {
        'x': x,
        'p': p,
        'positions': positions,
        'g_mix': gain(ks[3], (L, D)),
        'w_in': nrm(ks[4], (L, D, D_IN), D),
        'b_if': jnp.concatenate([b_i, b_f], axis=-1),
        'w_ck1': nrm(ks[7], (L, CMP_LEN * NSA_HD, CMP_HIDDEN), CMP_LEN * NSA_HD),
        'w_ck2': nrm(ks[8], (L, CMP_HIDDEN, NSA_HD), CMP_HIDDEN),
        'pe_ck': 0.1 * jax.random.normal(ks[9], (L, CMP_LEN, NSA_HD), f32),
        'w_cv1': nrm(ks[10], (L, CMP_LEN * NSA_HD, CMP_HIDDEN), CMP_LEN * NSA_HD),
        'w_cv2': nrm(ks[11], (L, CMP_HIDDEN, NSA_HD), CMP_HIDDEN),
        'pe_cv': 0.1 * jax.random.normal(ks[12], (L, CMP_LEN, NSA_HD), f32),
        'w_conv': nrm(ks[13], (L, CONV_W, 2 * ML_WIDTH), CONV_W),
        'b_conv': 0.02 * jax.random.normal(ks[14], (L, 2 * ML_WIDTH), f32),
        'g_hn': gain(ks[15], (L, ML_WIDTH)),
        'w_pa': nrm(ks[16], (L, NSA_QW, D), NSA_QW),
        'w_pb': nrm(ks[17], (L, ML_WIDTH, D), ML_WIDTH),
        'w_out': nrm(ks[18], (L, D, D), D),
        'g_ffn': gain(ks[19], (L, D)),
        'w_rg': nrm(ks[20], (L, D, N_GROUPS), D),
        'b_rg': 0.01 * jax.random.normal(ks[21], (L, N_GROUPS), f32),
        'w_re': nrm(ks[22], (L, D, N_EXPERTS), D),
        'b_re': 0.01 * jax.random.normal(ks[23], (L, N_EXPERTS), f32),
        'w_e13': nrm(ks[24], (L, N_EXPERTS, D, 2 * D_EXPERT), D),
        'w_e2': nrm(ks[25], (L, N_EXPERTS, D_EXPERT, D), D_EXPERT),
        'g_ple': gain(ks[26], (L, D)),
        'w_pg': nrm(ks[27], (L, D, D), D),
        'w_pp': nrm(ks[28], (L, PLE_DIM, D), PLE_DIM),
        'g_final': gain(ks[29], (D,)),
    }


def reference(x, p, positions, g_mix, w_in, b_if, w_ck1, w_ck2, pe_ck, w_cv1, w_cv2, pe_cv, w_conv, b_conv, g_hn, w_pa, w_pb, w_out, g_ffn, w_rg, b_rg, w_re, b_re, w_e13, w_e2, g_ple, w_pg, w_pp, g_final):
    b, s, _ = x.shape
    cos, sin = rope_tables(positions)
    offs = [int(o) for o in np.cumsum(IN_SIZES)[:-1]]
    for i in range(DEPTH):
        h = rmsnorm(x, g_mix[i])
        z = h @ w_in[i]
        (q_a, kc_a, vc_a, ks_a, vs_a, kw_a, vw_a, gate_a, qk_b, v_b, o_b, if_b, merge) = jnp.split(z, offs, axis=-1)
        nsa_q = partial_rope(q_a.reshape(b, s, NSA_HEADS, NSA_HD), cos, sin)
        k_cmp = partial_rope(kc_a.reshape(b, s, NSA_KV, NSA_HD), cos, sin)
        k_sel = partial_rope(ks_a.reshape(b, s, NSA_KV, NSA_HD), cos, sin)
        k_win = partial_rope(kw_a.reshape(b, s, NSA_KV, NSA_HD), cos, sin)
        nsa_gates = jax.nn.sigmoid(gate_a.astype(jnp.float32)).reshape(b, s, NSA_HEADS, 3)
        y_a = nsa_attention(nsa_q, k_cmp, vc_a.reshape(b, s, NSA_KV, NSA_HD), k_sel, vs_a.reshape(b, s, NSA_KV, NSA_HD), k_win, vw_a.reshape(b, s, NSA_KV, NSA_HD), nsa_gates, w_ck1[i], w_ck2[i], pe_ck[i], w_cv1[i], w_cv2[i], pe_cv[i])
        qk_c = causal_conv_silu(qk_b, w_conv[i], b_conv[i])
        q_b, k_b = jnp.split(qk_c, 2, axis=-1)
        ifp = if_b.astype(jnp.float32) + b_if[i].astype(jnp.float32)
        hm = mlstm_chunkwise(q_b.reshape(b, s, ML_HEADS, ML_HD), k_b.reshape(b, s, ML_HEADS, ML_HD), v_b.reshape(b, s, ML_HEADS, ML_HD), ifp[..., :ML_HEADS], ifp[..., ML_HEADS:])
        hm = hm * jax.nn.sigmoid(o_b.astype(jnp.float32)).reshape(b, s, ML_HEADS, ML_HD)
        hm = hm * lax.rsqrt(jnp.mean(hm * hm, axis=-1, keepdims=True) + EPS) * g_hn[i].astype(jnp.float32).reshape(ML_HEADS, ML_HD)
        y_b = hm.reshape(b, s, ML_WIDTH).astype(x.dtype)
        g_a, g_b = jnp.split(merge, 2, axis=-1)
        mixed = jax.nn.sigmoid(g_a) * (y_a @ w_pa[i]) + jax.nn.sigmoid(g_b) * (y_b @ w_pb[i])
        x = x + mixed @ w_out[i]
        x = x + hier_moe(rmsnorm(x, g_ffn[i]), w_rg[i], b_rg[i], w_re[i], b_re[i], w_e13[i], w_e2[i])
        x = x + jax.nn.sigmoid(rmsnorm(x, g_ple[i]) @ w_pg[i]) * (p[i] @ w_pp[i])
    return rmsnorm(x, g_final)
```

```cpp
#include <hip/hip_runtime.h>
#include <cstdint>
#include <cstdio>

typedef unsigned short bf16_t;
typedef short bf16x8 __attribute__((ext_vector_type(8)));
typedef float f32x16 __attribute__((ext_vector_type(16)));

#define DI __device__ __forceinline__

constexpr int T_TOK = 16384, SEQ = 4096, DM = 1024, DIN = 5408;
constexpr int ZC_Q = 0, ZC_KC = 512, ZC_VC = 640, ZC_KS = 768, ZC_VS = 896, ZC_KW = 1024, ZC_VW = 1152, ZC_GATE = 1280,
              ZC_MQK = 1304, ZC_MV = 2328, ZC_MO = 2840, ZC_IF = 3352, ZC_GA = 3360, ZC_GB = 4384;

DI bf16_t f2bf(float f) { unsigned u = __float_as_uint(f); return (bf16_t)((u + 0x7fffu + ((u >> 16) & 1u)) >> 16); }
DI float bf2f(bf16_t h) { return __uint_as_float(((unsigned)h) << 16); }
DI float sigmoidf_(float x) { return 1.f / (1.f + __expf(-x)); }
DI float wave_sum(float v) {
#pragma unroll
    for (int o = 1; o < 64; o <<= 1) v += __shfl_xor(v, o);
    return v;
}
DI float wave_max(float v) {
#pragma unroll
    for (int o = 1; o < 64; o <<= 1) v = fmaxf(v, __shfl_xor(v, o));
    return v;
}

template <class Epi>
__global__ __launch_bounds__(256) void gemm_v1(const bf16_t* __restrict__ A, int lda, const float* __restrict__ B, int ldb, int N, int K, Epi epi) {
    __shared__ __attribute__((aligned(16))) bf16_t As[128 * 40];
    __shared__ __attribute__((aligned(16))) bf16_t Bs[128 * 40];
    const int tid = threadIdx.x, lane = tid & 63, w = tid >> 6, wr = w >> 1, wc = w & 1, r32 = lane & 31, hi = lane >> 5;
    const int m0 = blockIdx.y * 128, n0 = blockIdx.x * 128;
    f32x16 acc[2][2];
#pragma unroll
    for (int i = 0; i < 2; ++i)
#pragma unroll
        for (int j = 0; j < 2; ++j)
#pragma unroll
            for (int r = 0; r < 16; ++r) acc[i][j][r] = 0.f;
    for (int k0 = 0; k0 < K; k0 += 32) {
#pragma unroll
        for (int i = 0; i < 2; ++i) {
            const int c = tid + i * 256, row = c >> 2, col = (c & 3) * 8;
            const uint4 v = *(const uint4*)(A + (size_t)(m0 + row) * lda + k0 + col);
            *(uint4*)(As + row * 40 + col) = v;
        }
#pragma unroll
        for (int i = 0; i < 4; ++i) {
            const int idx = tid + i * 256, k = idx >> 5, n = (idx & 31) * 4;
            float4 v = make_float4(0.f, 0.f, 0.f, 0.f);
            if (n0 + n < N) v = *(const float4*)(B + (size_t)(k0 + k) * ldb + n0 + n);
            Bs[(n + 0) * 40 + k] = f2bf(v.x); Bs[(n + 1) * 40 + k] = f2bf(v.y); Bs[(n + 2) * 40 + k] = f2bf(v.z); Bs[(n + 3) * 40 + k] = f2bf(v.w);
        }
        __syncthreads();
#pragma unroll
        for (int kk = 0; kk < 32; kk += 16) {
            bf16x8 a[2], b[2];
#pragma unroll
            for (int i = 0; i < 2; ++i) a[i] = *(const bf16x8*)(As + (wr * 64 + i * 32 + r32) * 40 + kk + hi * 8);
#pragma unroll
            for (int j = 0; j < 2; ++j) b[j] = *(const bf16x8*)(Bs + (wc * 64 + j * 32 + r32) * 40 + kk + hi * 8);
#pragma unroll
            for (int i = 0; i < 2; ++i)
#pragma unroll
                for (int j = 0; j < 2; ++j) acc[i][j] = __builtin_amdgcn_mfma_f32_32x32x16_bf16(a[i], b[j], acc[i][j], 0, 0, 0);
        }
        __syncthreads();
    }
#pragma unroll
    for (int i = 0; i < 2; ++i)
#pragma unroll
        for (int j = 0; j < 2; ++j)
#pragma unroll
            for (int r = 0; r < 16; ++r) {
                const int row = m0 + wr * 64 + i * 32 + (r & 3) + 8 * (r >> 2) + 4 * hi;
                const int col = n0 + wc * 64 + j * 32 + r32;
                if (col < N) epi(row, col, acc[i][j][r]);
            }
}

struct EpiIn {
    bf16_t* zb; float* gates; float* ifp; const float* b_if;
    DI void operator()(int row, int col, float v) const {
        zb[(size_t)row * DIN + col] = f2bf(v);
        if (col >= ZC_GATE && col < ZC_GATE + 24) gates[row * 24 + col - ZC_GATE] = sigmoidf_(v);
        if (col >= ZC_IF && col < ZC_IF + 8) ifp[row * 8 + col - ZC_IF] = v + b_if[col - ZC_IF];
    }
};
struct EpiPa {
    const bf16_t* zb; float* tmp;
    DI void operator()(int row, int col, float v) const { tmp[(size_t)row * DM + col] = sigmoidf_(bf2f(zb[(size_t)row * DIN + ZC_GA + col])) * v; }
};
struct EpiPb {
    const bf16_t* zb; const float* tmp; bf16_t* mixed;
    DI void operator()(int row, int col, float v) const {
        mixed[(size_t)row * DM + col] = f2bf(tmp[(size_t)row * DM + col] + sigmoidf_(bf2f(zb[(size_t)row * DIN + ZC_GB + col])) * v);
    }
};
struct EpiResid {
    const float* base; float* out;
    DI void operator()(int row, int col, float v) const { out[(size_t)row * DM + col] = base[(size_t)row * DM + col] + v; }
};
struct EpiBf {
    bf16_t* o; int ld;
    DI void operator()(int row, int col, float v) const { o[(size_t)row * ld + col] = f2bf(v); }
};
struct EpiF32 {
    float* o; int ld;
    DI void operator()(int row, int col, float v) const { o[(size_t)row * ld + col] = v; }
};
struct EpiPle {
    float* x; const float* pp;
    DI void operator()(int row, int col, float v) const { const size_t i = (size_t)row * DM + col; x[i] = x[i] + sigmoidf_(v) * pp[i]; }
};

__global__ __launch_bounds__(256) void rmsnorm_rows(const float* x, const float* __restrict__ g, bf16_t* outb, float* outf, int rows) {
    const int row = blockIdx.x * 4 + (threadIdx.x >> 6), lane = threadIdx.x & 63;
    if (row >= rows) return;
    const float4* xr = (const float4*)(x + (size_t)row * DM);
    float4 v[4]; float s = 0.f;
#pragma unroll
    for (int j = 0; j < 4; ++j) { v[j] = xr[lane + 64 * j]; s += v[j].x * v[j].x + v[j].y * v[j].y + v[j].z * v[j].z + v[j].w * v[j].w; }
    const float rstd = rsqrtf(wave_sum(s) * (1.f / DM) + 1e-6f);
#pragma unroll
    for (int j = 0; j < 4; ++j) {
        const float4 gg = ((const float4*)g)[lane + 64 * j];
        const float a = v[j].x * rstd * gg.x, b = v[j].y * rstd * gg.y, c = v[j].z * rstd * gg.z, d = v[j].w * rstd * gg.w;
        if (outf) ((float4*)(outf + (size_t)row * DM))[lane + 64 * j] = make_float4(a, b, c, d);
        else { ushort4 o; o.x = f2bf(a); o.y = f2bf(b); o.z = f2bf(c); o.w = f2bf(d); ((ushort4*)(outb + (size_t)row * DM))[lane + 64 * j] = o; }
    }
}

__global__ void cvt_bf16(const float* __restrict__ in, bf16_t* __restrict__ out, size_t n) {
    for (size_t i = blockIdx.x * (size_t)blockDim.x + threadIdx.x; i < n; i += (size_t)gridDim.x * blockDim.x) out[i] = f2bf(in[i]);
}

__global__ void rope_apply(bf16_t* zb, const int* __restrict__ pos) {
    const int idx = blockIdx.x * blockDim.x + threadIdx.x;
    if (idx >= T_TOK * 14 * 8) return;
    const int i = idx & 7, hs = (idx >> 3) % 14, tok = idx / 112;
    int base;
    if (hs < 8) base = ZC_Q + hs * 64;
    else if (hs < 10) base = ZC_KC + (hs - 8) * 64;
    else if (hs < 12) base = ZC_KS + (hs - 10) * 64;
    else base = ZC_KW + (hs - 12) * 64;
    const float inv = powf(500000.0f, -(float)(2 * i) / 16.0f);
    const float ang = (float)pos[tok] * inv;
    float sn, cs; sincosf(ang, &sn, &cs);
    bf16_t* p = zb + (size_t)tok * DIN + base;
    const float t1 = bf2f(p[i]), t2 = bf2f(p[i + 8]);
    p[i] = f2bf(t1 * cs - t2 * sn); p[i + 8] = f2bf(t2 * cs + t1 * sn);
}

DI float gelu_tanh(float x) { const float u = 0.7978845608028654f * (x + 0.044715f * x * x * x); return 0.5f * x * (1.f + tanhf(u)); }

__global__ __launch_bounds__(256) void compress_naive(const bf16_t* __restrict__ zb, const float* __restrict__ w1k, const float* __restrict__ w2k, const float* __restrict__ pek,
                                                      const float* __restrict__ w1v, const float* __restrict__ w2v, const float* __restrict__ pev, float* __restrict__ outk, float* __restrict__ outv) {
    __shared__ float flat[2048];
    __shared__ float h1[256];
    const int j = blockIdx.x, bg = blockIdx.y, kv = blockIdx.z, b = bg >> 1, g = bg & 1, tid = threadIdx.x;
    const float* w1 = kv ? w1v : w1k; const float* w2 = kv ? w2v : w2k; const float* pe = kv ? pev : pek; float* out = kv ? outv : outk;
    const int colbase = (kv ? ZC_VC : ZC_KC) + g * 64;
    for (int e = tid; e < 2048; e += 256) {
        const int i = e >> 6, d = e & 63;
        flat[e] = bf2f(zb[(size_t)(b * SEQ + 16 * j + i) * DIN + colbase + d]) + pe[e];
    }
    __syncthreads();
    float s = 0.f;
    for (int k = 0; k < 2048; ++k) s += flat[k] * w1[(size_t)k * 256 + tid];
    h1[tid] = gelu_tanh(s);
    __syncthreads();
    if (tid < 64) {
        float o = 0.f;
        for (int n = 0; n < 256; ++n) o += h1[n] * w2[n * 64 + tid];
        out[((size_t)bg * 256 + j) * 64 + tid] = o;
    }
}

DI void softmax_row(float* row, int n, int lane) {
    float m = -3.0e38f;
    for (int j = lane; j < n; j += 64) m = fmaxf(m, row[j]);
    m = wave_max(m);
    float s = 0.f;
    for (int j = lane; j < n; j += 64) { const float e = __expf(row[j] - m); row[j] = e; s += e; }
    s = wave_sum(s);
    const float inv = 1.f / s;
    for (int j = lane; j < n; j += 64) row[j] *= inv;
}

__global__ __launch_bounds__(256) void nsa_naive(const bf16_t* __restrict__ zb, const float* __restrict__ kcc, const float* __restrict__ vcc, const float* __restrict__ gates, bf16_t* __restrict__ Y) {
    __shared__ float q[4][64];
    __shared__ float sc[4][1024];
    __shared__ float impv[64];
    __shared__ int sellist[16];
    __shared__ int nsel_s;
    __shared__ int selflag[64];
    const int tok = blockIdx.x, g = blockIdx.y, b = tok >> 12, t = tok & 4095, tid = threadIdx.x, hh = tid >> 6, lane = tid & 63, d = lane;
    q[hh][d] = bf2f(zb[(size_t)tok * DIN + ZC_Q + (g * 4 + hh) * 64 + d]) * 0.125f;
    __syncthreads();
    const int nv = (t >= 31) ? ((t - 15) >> 4) : 0;
    const float* kcb = kcc + (size_t)(b * 2 + g) * 256 * 64; const float* vcb = vcc + (size_t)(b * 2 + g) * 256 * 64;
    if (tid < nv) {
        float s0 = 0.f, s1 = 0.f, s2 = 0.f, s3 = 0.f;
        for (int dd = 0; dd < 64; ++dd) { const float kx = kcb[tid * 64 + dd]; s0 += q[0][dd] * kx; s1 += q[1][dd] * kx; s2 += q[2][dd] * kx; s3 += q[3][dd] * kx; }
        sc[0][tid] = s0; sc[1][tid] = s1; sc[2][tid] = s2; sc[3][tid] = s3;
    }
    __syncthreads();
    if (nv > 0) softmax_row(sc[hh], nv, lane);
    for (int j = nv + lane; j < 256; j += 64) sc[hh][j] = 0.f;
    __syncthreads();
    float o_cmp = 0.f;
    for (int j = 0; j < nv; ++j) o_cmp += sc[hh][j] * vcb[j * 64 + d];
    const int cur = t >> 6;
    if (tid < 64) {
        const int s = tid; int lo = 4 * s - 1; if (lo < 0) lo = 0; int hi2 = 4 * s + 3; if (hi2 > 254) hi2 = 254;
        float v = 0.f;
        for (int h2 = 0; h2 < 4; ++h2) for (int j = lo; j <= hi2; ++j) v += sc[h2][j];
        if (s == 0 || s == cur || s == cur - 1) v += 1000.0f;
        if (s > cur) v = -1e30f;
        impv[s] = v;
    }
    __syncthreads();
    if (tid < 64) {
        const float v = impv[tid]; int rank = 0;
        for (int s2 = 0; s2 < 64; ++s2) { const float u = impv[s2]; rank += (u > v || (u == v && s2 < tid)) ? 1 : 0; }
        selflag[tid] = (rank < 16 && tid <= cur) ? 1 : 0;
    }
    __syncthreads();
    if (tid == 0) { int n = 0; for (int s = 0; s < 64; ++s) if (selflag[s]) { if (n < 16) sellist[n] = s; ++n; } nsel_s = n < 16 ? n : 16; }
    __syncthreads();
    const int ns = nsel_s, ne = ns * 64;
    for (int e = tid; e < ne; e += 256) {
        const int kpos = sellist[e >> 6] * 64 + (e & 63);
        if (kpos <= t) {
            const bf16_t* kp = zb + (size_t)(b * SEQ + kpos) * DIN + ZC_KS + g * 64;
            float s0 = 0.f, s1 = 0.f, s2 = 0.f, s3 = 0.f;
            for (int dd = 0; dd < 64; ++dd) { const float kx = bf2f(kp[dd]); s0 += q[0][dd] * kx; s1 += q[1][dd] * kx; s2 += q[2][dd] * kx; s3 += q[3][dd] * kx; }
            sc[0][e] = s0; sc[1][e] = s1; sc[2][e] = s2; sc[3][e] = s3;
        } else { sc[0][e] = -1e30f; sc[1][e] = -1e30f; sc[2][e] = -1e30f; sc[3][e] = -1e30f; }
    }
    __syncthreads();
    softmax_row(sc[hh], ne, lane);
    __syncthreads();
    float o_sel = 0.f;
    for (int e = 0; e < ne; ++e) {
        const int kpos = sellist[e >> 6] * 64 + (e & 63);
        o_sel += sc[hh][e] * bf2f(zb[(size_t)(b * SEQ + kpos) * DIN + ZC_VS + g * 64 + d]);
    }
    __syncthreads();
    const int nw = (t + 1 < 512) ? (t + 1) : 512, w0 = t - nw + 1;
    for (int e = tid; e < nw; e += 256) {
        const bf16_t* kp = zb + (size_t)(b * SEQ + w0 + e) * DIN + ZC_KW + g * 64;
        float s0 = 0.f, s1 = 0.f, s2 = 0.f, s3 = 0.f;
        for (int dd = 0; dd < 64; ++dd) { const float kx = bf2f(kp[dd]); s0 += q[0][dd] * kx; s1 += q[1][dd] * kx; s2 += q[2][dd] * kx; s3 += q[3][dd] * kx; }
        sc[0][e] = s0; sc[1][e] = s1; sc[2][e] = s2; sc[3][e] = s3;
    }
    __syncthreads();
    softmax_row(sc[hh], nw, lane);
    __syncthreads();
    float o_win = 0.f;
    for (int e = 0; e < nw; ++e) o_win += sc[hh][e] * bf2f(zb[(size_t)(b * SEQ + w0 + e) * DIN + ZC_VW + g * 64 + d]);
    const float* gt = gates + (size_t)tok * 24 + (g * 4 + hh) * 3;
    Y[(size_t)tok * DM + (g * 4 + hh) * 64 + d] = f2bf(gt[0] * o_cmp + gt[1] * o_sel + gt[2] * o_win);
}

__global__ void conv_silu(const bf16_t* __restrict__ zb, const float* __restrict__ wc, const float* __restrict__ bc, bf16_t* __restrict__ out) {
    const int idx = blockIdx.x * blockDim.x + threadIdx.x;
    if (idx >= T_TOK * 1024) return;
    const int c = idx & 1023, tok = idx >> 10, t = tok & 4095;
    float y = bc[c];
#pragma unroll
    for (int j = 0; j < 4; ++j) { const int tt = t - 3 + j; if (tt >= 0) y += wc[j * 1024 + c] * bf2f(zb[(size_t)(tok - 3 + j) * DIN + ZC_MQK + c]); }
    y = y * sigmoidf_(y);
    if (c >= 512) y *= 0.08838834764831845f;
    out[idx] = f2bf(y);
}

__global__ __launch_bounds__(256) void mlstm_naive(const bf16_t* __restrict__ qkc, const bf16_t* __restrict__ zb, const float* __restrict__ ifp, float* __restrict__ hm) {
    __shared__ float qs[32][128];
    __shared__ float ks[32][128];
    __shared__ float vs[32][16];
    __shared__ float os[32][16];
    __shared__ float gi[32], gf[32];
    const int bh = blockIdx.x >> 3, vsl = blockIdx.x & 7, b = bh >> 2, h = bh & 3, tid = threadIdx.x, v = tid >> 4, kg = tid & 15;
    float C[8], n[8];
#pragma unroll
    for (int j = 0; j < 8; ++j) { C[j] = 0.f; n[j] = 0.f; }
    for (int c0 = 0; c0 < SEQ; c0 += 32) {
        __syncthreads();
        for (int e = tid; e < 32 * 128; e += 256) {
            const int s = e >> 7, k = e & 127; const size_t tok = (size_t)b * SEQ + c0 + s;
            qs[s][k] = bf2f(qkc[tok * 1024 + h * 128 + k]); ks[s][k] = bf2f(qkc[tok * 1024 + 512 + h * 128 + k]);
        }
        for (int e = tid; e < 32 * 16; e += 256) {
            const int s = e >> 4, vv = e & 15; const size_t tok = (size_t)b * SEQ + c0 + s;
            vs[s][vv] = bf2f(zb[tok * DIN + ZC_MV + h * 128 + vsl * 16 + vv]);
            os[s][vv] = sigmoidf_(bf2f(zb[tok * DIN + ZC_MO + h * 128 + vsl * 16 + vv]));
        }
        if (tid < 32) { const size_t tok = (size_t)b * SEQ + c0 + tid; gi[tid] = __expf(ifp[tok * 8 + h]); gf[tid] = sigmoidf_(ifp[tok * 8 + 4 + h]); }
        __syncthreads();
        for (int s = 0; s < 32; ++s) {
            const float f = gf[s], iv = gi[s] * vs[s][v], ig = gi[s];
            float num = 0.f, den = 0.f;
#pragma unroll
            for (int j = 0; j < 8; ++j) {
                const float kx = ks[s][kg * 8 + j], qx = qs[s][kg * 8 + j];
                C[j] = f * C[j] + iv * kx; n[j] = f * n[j] + ig * kx;
                num += C[j] * qx; den += n[j] * qx;
            }
#pragma unroll
            for (int o = 1; o < 16; o <<= 1) { num += __shfl_xor(num, o); den += __shfl_xor(den, o); }
            if (kg == 0) hm[((size_t)b * SEQ + c0 + s) * 512 + h * 128 + vsl * 16 + v] = num / fmaxf(fabsf(den), 1.0f) * os[s][v];
        }
    }
}

__global__ __launch_bounds__(256) void hnorm(const float* __restrict__ hm, const float* __restrict__ g_hn, bf16_t* __restrict__ Y) {
    const int item = blockIdx.x * 4 + (threadIdx.x >> 6), lane = threadIdx.x & 63;
    const int tok = item >> 2, h = item & 3;
    const float a = hm[(size_t)tok * 512 + h * 128 + lane], b = hm[(size_t)tok * 512 + h * 128 + 64 + lane];
    const float rstd = rsqrtf(wave_sum(a * a + b * b) * (1.f / 128.f) + 1e-6f);
    Y[(size_t)tok * DM + 512 + h * 128 + lane] = f2bf(a * rstd * g_hn[h * 128 + lane]);
    Y[(size_t)tok * DM + 512 + h * 128 + 64 + lane] = f2bf(b * rstd * g_hn[h * 128 + 64 + lane]);
}

__global__ __launch_bounds__(256) void router(const float* __restrict__ x, const float* __restrict__ g, const float* __restrict__ w_rg, const float* __restrict__ b_rg,
                                              const float* __restrict__ w_re, const float* __restrict__ b_re, bf16_t* __restrict__ xn, float* __restrict__ gate) {
    const int tok = blockIdx.x * 4 + (threadIdx.x >> 6), lane = threadIdx.x & 63;
    float xv[16]; float s = 0.f;
#pragma unroll
    for (int j = 0; j < 4; ++j) { const float4 v = ((const float4*)(x + (size_t)tok * DM))[lane + 64 * j]; xv[4 * j] = v.x; xv[4 * j + 1] = v.y; xv[4 * j + 2] = v.z; xv[4 * j + 3] = v.w; s += v.x * v.x + v.y * v.y + v.z * v.z + v.w * v.w; }
    const float rstd = rsqrtf(wave_sum(s) * (1.f / DM) + 1e-6f);
#pragma unroll
    for (int j = 0; j < 4; ++j) { const float4 gg = ((const float4*)g)[lane + 64 * j]; xv[4 * j] *= rstd * gg.x; xv[4 * j + 1] *= rstd * gg.y; xv[4 * j + 2] *= rstd * gg.z; xv[4 * j + 3] *= rstd * gg.w;
        ushort4 o; o.x = f2bf(xv[4 * j]); o.y = f2bf(xv[4 * j + 1]); o.z = f2bf(xv[4 * j + 2]); o.w = f2bf(xv[4 * j + 3]); ((ushort4*)(xn + (size_t)tok * DM))[lane + 64 * j] = o; }
    float gl[4], el[16];
#pragma unroll
    for (int c = 0; c < 4; ++c) { float a = 0.f;
#pragma unroll
        for (int j = 0; j < 4; ++j)
#pragma unroll
            for (int i = 0; i < 4; ++i) a += xv[4 * j + i] * w_rg[(size_t)(4 * (lane + 64 * j) + i) * 4 + c];
        gl[c] = wave_sum(a) + b_rg[c]; }
#pragma unroll
    for (int c = 0; c < 16; ++c) { float a = 0.f;
#pragma unroll
        for (int j = 0; j < 4; ++j)
#pragma unroll
            for (int i = 0; i < 4; ++i) a += xv[4 * j + i] * w_re[(size_t)(4 * (lane + 64 * j) + i) * 16 + c];
        el[c] = wave_sum(a) + b_re[c]; }
    if (lane == 0) {
        int gs = 0; float gm = gl[0];
#pragma unroll
        for (int c = 1; c < 4; ++c) if (gl[c] > gm) { gm = gl[c]; gs = c; }
        float se = 0.f;
#pragma unroll
        for (int c = 0; c < 4; ++c) se += __expf(gl[c] - gm);
        const float pg = 1.f / se;
        float e4[4];
#pragma unroll
        for (int c = 0; c < 4; ++c) e4[c] = gs == 0 ? el[c] : gs == 1 ? el[4 + c] : gs == 2 ? el[8 + c] : el[12 + c];
        int i0 = 0; float v0 = e4[0];
#pragma unroll
        for (int c = 1; c < 4; ++c) if (e4[c] > v0) { v0 = e4[c]; i0 = c; }
        int i1 = -1; float v1 = -3.0e38f;
#pragma unroll
        for (int c = 0; c < 4; ++c) if (c != i0 && e4[c] > v1) { v1 = e4[c]; i1 = c; }
        const float ex = __expf(v1 - v0);
        const float w0 = pg / (1.f + ex), w1 = pg * ex / (1.f + ex);
#pragma unroll
        for (int c = 0; c < 16; ++c) gate[(size_t)tok * 16 + c] = (c == gs * 4 + i0) ? w0 : (c == gs * 4 + i1) ? w1 : 0.f;
    }
}

__global__ void moe_act(const bf16_t* __restrict__ a, const float* __restrict__ gate, bf16_t* __restrict__ act, int e) {
    const int idx = blockIdx.x * blockDim.x + threadIdx.x;
    if (idx >= T_TOK * 256) return;
    const int f = idx & 255, tok = idx >> 8;
    const float gg = bf2f(a[(size_t)tok * 512 + f]), u = bf2f(a[(size_t)tok * 512 + 256 + f]);
    act[(size_t)tok * 4096 + e * 256 + f] = f2bf(gg * sigmoidf_(gg) * u * gate[(size_t)tok * 16 + e]);
}

template <class Epi>
static void launch_gemm(hipStream_t st, const bf16_t* A, int lda, const float* B, int ldb, int M, int N, int K, Epi epi) {
    dim3 grid((N + 127) / 128, M / 128);
    hipLaunchKernelGGL(gemm_v1<Epi>, grid, dim3(256), 0, st, A, lda, B, ldb, N, K, epi);
}

extern "C" void kernel_launch(void* const* d_in, const int* in_sizes, int n_in, void* d_out, int out_size, void* d_ws, size_t ws_size, hipStream_t stream) {
    const float* x = (const float*)d_in[0]; const float* p = (const float*)d_in[1]; const int* pos = (const int*)d_in[2];
    const float* g_mix = (const float*)d_in[3]; const float* w_in = (const float*)d_in[4]; const float* b_if = (const float*)d_in[5];
    const float* w_ck1 = (const float*)d_in[6]; const float* w_ck2 = (const float*)d_in[7]; const float* pe_ck = (const float*)d_in[8];
    const float* w_cv1 = (const float*)d_in[9]; const float* w_cv2 = (const float*)d_in[10]; const float* pe_cv = (const float*)d_in[11];
    const float* w_conv = (const float*)d_in[12]; const float* b_conv = (const float*)d_in[13]; const float* g_hn = (const float*)d_in[14];
    const float* w_pa = (const float*)d_in[15]; const float* w_pb = (const float*)d_in[16]; const float* w_out = (const float*)d_in[17];
    const float* g_ffn = (const float*)d_in[18]; const float* w_rg = (const float*)d_in[19]; const float* b_rg = (const float*)d_in[20];
    const float* w_re = (const float*)d_in[21]; const float* b_re = (const float*)d_in[22]; const float* w_e13 = (const float*)d_in[23];
    const float* w_e2 = (const float*)d_in[24]; const float* g_ple = (const float*)d_in[25]; const float* w_pg = (const float*)d_in[26];
    const float* w_pp = (const float*)d_in[27]; const float* g_final = (const float*)d_in[28];
    float* out = (float*)d_out;
    char* ws = (char*)d_ws;
    const size_t MiB = 1u << 20;
    bf16_t* zb = (bf16_t*)(ws);
    bf16_t* xn = (bf16_t*)(ws + 170 * MiB);
    bf16_t* Y = (bf16_t*)(ws + 202 * MiB);
    float* gates = (float*)(ws + 234 * MiB);
    float* ifp = (float*)(ws + 236 * MiB);
    float* kcc = (float*)(ws + 237 * MiB);
    float* vcc = (float*)(ws + 238 * MiB);
    float* gate16 = (float*)(ws + 239 * MiB);
    (void)ws_size; (void)n_in; (void)in_sizes; (void)out_size;

    hipLaunchKernelGGL(rmsnorm_rows, dim3(T_TOK / 4), dim3(256), 0, stream, x, g_mix, xn, (float*)nullptr, T_TOK);
    launch_gemm(stream, xn, DM, w_in, DIN, T_TOK, DIN, DM, EpiIn{zb, gates, ifp, b_if});
    hipLaunchKernelGGL(rope_apply, dim3((T_TOK * 112 + 255) / 256), dim3(256), 0, stream, zb, pos);
    hipLaunchKernelGGL(compress_naive, dim3(255, 8, 2), dim3(256), 0, stream, zb, w_ck1, w_ck2, pe_ck, w_cv1, w_cv2, pe_cv, kcc, vcc);
    hipLaunchKernelGGL(nsa_naive, dim3(T_TOK, 2), dim3(256), 0, stream, zb, kcc, vcc, gates, Y);
    bf16_t* qkc = xn;
    hipLaunchKernelGGL(conv_silu, dim3(T_TOK * 1024 / 256), dim3(256), 0, stream, zb, w_conv, b_conv, qkc);
    float* hm = out;
    hipLaunchKernelGGL(mlstm_naive, dim3(128), dim3(256), 0, stream, qkc, zb, ifp, hm);
    hipLaunchKernelGGL(hnorm, dim3(T_TOK), dim3(256), 0, stream, hm, g_hn, Y);
    float* tmp = out;
    bf16_t* mixed = xn;
    launch_gemm(stream, Y, DM, w_pa, DM, T_TOK, DM, 512, EpiPa{zb, tmp});
    launch_gemm(stream, Y + 512, DM, w_pb, DM, T_TOK, DM, 512, EpiPb{zb, tmp, mixed});
    launch_gemm(stream, mixed, DM, w_out, DM, T_TOK, DM, DM, EpiResid{x, out});
    bf16_t* xn1 = Y;
    hipLaunchKernelGGL(router, dim3(T_TOK / 4), dim3(256), 0, stream, out, g_ffn, w_rg, b_rg, w_re, b_re, xn1, gate16);
    bf16_t* abuf = xn; bf16_t* act = zb;
    for (int e = 0; e < 16; ++e) {
        launch_gemm(stream, xn1, DM, w_e13 + (size_t)e * 1024 * 512, 512, T_TOK, 512, DM, EpiBf{abuf, 512});
        hipLaunchKernelGGL(moe_act, dim3(T_TOK * 256 / 256), dim3(256), 0, stream, abuf, gate16, act, e);
    }
    launch_gemm(stream, act, 4096, w_e2, DM, T_TOK, DM, 4096, EpiResid{out, out});
    bf16_t* xn2 = Y; bf16_t* pb = (bf16_t*)(ws + 186 * MiB); float* pp = (float*)ws;
    hipLaunchKernelGGL(rmsnorm_rows, dim3(T_TOK / 4), dim3(256), 0, stream, out, g_ple, xn2, (float*)nullptr, T_TOK);
    hipLaunchKernelGGL(cvt_bf16, dim3(2048), dim3(256), 0, stream, p, pb, (size_t)T_TOK * 256);
    launch_gemm(stream, pb, 256, w_pp, DM, T_TOK, DM, 256, EpiF32{pp, DM});
    launch_gemm(stream, xn2, DM, w_pg, DM, T_TOK, DM, DM, EpiPle{out, pp});
    hipLaunchKernelGGL(rmsnorm_rows, dim3(T_TOK / 4), dim3(256), 0, stream, out, g_final, (bf16_t*)nullptr, out, T_TOK);
}
```

```cpp
#include <hip/hip_runtime.h>
#include <cstdint>
#include <cstdio>
#include <hip/hip_cooperative_groups.h>
namespace cg = cooperative_groups;

typedef unsigned short bf16_t;
typedef short bf16x8 __attribute__((ext_vector_type(8)));
typedef float f32x16 __attribute__((ext_vector_type(16)));

#define DI __device__ __forceinline__

constexpr int T_TOK = 16384, SEQ = 4096, DM = 1024, DIN = 5408;
constexpr int ZC_Q = 0, ZC_KC = 512, ZC_VC = 640, ZC_KS = 768, ZC_VS = 896, ZC_KW = 1024, ZC_VW = 1152, ZC_GATE = 1280,
              ZC_MQK = 1304, ZC_MV = 2328, ZC_MO = 2840, ZC_IF = 3352, ZC_GA = 3360, ZC_GB = 4384;

DI bf16_t f2bf(float f) { unsigned u = __float_as_uint(f); return (bf16_t)((u + 0x7fffu + ((u >> 16) & 1u)) >> 16); }
DI float bf2f(bf16_t h) { return __uint_as_float(((unsigned)h) << 16); }
DI float sigmoidf_(float x) { return 1.f / (1.f + __expf(-x)); }
DI float wave_sum(float v) {
#pragma unroll
    for (int o = 1; o < 64; o <<= 1) v += __shfl_xor(v, o);
    return v;
}
DI float wave_max(float v) {
#pragma unroll
    for (int o = 1; o < 64; o <<= 1) v = fmaxf(v, __shfl_xor(v, o));
    return v;
}

struct BMapId { DI int operator()(int n) const { return n; } };
struct BMapMoe { DI int operator()(int n) const { const int t = n >> 7, c = n & 127, e = t >> 2, jt = t & 3; return e * (1024 * 512) + ((c >> 5) & 1) * 256 + jt * 64 + (c >> 6) * 32 + (c & 31); } };
template <class Epi, class BMap>
DI void gemm_v1(int bx, int by, int tid, char* sm, const bf16_t* __restrict__ A, int lda, const float* __restrict__ B, int ldb, int N, int K, Epi epi, BMap bmap) {
    bf16_t* As = (bf16_t*)sm;
    bf16_t* Bs = (bf16_t*)(sm + 128 * 40 * 2);
    const int lane = tid & 63, w = tid >> 6, wr = w >> 1, wc = w & 1, r32 = lane & 31, hi = lane >> 5;
    const int m0 = by * 128, n0 = bx * 128;
    f32x16 acc[2][2];
#pragma unroll
    for (int i = 0; i < 2; ++i)
#pragma unroll
        for (int j = 0; j < 2; ++j)
#pragma unroll
            for (int r = 0; r < 16; ++r) acc[i][j][r] = 0.f;
    for (int k0 = 0; k0 < K; k0 += 32) {
#pragma unroll
        for (int i = 0; i < 2; ++i) {
            const int c = tid + i * 256, row = c >> 2, col = (c & 3) * 8;
            const uint4 v = *(const uint4*)(A + (size_t)(m0 + row) * lda + k0 + col);
            *(uint4*)(As + row * 40 + col) = v;
        }
#pragma unroll
        for (int i = 0; i < 4; ++i) {
            const int idx = tid + i * 256, k = idx >> 5, n = (idx & 31) * 4;
            float4 v = make_float4(0.f, 0.f, 0.f, 0.f);
            if (n0 + n < N) v = *(const float4*)(B + (size_t)(k0 + k) * ldb + bmap(n0 + n));
            Bs[(n + 0) * 40 + k] = f2bf(v.x); Bs[(n + 1) * 40 + k] = f2bf(v.y); Bs[(n + 2) * 40 + k] = f2bf(v.z); Bs[(n + 3) * 40 + k] = f2bf(v.w);
        }
        __syncthreads();
#pragma unroll
        for (int kk = 0; kk < 32; kk += 16) {
            bf16x8 a[2], b[2];
#pragma unroll
            for (int i = 0; i < 2; ++i) a[i] = *(const bf16x8*)(As + (wr * 64 + i * 32 + r32) * 40 + kk + hi * 8);
#pragma unroll
            for (int j = 0; j < 2; ++j) b[j] = *(const bf16x8*)(Bs + (wc * 64 + j * 32 + r32) * 40 + kk + hi * 8);
#pragma unroll
            for (int i = 0; i < 2; ++i)
#pragma unroll
                for (int j = 0; j < 2; ++j) acc[i][j] = __builtin_amdgcn_mfma_f32_32x32x16_bf16(a[i], b[j], acc[i][j], 0, 0, 0);
        }
        __syncthreads();
    }
#pragma unroll
    for (int i = 0; i < 2; ++i)
#pragma unroll
        for (int j = 0; j < 2; ++j)
#pragma unroll
            for (int r = 0; r < 16; ++r) {
                const int row = m0 + wr * 64 + i * 32 + (r & 3) + 8 * (r >> 2) + 4 * hi;
                const int col = n0 + wc * 64 + j * 32 + r32;
                if constexpr (Epi::PAIR) { if (j == 0) epi.pair(row, col, acc[i][0][r], acc[i][1][r]); }
                else { if (col < N) epi(row, col, acc[i][j][r]); }
            }
}

struct EpiIn { static constexpr bool PAIR = false;
    bf16_t* zb; float* gates; float* ifp; const float* b_if;
    DI void operator()(int row, int col, float v) const {
        zb[(size_t)row * DIN + col] = f2bf(v);
        if (col >= ZC_GATE && col < ZC_GATE + 24) gates[row * 24 + col - ZC_GATE] = sigmoidf_(v);
        if (col >= ZC_IF && col < ZC_IF + 8) ifp[row * 8 + col - ZC_IF] = v + b_if[col - ZC_IF];
    }
};
struct EpiPa { static constexpr bool PAIR = false;
    const bf16_t* zb; float* tmp;
    DI void operator()(int row, int col, float v) const { tmp[(size_t)row * DM + col] = sigmoidf_(bf2f(zb[(size_t)row * DIN + ZC_GA + col])) * v; }
};
struct EpiPb { static constexpr bool PAIR = false;
    const bf16_t* zb; const float* tmp; bf16_t* mixed;
    DI void operator()(int row, int col, float v) const {
        mixed[(size_t)row * DM + col] = f2bf(tmp[(size_t)row * DM + col] + sigmoidf_(bf2f(zb[(size_t)row * DIN + ZC_GB + col])) * v);
    }
};
struct EpiResid { static constexpr bool PAIR = false;
    const float* base; float* out;
    DI void operator()(int row, int col, float v) const { out[(size_t)row * DM + col] = base[(size_t)row * DM + col] + v; }
};
struct EpiBf { static constexpr bool PAIR = false;
    bf16_t* o; int ld;
    DI void operator()(int row, int col, float v) const { o[(size_t)row * ld + col] = f2bf(v); }
};
struct EpiF32 { static constexpr bool PAIR = false;
    float* o; int ld;
    DI void operator()(int row, int col, float v) const { o[(size_t)row * ld + col] = v; }
};
struct EpiPle { static constexpr bool PAIR = false;
    float* x; const float* pp;
    DI void operator()(int row, int col, float v) const { const size_t i = (size_t)row * DM + col; x[i] = x[i] + sigmoidf_(v) * pp[i]; }
};

DI void rmsnorm_rows(int bx, int tid, const float* x, const float* __restrict__ g, bf16_t* outb, float* outf, int rows) {
    const int row = bx * 4 + (tid >> 6), lane = tid & 63;
    if (row >= rows) return;
    const float4* xr = (const float4*)(x + (size_t)row * DM);
    float4 v[4]; float s = 0.f;
#pragma unroll
    for (int j = 0; j < 4; ++j) { v[j] = xr[lane + 64 * j]; s += v[j].x * v[j].x + v[j].y * v[j].y + v[j].z * v[j].z + v[j].w * v[j].w; }
    const float rstd = rsqrtf(wave_sum(s) * (1.f / DM) + 1e-6f);
#pragma unroll
    for (int j = 0; j < 4; ++j) {
        const float4 gg = ((const float4*)g)[lane + 64 * j];
        const float a = v[j].x * rstd * gg.x, b = v[j].y * rstd * gg.y, c = v[j].z * rstd * gg.z, d = v[j].w * rstd * gg.w;
        if (outf) ((float4*)(outf + (size_t)row * DM))[lane + 64 * j] = make_float4(a, b, c, d);
        else { ushort4 o; o.x = f2bf(a); o.y = f2bf(b); o.z = f2bf(c); o.w = f2bf(d); ((ushort4*)(outb + (size_t)row * DM))[lane + 64 * j] = o; }
    }
}

DI void cvt_bf16(int bx, int nb, int tid, const float* __restrict__ in, bf16_t* __restrict__ out, size_t n) {
    for (size_t i = bx * (size_t)256 + tid; i < n; i += (size_t)nb * 256) out[i] = f2bf(in[i]);
}

DI void rope_apply(int bx, int tid, bf16_t* zb, const int* __restrict__ pos) {
    const int idx = bx * 256 + tid;
    if (idx >= T_TOK * 14 * 8) return;
    const int i = idx & 7, hs = (idx >> 3) % 14, tok = idx / 112;
    int base;
    if (hs < 8) base = ZC_Q + hs * 64;
    else if (hs < 10) base = ZC_KC + (hs - 8) * 64;
    else if (hs < 12) base = ZC_KS + (hs - 10) * 64;
    else base = ZC_KW + (hs - 12) * 64;
    const float inv = powf(500000.0f, -(float)(2 * i) / 16.0f);
    const float ang = (float)pos[tok] * inv;
    float sn, cs; sincosf(ang, &sn, &cs);
    bf16_t* p = zb + (size_t)tok * DIN + base;
    const float t1 = bf2f(p[i]), t2 = bf2f(p[i + 8]);
    p[i] = f2bf(t1 * cs - t2 * sn); p[i + 8] = f2bf(t2 * cs + t1 * sn);
}

DI float gelu_tanh(float x) { const float u = 0.7978845608028654f * (x + 0.044715f * x * x * x); return 0.5f * x * (1.f + tanhf(u)); }

DI void compress_naive(int bx, int by, int bz, int tid, char* sm, const bf16_t* __restrict__ zb, const float* __restrict__ w1k, const float* __restrict__ w2k, const float* __restrict__ pek,
                                                      const float* __restrict__ w1v, const float* __restrict__ w2v, const float* __restrict__ pev, float* __restrict__ outk, float* __restrict__ outv) {
    float* flat = (float*)sm;
    float* h1 = flat + 2048;
    __syncthreads();
    const int j = bx, bg = by, kv = bz, b = bg >> 1, g = bg & 1;
    const float* w1 = kv ? w1v : w1k; const float* w2 = kv ? w2v : w2k; const float* pe = kv ? pev : pek; float* out = kv ? outv : outk;
    const int colbase = (kv ? ZC_VC : ZC_KC) + g * 64;
    for (int e = tid; e < 2048; e += 256) {
        const int i = e >> 6, d = e & 63;
        flat[e] = bf2f(zb[(size_t)(b * SEQ + 16 * j + i) * DIN + colbase + d]) + pe[e];
    }
    __syncthreads();
    float s = 0.f;
    for (int k = 0; k < 2048; ++k) s += flat[k] * w1[(size_t)k * 256 + tid];
    h1[tid] = gelu_tanh(s);
    __syncthreads();
    if (tid < 64) {
        float o = 0.f;
        for (int n = 0; n < 256; ++n) o += h1[n] * w2[n * 64 + tid];
        out[((size_t)bg * 256 + j) * 64 + tid] = o;
    }
}

DI void softmax_row(float* row, int n, int lane) {
    float m = -3.0e38f;
    for (int j = lane; j < n; j += 64) m = fmaxf(m, row[j]);
    m = wave_max(m);
    float s = 0.f;
    for (int j = lane; j < n; j += 64) { const float e = __expf(row[j] - m); row[j] = e; s += e; }
    s = wave_sum(s);
    const float inv = 1.f / s;
    for (int j = lane; j < n; j += 64) row[j] *= inv;
}

DI void nsa_naive(int bx, int by, int tid, char* sm, const bf16_t* __restrict__ zb, const float* __restrict__ kcc, const float* __restrict__ vcc, const float* __restrict__ gates, bf16_t* __restrict__ Y) {
    float (*q)[64] = (float (*)[64])sm;
    float (*sc)[1024] = (float (*)[1024])(sm + 1024);
    float* impv = (float*)(sm + 1024 + 16384);
    int* sellist = (int*)(sm + 1024 + 16384 + 256);
    int* selflag = (int*)(sm + 1024 + 16384 + 256 + 64);
    int& nsel_s = *(int*)(sm + 1024 + 16384 + 256 + 64 + 256);
    __syncthreads();
    const int tok = bx, g = by, b = tok >> 12, t = tok & 4095, hh = tid >> 6, lane = tid & 63, d = lane;
    q[hh][d] = bf2f(zb[(size_t)tok * DIN + ZC_Q + (g * 4 + hh) * 64 + d]) * 0.125f;
    __syncthreads();
    const int nv = (t >= 31) ? ((t - 15) >> 4) : 0;
    const float* kcb = kcc + (size_t)(b * 2 + g) * 256 * 64; const float* vcb = vcc + (size_t)(b * 2 + g) * 256 * 64;
    if (tid < nv) {
        float s0 = 0.f, s1 = 0.f, s2 = 0.f, s3 = 0.f;
#pragma unroll 8
        for (int dd = 0; dd < 64; ++dd) { const float kx = kcb[tid * 64 + dd]; s0 += q[0][dd] * kx; s1 += q[1][dd] * kx; s2 += q[2][dd] * kx; s3 += q[3][dd] * kx; }
        sc[0][tid] = s0; sc[1][tid] = s1; sc[2][tid] = s2; sc[3][tid] = s3;
    }
    __syncthreads();
    if (nv > 0) softmax_row(sc[hh], nv, lane);
    for (int j = nv + lane; j < 256; j += 64) sc[hh][j] = 0.f;
    __syncthreads();
    float o_cmp = 0.f;
    for (int j = 0; j < nv; ++j) o_cmp += sc[hh][j] * vcb[j * 64 + d];
    const int cur = t >> 6;
    if (tid < 64) {
        const int s = tid; int lo = 4 * s - 1; if (lo < 0) lo = 0; int hi2 = 4 * s + 3; if (hi2 > 254) hi2 = 254;
        float v = 0.f;
        for (int h2 = 0; h2 < 4; ++h2) for (int j = lo; j <= hi2; ++j) v += sc[h2][j];
        if (s == 0 || s == cur || s == cur - 1) v += 1000.0f;
        if (s > cur) v = -1e30f;
        impv[s] = v;
    }
    __syncthreads();
    if (tid < 64) {
        const float v = impv[tid]; int rank = 0;
        for (int s2 = 0; s2 < 64; ++s2) { const float u = impv[s2]; rank += (u > v || (u == v && s2 < tid)) ? 1 : 0; }
        selflag[tid] = (rank < 16 && tid <= cur) ? 1 : 0;
    }
    __syncthreads();
    if (tid == 0) { int n = 0; for (int s = 0; s < 64; ++s) if (selflag[s]) { if (n < 16) sellist[n] = s; ++n; } nsel_s = n < 16 ? n : 16; }
    __syncthreads();
    const int ns = nsel_s, ne = ns * 64;
    for (int e = tid; e < ne; e += 256) {
        const int kpos = sellist[e >> 6] * 64 + (e & 63);
        if (kpos <= t) {
            const bf16_t* kp = zb + (size_t)(b * SEQ + kpos) * DIN + ZC_KS + g * 64;
            float s0 = 0.f, s1 = 0.f, s2 = 0.f, s3 = 0.f;
    #pragma unroll 8
        for (int dd = 0; dd < 64; ++dd) { const float kx = bf2f(kp[dd]); s0 += q[0][dd] * kx; s1 += q[1][dd] * kx; s2 += q[2][dd] * kx; s3 += q[3][dd] * kx; }
            sc[0][e] = s0; sc[1][e] = s1; sc[2][e] = s2; sc[3][e] = s3;
        } else { sc[0][e] = -1e30f; sc[1][e] = -1e30f; sc[2][e] = -1e30f; sc[3][e] = -1e30f; }
    }
    __syncthreads();
    softmax_row(sc[hh], ne, lane);
    __syncthreads();
    float o_sel = 0.f;
    for (int e = 0; e < ne; ++e) {
        const int kpos = sellist[e >> 6] * 64 + (e & 63);
        o_sel += sc[hh][e] * bf2f(zb[(size_t)(b * SEQ + kpos) * DIN + ZC_VS + g * 64 + d]);
    }
    __syncthreads();
    const int nw = (t + 1 < 512) ? (t + 1) : 512, w0 = t - nw + 1;
    for (int e = tid; e < nw; e += 256) {
        const bf16_t* kp = zb + (size_t)(b * SEQ + w0 + e) * DIN + ZC_KW + g * 64;
        float s0 = 0.f, s1 = 0.f, s2 = 0.f, s3 = 0.f;
#pragma unroll 8
        for (int dd = 0; dd < 64; ++dd) { const float kx = bf2f(kp[dd]); s0 += q[0][dd] * kx; s1 += q[1][dd] * kx; s2 += q[2][dd] * kx; s3 += q[3][dd] * kx; }
        sc[0][e] = s0; sc[1][e] = s1; sc[2][e] = s2; sc[3][e] = s3;
    }
    __syncthreads();
    softmax_row(sc[hh], nw, lane);
    __syncthreads();
    float o_win = 0.f;
    for (int e = 0; e < nw; ++e) o_win += sc[hh][e] * bf2f(zb[(size_t)(b * SEQ + w0 + e) * DIN + ZC_VW + g * 64 + d]);
    const float* gt = gates + (size_t)tok * 24 + (g * 4 + hh) * 3;
    Y[(size_t)tok * DM + (g * 4 + hh) * 64 + d] = f2bf(gt[0] * o_cmp + gt[1] * o_sel + gt[2] * o_win);
}

DI void conv_silu(int bx, int tid, const bf16_t* __restrict__ zb, const float* __restrict__ wc, const float* __restrict__ bc, bf16_t* __restrict__ out) {
    const int idx = bx * 256 + tid;
    if (idx >= T_TOK * 1024) return;
    const int c = idx & 1023, tok = idx >> 10, t = tok & 4095;
    float y = bc[c];
#pragma unroll
    for (int j = 0; j < 4; ++j) { const int tt = t - 3 + j; if (tt >= 0) y += wc[j * 1024 + c] * bf2f(zb[(size_t)(tok - 3 + j) * DIN + ZC_MQK + c]); }
    y = y * sigmoidf_(y);
    if (c >= 512) y *= 0.08838834764831845f;
    out[idx] = f2bf(y);
}

DI void mlstm_naive(int bx, int tid, char* sm, const bf16_t* __restrict__ qkc, const bf16_t* __restrict__ zb, const float* __restrict__ ifp, float* __restrict__ hm) {
    float (*qs)[128] = (float (*)[128])sm;
    float (*ks)[128] = (float (*)[128])(sm + 16384);
    float (*vs)[16] = (float (*)[16])(sm + 32768);
    float (*os)[16] = (float (*)[16])(sm + 32768 + 2048);
    float* gi = (float*)(sm + 32768 + 4096); float* gf = gi + 32;
    const int bh = bx >> 3, vsl = bx & 7, b = bh >> 2, h = bh & 3, v = tid >> 4, kg = tid & 15;
    float C[8], n[8];
#pragma unroll
    for (int j = 0; j < 8; ++j) { C[j] = 0.f; n[j] = 0.f; }
    for (int c0 = 0; c0 < SEQ; c0 += 32) {
        __syncthreads();
        for (int e = tid; e < 32 * 128; e += 256) {
            const int s = e >> 7, k = e & 127; const size_t tok = (size_t)b * SEQ + c0 + s;
            qs[s][k] = bf2f(qkc[tok * 1024 + h * 128 + k]); ks[s][k] = bf2f(qkc[tok * 1024 + 512 + h * 128 + k]);
        }
        for (int e = tid; e < 32 * 16; e += 256) {
            const int s = e >> 4, vv = e & 15; const size_t tok = (size_t)b * SEQ + c0 + s;
            vs[s][vv] = bf2f(zb[tok * DIN + ZC_MV + h * 128 + vsl * 16 + vv]);
            os[s][vv] = sigmoidf_(bf2f(zb[tok * DIN + ZC_MO + h * 128 + vsl * 16 + vv]));
        }
        if (tid < 32) { const size_t tok = (size_t)b * SEQ + c0 + tid; gi[tid] = __expf(ifp[tok * 8 + h]); gf[tid] = sigmoidf_(ifp[tok * 8 + 4 + h]); }
        __syncthreads();
        for (int s = 0; s < 32; ++s) {
            const float f = gf[s], iv = gi[s] * vs[s][v], ig = gi[s];
            float num = 0.f, den = 0.f;
#pragma unroll
            for (int j = 0; j < 8; ++j) {
                const float kx = ks[s][kg * 8 + j], qx = qs[s][kg * 8 + j];
                C[j] = f * C[j] + iv * kx; n[j] = f * n[j] + ig * kx;
                num += C[j] * qx; den += n[j] * qx;
            }
#pragma unroll
            for (int o = 1; o < 16; o <<= 1) { num += __shfl_xor(num, o); den += __shfl_xor(den, o); }
            if (kg == 0) hm[((size_t)b * SEQ + c0 + s) * 512 + h * 128 + vsl * 16 + v] = num / fmaxf(fabsf(den), 1.0f) * os[s][v];
        }
    }
}

DI void hnorm(int bx, int tid, const float* __restrict__ hm, const float* __restrict__ g_hn, bf16_t* __restrict__ Y) {
    const int item = bx * 4 + (tid >> 6), lane = tid & 63;
    const int tok = item >> 2, h = item & 3;
    const float a = hm[(size_t)tok * 512 + h * 128 + lane], b = hm[(size_t)tok * 512 + h * 128 + 64 + lane];
    const float rstd = rsqrtf(wave_sum(a * a + b * b) * (1.f / 128.f) + 1e-6f);
    Y[(size_t)tok * DM + 512 + h * 128 + lane] = f2bf(a * rstd * g_hn[h * 128 + lane]);
    Y[(size_t)tok * DM + 512 + h * 128 + 64 + lane] = f2bf(b * rstd * g_hn[h * 128 + 64 + lane]);
}

DI void router(int bx, int tid, const float* __restrict__ x, const float* __restrict__ g, const float* __restrict__ w_rg, const float* __restrict__ b_rg,
                                              const float* __restrict__ w_re, const float* __restrict__ b_re, bf16_t* __restrict__ xn, float* __restrict__ gate) {
    const int tok = bx * 4 + (tid >> 6), lane = tid & 63;
    float xv[16]; float s = 0.f;
#pragma unroll
    for (int j = 0; j < 4; ++j) { const float4 v = ((const float4*)(x + (size_t)tok * DM))[lane + 64 * j]; xv[4 * j] = v.x; xv[4 * j + 1] = v.y; xv[4 * j + 2] = v.z; xv[4 * j + 3] = v.w; s += v.x * v.x + v.y * v.y + v.z * v.z + v.w * v.w; }
    const float rstd = rsqrtf(wave_sum(s) * (1.f / DM) + 1e-6f);
#pragma unroll
    for (int j = 0; j < 4; ++j) { const float4 gg = ((const float4*)g)[lane + 64 * j]; xv[4 * j] *= rstd * gg.x; xv[4 * j + 1] *= rstd * gg.y; xv[4 * j + 2] *= rstd * gg.z; xv[4 * j + 3] *= rstd * gg.w;
        ushort4 o; o.x = f2bf(xv[4 * j]); o.y = f2bf(xv[4 * j + 1]); o.z = f2bf(xv[4 * j + 2]); o.w = f2bf(xv[4 * j + 3]); ((ushort4*)(xn + (size_t)tok * DM))[lane + 64 * j] = o; }
    float mylog = 0.f;
#pragma unroll 1
    for (int c = 0; c < 20; ++c) {
        const float* w = c < 4 ? w_rg + c : w_re + (c - 4); const int ld = c < 4 ? 4 : 16;
        float a = 0.f;
#pragma unroll
        for (int j = 0; j < 4; ++j)
#pragma unroll
            for (int i = 0; i < 4; ++i) a += xv[4 * j + i] * w[(size_t)(4 * (lane + 64 * j) + i) * ld];
        a = wave_sum(a) + (c < 4 ? b_rg[c] : b_re[c - 4]);
        if (lane == c) mylog = a;
    }
    float gl[4], el[16];
#pragma unroll
    for (int c = 0; c < 4; ++c) gl[c] = __shfl(mylog, c);
#pragma unroll
    for (int c = 0; c < 16; ++c) el[c] = __shfl(mylog, 4 + c);
    if (lane == 0) {
        int gs = 0; float gm = gl[0];
#pragma unroll
        for (int c = 1; c < 4; ++c) if (gl[c] > gm) { gm = gl[c]; gs = c; }
        float se = 0.f;
#pragma unroll
        for (int c = 0; c < 4; ++c) se += __expf(gl[c] - gm);
        const float pg = 1.f / se;
        float e4[4];
#pragma unroll
        for (int c = 0; c < 4; ++c) e4[c] = gs == 0 ? el[c] : gs == 1 ? el[4 + c] : gs == 2 ? el[8 + c] : el[12 + c];
        int i0 = 0; float v0 = e4[0];
#pragma unroll
        for (int c = 1; c < 4; ++c) if (e4[c] > v0) { v0 = e4[c]; i0 = c; }
        int i1 = -1; float v1 = -3.0e38f;
#pragma unroll
        for (int c = 0; c < 4; ++c) if (c != i0 && e4[c] > v1) { v1 = e4[c]; i1 = c; }
        const float ex = __expf(v1 - v0);
        const float w0 = pg / (1.f + ex), w1 = pg * ex / (1.f + ex);
#pragma unroll
        for (int c = 0; c < 16; ++c) gate[(size_t)tok * 16 + c] = (c == gs * 4 + i0) ? w0 : (c == gs * 4 + i1) ? w1 : 0.f;
    }
}


struct EpiMoe { static constexpr bool PAIR = true;
    const float* gate; bf16_t* act;
    DI void operator()(int, int, float) const {}
    DI void pair(int row, int col, float gg, float u) const {
        const int t = col >> 7, c = col & 127, e = t >> 2, jt = t & 3, f = jt * 64 + (c >> 6) * 32 + (c & 31);
        act[(size_t)row * 4096 + e * 256 + f] = f2bf(gg * sigmoidf_(gg) * u * gate[(size_t)row * 16 + e]);
    }
};

struct Args { const float* in[29]; float* out; char* ws; };
constexpr int LDS_BYTES = 147456;

__global__ __launch_bounds__(512, 2) void mk_fwd(Args a) {
    extern __shared__ __attribute__((aligned(16))) char lds_raw[];
    cg::grid_group grid = cg::this_grid();
    const int half = threadIdx.x >> 8, tid = threadIdx.x & 255;
    char* sm = lds_raw + half * 65536;
    const int NB = gridDim.x * 2;
    const float* x = a.in[0]; const float* p = a.in[1]; const int* pos = (const int*)a.in[2];
    const float* g_mix = a.in[3]; const float* w_in = a.in[4]; const float* b_if = a.in[5];
    const float* w_ck1 = a.in[6]; const float* w_ck2 = a.in[7]; const float* pe_ck = a.in[8];
    const float* w_cv1 = a.in[9]; const float* w_cv2 = a.in[10]; const float* pe_cv = a.in[11];
    const float* w_conv = a.in[12]; const float* b_conv = a.in[13]; const float* g_hn = a.in[14];
    const float* w_pa = a.in[15]; const float* w_pb = a.in[16]; const float* w_out = a.in[17];
    const float* g_ffn = a.in[18]; const float* w_rg = a.in[19]; const float* b_rg = a.in[20];
    const float* w_re = a.in[21]; const float* b_re = a.in[22]; const float* w_e13 = a.in[23];
    const float* w_e2 = a.in[24]; const float* g_ple = a.in[25]; const float* w_pg = a.in[26];
    const float* w_pp = a.in[27]; const float* g_final = a.in[28];
    float* out = a.out; char* ws = a.ws;
    const size_t MiB = 1u << 20;
    bf16_t* zb = (bf16_t*)(ws);
    bf16_t* xn = (bf16_t*)(ws + 170 * MiB);
    bf16_t* Y = (bf16_t*)(ws + 202 * MiB);
    float* gates = (float*)(ws + 234 * MiB);
    float* ifp = (float*)(ws + 236 * MiB);
    float* kcc = (float*)(ws + 237 * MiB);
    float* vcc = (float*)(ws + 238 * MiB);
    float* gate16 = (float*)(ws + 239 * MiB);
#define VB_LOOP(nvb) for (int vb = blockIdx.x * 2 + half; vb < (nvb); vb += NB)
#define GEMM_PHASE(NT, MT, ...) do { VB_LOOP((NT) * (MT)) { const int bx_ = vb % (NT), by_ = vb / (NT); __syncthreads(); gemm_v1(bx_, by_, tid, sm, __VA_ARGS__); } } while (0)
    VB_LOOP(T_TOK / 4) rmsnorm_rows(vb, tid, x, g_mix, xn, (float*)nullptr, T_TOK);
    grid.sync();
    GEMM_PHASE(43, 128, xn, DM, w_in, DIN, DIN, DM, EpiIn{zb, gates, ifp, b_if}, BMapId{});
    grid.sync();
    VB_LOOP(T_TOK * 112 / 256) rope_apply(vb, tid, zb, pos);
    grid.sync();
    VB_LOOP(4080) { const int j = vb % 255, r = vb / 255; compress_naive(j, r & 7, r >> 3, tid, sm, zb, w_ck1, w_ck2, pe_ck, w_cv1, w_cv2, pe_cv, kcc, vcc); }
    bf16_t* qkc = xn;
    VB_LOOP(T_TOK * 1024 / 256) conv_silu(vb, tid, zb, w_conv, b_conv, qkc);
    grid.sync();
    float* hm = out;
    VB_LOOP(128) mlstm_naive(vb, tid, sm, qkc, zb, ifp, hm);
    VB_LOOP(T_TOK * 2) nsa_naive(vb >> 1, vb & 1, tid, sm, zb, kcc, vcc, gates, Y);
    grid.sync();
    VB_LOOP(T_TOK) hnorm(vb, tid, hm, g_hn, Y);
    grid.sync();
    float* tmp = out; bf16_t* mixed = xn;
    GEMM_PHASE(8, 128, Y, DM, w_pa, DM, DM, 512, EpiPa{zb, tmp}, BMapId{});
    grid.sync();
    GEMM_PHASE(8, 128, Y + 512, DM, w_pb, DM, DM, 512, EpiPb{zb, tmp, mixed}, BMapId{});
    grid.sync();
    GEMM_PHASE(8, 128, mixed, DM, w_out, DM, DM, DM, EpiResid{x, out}, BMapId{});
    grid.sync();
    bf16_t* xn1 = Y; bf16_t* act = zb;
    VB_LOOP(T_TOK / 4) router(vb, tid, out, g_ffn, w_rg, b_rg, w_re, b_re, xn1, gate16);
    grid.sync();
    GEMM_PHASE(64, 128, xn1, DM, w_e13, 512, 8192, DM, EpiMoe{gate16, act}, BMapMoe{});
    grid.sync();
    GEMM_PHASE(8, 128, act, 4096, w_e2, DM, DM, 4096, EpiResid{out, out}, BMapId{});
    grid.sync();
    bf16_t* xn2 = Y; bf16_t* pb = (bf16_t*)(ws + 186 * MiB); float* pp = (float*)ws;
    VB_LOOP(T_TOK / 4) rmsnorm_rows(vb, tid, out, g_ple, xn2, (float*)nullptr, T_TOK);
    VB_LOOP(NB) cvt_bf16(vb, NB, tid, p, pb, (size_t)T_TOK * 256);
    grid.sync();
    GEMM_PHASE(8, 128, pb, 256, w_pp, DM, DM, 256, EpiF32{pp, DM}, BMapId{});
    grid.sync();
    GEMM_PHASE(8, 128, xn2, DM, w_pg, DM, DM, DM, EpiPle{out, pp}, BMapId{});
    grid.sync();
    VB_LOOP(T_TOK / 4) rmsnorm_rows(vb, tid, out, g_final, (bf16_t*)nullptr, out, T_TOK);
}

extern "C" void kernel_launch(void* const* d_in, const int* in_sizes, int n_in, void* d_out, int out_size, void* d_ws, size_t ws_size, hipStream_t stream) {
    static int grid_blocks = 0;
    if (grid_blocks == 0) {
        int dev = 0, cus = 0, per_cu = 0;
        (void)hipGetDevice(&dev);
        (void)hipDeviceGetAttribute(&cus, hipDeviceAttributeMultiprocessorCount, dev);
        (void)hipFuncSetAttribute((const void*)mk_fwd, hipFuncAttributeMaxDynamicSharedMemorySize, LDS_BYTES);
        (void)hipOccupancyMaxActiveBlocksPerMultiprocessor(&per_cu, (const void*)mk_fwd, 512, LDS_BYTES);
        if (per_cu < 1) { fprintf(stderr, "kernel_launch: occupancy query returned %d\n", per_cu); per_cu = 1; }
        grid_blocks = cus * 1;
        fprintf(stderr, "kernel_launch: cus=%d per_cu=%d grid=%d ws=%zu\n", cus, per_cu, grid_blocks, ws_size);
    }
    Args a{};
    for (int i = 0; i < 29; ++i) a.in[i] = (const float*)d_in[i];
    a.out = (float*)d_out; a.ws = (char*)d_ws;
    void* args[] = {&a};
    hipError_t e = hipLaunchCooperativeKernel((const void*)mk_fwd, dim3(grid_blocks), dim3(512), args, LDS_BYTES, stream);
    if (e != hipSuccess) fprintf(stderr, "cooperative launch failed: %s (grid %d)\n", hipGetErrorString(e), grid_blocks);
    (void)in_sizes; (void)n_in; (void)out_size; (void)ws_size;
}
```

```cpp
#include <hip/hip_runtime.h>
#include <cstdint>
#include <cstdio>
#include <hip/hip_cooperative_groups.h>
namespace cg = cooperative_groups;

typedef unsigned short bf16_t;
typedef short bf16x8 __attribute__((ext_vector_type(8)));
typedef float f32x16 __attribute__((ext_vector_type(16)));

#define DI __device__ __forceinline__

constexpr int T_TOK = 16384, SEQ = 4096, DM = 1024, DIN = 5408, NIN = 5632;
constexpr float QSCALE = 0.125f * 1.4426950408889634f;
constexpr int ZC_Q = 0, ZC_KC = 512, ZC_VC = 640, ZC_KS = 768, ZC_VS = 896, ZC_KW = 1024, ZC_VW = 1152, ZC_GATE = 1280,
              ZC_MQK = 1304, ZC_MV = 2328, ZC_MO = 2840, ZC_IF = 3352, ZC_GA = 3360, ZC_GB = 4384;

DI bf16_t f2bf(float f) { unsigned u = __float_as_uint(f); return (bf16_t)((u + 0x7fffu + ((u >> 16) & 1u)) >> 16); }
DI float bf2f(bf16_t h) { return __uint_as_float(((unsigned)h) << 16); }
DI float sigmoidf_(float x) { return 1.f / (1.f + __expf(-x)); }
DI int lane_id_opaque() { int z = 0; asm volatile("" : "+v"(z)); return __builtin_amdgcn_mbcnt_hi(-1, __builtin_amdgcn_mbcnt_lo(-1, z)); }
DI float lane_xor(float v, int o, int lane) { return __int_as_float(__builtin_amdgcn_ds_bpermute((lane ^ o) << 2, __float_as_int(v))); }
DI float lane_get(float v, int src) { return __int_as_float(__builtin_amdgcn_ds_bpermute(src << 2, __float_as_int(v))); }
DI float wave_sum(float v) {
    const int l = lane_id_opaque();
#pragma unroll
    for (int o = 1; o < 64; o <<= 1) v += lane_xor(v, o, l);
    return v;
}
DI float wave_max(float v) {
    const int l = lane_id_opaque();
#pragma unroll
    for (int o = 1; o < 64; o <<= 1) v = fmaxf(v, lane_xor(v, o, l));
    return v;
}

namespace pg8 {
#define PG8_LAS __attribute__((address_space(3)))
typedef unsigned short bf16_t;
typedef short bf16x8 __attribute__((ext_vector_type(8)));
typedef float f32x4 __attribute__((ext_vector_type(4)));
typedef unsigned u32x4 __attribute__((ext_vector_type(4)));
constexpr int BM = 256, BK = 64, HALF = 128, HTB = HALF * BK * 2  , STAGE_BYTES = 8 * HTB, NXCD = 8, WGM = 8;

__host__ __device__ __forceinline__ int lds_byte(int r, int c) { const int st = (r >> 4) * 2 + (c >> 5), rr = r & 15, cc = c & 31, ob = rr * 64 + cc * 2; return st * 1024 + (ob ^ (((ob >> 9) & 1) << 5)); }
__host__ __device__ __forceinline__ void stage_rc(int b, int& R, int& C) { const int st = b / 1024, sb = b % 1024, swz = sb ^ (((sb >> 9) & 1) << 5); R = (st >> 1) * 16 + swz / 64; C = (st & 1) * 32 + (swz % 64) / 2; }
__host__ __device__ __forceinline__ int perm32(int rho) { const int n = rho >> 4, i = rho & 15; return 8 * (i >> 2) + 4 * n + (i & 3); }

struct Unit { int pm, pn; };
struct Gemm { const bf16_t* A; const bf16_t* Bt; int M, N, K, lda, ldb; };

struct StaticOrder {
    int nM, nN, nwg, G, c;
    __host__ __device__ __forceinline__ void init(int M, int N, int G_, int c_) { nM = M / BM; nN = N / BM; nwg = nM * nN; G = G_; c = c_; }
    __host__ __device__ __forceinline__ bool next(int i, Unit& u) const {
        const long L = (long)i * G + c; if (L >= nwg) return false;
        int wgid = (int)L; { const int q = nwg / NXCD, r = nwg % NXCD, xcd = wgid % NXCD, off = wgid / NXCD; wgid = (xcd < r ? xcd * (q + 1) : r * (q + 1) + (xcd - r) * q) + off; }
        const int nig = WGM * nN, gid = wgid / nig, fm = gid * WGM, gsz = (nM - fm) < WGM ? (nM - fm) : WGM;
        u.pm = fm + ((wgid % nig) % gsz); u.pn = (wgid % nig) / gsz; return true;
    }
    __device__ __forceinline__ void a_ready(const Unit&) const {}
    __device__ __forceinline__ void done(const Unit&) const {}
};

__device__ __forceinline__ unsigned cvt_pk_bf16(float lo, float hi) { unsigned r; asm volatile("v_cvt_pk_bf16_f32 %0, %1, %2" : "=v"(r) : "v"(lo), "v"(hi)); return r; }
typedef float f32x2 __attribute__((ext_vector_type(2)));
__device__ __forceinline__ f32x2 gelu_pk(f32x2 v) {
    const f32x2 av = __builtin_elementwise_abs(v), d = av * 0.2316418882f + 1.0f;
    f32x2 t; t.x = __builtin_amdgcn_rcpf(d.x); t.y = __builtin_amdgcn_rcpf(d.y);
    f32x2 q = t * 0.5307027145f + (-0.7265760135f); q = q * t + 0.7107068705f; q = q * t + (-0.142248368f); q = q * t + 0.127414796f; q = q * t;
    const f32x2 s = (v * v) * (-0.72134752044f);
    f32x2 e; e.x = __builtin_amdgcn_exp2f(s.x); e.y = __builtin_amdgcn_exp2f(s.y);
    const f32x2 m = v * (q * e), r = v - m;
    f32x2 o; o.x = v.x < 0.f ? m.x : r.x; o.y = v.y < 0.f ? m.y : r.y; return o;
}

template <int ACT  > struct EpiBf16 {
    static constexpr bool PERM = true, AFTER_DRAIN = false; static_assert(ACT == 0 || ACT == 1, "EpiBf16: ACT is 0 (none) or 1 (gelu_pk)");
    bf16_t* O; int ldc; const float* bias; int split_cols; size_t split_stride; float scale0;
    __device__ __forceinline__ void operator()(const f32x4 (&acc)[2][2][4][2], const Unit& u, int wr, int wc, int fr, int fq) const {
        const int row0 = u.pm * BM + wr * 64 + fr; int colt = u.pn * BM; bf16_t* base = O;
        float sc = 1.f; if (split_cols) { const int t = colt / split_cols; base += (size_t)t * split_stride; colt -= t * split_cols; if (t == 0) sc = scale0; }
        const int col0 = colt + wc * 32 + 8 * fq, bcol0 = u.pn * BM + wc * 32 + 8 * fq;
        f32x4 bv[2][2];
#pragma unroll
        for (int bj = 0; bj < 2; ++bj)
#pragma unroll
            for (int n = 0; n < 2; ++n) bv[bj][n] = bias ? *(const f32x4*)(bias + bcol0 + bj * HALF + 4 * n) : (f32x4){0.f, 0.f, 0.f, 0.f};
#pragma unroll
        for (int ai = 0; ai < 2; ++ai)
#pragma unroll
            for (int m = 0; m < 4; ++m) { bf16_t* rowp = base + (size_t)(row0 + ai * HALF + m * 16) * ldc + col0;
#pragma unroll
                for (int bj = 0; bj < 2; ++bj) { f32x4 v0 = acc[ai][bj][m][0] + bv[bj][0], v1 = acc[ai][bj][m][1] + bv[bj][1];
                    if (ACT == 1) { f32x2 a = gelu_pk((f32x2){v0[0], v0[1]}), b = gelu_pk((f32x2){v0[2], v0[3]}), c = gelu_pk((f32x2){v1[0], v1[1]}), d = gelu_pk((f32x2){v1[2], v1[3]});
                        v0 = (f32x4){a.x, a.y, b.x, b.y}; v1 = (f32x4){c.x, c.y, d.x, d.y}; }
                    v0 = v0 * sc; v1 = v1 * sc; u32x4 w; w.x = cvt_pk_bf16(v0[0], v0[1]); w.y = cvt_pk_bf16(v0[2], v0[3]); w.z = cvt_pk_bf16(v1[0], v1[1]); w.w = cvt_pk_bf16(v1[2], v1[3]);
                    *(u32x4*)(rowp + bj * HALF) = w; } }
    }
};

template <class Epi, class Sched, bool ALIGN_EPI = false, bool SP2 = false>
__device__ __forceinline__ void gemm_phase(PG8_LAS unsigned char* lds, const Gemm g, const Sched& S, const Epi& E, const int tid) {
    const int wid = __builtin_amdgcn_readfirstlane(tid >> 6), lane = tid & 63, wr = wid >> 2, wc = wid & 3, fr = lane & 15, fq = lane >> 4;
    const int K = g.K, nt = K / BK;
    unsigned voffA[2], voffB[2];
#pragma unroll
    for (int i = 0; i < 2; ++i) { int R, C; stage_rc(tid * 16 + i * 8192, R, C); const int Rb = Epi::PERM ? ((R & ~31) + perm32(R & 31)) : R;
        voffA[i] = (unsigned)(R * g.lda + C) * 2u; voffB[i] = (unsigned)(Rb * g.ldb + C) * 2u; }
    const size_t kstep = (size_t)(BK * 2);
    const size_t hstepA = (size_t)HALF * g.lda * 2, hstepB = (size_t)HALF * g.ldb * 2;
    const size_t tstepA = 2 * hstepA, tstepB = 2 * hstepB;
    const unsigned ldsw = (unsigned)wid * 1024u;
    const int aoff = lds_byte(wr * 64 + fr, fq * 8), boff = lds_byte(wc * 32 + fr, fq * 8);
#define PG8_SA(b, h) (((b) * 2 + (h)) * HTB)
#define PG8_SB(b, h) ((4 + (b) * 2 + (h)) * HTB)
#define PG8_STAGE(bufoff, gbase, voff) do { _Pragma("unroll") for (int _i = 0; _i < 2; ++_i) \
        __builtin_amdgcn_global_load_lds((const unsigned*)((const char*)(gbase) + (voff)[_i]), (PG8_LAS unsigned*)(lds + (bufoff) + ldsw + _i * 8192), 16, 0, 0); } while (0)
#define PG8_LDA(dst, b, h) do { _Pragma("unroll") for (int m = 0; m < 4; ++m) _Pragma("unroll") for (int k = 0; k < 2; ++k) dst[m][k] = *(const PG8_LAS bf16x8*)(lds + PG8_SA(b, h) + aoff + m * 2048 + k * 1024); } while (0)
#define PG8_LDB(dst, b, h) do { _Pragma("unroll") for (int n = 0; n < 2; ++n) _Pragma("unroll") for (int k = 0; k < 2; ++k) dst[n][k] = *(const PG8_LAS bf16x8*)(lds + PG8_SB(b, h) + boff + n * 2048 + k * 1024); } while (0)
#define PG8_MMA(ai, bj, At, Bt) do { __builtin_amdgcn_s_setprio(1); _Pragma("unroll") for (int m = 0; m < 4; ++m) _Pragma("unroll") for (int n = 0; n < 2; ++n) _Pragma("unroll") for (int k = 0; k < 2; ++k) \
        acc[ai][bj][m][n] = __builtin_amdgcn_mfma_f32_16x16x32_bf16(Bt[n][k], At[m][k], acc[ai][bj][m][n], 0, 0, 0); __builtin_amdgcn_s_setprio(0); } while (0)
#define PG8_WAIT_V(n) asm volatile("s_waitcnt vmcnt(" #n ")" ::: "memory")
#define PG8_WAIT_L(n) asm volatile("s_waitcnt lgkmcnt(" #n ")" ::: "memory")
#define PG8_BAR __builtin_amdgcn_s_barrier()
#define PG8_SCHED __builtin_amdgcn_sched_barrier(0)
    Unit cur, nxt; int ui = 0;
    if (!S.next(0, cur)) return;
    f32x4 acc[2][2][4][2];
#pragma unroll
    for (int a = 0; a < 2; ++a)
#pragma unroll
        for (int b = 0; b < 2; ++b)
#pragma unroll
            for (int m = 0; m < 4; ++m)
#pragma unroll
                for (int n = 0; n < 2; ++n) acc[a][b][m][n] = (f32x4){0.f, 0.f, 0.f, 0.f};
    bf16x8 At[4][2], B0[2][2], B1[2][2];
    const char* cA = (const char*)g.A + (size_t)cur.pm * tstepA; const char* cB = (const char*)g.Bt + (size_t)cur.pn * tstepB;
    S.a_ready(cur);
    if constexpr (SP2) {
        PG8_STAGE(PG8_SB(0, 0), cB, voffB); PG8_STAGE(PG8_SB(0, 1), cB + hstepB, voffB); PG8_STAGE(PG8_SA(0, 0), cA, voffA); PG8_STAGE(PG8_SA(0, 1), cA + hstepA, voffA);
        if (wr == 1) PG8_BAR;
        PG8_WAIT_V(2); PG8_BAR;
        PG8_STAGE(PG8_SB(1, 0), cB + kstep, voffB); PG8_STAGE(PG8_SA(1, 0), cA + kstep, voffA); PG8_STAGE(PG8_SB(1, 1), cB + hstepB + kstep, voffB);
        PG8_WAIT_V(6); PG8_BAR;
    } else {
        PG8_STAGE(PG8_SB(0, 0), cB, voffB); PG8_STAGE(PG8_SA(0, 0), cA, voffA); PG8_STAGE(PG8_SB(0, 1), cB + hstepB, voffB); PG8_STAGE(PG8_SA(0, 1), cA + hstepA, voffA);
        if (wr == 1) PG8_BAR;
        PG8_WAIT_V(4); PG8_BAR;
        PG8_STAGE(PG8_SB(1, 0), cB + kstep, voffB); PG8_STAGE(PG8_SA(1, 0), cA + kstep, voffA); PG8_STAGE(PG8_SB(1, 1), cB + hstepB + kstep, voffB);
        PG8_WAIT_V(6); PG8_BAR;
    }
    for (;;) {
        const bool has_next = S.next(ui + 1, nxt);
        const char* nA = has_next ? (const char*)g.A + (size_t)nxt.pm * tstepA : cA; const char* nB = has_next ? (const char*)g.Bt + (size_t)nxt.pn * tstepB : cB;
        for (int t = 0; t < nt; t += 2) {
            const bool last = (t == nt - 2);
            const char* a1 = cA + (size_t)(t + 1) * kstep;
            const char* a2 = last ? nA : cA + (size_t)(t + 2) * kstep; const char* b2 = last ? nB : cB + (size_t)(t + 2) * kstep;
            const char* a3 = a2 + kstep; const char* b3 = b2 + kstep;
            if (last && has_next) S.a_ready(nxt);
            if constexpr (SP2) {
            PG8_LDB(B0, 0, 0); PG8_LDB(B1, 0, 1); PG8_SCHED; PG8_LDA(At, 0, 0); PG8_STAGE(PG8_SA(1, 1), a1 + hstepA, voffA);
            PG8_WAIT_V(8); PG8_WAIT_L(0); PG8_BAR; PG8_MMA(0, 0, At, B0); PG8_MMA(0, 1, At, B1); PG8_BAR; PG8_SCHED;
            PG8_LDA(At, 0, 1); PG8_STAGE(PG8_SB(0, 0), b2, voffB); PG8_STAGE(PG8_SB(0, 1), b2 + hstepB, voffB); PG8_STAGE(PG8_SA(0, 0), a2, voffA);
            PG8_WAIT_V(8); PG8_WAIT_L(0); PG8_BAR; PG8_MMA(1, 0, At, B0); PG8_MMA(1, 1, At, B1); PG8_BAR; PG8_SCHED;
            PG8_LDB(B0, 1, 0); PG8_LDB(B1, 1, 1); PG8_SCHED; PG8_LDA(At, 1, 0); PG8_STAGE(PG8_SA(0, 1), a2 + hstepA, voffA);
            PG8_WAIT_V(8); PG8_WAIT_L(0); PG8_BAR; PG8_MMA(0, 0, At, B0); PG8_MMA(0, 1, At, B1); PG8_BAR; PG8_SCHED;
            PG8_LDA(At, 1, 1); PG8_STAGE(PG8_SB(1, 0), b3, voffB); PG8_STAGE(PG8_SB(1, 1), b3 + hstepB, voffB); PG8_STAGE(PG8_SA(1, 0), a3, voffA);
            PG8_WAIT_V(8); PG8_WAIT_L(0); PG8_BAR; PG8_MMA(1, 0, At, B0); PG8_MMA(1, 1, At, B1); PG8_BAR; PG8_SCHED;
            } else {
            PG8_LDB(B0, 0, 0); PG8_SCHED; PG8_LDA(At, 0, 0); PG8_STAGE(PG8_SA(1, 1), a1 + hstepA, voffA);
            PG8_WAIT_L(8); PG8_BAR; PG8_WAIT_L(0); PG8_MMA(0, 0, At, B0); PG8_BAR; PG8_SCHED;
            PG8_LDB(B1, 0, 1); PG8_STAGE(PG8_SB(0, 0), b2, voffB);
            PG8_BAR; PG8_WAIT_L(0); PG8_MMA(0, 1, At, B1); PG8_BAR;
            PG8_LDA(At, 0, 1); PG8_STAGE(PG8_SA(0, 0), a2, voffA);
            PG8_BAR; PG8_WAIT_L(0); PG8_MMA(1, 0, At, B0); PG8_BAR; PG8_SCHED;
            PG8_STAGE(PG8_SB(0, 1), b2 + hstepB, voffB);
            PG8_WAIT_V(6); PG8_BAR; PG8_MMA(1, 1, At, B1); PG8_BAR;
            PG8_LDB(B0, 1, 0); PG8_SCHED; PG8_LDA(At, 1, 0); PG8_STAGE(PG8_SA(0, 1), a2 + hstepA, voffA);
            PG8_WAIT_L(8); PG8_BAR; PG8_WAIT_L(0); PG8_MMA(0, 0, At, B0); PG8_BAR; PG8_SCHED;
            PG8_LDB(B1, 1, 1); PG8_STAGE(PG8_SB(1, 0), b3, voffB);
            PG8_BAR; PG8_WAIT_L(0); PG8_MMA(0, 1, At, B1); PG8_BAR;
            PG8_LDA(At, 1, 1); PG8_STAGE(PG8_SA(1, 0), a3, voffA);
            PG8_BAR; PG8_WAIT_L(0); PG8_MMA(1, 0, At, B0); PG8_BAR; PG8_SCHED;
            PG8_STAGE(PG8_SB(1, 1), b3 + hstepB, voffB);
            PG8_WAIT_V(6); PG8_BAR; PG8_MMA(1, 1, At, B1); PG8_BAR;
            }
        }
        if constexpr (ALIGN_EPI) { if (wr == 0) PG8_BAR; }
        if constexpr (!Epi::AFTER_DRAIN) { E(acc, cur, wr, wc, fr, fq); S.done(cur); }
        if (!has_next) break;
#pragma unroll
        for (int a = 0; a < 2; ++a)
#pragma unroll
            for (int b = 0; b < 2; ++b)
#pragma unroll
                for (int m = 0; m < 4; ++m)
#pragma unroll
                    for (int n = 0; n < 2; ++n) acc[a][b][m][n] = (f32x4){0.f, 0.f, 0.f, 0.f};
        cur = nxt; cA = nA; cB = nB; ++ui;
        if constexpr (ALIGN_EPI) { if (wr == 1) PG8_BAR; }
    }
    PG8_WAIT_V(0);
    if constexpr (!ALIGN_EPI) { if (wr == 0) PG8_BAR; }
    PG8_BAR;
    if constexpr (Epi::AFTER_DRAIN) { E.fused(acc, cur, wr, wc, fr, fq, lds, wid, lane); S.done(cur); }
#undef PG8_SA
#undef PG8_SB
#undef PG8_STAGE
#undef PG8_LDA
#undef PG8_LDB
#undef PG8_MMA
#undef PG8_WAIT_V
#undef PG8_WAIT_L
#undef PG8_BAR
#undef PG8_SCHED
}
}


#define LAS __attribute__((address_space(3)))
DI unsigned pk2(float lo, float hi) { return (unsigned)f2bf(lo) | ((unsigned)f2bf(hi) << 16); }
template <class Map>
DI void prep_wt_item(const float* __restrict__ W, int ldw, int K, bf16_t* __restrict__ WT, const float* __restrict__ gain, Map map, float* scr, int item, int nblk, int lane) {
    const int kb = item / nblk, nb = item % nblk, k0 = 64 * kb, n0 = 32 * nb;
    const int srcn = map(n0 + (lane & 31));
#pragma unroll 8
    for (int i = 0; i < 32; ++i) { const int kk = 2 * i + (lane >> 5); float v = 0.f; if (srcn >= 0) { v = W[(size_t)(k0 + kk) * ldw + srcn]; if (gain) v *= gain[k0 + kk]; } scr[kk * 33 + (lane & 31)] = v; }
    __builtin_amdgcn_s_waitcnt(0xC07F); asm volatile("" ::: "memory");
    const int c = lane & 7;
#pragma unroll
    for (int j = 0; j < 4; ++j) { const int n = (lane >> 3) + 8 * j; const float* s = scr + (8 * c) * 33 + n;
        uint4 o; o.x = pk2(s[0 * 33], s[1 * 33]); o.y = pk2(s[2 * 33], s[3 * 33]); o.z = pk2(s[4 * 33], s[5 * 33]); o.w = pk2(s[6 * 33], s[7 * 33]);
        *(uint4*)(WT + (size_t)(n0 + n) * K + k0 + 8 * c) = o; }
    __builtin_amdgcn_s_waitcnt(0xC07F); asm volatile("" ::: "memory");
}
struct MapIn {
    DI int operator()(int n) const {
        if (n < 1280) return n;
        if (n < 1536) { const int i = n - 1280; return i < 24 ? ZC_GATE + i : (i < 32 ? ZC_IF + (i - 24) : -1); }
        if (n < 2560) return ZC_MQK + (n - 1536);
        if (n < 3072) return ZC_MV + (n - 2560);
        if (n < 3584) return ZC_MO + (n - 3072);
        return ZC_GA + (n - 3584);
    }
};
DI void prep_x_row(const float* __restrict__ x, bf16_t* __restrict__ xb, float* __restrict__ rstd, int row, int lane) {
    const float4* xr = (const float4*)(x + (size_t)row * DM);
    float4 v[4]; float s = 0.f;
#pragma unroll
    for (int j = 0; j < 4; ++j) { v[j] = xr[lane + 64 * j]; s += v[j].x * v[j].x + v[j].y * v[j].y + v[j].z * v[j].z + v[j].w * v[j].w; }
    s = wave_sum(s);
    if (lane == 0) rstd[row] = rsqrtf(s * (1.f / DM) + 1e-6f);
#pragma unroll
    for (int j = 0; j < 4; ++j) { uint2 o; o.x = pk2(v[j].x, v[j].y); o.y = pk2(v[j].z, v[j].w); ((uint2*)(xb + (size_t)row * DM))[lane + 64 * j] = o; }
}

struct EpiInProj {
    static constexpr bool PERM = true, AFTER_DRAIN = false;
    const float* rstd; const float* cosT; const float* sinT; const float* b_if;
    bf16_t* Qb; bf16_t* KVb; float* gates; float* ifp; bf16_t* MQK; bf16_t* MV; bf16_t* MO; bf16_t* MG; bf16_t* VT;
    DI void operator()(const pg8::f32x4 (&acc)[2][2][4][2], const pg8::Unit& u, int wr, int wc, int fr, int fq) const {
        const int pn = u.pn;
        asm volatile("" : "+v"(fr), "+v"(fq));
#pragma unroll
        for (int ai = 0; ai < 2; ++ai)
#pragma unroll
            for (int m = 0; m < 4; ++m) {
                const int row = u.pm * 256 + ai * 128 + wr * 64 + m * 16 + fr;
                const float rs = rstd[row];
#pragma unroll
                for (int bj = 0; bj < 2; ++bj) {
                    float v[8];
#pragma unroll
                    for (int i = 0; i < 4; ++i) { v[i] = acc[ai][bj][m][0][i] * rs; v[4 + i] = acc[ai][bj][m][1][i] * rs; }
                    const int c0 = bj * 128 + wc * 32 + 8 * fq;
                    if (pn <= 4) {
                        const bool is_k = (pn < 2) || (bj == 0);
                        if (is_k && (wc & 1) == 0) {
                            const float4 c_lo = *(const float4*)(cosT + (size_t)row * 8), c_hi = *(const float4*)(cosT + (size_t)row * 8 + 4);
                            const float4 s_lo = *(const float4*)(sinT + (size_t)row * 8), s_hi = *(const float4*)(sinT + (size_t)row * 8 + 4);
                            const float cs[8] = {c_lo.x, c_lo.y, c_lo.z, c_lo.w, c_hi.x, c_hi.y, c_hi.z, c_hi.w};
                            const float sn[8] = {s_lo.x, s_lo.y, s_lo.z, s_lo.w, s_hi.x, s_hi.y, s_hi.z, s_hi.w};
                            const int l_ = lane_id_opaque();
#pragma unroll
                            for (int i = 0; i < 8; ++i) {
                                const float other = lane_xor(v[i], 16, l_);
                                if (fq == 0) v[i] = v[i] * cs[i] - other * sn[i];
                                else if (fq == 1) v[i] = v[i] * cs[i] + other * sn[i];
                            }
                        }
                        const float sc = pn < 2 ? QSCALE : 1.f;
                        pg8::u32x4 w; w.x = pg8::cvt_pk_bf16(v[0] * sc, v[1] * sc); w.y = pg8::cvt_pk_bf16(v[2] * sc, v[3] * sc); w.z = pg8::cvt_pk_bf16(v[4] * sc, v[5] * sc); w.w = pg8::cvt_pk_bf16(v[6] * sc, v[7] * sc);
                        if (pn < 2) *(pg8::u32x4*)(Qb + (size_t)row * 512 + pn * 256 + c0) = w;
                        else if (pn == 2) *(pg8::u32x4*)(KVb + (size_t)row * 512 + c0) = w;
                        else if (bj == 0) *(pg8::u32x4*)(KVb + (size_t)row * 512 + (pn - 2) * 128 + 128 + wc * 32 + 8 * fq) = w;
                        else {
                            const int cv = wc * 32 + 8 * fq, gg = cv >> 6, d0 = cv & 63, bb = row >> 12, tt = row & 4095;
                            bf16_t* vt = VT + ((size_t)((pn - 3) * 8 + bb * 2 + gg) * 64 + (tt >> 6)) * 4096 + (size_t)d0 * 64 + (tt & 63);
                            vt[0] = (bf16_t)(w.x & 0xffffu); vt[64] = (bf16_t)(w.x >> 16); vt[128] = (bf16_t)(w.y & 0xffffu); vt[192] = (bf16_t)(w.y >> 16);
                            vt[256] = (bf16_t)(w.z & 0xffffu); vt[320] = (bf16_t)(w.z >> 16); vt[384] = (bf16_t)(w.w & 0xffffu); vt[448] = (bf16_t)(w.w >> 16);
                        }
                    } else if (pn == 5) {
                        if (bj == 0 && wc == 0) {
#pragma unroll
                            for (int i = 0; i < 8; ++i) { const int c = 8 * fq + i;
                                if (c < 24) gates[(size_t)row * 24 + c] = sigmoidf_(v[i]);
                                else if (c < 32) ifp[(size_t)row * 8 + (c - 24)] = v[i] + b_if[c - 24]; }
                        }
                    } else {
                        if (pn >= 14) {
#pragma unroll
                            for (int i = 0; i < 8; ++i) v[i] = sigmoidf_(v[i]);
                        }
                        pg8::u32x4 w; w.x = pg8::cvt_pk_bf16(v[0], v[1]); w.y = pg8::cvt_pk_bf16(v[2], v[3]); w.z = pg8::cvt_pk_bf16(v[4], v[5]); w.w = pg8::cvt_pk_bf16(v[6], v[7]);
                        bf16_t* dst;
                        if (pn < 10) dst = MQK + (size_t)row * 1024 + (pn - 6) * 256 + c0;
                        else if (pn < 12) dst = MV + (size_t)row * 512 + (pn - 10) * 256 + c0;
                        else if (pn < 14) dst = MO + (size_t)row * 512 + (pn - 12) * 256 + c0;
                        else dst = MG + (size_t)row * 2048 + (pn - 14) * 256 + c0;
                        *(pg8::u32x4*)dst = w;
                    }
                }
            }
    }
};


DI pg8::u32x4 pack8(const float (&v)[8]) { pg8::u32x4 w; w.x = pg8::cvt_pk_bf16(v[0], v[1]); w.y = pg8::cvt_pk_bf16(v[2], v[3]); w.z = pg8::cvt_pk_bf16(v[4], v[5]); w.w = pg8::cvt_pk_bf16(v[6], v[7]); return w; }
DI void unpack8(const pg8::u32x4 w, float (&v)[8]) {
    v[0] = __uint_as_float(w.x << 16); v[1] = __uint_as_float(w.x & 0xffff0000u); v[2] = __uint_as_float(w.y << 16); v[3] = __uint_as_float(w.y & 0xffff0000u);
    v[4] = __uint_as_float(w.z << 16); v[5] = __uint_as_float(w.z & 0xffff0000u); v[6] = __uint_as_float(w.w << 16); v[7] = __uint_as_float(w.w & 0xffff0000u);
}
#define EPI_ROWS_BEGIN asm volatile("" : "+v"(fr), "+v"(fq)); _Pragma("unroll") for (int ai = 0; ai < 2; ++ai) _Pragma("unroll") for (int m = 0; m < 4; ++m) { const int row = u.pm * 256 + ai * 128 + wr * 64 + m * 16 + fr; _Pragma("unroll") for (int bj = 0; bj < 2; ++bj) { \
    float v[8]; _Pragma("unroll") for (int i = 0; i < 4; ++i) { v[i] = acc[ai][bj][m][0][i]; v[4 + i] = acc[ai][bj][m][1][i]; } const int c0 = bj * 128 + wc * 32 + 8 * fq; (void)c0; (void)row;
#define EPI_ROWS_END } asm volatile("" ::: "memory"); }
template <int MODE> struct EpiMerge {
    static constexpr bool PERM = true, AFTER_DRAIN = false;
    const bf16_t* MG; float* tmp; bf16_t* mixed;
    DI void operator()(const pg8::f32x4 (&acc)[2][2][4][2], const pg8::Unit& u, int wr, int wc, int fr, int fq) const {
        EPI_ROWS_BEGIN
            const int col = u.pn * 256 + c0; float gt[8];
            unpack8(*(const pg8::u32x4*)(MG + (size_t)row * 2048 + MODE * 1024 + col), gt);
            float* tp = tmp + (size_t)row * DM + col;
            if (MODE == 0) {
                *(float4*)tp = make_float4(gt[0] * v[0], gt[1] * v[1], gt[2] * v[2], gt[3] * v[3]); *(float4*)(tp + 4) = make_float4(gt[4] * v[4], gt[5] * v[5], gt[6] * v[6], gt[7] * v[7]);
            } else {
                const float4 t0 = *(const float4*)tp, t1 = *(const float4*)(tp + 4);
                float o[8] = {t0.x + gt[0] * v[0], t0.y + gt[1] * v[1], t0.z + gt[2] * v[2], t0.w + gt[3] * v[3], t1.x + gt[4] * v[4], t1.y + gt[5] * v[5], t1.z + gt[6] * v[6], t1.w + gt[7] * v[7]};
                *(pg8::u32x4*)(mixed + (size_t)row * DM + col) = pack8(o);
            }
        EPI_ROWS_END
    }
};
struct EpiX1 {
    static constexpr bool PERM = true, AFTER_DRAIN = false;
    const float* base; float* out;
    DI void operator()(const pg8::f32x4 (&acc)[2][2][4][2], const pg8::Unit& u, int wr, int wc, int fr, int fq) const {
        EPI_ROWS_BEGIN
            const size_t o = (size_t)row * DM + u.pn * 256 + c0;
            const float4 b0 = *(const float4*)(base + o), b1 = *(const float4*)(base + o + 4);
            *(float4*)(out + o) = make_float4(b0.x + v[0], b0.y + v[1], b0.z + v[2], b0.w + v[3]); *(float4*)(out + o + 4) = make_float4(b1.x + v[4], b1.y + v[5], b1.z + v[6], b1.w + v[7]);
        EPI_ROWS_END
    }
};
struct EpiStoreBf {
    static constexpr bool PERM = true, AFTER_DRAIN = false;
    bf16_t* O; int ld; int pnmask;
    DI void operator()(const pg8::f32x4 (&acc)[2][2][4][2], const pg8::Unit& u, int wr, int wc, int fr, int fq) const {
        EPI_ROWS_BEGIN
            *(pg8::u32x4*)(O + (size_t)row * ld + (u.pn & pnmask) * 256 + c0) = pack8(v);
        EPI_ROWS_END
    }
};
struct EpiSwiglu {
    static constexpr bool PERM = true, AFTER_DRAIN = false;
    bf16_t* act;
    DI void operator()(const pg8::f32x4 (&acc)[2][2][4][2], const pg8::Unit& u, int wr, int wc, int fr, int fq) const {
        asm volatile("" : "+v"(fr), "+v"(fq));
#pragma unroll
        for (int ai = 0; ai < 2; ++ai)
#pragma unroll
            for (int m = 0; m < 4; ++m) {
                const int row = u.pm * 256 + ai * 128 + wr * 64 + m * 16 + fr; float o[8];
#pragma unroll
                for (int i = 0; i < 4; ++i) { const float g0 = acc[ai][0][m][0][i], g1 = acc[ai][0][m][1][i]; o[i] = g0 * sigmoidf_(g0) * acc[ai][1][m][0][i]; o[4 + i] = g1 * sigmoidf_(g1) * acc[ai][1][m][1][i]; }
                *(pg8::u32x4*)(act + (size_t)row * 256 + (u.pn & 1) * 128 + wc * 32 + 8 * fq) = pack8(o);
            }
    }
};
struct EpiPle2 {
    static constexpr bool PERM = true, AFTER_DRAIN = false;
    float* x; const bf16_t* PP; const float* rstd;
    DI void operator()(const pg8::f32x4 (&acc)[2][2][4][2], const pg8::Unit& u, int wr, int wc, int fr, int fq) const {
        EPI_ROWS_BEGIN
            const size_t o = (size_t)row * DM + u.pn * 256 + c0; const float rs = rstd[row]; float pp[8];
            unpack8(*(const pg8::u32x4*)(PP + o), pp);
            const float4 b0 = *(const float4*)(x + o), b1 = *(const float4*)(x + o + 4);
            *(float4*)(x + o) = make_float4(b0.x + sigmoidf_(rs * v[0]) * pp[0], b0.y + sigmoidf_(rs * v[1]) * pp[1], b0.z + sigmoidf_(rs * v[2]) * pp[2], b0.w + sigmoidf_(rs * v[3]) * pp[3]);
            *(float4*)(x + o + 4) = make_float4(b1.x + sigmoidf_(rs * v[4]) * pp[4], b1.y + sigmoidf_(rs * v[5]) * pp[5], b1.z + sigmoidf_(rs * v[6]) * pp[6], b1.w + sigmoidf_(rs * v[7]) * pp[7]);
        EPI_ROWS_END
    }
};
struct MoeOrder {
    const int* cnt; int NJ, G, c;
    DI bool next(int i, pg8::Unit& u) const {
        int L = i * G + c, tb = 0;
        for (int e = 0; e < 16; ++e) { const int mt = (cnt[e] + 255) >> 8, n = mt * NJ; if (L < n) { u.pm = tb + L / NJ; u.pn = e * NJ + L % NJ; return true; } L -= n; tb += mt; }
        return false;
    }
    DI void a_ready(const pg8::Unit&) const {}
    DI void done(const pg8::Unit&) const {}
};
DI int moe_base_row(const int* cnt, int e) { int tb = 0; for (int k = 0; k < 16; ++k) { if (k < e) tb += (cnt[k] + 255) >> 8; } return tb * 256; }
struct MapId { DI int operator()(int n) const { return n; } };
struct MapE13 { DI int operator()(int n) const { return ((n >> 7) & 1) * 256 + (n >> 8) * 128 + (n & 127); } };

DI void router2(int tok, int lane, const float* __restrict__ x, const float* __restrict__ g, const float* __restrict__ w_rg, const float* __restrict__ b_rg,
                const float* __restrict__ w_re, const float* __restrict__ b_re, float* __restrict__ rstd1, int* __restrict__ rinfo, int* cnt) {
    float xv[16]; float s = 0.f;
#pragma unroll
    for (int j = 0; j < 4; ++j) { const float4 v = ((const float4*)(x + (size_t)tok * DM))[lane + 64 * j]; xv[4 * j] = v.x; xv[4 * j + 1] = v.y; xv[4 * j + 2] = v.z; xv[4 * j + 3] = v.w; s += v.x * v.x + v.y * v.y + v.z * v.z + v.w * v.w; }
    const float rstd = rsqrtf(wave_sum(s) * (1.f / DM) + 1e-6f);
#pragma unroll
    for (int j = 0; j < 4; ++j) { const float4 gg = ((const float4*)g)[lane + 64 * j]; xv[4 * j] *= rstd * gg.x; xv[4 * j + 1] *= rstd * gg.y; xv[4 * j + 2] *= rstd * gg.z; xv[4 * j + 3] *= rstd * gg.w; }
    float mylog = 0.f;
#pragma unroll 1
    for (int c = 0; c < 20; ++c) {
        const float* w = c < 4 ? w_rg + c : w_re + (c - 4); const int ld = c < 4 ? 4 : 16;
        float a = 0.f;
#pragma unroll
        for (int j = 0; j < 4; ++j)
#pragma unroll
            for (int i = 0; i < 4; ++i) a += xv[4 * j + i] * w[(size_t)(4 * (lane + 64 * j) + i) * ld];
        a = wave_sum(a) + (c < 4 ? b_rg[c] : b_re[c - 4]);
        if (lane == c) mylog = a;
    }
    float gl[4], el[16];
#pragma unroll
    for (int c = 0; c < 4; ++c) gl[c] = lane_get(mylog, c);
#pragma unroll
    for (int c = 0; c < 16; ++c) el[c] = lane_get(mylog, 4 + c);
    if (lane == 0) {
        int gs = 0; float gm = gl[0];
#pragma unroll
        for (int c = 1; c < 4; ++c) if (gl[c] > gm) { gm = gl[c]; gs = c; }
        float se = 0.f;
#pragma unroll
        for (int c = 0; c < 4; ++c) se += __expf(gl[c] - gm);
        const float pg = 1.f / se;
        float e4[4];
#pragma unroll
        for (int c = 0; c < 4; ++c) e4[c] = gs == 0 ? el[c] : gs == 1 ? el[4 + c] : gs == 2 ? el[8 + c] : el[12 + c];
        int i0 = 0; float v0 = e4[0];
#pragma unroll
        for (int c = 1; c < 4; ++c) if (e4[c] > v0) { v0 = e4[c]; i0 = c; }
        int i1 = -1; float v1 = -3.0e38f;
#pragma unroll
        for (int c = 0; c < 4; ++c) if (c != i0 && e4[c] > v1) { v1 = e4[c]; i1 = c; }
        const float ex = __expf(v1 - v0);
        const float w0 = pg / (1.f + ex), w1 = pg * ex / (1.f + ex);
        const int e0 = gs * 4 + i0, e1 = gs * 4 + i1;
        const int p0 = atomicAdd(cnt + e0, 1), p1 = atomicAdd(cnt + e1, 1);
        rstd1[tok] = rstd;
        int4 ri; ri.x = e0 | (e1 << 8); ri.y = p0 | (p1 << 16); ri.z = __float_as_int(w0); ri.w = __float_as_int(w1);
        *(int4*)(rinfo + (size_t)tok * 4) = ri;
    }
}

struct BMapId { DI int operator()(int n) const { return n; } };
struct BMapMoe { DI int operator()(int n) const { const int t = n >> 7, c = n & 127, e = t >> 2, jt = t & 3; return e * (1024 * 512) + ((c >> 5) & 1) * 256 + jt * 64 + (c >> 6) * 32 + (c & 31); } };
template <class Epi, class BMap>
DI void gemm_v1(int bx, int by, int tid, char* sm, const bf16_t* __restrict__ A, int lda, const float* __restrict__ B, int ldb, int N, int K, Epi epi, BMap bmap) {
    bf16_t* As = (bf16_t*)sm;
    bf16_t* Bs = (bf16_t*)(sm + 128 * 40 * 2);
    const int lane = tid & 63, w = tid >> 6, wr = w >> 1, wc = w & 1, r32 = lane & 31, hi = lane >> 5;
    const int m0 = by * 128, n0 = bx * 128;
    f32x16 acc[2][2];
#pragma unroll
    for (int i = 0; i < 2; ++i)
#pragma unroll
        for (int j = 0; j < 2; ++j)
#pragma unroll
            for (int r = 0; r < 16; ++r) acc[i][j][r] = 0.f;
    for (int k0 = 0; k0 < K; k0 += 32) {
#pragma unroll
        for (int i = 0; i < 2; ++i) {
            const int c = tid + i * 256, row = c >> 2, col = (c & 3) * 8;
            const uint4 v = *(const uint4*)(A + (size_t)(m0 + row) * lda + k0 + col);
            *(uint4*)(As + row * 40 + col) = v;
        }
#pragma unroll
        for (int i = 0; i < 4; ++i) {
            const int idx = tid + i * 256, k = idx >> 5, n = (idx & 31) * 4;
            float4 v = make_float4(0.f, 0.f, 0.f, 0.f);
            if (n0 + n < N) v = *(const float4*)(B + (size_t)(k0 + k) * ldb + bmap(n0 + n));
            Bs[(n + 0) * 40 + k] = f2bf(v.x); Bs[(n + 1) * 40 + k] = f2bf(v.y); Bs[(n + 2) * 40 + k] = f2bf(v.z); Bs[(n + 3) * 40 + k] = f2bf(v.w);
        }
        __syncthreads();
#pragma unroll
        for (int kk = 0; kk < 32; kk += 16) {
            bf16x8 a[2], b[2];
#pragma unroll
            for (int i = 0; i < 2; ++i) a[i] = *(const bf16x8*)(As + (wr * 64 + i * 32 + r32) * 40 + kk + hi * 8);
#pragma unroll
            for (int j = 0; j < 2; ++j) b[j] = *(const bf16x8*)(Bs + (wc * 64 + j * 32 + r32) * 40 + kk + hi * 8);
#pragma unroll
            for (int i = 0; i < 2; ++i)
#pragma unroll
                for (int j = 0; j < 2; ++j) acc[i][j] = __builtin_amdgcn_mfma_f32_32x32x16_bf16(a[i], b[j], acc[i][j], 0, 0, 0);
        }
        __syncthreads();
    }
#pragma unroll
    for (int i = 0; i < 2; ++i)
#pragma unroll
        for (int j = 0; j < 2; ++j)
#pragma unroll
            for (int r = 0; r < 16; ++r) {
                const int row = m0 + wr * 64 + i * 32 + (r & 3) + 8 * (r >> 2) + 4 * hi;
                const int col = n0 + wc * 64 + j * 32 + r32;
                if constexpr (Epi::PAIR) { if (j == 0) epi.pair(row, col, acc[i][0][r], acc[i][1][r]); }
                else { if (col < N) epi(row, col, acc[i][j][r]); }
            }
}

struct EpiPa { static constexpr bool PAIR = false;
    const bf16_t* MG; float* tmp;
    DI void operator()(int row, int col, float v) const { tmp[(size_t)row * DM + col] = bf2f(MG[(size_t)row * 2048 + col]) * v; }
};
struct EpiPb { static constexpr bool PAIR = false;
    const bf16_t* MG; const float* tmp; bf16_t* mixed;
    DI void operator()(int row, int col, float v) const {
        mixed[(size_t)row * DM + col] = f2bf(tmp[(size_t)row * DM + col] + bf2f(MG[(size_t)row * 2048 + 1024 + col]) * v);
    }
};
struct EpiResid { static constexpr bool PAIR = false;
    const float* base; float* out;
    DI void operator()(int row, int col, float v) const { out[(size_t)row * DM + col] = base[(size_t)row * DM + col] + v; }
};
struct EpiBf { static constexpr bool PAIR = false;
    bf16_t* o; int ld;
    DI void operator()(int row, int col, float v) const { o[(size_t)row * ld + col] = f2bf(v); }
};
struct EpiF32 { static constexpr bool PAIR = false;
    float* o; int ld;
    DI void operator()(int row, int col, float v) const { o[(size_t)row * ld + col] = v; }
};
struct EpiPle { static constexpr bool PAIR = false;
    float* x; const float* pp;
    DI void operator()(int row, int col, float v) const { const size_t i = (size_t)row * DM + col; x[i] = x[i] + sigmoidf_(v) * pp[i]; }
};

DI void rmsnorm_rows(int bx, int tid, const float* x, const float* __restrict__ g, bf16_t* outb, float* outf, int rows) {
    const int row = bx * 4 + (tid >> 6), lane = tid & 63;
    if (row >= rows) return;
    const float4* xr = (const float4*)(x + (size_t)row * DM);
    float4 v[4]; float s = 0.f;
#pragma unroll
    for (int j = 0; j < 4; ++j) { v[j] = xr[lane + 64 * j]; s += v[j].x * v[j].x + v[j].y * v[j].y + v[j].z * v[j].z + v[j].w * v[j].w; }
    const float rstd = rsqrtf(wave_sum(s) * (1.f / DM) + 1e-6f);
#pragma unroll
    for (int j = 0; j < 4; ++j) {
        const float4 gg = ((const float4*)g)[lane + 64 * j];
        const float a = v[j].x * rstd * gg.x, b = v[j].y * rstd * gg.y, c = v[j].z * rstd * gg.z, d = v[j].w * rstd * gg.w;
        if (outf) ((float4*)(outf + (size_t)row * DM))[lane + 64 * j] = make_float4(a, b, c, d);
        else { ushort4 o; o.x = f2bf(a); o.y = f2bf(b); o.z = f2bf(c); o.w = f2bf(d); ((ushort4*)(outb + (size_t)row * DM))[lane + 64 * j] = o; }
    }
}

DI void cvt_bf16(int bx, int nb, int tid, const float* __restrict__ in, bf16_t* __restrict__ out, size_t n) {
    for (size_t i = bx * (size_t)256 + tid; i < n; i += (size_t)nb * 256) out[i] = f2bf(in[i]);
}

DI float gelu_tanh(float x) { const float u = 0.7978845608028654f * (x + 0.044715f * x * x * x); return 0.5f * x * (1.f + tanhf(u)); }

DI void compress_naive(int bx, int by, int bz, int tid, char* sm, const bf16_t* __restrict__ KVb, const float* __restrict__ w1k, const float* __restrict__ w2k, const float* __restrict__ pek,
                                                      const float* __restrict__ w1v, const float* __restrict__ w2v, const float* __restrict__ pev, float* __restrict__ outk, float* __restrict__ outv, bf16_t* __restrict__ kcb, bf16_t* __restrict__ vcT) {
    float* flat = (float*)sm;
    float* h1 = flat + 2048;
    __syncthreads();
    const int j = bx, bg = by, kv = bz, b = bg >> 1, g = bg & 1;
    const float* w1 = kv ? w1v : w1k; const float* w2 = kv ? w2v : w2k; const float* pe = kv ? pev : pek; float* out = kv ? outv : outk;
    const int colbase = (kv ? 128 : 0) + g * 64;
    for (int e = tid; e < 2048; e += 256) {
        const int i = e >> 6, d = e & 63;
        flat[e] = bf2f(KVb[(size_t)(b * SEQ + 16 * j + i) * 512 + colbase + d]) + pe[e];
    }
    __syncthreads();
    float s = 0.f;
    for (int k = 0; k < 2048; ++k) s += flat[k] * w1[(size_t)k * 256 + tid];
    h1[tid] = gelu_tanh(s);
    __syncthreads();
    if (tid < 64) {
        float o = 0.f;
        for (int n = 0; n < 256; ++n) o += h1[n] * w2[n * 64 + tid];
        out[((size_t)bg * 256 + j) * 64 + tid] = o;
        if (kv == 0) { kcb[((size_t)bg * 256 + j) * 64 + tid] = f2bf(o); if (j == 254) kcb[((size_t)bg * 256 + 255) * 64 + tid] = 0; }
        else { vcT[((size_t)bg * 4 + (j >> 6)) * 4096 + tid * 64 + (j & 63)] = f2bf(o); if (j == 254) vcT[((size_t)bg * 4 + 3) * 4096 + tid * 64 + 63] = 0; }
    }
}

DI void softmax_row(float* row, int n, int lane) {
    float m = -3.0e38f;
    for (int j = lane; j < n; j += 64) m = fmaxf(m, row[j]);
    m = wave_max(m);
    float s = 0.f;
    for (int j = lane; j < n; j += 64) { const float e = exp2f(row[j] - m); row[j] = e; s += e; }
    s = wave_sum(s);
    const float inv = 1.f / s;
    for (int j = lane; j < n; j += 64) row[j] *= inv;
}

DI void nsa_naive(int bx, int by, int tid, char* sm, const bf16_t* __restrict__ Qb, const bf16_t* __restrict__ KVb, const bf16_t* __restrict__ VT, const float* __restrict__ kcc, const float* __restrict__ vcc, const float* __restrict__ gates, bf16_t* __restrict__ Y) {
    float (*q)[64] = (float (*)[64])sm;
    float (*sc)[1024] = (float (*)[1024])(sm + 1024);
    float* impv = (float*)(sm + 1024 + 16384);
    int* sellist = (int*)(sm + 1024 + 16384 + 256);
    int* selflag = (int*)(sm + 1024 + 16384 + 256 + 64);
    int& nsel_s = *(int*)(sm + 1024 + 16384 + 256 + 64 + 256);
    __syncthreads();
    const int tok = bx, g = by, b = tok >> 12, t = tok & 4095, hh = tid >> 6, lane = tid & 63, d = lane;
    q[hh][d] = bf2f(Qb[(size_t)tok * 512 + (g * 4 + hh) * 64 + d]);
    __syncthreads();
    const int nv = (t >= 31) ? ((t - 15) >> 4) : 0;
    const float* kcb = kcc + (size_t)(b * 2 + g) * 256 * 64; const float* vcb = vcc + (size_t)(b * 2 + g) * 256 * 64;
    if (tid < nv) {
        float s0 = 0.f, s1 = 0.f, s2 = 0.f, s3 = 0.f;
#pragma unroll 8
        for (int dd = 0; dd < 64; ++dd) { const float kx = kcb[tid * 64 + dd]; s0 += q[0][dd] * kx; s1 += q[1][dd] * kx; s2 += q[2][dd] * kx; s3 += q[3][dd] * kx; }
        sc[0][tid] = s0; sc[1][tid] = s1; sc[2][tid] = s2; sc[3][tid] = s3;
    }
    __syncthreads();
    if (nv > 0) softmax_row(sc[hh], nv, lane);
    for (int j = nv + lane; j < 256; j += 64) sc[hh][j] = 0.f;
    __syncthreads();
    float o_cmp = 0.f;
    for (int j = 0; j < nv; ++j) o_cmp += sc[hh][j] * vcb[j * 64 + d];
    const int cur = t >> 6;
    if (tid < 64) {
        const int s = tid; int lo = 4 * s - 1; if (lo < 0) lo = 0; int hi2 = 4 * s + 3; if (hi2 > 254) hi2 = 254;
        float v = 0.f;
        for (int h2 = 0; h2 < 4; ++h2) for (int j = lo; j <= hi2; ++j) v += sc[h2][j];
        if (s == 0 || s == cur || s == cur - 1) v += 1000.0f;
        if (s > cur) v = -1e30f;
        impv[s] = v;
    }
    __syncthreads();
    if (tid < 64) {
        const float v = impv[tid]; int rank = 0;
        for (int s2 = 0; s2 < 64; ++s2) { const float u = impv[s2]; rank += (u > v || (u == v && s2 < tid)) ? 1 : 0; }
        selflag[tid] = (rank < 16 && tid <= cur) ? 1 : 0;
    }
    __syncthreads();
    if (tid == 0) { int n = 0; for (int s = 0; s < 64; ++s) if (selflag[s]) { if (n < 16) sellist[n] = s; ++n; } nsel_s = n < 16 ? n : 16; }
    __syncthreads();
    const int ns = nsel_s, ne = ns * 64;
    for (int e = tid; e < ne; e += 256) {
        const int kpos = sellist[e >> 6] * 64 + (e & 63);
        if (kpos <= t) {
            const bf16_t* kp = KVb + (size_t)(b * SEQ + kpos) * 512 + 256 + g * 64;
            float s0 = 0.f, s1 = 0.f, s2 = 0.f, s3 = 0.f;
    #pragma unroll 8
        for (int dd = 0; dd < 64; ++dd) { const float kx = bf2f(kp[dd]); s0 += q[0][dd] * kx; s1 += q[1][dd] * kx; s2 += q[2][dd] * kx; s3 += q[3][dd] * kx; }
            sc[0][e] = s0; sc[1][e] = s1; sc[2][e] = s2; sc[3][e] = s3;
        } else { sc[0][e] = -1e30f; sc[1][e] = -1e30f; sc[2][e] = -1e30f; sc[3][e] = -1e30f; }
    }
    __syncthreads();
    softmax_row(sc[hh], ne, lane);
    __syncthreads();
    float o_sel = 0.f;
    for (int e = 0; e < ne; ++e) {
        const int kpos = sellist[e >> 6] * 64 + (e & 63);
        o_sel += sc[hh][e] * bf2f(VT[((size_t)(b * 2 + g) * 64 + (kpos >> 6)) * 4096 + d * 64 + (kpos & 63)]);
    }
    __syncthreads();
    const int nw = (t + 1 < 512) ? (t + 1) : 512, w0 = t - nw + 1;
    for (int e = tid; e < nw; e += 256) {
        const bf16_t* kp = KVb + (size_t)(b * SEQ + w0 + e) * 512 + 384 + g * 64;
        float s0 = 0.f, s1 = 0.f, s2 = 0.f, s3 = 0.f;
#pragma unroll 8
        for (int dd = 0; dd < 64; ++dd) { const float kx = bf2f(kp[dd]); s0 += q[0][dd] * kx; s1 += q[1][dd] * kx; s2 += q[2][dd] * kx; s3 += q[3][dd] * kx; }
        sc[0][e] = s0; sc[1][e] = s1; sc[2][e] = s2; sc[3][e] = s3;
    }
    __syncthreads();
    softmax_row(sc[hh], nw, lane);
    __syncthreads();
    float o_win = 0.f;
    for (int e = 0; e < nw; ++e) { const int kpos = w0 + e; o_win += sc[hh][e] * bf2f(VT[((size_t)(8 + b * 2 + g) * 64 + (kpos >> 6)) * 4096 + d * 64 + (kpos & 63)]); }
    const float* gt = gates + (size_t)tok * 24 + (g * 4 + hh) * 3;
    Y[(size_t)tok * DM + (g * 4 + hh) * 64 + d] = f2bf(gt[0] * o_cmp + gt[1] * o_sel + gt[2] * o_win);
}

DI void conv_silu(int bx, int tid, const bf16_t* __restrict__ MQK, const float* __restrict__ wc, const float* __restrict__ bc, bf16_t* __restrict__ out) {
    const int idx = bx * 256 + tid;
    if (idx >= T_TOK * 1024) return;
    const int c = idx & 1023, tok = idx >> 10, t = tok & 4095;
    float y = bc[c];
#pragma unroll
    for (int j = 0; j < 4; ++j) { const int tt = t - 3 + j; if (tt >= 0) y += wc[j * 1024 + c] * bf2f(MQK[(size_t)(tok - 3 + j) * 1024 + c]); }
    y = y * sigmoidf_(y);
    if (c >= 512) y *= 0.08838834764831845f;
    out[idx] = f2bf(y);
}

DI void mlstm_naive(int bx, int tid, char* sm, const bf16_t* __restrict__ qkc, const bf16_t* __restrict__ MV, const bf16_t* __restrict__ MO, const float* __restrict__ ifp, float* __restrict__ hm) {
    float (*qs)[128] = (float (*)[128])sm;
    float (*ks)[128] = (float (*)[128])(sm + 16384);
    float (*vs)[16] = (float (*)[16])(sm + 32768);
    float (*os)[16] = (float (*)[16])(sm + 32768 + 2048);
    float* gi = (float*)(sm + 32768 + 4096); float* gf = gi + 32;
    const int bh = bx >> 3, vsl = bx & 7, b = bh >> 2, h = bh & 3, v = tid >> 4, kg = tid & 15;
    float C[8], n[8];
#pragma unroll
    for (int j = 0; j < 8; ++j) { C[j] = 0.f; n[j] = 0.f; }
    for (int c0 = 0; c0 < SEQ; c0 += 32) {
        __syncthreads();
        for (int e = tid; e < 32 * 128; e += 256) {
            const int s = e >> 7, k = e & 127; const size_t tok = (size_t)b * SEQ + c0 + s;
            qs[s][k] = bf2f(qkc[tok * 1024 + h * 128 + k]); ks[s][k] = bf2f(qkc[tok * 1024 + 512 + h * 128 + k]);
        }
        for (int e = tid; e < 32 * 16; e += 256) {
            const int s = e >> 4, vv = e & 15; const size_t tok = (size_t)b * SEQ + c0 + s;
            vs[s][vv] = bf2f(MV[tok * 512 + h * 128 + vsl * 16 + vv]);
            os[s][vv] = sigmoidf_(bf2f(MO[tok * 512 + h * 128 + vsl * 16 + vv]));
        }
        if (tid < 32) { const size_t tok = (size_t)b * SEQ + c0 + tid; gi[tid] = __expf(ifp[tok * 8 + h]); gf[tid] = sigmoidf_(ifp[tok * 8 + 4 + h]); }
        __syncthreads();
        for (int s = 0; s < 32; ++s) {
            const float f = gf[s], iv = gi[s] * vs[s][v], ig = gi[s];
            float num = 0.f, den = 0.f;
#pragma unroll
            for (int j = 0; j < 8; ++j) {
                const float kx = ks[s][kg * 8 + j], qx = qs[s][kg * 8 + j];
                C[j] = f * C[j] + iv * kx; n[j] = f * n[j] + ig * kx;
                num += C[j] * qx; den += n[j] * qx;
            }
            const int l_ = lane_id_opaque();
#pragma unroll
            for (int o = 1; o < 16; o <<= 1) { num += lane_xor(num, o, l_); den += lane_xor(den, o, l_); }
            if (kg == 0) hm[((size_t)b * SEQ + c0 + s) * 512 + h * 128 + vsl * 16 + v] = num / fmaxf(fabsf(den), 1.0f) * os[s][v];
        }
    }
}

DI void hnorm(int bx, int tid, const float* __restrict__ hm, const float* __restrict__ g_hn, bf16_t* __restrict__ Y) {
    const int item = bx * 4 + (tid >> 6), lane = tid & 63;
    const int tok = item >> 2, h = item & 3;
    const float a = hm[(size_t)tok * 512 + h * 128 + lane], b = hm[(size_t)tok * 512 + h * 128 + 64 + lane];
    const float rstd = rsqrtf(wave_sum(a * a + b * b) * (1.f / 128.f) + 1e-6f);
    Y[(size_t)tok * DM + 512 + h * 128 + lane] = f2bf(a * rstd * g_hn[h * 128 + lane]);
    Y[(size_t)tok * DM + 512 + h * 128 + 64 + lane] = f2bf(b * rstd * g_hn[h * 128 + 64 + lane]);
}

DI void router(int bx, int tid, const float* __restrict__ x, const float* __restrict__ g, const float* __restrict__ w_rg, const float* __restrict__ b_rg,
                                              const float* __restrict__ w_re, const float* __restrict__ b_re, bf16_t* __restrict__ xn, float* __restrict__ gate) {
    const int tok = bx * 4 + (tid >> 6), lane = tid & 63;
    float xv[16]; float s = 0.f;
#pragma unroll
    for (int j = 0; j < 4; ++j) { const float4 v = ((const float4*)(x + (size_t)tok * DM))[lane + 64 * j]; xv[4 * j] = v.x; xv[4 * j + 1] = v.y; xv[4 * j + 2] = v.z; xv[4 * j + 3] = v.w; s += v.x * v.x + v.y * v.y + v.z * v.z + v.w * v.w; }
    const float rstd = rsqrtf(wave_sum(s) * (1.f / DM) + 1e-6f);
#pragma unroll
    for (int j = 0; j < 4; ++j) { const float4 gg = ((const float4*)g)[lane + 64 * j]; xv[4 * j] *= rstd * gg.x; xv[4 * j + 1] *= rstd * gg.y; xv[4 * j + 2] *= rstd * gg.z; xv[4 * j + 3] *= rstd * gg.w;
        ushort4 o; o.x = f2bf(xv[4 * j]); o.y = f2bf(xv[4 * j + 1]); o.z = f2bf(xv[4 * j + 2]); o.w = f2bf(xv[4 * j + 3]); ((ushort4*)(xn + (size_t)tok * DM))[lane + 64 * j] = o; }
    float mylog = 0.f;
#pragma unroll 1
    for (int c = 0; c < 20; ++c) {
        const float* w = c < 4 ? w_rg + c : w_re + (c - 4); const int ld = c < 4 ? 4 : 16;
        float a = 0.f;
#pragma unroll
        for (int j = 0; j < 4; ++j)
#pragma unroll
            for (int i = 0; i < 4; ++i) a += xv[4 * j + i] * w[(size_t)(4 * (lane + 64 * j) + i) * ld];
        a = wave_sum(a) + (c < 4 ? b_rg[c] : b_re[c - 4]);
        if (lane == c) mylog = a;
    }
    float gl[4], el[16];
#pragma unroll
    for (int c = 0; c < 4; ++c) gl[c] = lane_get(mylog, c);
#pragma unroll
    for (int c = 0; c < 16; ++c) el[c] = lane_get(mylog, 4 + c);
    if (lane == 0) {
        int gs = 0; float gm = gl[0];
#pragma unroll
        for (int c = 1; c < 4; ++c) if (gl[c] > gm) { gm = gl[c]; gs = c; }
        float se = 0.f;
#pragma unroll
        for (int c = 0; c < 4; ++c) se += __expf(gl[c] - gm);
        const float pg = 1.f / se;
        float e4[4];
#pragma unroll
        for (int c = 0; c < 4; ++c) e4[c] = gs == 0 ? el[c] : gs == 1 ? el[4 + c] : gs == 2 ? el[8 + c] : el[12 + c];
        int i0 = 0; float v0 = e4[0];
#pragma unroll
        for (int c = 1; c < 4; ++c) if (e4[c] > v0) { v0 = e4[c]; i0 = c; }
        int i1 = -1; float v1 = -3.0e38f;
#pragma unroll
        for (int c = 0; c < 4; ++c) if (c != i0 && e4[c] > v1) { v1 = e4[c]; i1 = c; }
        const float ex = __expf(v1 - v0);
        const float w0 = pg / (1.f + ex), w1 = pg * ex / (1.f + ex);
#pragma unroll
        for (int c = 0; c < 16; ++c) gate[(size_t)tok * 16 + c] = (c == gs * 4 + i0) ? w0 : (c == gs * 4 + i1) ? w1 : 0.f;
    }
}


struct EpiMoe { static constexpr bool PAIR = true;
    const float* gate; bf16_t* act;
    DI void operator()(int, int, float) const {}
    DI void pair(int row, int col, float gg, float u) const {
        const int t = col >> 7, c = col & 127, e = t >> 2, jt = t & 3, f = jt * 64 + (c >> 6) * 32 + (c & 31);
        act[(size_t)row * 4096 + e * 256 + f] = f2bf(gg * sigmoidf_(gg) * u * gate[(size_t)row * 16 + e]);
    }
};

typedef float f32x2_t __attribute__((ext_vector_type(2))); typedef __bf16 bf16x2_t __attribute__((ext_vector_type(2)));
DI unsigned cvtpk(float lo, float hi) { f32x2_t v = {lo, hi}; bf16x2_t b = __builtin_convertvector(v, bf16x2_t); return __builtin_bit_cast(unsigned, b); }
typedef __attribute__((address_space(3))) char lds_c;
typedef unsigned u32x2v __attribute__((ext_vector_type(2))); typedef unsigned u32x4v __attribute__((ext_vector_type(4)));
constexpr int NSA_KC = 0, NSA_VC = 4 * 9216, NSA_KB = NSA_VC + 4 * 8704, NSA_VB = NSA_KB + 2 * 9216, NSA_IMP = NSA_VB + 2 * 8704, NSA_MASK = NSA_IMP + 64 * 65 * 4, NSA_END = NSA_MASK + 512;
static_assert(NSA_END <= 147456, "NSA LDS map");
DI int crow(int r, int hi) { return (r & 3) + 8 * (r >> 2) + 4 * hi; }
#define MFMA32(a, b, c) __builtin_amdgcn_mfma_f32_32x32x16_bf16((a), (b), (c), 0, 0, 0)

DI void nsa_qk(f32x16& p0, f32x16& p1, const lds_c* K, const bf16x8 (&qf)[4], int r32, int hi) {
#pragma unroll
    for (int r = 0; r < 16; ++r) { p0[r] = 0.f; p1[r] = 0.f; }
#pragma unroll
    for (int ks = 0; ks < 4; ++ks) {
        const bf16x8 a0 = *(const __attribute__((address_space(3))) bf16x8*)(K + r32 * 144 + ks * 32 + hi * 16);
        const bf16x8 a1 = *(const __attribute__((address_space(3))) bf16x8*)(K + (32 + r32) * 144 + ks * 32 + hi * 16);
        p0 = MFMA32(a0, qf[ks], p0); p1 = MFMA32(a1, qf[ks], p1);
    }
}
DI void nsa_softmax(f32x16& p0, f32x16& p1, float& m, float& l, f32x16& o0, f32x16& o1) {
    float mx = fmaxf(p0[0], p1[0]);
#pragma unroll
    for (int r = 1; r < 16; ++r) mx = fmaxf(mx, fmaxf(p0[r], p1[r]));
    { auto rr = __builtin_amdgcn_permlane32_swap(__float_as_uint(mx), __float_as_uint(mx), false, false); mx = fmaxf(__uint_as_float(rr[0]), __uint_as_float(rr[1])); }
    const float mn = fmaxf(m, mx), alpha = __builtin_amdgcn_exp2f(m - mn);
    m = mn;
    float s = 0.f;
#pragma unroll
    for (int r = 0; r < 16; ++r) { p0[r] = __builtin_amdgcn_exp2f(p0[r] - mn); p1[r] = __builtin_amdgcn_exp2f(p1[r] - mn); s += p0[r] + p1[r]; }
    l = l * alpha + s;
#pragma unroll
    for (int r = 0; r < 16; ++r) { o0[r] *= alpha; o1[r] *= alpha; }
}
DI void nsa_pv(f32x16& o0, f32x16& o1, const f32x16& p0, const f32x16& p1, const lds_c* V, int r32, int hi) {
#pragma unroll
    for (int hf = 0; hf < 2; ++hf)
#pragma unroll
        for (int s = 0; s < 2; ++s) {
            unsigned pw[4];
#pragma unroll
            for (int j = 0; j < 4; ++j) pw[j] = hf ? cvtpk(p1[8 * s + 2 * j], p1[8 * s + 2 * j + 1]) : cvtpk(p0[8 * s + 2 * j], p0[8 * s + 2 * j + 1]);
            const u32x4v pbw = {pw[0], pw[1], pw[2], pw[3]};
            const bf16x8 pb = __builtin_bit_cast(bf16x8, pbw);
            const lds_c* vp = V + r32 * 136 + hf * 64 + s * 32 + hi * 8;
            const u32x2v a0l = *(const __attribute__((address_space(3))) u32x2v*)(vp), a0h = *(const __attribute__((address_space(3))) u32x2v*)(vp + 16);
            const u32x2v a1l = *(const __attribute__((address_space(3))) u32x2v*)(vp + 32 * 136), a1h = *(const __attribute__((address_space(3))) u32x2v*)(vp + 32 * 136 + 16);
            const u32x4v A0w = {a0l.x, a0l.y, a0h.x, a0h.y}, A1w = {a1l.x, a1l.y, a1h.x, a1h.y};
            o0 = MFMA32(__builtin_bit_cast(bf16x8, A0w), pb, o0); o1 = MFMA32(__builtin_bit_cast(bf16x8, A1w), pb, o1);
        }
}
DI void nsa_store_k(lds_c* K, const u32x4v v, int tid) { *(__attribute__((address_space(3))) u32x4v*)(K + (tid >> 3) * 144 + (tid & 7) * 16) = v; }
DI void nsa_store_v(lds_c* V, const u32x4v v, int tid) { lds_c* p = V + (tid >> 3) * 136 + (tid & 7) * 16; *(__attribute__((address_space(3))) u32x2v*)p = (u32x2v){v.x, v.y}; *(__attribute__((address_space(3))) u32x2v*)(p + 8) = (u32x2v){v.z, v.w}; }
#define NEG_INF (-__builtin_inff())
DI void nsa_finish(f32x16& y0, f32x16& y1, f32x16& o0, f32x16& o1, float& m, float& l, float gate) {
    float lt; { auto rr = __builtin_amdgcn_permlane32_swap(__float_as_uint(l), __float_as_uint(l), false, false); lt = __uint_as_float(rr[0]) + __uint_as_float(rr[1]); }
    const float f = lt > 0.f ? gate / lt : 0.f;
#pragma unroll
    for (int r = 0; r < 16; ++r) { y0[r] += f * o0[r]; y1[r] += f * o1[r]; o0[r] = 0.f; o1[r] = 0.f; }
    m = -1e30f; l = 0.f;
}

DI void nsa_unit(int bg, int qb, int tx, lds_c* lds, const bf16_t* __restrict__ Qb, const bf16_t* __restrict__ KVb, const bf16_t* __restrict__ VT, const bf16_t* __restrict__ kcb, const bf16_t* __restrict__ vcT,
                 const float* __restrict__ gates, bf16_t* __restrict__ Y) {
    const int lane = tx & 63, r32 = lane & 31, hi = lane >> 5, wave = __builtin_amdgcn_readfirstlane(tx >> 6), hh = wave >> 1, qs = wave & 1;
    const int b = bg >> 1, g = bg & 1, ql = 32 * qs + r32, tq = 64 * qb + ql;
    const size_t tok = (size_t)b * SEQ + tq; const int head = g * 4 + hh;
    const int nc = (4 * qb + 66) >> 6;
    const bool need_topk = qb >= 16;
    lds_c* KC = lds + NSA_KC; lds_c* VC = lds + NSA_VC; lds_c* KB = lds + NSA_KB; lds_c* VB = lds + NSA_VB;
    __attribute__((address_space(3))) float* imp = (__attribute__((address_space(3))) float*)(lds + NSA_IMP);
    __attribute__((address_space(3))) unsigned* msk = (__attribute__((address_space(3))) unsigned*)(lds + NSA_MASK);
    const bf16_t* kcsrc = kcb + (size_t)bg * 256 * 64; const bf16_t* vcsrc = vcT + (size_t)bg * 4 * 4096;
    const bf16_t* kssrc = KVb + (size_t)b * SEQ * 512 + 256 + g * 64; const bf16_t* kwsrc = KVb + (size_t)b * SEQ * 512 + 384 + g * 64;
    const bf16_t* vssrc = VT + (size_t)bg * 64 * 4096; const bf16_t* vwsrc = VT + (size_t)(8 + bg) * 64 * 4096;
    const int n_sel = qb + 1, n_win = qb + 1 < 9 ? qb + 1 : 9, ntile = n_sel + n_win;
    __syncthreads();
    for (int c = 0; c < nc; ++c) {
        nsa_store_k(KC + c * 9216, *(const u32x4v*)(kcsrc + (size_t)(c * 64 + (tx >> 3)) * 64 + (tx & 7) * 8), tx);
        nsa_store_v(VC + c * 8704, *(const u32x4v*)(vcsrc + (size_t)c * 4096 + (tx >> 3) * 64 + (tx & 7) * 8), tx);
    }
    nsa_store_k(KB, *(const u32x4v*)(kssrc + (size_t)(tx >> 3) * 512 + (tx & 7) * 8), tx);
    nsa_store_v(VB, *(const u32x4v*)(vssrc + (tx >> 3) * 64 + (tx & 7) * 8), tx);
    for (int i = tx; i < 64 * 65; i += 512) imp[i] = 0.f;
    bf16x8 qf[4];
#pragma unroll
    for (int ks = 0; ks < 4; ++ks) qf[ks] = *(const bf16x8*)(Qb + tok * 512 + head * 64 + ks * 16 + hi * 8);
    const float g_cmp = gates[tok * 24 + head * 3 + 0], g_sel = gates[tok * 24 + head * 3 + 1], g_win = gates[tok * 24 + head * 3 + 2];
    f32x16 y0, y1, o0, o1, p0, p1;
#pragma unroll
    for (int r = 0; r < 16; ++r) { y0[r] = 0.f; y1[r] = 0.f; o0[r] = 0.f; o1[r] = 0.f; }
    float m = -1e30f, l = 0.f;
    __syncthreads();
    const int nvq = tq >= 31 ? ((tq - 15) >> 4) : 0;
    for (int c = 0; c < nc; ++c) {
        nsa_qk(p0, p1, KC + c * 9216, qf, r32, hi);
        const int lim = nvq - 64 * c;
#pragma unroll
        for (int r = 0; r < 16; ++r) { const int kl = crow(r, hi); if (kl >= lim) p0[r] = NEG_INF; if (kl + 32 >= lim) p1[r] = NEG_INF; }
        nsa_softmax(p0, p1, m, l, o0, o1);
        nsa_pv(o0, o1, p0, p1, VC + c * 8704, r32, hi);
    }
    const float m_c = m; float l_c; { auto rr = __builtin_amdgcn_permlane32_swap(__float_as_uint(l), __float_as_uint(l), false, false); l_c = __uint_as_float(rr[0]) + __uint_as_float(rr[1]); }
    nsa_finish(y0, y1, o0, o1, m, l, g_cmp);
    unsigned mlo = 0xffffffffu, mhi = 0xffffffffu;
    if (need_topk) {
        const float invl = l_c > 0.f ? 1.f / l_c : 0.f;
        for (int c = 0; c < nc; ++c) {
            nsa_qk(p0, p1, KC + c * 9216, qf, r32, hi);
            const int lim = nvq - 64 * c;
#pragma unroll
            for (int r = 0; r < 16; ++r) { const int kl = crow(r, hi);
                p0[r] = kl < lim ? __builtin_amdgcn_exp2f(p0[r] - m_c) * invl : 0.f; p1[r] = kl + 32 < lim ? __builtin_amdgcn_exp2f(p1[r] - m_c) * invl : 0.f; }
            for (int h = 0; h < 4; ++h) {
                if (hh == h) {
#pragma unroll
                    for (int hf = 0; hf < 2; ++hf)
#pragma unroll
                        for (int i = 0; i < 4; ++i) {
                            const int a = 16 * c + 8 * hf + 2 * i + hi;
                            const float gsum = hf ? (p1[4 * i] + p1[4 * i + 1]) + (p1[4 * i + 2] + p1[4 * i + 3]) : (p0[4 * i] + p0[4 * i + 1]) + (p0[4 * i + 2] + p0[4 * i + 3]);
                            imp[ql * 65 + a] += gsum;
                        }
                    asm volatile("s_waitcnt lgkmcnt(0)" ::: "memory");
#pragma unroll
                    for (int hf = 0; hf < 2; ++hf)
#pragma unroll
                        for (int i = 0; i < 4; ++i) {
                            const int a = 16 * c + 8 * hf + 2 * i + hi;
                            const float last = hf ? p1[4 * i + 3] : p0[4 * i + 3];
                            if (a + 1 < 64) imp[ql * 65 + a + 1] += last;
                        }
                }
                __syncthreads();
            }
        }
        {
            const int q = tx >> 3, j8 = tx & 7, smax = qb - 2;
            unsigned blo = 0u, bhi = 0u;
#pragma unroll 1
            for (int k = 0; k < 8; ++k) {
                const int s = j8 + 8 * k;
                if (s >= 1 && s <= smax) {
                    const float v = imp[q * 65 + s]; int rank = 0;
                    for (int s2 = 1; s2 <= smax; ++s2) { const float u = imp[q * 65 + s2]; rank += (u > v || (u == v && s2 < s)) ? 1 : 0; }
                    if (rank < 13) { if (s < 32) blo |= 1u << s; else bhi |= 1u << (s - 32); }
                }
            }
            const int l_ = lane_id_opaque();
#pragma unroll
            for (int o = 1; o < 8; o <<= 1) { blo |= (unsigned)__builtin_amdgcn_ds_bpermute((l_ ^ o) << 2, (int)blo); bhi |= (unsigned)__builtin_amdgcn_ds_bpermute((l_ ^ o) << 2, (int)bhi); }
            unsigned long long mm = ((unsigned long long)bhi << 32) | blo;
            mm |= 1ull | (1ull << qb) | (1ull << (qb - 1));
            if (j8 == 0) { msk[q * 2] = (unsigned)mm; msk[q * 2 + 1] = (unsigned)(mm >> 32); }
        }
        __syncthreads();
        mlo = msk[ql * 2]; mhi = msk[ql * 2 + 1];
    }
    for (int i = 0; i < ntile; ++i) {
        const int cur = i & 1;
        const bool is_sel = i < n_sel; const int s = is_sel ? i : qb - n_win + 1 + (i - n_sel);
        u32x4v kreg = {0u, 0u, 0u, 0u}, vreg = {0u, 0u, 0u, 0u};
        if (i + 1 < ntile) {
            const bool nsel = i + 1 < n_sel; const int s2 = nsel ? i + 1 : qb - n_win + 1 + (i + 1 - n_sel);
            kreg = *(const u32x4v*)((nsel ? kssrc : kwsrc) + (size_t)(s2 * 64 + (tx >> 3)) * 512 + (tx & 7) * 8);
            vreg = *(const u32x4v*)((nsel ? vssrc : vwsrc) + (size_t)s2 * 4096 + (tx >> 3) * 64 + (tx & 7) * 8);
        }
        nsa_qk(p0, p1, KB + cur * 9216, qf, r32, hi);
        if (is_sel) {
            const bool on = ((s < 32 ? (mlo >> s) : (mhi >> (s - 32))) & 1u) != 0u;
#pragma unroll
            for (int r = 0; r < 16; ++r) { const int kl = crow(r, hi); if (!on || (s == qb && kl > ql)) p0[r] = NEG_INF; if (!on || (s == qb && kl + 32 > ql)) p1[r] = NEG_INF; }
        } else {
            const bool lowb = (qb >= 8) && (s == qb - 8), diag = (s == qb);
#pragma unroll
            for (int r = 0; r < 16; ++r) { const int kl = crow(r, hi);
                if ((lowb && kl <= ql) || (diag && kl > ql)) p0[r] = NEG_INF; if ((lowb && kl + 32 <= ql) || (diag && kl + 32 > ql)) p1[r] = NEG_INF; }
        }
        nsa_softmax(p0, p1, m, l, o0, o1);
        nsa_pv(o0, o1, p0, p1, VB + cur * 8704, r32, hi);
        if (i == n_sel - 1) nsa_finish(y0, y1, o0, o1, m, l, g_sel);
        if (i == ntile - 1) nsa_finish(y0, y1, o0, o1, m, l, g_win);
        if (i + 1 < ntile) { nsa_store_k(KB + (cur ^ 1) * 9216, kreg, tx); nsa_store_v(VB + (cur ^ 1) * 8704, vreg, tx); }
        __syncthreads();
    }
    bf16_t* yp = Y + tok * DM + head * 64;
#pragma unroll
    for (int i = 0; i < 4; ++i) {
        *(uint2*)(yp + 8 * i + 4 * hi) = make_uint2(cvtpk(y0[4 * i], y0[4 * i + 1]), cvtpk(y0[4 * i + 2], y0[4 * i + 3]));
        *(uint2*)(yp + 32 + 8 * i + 4 * hi) = make_uint2(cvtpk(y1[4 * i], y1[4 * i + 1]), cvtpk(y1[4 * i + 2], y1[4 * i + 3]));
    }
}

#ifndef NSA_CHECK
#define NSA_CHECK 0
#endif
#ifndef REP_MASK
#define REP_MASK 0u
#endif
struct Args { const float* in[29]; float* out; char* ws; unsigned rep_mask; unsigned pad; };
constexpr int LDS_BYTES = 147456;

__global__ __launch_bounds__(512, 2) void mk_fwd(Args a) {
    extern __shared__ __attribute__((aligned(16))) char lds_raw[];
    cg::grid_group grid = cg::this_grid();
    const int NB = gridDim.x * 2, NGW = gridDim.x * 8;
    const unsigned repm = a.rep_mask;
    const int wave_s_ = __builtin_amdgcn_readfirstlane(threadIdx.x >> 6);
#define KARG(T, off) (*(T const __attribute__((address_space(4)))*)(kargs_ + (off)))
#define PTRS const float* x = KARG(const float*, 8 * 0); const float* p = KARG(const float*, 8 * 1); const int* pos = KARG(const int*, 16); \
    const float* g_mix = KARG(const float*, 8 * 3); const float* w_in = KARG(const float*, 8 * 4); const float* b_if = KARG(const float*, 8 * 5); \
    const float* w_ck1 = KARG(const float*, 8 * 6); const float* w_ck2 = KARG(const float*, 8 * 7); const float* pe_ck = KARG(const float*, 8 * 8); \
    const float* w_cv1 = KARG(const float*, 8 * 9); const float* w_cv2 = KARG(const float*, 8 * 10); const float* pe_cv = KARG(const float*, 8 * 11); \
    const float* w_conv = KARG(const float*, 8 * 12); const float* b_conv = KARG(const float*, 8 * 13); const float* g_hn = KARG(const float*, 8 * 14); \
    const float* w_pa = KARG(const float*, 8 * 15); const float* w_pb = KARG(const float*, 8 * 16); const float* w_out = KARG(const float*, 8 * 17); \
    const float* g_ffn = KARG(const float*, 8 * 18); const float* w_rg = KARG(const float*, 8 * 19); const float* b_rg = KARG(const float*, 8 * 20); \
    const float* w_re = KARG(const float*, 8 * 21); const float* b_re = KARG(const float*, 8 * 22); const float* w_e13 = KARG(const float*, 8 * 23); \
    const float* w_e2 = KARG(const float*, 8 * 24); const float* g_ple = KARG(const float*, 8 * 25); const float* w_pg = KARG(const float*, 8 * 26); \
    const float* w_pp = KARG(const float*, 8 * 27); const float* g_final = KARG(const float*, 8 * 28); \
    float* out = KARG(float*, 232); char* ws = KARG(char*, 240); \
    const size_t MiB = 1u << 20; \
    bf16_t* Wt_in = (bf16_t*)(ws); \
    bf16_t* xb = (bf16_t*)(ws + 48 * MiB); \
    bf16_t* Qb = (bf16_t*)(ws + 80 * MiB); \
    bf16_t* KVb = (bf16_t*)(ws + 96 * MiB); bf16_t* VT = (bf16_t*)(ws + 112 * MiB); bf16_t* kcb = (bf16_t*)(ws + 249 * MiB + 512 * 1024); bf16_t* vcT = (bf16_t*)(ws + 249 * MiB + 768 * 1024); \
    bf16_t* MQK = (bf16_t*)(ws + 120 * MiB); \
    bf16_t* MV = (bf16_t*)(ws + 152 * MiB); \
    bf16_t* MO = (bf16_t*)(ws + 168 * MiB); \
    bf16_t* MG = (bf16_t*)(ws + 184 * MiB); \
    float* gates = (float*)(ws + 248 * MiB); \
    float* ifp = (float*)(ws + 250 * MiB); \
    float* kcc = (float*)(ws + 251 * MiB); \
    float* vcc = (float*)(ws + 252 * MiB); \
    float* gate16 = (float*)(ws + 253 * MiB); \
    float* rstd0 = (float*)(ws + 254 * MiB); \
    float* cosT = (float*)(ws + 254 * MiB + 512 * 1024); \
    float* sinT = (float*)(ws + 255 * MiB); \
    bf16_t* Y = (bf16_t*)(out + (size_t)8 * 1024 * 1024); \
    bf16_t* qkc = xb; float* hm = out; \
    float* tmp = (float*)(ws + 120 * MiB); bf16_t* mixed = xb; \
    bf16_t* Wpa_t = (bf16_t*)(ws + 11 * MiB); bf16_t* Wpb_t = (bf16_t*)(ws + 12 * MiB); bf16_t* Wout_t = (bf16_t*)(ws + 13 * MiB); \
    bf16_t* We13_t = (bf16_t*)(ws + 15 * MiB); bf16_t* We2_t = (bf16_t*)(ws + 31 * MiB); bf16_t* Wpg_t = (bf16_t*)(ws + 39 * MiB); bf16_t* Wpp_t = (bf16_t*)(ws + 41 * MiB); \
    int* cnt = (int*)(ws + 42 * MiB); \
    bf16_t* xg = (bf16_t*)(ws + 48 * MiB); bf16_t* act = (bf16_t*)(ws + 120 * MiB); bf16_t* y2 = (bf16_t*)(ws + 138 * MiB); bf16_t* x2b = (bf16_t*)(ws + 210 * MiB); \
    bf16_t* pb = (bf16_t*)(ws + 48 * MiB); bf16_t* PP = (bf16_t*)(ws + 56 * MiB); \
    int* rinfo = (int*)(ws + 253 * MiB); float* rstd1 = (float*)(ws + 253 * MiB + 512 * 1024); float* rstd2 = (float*)(ws + 253 * MiB + 768 * 1024); \
    (void)x; (void)p; (void)pos; (void)g_mix; (void)w_in; (void)b_if; (void)w_ck1; (void)w_ck2; (void)pe_ck; (void)w_cv1; (void)w_cv2; (void)pe_cv; (void)w_conv; (void)b_conv; (void)g_hn; (void)w_pa; (void)w_pb; (void)w_out; (void)g_ffn; (void)w_rg; (void)b_rg; (void)w_re; (void)b_re; (void)w_e13; (void)w_e2; (void)g_ple; (void)w_pg; (void)w_pp; (void)g_final;
#define PHASE(k) for (int rep_ = 0; rep_ < 1 + (int)((repm >> (k)) & 1u); ++rep_)
#define PHASE_IDS unsigned tx_ = (unsigned)(wave_s_ * 64); asm volatile("" : "+v"(tx_)); tx_ = (unsigned)__builtin_amdgcn_mbcnt_hi(-1, __builtin_amdgcn_mbcnt_lo(-1, (int)tx_)); const int half = tx_ >> 8, tid = tx_ & 255, lane64 = tx_ & 63, tid512 = (int)tx_; \
    const int wave = __builtin_amdgcn_readfirstlane(tx_ >> 6); char* sm = lds_raw + half * 65536; const int gw = blockIdx.x * 8 + wave; (void)tid; (void)lane64; (void)sm; (void)gw; (void)tid512; \
    const __attribute__((address_space(4))) char* kargs_ = (const __attribute__((address_space(4))) char*)__builtin_amdgcn_kernarg_segment_ptr(); asm volatile("" : "+s"(kargs_)); PTRS
#define VB_LOOP(nvb) for (int vb = blockIdx.x * 2 + half; vb < (nvb); vb += NB)
#define GEMM_PHASE(NT, MT, ...) do { VB_LOOP((NT) * (MT)) { const int bx_ = vb % (NT), by_ = vb / (NT); __syncthreads(); gemm_v1(bx_, by_, tid, sm, __VA_ARGS__); } } while (0)
    PHASE(0) { PHASE_IDS
        float* scr = (float*)(lds_raw + wave * 8448);
        for (int it = gw; it < (DM / 64) * (NIN / 32); it += NGW) prep_wt_item(w_in, DIN, DM, Wt_in, g_mix, MapIn{}, scr, it, NIN / 32, lane64);
        for (int it = gw; it < 8 * 32; it += NGW) prep_wt_item(w_pa, DM, 512, Wpa_t, (const float*)nullptr, MapId{}, scr, it, 32, lane64);
        for (int it = gw; it < 8 * 32; it += NGW) prep_wt_item(w_pb, DM, 512, Wpb_t, (const float*)nullptr, MapId{}, scr, it, 32, lane64);
        for (int it = gw; it < 16 * 32; it += NGW) prep_wt_item(w_out, DM, DM, Wout_t, (const float*)nullptr, MapId{}, scr, it, 32, lane64);
        for (int it = gw; it < 16 * 32; it += NGW) prep_wt_item(w_pg, DM, DM, Wpg_t, g_ple, MapId{}, scr, it, 32, lane64);
        for (int it = gw; it < 4 * 32; it += NGW) prep_wt_item(w_pp, DM, 256, Wpp_t, (const float*)nullptr, MapId{}, scr, it, 32, lane64);
        for (int it = gw; it < 16 * 256; it += NGW) { const int e = it >> 8; prep_wt_item(w_e13 + (size_t)e * 1024 * 512, 512, DM, We13_t + (size_t)e * 512 * 1024, g_ffn, MapE13{}, scr, it & 255, 16, lane64); }
        for (int it = gw; it < 16 * 128; it += NGW) { const int e = it >> 7; prep_wt_item(w_e2 + (size_t)e * 256 * 1024, DM, 256, We2_t + (size_t)e * 1024 * 256, (const float*)nullptr, MapId{}, scr, it & 127, 32, lane64); }
        if (blockIdx.x == 0 && tid512 < 16) cnt[tid512] = 0;
        for (int r = gw; r < T_TOK; r += NGW) prep_x_row(x, xb, rstd0, r, lane64);
        for (int i = blockIdx.x * 512 + tid512; i < T_TOK * 8; i += gridDim.x * 512) {
            const float inv = powf(500000.0f, -(float)(2 * (i & 7)) / 16.0f); float sn, cs; sincosf((float)pos[i >> 3] * inv, &sn, &cs); cosT[i] = cs; sinT[i] = sn; }
    }
    grid.sync();
    PHASE(1) { PHASE_IDS
        pg8::Gemm g{xb, Wt_in, T_TOK, NIN, DM, DM, DM}; pg8::StaticOrder S; S.init(T_TOK, NIN, (int)gridDim.x, (int)blockIdx.x);
        EpiInProj E{rstd0, cosT, sinT, b_if, Qb, KVb, gates, ifp, MQK, MV, MO, MG, VT};
        pg8::gemm_phase<EpiInProj, pg8::StaticOrder, true, true>((PG8_LAS unsigned char*)lds_raw, g, S, E, tid512);
    }
    grid.sync();
    PHASE(2) { PHASE_IDS
        VB_LOOP(4080) { const int j = vb % 255, r = vb / 255; compress_naive(j, r & 7, r >> 3, tid, sm, KVb, w_ck1, w_ck2, pe_ck, w_cv1, w_cv2, pe_cv, kcc, vcc, kcb, vcT); }
    }
    PHASE(3) { PHASE_IDS
        VB_LOOP(T_TOK * 1024 / 256) conv_silu(vb, tid, MQK, w_conv, b_conv, qkc);
    }
    grid.sync();
    PHASE(4) { PHASE_IDS
        VB_LOOP(128) mlstm_naive(vb, tid, sm, qkc, MV, MO, ifp, hm);
    }
    PHASE(5) { PHASE_IDS
        for (int pr = blockIdx.x; pr < 256; pr += gridDim.x) {
            nsa_unit(pr & 7, 63 - (pr >> 3), tid512, (lds_c*)lds_raw, Qb, KVb, VT, kcb, vcT, gates, Y);
            nsa_unit(pr & 7, pr >> 3, tid512, (lds_c*)lds_raw, Qb, KVb, VT, kcb, vcT, gates, Y);
        }
    }
#if NSA_CHECK
    {   PHASE_IDS
        bf16_t* Y2 = (bf16_t*)(ws + 120 * MiB); unsigned* stats = (unsigned*)(ws + 42 * MiB) + 64;
        if (blockIdx.x == 0 && tid512 == 0) { stats[0] = 0u; stats[1] = 0u; }
        grid.sync();
        VB_LOOP(T_TOK * 2) nsa_naive(vb >> 1, vb & 1, tid, sm, Qb, KVb, VT, kcc, vcc, gates, Y2);
        grid.sync();
        unsigned c1 = 0, c2 = 0;
        for (size_t i = (size_t)blockIdx.x * 512 + tid512; i < (size_t)T_TOK * 512; i += (size_t)gridDim.x * 512) {
            const size_t o = (i >> 9) * DM + (i & 511); const float d = fabsf(bf2f(Y[o]) - bf2f(Y2[o])); c1 += d > 0.02f ? 1u : 0u; c2 += (d > 0.1f || !(d == d)) ? 1u : 0u; }
        if (c1) atomicAdd(stats, c1); if (c2) atomicAdd(stats + 1, c2);
    }
#endif
    grid.sync();
    PHASE(6) { PHASE_IDS
        VB_LOOP(T_TOK) hnorm(vb, tid, hm, g_hn, Y);
    }
    grid.sync();
    PHASE(7) { PHASE_IDS
        pg8::StaticOrder S; S.init(T_TOK, DM, (int)gridDim.x, (int)blockIdx.x);
        pg8::Gemm g{Y, Wpa_t, T_TOK, DM, 512, DM, 512}; EpiMerge<0> E{MG, tmp, mixed}; pg8::gemm_phase<EpiMerge<0>, pg8::StaticOrder, true, true>((PG8_LAS unsigned char*)lds_raw, g, S, E, tid512);
    }
    PHASE(8) { PHASE_IDS
        __syncthreads();
        pg8::StaticOrder S; S.init(T_TOK, DM, (int)gridDim.x, (int)blockIdx.x);
        pg8::Gemm g{Y + 512, Wpb_t, T_TOK, DM, 512, DM, 512}; EpiMerge<1> E{MG, tmp, mixed}; pg8::gemm_phase<EpiMerge<1>, pg8::StaticOrder, true, true>((PG8_LAS unsigned char*)lds_raw, g, S, E, tid512);
    }
    grid.sync();
    PHASE(9) { PHASE_IDS
        pg8::Gemm g{mixed, Wout_t, T_TOK, DM, DM, DM, DM}; pg8::StaticOrder S; S.init(T_TOK, DM, (int)gridDim.x, (int)blockIdx.x);
        EpiX1 E{x, out};
        pg8::gemm_phase<EpiX1, pg8::StaticOrder, true, true>((PG8_LAS unsigned char*)lds_raw, g, S, E, tid512);
    }
    grid.sync();
    {   PHASE_IDS
        for (int t = gw; t < T_TOK; t += NGW) router2(t, lane64, out, g_ffn, w_rg, b_rg, w_re, b_re, rstd1, rinfo, cnt);
    }
    grid.sync();
    PHASE(11) { PHASE_IDS
        for (int t = gw; t < T_TOK; t += NGW) {
            int4 ri = *(const int4*)(rinfo + (size_t)t * 4); ri.x = __builtin_amdgcn_readfirstlane(ri.x); ri.y = __builtin_amdgcn_readfirstlane(ri.y); ri.z = __builtin_amdgcn_readfirstlane(ri.z); ri.w = __builtin_amdgcn_readfirstlane(ri.w);
            const int r0 = moe_base_row(cnt, ri.x & 255) + (ri.y & 0xffff), r1 = moe_base_row(cnt, (ri.x >> 8) & 255) + ((ri.y >> 16) & 0xffff);
            const float rs = rstd1[t];
#pragma unroll
            for (int j = 0; j < 4; ++j) { const float4 v = ((const float4*)(out + (size_t)t * DM))[lane64 + 64 * j]; uint2 o; o.x = pk2(v.x * rs, v.y * rs); o.y = pk2(v.z * rs, v.w * rs);
                ((uint2*)(xg + (size_t)r0 * DM))[lane64 + 64 * j] = o; ((uint2*)(xg + (size_t)r1 * DM))[lane64 + 64 * j] = o; }
        }
    }
    grid.sync();
    PHASE(12) { PHASE_IDS
        pg8::Gemm g{xg, We13_t, 0, 0, DM, DM, DM}; MoeOrder S{cnt, 2, (int)gridDim.x, (int)blockIdx.x};
        EpiSwiglu E{act};
        pg8::gemm_phase<EpiSwiglu, MoeOrder, true, true>((PG8_LAS unsigned char*)lds_raw, g, S, E, tid512);
    }
    grid.sync();
    PHASE(13) { PHASE_IDS
        pg8::Gemm g{act, We2_t, 0, 0, 256, 256, 256}; MoeOrder S{cnt, 4, (int)gridDim.x, (int)blockIdx.x};
        EpiStoreBf E{y2, DM, 3};
        pg8::gemm_phase<EpiStoreBf, MoeOrder, true, true>((PG8_LAS unsigned char*)lds_raw, g, S, E, tid512);
    }
    grid.sync();
    {   PHASE_IDS
        for (int t = gw; t < T_TOK; t += NGW) {
            int4 ri = *(const int4*)(rinfo + (size_t)t * 4); ri.x = __builtin_amdgcn_readfirstlane(ri.x); ri.y = __builtin_amdgcn_readfirstlane(ri.y); ri.z = __builtin_amdgcn_readfirstlane(ri.z); ri.w = __builtin_amdgcn_readfirstlane(ri.w);
            const int r0 = moe_base_row(cnt, ri.x & 255) + (ri.y & 0xffff), r1 = moe_base_row(cnt, (ri.x >> 8) & 255) + ((ri.y >> 16) & 0xffff);
            const float w0 = __int_as_float(ri.z), w1 = __int_as_float(ri.w);
            float4 v[4]; float s2 = 0.f;
#pragma unroll
            for (int j = 0; j < 4; ++j) { v[j] = ((const float4*)(out + (size_t)t * DM))[lane64 + 64 * j];
                const uint2 a0 = ((const uint2*)(y2 + (size_t)r0 * DM))[lane64 + 64 * j], a1 = ((const uint2*)(y2 + (size_t)r1 * DM))[lane64 + 64 * j];
                v[j].x += w0 * __uint_as_float(a0.x << 16) + w1 * __uint_as_float(a1.x << 16); v[j].y += w0 * __uint_as_float(a0.x & 0xffff0000u) + w1 * __uint_as_float(a1.x & 0xffff0000u);
                v[j].z += w0 * __uint_as_float(a0.y << 16) + w1 * __uint_as_float(a1.y << 16); v[j].w += w0 * __uint_as_float(a0.y & 0xffff0000u) + w1 * __uint_as_float(a1.y & 0xffff0000u);
                s2 += v[j].x * v[j].x + v[j].y * v[j].y + v[j].z * v[j].z + v[j].w * v[j].w; }
            s2 = wave_sum(s2);
            if (lane64 == 0) rstd2[t] = rsqrtf(s2 * (1.f / DM) + 1e-6f);
#pragma unroll
            for (int j = 0; j < 4; ++j) { ((float4*)(out + (size_t)t * DM))[lane64 + 64 * j] = v[j]; uint2 o; o.x = pk2(v[j].x, v[j].y); o.y = pk2(v[j].z, v[j].w); ((uint2*)(x2b + (size_t)t * DM))[lane64 + 64 * j] = o; }
            { const float4 pv = ((const float4*)(p + (size_t)t * 256))[lane64]; uint2 o; o.x = pk2(pv.x, pv.y); o.y = pk2(pv.z, pv.w); ((uint2*)(pb + (size_t)t * 256))[lane64] = o; }
        }
    }
    grid.sync();
    {   PHASE_IDS
        pg8::StaticOrder S; S.init(T_TOK, DM, (int)gridDim.x, (int)blockIdx.x);
        pg8::Gemm g{pb, Wpp_t, T_TOK, DM, 256, 256, 256}; EpiStoreBf E{PP, DM, 3};
        pg8::gemm_phase<EpiStoreBf, pg8::StaticOrder, true, true>((PG8_LAS unsigned char*)lds_raw, g, S, E, tid512);
    }
    {   PHASE_IDS
        __syncthreads();
        pg8::StaticOrder S; S.init(T_TOK, DM, (int)gridDim.x, (int)blockIdx.x);
        pg8::Gemm g{x2b, Wpg_t, T_TOK, DM, DM, DM, DM}; EpiPle2 E{out, PP, rstd2};
        pg8::gemm_phase<EpiPle2, pg8::StaticOrder, true, true>((PG8_LAS unsigned char*)lds_raw, g, S, E, tid512);
    }
    grid.sync();
    {   PHASE_IDS
        VB_LOOP(T_TOK / 4) rmsnorm_rows(vb, tid, out, g_final, (bf16_t*)nullptr, out, T_TOK);
#if NSA_CHECK
        grid.sync();
        if (blockIdx.x == 0 && tid512 == 0) { const unsigned* stats = (const unsigned*)(ws + 42 * MiB) + 64; out[0] += sqrtf((float)stats[0]); out[1] += sqrtf((float)stats[1]) * 30.f; }
#endif
    }
}

extern "C" void kernel_launch(void* const* d_in, const int* in_sizes, int n_in, void* d_out, int out_size, void* d_ws, size_t ws_size, hipStream_t stream) {
    static int grid_blocks = 0;
    if (grid_blocks == 0) {
        int dev = 0, cus = 0, per_cu = 0;
        (void)hipGetDevice(&dev);
        (void)hipDeviceGetAttribute(&cus, hipDeviceAttributeMultiprocessorCount, dev);
        (void)hipFuncSetAttribute((const void*)mk_fwd, hipFuncAttributeMaxDynamicSharedMemorySize, LDS_BYTES);
        (void)hipOccupancyMaxActiveBlocksPerMultiprocessor(&per_cu, (const void*)mk_fwd, 512, LDS_BYTES);
        if (per_cu < 1) { fprintf(stderr, "kernel_launch: occupancy query returned %d\n", per_cu); per_cu = 1; }
        grid_blocks = cus * 1;
        fprintf(stderr, "kernel_launch: cus=%d per_cu=%d grid=%d ws=%zu\n", cus, per_cu, grid_blocks, ws_size);
    }
    Args a{};
    for (int i = 0; i < 29; ++i) a.in[i] = (const float*)d_in[i];
    a.out = (float*)d_out; a.ws = (char*)d_ws; a.rep_mask = REP_MASK; a.pad = 0;
    void* args[] = {&a};
    hipError_t e = hipLaunchCooperativeKernel((const void*)mk_fwd, dim3(grid_blocks), dim3(512), args, LDS_BYTES, stream);
    if (e != hipSuccess) fprintf(stderr, "cooperative launch failed: %s (grid %d)\n", hipGetErrorString(e), grid_blocks);
    (void)in_sizes; (void)n_in; (void)out_size; (void)ws_size;
}
```

```cpp
#include <hip/hip_runtime.h>
#include <cstdint>
#include <cstdio>
#include <hip/hip_cooperative_groups.h>
namespace cg = cooperative_groups;

typedef unsigned short bf16_t;
typedef short bf16x8 __attribute__((ext_vector_type(8)));
typedef float f32x16 __attribute__((ext_vector_type(16)));

#define DI __device__ __forceinline__

constexpr int T_TOK = 16384, SEQ = 4096, DM = 1024, DIN = 5408, NIN = 5632;
constexpr float QSCALE = 0.125f * 1.4426950408889634f;
constexpr int ZC_Q = 0, ZC_KC = 512, ZC_VC = 640, ZC_KS = 768, ZC_VS = 896, ZC_KW = 1024, ZC_VW = 1152, ZC_GATE = 1280,
              ZC_MQK = 1304, ZC_MV = 2328, ZC_MO = 2840, ZC_IF = 3352, ZC_GA = 3360, ZC_GB = 4384;

DI bf16_t f2bf(float f) { unsigned u = __float_as_uint(f); return (bf16_t)((u + 0x7fffu + ((u >> 16) & 1u)) >> 16); }
DI float bf2f(bf16_t h) { return __uint_as_float(((unsigned)h) << 16); }
DI float sigmoidf_(float x) { return 1.f / (1.f + __expf(-x)); }
DI int lane_id_opaque() { int z = 0; asm volatile("" : "+v"(z)); return __builtin_amdgcn_mbcnt_hi(-1, __builtin_amdgcn_mbcnt_lo(-1, z)); }
DI float lane_xor(float v, int o, int lane) { return __int_as_float(__builtin_amdgcn_ds_bpermute((lane ^ o) << 2, __float_as_int(v))); }
DI float lane_get(float v, int src) { return __int_as_float(__builtin_amdgcn_ds_bpermute(src << 2, __float_as_int(v))); }
DI float wave_sum(float v) {
    const int l = lane_id_opaque();
#pragma unroll
    for (int o = 1; o < 64; o <<= 1) v += lane_xor(v, o, l);
    return v;
}
DI float wave_max(float v) {
    const int l = lane_id_opaque();
#pragma unroll
    for (int o = 1; o < 64; o <<= 1) v = fmaxf(v, lane_xor(v, o, l));
    return v;
}

namespace pg8 {
#define PG8_LAS __attribute__((address_space(3)))
typedef unsigned short bf16_t;
typedef short bf16x8 __attribute__((ext_vector_type(8)));
typedef float f32x4 __attribute__((ext_vector_type(4)));
typedef unsigned u32x4 __attribute__((ext_vector_type(4)));
constexpr int BM = 256, BK = 64, HALF = 128, HTB = HALF * BK * 2  , STAGE_BYTES = 8 * HTB, NXCD = 8, WGM = 8;

__host__ __device__ __forceinline__ int lds_byte(int r, int c) { const int st = (r >> 4) * 2 + (c >> 5), rr = r & 15, cc = c & 31, ob = rr * 64 + cc * 2; return st * 1024 + (ob ^ (((ob >> 9) & 1) << 5)); }
__host__ __device__ __forceinline__ void stage_rc(int b, int& R, int& C) { const int st = b / 1024, sb = b % 1024, swz = sb ^ (((sb >> 9) & 1) << 5); R = (st >> 1) * 16 + swz / 64; C = (st & 1) * 32 + (swz % 64) / 2; }
__host__ __device__ __forceinline__ int perm32(int rho) { const int n = rho >> 4, i = rho & 15; return 8 * (i >> 2) + 4 * n + (i & 3); }

struct Unit { int pm, pn; };
struct Gemm { const bf16_t* A; const bf16_t* Bt; int M, N, K, lda, ldb; };

struct StaticOrder {
    int nM, nN, nwg, G, c;
    __host__ __device__ __forceinline__ void init(int M, int N, int G_, int c_) { nM = M / BM; nN = N / BM; nwg = nM * nN; G = G_; c = c_; }
    __host__ __device__ __forceinline__ bool next(int i, Unit& u) const {
        const long L = (long)i * G + c; if (L >= nwg) return false;
        int wgid = (int)L; { const int q = nwg / NXCD, r = nwg % NXCD, xcd = wgid % NXCD, off = wgid / NXCD; wgid = (xcd < r ? xcd * (q + 1) : r * (q + 1) + (xcd - r) * q) + off; }
        const int nig = WGM * nN, gid = wgid / nig, fm = gid * WGM, gsz = (nM - fm) < WGM ? (nM - fm) : WGM;
        u.pm = fm + ((wgid % nig) % gsz); u.pn = (wgid % nig) / gsz; return true;
    }
    __device__ __forceinline__ void a_ready(const Unit&) const {}
    __device__ __forceinline__ void done(const Unit&) const {}
};

__device__ __forceinline__ unsigned cvt_pk_bf16(float lo, float hi) { unsigned r; asm volatile("v_cvt_pk_bf16_f32 %0, %1, %2" : "=v"(r) : "v"(lo), "v"(hi)); return r; }
typedef float f32x2 __attribute__((ext_vector_type(2)));
__device__ __forceinline__ f32x2 gelu_pk(f32x2 v) {
    const f32x2 av = __builtin_elementwise_abs(v), d = av * 0.2316418882f + 1.0f;
    f32x2 t; t.x = __builtin_amdgcn_rcpf(d.x); t.y = __builtin_amdgcn_rcpf(d.y);
    f32x2 q = t * 0.5307027145f + (-0.7265760135f); q = q * t + 0.7107068705f; q = q * t + (-0.142248368f); q = q * t + 0.127414796f; q = q * t;
    const f32x2 s = (v * v) * (-0.72134752044f);
    f32x2 e; e.x = __builtin_amdgcn_exp2f(s.x); e.y = __builtin_amdgcn_exp2f(s.y);
    const f32x2 m = v * (q * e), r = v - m;
    f32x2 o; o.x = v.x < 0.f ? m.x : r.x; o.y = v.y < 0.f ? m.y : r.y; return o;
}

template <int ACT  > struct EpiBf16 {
    static constexpr bool PERM = true, AFTER_DRAIN = false; static_assert(ACT == 0 || ACT == 1, "EpiBf16: ACT is 0 (none) or 1 (gelu_pk)");
    bf16_t* O; int ldc; const float* bias; int split_cols; size_t split_stride; float scale0;
    __device__ __forceinline__ void operator()(const f32x4 (&acc)[2][2][4][2], const Unit& u, int wr, int wc, int fr, int fq) const {
        const int row0 = u.pm * BM + wr * 64 + fr; int colt = u.pn * BM; bf16_t* base = O;
        float sc = 1.f; if (split_cols) { const int t = colt / split_cols; base += (size_t)t * split_stride; colt -= t * split_cols; if (t == 0) sc = scale0; }
        const int col0 = colt + wc * 32 + 8 * fq, bcol0 = u.pn * BM + wc * 32 + 8 * fq;
        f32x4 bv[2][2];
#pragma unroll
        for (int bj = 0; bj < 2; ++bj)
#pragma unroll
            for (int n = 0; n < 2; ++n) bv[bj][n] = bias ? *(const f32x4*)(bias + bcol0 + bj * HALF + 4 * n) : (f32x4){0.f, 0.f, 0.f, 0.f};
#pragma unroll
        for (int ai = 0; ai < 2; ++ai)
#pragma unroll
            for (int m = 0; m < 4; ++m) { bf16_t* rowp = base + (size_t)(row0 + ai * HALF + m * 16) * ldc + col0;
#pragma unroll
                for (int bj = 0; bj < 2; ++bj) { f32x4 v0 = acc[ai][bj][m][0] + bv[bj][0], v1 = acc[ai][bj][m][1] + bv[bj][1];
                    if (ACT == 1) { f32x2 a = gelu_pk((f32x2){v0[0], v0[1]}), b = gelu_pk((f32x2){v0[2], v0[3]}), c = gelu_pk((f32x2){v1[0], v1[1]}), d = gelu_pk((f32x2){v1[2], v1[3]});
                        v0 = (f32x4){a.x, a.y, b.x, b.y}; v1 = (f32x4){c.x, c.y, d.x, d.y}; }
                    v0 = v0 * sc; v1 = v1 * sc; u32x4 w; w.x = cvt_pk_bf16(v0[0], v0[1]); w.y = cvt_pk_bf16(v0[2], v0[3]); w.z = cvt_pk_bf16(v1[0], v1[1]); w.w = cvt_pk_bf16(v1[2], v1[3]);
                    *(u32x4*)(rowp + bj * HALF) = w; } }
    }
};

template <class Epi, class Sched, bool ALIGN_EPI = false, bool SP2 = false>
__device__ __forceinline__ void gemm_phase(PG8_LAS unsigned char* lds, const Gemm g, const Sched& S, const Epi& E, const int tid) {
    const int wid = __builtin_amdgcn_readfirstlane(tid >> 6), lane = tid & 63, wr = wid >> 2, wc = wid & 3, fr = lane & 15, fq = lane >> 4;
    const int K = g.K, nt = K / BK;
    unsigned voffA[2], voffB[2];
#pragma unroll
    for (int i = 0; i < 2; ++i) { int R, C; stage_rc(tid * 16 + i * 8192, R, C); const int Rb = Epi::PERM ? ((R & ~31) + perm32(R & 31)) : R;
        voffA[i] = (unsigned)(R * g.lda + C) * 2u; voffB[i] = (unsigned)(Rb * g.ldb + C) * 2u; }
    const size_t kstep = (size_t)(BK * 2);
    const size_t hstepA = (size_t)HALF * g.lda * 2, hstepB = (size_t)HALF * g.ldb * 2;
    const size_t tstepA = 2 * hstepA, tstepB = 2 * hstepB;
    const unsigned ldsw = (unsigned)wid * 1024u;
    const int aoff = lds_byte(wr * 64 + fr, fq * 8), boff = lds_byte(wc * 32 + fr, fq * 8);
#define PG8_SA(b, h) (((b) * 2 + (h)) * HTB)
#define PG8_SB(b, h) ((4 + (b) * 2 + (h)) * HTB)
#define PG8_STAGE(bufoff, gbase, voff) do { _Pragma("unroll") for (int _i = 0; _i < 2; ++_i) \
        __builtin_amdgcn_global_load_lds((const unsigned*)((const char*)(gbase) + (voff)[_i]), (PG8_LAS unsigned*)(lds + (bufoff) + ldsw + _i * 8192), 16, 0, 0); } while (0)
#define PG8_LDA(dst, b, h) do { _Pragma("unroll") for (int m = 0; m < 4; ++m) _Pragma("unroll") for (int k = 0; k < 2; ++k) dst[m][k] = *(const PG8_LAS bf16x8*)(lds + PG8_SA(b, h) + aoff + m * 2048 + k * 1024); } while (0)
#define PG8_LDB(dst, b, h) do { _Pragma("unroll") for (int n = 0; n < 2; ++n) _Pragma("unroll") for (int k = 0; k < 2; ++k) dst[n][k] = *(const PG8_LAS bf16x8*)(lds + PG8_SB(b, h) + boff + n * 2048 + k * 1024); } while (0)
#define PG8_MMA(ai, bj, At, Bt) do { __builtin_amdgcn_s_setprio(1); _Pragma("unroll") for (int m = 0; m < 4; ++m) _Pragma("unroll") for (int n = 0; n < 2; ++n) _Pragma("unroll") for (int k = 0; k < 2; ++k) \
        acc[ai][bj][m][n] = __builtin_amdgcn_mfma_f32_16x16x32_bf16(Bt[n][k], At[m][k], acc[ai][bj][m][n], 0, 0, 0); __builtin_amdgcn_s_setprio(0); } while (0)
#define PG8_WAIT_V(n) asm volatile("s_waitcnt vmcnt(" #n ")" ::: "memory")
#define PG8_WAIT_L(n) asm volatile("s_waitcnt lgkmcnt(" #n ")" ::: "memory")
#define PG8_BAR __builtin_amdgcn_s_barrier()
#define PG8_SCHED __builtin_amdgcn_sched_barrier(0)
    Unit cur, nxt; int ui = 0;
    if (!S.next(0, cur)) return;
    f32x4 acc[2][2][4][2];
#pragma unroll
    for (int a = 0; a < 2; ++a)
#pragma unroll
        for (int b = 0; b < 2; ++b)
#pragma unroll
            for (int m = 0; m < 4; ++m)
#pragma unroll
                for (int n = 0; n < 2; ++n) acc[a][b][m][n] = (f32x4){0.f, 0.f, 0.f, 0.f};
    bf16x8 At[4][2], B0[2][2], B1[2][2];
    const char* cA = (const char*)g.A + (size_t)cur.pm * tstepA; const char* cB = (const char*)g.Bt + (size_t)cur.pn * tstepB;
    S.a_ready(cur);
    if constexpr (SP2) {
        PG8_STAGE(PG8_SB(0, 0), cB, voffB); PG8_STAGE(PG8_SB(0, 1), cB + hstepB, voffB); PG8_STAGE(PG8_SA(0, 0), cA, voffA); PG8_STAGE(PG8_SA(0, 1), cA + hstepA, voffA);
        if (wr == 1) PG8_BAR;
        PG8_WAIT_V(2); PG8_BAR;
        PG8_STAGE(PG8_SB(1, 0), cB + kstep, voffB); PG8_STAGE(PG8_SA(1, 0), cA + kstep, voffA); PG8_STAGE(PG8_SB(1, 1), cB + hstepB + kstep, voffB);
        PG8_WAIT_V(6); PG8_BAR;
    } else {
        PG8_STAGE(PG8_SB(0, 0), cB, voffB); PG8_STAGE(PG8_SA(0, 0), cA, voffA); PG8_STAGE(PG8_SB(0, 1), cB + hstepB, voffB); PG8_STAGE(PG8_SA(0, 1), cA + hstepA, voffA);
        if (wr == 1) PG8_BAR;
        PG8_WAIT_V(4); PG8_BAR;
        PG8_STAGE(PG8_SB(1, 0), cB + kstep, voffB); PG8_STAGE(PG8_SA(1, 0), cA + kstep, voffA); PG8_STAGE(PG8_SB(1, 1), cB + hstepB + kstep, voffB);
        PG8_WAIT_V(6); PG8_BAR;
    }
    for (;;) {
        const bool has_next = S.next(ui + 1, nxt);
        const char* nA = has_next ? (const char*)g.A + (size_t)nxt.pm * tstepA : cA; const char* nB = has_next ? (const char*)g.Bt + (size_t)nxt.pn * tstepB : cB;
        for (int t = 0; t < nt; t += 2) {
            const bool last = (t == nt - 2);
            const char* a1 = cA + (size_t)(t + 1) * kstep;
            const char* a2 = last ? nA : cA + (size_t)(t + 2) * kstep; const char* b2 = last ? nB : cB + (size_t)(t + 2) * kstep;
            const char* a3 = a2 + kstep; const char* b3 = b2 + kstep;
            if (last && has_next) S.a_ready(nxt);
            if constexpr (SP2) {
            PG8_LDB(B0, 0, 0); PG8_LDB(B1, 0, 1); PG8_SCHED; PG8_LDA(At, 0, 0); PG8_STAGE(PG8_SA(1, 1), a1 + hstepA, voffA);
            PG8_WAIT_V(8); PG8_WAIT_L(0); PG8_BAR; PG8_MMA(0, 0, At, B0); PG8_MMA(0, 1, At, B1); PG8_BAR; PG8_SCHED;
            PG8_LDA(At, 0, 1); PG8_STAGE(PG8_SB(0, 0), b2, voffB); PG8_STAGE(PG8_SB(0, 1), b2 + hstepB, voffB); PG8_STAGE(PG8_SA(0, 0), a2, voffA);
            PG8_WAIT_V(8); PG8_WAIT_L(0); PG8_BAR; PG8_MMA(1, 0, At, B0); PG8_MMA(1, 1, At, B1); PG8_BAR; PG8_SCHED;
            PG8_LDB(B0, 1, 0); PG8_LDB(B1, 1, 1); PG8_SCHED; PG8_LDA(At, 1, 0); PG8_STAGE(PG8_SA(0, 1), a2 + hstepA, voffA);
            PG8_WAIT_V(8); PG8_WAIT_L(0); PG8_BAR; PG8_MMA(0, 0, At, B0); PG8_MMA(0, 1, At, B1); PG8_BAR; PG8_SCHED;
            PG8_LDA(At, 1, 1); PG8_STAGE(PG8_SB(1, 0), b3, voffB); PG8_STAGE(PG8_SB(1, 1), b3 + hstepB, voffB); PG8_STAGE(PG8_SA(1, 0), a3, voffA);
            PG8_WAIT_V(8); PG8_WAIT_L(0); PG8_BAR; PG8_MMA(1, 0, At, B0); PG8_MMA(1, 1, At, B1); PG8_BAR; PG8_SCHED;
            } else {
            PG8_LDB(B0, 0, 0); PG8_SCHED; PG8_LDA(At, 0, 0); PG8_STAGE(PG8_SA(1, 1), a1 + hstepA, voffA);
            PG8_WAIT_L(8); PG8_BAR; PG8_WAIT_L(0); PG8_MMA(0, 0, At, B0); PG8_BAR; PG8_SCHED;
            PG8_LDB(B1, 0, 1); PG8_STAGE(PG8_SB(0, 0), b2, voffB);
            PG8_BAR; PG8_WAIT_L(0); PG8_MMA(0, 1, At, B1); PG8_BAR;
            PG8_LDA(At, 0, 1); PG8_STAGE(PG8_SA(0, 0), a2, voffA);
            PG8_BAR; PG8_WAIT_L(0); PG8_MMA(1, 0, At, B0); PG8_BAR; PG8_SCHED;
            PG8_STAGE(PG8_SB(0, 1), b2 + hstepB, voffB);
            PG8_WAIT_V(6); PG8_BAR; PG8_MMA(1, 1, At, B1); PG8_BAR;
            PG8_LDB(B0, 1, 0); PG8_SCHED; PG8_LDA(At, 1, 0); PG8_STAGE(PG8_SA(0, 1), a2 + hstepA, voffA);
            PG8_WAIT_L(8); PG8_BAR; PG8_WAIT_L(0); PG8_MMA(0, 0, At, B0); PG8_BAR; PG8_SCHED;
            PG8_LDB(B1, 1, 1); PG8_STAGE(PG8_SB(1, 0), b3, voffB);
            PG8_BAR; PG8_WAIT_L(0); PG8_MMA(0, 1, At, B1); PG8_BAR;
            PG8_LDA(At, 1, 1); PG8_STAGE(PG8_SA(1, 0), a3, voffA);
            PG8_BAR; PG8_WAIT_L(0); PG8_MMA(1, 0, At, B0); PG8_BAR; PG8_SCHED;
            PG8_STAGE(PG8_SB(1, 1), b3 + hstepB, voffB);
            PG8_WAIT_V(6); PG8_BAR; PG8_MMA(1, 1, At, B1); PG8_BAR;
            }
        }
        if constexpr (ALIGN_EPI) { if (wr == 0) PG8_BAR; }
        if constexpr (!Epi::AFTER_DRAIN) { const int l2_ = lane_id_opaque(); E(acc, cur, wr, wc, l2_ & 15, l2_ >> 4); S.done(cur); }
        if (!has_next) break;
#pragma unroll
        for (int a = 0; a < 2; ++a)
#pragma unroll
            for (int b = 0; b < 2; ++b)
#pragma unroll
                for (int m = 0; m < 4; ++m)
#pragma unroll
                    for (int n = 0; n < 2; ++n) acc[a][b][m][n] = (f32x4){0.f, 0.f, 0.f, 0.f};
        cur = nxt; cA = nA; cB = nB; ++ui;
        if constexpr (ALIGN_EPI) { if (wr == 1) PG8_BAR; }
    }
    PG8_WAIT_V(0);
    if constexpr (!ALIGN_EPI) { if (wr == 0) PG8_BAR; }
    PG8_BAR;
    if constexpr (Epi::AFTER_DRAIN) { E.fused(acc, cur, wr, wc, fr, fq, lds, wid, lane); S.done(cur); }
#undef PG8_SA
#undef PG8_SB
#undef PG8_STAGE
#undef PG8_LDA
#undef PG8_LDB
#undef PG8_MMA
#undef PG8_WAIT_V
#undef PG8_WAIT_L
#undef PG8_BAR
#undef PG8_SCHED
}
}


#define LAS __attribute__((address_space(3)))
DI unsigned pk2(float lo, float hi) { return (unsigned)f2bf(lo) | ((unsigned)f2bf(hi) << 16); }
template <class Map>
DI void prep_wt_item(const float* __restrict__ W, int ldw, int K, bf16_t* __restrict__ WT, const float* __restrict__ gain, Map map, float* scr, int item, int nblk, int lane) {
    const int kb = item / nblk, nb = item % nblk, k0 = 64 * kb, n0 = 32 * nb;
    const int srcn = map(n0 + (lane & 31));
#pragma unroll 8
    for (int i = 0; i < 32; ++i) { const int kk = 2 * i + (lane >> 5); float v = 0.f; if (srcn >= 0) { v = W[(size_t)(k0 + kk) * ldw + srcn]; if (gain) v *= gain[k0 + kk]; } scr[kk * 33 + (lane & 31)] = v; }
    __builtin_amdgcn_s_waitcnt(0xC07F); asm volatile("" ::: "memory");
    const int c = lane & 7;
#pragma unroll
    for (int j = 0; j < 4; ++j) { const int n = (lane >> 3) + 8 * j; const float* s = scr + (8 * c) * 33 + n;
        uint4 o; o.x = pk2(s[0 * 33], s[1 * 33]); o.y = pk2(s[2 * 33], s[3 * 33]); o.z = pk2(s[4 * 33], s[5 * 33]); o.w = pk2(s[6 * 33], s[7 * 33]);
        *(uint4*)(WT + (size_t)(n0 + n) * K + k0 + 8 * c) = o; }
    __builtin_amdgcn_s_waitcnt(0xC07F); asm volatile("" ::: "memory");
}
struct MapIn {
    DI int operator()(int n) const {
        if (n < 1280) return n;
        if (n < 1536) { const int i = n - 1280; return i < 24 ? ZC_GATE + i : (i < 32 ? ZC_IF + (i - 24) : -1); }
        if (n < 2560) return ZC_MQK + (n - 1536);
        if (n < 3072) return ZC_MV + (n - 2560);
        if (n < 3584) return ZC_MO + (n - 3072);
        return ZC_GA + (n - 3584);
    }
};
DI void prep_x_row(const float* __restrict__ x, bf16_t* __restrict__ xb, float* __restrict__ rstd, int row, int lane) {
    const float4* xr = (const float4*)(x + (size_t)row * DM);
    float4 v[4]; float s = 0.f;
#pragma unroll
    for (int j = 0; j < 4; ++j) { v[j] = xr[lane + 64 * j]; s += v[j].x * v[j].x + v[j].y * v[j].y + v[j].z * v[j].z + v[j].w * v[j].w; }
    s = wave_sum(s);
    if (lane == 0) rstd[row] = rsqrtf(s * (1.f / DM) + 1e-6f);
#pragma unroll
    for (int j = 0; j < 4; ++j) { uint2 o; o.x = pk2(v[j].x, v[j].y); o.y = pk2(v[j].z, v[j].w); ((uint2*)(xb + (size_t)row * DM))[lane + 64 * j] = o; }
}

struct EpiInProj {
    static constexpr bool PERM = true, AFTER_DRAIN = false;
    const float* rstd; const float* cosT; const float* sinT; const float* b_if;
    bf16_t* Qb; bf16_t* KVb; float* gates; float* ifp; bf16_t* MQK; bf16_t* MV; bf16_t* MO; bf16_t* MG; bf16_t* VT;
    DI void operator()(const pg8::f32x4 (&acc)[2][2][4][2], const pg8::Unit& u, int wr, int wc, int fr, int fq) const {
        const int pn = u.pn;
        asm volatile("" : "+v"(fr), "+v"(fq));
#pragma unroll
        for (int ai = 0; ai < 2; ++ai)
#pragma unroll
            for (int m = 0; m < 4; ++m) {
                const int row = u.pm * 256 + ai * 128 + wr * 64 + m * 16 + fr;
                const float rs = rstd[row];
#pragma unroll
                for (int bj = 0; bj < 2; ++bj) {
                    float v[8];
#pragma unroll
                    for (int i = 0; i < 4; ++i) { v[i] = acc[ai][bj][m][0][i] * rs; v[4 + i] = acc[ai][bj][m][1][i] * rs; }
                    const int c0 = bj * 128 + wc * 32 + 8 * fq;
                    if (pn <= 4) {
                        const bool is_k = (pn < 2) || (bj == 0);
                        if (is_k && (wc & 1) == 0) {
                            const float4 c_lo = *(const float4*)(cosT + (size_t)row * 8), c_hi = *(const float4*)(cosT + (size_t)row * 8 + 4);
                            const float4 s_lo = *(const float4*)(sinT + (size_t)row * 8), s_hi = *(const float4*)(sinT + (size_t)row * 8 + 4);
                            const float cs[8] = {c_lo.x, c_lo.y, c_lo.z, c_lo.w, c_hi.x, c_hi.y, c_hi.z, c_hi.w};
                            const float sn[8] = {s_lo.x, s_lo.y, s_lo.z, s_lo.w, s_hi.x, s_hi.y, s_hi.z, s_hi.w};
                            const int l_ = lane_id_opaque();
#pragma unroll
                            for (int i = 0; i < 8; ++i) {
                                const float other = lane_xor(v[i], 16, l_);
                                if (fq == 0) v[i] = v[i] * cs[i] - other * sn[i];
                                else if (fq == 1) v[i] = v[i] * cs[i] + other * sn[i];
                            }
                        }
                        const float sc = pn < 2 ? QSCALE : 1.f;
                        pg8::u32x4 w; w.x = pg8::cvt_pk_bf16(v[0] * sc, v[1] * sc); w.y = pg8::cvt_pk_bf16(v[2] * sc, v[3] * sc); w.z = pg8::cvt_pk_bf16(v[4] * sc, v[5] * sc); w.w = pg8::cvt_pk_bf16(v[6] * sc, v[7] * sc);
                        if (pn < 2) *(pg8::u32x4*)(Qb + (size_t)row * 512 + pn * 256 + c0) = w;
                        else if (pn == 2) *(pg8::u32x4*)(KVb + (size_t)row * 512 + c0) = w;
                        else if (bj == 0) *(pg8::u32x4*)(KVb + (size_t)row * 512 + (pn - 2) * 128 + 128 + wc * 32 + 8 * fq) = w;
                        else {
                            const int cv = wc * 32 + 8 * fq, gg = cv >> 6, d0 = cv & 63, bb = row >> 12, tt = row & 4095;
                            bf16_t* vt = VT + ((size_t)((pn - 3) * 8 + bb * 2 + gg) * 64 + (tt >> 6)) * 4096 + (size_t)d0 * 64 + (tt & 63);
                            vt[0] = (bf16_t)(w.x & 0xffffu); vt[64] = (bf16_t)(w.x >> 16); vt[128] = (bf16_t)(w.y & 0xffffu); vt[192] = (bf16_t)(w.y >> 16);
                            vt[256] = (bf16_t)(w.z & 0xffffu); vt[320] = (bf16_t)(w.z >> 16); vt[384] = (bf16_t)(w.w & 0xffffu); vt[448] = (bf16_t)(w.w >> 16);
                        }
                    } else if (pn == 5) {
                        if (bj == 0 && wc == 0) {
#pragma unroll
                            for (int i = 0; i < 8; ++i) { const int c = 8 * fq + i;
                                if (c < 24) gates[(size_t)row * 24 + c] = sigmoidf_(v[i]);
                                else if (c < 32) ifp[(size_t)row * 8 + (c - 24)] = v[i] + b_if[c - 24]; }
                        }
                    } else {
                        if (pn >= 14) {
#pragma unroll
                            for (int i = 0; i < 8; ++i) v[i] = sigmoidf_(v[i]);
                        }
                        pg8::u32x4 w; w.x = pg8::cvt_pk_bf16(v[0], v[1]); w.y = pg8::cvt_pk_bf16(v[2], v[3]); w.z = pg8::cvt_pk_bf16(v[4], v[5]); w.w = pg8::cvt_pk_bf16(v[6], v[7]);
                        bf16_t* dst;
                        if (pn < 10) dst = MQK + (size_t)row * 1024 + (pn - 6) * 256 + c0;
                        else if (pn < 12) dst = MV + (size_t)row * 512 + (pn - 10) * 256 + c0;
                        else if (pn < 14) dst = MO + (size_t)row * 512 + (pn - 12) * 256 + c0;
                        else dst = MG + (size_t)row * 2048 + (pn - 14) * 256 + c0;
                        *(pg8::u32x4*)dst = w;
                    }
                }
            }
    }
};


DI pg8::u32x4 pack8(const float (&v)[8]) { pg8::u32x4 w; w.x = pg8::cvt_pk_bf16(v[0], v[1]); w.y = pg8::cvt_pk_bf16(v[2], v[3]); w.z = pg8::cvt_pk_bf16(v[4], v[5]); w.w = pg8::cvt_pk_bf16(v[6], v[7]); return w; }
DI void unpack8(const pg8::u32x4 w, float (&v)[8]) {
    v[0] = __uint_as_float(w.x << 16); v[1] = __uint_as_float(w.x & 0xffff0000u); v[2] = __uint_as_float(w.y << 16); v[3] = __uint_as_float(w.y & 0xffff0000u);
    v[4] = __uint_as_float(w.z << 16); v[5] = __uint_as_float(w.z & 0xffff0000u); v[6] = __uint_as_float(w.w << 16); v[7] = __uint_as_float(w.w & 0xffff0000u);
}
#define EPI_ROWS_BEGIN asm volatile("" : "+v"(fr), "+v"(fq)); _Pragma("unroll") for (int ai = 0; ai < 2; ++ai) _Pragma("unroll") for (int m = 0; m < 4; ++m) { const int row = u.pm * 256 + ai * 128 + wr * 64 + m * 16 + fr; _Pragma("unroll") for (int bj = 0; bj < 2; ++bj) { \
    float v[8]; _Pragma("unroll") for (int i = 0; i < 4; ++i) { v[i] = acc[ai][bj][m][0][i]; v[4 + i] = acc[ai][bj][m][1][i]; } const int c0 = bj * 128 + wc * 32 + 8 * fq; (void)c0; (void)row;
#define EPI_ROWS_END } asm volatile("" ::: "memory"); }
template <int MODE> struct EpiMerge {
    static constexpr bool PERM = true, AFTER_DRAIN = false;
    const bf16_t* MG; float* tmp; bf16_t* mixed;
    DI void operator()(const pg8::f32x4 (&acc)[2][2][4][2], const pg8::Unit& u, int wr, int wc, int fr, int fq) const {
        EPI_ROWS_BEGIN
            const int col = u.pn * 256 + c0; float gt[8];
            unpack8(*(const pg8::u32x4*)(MG + (size_t)row * 2048 + MODE * 1024 + col), gt);
            float* tp = tmp + (size_t)row * DM + col;
            if (MODE == 0) {
                *(float4*)tp = make_float4(gt[0] * v[0], gt[1] * v[1], gt[2] * v[2], gt[3] * v[3]); *(float4*)(tp + 4) = make_float4(gt[4] * v[4], gt[5] * v[5], gt[6] * v[6], gt[7] * v[7]);
            } else {
                const float4 t0 = *(const float4*)tp, t1 = *(const float4*)(tp + 4);
                float o[8] = {t0.x + gt[0] * v[0], t0.y + gt[1] * v[1], t0.z + gt[2] * v[2], t0.w + gt[3] * v[3], t1.x + gt[4] * v[4], t1.y + gt[5] * v[5], t1.z + gt[6] * v[6], t1.w + gt[7] * v[7]};
                *(pg8::u32x4*)(mixed + (size_t)row * DM + col) = pack8(o);
            }
        EPI_ROWS_END
    }
};
struct EpiX1 {
    static constexpr bool PERM = true, AFTER_DRAIN = false;
    const float* base; float* out;
    DI void operator()(const pg8::f32x4 (&acc)[2][2][4][2], const pg8::Unit& u, int wr, int wc, int fr, int fq) const {
        EPI_ROWS_BEGIN
            const size_t o = (size_t)row * DM + u.pn * 256 + c0;
            const float4 b0 = *(const float4*)(base + o), b1 = *(const float4*)(base + o + 4);
            *(float4*)(out + o) = make_float4(b0.x + v[0], b0.y + v[1], b0.z + v[2], b0.w + v[3]); *(float4*)(out + o + 4) = make_float4(b1.x + v[4], b1.y + v[5], b1.z + v[6], b1.w + v[7]);
        EPI_ROWS_END
    }
};
struct EpiStoreBf {
    static constexpr bool PERM = true, AFTER_DRAIN = false;
    bf16_t* O; int ld; int pnmask;
    DI void operator()(const pg8::f32x4 (&acc)[2][2][4][2], const pg8::Unit& u, int wr, int wc, int fr, int fq) const {
        EPI_ROWS_BEGIN
            *(pg8::u32x4*)(O + (size_t)row * ld + (u.pn & pnmask) * 256 + c0) = pack8(v);
        EPI_ROWS_END
    }
};
struct EpiSwiglu {
    static constexpr bool PERM = true, AFTER_DRAIN = false;
    bf16_t* act;
    DI void operator()(const pg8::f32x4 (&acc)[2][2][4][2], const pg8::Unit& u, int wr, int wc, int fr, int fq) const {
        asm volatile("" : "+v"(fr), "+v"(fq));
#pragma unroll
        for (int ai = 0; ai < 2; ++ai)
#pragma unroll
            for (int m = 0; m < 4; ++m) {
                const int row = u.pm * 256 + ai * 128 + wr * 64 + m * 16 + fr; float o[8];
#pragma unroll
                for (int i = 0; i < 4; ++i) { const float g0 = acc[ai][0][m][0][i], g1 = acc[ai][0][m][1][i]; o[i] = g0 * sigmoidf_(g0) * acc[ai][1][m][0][i]; o[4 + i] = g1 * sigmoidf_(g1) * acc[ai][1][m][1][i]; }
                *(pg8::u32x4*)(act + (size_t)row * 256 + (u.pn & 1) * 128 + wc * 32 + 8 * fq) = pack8(o);
            }
    }
};
struct EpiPle2 {
    static constexpr bool PERM = true, AFTER_DRAIN = false;
    float* x; const bf16_t* PP; const float* rstd;
    DI void operator()(const pg8::f32x4 (&acc)[2][2][4][2], const pg8::Unit& u, int wr, int wc, int fr, int fq) const {
        EPI_ROWS_BEGIN
            const size_t o = (size_t)row * DM + u.pn * 256 + c0; const float rs = rstd[row]; float pp[8];
            unpack8(*(const pg8::u32x4*)(PP + o), pp);
            const float4 b0 = *(const float4*)(x + o), b1 = *(const float4*)(x + o + 4);
            *(float4*)(x + o) = make_float4(b0.x + sigmoidf_(rs * v[0]) * pp[0], b0.y + sigmoidf_(rs * v[1]) * pp[1], b0.z + sigmoidf_(rs * v[2]) * pp[2], b0.w + sigmoidf_(rs * v[3]) * pp[3]);
            *(float4*)(x + o + 4) = make_float4(b1.x + sigmoidf_(rs * v[4]) * pp[4], b1.y + sigmoidf_(rs * v[5]) * pp[5], b1.z + sigmoidf_(rs * v[6]) * pp[6], b1.w + sigmoidf_(rs * v[7]) * pp[7]);
        EPI_ROWS_END
    }
};
struct MoeOrder {
    const int* cnt; int NJ, G, c;
    DI bool next(int i, pg8::Unit& u) const {
        int L = i * G + c, tb = 0;
        for (int e = 0; e < 16; ++e) { const int mt = (cnt[e] + 255) >> 8, n = mt * NJ; if (L < n) { u.pm = tb + L / NJ; u.pn = e * NJ + L % NJ; return true; } L -= n; tb += mt; }
        return false;
    }
    DI void a_ready(const pg8::Unit&) const {}
    DI void done(const pg8::Unit&) const {}
};
DI int moe_base_row(const int* cnt, int e) { int tb = 0; for (int k = 0; k < 16; ++k) { if (k < e) tb += (cnt[k] + 255) >> 8; } return tb * 256; }
struct MapId { DI int operator()(int n) const { return n; } };
struct MapE13 { DI int operator()(int n) const { return ((n >> 7) & 1) * 256 + (n >> 8) * 128 + (n & 127); } };

DI void router2(int tok, int lane, const float* __restrict__ x, const float* __restrict__ g, const float* __restrict__ w_rg, const float* __restrict__ b_rg,
                const float* __restrict__ w_re, const float* __restrict__ b_re, float* __restrict__ rstd1, int* __restrict__ rinfo, int* cnt) {
    float xv[16]; float s = 0.f;
#pragma unroll
    for (int j = 0; j < 4; ++j) { const float4 v = ((const float4*)(x + (size_t)tok * DM))[lane + 64 * j]; xv[4 * j] = v.x; xv[4 * j + 1] = v.y; xv[4 * j + 2] = v.z; xv[4 * j + 3] = v.w; s += v.x * v.x + v.y * v.y + v.z * v.z + v.w * v.w; }
    const float rstd = rsqrtf(wave_sum(s) * (1.f / DM) + 1e-6f);
#pragma unroll
    for (int j = 0; j < 4; ++j) { const float4 gg = ((const float4*)g)[lane + 64 * j]; xv[4 * j] *= rstd * gg.x; xv[4 * j + 1] *= rstd * gg.y; xv[4 * j + 2] *= rstd * gg.z; xv[4 * j + 3] *= rstd * gg.w; }
    float mylog = 0.f;
#pragma unroll 1
    for (int c = 0; c < 20; ++c) {
        const float* w = c < 4 ? w_rg + c : w_re + (c - 4); const int ld = c < 4 ? 4 : 16;
        float a = 0.f;
#pragma unroll
        for (int j = 0; j < 4; ++j)
#pragma unroll
            for (int i = 0; i < 4; ++i) a += xv[4 * j + i] * w[(size_t)(4 * (lane + 64 * j) + i) * ld];
        a = wave_sum(a) + (c < 4 ? b_rg[c] : b_re[c - 4]);
        if (lane == c) mylog = a;
    }
    float gl[4], el[16];
#pragma unroll
    for (int c = 0; c < 4; ++c) gl[c] = lane_get(mylog, c);
#pragma unroll
    for (int c = 0; c < 16; ++c) el[c] = lane_get(mylog, 4 + c);
    if (lane == 0) {
        int gs = 0; float gm = gl[0];
#pragma unroll
        for (int c = 1; c < 4; ++c) if (gl[c] > gm) { gm = gl[c]; gs = c; }
        float se = 0.f;
#pragma unroll
        for (int c = 0; c < 4; ++c) se += __expf(gl[c] - gm);
        const float pg = 1.f / se;
        float e4[4];
#pragma unroll
        for (int c = 0; c < 4; ++c) e4[c] = gs == 0 ? el[c] : gs == 1 ? el[4 + c] : gs == 2 ? el[8 + c] : el[12 + c];
        int i0 = 0; float v0 = e4[0];
#pragma unroll
        for (int c = 1; c < 4; ++c) if (e4[c] > v0) { v0 = e4[c]; i0 = c; }
        int i1 = -1; float v1 = -3.0e38f;
#pragma unroll
        for (int c = 0; c < 4; ++c) if (c != i0 && e4[c] > v1) { v1 = e4[c]; i1 = c; }
        const float ex = __expf(v1 - v0);
        const float w0 = pg / (1.f + ex), w1 = pg * ex / (1.f + ex);
        const int e0 = gs * 4 + i0, e1 = gs * 4 + i1;
        const int p0 = atomicAdd(cnt + e0, 1), p1 = atomicAdd(cnt + e1, 1);
        rstd1[tok] = rstd;
        int4 ri; ri.x = e0 | (e1 << 8); ri.y = p0 | (p1 << 16); ri.z = __float_as_int(w0); ri.w = __float_as_int(w1);
        *(int4*)(rinfo + (size_t)tok * 4) = ri;
    }
}

struct BMapId { DI int operator()(int n) const { return n; } };
struct BMapMoe { DI int operator()(int n) const { const int t = n >> 7, c = n & 127, e = t >> 2, jt = t & 3; return e * (1024 * 512) + ((c >> 5) & 1) * 256 + jt * 64 + (c >> 6) * 32 + (c & 31); } };
template <class Epi, class BMap>
DI void gemm_v1(int bx, int by, int tid, char* sm, const bf16_t* __restrict__ A, int lda, const float* __restrict__ B, int ldb, int N, int K, Epi epi, BMap bmap) {
    bf16_t* As = (bf16_t*)sm;
    bf16_t* Bs = (bf16_t*)(sm + 128 * 40 * 2);
    const int lane = tid & 63, w = tid >> 6, wr = w >> 1, wc = w & 1, r32 = lane & 31, hi = lane >> 5;
    const int m0 = by * 128, n0 = bx * 128;
    f32x16 acc[2][2];
#pragma unroll
    for (int i = 0; i < 2; ++i)
#pragma unroll
        for (int j = 0; j < 2; ++j)
#pragma unroll
            for (int r = 0; r < 16; ++r) acc[i][j][r] = 0.f;
    for (int k0 = 0; k0 < K; k0 += 32) {
#pragma unroll
        for (int i = 0; i < 2; ++i) {
            const int c = tid + i * 256, row = c >> 2, col = (c & 3) * 8;
            const uint4 v = *(const uint4*)(A + (size_t)(m0 + row) * lda + k0 + col);
            *(uint4*)(As + row * 40 + col) = v;
        }
#pragma unroll
        for (int i = 0; i < 4; ++i) {
            const int idx = tid + i * 256, k = idx >> 5, n = (idx & 31) * 4;
            float4 v = make_float4(0.f, 0.f, 0.f, 0.f);
            if (n0 + n < N) v = *(const float4*)(B + (size_t)(k0 + k) * ldb + bmap(n0 + n));
            Bs[(n + 0) * 40 + k] = f2bf(v.x); Bs[(n + 1) * 40 + k] = f2bf(v.y); Bs[(n + 2) * 40 + k] = f2bf(v.z); Bs[(n + 3) * 40 + k] = f2bf(v.w);
        }
        __syncthreads();
#pragma unroll
        for (int kk = 0; kk < 32; kk += 16) {
            bf16x8 a[2], b[2];
#pragma unroll
            for (int i = 0; i < 2; ++i) a[i] = *(const bf16x8*)(As + (wr * 64 + i * 32 + r32) * 40 + kk + hi * 8);
#pragma unroll
            for (int j = 0; j < 2; ++j) b[j] = *(const bf16x8*)(Bs + (wc * 64 + j * 32 + r32) * 40 + kk + hi * 8);
#pragma unroll
            for (int i = 0; i < 2; ++i)
#pragma unroll
                for (int j = 0; j < 2; ++j) acc[i][j] = __builtin_amdgcn_mfma_f32_32x32x16_bf16(a[i], b[j], acc[i][j], 0, 0, 0);
        }
        __syncthreads();
    }
#pragma unroll
    for (int i = 0; i < 2; ++i)
#pragma unroll
        for (int j = 0; j < 2; ++j)
#pragma unroll
            for (int r = 0; r < 16; ++r) {
                const int row = m0 + wr * 64 + i * 32 + (r & 3) + 8 * (r >> 2) + 4 * hi;
                const int col = n0 + wc * 64 + j * 32 + r32;
                if constexpr (Epi::PAIR) { if (j == 0) epi.pair(row, col, acc[i][0][r], acc[i][1][r]); }
                else { if (col < N) epi(row, col, acc[i][j][r]); }
            }
}

struct EpiPa { static constexpr bool PAIR = false;
    const bf16_t* MG; float* tmp;
    DI void operator()(int row, int col, float v) const { tmp[(size_t)row * DM + col] = bf2f(MG[(size_t)row * 2048 + col]) * v; }
};
struct EpiPb { static constexpr bool PAIR = false;
    const bf16_t* MG; const float* tmp; bf16_t* mixed;
    DI void operator()(int row, int col, float v) const {
        mixed[(size_t)row * DM + col] = f2bf(tmp[(size_t)row * DM + col] + bf2f(MG[(size_t)row * 2048 + 1024 + col]) * v);
    }
};
struct EpiResid { static constexpr bool PAIR = false;
    const float* base; float* out;
    DI void operator()(int row, int col, float v) const { out[(size_t)row * DM + col] = base[(size_t)row * DM + col] + v; }
};
struct EpiBf { static constexpr bool PAIR = false;
    bf16_t* o; int ld;
    DI void operator()(int row, int col, float v) const { o[(size_t)row * ld + col] = f2bf(v); }
};
struct EpiF32 { static constexpr bool PAIR = false;
    float* o; int ld;
    DI void operator()(int row, int col, float v) const { o[(size_t)row * ld + col] = v; }
};
struct EpiPle { static constexpr bool PAIR = false;
    float* x; const float* pp;
    DI void operator()(int row, int col, float v) const { const size_t i = (size_t)row * DM + col; x[i] = x[i] + sigmoidf_(v) * pp[i]; }
};

DI void rmsnorm_rows(int bx, int tid, const float* x, const float* __restrict__ g, bf16_t* outb, float* outf, int rows) {
    const int row = bx * 4 + (tid >> 6), lane = tid & 63;
    if (row >= rows) return;
    const float4* xr = (const float4*)(x + (size_t)row * DM);
    float4 v[4]; float s = 0.f;
#pragma unroll
    for (int j = 0; j < 4; ++j) { v[j] = xr[lane + 64 * j]; s += v[j].x * v[j].x + v[j].y * v[j].y + v[j].z * v[j].z + v[j].w * v[j].w; }
    const float rstd = rsqrtf(wave_sum(s) * (1.f / DM) + 1e-6f);
#pragma unroll
    for (int j = 0; j < 4; ++j) {
        const float4 gg = ((const float4*)g)[lane + 64 * j];
        const float a = v[j].x * rstd * gg.x, b = v[j].y * rstd * gg.y, c = v[j].z * rstd * gg.z, d = v[j].w * rstd * gg.w;
        if (outf) ((float4*)(outf + (size_t)row * DM))[lane + 64 * j] = make_float4(a, b, c, d);
        else { ushort4 o; o.x = f2bf(a); o.y = f2bf(b); o.z = f2bf(c); o.w = f2bf(d); ((ushort4*)(outb + (size_t)row * DM))[lane + 64 * j] = o; }
    }
}

DI void cvt_bf16(int bx, int nb, int tid, const float* __restrict__ in, bf16_t* __restrict__ out, size_t n) {
    for (size_t i = bx * (size_t)256 + tid; i < n; i += (size_t)nb * 256) out[i] = f2bf(in[i]);
}

DI float gelu_tanh(float x) { const float u = 0.7978845608028654f * (x + 0.044715f * x * x * x); return 0.5f * x * (1.f + tanhf(u)); }

DI void compress_naive(int bx, int by, int bz, int tid, char* sm, const bf16_t* __restrict__ KVb, const float* __restrict__ w1k, const float* __restrict__ w2k, const float* __restrict__ pek,
                                                      const float* __restrict__ w1v, const float* __restrict__ w2v, const float* __restrict__ pev, float* __restrict__ outk, float* __restrict__ outv, bf16_t* __restrict__ kcb, bf16_t* __restrict__ vcT) {
    float* flat = (float*)sm;
    float* h1 = flat + 2048;
    __syncthreads();
    const int j = bx, bg = by, kv = bz, b = bg >> 1, g = bg & 1;
    const float* w1 = kv ? w1v : w1k; const float* w2 = kv ? w2v : w2k; const float* pe = kv ? pev : pek; float* out = kv ? outv : outk;
    const int colbase = (kv ? 128 : 0) + g * 64;
    for (int e = tid; e < 2048; e += 256) {
        const int i = e >> 6, d = e & 63;
        flat[e] = bf2f(KVb[(size_t)(b * SEQ + 16 * j + i) * 512 + colbase + d]) + pe[e];
    }
    __syncthreads();
    float s = 0.f;
    for (int k = 0; k < 2048; ++k) s += flat[k] * w1[(size_t)k * 256 + tid];
    h1[tid] = gelu_tanh(s);
    __syncthreads();
    if (tid < 64) {
        float o = 0.f;
        for (int n = 0; n < 256; ++n) o += h1[n] * w2[n * 64 + tid];
        out[((size_t)bg * 256 + j) * 64 + tid] = o;
        if (kv == 0) { kcb[((size_t)bg * 256 + j) * 64 + tid] = f2bf(o); if (j == 254) kcb[((size_t)bg * 256 + 255) * 64 + tid] = 0; }
        else { vcT[((size_t)bg * 4 + (j >> 6)) * 4096 + tid * 64 + (j & 63)] = f2bf(o); if (j == 254) vcT[((size_t)bg * 4 + 3) * 4096 + tid * 64 + 63] = 0; }
    }
}

DI void softmax_row(float* row, int n, int lane) {
    float m = -3.0e38f;
    for (int j = lane; j < n; j += 64) m = fmaxf(m, row[j]);
    m = wave_max(m);
    float s = 0.f;
    for (int j = lane; j < n; j += 64) { const float e = exp2f(row[j] - m); row[j] = e; s += e; }
    s = wave_sum(s);
    const float inv = 1.f / s;
    for (int j = lane; j < n; j += 64) row[j] *= inv;
}

DI void nsa_naive(int bx, int by, int tid, char* sm, const bf16_t* __restrict__ Qb, const bf16_t* __restrict__ KVb, const bf16_t* __restrict__ VT, const float* __restrict__ kcc, const float* __restrict__ vcc, const float* __restrict__ gates, bf16_t* __restrict__ Y) {
    float (*q)[64] = (float (*)[64])sm;
    float (*sc)[1024] = (float (*)[1024])(sm + 1024);
    float* impv = (float*)(sm + 1024 + 16384);
    int* sellist = (int*)(sm + 1024 + 16384 + 256);
    int* selflag = (int*)(sm + 1024 + 16384 + 256 + 64);
    int& nsel_s = *(int*)(sm + 1024 + 16384 + 256 + 64 + 256);
    __syncthreads();
    const int tok = bx, g = by, b = tok >> 12, t = tok & 4095, hh = tid >> 6, lane = tid & 63, d = lane;
    q[hh][d] = bf2f(Qb[(size_t)tok * 512 + (g * 4 + hh) * 64 + d]);
    __syncthreads();
    const int nv = (t >= 31) ? ((t - 15) >> 4) : 0;
    const float* kcb = kcc + (size_t)(b * 2 + g) * 256 * 64; const float* vcb = vcc + (size_t)(b * 2 + g) * 256 * 64;
    if (tid < nv) {
        float s0 = 0.f, s1 = 0.f, s2 = 0.f, s3 = 0.f;
#pragma unroll 8
        for (int dd = 0; dd < 64; ++dd) { const float kx = kcb[tid * 64 + dd]; s0 += q[0][dd] * kx; s1 += q[1][dd] * kx; s2 += q[2][dd] * kx; s3 += q[3][dd] * kx; }
        sc[0][tid] = s0; sc[1][tid] = s1; sc[2][tid] = s2; sc[3][tid] = s3;
    }
    __syncthreads();
    if (nv > 0) softmax_row(sc[hh], nv, lane);
    for (int j = nv + lane; j < 256; j += 64) sc[hh][j] = 0.f;
    __syncthreads();
    float o_cmp = 0.f;
    for (int j = 0; j < nv; ++j) o_cmp += sc[hh][j] * vcb[j * 64 + d];
    const int cur = t >> 6;
    if (tid < 64) {
        const int s = tid; int lo = 4 * s - 1; if (lo < 0) lo = 0; int hi2 = 4 * s + 3; if (hi2 > 254) hi2 = 254;
        float v = 0.f;
        for (int h2 = 0; h2 < 4; ++h2) for (int j = lo; j <= hi2; ++j) v += sc[h2][j];
        if (s == 0 || s == cur || s == cur - 1) v += 1000.0f;
        if (s > cur) v = -1e30f;
        impv[s] = v;
    }
    __syncthreads();
    if (tid < 64) {
        const float v = impv[tid]; int rank = 0;
        for (int s2 = 0; s2 < 64; ++s2) { const float u = impv[s2]; rank += (u > v || (u == v && s2 < tid)) ? 1 : 0; }
        selflag[tid] = (rank < 16 && tid <= cur) ? 1 : 0;
    }
    __syncthreads();
    if (tid == 0) { int n = 0; for (int s = 0; s < 64; ++s) if (selflag[s]) { if (n < 16) sellist[n] = s; ++n; } nsel_s = n < 16 ? n : 16; }
    __syncthreads();
    const int ns = nsel_s, ne = ns * 64;
    for (int e = tid; e < ne; e += 256) {
        const int kpos = sellist[e >> 6] * 64 + (e & 63);
        if (kpos <= t) {
            const bf16_t* kp = KVb + (size_t)(b * SEQ + kpos) * 512 + 256 + g * 64;
            float s0 = 0.f, s1 = 0.f, s2 = 0.f, s3 = 0.f;
    #pragma unroll 8
        for (int dd = 0; dd < 64; ++dd) { const float kx = bf2f(kp[dd]); s0 += q[0][dd] * kx; s1 += q[1][dd] * kx; s2 += q[2][dd] * kx; s3 += q[3][dd] * kx; }
            sc[0][e] = s0; sc[1][e] = s1; sc[2][e] = s2; sc[3][e] = s3;
        } else { sc[0][e] = -1e30f; sc[1][e] = -1e30f; sc[2][e] = -1e30f; sc[3][e] = -1e30f; }
    }
    __syncthreads();
    softmax_row(sc[hh], ne, lane);
    __syncthreads();
    float o_sel = 0.f;
    for (int e = 0; e < ne; ++e) {
        const int kpos = sellist[e >> 6] * 64 + (e & 63);
        o_sel += sc[hh][e] * bf2f(VT[((size_t)(b * 2 + g) * 64 + (kpos >> 6)) * 4096 + d * 64 + (kpos & 63)]);
    }
    __syncthreads();
    const int nw = (t + 1 < 512) ? (t + 1) : 512, w0 = t - nw + 1;
    for (int e = tid; e < nw; e += 256) {
        const bf16_t* kp = KVb + (size_t)(b * SEQ + w0 + e) * 512 + 384 + g * 64;
        float s0 = 0.f, s1 = 0.f, s2 = 0.f, s3 = 0.f;
#pragma unroll 8
        for (int dd = 0; dd < 64; ++dd) { const float kx = bf2f(kp[dd]); s0 += q[0][dd] * kx; s1 += q[1][dd] * kx; s2 += q[2][dd] * kx; s3 += q[3][dd] * kx; }
        sc[0][e] = s0; sc[1][e] = s1; sc[2][e] = s2; sc[3][e] = s3;
    }
    __syncthreads();
    softmax_row(sc[hh], nw, lane);
    __syncthreads();
    float o_win = 0.f;
    for (int e = 0; e < nw; ++e) { const int kpos = w0 + e; o_win += sc[hh][e] * bf2f(VT[((size_t)(8 + b * 2 + g) * 64 + (kpos >> 6)) * 4096 + d * 64 + (kpos & 63)]); }
    const float* gt = gates + (size_t)tok * 24 + (g * 4 + hh) * 3;
    Y[(size_t)tok * DM + (g * 4 + hh) * 64 + d] = f2bf(gt[0] * o_cmp + gt[1] * o_sel + gt[2] * o_win);
}

DI void conv_silu(int bx, int tid, const bf16_t* __restrict__ MQK, const float* __restrict__ wc, const float* __restrict__ bc, bf16_t* __restrict__ out) {
    const int idx = bx * 256 + tid;
    if (idx >= T_TOK * 1024) return;
    const int c = idx & 1023, tok = idx >> 10, t = tok & 4095;
    float y = bc[c];
#pragma unroll
    for (int j = 0; j < 4; ++j) { const int tt = t - 3 + j; if (tt >= 0) y += wc[j * 1024 + c] * bf2f(MQK[(size_t)(tok - 3 + j) * 1024 + c]); }
    y = y * sigmoidf_(y);
    if (c >= 512) y *= 0.08838834764831845f;
    out[idx] = f2bf(y);
}

DI void mlstm_naive(int bx, int tid, char* sm, const bf16_t* __restrict__ qkc, const bf16_t* __restrict__ MV, const bf16_t* __restrict__ MO, const float* __restrict__ ifp, float* __restrict__ hm) {
    float (*qs)[128] = (float (*)[128])sm;
    float (*ks)[128] = (float (*)[128])(sm + 16384);
    float (*vs)[16] = (float (*)[16])(sm + 32768);
    float (*os)[16] = (float (*)[16])(sm + 32768 + 2048);
    float* gi = (float*)(sm + 32768 + 4096); float* gf = gi + 32;
    const int bh = bx >> 3, vsl = bx & 7, b = bh >> 2, h = bh & 3, v = tid >> 4, kg = tid & 15;
    float C[8], n[8];
#pragma unroll
    for (int j = 0; j < 8; ++j) { C[j] = 0.f; n[j] = 0.f; }
    for (int c0 = 0; c0 < SEQ; c0 += 32) {
        __syncthreads();
        for (int e = tid; e < 32 * 128; e += 256) {
            const int s = e >> 7, k = e & 127; const size_t tok = (size_t)b * SEQ + c0 + s;
            qs[s][k] = bf2f(qkc[tok * 1024 + h * 128 + k]); ks[s][k] = bf2f(qkc[tok * 1024 + 512 + h * 128 + k]);
        }
        for (int e = tid; e < 32 * 16; e += 256) {
            const int s = e >> 4, vv = e & 15; const size_t tok = (size_t)b * SEQ + c0 + s;
            vs[s][vv] = bf2f(MV[tok * 512 + h * 128 + vsl * 16 + vv]);
            os[s][vv] = sigmoidf_(bf2f(MO[tok * 512 + h * 128 + vsl * 16 + vv]));
        }
        if (tid < 32) { const size_t tok = (size_t)b * SEQ + c0 + tid; gi[tid] = __expf(ifp[tok * 8 + h]); gf[tid] = sigmoidf_(ifp[tok * 8 + 4 + h]); }
        __syncthreads();
        for (int s = 0; s < 32; ++s) {
            const float f = gf[s], iv = gi[s] * vs[s][v], ig = gi[s];
            float num = 0.f, den = 0.f;
#pragma unroll
            for (int j = 0; j < 8; ++j) {
                const float kx = ks[s][kg * 8 + j], qx = qs[s][kg * 8 + j];
                C[j] = f * C[j] + iv * kx; n[j] = f * n[j] + ig * kx;
                num += C[j] * qx; den += n[j] * qx;
            }
            const int l_ = lane_id_opaque();
#pragma unroll
            for (int o = 1; o < 16; o <<= 1) { num += lane_xor(num, o, l_); den += lane_xor(den, o, l_); }
            if (kg == 0) hm[((size_t)b * SEQ + c0 + s) * 512 + h * 128 + vsl * 16 + v] = num / fmaxf(fabsf(den), 1.0f) * os[s][v];
        }
    }
}

DI void hnorm(int bx, int tid, const float* __restrict__ hm, const float* __restrict__ g_hn, bf16_t* __restrict__ Y) {
    const int item = bx * 4 + (tid >> 6), lane = tid & 63;
    const int tok = item >> 2, h = item & 3;
    const float a = hm[(size_t)tok * 512 + h * 128 + lane], b = hm[(size_t)tok * 512 + h * 128 + 64 + lane];
    const float rstd = rsqrtf(wave_sum(a * a + b * b) * (1.f / 128.f) + 1e-6f);
    Y[(size_t)tok * DM + 512 + h * 128 + lane] = f2bf(a * rstd * g_hn[h * 128 + lane]);
    Y[(size_t)tok * DM + 512 + h * 128 + 64 + lane] = f2bf(b * rstd * g_hn[h * 128 + 64 + lane]);
}

DI void router(int bx, int tid, const float* __restrict__ x, const float* __restrict__ g, const float* __restrict__ w_rg, const float* __restrict__ b_rg,
                                              const float* __restrict__ w_re, const float* __restrict__ b_re, bf16_t* __restrict__ xn, float* __restrict__ gate) {
    const int tok = bx * 4 + (tid >> 6), lane = tid & 63;
    float xv[16]; float s = 0.f;
#pragma unroll
    for (int j = 0; j < 4; ++j) { const float4 v = ((const float4*)(x + (size_t)tok * DM))[lane + 64 * j]; xv[4 * j] = v.x; xv[4 * j + 1] = v.y; xv[4 * j + 2] = v.z; xv[4 * j + 3] = v.w; s += v.x * v.x + v.y * v.y + v.z * v.z + v.w * v.w; }
    const float rstd = rsqrtf(wave_sum(s) * (1.f / DM) + 1e-6f);
#pragma unroll
    for (int j = 0; j < 4; ++j) { const float4 gg = ((const float4*)g)[lane + 64 * j]; xv[4 * j] *= rstd * gg.x; xv[4 * j + 1] *= rstd * gg.y; xv[4 * j + 2] *= rstd * gg.z; xv[4 * j + 3] *= rstd * gg.w;
        ushort4 o; o.x = f2bf(xv[4 * j]); o.y = f2bf(xv[4 * j + 1]); o.z = f2bf(xv[4 * j + 2]); o.w = f2bf(xv[4 * j + 3]); ((ushort4*)(xn + (size_t)tok * DM))[lane + 64 * j] = o; }
    float mylog = 0.f;
#pragma unroll 1
    for (int c = 0; c < 20; ++c) {
        const float* w = c < 4 ? w_rg + c : w_re + (c - 4); const int ld = c < 4 ? 4 : 16;
        float a = 0.f;
#pragma unroll
        for (int j = 0; j < 4; ++j)
#pragma unroll
            for (int i = 0; i < 4; ++i) a += xv[4 * j + i] * w[(size_t)(4 * (lane + 64 * j) + i) * ld];
        a = wave_sum(a) + (c < 4 ? b_rg[c] : b_re[c - 4]);
        if (lane == c) mylog = a;
    }
    float gl[4], el[16];
#pragma unroll
    for (int c = 0; c < 4; ++c) gl[c] = lane_get(mylog, c);
#pragma unroll
    for (int c = 0; c < 16; ++c) el[c] = lane_get(mylog, 4 + c);
    if (lane == 0) {
        int gs = 0; float gm = gl[0];
#pragma unroll
        for (int c = 1; c < 4; ++c) if (gl[c] > gm) { gm = gl[c]; gs = c; }
        float se = 0.f;
#pragma unroll
        for (int c = 0; c < 4; ++c) se += __expf(gl[c] - gm);
        const float pg = 1.f / se;
        float e4[4];
#pragma unroll
        for (int c = 0; c < 4; ++c) e4[c] = gs == 0 ? el[c] : gs == 1 ? el[4 + c] : gs == 2 ? el[8 + c] : el[12 + c];
        int i0 = 0; float v0 = e4[0];
#pragma unroll
        for (int c = 1; c < 4; ++c) if (e4[c] > v0) { v0 = e4[c]; i0 = c; }
        int i1 = -1; float v1 = -3.0e38f;
#pragma unroll
        for (int c = 0; c < 4; ++c) if (c != i0 && e4[c] > v1) { v1 = e4[c]; i1 = c; }
        const float ex = __expf(v1 - v0);
        const float w0 = pg / (1.f + ex), w1 = pg * ex / (1.f + ex);
#pragma unroll
        for (int c = 0; c < 16; ++c) gate[(size_t)tok * 16 + c] = (c == gs * 4 + i0) ? w0 : (c == gs * 4 + i1) ? w1 : 0.f;
    }
}


struct EpiMoe { static constexpr bool PAIR = true;
    const float* gate; bf16_t* act;
    DI void operator()(int, int, float) const {}
    DI void pair(int row, int col, float gg, float u) const {
        const int t = col >> 7, c = col & 127, e = t >> 2, jt = t & 3, f = jt * 64 + (c >> 6) * 32 + (c & 31);
        act[(size_t)row * 4096 + e * 256 + f] = f2bf(gg * sigmoidf_(gg) * u * gate[(size_t)row * 16 + e]);
    }
};

typedef float f32x2_t __attribute__((ext_vector_type(2))); typedef __bf16 bf16x2_t __attribute__((ext_vector_type(2)));
DI unsigned cvtpk(float lo, float hi) { f32x2_t v = {lo, hi}; bf16x2_t b = __builtin_convertvector(v, bf16x2_t); return __builtin_bit_cast(unsigned, b); }
typedef __attribute__((address_space(3))) char lds_c;
typedef unsigned u32x2v __attribute__((ext_vector_type(2))); typedef unsigned u32x4v __attribute__((ext_vector_type(4)));
constexpr int NSA_KC = 0, NSA_VC = 4 * 9216, NSA_KB = NSA_VC + 4 * 8704, NSA_VB = NSA_KB + 2 * 9216, NSA_IMP = NSA_VB + 2 * 8704, NSA_MASK = NSA_IMP + 64 * 65 * 4, NSA_END = NSA_MASK + 512;
static_assert(NSA_END <= 147456, "NSA LDS map");
DI int crow(int r, int hi) { return (r & 3) + 8 * (r >> 2) + 4 * hi; }
#define MFMA32(a, b, c) __builtin_amdgcn_mfma_f32_32x32x16_bf16((a), (b), (c), 0, 0, 0)

DI void nsa_qk(f32x16& p0, f32x16& p1, const lds_c* K, const bf16x8 (&qf)[4], int r32, int hi) {
#pragma unroll
    for (int r = 0; r < 16; ++r) { p0[r] = 0.f; p1[r] = 0.f; }
#pragma unroll
    for (int ks = 0; ks < 4; ++ks) {
        const bf16x8 a0 = *(const __attribute__((address_space(3))) bf16x8*)(K + r32 * 144 + ks * 32 + hi * 16);
        const bf16x8 a1 = *(const __attribute__((address_space(3))) bf16x8*)(K + (32 + r32) * 144 + ks * 32 + hi * 16);
        p0 = MFMA32(a0, qf[ks], p0); p1 = MFMA32(a1, qf[ks], p1);
    }
}
DI void nsa_softmax(f32x16& p0, f32x16& p1, float& m, float& l, f32x16& o0, f32x16& o1) {
    float mx = fmaxf(p0[0], p1[0]);
#pragma unroll
    for (int r = 1; r < 16; ++r) mx = fmaxf(mx, fmaxf(p0[r], p1[r]));
    { auto rr = __builtin_amdgcn_permlane32_swap(__float_as_uint(mx), __float_as_uint(mx), false, false); mx = fmaxf(__uint_as_float(rr[0]), __uint_as_float(rr[1])); }
    const float mn = fmaxf(m, mx), alpha = __builtin_amdgcn_exp2f(m - mn);
    m = mn;
    float s = 0.f;
#pragma unroll
    for (int r = 0; r < 16; ++r) { p0[r] = __builtin_amdgcn_exp2f(p0[r] - mn); p1[r] = __builtin_amdgcn_exp2f(p1[r] - mn); s += p0[r] + p1[r]; }
    l = l * alpha + s;
#pragma unroll
    for (int r = 0; r < 16; ++r) { o0[r] *= alpha; o1[r] *= alpha; }
}
DI void nsa_pv(f32x16& o0, f32x16& o1, const f32x16& p0, const f32x16& p1, const lds_c* V, int r32, int hi) {
#pragma unroll
    for (int hf = 0; hf < 2; ++hf)
#pragma unroll
        for (int s = 0; s < 2; ++s) {
            unsigned pw[4];
#pragma unroll
            for (int j = 0; j < 4; ++j) pw[j] = hf ? cvtpk(p1[8 * s + 2 * j], p1[8 * s + 2 * j + 1]) : cvtpk(p0[8 * s + 2 * j], p0[8 * s + 2 * j + 1]);
            const u32x4v pbw = {pw[0], pw[1], pw[2], pw[3]};
            const bf16x8 pb = __builtin_bit_cast(bf16x8, pbw);
            const lds_c* vp = V + r32 * 136 + hf * 64 + s * 32 + hi * 8;
            const u32x2v a0l = *(const __attribute__((address_space(3))) u32x2v*)(vp), a0h = *(const __attribute__((address_space(3))) u32x2v*)(vp + 16);
            const u32x2v a1l = *(const __attribute__((address_space(3))) u32x2v*)(vp + 32 * 136), a1h = *(const __attribute__((address_space(3))) u32x2v*)(vp + 32 * 136 + 16);
            const u32x4v A0w = {a0l.x, a0l.y, a0h.x, a0h.y}, A1w = {a1l.x, a1l.y, a1h.x, a1h.y};
            o0 = MFMA32(__builtin_bit_cast(bf16x8, A0w), pb, o0); o1 = MFMA32(__builtin_bit_cast(bf16x8, A1w), pb, o1);
        }
}
DI void nsa_store_k(lds_c* K, const u32x4v v, int tid) { *(__attribute__((address_space(3))) u32x4v*)(K + (tid >> 3) * 144 + (tid & 7) * 16) = v; }
DI void nsa_store_v(lds_c* V, const u32x4v v, int tid) { lds_c* p = V + (tid >> 3) * 136 + (tid & 7) * 16; *(__attribute__((address_space(3))) u32x2v*)p = (u32x2v){v.x, v.y}; *(__attribute__((address_space(3))) u32x2v*)(p + 8) = (u32x2v){v.z, v.w}; }
#define NEG_INF (-__builtin_inff())
DI void nsa_finish(f32x16& y0, f32x16& y1, f32x16& o0, f32x16& o1, float& m, float& l, float gate) {
    float lt; { auto rr = __builtin_amdgcn_permlane32_swap(__float_as_uint(l), __float_as_uint(l), false, false); lt = __uint_as_float(rr[0]) + __uint_as_float(rr[1]); }
    const float f = lt > 0.f ? gate / lt : 0.f;
#pragma unroll
    for (int r = 0; r < 16; ++r) { y0[r] += f * o0[r]; y1[r] += f * o1[r]; o0[r] = 0.f; o1[r] = 0.f; }
    m = -1e30f; l = 0.f;
}

DI void nsa_unit(int bg, int qb, int tx, lds_c* lds, const bf16_t* __restrict__ Qb, const bf16_t* __restrict__ KVb, const bf16_t* __restrict__ VT, const bf16_t* __restrict__ kcb, const bf16_t* __restrict__ vcT,
                 const float* __restrict__ gates, bf16_t* __restrict__ Y) {
    const int lane = tx & 63, r32 = lane & 31, hi = lane >> 5, wave = __builtin_amdgcn_readfirstlane(tx >> 6), hh = wave >> 1, qs = wave & 1;
    const int b = bg >> 1, g = bg & 1, ql = 32 * qs + r32, tq = 64 * qb + ql;
    const size_t tok = (size_t)b * SEQ + tq; const int head = g * 4 + hh;
    const int nc = (4 * qb + 66) >> 6;
    const bool need_topk = qb >= 16;
    lds_c* KC = lds + NSA_KC; lds_c* VC = lds + NSA_VC; lds_c* KB = lds + NSA_KB; lds_c* VB = lds + NSA_VB;
    __attribute__((address_space(3))) float* imp = (__attribute__((address_space(3))) float*)(lds + NSA_IMP);
    __attribute__((address_space(3))) unsigned* msk = (__attribute__((address_space(3))) unsigned*)(lds + NSA_MASK);
    const bf16_t* kcsrc = kcb + (size_t)bg * 256 * 64; const bf16_t* vcsrc = vcT + (size_t)bg * 4 * 4096;
    const bf16_t* kssrc = KVb + (size_t)b * SEQ * 512 + 256 + g * 64; const bf16_t* kwsrc = KVb + (size_t)b * SEQ * 512 + 384 + g * 64;
    const bf16_t* vssrc = VT + (size_t)bg * 64 * 4096; const bf16_t* vwsrc = VT + (size_t)(8 + bg) * 64 * 4096;
    const int n_sel = qb + 1, n_win = qb + 1 < 9 ? qb + 1 : 9, ntile = n_sel + n_win;
    __syncthreads();
    for (int c = 0; c < nc; ++c) {
        nsa_store_k(KC + c * 9216, *(const u32x4v*)(kcsrc + (size_t)(c * 64 + (tx >> 3)) * 64 + (tx & 7) * 8), tx);
        nsa_store_v(VC + c * 8704, *(const u32x4v*)(vcsrc + (size_t)c * 4096 + (tx >> 3) * 64 + (tx & 7) * 8), tx);
    }
    nsa_store_k(KB, *(const u32x4v*)(kssrc + (size_t)(tx >> 3) * 512 + (tx & 7) * 8), tx);
    nsa_store_v(VB, *(const u32x4v*)(vssrc + (tx >> 3) * 64 + (tx & 7) * 8), tx);
    for (int i = tx; i < 64 * 65; i += 512) imp[i] = 0.f;
    bf16x8 qf[4];
#pragma unroll
    for (int ks = 0; ks < 4; ++ks) qf[ks] = *(const bf16x8*)(Qb + tok * 512 + head * 64 + ks * 16 + hi * 8);
    const float g_cmp = gates[tok * 24 + head * 3 + 0], g_sel = gates[tok * 24 + head * 3 + 1], g_win = gates[tok * 24 + head * 3 + 2];
    f32x16 y0, y1, o0, o1, p0, p1;
#pragma unroll
    for (int r = 0; r < 16; ++r) { y0[r] = 0.f; y1[r] = 0.f; o0[r] = 0.f; o1[r] = 0.f; }
    float m = -1e30f, l = 0.f;
    __syncthreads();
    const int nvq = tq >= 31 ? ((tq - 15) >> 4) : 0;
    for (int c = 0; c < nc; ++c) {
        nsa_qk(p0, p1, KC + c * 9216, qf, r32, hi);
        const int lim = nvq - 64 * c;
#pragma unroll
        for (int r = 0; r < 16; ++r) { const int kl = crow(r, hi); if (kl >= lim) p0[r] = NEG_INF; if (kl + 32 >= lim) p1[r] = NEG_INF; }
        nsa_softmax(p0, p1, m, l, o0, o1);
        nsa_pv(o0, o1, p0, p1, VC + c * 8704, r32, hi);
    }
    const float m_c = m; float l_c; { auto rr = __builtin_amdgcn_permlane32_swap(__float_as_uint(l), __float_as_uint(l), false, false); l_c = __uint_as_float(rr[0]) + __uint_as_float(rr[1]); }
    nsa_finish(y0, y1, o0, o1, m, l, g_cmp);
    unsigned mlo = 0xffffffffu, mhi = 0xffffffffu;
    if (need_topk) {
        const float invl = l_c > 0.f ? 1.f / l_c : 0.f;
        for (int c = 0; c < nc; ++c) {
            nsa_qk(p0, p1, KC + c * 9216, qf, r32, hi);
            const int lim = nvq - 64 * c;
#pragma unroll
            for (int r = 0; r < 16; ++r) { const int kl = crow(r, hi);
                p0[r] = kl < lim ? __builtin_amdgcn_exp2f(p0[r] - m_c) * invl : 0.f; p1[r] = kl + 32 < lim ? __builtin_amdgcn_exp2f(p1[r] - m_c) * invl : 0.f; }
            for (int h = 0; h < 4; ++h) {
                if (hh == h) {
#pragma unroll
                    for (int hf = 0; hf < 2; ++hf)
#pragma unroll
                        for (int i = 0; i < 4; ++i) {
                            const int a = 16 * c + 8 * hf + 2 * i + hi;
                            const float gsum = hf ? (p1[4 * i] + p1[4 * i + 1]) + (p1[4 * i + 2] + p1[4 * i + 3]) : (p0[4 * i] + p0[4 * i + 1]) + (p0[4 * i + 2] + p0[4 * i + 3]);
                            imp[ql * 65 + a] += gsum;
                        }
                    asm volatile("s_waitcnt lgkmcnt(0)" ::: "memory");
#pragma unroll
                    for (int hf = 0; hf < 2; ++hf)
#pragma unroll
                        for (int i = 0; i < 4; ++i) {
                            const int a = 16 * c + 8 * hf + 2 * i + hi;
                            const float last = hf ? p1[4 * i + 3] : p0[4 * i + 3];
                            if (a + 1 < 64) imp[ql * 65 + a + 1] += last;
                        }
                }
                __syncthreads();
            }
        }
        {
            const int q = tx >> 3, j8 = tx & 7, smax = qb - 2;
            unsigned blo = 0u, bhi = 0u;
#pragma unroll 1
            for (int k = 0; k < 8; ++k) {
                const int s = j8 + 8 * k;
                if (s >= 1 && s <= smax) {
                    const float v = imp[q * 65 + s]; int rank = 0;
                    for (int s2 = 1; s2 <= smax; ++s2) { const float u = imp[q * 65 + s2]; rank += (u > v || (u == v && s2 < s)) ? 1 : 0; }
                    if (rank < 13) { if (s < 32) blo |= 1u << s; else bhi |= 1u << (s - 32); }
                }
            }
            const int l_ = lane_id_opaque();
#pragma unroll
            for (int o = 1; o < 8; o <<= 1) { blo |= (unsigned)__builtin_amdgcn_ds_bpermute((l_ ^ o) << 2, (int)blo); bhi |= (unsigned)__builtin_amdgcn_ds_bpermute((l_ ^ o) << 2, (int)bhi); }
            unsigned long long mm = ((unsigned long long)bhi << 32) | blo;
            mm |= 1ull | (1ull << qb) | (1ull << (qb - 1));
            if (j8 == 0) { msk[q * 2] = (unsigned)mm; msk[q * 2 + 1] = (unsigned)(mm >> 32); }
        }
        __syncthreads();
        mlo = msk[ql * 2]; mhi = msk[ql * 2 + 1];
    }
    for (int i = 0; i < ntile; ++i) {
        const int cur = i & 1;
        const bool is_sel = i < n_sel; const int s = is_sel ? i : qb - n_win + 1 + (i - n_sel);
        u32x4v kreg = {0u, 0u, 0u, 0u}, vreg = {0u, 0u, 0u, 0u};
        if (i + 1 < ntile) {
            const bool nsel = i + 1 < n_sel; const int s2 = nsel ? i + 1 : qb - n_win + 1 + (i + 1 - n_sel);
            kreg = *(const u32x4v*)((nsel ? kssrc : kwsrc) + (size_t)(s2 * 64 + (tx >> 3)) * 512 + (tx & 7) * 8);
            vreg = *(const u32x4v*)((nsel ? vssrc : vwsrc) + (size_t)s2 * 4096 + (tx >> 3) * 64 + (tx & 7) * 8);
        }
        nsa_qk(p0, p1, KB + cur * 9216, qf, r32, hi);
        if (is_sel) {
            const bool on = ((s < 32 ? (mlo >> s) : (mhi >> (s - 32))) & 1u) != 0u;
#pragma unroll
            for (int r = 0; r < 16; ++r) { const int kl = crow(r, hi); if (!on || (s == qb && kl > ql)) p0[r] = NEG_INF; if (!on || (s == qb && kl + 32 > ql)) p1[r] = NEG_INF; }
        } else {
            const bool lowb = (qb >= 8) && (s == qb - 8), diag = (s == qb);
#pragma unroll
            for (int r = 0; r < 16; ++r) { const int kl = crow(r, hi);
                if ((lowb && kl <= ql) || (diag && kl > ql)) p0[r] = NEG_INF; if ((lowb && kl + 32 <= ql) || (diag && kl + 32 > ql)) p1[r] = NEG_INF; }
        }
        nsa_softmax(p0, p1, m, l, o0, o1);
        nsa_pv(o0, o1, p0, p1, VB + cur * 8704, r32, hi);
        if (i == n_sel - 1) nsa_finish(y0, y1, o0, o1, m, l, g_sel);
        if (i == ntile - 1) nsa_finish(y0, y1, o0, o1, m, l, g_win);
        if (i + 1 < ntile) { nsa_store_k(KB + (cur ^ 1) * 9216, kreg, tx); nsa_store_v(VB + (cur ^ 1) * 8704, vreg, tx); }
        __syncthreads();
    }
    bf16_t* yp = Y + tok * DM + head * 64;
#pragma unroll
    for (int i = 0; i < 4; ++i) {
        *(uint2*)(yp + 8 * i + 4 * hi) = make_uint2(cvtpk(y0[4 * i], y0[4 * i + 1]), cvtpk(y0[4 * i + 2], y0[4 * i + 3]));
        *(uint2*)(yp + 32 + 8 * i + 4 * hi) = make_uint2(cvtpk(y1[4 * i], y1[4 * i + 1]), cvtpk(y1[4 * i + 2], y1[4 * i + 3]));
    }
}

DI float log_sigmoid_(float x) { return x >= 0.f ? -log1pf(__expf(-x)) : x - log1pf(__expf(x)); }
DI float lane_shr_add(float v, int l) {
#pragma unroll
    for (int o = 1; o < 64; o <<= 1) { const float t = lane_get(v, l - o); if (l >= o) v += t; }
    return v;
}
DI float lane_shr_max(float v, int l) {
#pragma unroll
    for (int o = 1; o < 64; o <<= 1) { const float t = lane_get(v, l - o); if (l >= o) v = fmaxf(v, t); }
    return v;
}
DI void ml_mscan(const float* __restrict__ ifp, int b, int h, int c, int lane, float& m_c, float& m_n) {
    const float* gp = ifp + ((size_t)b * SEQ + 64 * lane) * 8 + h;
    float L = 0.f, mx = -3.0e38f;
#pragma unroll 8
    for (int s = 0; s < 64; ++s) { const float iv = gp[s * 8], fv = gp[s * 8 + 4]; L += log_sigmoid_(fv); mx = fmaxf(mx, iv - L); }
    const float G = L + mx;
    float m = 0.f; m_c = 0.f; m_n = 0.f;
#pragma unroll
    for (int k = 0; k < 64; ++k) {
        const float Lk = __builtin_bit_cast(float, __builtin_amdgcn_readlane(__builtin_bit_cast(int, L), k)), Gk = __builtin_bit_cast(float, __builtin_amdgcn_readlane(__builtin_bit_cast(int, G), k));
        if (k == c) m_c = m;
        m = fmaxf(Lk + m, Gk);
        if (k == c) m_n = m;
    }
}
DI void ml_conv8(float (&o)[8], const bf16_t* __restrict__ MQK, size_t tok, int t_in_seq, int col, const float* __restrict__ wc, const float* __restrict__ bc, float scale) {
    const float4 b0 = *(const float4*)(bc + col), b1 = *(const float4*)(bc + col + 4);
    o[0] = b0.x; o[1] = b0.y; o[2] = b0.z; o[3] = b0.w; o[4] = b1.x; o[5] = b1.y; o[6] = b1.z; o[7] = b1.w;
#pragma unroll
    for (int j = 0; j < 4; ++j) {
        if (t_in_seq - 3 + j >= 0) {
            float u[8]; unpack8(*(const pg8::u32x4*)(MQK + (tok - 3 + j) * 1024 + col), u);
            const float4 w0 = *(const float4*)(wc + j * 1024 + col), w1 = *(const float4*)(wc + j * 1024 + col + 4);
            o[0] += w0.x * u[0]; o[1] += w0.y * u[1]; o[2] += w0.z * u[2]; o[3] += w0.w * u[3]; o[4] += w1.x * u[4]; o[5] += w1.y * u[5]; o[6] += w1.z * u[6]; o[7] += w1.w * u[7];
        }
    }
#pragma unroll
    for (int i = 0; i < 8; ++i) o[i] = o[i] * sigmoidf_(o[i]) * scale;
}
constexpr float ML_KSCALE = 0.08838834764831845f;
DI void ml_unit_c(int bh, int c, int tx, lds_c* lds, const bf16_t* __restrict__ MQK, const bf16_t* __restrict__ MV, const float* __restrict__ ifp, const float* __restrict__ wc, const float* __restrict__ bc,
                  bf16_t* __restrict__ dC, float* __restrict__ dn, float* __restrict__ wprev, float* __restrict__ mtab) {
    const int b = bh >> 2, h = bh & 3, lane = tx & 63, r32 = lane & 31, hi = lane >> 5, wave = __builtin_amdgcn_readfirstlane(tx >> 6);
    lds_c* KT = lds; lds_c* VTw = lds + 128 * 144;
    __attribute__((address_space(3))) float* wsm = (__attribute__((address_space(3))) float*)(lds + 2 * 128 * 144);
    const size_t tok0 = (size_t)b * SEQ + 64 * c;
    __syncthreads();
    if (wave == 0) {
        float m_c, m_n; ml_mscan(ifp, b, h, c, lane, m_c, m_n);
        const float iv = ifp[(tok0 + lane) * 8 + h], lf = log_sigmoid_(ifp[(tok0 + lane) * 8 + 4 + h]);
        const int l_ = lane_id_opaque();
        const float bc_ = lane_shr_add(lf, l_), Lc = lane_get(bc_, 63);
        wsm[lane] = __expf(Lc - bc_ + iv - m_n);
        if (lane == 0) { wprev[bh * 64 + c] = __expf(Lc + m_c - m_n); mtab[bh * 64 + c] = m_c; }
    }
    __syncthreads();
#pragma unroll 1
    for (int it = tx; it < 1024; it += 512) {
        const int s = it >> 4, d0 = (it & 15) * 8; float kv[8];
        ml_conv8(kv, MQK, tok0 + s, 64 * c + s, 512 + h * 128 + d0, wc, bc, ML_KSCALE);
        float vv[8]; unpack8(*(const pg8::u32x4*)(MV + (tok0 + s) * 512 + h * 128 + d0), vv);
        const float w = wsm[s];
#pragma unroll
        for (int i = 0; i < 8; ++i) {
            *(__attribute__((address_space(3))) bf16_t*)(KT + (d0 + i) * 144 + s * 2) = f2bf(kv[i]);
            *(__attribute__((address_space(3))) bf16_t*)(VTw + (d0 + i) * 144 + s * 2) = f2bf(vv[i] * w);
        }
    }
    __syncthreads();
    if (tx < 128) {
        float a = 0.f;
        for (int s = 0; s < 64; ++s) a += wsm[s] * bf2f(*(const __attribute__((address_space(3))) bf16_t*)(KT + tx * 144 + s * 2));
        dn[((size_t)bh * 64 + c) * 128 + tx] = a;
    }
    {
        const int vb = wave >> 1, kh = wave & 1;
        f32x16 acc0, acc1;
#pragma unroll
        for (int r = 0; r < 16; ++r) { acc0[r] = 0.f; acc1[r] = 0.f; }
#pragma unroll
        for (int ks = 0; ks < 4; ++ks) {
            const bf16x8 a = *(const __attribute__((address_space(3))) bf16x8*)(VTw + (vb * 32 + r32) * 144 + ks * 32 + hi * 16);
            const bf16x8 b0 = *(const __attribute__((address_space(3))) bf16x8*)(KT + (kh * 64 + r32) * 144 + ks * 32 + hi * 16);
            const bf16x8 b1 = *(const __attribute__((address_space(3))) bf16x8*)(KT + (kh * 64 + 32 + r32) * 144 + ks * 32 + hi * 16);
            acc0 = MFMA32(a, b0, acc0); acc1 = MFMA32(a, b1, acc1);
        }
        bf16_t* o = dC + ((size_t)bh * 64 + c) * 16384;
#pragma unroll
        for (int r = 0; r < 16; ++r) { const int v = vb * 32 + crow(r, hi);
            o[v * 128 + kh * 64 + r32] = f2bf(acc0[r]); o[v * 128 + kh * 64 + 32 + r32] = f2bf(acc1[r]); }
    }
}
DI void ml_scan(int gtid, int nthreads, bf16_t* __restrict__ dC, float* __restrict__ dn, const float* __restrict__ wprev) {
    for (int p = gtid; p < 16 * 8192; p += nthreads) {
        const int bh = p >> 13, e2 = p & 8191;
        unsigned* base = (unsigned*)(dC + (size_t)bh * 64 * 16384) + e2;
        float r0 = 0.f, r1 = 0.f;
#pragma unroll 1
        for (int c0 = 0; c0 < 64; c0 += 16) {
            unsigned v[16];
#pragma unroll
            for (int j = 0; j < 16; ++j) v[j] = base[(size_t)(c0 + j) * 8192];
#pragma unroll
            for (int j = 0; j < 16; ++j) {
                const float w = wprev[bh * 64 + c0 + j];
                base[(size_t)(c0 + j) * 8192] = pk2(r0, r1);
                r0 = w * r0 + __uint_as_float(v[j] << 16); r1 = w * r1 + __uint_as_float(v[j] & 0xffff0000u);
            }
        }
    }
    for (int p = gtid; p < 16 * 128; p += nthreads) {
        const int bh = p >> 7, k = p & 127; float r = 0.f;
        for (int c = 0; c < 64; ++c) { float* q = dn + ((size_t)bh * 64 + c) * 128 + k; const float t = *q; *q = r; r = wprev[bh * 64 + c] * r + t; }
    }
}
DI void ml_unit_e(int bh, int c, int tx, lds_c* lds, const bf16_t* __restrict__ MQK, const bf16_t* __restrict__ MV, const bf16_t* __restrict__ MO, const float* __restrict__ ifp,
                  const float* __restrict__ wc, const float* __restrict__ bc, const bf16_t* __restrict__ Sst, const float* __restrict__ nst, const float* __restrict__ mtab, const float* __restrict__ g_hn, bf16_t* __restrict__ Y) {
    const int b = bh >> 2, h = bh & 3, lane = tx & 63, r32 = lane & 31, hi = lane >> 5, wave = __builtin_amdgcn_readfirstlane(tx >> 6);
    lds_c* Qi = lds; lds_c* Ki = lds + 64 * 272; lds_c* VTi = lds + 2 * 64 * 272; lds_c* Si = VTi + 128 * 136;
    __attribute__((address_space(3))) float* fsm = (__attribute__((address_space(3))) float*)(Si + 128 * 272);
    const size_t tok0 = (size_t)b * SEQ + 64 * c;
    const float m_c = mtab[bh * 64 + c];
    __syncthreads();
    if (wave == 0) {
        const float iv = ifp[(tok0 + lane) * 8 + h], lf = log_sigmoid_(ifp[(tok0 + lane) * 8 + 4 + h]);
        const int l_ = lane_id_opaque();
        const float bc_ = lane_shr_add(lf, l_), u = iv - bc_, M = fmaxf(lane_shr_max(u, l_), m_c);
        fsm[lane] = u; fsm[64 + lane] = M; fsm[128 + lane] = __expf(-(bc_ + M));
    }
    if (wave == 1) { fsm[192 + lane] = nst[((size_t)bh * 64 + c) * 128 + lane]; fsm[192 + 64 + lane] = nst[((size_t)bh * 64 + c) * 128 + 64 + lane]; }
#pragma unroll 1
    for (int it = tx; it < 1024; it += 512) {
        const int s = it >> 4, d0 = (it & 15) * 8; float qv[8], kv[8];
        ml_conv8(qv, MQK, tok0 + s, 64 * c + s, h * 128 + d0, wc, bc, 1.f);
        ml_conv8(kv, MQK, tok0 + s, 64 * c + s, 512 + h * 128 + d0, wc, bc, ML_KSCALE);
        *(__attribute__((address_space(3))) pg8::u32x4*)(Qi + s * 272 + d0 * 2) = pack8(qv);
        *(__attribute__((address_space(3))) pg8::u32x4*)(Ki + s * 272 + d0 * 2) = pack8(kv);
        const pg8::u32x4 vw = *(const pg8::u32x4*)(MV + (tok0 + s) * 512 + h * 128 + d0);
        __attribute__((address_space(3))) bf16_t* vt = (__attribute__((address_space(3))) bf16_t*)(VTi + d0 * 136 + s * 2);
        vt[0] = (bf16_t)(vw.x & 0xffffu); vt[68] = (bf16_t)(vw.x >> 16); vt[136] = (bf16_t)(vw.y & 0xffffu); vt[204] = (bf16_t)(vw.y >> 16);
        vt[272] = (bf16_t)(vw.z & 0xffffu); vt[340] = (bf16_t)(vw.z >> 16); vt[408] = (bf16_t)(vw.w & 0xffffu); vt[476] = (bf16_t)(vw.w >> 16);
    }
    {
        const bf16_t* src = Sst + ((size_t)bh * 64 + c) * 16384;
#pragma unroll
        for (int j = 0; j < 4; ++j) { const int ch = tx + 512 * j, v = ch >> 4, k8 = (ch & 15) * 8;
            *(__attribute__((address_space(3))) pg8::u32x4*)(Si + v * 272 + k8 * 2) = *(const pg8::u32x4*)(src + v * 128 + k8); }
    }
    __syncthreads();
    const int tb = wave & 1, vb = wave >> 1, t = tb * 32 + r32;
    bf16x8 qf[8];
#pragma unroll
    for (int ks = 0; ks < 8; ++ks) qf[ks] = *(const __attribute__((address_space(3))) bf16x8*)(Qi + t * 272 + ks * 32 + hi * 16);
    f32x16 a0, a1;
#pragma unroll
    for (int r = 0; r < 16; ++r) { a0[r] = 0.f; a1[r] = 0.f; }
#pragma unroll
    for (int ks = 0; ks < 8; ++ks) {
        const bf16x8 k0 = *(const __attribute__((address_space(3))) bf16x8*)(Ki + r32 * 272 + ks * 32 + hi * 16);
        const bf16x8 k1 = *(const __attribute__((address_space(3))) bf16x8*)(Ki + (32 + r32) * 272 + ks * 32 + hi * 16);
        a0 = MFMA32(k0, qf[ks], a0); a1 = MFMA32(k1, qf[ks], a1);
    }
    const float Mt = fsm[64 + t], dec = __expf(m_c - Mt);
    float rs = 0.f;
#pragma unroll
    for (int r = 0; r < 16; ++r) {
        const int s0 = crow(r, hi), s1 = 32 + s0;
        a0[r] = s0 <= t ? __expf(fsm[s0] - Mt) * a0[r] : 0.f; a1[r] = s1 <= t ? __expf(fsm[s1] - Mt) * a1[r] : 0.f;
        rs += a0[r] + a1[r];
    }
    float nq = 0.f;
#pragma unroll
    for (int ks = 0; ks < 8; ++ks) { float qv[8]; unpack8(__builtin_bit_cast(pg8::u32x4, qf[ks]), qv);
#pragma unroll
        for (int j = 0; j < 8; ++j) nq += qv[j] * fsm[192 + ks * 16 + hi * 8 + j]; }
    float den = rs + dec * nq;
    { auto rr = __builtin_amdgcn_permlane32_swap(__float_as_uint(den), __float_as_uint(den), false, false); den = __uint_as_float(rr[0]) + __uint_as_float(rr[1]); }
    f32x16 n1, n2;
#pragma unroll
    for (int r = 0; r < 16; ++r) { n1[r] = 0.f; n2[r] = 0.f; }
#pragma unroll
    for (int hf = 0; hf < 2; ++hf)
#pragma unroll
        for (int ss = 0; ss < 2; ++ss) {
            unsigned pw[4];
#pragma unroll
            for (int j = 0; j < 4; ++j) pw[j] = hf ? cvtpk(a1[8 * ss + 2 * j], a1[8 * ss + 2 * j + 1]) : cvtpk(a0[8 * ss + 2 * j], a0[8 * ss + 2 * j + 1]);
            const u32x4v pbw = {pw[0], pw[1], pw[2], pw[3]};
            const lds_c* vp = VTi + (vb * 32 + r32) * 136 + hf * 64 + ss * 32 + hi * 8;
            const u32x2v lo = *(const __attribute__((address_space(3))) u32x2v*)vp, hi2 = *(const __attribute__((address_space(3))) u32x2v*)(vp + 16);
            const u32x4v aw = {lo.x, lo.y, hi2.x, hi2.y};
            n1 = MFMA32(__builtin_bit_cast(bf16x8, aw), __builtin_bit_cast(bf16x8, pbw), n1);
        }
#pragma unroll
    for (int ks = 0; ks < 8; ++ks) {
        const bf16x8 sa = *(const __attribute__((address_space(3))) bf16x8*)(Si + (vb * 32 + r32) * 272 + ks * 32 + hi * 16);
        n2 = MFMA32(sa, qf[ks], n2);
    }
    const float inv = 1.f / fmaxf(fabsf(den), fsm[128 + t]);
    const bf16_t* op = MO + (tok0 + t) * 512 + h * 128 + vb * 32;
    float hv[16]; float ssq = 0.f;
#pragma unroll
    for (int i = 0; i < 4; ++i) {
        const u32x2v ow = *(const u32x2v*)(op + 8 * i + 4 * hi);
        const float o4[4] = {__uint_as_float(ow.x << 16), __uint_as_float(ow.x & 0xffff0000u), __uint_as_float(ow.y << 16), __uint_as_float(ow.y & 0xffff0000u)};
#pragma unroll
        for (int j = 0; j < 4; ++j) { const float x = (n1[4 * i + j] + dec * n2[4 * i + j]) * inv * sigmoidf_(o4[j]); hv[4 * i + j] = x; ssq += x * x; }
    }
    { auto rr = __builtin_amdgcn_permlane32_swap(__float_as_uint(ssq), __float_as_uint(ssq), false, false); ssq = __uint_as_float(rr[0]) + __uint_as_float(rr[1]); }
    if (hi == 0) fsm[320 + t * 4 + vb] = ssq;
    __syncthreads();
    const float tot = (fsm[320 + t * 4] + fsm[320 + t * 4 + 1]) + (fsm[320 + t * 4 + 2] + fsm[320 + t * 4 + 3]);
    const float rstd = rsqrtf(tot * (1.f / 128.f) + 1e-6f);
    bf16_t* yp = Y + (tok0 + t) * DM + 512 + h * 128 + vb * 32; const float* gp = g_hn + h * 128 + vb * 32;
#pragma unroll
    for (int i = 0; i < 4; ++i) {
        const float4 gg = *(const float4*)(gp + 8 * i + 4 * hi);
        *(u32x2v*)(yp + 8 * i + 4 * hi) = (u32x2v){cvtpk(hv[4 * i] * rstd * gg.x, hv[4 * i + 1] * rstd * gg.y), cvtpk(hv[4 * i + 2] * rstd * gg.z, hv[4 * i + 3] * rstd * gg.w)};
    }
}

DI void cmp_unit(int kv, int bg, int jt, int tx, lds_c* lds, const bf16_t* __restrict__ KVb, const bf16_t* __restrict__ W1t, const bf16_t* __restrict__ W2t, const float* __restrict__ bias1p,
                 float* __restrict__ outf, bf16_t* __restrict__ kcb, bf16_t* __restrict__ vcT) {
    const int b = bg >> 1, g = bg & 1, lane = tx & 63, r32 = lane & 31, hi = lane >> 5, wave = __builtin_amdgcn_readfirstlane(tx >> 6), j0 = jt * 32;
    lds_c* TI = lds; lds_c* H1 = lds + 16 * 34 * 144;
    const bf16_t* src = KVb + ((size_t)b * SEQ + 16 * j0) * 512 + (kv ? 128 : 0) + g * 64;
    __syncthreads();
    for (int ch = tx; ch < 528 * 8; ch += 512) {
        const int t = ch >> 3, c8 = ch & 7;
        *(__attribute__((address_space(3))) pg8::u32x4*)(TI + ((t & 15) * 34 + (t >> 4)) * 144 + c8 * 16) = *(const pg8::u32x4*)(src + (size_t)t * 512 + c8 * 8);
    }
    __syncthreads();
    f32x16 acc;
#pragma unroll
    for (int r = 0; r < 16; ++r) acc[r] = 0.f;
    const bf16_t* wrow = W1t + (size_t)(wave * 32 + r32) * 2048 + hi * 8;
#pragma unroll 4
    for (int i = 0; i < 32; ++i) {
        const lds_c* arow = TI + ((i & 15) * 34 + r32 + (i >> 4)) * 144 + hi * 16;
#pragma unroll
        for (int dk = 0; dk < 4; ++dk) {
            const bf16x8 a = *(const __attribute__((address_space(3))) bf16x8*)(arow + dk * 32);
            const bf16x8 bfr = *(const bf16x8*)(wrow + i * 64 + dk * 16);
            acc = MFMA32(a, bfr, acc);
        }
    }
    {
        const int n = wave * 32 + r32; float bias = 0.f;
#pragma unroll
        for (int k = 0; k < 16; ++k) bias += bias1p[k * 512 + kv * 256 + n];
#pragma unroll
        for (int r = 0; r < 16; ++r) *(__attribute__((address_space(3))) bf16_t*)(H1 + crow(r, hi) * 528 + n * 2) = f2bf(gelu_tanh(acc[r] + bias));
    }
    __syncthreads();
    if (wave < 2) {
        f32x16 o;
#pragma unroll
        for (int r = 0; r < 16; ++r) o[r] = 0.f;
        const bf16_t* w2row = W2t + (size_t)(wave * 32 + r32) * 256 + hi * 8;
#pragma unroll
        for (int ks = 0; ks < 16; ++ks) {
            const bf16x8 a = *(const __attribute__((address_space(3))) bf16x8*)(H1 + r32 * 528 + ks * 32 + hi * 16);
            const bf16x8 bfr = *(const bf16x8*)(w2row + ks * 16);
            o = MFMA32(a, bfr, o);
        }
        const int d = wave * 32 + r32;
#pragma unroll
        for (int r = 0; r < 16; ++r) {
            const int j = j0 + crow(r, hi); const float v = j < 255 ? o[r] : 0.f;
            outf[((size_t)bg * 256 + j) * 64 + d] = v;
            if (kv == 0) kcb[((size_t)bg * 256 + j) * 64 + d] = f2bf(v);
            else vcT[((size_t)bg * 4 + (j >> 6)) * 4096 + d * 64 + (j & 63)] = f2bf(v);
        }
    }
}

#define XB_TMO      128
#define XB_XCNT(j)  (256  + 64 * (j))
#define XB_XSUB(j)  (1280 + 64 * (j))
#define XB_XGEN(j)  (2304 + 64 * (j))
#define XB_TOP      3328
#define XB_TOPGEN   3392
#define XCD_BAR_WORDS 3456
#define XB_SPIN_CAP (1u << 23)

__device__ __forceinline__ unsigned xb_ld(unsigned* p)              { return __hip_atomic_load(p, __ATOMIC_RELAXED, __HIP_MEMORY_SCOPE_AGENT); }
__device__ __forceinline__ unsigned xb_add(unsigned* p, unsigned v) { return __hip_atomic_fetch_add(p, v, __ATOMIC_RELAXED, __HIP_MEMORY_SCOPE_AGENT); }
__device__ __forceinline__ unsigned xb_xcc_id() { return (unsigned)__builtin_amdgcn_s_getreg((3 << 11) | 20) & 0xFu; }
#define XB_SPIN(cond, bar) do { unsigned _sp = 0; while (cond) { __builtin_amdgcn_s_sleep(1); \
    if ((++_sp & 255u) == 0u) { if (xb_ld(&(bar)[XB_TMO])) break; if (_sp > XB_SPIN_CAP) { atomicAdd(&(bar)[XB_TMO], 1u); break; } } } } while (0)

struct XcdBarrier {
    unsigned* bar; unsigned x;
    volatile __attribute__((address_space(3))) unsigned* st;
};

__device__ __forceinline__ XcdBarrier xcd_barrier_post(unsigned* bar, volatile __attribute__((address_space(3))) unsigned* st) {
    XcdBarrier b; b.bar = bar; b.x = xb_xcc_id(); b.st = st;
    if (threadIdx.x == 0) (void)xb_add(&bar[XB_XCNT(b.x)], 1u);
    return b;
}
__device__ __forceinline__ void xcd_barrier_complete(unsigned* bar, unsigned x, unsigned& nloc, unsigned& nx) {
    const unsigned G = gridDim.x * gridDim.y * gridDim.z;
    unsigned sum, cnt, mine, sp = 0u;
    for (;;) {
        sum = 0u; cnt = 0u; mine = 0u;
#pragma unroll
        for (unsigned j = 0; j < 16; ++j) { const unsigned c = xb_ld(&bar[XB_XCNT(j)]); sum += c; cnt += (c > 0u) ? 1u : 0u; mine = (j == x) ? c : mine; }
        if (sum == G) break;
        __builtin_amdgcn_s_sleep(1);
        if ((++sp & 255u) == 0u) { if (xb_ld(&bar[XB_TMO])) break; if (sp > XB_SPIN_CAP) { atomicAdd(&bar[XB_TMO], 1u); break; } }
    }
    nloc = mine > 0u ? mine : 1u; nx = cnt > 0u ? cnt : 1u;
}

__device__ __forceinline__ void xcd_barrier(const XcdBarrier& b) {
    asm volatile("s_waitcnt vmcnt(0)" ::: "memory");
    __syncthreads();
    if (threadIdx.x == 0) {
        unsigned* bar = b.bar;
        __builtin_amdgcn_s_waitcnt(0);
        unsigned nloc = b.st[0], nx = b.st[1];
        if (nloc == 0u) { xcd_barrier_complete(bar, b.x, nloc, nx); b.st[0] = nloc; b.st[1] = nx; }
        const unsigned old = xb_add(&bar[XB_XSUB(b.x)], 1u);
        const unsigned gen = old / nloc;
        if (old + 1u == (gen + 1u) * nloc) {
            __builtin_amdgcn_fence(__ATOMIC_RELEASE, "agent");
            asm volatile("s_waitcnt vmcnt(0)" ::: "memory");
            const unsigned og = xb_add(&bar[XB_TOP], 1u);
            const unsigned tg = og / nx;
            if (og + 1u == (tg + 1u) * nx) xb_add(&bar[XB_TOPGEN], 1u);
            else XB_SPIN(xb_ld(&bar[XB_TOPGEN]) == tg, bar);
            __builtin_amdgcn_fence(__ATOMIC_ACQUIRE, "agent");
            xb_add(&bar[XB_XGEN(b.x)], 1u);
            asm volatile("s_waitcnt vmcnt(0)" ::: "memory");
        } else {
            XB_SPIN(xb_ld(&bar[XB_XGEN(b.x)]) == gen, bar);
            __builtin_amdgcn_fence(__ATOMIC_ACQUIRE, "agent");
            asm volatile("s_waitcnt vmcnt(0)" ::: "memory");
        }
    }
    __syncthreads();
}

#ifndef NSA_CHECK
#define NSA_CHECK 0
#endif
#ifndef REP_MASK
#define REP_MASK 0u
#endif
struct Args { const float* in[29]; float* out; char* ws; unsigned rep_mask; unsigned pad; };
constexpr int LDS_BYTES = 147456;

__global__ __launch_bounds__(512, 2) void mk_fwd(Args a) {
    extern __shared__ __attribute__((aligned(16))) char lds_raw[];
    cg::grid_group grid = cg::this_grid();
    const int NB = gridDim.x * 2, NGW = gridDim.x * 8;
    const unsigned repm = a.rep_mask;
    volatile __attribute__((address_space(3))) unsigned* bar_st = (volatile __attribute__((address_space(3))) unsigned*)((lds_c*)lds_raw + (LDS_BYTES - 64));
    if (threadIdx.x < 2) bar_st[threadIdx.x] = 0u;
    __syncthreads();
    const XcdBarrier xbar = xcd_barrier_post((unsigned*)(a.ws + ((size_t)42 << 20) + 65536), bar_st);
#define GRID_BAR() xcd_barrier(xbar)
    const int wave_s_ = __builtin_amdgcn_readfirstlane(threadIdx.x >> 6);
#define KARG(T, off) (*(T const __attribute__((address_space(4)))*)(kargs_ + (off)))
#define PTRS const float* x = KARG(const float*, 8 * 0); const float* p = KARG(const float*, 8 * 1); const int* pos = KARG(const int*, 16); \
    const float* g_mix = KARG(const float*, 8 * 3); const float* w_in = KARG(const float*, 8 * 4); const float* b_if = KARG(const float*, 8 * 5); \
    const float* w_ck1 = KARG(const float*, 8 * 6); const float* w_ck2 = KARG(const float*, 8 * 7); const float* pe_ck = KARG(const float*, 8 * 8); \
    const float* w_cv1 = KARG(const float*, 8 * 9); const float* w_cv2 = KARG(const float*, 8 * 10); const float* pe_cv = KARG(const float*, 8 * 11); \
    const float* w_conv = KARG(const float*, 8 * 12); const float* b_conv = KARG(const float*, 8 * 13); const float* g_hn = KARG(const float*, 8 * 14); \
    const float* w_pa = KARG(const float*, 8 * 15); const float* w_pb = KARG(const float*, 8 * 16); const float* w_out = KARG(const float*, 8 * 17); \
    const float* g_ffn = KARG(const float*, 8 * 18); const float* w_rg = KARG(const float*, 8 * 19); const float* b_rg = KARG(const float*, 8 * 20); \
    const float* w_re = KARG(const float*, 8 * 21); const float* b_re = KARG(const float*, 8 * 22); const float* w_e13 = KARG(const float*, 8 * 23); \
    const float* w_e2 = KARG(const float*, 8 * 24); const float* g_ple = KARG(const float*, 8 * 25); const float* w_pg = KARG(const float*, 8 * 26); \
    const float* w_pp = KARG(const float*, 8 * 27); const float* g_final = KARG(const float*, 8 * 28); \
    float* out = KARG(float*, 232); char* ws = KARG(char*, 240); \
    const size_t MiB = 1u << 20; \
    bf16_t* Wt_in = (bf16_t*)(ws); \
    bf16_t* xb = (bf16_t*)(ws + 48 * MiB); \
    bf16_t* Qb = (bf16_t*)(ws + 80 * MiB); \
    bf16_t* KVb = (bf16_t*)(ws + 96 * MiB); bf16_t* VT = (bf16_t*)(ws + 112 * MiB); bf16_t* kcb = (bf16_t*)(ws + 249 * MiB + 512 * 1024); bf16_t* vcT = (bf16_t*)(ws + 249 * MiB + 768 * 1024); \
    bf16_t* MQK = (bf16_t*)(ws + 120 * MiB); \
    bf16_t* MV = (bf16_t*)(ws + 152 * MiB); \
    bf16_t* MO = (bf16_t*)(ws + 168 * MiB); \
    bf16_t* MG = (bf16_t*)(ws + 184 * MiB); \
    float* gates = (float*)(ws + 248 * MiB); \
    float* ifp = (float*)(ws + 250 * MiB); \
    float* kcc = (float*)(ws + 251 * MiB); \
    float* vcc = (float*)(ws + 252 * MiB); \
    float* gate16 = (float*)(ws + 253 * MiB); \
    float* rstd0 = (float*)(ws + 254 * MiB); \
    float* cosT = (float*)(ws + 254 * MiB + 512 * 1024); \
    float* sinT = (float*)(ws + 255 * MiB); \
    bf16_t* Y = (bf16_t*)(out + (size_t)8 * 1024 * 1024); \
    bf16_t* dC = xb; float* dn = (float*)(ws + 250 * MiB + 512 * 1024); float* wprev = (float*)(ws + 42 * MiB + 4096); float* mtab = (float*)(ws + 42 * MiB + 8192); \
    float* tmp = (float*)(ws + 120 * MiB); bf16_t* mixed = xb; \
    bf16_t* Wpa_t = (bf16_t*)(ws + 11 * MiB); bf16_t* Wpb_t = (bf16_t*)(ws + 12 * MiB); bf16_t* Wout_t = (bf16_t*)(ws + 13 * MiB); \
    bf16_t* We13_t = (bf16_t*)(ws + 15 * MiB); bf16_t* We2_t = (bf16_t*)(ws + 31 * MiB); bf16_t* Wpg_t = (bf16_t*)(ws + 39 * MiB); bf16_t* Wpp_t = (bf16_t*)(ws + 41 * MiB); \
    int* cnt = (int*)(ws + 42 * MiB); bf16_t* W1t_k = (bf16_t*)(ws + 43 * MiB); bf16_t* W1t_v = (bf16_t*)(ws + 44 * MiB); bf16_t* W2t_k = (bf16_t*)(ws + 45 * MiB); bf16_t* W2t_v = (bf16_t*)(ws + 45 * MiB + 65536); float* bias1p = (float*)(ws + 45 * MiB + 524288); \
    bf16_t* xg = (bf16_t*)(ws + 48 * MiB); bf16_t* act = (bf16_t*)(ws + 120 * MiB); bf16_t* y2 = (bf16_t*)(ws + 138 * MiB); bf16_t* x2b = (bf16_t*)(ws + 210 * MiB); \
    bf16_t* pb = (bf16_t*)(ws + 48 * MiB); bf16_t* PP = (bf16_t*)(ws + 56 * MiB); \
    int* rinfo = (int*)(ws + 253 * MiB); float* rstd1 = (float*)(ws + 253 * MiB + 512 * 1024); float* rstd2 = (float*)(ws + 253 * MiB + 768 * 1024); \
    (void)x; (void)p; (void)pos; (void)g_mix; (void)w_in; (void)b_if; (void)w_ck1; (void)w_ck2; (void)pe_ck; (void)w_cv1; (void)w_cv2; (void)pe_cv; (void)w_conv; (void)b_conv; (void)g_hn; (void)w_pa; (void)w_pb; (void)w_out; (void)g_ffn; (void)w_rg; (void)b_rg; (void)w_re; (void)b_re; (void)w_e13; (void)w_e2; (void)g_ple; (void)w_pg; (void)w_pp; (void)g_final;
#define PHASE(k) for (int rep_ = 0; rep_ < 1 + (int)((repm >> (k)) & 1u); ++rep_)
#define PHASE_IDS unsigned tx_ = (unsigned)(wave_s_ * 64); asm volatile("" : "+v"(tx_)); tx_ = (unsigned)__builtin_amdgcn_mbcnt_hi(-1, __builtin_amdgcn_mbcnt_lo(-1, (int)tx_)); const int half = tx_ >> 8, tid = tx_ & 255, lane64 = tx_ & 63, tid512 = (int)tx_; \
    const int wave = __builtin_amdgcn_readfirstlane(tx_ >> 6); char* sm = lds_raw + half * 65536; const int gw = blockIdx.x * 8 + wave; (void)tid; (void)lane64; (void)sm; (void)gw; (void)tid512; \
    const __attribute__((address_space(4))) char* kargs_ = (const __attribute__((address_space(4))) char*)__builtin_amdgcn_kernarg_segment_ptr(); asm volatile("" : "+s"(kargs_)); PTRS
#define VB_LOOP(nvb) for (int vb = blockIdx.x * 2 + half; vb < (nvb); vb += NB)
#define GEMM_PHASE(NT, MT, ...) do { VB_LOOP((NT) * (MT)) { const int bx_ = vb % (NT), by_ = vb / (NT); __syncthreads(); gemm_v1(bx_, by_, tid, sm, __VA_ARGS__); } } while (0)
    PHASE(0) { PHASE_IDS
        float* scr = (float*)(lds_raw + wave * 8448);
        for (int it = gw; it < (DM / 64) * (NIN / 32); it += NGW) prep_wt_item(w_in, DIN, DM, Wt_in, g_mix, MapIn{}, scr, it, NIN / 32, lane64);
        for (int it = gw; it < 8 * 32; it += NGW) prep_wt_item(w_pa, DM, 512, Wpa_t, (const float*)nullptr, MapId{}, scr, it, 32, lane64);
        for (int it = gw; it < 8 * 32; it += NGW) prep_wt_item(w_pb, DM, 512, Wpb_t, (const float*)nullptr, MapId{}, scr, it, 32, lane64);
        for (int it = gw; it < 16 * 32; it += NGW) prep_wt_item(w_out, DM, DM, Wout_t, (const float*)nullptr, MapId{}, scr, it, 32, lane64);
        for (int it = gw; it < 16 * 32; it += NGW) prep_wt_item(w_pg, DM, DM, Wpg_t, g_ple, MapId{}, scr, it, 32, lane64);
        for (int it = gw; it < 4 * 32; it += NGW) prep_wt_item(w_pp, DM, 256, Wpp_t, (const float*)nullptr, MapId{}, scr, it, 32, lane64);
        for (int it = gw; it < 16 * 256; it += NGW) { const int e = it >> 8; prep_wt_item(w_e13 + (size_t)e * 1024 * 512, 512, DM, We13_t + (size_t)e * 512 * 1024, g_ffn, MapE13{}, scr, it & 255, 16, lane64); }
        for (int it = gw; it < 16 * 128; it += NGW) { const int e = it >> 7; prep_wt_item(w_e2 + (size_t)e * 256 * 1024, DM, 256, We2_t + (size_t)e * 1024 * 256, (const float*)nullptr, MapId{}, scr, it & 127, 32, lane64); }
        for (int it = gw; it < 2 * 256; it += NGW) { const int kv = it >> 8; prep_wt_item(kv ? w_cv1 : w_ck1, 256, 2048, kv ? W1t_v : W1t_k, (const float*)nullptr, MapId{}, scr, it & 255, 8, lane64); }
        for (int it = gw; it < 2 * 8; it += NGW) { const int kv = it >> 3; prep_wt_item(kv ? w_cv2 : w_ck2, 64, 256, kv ? W2t_v : W2t_k, (const float*)nullptr, MapId{}, scr, it & 7, 2, lane64); }
        if (blockIdx.x < 16) {
            const int kv = tid512 >> 8, n = tid512 & 255; const float* w1 = kv ? w_cv1 : w_ck1; const float* pe = kv ? pe_cv : pe_ck; float a = 0.f;
            for (int k = blockIdx.x * 128; k < blockIdx.x * 128 + 128; ++k) a += pe[k] * w1[(size_t)k * 256 + n];
            bias1p[blockIdx.x * 512 + tid512] = a;
        }
        if (blockIdx.x == 0 && tid512 < 16) cnt[tid512] = 0;
        for (int r = gw; r < T_TOK; r += NGW) prep_x_row(x, xb, rstd0, r, lane64);
        for (int i = blockIdx.x * 512 + tid512; i < T_TOK * 8; i += gridDim.x * 512) {
            const float inv = powf(500000.0f, -(float)(2 * (i & 7)) / 16.0f); float sn, cs; sincosf((float)pos[i >> 3] * inv, &sn, &cs); cosT[i] = cs; sinT[i] = sn; }
    }
    grid.sync();
    PHASE(1) { PHASE_IDS
        pg8::Gemm g{xb, Wt_in, T_TOK, NIN, DM, DM, DM}; pg8::StaticOrder S; S.init(T_TOK, NIN, (int)gridDim.x, (int)blockIdx.x);
        EpiInProj E{rstd0, cosT, sinT, b_if, Qb, KVb, gates, ifp, MQK, MV, MO, MG, VT};
        pg8::gemm_phase<EpiInProj, pg8::StaticOrder, true, true>((PG8_LAS unsigned char*)lds_raw, g, S, E, tid512);
    }
    GRID_BAR();
    PHASE(2) { PHASE_IDS
        for (int u = blockIdx.x; u < 128; u += gridDim.x) { const int kv = u >> 6, bg = (u >> 3) & 7, jt = u & 7;
            cmp_unit(kv, bg, jt, tid512, (lds_c*)lds_raw, KVb, kv ? W1t_v : W1t_k, kv ? W2t_v : W2t_k, bias1p, kv ? vcc : kcc, kcb, vcT); }
    }
    PHASE(3) { PHASE_IDS
        for (int u = blockIdx.x; u < 1024; u += gridDim.x) ml_unit_c(u >> 6, u & 63, tid512, (lds_c*)lds_raw, MQK, MV, ifp, w_conv, b_conv, dC, dn, wprev, mtab);
    }
    GRID_BAR();
    {   PHASE_IDS
        ml_scan(blockIdx.x * 512 + tid512, gridDim.x * 512, dC, dn, wprev);
    }
    GRID_BAR();
    PHASE(4) { PHASE_IDS
        for (int u = blockIdx.x; u < 1024; u += gridDim.x) ml_unit_e(u >> 6, u & 63, tid512, (lds_c*)lds_raw, MQK, MV, MO, ifp, w_conv, b_conv, dC, dn, mtab, g_hn, Y);
    }
    PHASE(5) { PHASE_IDS
        for (int pr = blockIdx.x; pr < 256; pr += gridDim.x) {
            nsa_unit(pr & 7, 63 - (pr >> 3), tid512, (lds_c*)lds_raw, Qb, KVb, VT, kcb, vcT, gates, Y);
            nsa_unit(pr & 7, pr >> 3, tid512, (lds_c*)lds_raw, Qb, KVb, VT, kcb, vcT, gates, Y);
        }
    }
#if NSA_CHECK
    {   PHASE_IDS
        bf16_t* Y2 = (bf16_t*)(ws + 120 * MiB); unsigned* stats = (unsigned*)(ws + 42 * MiB) + 64;
        if (blockIdx.x == 0 && tid512 == 0) { stats[0] = 0u; stats[1] = 0u; }
        grid.sync();
        float* kcc2 = (float*)(ws + 251 * MiB + 512 * 1024); float* vcc2 = (float*)(ws + 252 * MiB + 512 * 1024); bf16_t* dummy = (bf16_t*)(ws + 160 * MiB);
        VB_LOOP(4080) { const int j = vb % 255, r = vb / 255; compress_naive(j, r & 7, r >> 3, tid, sm, KVb, w_ck1, w_ck2, pe_ck, w_cv1, w_cv2, pe_cv, kcc2, vcc2, dummy, dummy + 1048576); }
        grid.sync();
        VB_LOOP(T_TOK * 2) nsa_naive(vb >> 1, vb & 1, tid, sm, Qb, KVb, VT, kcc2, vcc2, gates, Y2);
        grid.sync();
        unsigned c1 = 0, c2 = 0;
        for (size_t i = (size_t)blockIdx.x * 512 + tid512; i < (size_t)T_TOK * 512; i += (size_t)gridDim.x * 512) {
            const size_t o = (i >> 9) * DM + (i & 511); const float d = fabsf(bf2f(Y[o]) - bf2f(Y2[o])); c1 += d > 0.02f ? 1u : 0u; c2 += (d > 0.1f || !(d == d)) ? 1u : 0u; }
        if (c1) atomicAdd(stats, c1); if (c2) atomicAdd(stats + 1, c2);
    }
#endif
    GRID_BAR();
    PHASE(7) { PHASE_IDS
        pg8::StaticOrder S; S.init(T_TOK, DM, (int)gridDim.x, (int)blockIdx.x);
        pg8::Gemm g{Y, Wpa_t, T_TOK, DM, 512, DM, 512}; EpiMerge<0> E{MG, tmp, mixed}; pg8::gemm_phase<EpiMerge<0>, pg8::StaticOrder, true, true>((PG8_LAS unsigned char*)lds_raw, g, S, E, tid512);
    }
    PHASE(8) { PHASE_IDS
        __syncthreads();
        pg8::StaticOrder S; S.init(T_TOK, DM, (int)gridDim.x, (int)blockIdx.x);
        pg8::Gemm g{Y + 512, Wpb_t, T_TOK, DM, 512, DM, 512}; EpiMerge<1> E{MG, tmp, mixed}; pg8::gemm_phase<EpiMerge<1>, pg8::StaticOrder, true, true>((PG8_LAS unsigned char*)lds_raw, g, S, E, tid512);
    }
    GRID_BAR();
    PHASE(9) { PHASE_IDS
        pg8::Gemm g{mixed, Wout_t, T_TOK, DM, DM, DM, DM}; pg8::StaticOrder S; S.init(T_TOK, DM, (int)gridDim.x, (int)blockIdx.x);
        EpiX1 E{x, out};
        pg8::gemm_phase<EpiX1, pg8::StaticOrder, true, true>((PG8_LAS unsigned char*)lds_raw, g, S, E, tid512);
    }
    GRID_BAR();
    {   PHASE_IDS
        for (int t = gw; t < T_TOK; t += NGW) router2(t, lane64, out, g_ffn, w_rg, b_rg, w_re, b_re, rstd1, rinfo, cnt);
    }
    GRID_BAR();
    PHASE(11) { PHASE_IDS
        for (int t = gw; t < T_TOK; t += NGW) {
            int4 ri = *(const int4*)(rinfo + (size_t)t * 4); ri.x = __builtin_amdgcn_readfirstlane(ri.x); ri.y = __builtin_amdgcn_readfirstlane(ri.y); ri.z = __builtin_amdgcn_readfirstlane(ri.z); ri.w = __builtin_amdgcn_readfirstlane(ri.w);
            const int r0 = moe_base_row(cnt, ri.x & 255) + (ri.y & 0xffff), r1 = moe_base_row(cnt, (ri.x >> 8) & 255) + ((ri.y >> 16) & 0xffff);
            const float rs = rstd1[t];
#pragma unroll
            for (int j = 0; j < 4; ++j) { const float4 v = ((const float4*)(out + (size_t)t * DM))[lane64 + 64 * j]; uint2 o; o.x = pk2(v.x * rs, v.y * rs); o.y = pk2(v.z * rs, v.w * rs);
                ((uint2*)(xg + (size_t)r0 * DM))[lane64 + 64 * j] = o; ((uint2*)(xg + (size_t)r1 * DM))[lane64 + 64 * j] = o; }
        }
    }
    GRID_BAR();
    PHASE(12) { PHASE_IDS
        pg8::Gemm g{xg, We13_t, 0, 0, DM, DM, DM}; MoeOrder S{cnt, 2, (int)gridDim.x, (int)blockIdx.x};
        EpiSwiglu E{act};
        pg8::gemm_phase<EpiSwiglu, MoeOrder, true, true>((PG8_LAS unsigned char*)lds_raw, g, S, E, tid512);
    }
    GRID_BAR();
    PHASE(13) { PHASE_IDS
        pg8::Gemm g{act, We2_t, 0, 0, 256, 256, 256}; MoeOrder S{cnt, 4, (int)gridDim.x, (int)blockIdx.x};
        EpiStoreBf E{y2, DM, 3};
        pg8::gemm_phase<EpiStoreBf, MoeOrder, true, true>((PG8_LAS unsigned char*)lds_raw, g, S, E, tid512);
    }
    GRID_BAR();
    {   PHASE_IDS
        for (int t = gw; t < T_TOK; t += NGW) {
            int4 ri = *(const int4*)(rinfo + (size_t)t * 4); ri.x = __builtin_amdgcn_readfirstlane(ri.x); ri.y = __builtin_amdgcn_readfirstlane(ri.y); ri.z = __builtin_amdgcn_readfirstlane(ri.z); ri.w = __builtin_amdgcn_readfirstlane(ri.w);
            const int r0 = moe_base_row(cnt, ri.x & 255) + (ri.y & 0xffff), r1 = moe_base_row(cnt, (ri.x >> 8) & 255) + ((ri.y >> 16) & 0xffff);
            const float w0 = __int_as_float(ri.z), w1 = __int_as_float(ri.w);
            float4 v[4]; float s2 = 0.f;
#pragma unroll
            for (int j = 0; j < 4; ++j) { v[j] = ((const float4*)(out + (size_t)t * DM))[lane64 + 64 * j];
                const uint2 a0 = ((const uint2*)(y2 + (size_t)r0 * DM))[lane64 + 64 * j], a1 = ((const uint2*)(y2 + (size_t)r1 * DM))[lane64 + 64 * j];
                v[j].x += w0 * __uint_as_float(a0.x << 16) + w1 * __uint_as_float(a1.x << 16); v[j].y += w0 * __uint_as_float(a0.x & 0xffff0000u) + w1 * __uint_as_float(a1.x & 0xffff0000u);
                v[j].z += w0 * __uint_as_float(a0.y << 16) + w1 * __uint_as_float(a1.y << 16); v[j].w += w0 * __uint_as_float(a0.y & 0xffff0000u) + w1 * __uint_as_float(a1.y & 0xffff0000u);
                s2 += v[j].x * v[j].x + v[j].y * v[j].y + v[j].z * v[j].z + v[j].w * v[j].w; }
            s2 = wave_sum(s2);
            if (lane64 == 0) rstd2[t] = rsqrtf(s2 * (1.f / DM) + 1e-6f);
#pragma unroll
            for (int j = 0; j < 4; ++j) { ((float4*)(out + (size_t)t * DM))[lane64 + 64 * j] = v[j]; uint2 o; o.x = pk2(v[j].x, v[j].y); o.y = pk2(v[j].z, v[j].w); ((uint2*)(x2b + (size_t)t * DM))[lane64 + 64 * j] = o; }
            { const float4 pv = ((const float4*)(p + (size_t)t * 256))[lane64]; uint2 o; o.x = pk2(pv.x, pv.y); o.y = pk2(pv.z, pv.w); ((uint2*)(pb + (size_t)t * 256))[lane64] = o; }
        }
    }
    GRID_BAR();
    {   PHASE_IDS
        pg8::StaticOrder S; S.init(T_TOK, DM, (int)gridDim.x, (int)blockIdx.x);
        pg8::Gemm g{pb, Wpp_t, T_TOK, DM, 256, 256, 256}; EpiStoreBf E{PP, DM, 3};
        pg8::gemm_phase<EpiStoreBf, pg8::StaticOrder, true, true>((PG8_LAS unsigned char*)lds_raw, g, S, E, tid512);
    }
    {   PHASE_IDS
        __syncthreads();
        pg8::StaticOrder S; S.init(T_TOK, DM, (int)gridDim.x, (int)blockIdx.x);
        pg8::Gemm g{x2b, Wpg_t, T_TOK, DM, DM, DM, DM}; EpiPle2 E{out, PP, rstd2};
        pg8::gemm_phase<EpiPle2, pg8::StaticOrder, true, true>((PG8_LAS unsigned char*)lds_raw, g, S, E, tid512);
    }
    GRID_BAR();
    {   PHASE_IDS
        VB_LOOP(T_TOK / 4) rmsnorm_rows(vb, tid, out, g_final, (bf16_t*)nullptr, out, T_TOK);
#if NSA_CHECK
        grid.sync();
        if (blockIdx.x == 0 && tid512 == 0) { const unsigned* stats = (const unsigned*)(ws + 42 * MiB) + 64; out[0] += sqrtf((float)stats[0]); out[1] += sqrtf((float)stats[1]) * 30.f; }
#endif
    }
}

extern "C" void kernel_launch(void* const* d_in, const int* in_sizes, int n_in, void* d_out, int out_size, void* d_ws, size_t ws_size, hipStream_t stream) {
    static int grid_blocks = 0;
    if (grid_blocks == 0) {
        int dev = 0, cus = 0, per_cu = 0;
        (void)hipGetDevice(&dev);
        (void)hipDeviceGetAttribute(&cus, hipDeviceAttributeMultiprocessorCount, dev);
        (void)hipFuncSetAttribute((const void*)mk_fwd, hipFuncAttributeMaxDynamicSharedMemorySize, LDS_BYTES);
        (void)hipOccupancyMaxActiveBlocksPerMultiprocessor(&per_cu, (const void*)mk_fwd, 512, LDS_BYTES);
        if (per_cu < 1) { fprintf(stderr, "kernel_launch: occupancy query returned %d\n", per_cu); per_cu = 1; }
        grid_blocks = cus * 1;
        fprintf(stderr, "kernel_launch: cus=%d per_cu=%d grid=%d ws=%zu\n", cus, per_cu, grid_blocks, ws_size);
    }
    (void)hipMemsetAsync((char*)d_ws + ((size_t)42 << 20), 0, 131072, stream);
    Args a{};
    for (int i = 0; i < 29; ++i) a.in[i] = (const float*)d_in[i];
    a.out = (float*)d_out; a.ws = (char*)d_ws; a.rep_mask = REP_MASK; a.pad = 0;
    void* args[] = {&a};
    hipError_t e = hipLaunchCooperativeKernel((const void*)mk_fwd, dim3(grid_blocks), dim3(512), args, LDS_BYTES, stream);
    if (e != hipSuccess) fprintf(stderr, "cooperative launch failed: %s (grid %d)\n", hipGetErrorString(e), grid_blocks);
    (void)in_sizes; (void)n_in; (void)out_size; (void)ws_size;
}
```

```cpp
#include <hip/hip_runtime.h>
#include <cstdint>
#include <cstdio>
#include <hip/hip_cooperative_groups.h>
namespace cg = cooperative_groups;

typedef unsigned short bf16_t;
typedef short bf16x8 __attribute__((ext_vector_type(8)));
typedef float f32x16 __attribute__((ext_vector_type(16)));

#define DI __device__ __forceinline__

constexpr int T_TOK = 16384, SEQ = 4096, DM = 1024, DIN = 5408, NIN = 5632;
constexpr int CNT_STRIDE = 64;
constexpr float QSCALE = 0.125f * 1.4426950408889634f;
constexpr int ZC_Q = 0, ZC_KC = 512, ZC_VC = 640, ZC_KS = 768, ZC_VS = 896, ZC_KW = 1024, ZC_VW = 1152, ZC_GATE = 1280,
              ZC_MQK = 1304, ZC_MV = 2328, ZC_MO = 2840, ZC_IF = 3352, ZC_GA = 3360, ZC_GB = 4384;

DI bf16_t f2bf(float f) { unsigned u = __float_as_uint(f); return (bf16_t)((u + 0x7fffu + ((u >> 16) & 1u)) >> 16); }
DI float bf2f(bf16_t h) { return __uint_as_float(((unsigned)h) << 16); }
DI float sigmoidf_(float x) { return 1.f / (1.f + __expf(-x)); }
DI int lane_id_opaque() { int z = 0; asm volatile("" : "+v"(z)); return __builtin_amdgcn_mbcnt_hi(-1, __builtin_amdgcn_mbcnt_lo(-1, z)); }
DI float lane_xor(float v, int o, int lane) { return __int_as_float(__builtin_amdgcn_ds_bpermute((lane ^ o) << 2, __float_as_int(v))); }
DI float lane_get(float v, int src) { return __int_as_float(__builtin_amdgcn_ds_bpermute(src << 2, __float_as_int(v))); }
DI float wave_sum(float v) {
    const int l = lane_id_opaque();
#pragma unroll
    for (int o = 1; o < 64; o <<= 1) v += lane_xor(v, o, l);
    return v;
}
DI float wave_max(float v) {
    const int l = lane_id_opaque();
#pragma unroll
    for (int o = 1; o < 64; o <<= 1) v = fmaxf(v, lane_xor(v, o, l));
    return v;
}

namespace pg8 {
#define PG8_LAS __attribute__((address_space(3)))
typedef unsigned short bf16_t;
typedef short bf16x8 __attribute__((ext_vector_type(8)));
typedef float f32x4 __attribute__((ext_vector_type(4)));
typedef unsigned u32x4 __attribute__((ext_vector_type(4)));
constexpr int BM = 256, BK = 64, HALF = 128, HTB = HALF * BK * 2  , STAGE_BYTES = 8 * HTB, NXCD = 8, WGM = 8;

__host__ __device__ __forceinline__ int lds_byte(int r, int c) { const int st = (r >> 4) * 2 + (c >> 5), rr = r & 15, cc = c & 31, ob = rr * 64 + cc * 2; return st * 1024 + (ob ^ (((ob >> 9) & 1) << 5)); }
__host__ __device__ __forceinline__ void stage_rc(int b, int& R, int& C) { const int st = b / 1024, sb = b % 1024, swz = sb ^ (((sb >> 9) & 1) << 5); R = (st >> 1) * 16 + swz / 64; C = (st & 1) * 32 + (swz % 64) / 2; }
__host__ __device__ __forceinline__ int perm32(int rho) { const int n = rho >> 4, i = rho & 15; return 8 * (i >> 2) + 4 * n + (i & 3); }

struct Unit { int pm, pn; };
struct Gemm { const bf16_t* A; const bf16_t* Bt; int M, N, K, lda, ldb; };

struct StaticOrder {
    int nM, nN, nwg, G, c;
    __host__ __device__ __forceinline__ void init(int M, int N, int G_, int c_) { nM = M / BM; nN = N / BM; nwg = nM * nN; G = G_; c = c_; }
    __host__ __device__ __forceinline__ bool next(int i, Unit& u) const {
        const long L = (long)i * G + c; if (L >= nwg) return false;
        int wgid = (int)L; { const int q = nwg / NXCD, r = nwg % NXCD, xcd = wgid % NXCD, off = wgid / NXCD; wgid = (xcd < r ? xcd * (q + 1) : r * (q + 1) + (xcd - r) * q) + off; }
        const int nig = WGM * nN, gid = wgid / nig, fm = gid * WGM, gsz = (nM - fm) < WGM ? (nM - fm) : WGM;
        u.pm = fm + ((wgid % nig) % gsz); u.pn = (wgid % nig) / gsz; return true;
    }
    __device__ __forceinline__ void a_ready(const Unit&) const {}
    __device__ __forceinline__ void done(const Unit&) const {}
};

__device__ __forceinline__ unsigned cvt_pk_bf16(float lo, float hi) { unsigned r; asm volatile("v_cvt_pk_bf16_f32 %0, %1, %2" : "=v"(r) : "v"(lo), "v"(hi)); return r; }
typedef float f32x2 __attribute__((ext_vector_type(2)));
__device__ __forceinline__ f32x2 gelu_pk(f32x2 v) {
    const f32x2 av = __builtin_elementwise_abs(v), d = av * 0.2316418882f + 1.0f;
    f32x2 t; t.x = __builtin_amdgcn_rcpf(d.x); t.y = __builtin_amdgcn_rcpf(d.y);
    f32x2 q = t * 0.5307027145f + (-0.7265760135f); q = q * t + 0.7107068705f; q = q * t + (-0.142248368f); q = q * t + 0.127414796f; q = q * t;
    const f32x2 s = (v * v) * (-0.72134752044f);
    f32x2 e; e.x = __builtin_amdgcn_exp2f(s.x); e.y = __builtin_amdgcn_exp2f(s.y);
    const f32x2 m = v * (q * e), r = v - m;
    f32x2 o; o.x = v.x < 0.f ? m.x : r.x; o.y = v.y < 0.f ? m.y : r.y; return o;
}

template <int ACT  > struct EpiBf16 {
    static constexpr bool PERM = true, AFTER_DRAIN = false; static_assert(ACT == 0 || ACT == 1, "EpiBf16: ACT is 0 (none) or 1 (gelu_pk)");
    bf16_t* O; int ldc; const float* bias; int split_cols; size_t split_stride; float scale0;
    __device__ __forceinline__ void operator()(const f32x4 (&acc)[2][2][4][2], const Unit& u, int wr, int wc, int fr, int fq) const {
        const int row0 = u.pm * BM + wr * 64 + fr; int colt = u.pn * BM; bf16_t* base = O;
        float sc = 1.f; if (split_cols) { const int t = colt / split_cols; base += (size_t)t * split_stride; colt -= t * split_cols; if (t == 0) sc = scale0; }
        const int col0 = colt + wc * 32 + 8 * fq, bcol0 = u.pn * BM + wc * 32 + 8 * fq;
        f32x4 bv[2][2];
#pragma unroll
        for (int bj = 0; bj < 2; ++bj)
#pragma unroll
            for (int n = 0; n < 2; ++n) bv[bj][n] = bias ? *(const f32x4*)(bias + bcol0 + bj * HALF + 4 * n) : (f32x4){0.f, 0.f, 0.f, 0.f};
#pragma unroll
        for (int ai = 0; ai < 2; ++ai)
#pragma unroll
            for (int m = 0; m < 4; ++m) { bf16_t* rowp = base + (size_t)(row0 + ai * HALF + m * 16) * ldc + col0;
#pragma unroll
                for (int bj = 0; bj < 2; ++bj) { f32x4 v0 = acc[ai][bj][m][0] + bv[bj][0], v1 = acc[ai][bj][m][1] + bv[bj][1];
                    if (ACT == 1) { f32x2 a = gelu_pk((f32x2){v0[0], v0[1]}), b = gelu_pk((f32x2){v0[2], v0[3]}), c = gelu_pk((f32x2){v1[0], v1[1]}), d = gelu_pk((f32x2){v1[2], v1[3]});
                        v0 = (f32x4){a.x, a.y, b.x, b.y}; v1 = (f32x4){c.x, c.y, d.x, d.y}; }
                    v0 = v0 * sc; v1 = v1 * sc; u32x4 w; w.x = cvt_pk_bf16(v0[0], v0[1]); w.y = cvt_pk_bf16(v0[2], v0[3]); w.z = cvt_pk_bf16(v1[0], v1[1]); w.w = cvt_pk_bf16(v1[2], v1[3]);
                    *(u32x4*)(rowp + bj * HALF) = w; } }
    }
};

template <class Epi, class Sched, bool ALIGN_EPI = false, bool SP2 = false>
__device__ __forceinline__ void gemm_phase(PG8_LAS unsigned char* lds, const Gemm g, const Sched& S, const Epi& E, const int tid) {
    const int wid = __builtin_amdgcn_readfirstlane(tid >> 6), lane = tid & 63, wr = wid >> 2, wc = wid & 3, fr = lane & 15, fq = lane >> 4;
    const int K = g.K, nt = K / BK;
    unsigned voffA[2], voffB[2];
#pragma unroll
    for (int i = 0; i < 2; ++i) { int R, C; stage_rc(tid * 16 + i * 8192, R, C); const int Rb = Epi::PERM ? ((R & ~31) + perm32(R & 31)) : R;
        voffA[i] = (unsigned)(R * g.lda + C) * 2u; voffB[i] = (unsigned)(Rb * g.ldb + C) * 2u; }
    const size_t kstep = (size_t)(BK * 2);
    const size_t hstepA = (size_t)HALF * g.lda * 2, hstepB = (size_t)HALF * g.ldb * 2;
    const size_t tstepA = 2 * hstepA, tstepB = 2 * hstepB;
    const unsigned ldsw = (unsigned)wid * 1024u;
    const int aoff = lds_byte(wr * 64 + fr, fq * 8), boff = lds_byte(wc * 32 + fr, fq * 8);
#define PG8_SA(b, h) (((b) * 2 + (h)) * HTB)
#define PG8_SB(b, h) ((4 + (b) * 2 + (h)) * HTB)
#define PG8_STAGE(bufoff, gbase, voff) do { _Pragma("unroll") for (int _i = 0; _i < 2; ++_i) \
        __builtin_amdgcn_global_load_lds((const unsigned*)((const char*)(gbase) + (voff)[_i]), (PG8_LAS unsigned*)(lds + (bufoff) + ldsw + _i * 8192), 16, 0, 0); } while (0)
#define PG8_LDA(dst, b, h) do { _Pragma("unroll") for (int m = 0; m < 4; ++m) _Pragma("unroll") for (int k = 0; k < 2; ++k) dst[m][k] = *(const PG8_LAS bf16x8*)(lds + PG8_SA(b, h) + aoff + m * 2048 + k * 1024); } while (0)
#define PG8_LDB(dst, b, h) do { _Pragma("unroll") for (int n = 0; n < 2; ++n) _Pragma("unroll") for (int k = 0; k < 2; ++k) dst[n][k] = *(const PG8_LAS bf16x8*)(lds + PG8_SB(b, h) + boff + n * 2048 + k * 1024); } while (0)
#define PG8_MMA(ai, bj, At, Bt) do { __builtin_amdgcn_s_setprio(1); _Pragma("unroll") for (int m = 0; m < 4; ++m) _Pragma("unroll") for (int n = 0; n < 2; ++n) _Pragma("unroll") for (int k = 0; k < 2; ++k) \
        acc[ai][bj][m][n] = __builtin_amdgcn_mfma_f32_16x16x32_bf16(Bt[n][k], At[m][k], acc[ai][bj][m][n], 0, 0, 0); __builtin_amdgcn_s_setprio(0); } while (0)
#define PG8_WAIT_V(n) asm volatile("s_waitcnt vmcnt(" #n ")" ::: "memory")
#define PG8_WAIT_L(n) asm volatile("s_waitcnt lgkmcnt(" #n ")" ::: "memory")
#define PG8_BAR __builtin_amdgcn_s_barrier()
#define PG8_SCHED __builtin_amdgcn_sched_barrier(0)
    Unit cur, nxt; int ui = 0;
    if (!S.next(0, cur)) return;
    f32x4 acc[2][2][4][2];
#pragma unroll
    for (int a = 0; a < 2; ++a)
#pragma unroll
        for (int b = 0; b < 2; ++b)
#pragma unroll
            for (int m = 0; m < 4; ++m)
#pragma unroll
                for (int n = 0; n < 2; ++n) acc[a][b][m][n] = (f32x4){0.f, 0.f, 0.f, 0.f};
    bf16x8 At[4][2], B0[2][2], B1[2][2];
    const char* cA = (const char*)g.A + (size_t)cur.pm * tstepA; const char* cB = (const char*)g.Bt + (size_t)cur.pn * tstepB;
    S.a_ready(cur);
    if constexpr (SP2) {
        PG8_STAGE(PG8_SB(0, 0), cB, voffB); PG8_STAGE(PG8_SB(0, 1), cB + hstepB, voffB); PG8_STAGE(PG8_SA(0, 0), cA, voffA); PG8_STAGE(PG8_SA(0, 1), cA + hstepA, voffA);
        if (wr == 1) PG8_BAR;
        PG8_WAIT_V(2); PG8_BAR;
        PG8_STAGE(PG8_SB(1, 0), cB + kstep, voffB); PG8_STAGE(PG8_SA(1, 0), cA + kstep, voffA); PG8_STAGE(PG8_SB(1, 1), cB + hstepB + kstep, voffB);
        PG8_WAIT_V(6); PG8_BAR;
    } else {
        PG8_STAGE(PG8_SB(0, 0), cB, voffB); PG8_STAGE(PG8_SA(0, 0), cA, voffA); PG8_STAGE(PG8_SB(0, 1), cB + hstepB, voffB); PG8_STAGE(PG8_SA(0, 1), cA + hstepA, voffA);
        if (wr == 1) PG8_BAR;
        PG8_WAIT_V(4); PG8_BAR;
        PG8_STAGE(PG8_SB(1, 0), cB + kstep, voffB); PG8_STAGE(PG8_SA(1, 0), cA + kstep, voffA); PG8_STAGE(PG8_SB(1, 1), cB + hstepB + kstep, voffB);
        PG8_WAIT_V(6); PG8_BAR;
    }
    for (;;) {
        const bool has_next = S.next(ui + 1, nxt);
        const char* nA = has_next ? (const char*)g.A + (size_t)nxt.pm * tstepA : cA; const char* nB = has_next ? (const char*)g.Bt + (size_t)nxt.pn * tstepB : cB;
        for (int t = 0; t < nt; t += 2) {
            const bool last = (t == nt - 2);
            const char* a1 = cA + (size_t)(t + 1) * kstep;
            const char* a2 = last ? nA : cA + (size_t)(t + 2) * kstep; const char* b2 = last ? nB : cB + (size_t)(t + 2) * kstep;
            const char* a3 = a2 + kstep; const char* b3 = b2 + kstep;
            if (last && has_next) S.a_ready(nxt);
            if constexpr (SP2) {
            PG8_LDB(B0, 0, 0); PG8_LDB(B1, 0, 1); PG8_SCHED; PG8_LDA(At, 0, 0); PG8_STAGE(PG8_SA(1, 1), a1 + hstepA, voffA);
            PG8_WAIT_V(8); PG8_WAIT_L(0); PG8_BAR; PG8_MMA(0, 0, At, B0); PG8_MMA(0, 1, At, B1); PG8_BAR; PG8_SCHED;
            PG8_LDA(At, 0, 1); PG8_STAGE(PG8_SB(0, 0), b2, voffB); PG8_STAGE(PG8_SB(0, 1), b2 + hstepB, voffB); PG8_STAGE(PG8_SA(0, 0), a2, voffA);
            PG8_WAIT_V(8); PG8_WAIT_L(0); PG8_BAR; PG8_MMA(1, 0, At, B0); PG8_MMA(1, 1, At, B1); PG8_BAR; PG8_SCHED;
            PG8_LDB(B0, 1, 0); PG8_LDB(B1, 1, 1); PG8_SCHED; PG8_LDA(At, 1, 0); PG8_STAGE(PG8_SA(0, 1), a2 + hstepA, voffA);
            PG8_WAIT_V(8); PG8_WAIT_L(0); PG8_BAR; PG8_MMA(0, 0, At, B0); PG8_MMA(0, 1, At, B1); PG8_BAR; PG8_SCHED;
            PG8_LDA(At, 1, 1); PG8_STAGE(PG8_SB(1, 0), b3, voffB); PG8_STAGE(PG8_SB(1, 1), b3 + hstepB, voffB); PG8_STAGE(PG8_SA(1, 0), a3, voffA);
            PG8_WAIT_V(8); PG8_WAIT_L(0); PG8_BAR; PG8_MMA(1, 0, At, B0); PG8_MMA(1, 1, At, B1); PG8_BAR; PG8_SCHED;
            } else {
            PG8_LDB(B0, 0, 0); PG8_SCHED; PG8_LDA(At, 0, 0); PG8_STAGE(PG8_SA(1, 1), a1 + hstepA, voffA);
            PG8_WAIT_L(8); PG8_BAR; PG8_WAIT_L(0); PG8_MMA(0, 0, At, B0); PG8_BAR; PG8_SCHED;
            PG8_LDB(B1, 0, 1); PG8_STAGE(PG8_SB(0, 0), b2, voffB);
            PG8_BAR; PG8_WAIT_L(0); PG8_MMA(0, 1, At, B1); PG8_BAR;
            PG8_LDA(At, 0, 1); PG8_STAGE(PG8_SA(0, 0), a2, voffA);
            PG8_BAR; PG8_WAIT_L(0); PG8_MMA(1, 0, At, B0); PG8_BAR; PG8_SCHED;
            PG8_STAGE(PG8_SB(0, 1), b2 + hstepB, voffB);
            PG8_WAIT_V(6); PG8_BAR; PG8_MMA(1, 1, At, B1); PG8_BAR;
            PG8_LDB(B0, 1, 0); PG8_SCHED; PG8_LDA(At, 1, 0); PG8_STAGE(PG8_SA(0, 1), a2 + hstepA, voffA);
            PG8_WAIT_L(8); PG8_BAR; PG8_WAIT_L(0); PG8_MMA(0, 0, At, B0); PG8_BAR; PG8_SCHED;
            PG8_LDB(B1, 1, 1); PG8_STAGE(PG8_SB(1, 0), b3, voffB);
            PG8_BAR; PG8_WAIT_L(0); PG8_MMA(0, 1, At, B1); PG8_BAR;
            PG8_LDA(At, 1, 1); PG8_STAGE(PG8_SA(1, 0), a3, voffA);
            PG8_BAR; PG8_WAIT_L(0); PG8_MMA(1, 0, At, B0); PG8_BAR; PG8_SCHED;
            PG8_STAGE(PG8_SB(1, 1), b3 + hstepB, voffB);
            PG8_WAIT_V(6); PG8_BAR; PG8_MMA(1, 1, At, B1); PG8_BAR;
            }
        }
        if constexpr (ALIGN_EPI) { if (wr == 0) PG8_BAR; }
        if constexpr (!Epi::AFTER_DRAIN) { const int l2_ = lane_id_opaque(); E(acc, cur, wr, wc, l2_ & 15, l2_ >> 4); S.done(cur); }
        if (!has_next) break;
#pragma unroll
        for (int a = 0; a < 2; ++a)
#pragma unroll
            for (int b = 0; b < 2; ++b)
#pragma unroll
                for (int m = 0; m < 4; ++m)
#pragma unroll
                    for (int n = 0; n < 2; ++n) acc[a][b][m][n] = (f32x4){0.f, 0.f, 0.f, 0.f};
        cur = nxt; cA = nA; cB = nB; ++ui;
        if constexpr (ALIGN_EPI) { if (wr == 1) PG8_BAR; }
    }
    PG8_WAIT_V(0);
    if constexpr (!ALIGN_EPI) { if (wr == 0) PG8_BAR; }
    PG8_BAR;
    if constexpr (Epi::AFTER_DRAIN) { E.fused(acc, cur, wr, wc, fr, fq, lds, wid, lane); S.done(cur); }
#undef PG8_SA
#undef PG8_SB
#undef PG8_STAGE
#undef PG8_LDA
#undef PG8_LDB
#undef PG8_MMA
#undef PG8_WAIT_V
#undef PG8_WAIT_L
#undef PG8_BAR
#undef PG8_SCHED
}
}


#define LAS __attribute__((address_space(3)))
DI unsigned pk2(float lo, float hi) { return (unsigned)f2bf(lo) | ((unsigned)f2bf(hi) << 16); }
template <class Map>
DI void prep_wt_item(const float* __restrict__ W, int ldw, int K, bf16_t* __restrict__ WT, const float* __restrict__ gain, Map map, float* scr, int item, int nblk, int lane) {
    const int kb = item / nblk, nb = item % nblk, k0 = 64 * kb, n0 = 32 * nb;
    const int srcn = map(n0 + (lane & 31));
#pragma unroll 8
    for (int i = 0; i < 32; ++i) { const int kk = 2 * i + (lane >> 5); float v = 0.f; if (srcn >= 0) { v = W[(size_t)(k0 + kk) * ldw + srcn]; if (gain) v *= gain[k0 + kk]; } scr[kk * 33 + (lane & 31)] = v; }
    __builtin_amdgcn_s_waitcnt(0xC07F); asm volatile("" ::: "memory");
    const int c = lane & 7;
#pragma unroll
    for (int j = 0; j < 4; ++j) { const int n = (lane >> 3) + 8 * j; const float* s = scr + (8 * c) * 33 + n;
        uint4 o; o.x = pk2(s[0 * 33], s[1 * 33]); o.y = pk2(s[2 * 33], s[3 * 33]); o.z = pk2(s[4 * 33], s[5 * 33]); o.w = pk2(s[6 * 33], s[7 * 33]);
        *(uint4*)(WT + (size_t)(n0 + n) * K + k0 + 8 * c) = o; }
    __builtin_amdgcn_s_waitcnt(0xC07F); asm volatile("" ::: "memory");
}
struct MapIn {
    DI int operator()(int n) const {
        if (n < 1280) return n;
        if (n < 1536) { const int i = n - 1280; return i < 24 ? ZC_GATE + i : (i < 32 ? ZC_IF + (i - 24) : -1); }
        if (n < 2560) return ZC_MQK + (n - 1536);
        if (n < 3072) return ZC_MV + (n - 2560);
        if (n < 3584) return ZC_MO + (n - 3072);
        return ZC_GA + (n - 3584);
    }
};
DI void prep_x_row(const float* __restrict__ x, bf16_t* __restrict__ xb, float* __restrict__ rstd, int row, int lane) {
    const float4* xr = (const float4*)(x + (size_t)row * DM);
    float4 v[4]; float s = 0.f;
#pragma unroll
    for (int j = 0; j < 4; ++j) { v[j] = xr[lane + 64 * j]; s += v[j].x * v[j].x + v[j].y * v[j].y + v[j].z * v[j].z + v[j].w * v[j].w; }
    s = wave_sum(s);
    if (lane == 0) rstd[row] = rsqrtf(s * (1.f / DM) + 1e-6f);
#pragma unroll
    for (int j = 0; j < 4; ++j) { uint2 o; o.x = pk2(v[j].x, v[j].y); o.y = pk2(v[j].z, v[j].w); ((uint2*)(xb + (size_t)row * DM))[lane + 64 * j] = o; }
}

struct EpiInProj {
    static constexpr bool PERM = true, AFTER_DRAIN = false;
    const float* rstd; const float* cosT; const float* sinT; const float* b_if;
    bf16_t* Qb; bf16_t* KVb; float* gates; float* ifp; bf16_t* MQK; bf16_t* MV; bf16_t* MO; bf16_t* MG; bf16_t* VT;
    DI void operator()(const pg8::f32x4 (&acc)[2][2][4][2], const pg8::Unit& u, int wr, int wc, int fr, int fq) const {
        const int pn = u.pn;
        asm volatile("" : "+v"(fr), "+v"(fq));
#pragma unroll
        for (int ai = 0; ai < 2; ++ai)
#pragma unroll
            for (int m = 0; m < 4; ++m) {
                const int row = u.pm * 256 + ai * 128 + wr * 64 + m * 16 + fr;
                const float rs = rstd[row];
#pragma unroll
                for (int bj = 0; bj < 2; ++bj) {
                    float v[8];
#pragma unroll
                    for (int i = 0; i < 4; ++i) { v[i] = acc[ai][bj][m][0][i] * rs; v[4 + i] = acc[ai][bj][m][1][i] * rs; }
                    const int c0 = bj * 128 + wc * 32 + 8 * fq;
                    if (pn <= 4) {
                        const bool is_k = (pn < 2) || (bj == 0);
                        if (is_k && (wc & 1) == 0) {
                            const float4 c_lo = *(const float4*)(cosT + (size_t)row * 8), c_hi = *(const float4*)(cosT + (size_t)row * 8 + 4);
                            const float4 s_lo = *(const float4*)(sinT + (size_t)row * 8), s_hi = *(const float4*)(sinT + (size_t)row * 8 + 4);
                            const float cs[8] = {c_lo.x, c_lo.y, c_lo.z, c_lo.w, c_hi.x, c_hi.y, c_hi.z, c_hi.w};
                            const float sn[8] = {s_lo.x, s_lo.y, s_lo.z, s_lo.w, s_hi.x, s_hi.y, s_hi.z, s_hi.w};
                            const int l_ = lane_id_opaque();
#pragma unroll
                            for (int i = 0; i < 8; ++i) {
                                const float other = lane_xor(v[i], 16, l_);
                                if (fq == 0) v[i] = v[i] * cs[i] - other * sn[i];
                                else if (fq == 1) v[i] = v[i] * cs[i] + other * sn[i];
                            }
                        }
                        const float sc = pn < 2 ? QSCALE : 1.f;
                        pg8::u32x4 w; w.x = pg8::cvt_pk_bf16(v[0] * sc, v[1] * sc); w.y = pg8::cvt_pk_bf16(v[2] * sc, v[3] * sc); w.z = pg8::cvt_pk_bf16(v[4] * sc, v[5] * sc); w.w = pg8::cvt_pk_bf16(v[6] * sc, v[7] * sc);
                        if (pn < 2) *(pg8::u32x4*)(Qb + (size_t)row * 512 + pn * 256 + c0) = w;
                        else if (pn == 2) *(pg8::u32x4*)(KVb + (size_t)row * 512 + c0) = w;
                        else if (bj == 0) *(pg8::u32x4*)(KVb + (size_t)row * 512 + (pn - 2) * 128 + 128 + wc * 32 + 8 * fq) = w;
                        else {
                            const int cv = wc * 32 + 8 * fq, gg = cv >> 6, d0 = cv & 63, bb = row >> 12, tt = row & 4095;
                            bf16_t* vt = VT + ((size_t)((pn - 3) * 8 + bb * 2 + gg) * 64 + (tt >> 6)) * 4096 + (size_t)d0 * 64 + (tt & 63);
                            vt[0] = (bf16_t)(w.x & 0xffffu); vt[64] = (bf16_t)(w.x >> 16); vt[128] = (bf16_t)(w.y & 0xffffu); vt[192] = (bf16_t)(w.y >> 16);
                            vt[256] = (bf16_t)(w.z & 0xffffu); vt[320] = (bf16_t)(w.z >> 16); vt[384] = (bf16_t)(w.w & 0xffffu); vt[448] = (bf16_t)(w.w >> 16);
                        }
                    } else if (pn == 5) {
                        if (bj == 0 && wc == 0) {
#pragma unroll
                            for (int i = 0; i < 8; ++i) { const int c = 8 * fq + i;
                                if (c < 24) gates[(size_t)row * 24 + c] = sigmoidf_(v[i]);
                                else if (c < 32) ifp[(size_t)row * 8 + (c - 24)] = v[i] + b_if[c - 24]; }
                        }
                    } else {
                        if (pn >= 14) {
#pragma unroll
                            for (int i = 0; i < 8; ++i) v[i] = sigmoidf_(v[i]);
                        }
                        pg8::u32x4 w; w.x = pg8::cvt_pk_bf16(v[0], v[1]); w.y = pg8::cvt_pk_bf16(v[2], v[3]); w.z = pg8::cvt_pk_bf16(v[4], v[5]); w.w = pg8::cvt_pk_bf16(v[6], v[7]);
                        bf16_t* dst;
                        if (pn < 10) dst = MQK + (size_t)row * 1024 + (pn - 6) * 256 + c0;
                        else if (pn < 12) dst = MV + (size_t)row * 512 + (pn - 10) * 256 + c0;
                        else if (pn < 14) dst = MO + (size_t)row * 512 + (pn - 12) * 256 + c0;
                        else dst = MG + (size_t)row * 2048 + (pn - 14) * 256 + c0;
                        *(pg8::u32x4*)dst = w;
                    }
                }
            }
    }
};


DI pg8::u32x4 pack8(const float (&v)[8]) { pg8::u32x4 w; w.x = pg8::cvt_pk_bf16(v[0], v[1]); w.y = pg8::cvt_pk_bf16(v[2], v[3]); w.z = pg8::cvt_pk_bf16(v[4], v[5]); w.w = pg8::cvt_pk_bf16(v[6], v[7]); return w; }
DI void unpack8(const pg8::u32x4 w, float (&v)[8]) {
    v[0] = __uint_as_float(w.x << 16); v[1] = __uint_as_float(w.x & 0xffff0000u); v[2] = __uint_as_float(w.y << 16); v[3] = __uint_as_float(w.y & 0xffff0000u);
    v[4] = __uint_as_float(w.z << 16); v[5] = __uint_as_float(w.z & 0xffff0000u); v[6] = __uint_as_float(w.w << 16); v[7] = __uint_as_float(w.w & 0xffff0000u);
}
#define EPI_ROWS_BEGIN asm volatile("" : "+v"(fr), "+v"(fq)); _Pragma("unroll") for (int ai = 0; ai < 2; ++ai) _Pragma("unroll") for (int m = 0; m < 4; ++m) { const int row = u.pm * 256 + ai * 128 + wr * 64 + m * 16 + fr; _Pragma("unroll") for (int bj = 0; bj < 2; ++bj) { \
    float v[8]; _Pragma("unroll") for (int i = 0; i < 4; ++i) { v[i] = acc[ai][bj][m][0][i]; v[4 + i] = acc[ai][bj][m][1][i]; } const int c0 = bj * 128 + wc * 32 + 8 * fq; (void)c0; (void)row;
#define EPI_ROWS_END } asm volatile("" ::: "memory"); }
template <int MODE> struct EpiMerge {
    static constexpr bool PERM = true, AFTER_DRAIN = false;
    const bf16_t* MG; float* tmp; bf16_t* mixed;
    DI void operator()(const pg8::f32x4 (&acc)[2][2][4][2], const pg8::Unit& u, int wr, int wc, int fr, int fq) const {
        EPI_ROWS_BEGIN
            const int col = u.pn * 256 + c0; float gt[8];
            unpack8(*(const pg8::u32x4*)(MG + (size_t)row * 2048 + MODE * 1024 + col), gt);
            float* tp = tmp + (size_t)row * DM + col;
            if (MODE == 0) {
                *(float4*)tp = make_float4(gt[0] * v[0], gt[1] * v[1], gt[2] * v[2], gt[3] * v[3]); *(float4*)(tp + 4) = make_float4(gt[4] * v[4], gt[5] * v[5], gt[6] * v[6], gt[7] * v[7]);
            } else {
                const float4 t0 = *(const float4*)tp, t1 = *(const float4*)(tp + 4);
                float o[8] = {t0.x + gt[0] * v[0], t0.y + gt[1] * v[1], t0.z + gt[2] * v[2], t0.w + gt[3] * v[3], t1.x + gt[4] * v[4], t1.y + gt[5] * v[5], t1.z + gt[6] * v[6], t1.w + gt[7] * v[7]};
                *(pg8::u32x4*)(mixed + (size_t)row * DM + col) = pack8(o);
            }
        EPI_ROWS_END
    }
};
struct EpiX1 {
    static constexpr bool PERM = true, AFTER_DRAIN = false;
    const float* base; float* out;
    DI void operator()(const pg8::f32x4 (&acc)[2][2][4][2], const pg8::Unit& u, int wr, int wc, int fr, int fq) const {
        EPI_ROWS_BEGIN
            const size_t o = (size_t)row * DM + u.pn * 256 + c0;
            const float4 b0 = *(const float4*)(base + o), b1 = *(const float4*)(base + o + 4);
            *(float4*)(out + o) = make_float4(b0.x + v[0], b0.y + v[1], b0.z + v[2], b0.w + v[3]); *(float4*)(out + o + 4) = make_float4(b1.x + v[4], b1.y + v[5], b1.z + v[6], b1.w + v[7]);
        EPI_ROWS_END
    }
};
struct EpiStoreBf {
    static constexpr bool PERM = true, AFTER_DRAIN = false;
    bf16_t* O; int ld; int pnmask;
    DI void operator()(const pg8::f32x4 (&acc)[2][2][4][2], const pg8::Unit& u, int wr, int wc, int fr, int fq) const {
        EPI_ROWS_BEGIN
            *(pg8::u32x4*)(O + (size_t)row * ld + (u.pn & pnmask) * 256 + c0) = pack8(v);
        EPI_ROWS_END
    }
};
struct EpiSwiglu {
    static constexpr bool PERM = true, AFTER_DRAIN = false;
    bf16_t* act;
    DI void operator()(const pg8::f32x4 (&acc)[2][2][4][2], const pg8::Unit& u, int wr, int wc, int fr, int fq) const {
        asm volatile("" : "+v"(fr), "+v"(fq));
#pragma unroll
        for (int ai = 0; ai < 2; ++ai)
#pragma unroll
            for (int m = 0; m < 4; ++m) {
                const int row = u.pm * 256 + ai * 128 + wr * 64 + m * 16 + fr; float o[8];
#pragma unroll
                for (int i = 0; i < 4; ++i) { const float g0 = acc[ai][0][m][0][i], g1 = acc[ai][0][m][1][i]; o[i] = g0 * sigmoidf_(g0) * acc[ai][1][m][0][i]; o[4 + i] = g1 * sigmoidf_(g1) * acc[ai][1][m][1][i]; }
                *(pg8::u32x4*)(act + (size_t)row * 256 + (u.pn & 1) * 128 + wc * 32 + 8 * fq) = pack8(o);
            }
    }
};
struct EpiPle2 {
    static constexpr bool PERM = true, AFTER_DRAIN = false;
    float* x; const bf16_t* PP; const float* rstd;
    DI void operator()(const pg8::f32x4 (&acc)[2][2][4][2], const pg8::Unit& u, int wr, int wc, int fr, int fq) const {
        EPI_ROWS_BEGIN
            const size_t o = (size_t)row * DM + u.pn * 256 + c0; const float rs = rstd[row]; float pp[8];
            unpack8(*(const pg8::u32x4*)(PP + o), pp);
            const float4 b0 = *(const float4*)(x + o), b1 = *(const float4*)(x + o + 4);
            *(float4*)(x + o) = make_float4(b0.x + sigmoidf_(rs * v[0]) * pp[0], b0.y + sigmoidf_(rs * v[1]) * pp[1], b0.z + sigmoidf_(rs * v[2]) * pp[2], b0.w + sigmoidf_(rs * v[3]) * pp[3]);
            *(float4*)(x + o + 4) = make_float4(b1.x + sigmoidf_(rs * v[4]) * pp[4], b1.y + sigmoidf_(rs * v[5]) * pp[5], b1.z + sigmoidf_(rs * v[6]) * pp[6], b1.w + sigmoidf_(rs * v[7]) * pp[7]);
        EPI_ROWS_END
    }
};
struct MoeOrder {
    const int* cnt; int NJ, G, c;
    DI bool next(int i, pg8::Unit& u) const {
        int L = i * G + c, tb = 0;
        for (int e = 0; e < 16; ++e) { const int mt = (cnt[e * CNT_STRIDE] + 255) >> 8, n = mt * NJ; if (L < n) { u.pm = tb + L / NJ; u.pn = e * NJ + L % NJ; return true; } L -= n; tb += mt; }
        return false;
    }
    DI void a_ready(const pg8::Unit&) const {}
    DI void done(const pg8::Unit&) const {}
};
DI int moe_base_row(const int* cnt, int e) { int tb = 0; for (int k = 0; k < 16; ++k) { if (k < e) tb += (cnt[k * CNT_STRIDE] + 255) >> 8; } return tb * 256; }
struct MapId { DI int operator()(int n) const { return n; } };
struct MapE13 { DI int operator()(int n) const { return ((n >> 7) & 1) * 256 + (n >> 8) * 128 + (n & 127); } };

DI void router_stage(__attribute__((address_space(3))) float* Wl, const float* __restrict__ g, const float* __restrict__ w_rg, const float* __restrict__ w_re, int tx) {
    for (int e = tx; e < 4096; e += 512) { const int k = e >> 2, c = e & 3; Wl[c * 1024 + k] = w_rg[e] * g[k]; }
    for (int e = tx; e < 16384; e += 512) { const int k = e >> 4, c = e & 15; Wl[(4 + c) * 1024 + k] = w_re[e] * g[k]; }
}
DI void router2(int tok, int lane, const float* __restrict__ x, const __attribute__((address_space(3))) float* Wl, const float* __restrict__ b_rg, const float* __restrict__ b_re,
                float* __restrict__ rstd1, __attribute__((address_space(3))) int* lcnt, __attribute__((address_space(3))) int* lri) {
    typedef float f4v __attribute__((ext_vector_type(4)));
    f4v xv[4]; float s = 0.f;
#pragma unroll
    for (int j = 0; j < 4; ++j) { const float4 v = ((const float4*)(x + (size_t)tok * DM))[lane + 64 * j]; xv[j] = (f4v){v.x, v.y, v.z, v.w}; s += v.x * v.x + v.y * v.y + v.z * v.z + v.w * v.w; }
    const float rstd = rsqrtf(wave_sum(s) * (1.f / DM) + 1e-6f);
    float al[20];
#pragma unroll
    for (int c = 0; c < 20; ++c) {
        float a = 0.f;
#pragma unroll
        for (int j = 0; j < 4; ++j) { const f4v w = *(const __attribute__((address_space(3))) f4v*)(Wl + c * 1024 + 4 * (lane + 64 * j)); a += (xv[j].x * w.x + xv[j].y * w.y) + (xv[j].z * w.z + xv[j].w * w.w); }
        al[c] = a;
    }
    {
        const int l_ = lane_id_opaque();
#pragma unroll
        for (int o = 1; o < 64; o <<= 1) {
            float t[20];
#pragma unroll
            for (int c = 0; c < 20; ++c) t[c] = lane_xor(al[c], o, l_);
#pragma unroll
            for (int c = 0; c < 20; ++c) al[c] += t[c];
        }
    }
    float gl[4], el[16];
#pragma unroll
    for (int c = 0; c < 4; ++c) gl[c] = al[c] * rstd + b_rg[c];
#pragma unroll
    for (int c = 0; c < 16; ++c) el[c] = al[4 + c] * rstd + b_re[c];
    if (lane == 0) {
        int gs = 0; float gm = gl[0];
#pragma unroll
        for (int c = 1; c < 4; ++c) if (gl[c] > gm) { gm = gl[c]; gs = c; }
        float se = 0.f;
#pragma unroll
        for (int c = 0; c < 4; ++c) se += __expf(gl[c] - gm);
        const float pg = 1.f / se;
        float e4[4];
#pragma unroll
        for (int c = 0; c < 4; ++c) e4[c] = gs == 0 ? el[c] : gs == 1 ? el[4 + c] : gs == 2 ? el[8 + c] : el[12 + c];
        int i0 = 0; float v0 = e4[0];
#pragma unroll
        for (int c = 1; c < 4; ++c) if (e4[c] > v0) { v0 = e4[c]; i0 = c; }
        int i1 = -1; float v1 = -3.0e38f;
#pragma unroll
        for (int c = 0; c < 4; ++c) if (c != i0 && e4[c] > v1) { v1 = e4[c]; i1 = c; }
        const float ex = __expf(v1 - v0);
        const float w0 = pg / (1.f + ex), w1 = pg * ex / (1.f + ex);
        const int e0 = gs * 4 + i0, e1 = gs * 4 + i1;
        const int p0 = __hip_atomic_fetch_add(lcnt + e0, 1, __ATOMIC_RELAXED, __HIP_MEMORY_SCOPE_WORKGROUP), p1 = __hip_atomic_fetch_add(lcnt + e1, 1, __ATOMIC_RELAXED, __HIP_MEMORY_SCOPE_WORKGROUP);
        rstd1[tok] = rstd;
        lri[0] = e0 | (e1 << 8); lri[1] = p0 | (p1 << 16); lri[2] = __float_as_int(w0); lri[3] = __float_as_int(w1);
    }
}

struct BMapId { DI int operator()(int n) const { return n; } };
struct BMapMoe { DI int operator()(int n) const { const int t = n >> 7, c = n & 127, e = t >> 2, jt = t & 3; return e * (1024 * 512) + ((c >> 5) & 1) * 256 + jt * 64 + (c >> 6) * 32 + (c & 31); } };
template <class Epi, class BMap>
DI void gemm_v1(int bx, int by, int tid, char* sm, const bf16_t* __restrict__ A, int lda, const float* __restrict__ B, int ldb, int N, int K, Epi epi, BMap bmap) {
    bf16_t* As = (bf16_t*)sm;
    bf16_t* Bs = (bf16_t*)(sm + 128 * 40 * 2);
    const int lane = tid & 63, w = tid >> 6, wr = w >> 1, wc = w & 1, r32 = lane & 31, hi = lane >> 5;
    const int m0 = by * 128, n0 = bx * 128;
    f32x16 acc[2][2];
#pragma unroll
    for (int i = 0; i < 2; ++i)
#pragma unroll
        for (int j = 0; j < 2; ++j)
#pragma unroll
            for (int r = 0; r < 16; ++r) acc[i][j][r] = 0.f;
    for (int k0 = 0; k0 < K; k0 += 32) {
#pragma unroll
        for (int i = 0; i < 2; ++i) {
            const int c = tid + i * 256, row = c >> 2, col = (c & 3) * 8;
            const uint4 v = *(const uint4*)(A + (size_t)(m0 + row) * lda + k0 + col);
            *(uint4*)(As + row * 40 + col) = v;
        }
#pragma unroll
        for (int i = 0; i < 4; ++i) {
            const int idx = tid + i * 256, k = idx >> 5, n = (idx & 31) * 4;
            float4 v = make_float4(0.f, 0.f, 0.f, 0.f);
            if (n0 + n < N) v = *(const float4*)(B + (size_t)(k0 + k) * ldb + bmap(n0 + n));
            Bs[(n + 0) * 40 + k] = f2bf(v.x); Bs[(n + 1) * 40 + k] = f2bf(v.y); Bs[(n + 2) * 40 + k] = f2bf(v.z); Bs[(n + 3) * 40 + k] = f2bf(v.w);
        }
        __syncthreads();
#pragma unroll
        for (int kk = 0; kk < 32; kk += 16) {
            bf16x8 a[2], b[2];
#pragma unroll
            for (int i = 0; i < 2; ++i) a[i] = *(const bf16x8*)(As + (wr * 64 + i * 32 + r32) * 40 + kk + hi * 8);
#pragma unroll
            for (int j = 0; j < 2; ++j) b[j] = *(const bf16x8*)(Bs + (wc * 64 + j * 32 + r32) * 40 + kk + hi * 8);
#pragma unroll
            for (int i = 0; i < 2; ++i)
#pragma unroll
                for (int j = 0; j < 2; ++j) acc[i][j] = __builtin_amdgcn_mfma_f32_32x32x16_bf16(a[i], b[j], acc[i][j], 0, 0, 0);
        }
        __syncthreads();
    }
#pragma unroll
    for (int i = 0; i < 2; ++i)
#pragma unroll
        for (int j = 0; j < 2; ++j)
#pragma unroll
            for (int r = 0; r < 16; ++r) {
                const int row = m0 + wr * 64 + i * 32 + (r & 3) + 8 * (r >> 2) + 4 * hi;
                const int col = n0 + wc * 64 + j * 32 + r32;
                if constexpr (Epi::PAIR) { if (j == 0) epi.pair(row, col, acc[i][0][r], acc[i][1][r]); }
                else { if (col < N) epi(row, col, acc[i][j][r]); }
            }
}

struct EpiPa { static constexpr bool PAIR = false;
    const bf16_t* MG; float* tmp;
    DI void operator()(int row, int col, float v) const { tmp[(size_t)row * DM + col] = bf2f(MG[(size_t)row * 2048 + col]) * v; }
};
struct EpiPb { static constexpr bool PAIR = false;
    const bf16_t* MG; const float* tmp; bf16_t* mixed;
    DI void operator()(int row, int col, float v) const {
        mixed[(size_t)row * DM + col] = f2bf(tmp[(size_t)row * DM + col] + bf2f(MG[(size_t)row * 2048 + 1024 + col]) * v);
    }
};
struct EpiResid { static constexpr bool PAIR = false;
    const float* base; float* out;
    DI void operator()(int row, int col, float v) const { out[(size_t)row * DM + col] = base[(size_t)row * DM + col] + v; }
};
struct EpiBf { static constexpr bool PAIR = false;
    bf16_t* o; int ld;
    DI void operator()(int row, int col, float v) const { o[(size_t)row * ld + col] = f2bf(v); }
};
struct EpiF32 { static constexpr bool PAIR = false;
    float* o; int ld;
    DI void operator()(int row, int col, float v) const { o[(size_t)row * ld + col] = v; }
};
struct EpiPle { static constexpr bool PAIR = false;
    float* x; const float* pp;
    DI void operator()(int row, int col, float v) const { const size_t i = (size_t)row * DM + col; x[i] = x[i] + sigmoidf_(v) * pp[i]; }
};

DI void rmsnorm_rows(int bx, int tid, const float* x, const float* __restrict__ g, bf16_t* outb, float* outf, int rows) {
    const int row = bx * 4 + (tid >> 6), lane = tid & 63;
    if (row >= rows) return;
    const float4* xr = (const float4*)(x + (size_t)row * DM);
    float4 v[4]; float s = 0.f;
#pragma unroll
    for (int j = 0; j < 4; ++j) { v[j] = xr[lane + 64 * j]; s += v[j].x * v[j].x + v[j].y * v[j].y + v[j].z * v[j].z + v[j].w * v[j].w; }
    const float rstd = rsqrtf(wave_sum(s) * (1.f / DM) + 1e-6f);
#pragma unroll
    for (int j = 0; j < 4; ++j) {
        const float4 gg = ((const float4*)g)[lane + 64 * j];
        const float a = v[j].x * rstd * gg.x, b = v[j].y * rstd * gg.y, c = v[j].z * rstd * gg.z, d = v[j].w * rstd * gg.w;
        if (outf) ((float4*)(outf + (size_t)row * DM))[lane + 64 * j] = make_float4(a, b, c, d);
        else { ushort4 o; o.x = f2bf(a); o.y = f2bf(b); o.z = f2bf(c); o.w = f2bf(d); ((ushort4*)(outb + (size_t)row * DM))[lane + 64 * j] = o; }
    }
}

DI void cvt_bf16(int bx, int nb, int tid, const float* __restrict__ in, bf16_t* __restrict__ out, size_t n) {
    for (size_t i = bx * (size_t)256 + tid; i < n; i += (size_t)nb * 256) out[i] = f2bf(in[i]);
}

DI float gelu_tanh(float x) { const float u = 0.7978845608028654f * (x + 0.044715f * x * x * x); return 0.5f * x * (1.f + tanhf(u)); }

DI void compress_naive(int bx, int by, int bz, int tid, char* sm, const bf16_t* __restrict__ KVb, const float* __restrict__ w1k, const float* __restrict__ w2k, const float* __restrict__ pek,
                                                      const float* __restrict__ w1v, const float* __restrict__ w2v, const float* __restrict__ pev, float* __restrict__ outk, float* __restrict__ outv, bf16_t* __restrict__ kcb, bf16_t* __restrict__ vcT) {
    float* flat = (float*)sm;
    float* h1 = flat + 2048;
    __syncthreads();
    const int j = bx, bg = by, kv = bz, b = bg >> 1, g = bg & 1;
    const float* w1 = kv ? w1v : w1k; const float* w2 = kv ? w2v : w2k; const float* pe = kv ? pev : pek; float* out = kv ? outv : outk;
    const int colbase = (kv ? 128 : 0) + g * 64;
    for (int e = tid; e < 2048; e += 256) {
        const int i = e >> 6, d = e & 63;
        flat[e] = bf2f(KVb[(size_t)(b * SEQ + 16 * j + i) * 512 + colbase + d]) + pe[e];
    }
    __syncthreads();
    float s = 0.f;
    for (int k = 0; k < 2048; ++k) s += flat[k] * w1[(size_t)k * 256 + tid];
    h1[tid] = gelu_tanh(s);
    __syncthreads();
    if (tid < 64) {
        float o = 0.f;
        for (int n = 0; n < 256; ++n) o += h1[n] * w2[n * 64 + tid];
        out[((size_t)bg * 256 + j) * 64 + tid] = o;
        if (kv == 0) { kcb[((size_t)bg * 256 + j) * 64 + tid] = f2bf(o); if (j == 254) kcb[((size_t)bg * 256 + 255) * 64 + tid] = 0; }
        else { vcT[((size_t)bg * 4 + (j >> 6)) * 4096 + tid * 64 + (j & 63)] = f2bf(o); if (j == 254) vcT[((size_t)bg * 4 + 3) * 4096 + tid * 64 + 63] = 0; }
    }
}

DI void softmax_row(float* row, int n, int lane) {
    float m = -3.0e38f;
    for (int j = lane; j < n; j += 64) m = fmaxf(m, row[j]);
    m = wave_max(m);
    float s = 0.f;
    for (int j = lane; j < n; j += 64) { const float e = exp2f(row[j] - m); row[j] = e; s += e; }
    s = wave_sum(s);
    const float inv = 1.f / s;
    for (int j = lane; j < n; j += 64) row[j] *= inv;
}

DI void nsa_naive(int bx, int by, int tid, char* sm, const bf16_t* __restrict__ Qb, const bf16_t* __restrict__ KVb, const bf16_t* __restrict__ VT, const float* __restrict__ kcc, const float* __restrict__ vcc, const float* __restrict__ gates, bf16_t* __restrict__ Y) {
    float (*q)[64] = (float (*)[64])sm;
    float (*sc)[1024] = (float (*)[1024])(sm + 1024);
    float* impv = (float*)(sm + 1024 + 16384);
    int* sellist = (int*)(sm + 1024 + 16384 + 256);
    int* selflag = (int*)(sm + 1024 + 16384 + 256 + 64);
    int& nsel_s = *(int*)(sm + 1024 + 16384 + 256 + 64 + 256);
    __syncthreads();
    const int tok = bx, g = by, b = tok >> 12, t = tok & 4095, hh = tid >> 6, lane = tid & 63, d = lane;
    q[hh][d] = bf2f(Qb[(size_t)tok * 512 + (g * 4 + hh) * 64 + d]);
    __syncthreads();
    const int nv = (t >= 31) ? ((t - 15) >> 4) : 0;
    const float* kcb = kcc + (size_t)(b * 2 + g) * 256 * 64; const float* vcb = vcc + (size_t)(b * 2 + g) * 256 * 64;
    if (tid < nv) {
        float s0 = 0.f, s1 = 0.f, s2 = 0.f, s3 = 0.f;
#pragma unroll 8
        for (int dd = 0; dd < 64; ++dd) { const float kx = kcb[tid * 64 + dd]; s0 += q[0][dd] * kx; s1 += q[1][dd] * kx; s2 += q[2][dd] * kx; s3 += q[3][dd] * kx; }
        sc[0][tid] = s0; sc[1][tid] = s1; sc[2][tid] = s2; sc[3][tid] = s3;
    }
    __syncthreads();
    if (nv > 0) softmax_row(sc[hh], nv, lane);
    for (int j = nv + lane; j < 256; j += 64) sc[hh][j] = 0.f;
    __syncthreads();
    float o_cmp = 0.f;
    for (int j = 0; j < nv; ++j) o_cmp += sc[hh][j] * vcb[j * 64 + d];
    const int cur = t >> 6;
    if (tid < 64) {
        const int s = tid; int lo = 4 * s - 1; if (lo < 0) lo = 0; int hi2 = 4 * s + 3; if (hi2 > 254) hi2 = 254;
        float v = 0.f;
        for (int h2 = 0; h2 < 4; ++h2) for (int j = lo; j <= hi2; ++j) v += sc[h2][j];
        if (s == 0 || s == cur || s == cur - 1) v += 1000.0f;
        if (s > cur) v = -1e30f;
        impv[s] = v;
    }
    __syncthreads();
    if (tid < 64) {
        const float v = impv[tid]; int rank = 0;
        for (int s2 = 0; s2 < 64; ++s2) { const float u = impv[s2]; rank += (u > v || (u == v && s2 < tid)) ? 1 : 0; }
        selflag[tid] = (rank < 16 && tid <= cur) ? 1 : 0;
    }
    __syncthreads();
    if (tid == 0) { int n = 0; for (int s = 0; s < 64; ++s) if (selflag[s]) { if (n < 16) sellist[n] = s; ++n; } nsel_s = n < 16 ? n : 16; }
    __syncthreads();
    const int ns = nsel_s, ne = ns * 64;
    for (int e = tid; e < ne; e += 256) {
        const int kpos = sellist[e >> 6] * 64 + (e & 63);
        if (kpos <= t) {
            const bf16_t* kp = KVb + (size_t)(b * SEQ + kpos) * 512 + 256 + g * 64;
            float s0 = 0.f, s1 = 0.f, s2 = 0.f, s3 = 0.f;
    #pragma unroll 8
        for (int dd = 0; dd < 64; ++dd) { const float kx = bf2f(kp[dd]); s0 += q[0][dd] * kx; s1 += q[1][dd] * kx; s2 += q[2][dd] * kx; s3 += q[3][dd] * kx; }
            sc[0][e] = s0; sc[1][e] = s1; sc[2][e] = s2; sc[3][e] = s3;
        } else { sc[0][e] = -1e30f; sc[1][e] = -1e30f; sc[2][e] = -1e30f; sc[3][e] = -1e30f; }
    }
    __syncthreads();
    softmax_row(sc[hh], ne, lane);
    __syncthreads();
    float o_sel = 0.f;
    for (int e = 0; e < ne; ++e) {
        const int kpos = sellist[e >> 6] * 64 + (e & 63);
        o_sel += sc[hh][e] * bf2f(VT[((size_t)(b * 2 + g) * 64 + (kpos >> 6)) * 4096 + d * 64 + (kpos & 63)]);
    }
    __syncthreads();
    const int nw = (t + 1 < 512) ? (t + 1) : 512, w0 = t - nw + 1;
    for (int e = tid; e < nw; e += 256) {
        const bf16_t* kp = KVb + (size_t)(b * SEQ + w0 + e) * 512 + 384 + g * 64;
        float s0 = 0.f, s1 = 0.f, s2 = 0.f, s3 = 0.f;
#pragma unroll 8
        for (int dd = 0; dd < 64; ++dd) { const float kx = bf2f(kp[dd]); s0 += q[0][dd] * kx; s1 += q[1][dd] * kx; s2 += q[2][dd] * kx; s3 += q[3][dd] * kx; }
        sc[0][e] = s0; sc[1][e] = s1; sc[2][e] = s2; sc[3][e] = s3;
    }
    __syncthreads();
    softmax_row(sc[hh], nw, lane);
    __syncthreads();
    float o_win = 0.f;
    for (int e = 0; e < nw; ++e) { const int kpos = w0 + e; o_win += sc[hh][e] * bf2f(VT[((size_t)(8 + b * 2 + g) * 64 + (kpos >> 6)) * 4096 + d * 64 + (kpos & 63)]); }
    const float* gt = gates + (size_t)tok * 24 + (g * 4 + hh) * 3;
    Y[(size_t)tok * DM + (g * 4 + hh) * 64 + d] = f2bf(gt[0] * o_cmp + gt[1] * o_sel + gt[2] * o_win);
}

DI void conv_silu(int bx, int tid, const bf16_t* __restrict__ MQK, const float* __restrict__ wc, const float* __restrict__ bc, bf16_t* __restrict__ out) {
    const int idx = bx * 256 + tid;
    if (idx >= T_TOK * 1024) return;
    const int c = idx & 1023, tok = idx >> 10, t = tok & 4095;
    float y = bc[c];
#pragma unroll
    for (int j = 0; j < 4; ++j) { const int tt = t - 3 + j; if (tt >= 0) y += wc[j * 1024 + c] * bf2f(MQK[(size_t)(tok - 3 + j) * 1024 + c]); }
    y = y * sigmoidf_(y);
    if (c >= 512) y *= 0.08838834764831845f;
    out[idx] = f2bf(y);
}

DI void mlstm_naive(int bx, int tid, char* sm, const bf16_t* __restrict__ qkc, const bf16_t* __restrict__ MV, const bf16_t* __restrict__ MO, const float* __restrict__ ifp, float* __restrict__ hm) {
    float (*qs)[128] = (float (*)[128])sm;
    float (*ks)[128] = (float (*)[128])(sm + 16384);
    float (*vs)[16] = (float (*)[16])(sm + 32768);
    float (*os)[16] = (float (*)[16])(sm + 32768 + 2048);
    float* gi = (float*)(sm + 32768 + 4096); float* gf = gi + 32;
    const int bh = bx >> 3, vsl = bx & 7, b = bh >> 2, h = bh & 3, v = tid >> 4, kg = tid & 15;
    float C[8], n[8];
#pragma unroll
    for (int j = 0; j < 8; ++j) { C[j] = 0.f; n[j] = 0.f; }
    for (int c0 = 0; c0 < SEQ; c0 += 32) {
        __syncthreads();
        for (int e = tid; e < 32 * 128; e += 256) {
            const int s = e >> 7, k = e & 127; const size_t tok = (size_t)b * SEQ + c0 + s;
            qs[s][k] = bf2f(qkc[tok * 1024 + h * 128 + k]); ks[s][k] = bf2f(qkc[tok * 1024 + 512 + h * 128 + k]);
        }
        for (int e = tid; e < 32 * 16; e += 256) {
            const int s = e >> 4, vv = e & 15; const size_t tok = (size_t)b * SEQ + c0 + s;
            vs[s][vv] = bf2f(MV[tok * 512 + h * 128 + vsl * 16 + vv]);
            os[s][vv] = sigmoidf_(bf2f(MO[tok * 512 + h * 128 + vsl * 16 + vv]));
        }
        if (tid < 32) { const size_t tok = (size_t)b * SEQ + c0 + tid; gi[tid] = __expf(ifp[tok * 8 + h]); gf[tid] = sigmoidf_(ifp[tok * 8 + 4 + h]); }
        __syncthreads();
        for (int s = 0; s < 32; ++s) {
            const float f = gf[s], iv = gi[s] * vs[s][v], ig = gi[s];
            float num = 0.f, den = 0.f;
#pragma unroll
            for (int j = 0; j < 8; ++j) {
                const float kx = ks[s][kg * 8 + j], qx = qs[s][kg * 8 + j];
                C[j] = f * C[j] + iv * kx; n[j] = f * n[j] + ig * kx;
                num += C[j] * qx; den += n[j] * qx;
            }
            const int l_ = lane_id_opaque();
#pragma unroll
            for (int o = 1; o < 16; o <<= 1) { num += lane_xor(num, o, l_); den += lane_xor(den, o, l_); }
            if (kg == 0) hm[((size_t)b * SEQ + c0 + s) * 512 + h * 128 + vsl * 16 + v] = num / fmaxf(fabsf(den), 1.0f) * os[s][v];
        }
    }
}

DI void hnorm(int bx, int tid, const float* __restrict__ hm, const float* __restrict__ g_hn, bf16_t* __restrict__ Y) {
    const int item = bx * 4 + (tid >> 6), lane = tid & 63;
    const int tok = item >> 2, h = item & 3;
    const float a = hm[(size_t)tok * 512 + h * 128 + lane], b = hm[(size_t)tok * 512 + h * 128 + 64 + lane];
    const float rstd = rsqrtf(wave_sum(a * a + b * b) * (1.f / 128.f) + 1e-6f);
    Y[(size_t)tok * DM + 512 + h * 128 + lane] = f2bf(a * rstd * g_hn[h * 128 + lane]);
    Y[(size_t)tok * DM + 512 + h * 128 + 64 + lane] = f2bf(b * rstd * g_hn[h * 128 + 64 + lane]);
}

DI void router(int bx, int tid, const float* __restrict__ x, const float* __restrict__ g, const float* __restrict__ w_rg, const float* __restrict__ b_rg,
                                              const float* __restrict__ w_re, const float* __restrict__ b_re, bf16_t* __restrict__ xn, float* __restrict__ gate) {
    const int tok = bx * 4 + (tid >> 6), lane = tid & 63;
    float xv[16]; float s = 0.f;
#pragma unroll
    for (int j = 0; j < 4; ++j) { const float4 v = ((const float4*)(x + (size_t)tok * DM))[lane + 64 * j]; xv[4 * j] = v.x; xv[4 * j + 1] = v.y; xv[4 * j + 2] = v.z; xv[4 * j + 3] = v.w; s += v.x * v.x + v.y * v.y + v.z * v.z + v.w * v.w; }
    const float rstd = rsqrtf(wave_sum(s) * (1.f / DM) + 1e-6f);
#pragma unroll
    for (int j = 0; j < 4; ++j) { const float4 gg = ((const float4*)g)[lane + 64 * j]; xv[4 * j] *= rstd * gg.x; xv[4 * j + 1] *= rstd * gg.y; xv[4 * j + 2] *= rstd * gg.z; xv[4 * j + 3] *= rstd * gg.w;
        ushort4 o; o.x = f2bf(xv[4 * j]); o.y = f2bf(xv[4 * j + 1]); o.z = f2bf(xv[4 * j + 2]); o.w = f2bf(xv[4 * j + 3]); ((ushort4*)(xn + (size_t)tok * DM))[lane + 64 * j] = o; }
    float mylog = 0.f;
#pragma unroll 1
    for (int c = 0; c < 20; ++c) {
        const float* w = c < 4 ? w_rg + c : w_re + (c - 4); const int ld = c < 4 ? 4 : 16;
        float a = 0.f;
#pragma unroll
        for (int j = 0; j < 4; ++j)
#pragma unroll
            for (int i = 0; i < 4; ++i) a += xv[4 * j + i] * w[(size_t)(4 * (lane + 64 * j) + i) * ld];
        a = wave_sum(a) + (c < 4 ? b_rg[c] : b_re[c - 4]);
        if (lane == c) mylog = a;
    }
    float gl[4], el[16];
#pragma unroll
    for (int c = 0; c < 4; ++c) gl[c] = lane_get(mylog, c);
#pragma unroll
    for (int c = 0; c < 16; ++c) el[c] = lane_get(mylog, 4 + c);
    if (lane == 0) {
        int gs = 0; float gm = gl[0];
#pragma unroll
        for (int c = 1; c < 4; ++c) if (gl[c] > gm) { gm = gl[c]; gs = c; }
        float se = 0.f;
#pragma unroll
        for (int c = 0; c < 4; ++c) se += __expf(gl[c] - gm);
        const float pg = 1.f / se;
        float e4[4];
#pragma unroll
        for (int c = 0; c < 4; ++c) e4[c] = gs == 0 ? el[c] : gs == 1 ? el[4 + c] : gs == 2 ? el[8 + c] : el[12 + c];
        int i0 = 0; float v0 = e4[0];
#pragma unroll
        for (int c = 1; c < 4; ++c) if (e4[c] > v0) { v0 = e4[c]; i0 = c; }
        int i1 = -1; float v1 = -3.0e38f;
#pragma unroll
        for (int c = 0; c < 4; ++c) if (c != i0 && e4[c] > v1) { v1 = e4[c]; i1 = c; }
        const float ex = __expf(v1 - v0);
        const float w0 = pg / (1.f + ex), w1 = pg * ex / (1.f + ex);
#pragma unroll
        for (int c = 0; c < 16; ++c) gate[(size_t)tok * 16 + c] = (c == gs * 4 + i0) ? w0 : (c == gs * 4 + i1) ? w1 : 0.f;
    }
}


struct EpiMoe { static constexpr bool PAIR = true;
    const float* gate; bf16_t* act;
    DI void operator()(int, int, float) const {}
    DI void pair(int row, int col, float gg, float u) const {
        const int t = col >> 7, c = col & 127, e = t >> 2, jt = t & 3, f = jt * 64 + (c >> 6) * 32 + (c & 31);
        act[(size_t)row * 4096 + e * 256 + f] = f2bf(gg * sigmoidf_(gg) * u * gate[(size_t)row * 16 + e]);
    }
};

typedef float f32x2_t __attribute__((ext_vector_type(2))); typedef __bf16 bf16x2_t __attribute__((ext_vector_type(2)));
DI unsigned cvtpk(float lo, float hi) { f32x2_t v = {lo, hi}; bf16x2_t b = __builtin_convertvector(v, bf16x2_t); return __builtin_bit_cast(unsigned, b); }
typedef __attribute__((address_space(3))) char lds_c;
typedef unsigned u32x2v __attribute__((ext_vector_type(2))); typedef unsigned u32x4v __attribute__((ext_vector_type(4)));
constexpr int NSA_KC = 0, NSA_VC = 4 * 9216, NSA_KB = NSA_VC + 4 * 8704, NSA_VB = NSA_KB + 2 * 9216, NSA_IMP = NSA_VB + 2 * 8704, NSA_MASK = NSA_IMP + 64 * 65 * 4, NSA_END = NSA_MASK + 512;
static_assert(NSA_END <= 147456, "NSA LDS map");
DI int crow(int r, int hi) { return (r & 3) + 8 * (r >> 2) + 4 * hi; }
#define MFMA32(a, b, c) __builtin_amdgcn_mfma_f32_32x32x16_bf16((a), (b), (c), 0, 0, 0)

DI void nsa_qk(f32x16& p0, f32x16& p1, const lds_c* K, const bf16x8 (&qf)[4], int r32, int hi) {
#pragma unroll
    for (int r = 0; r < 16; ++r) { p0[r] = 0.f; p1[r] = 0.f; }
#pragma unroll
    for (int ks = 0; ks < 4; ++ks) {
        const bf16x8 a0 = *(const __attribute__((address_space(3))) bf16x8*)(K + r32 * 144 + ks * 32 + hi * 16);
        const bf16x8 a1 = *(const __attribute__((address_space(3))) bf16x8*)(K + (32 + r32) * 144 + ks * 32 + hi * 16);
        p0 = MFMA32(a0, qf[ks], p0); p1 = MFMA32(a1, qf[ks], p1);
    }
}
DI void nsa_softmax(f32x16& p0, f32x16& p1, float& m, float& l, f32x16& o0, f32x16& o1) {
    float mx = fmaxf(p0[0], p1[0]);
#pragma unroll
    for (int r = 1; r < 16; ++r) mx = fmaxf(mx, fmaxf(p0[r], p1[r]));
    { auto rr = __builtin_amdgcn_permlane32_swap(__float_as_uint(mx), __float_as_uint(mx), false, false); mx = fmaxf(__uint_as_float(rr[0]), __uint_as_float(rr[1])); }
    const float mn = fmaxf(m, mx), alpha = __builtin_amdgcn_exp2f(m - mn);
    m = mn;
    float s = 0.f;
#pragma unroll
    for (int r = 0; r < 16; ++r) { p0[r] = __builtin_amdgcn_exp2f(p0[r] - mn); p1[r] = __builtin_amdgcn_exp2f(p1[r] - mn); s += p0[r] + p1[r]; }
    l = l * alpha + s;
#pragma unroll
    for (int r = 0; r < 16; ++r) { o0[r] *= alpha; o1[r] *= alpha; }
}
DI void nsa_pv(f32x16& o0, f32x16& o1, const f32x16& p0, const f32x16& p1, const lds_c* V, int r32, int hi) {
#pragma unroll
    for (int hf = 0; hf < 2; ++hf)
#pragma unroll
        for (int s = 0; s < 2; ++s) {
            unsigned pw[4];
#pragma unroll
            for (int j = 0; j < 4; ++j) pw[j] = hf ? cvtpk(p1[8 * s + 2 * j], p1[8 * s + 2 * j + 1]) : cvtpk(p0[8 * s + 2 * j], p0[8 * s + 2 * j + 1]);
            const u32x4v pbw = {pw[0], pw[1], pw[2], pw[3]};
            const bf16x8 pb = __builtin_bit_cast(bf16x8, pbw);
            const lds_c* vp = V + r32 * 136 + hf * 64 + s * 32 + hi * 8;
            const u32x2v a0l = *(const __attribute__((address_space(3))) u32x2v*)(vp), a0h = *(const __attribute__((address_space(3))) u32x2v*)(vp + 16);
            const u32x2v a1l = *(const __attribute__((address_space(3))) u32x2v*)(vp + 32 * 136), a1h = *(const __attribute__((address_space(3))) u32x2v*)(vp + 32 * 136 + 16);
            const u32x4v A0w = {a0l.x, a0l.y, a0h.x, a0h.y}, A1w = {a1l.x, a1l.y, a1h.x, a1h.y};
            o0 = MFMA32(__builtin_bit_cast(bf16x8, A0w), pb, o0); o1 = MFMA32(__builtin_bit_cast(bf16x8, A1w), pb, o1);
        }
}
DI void nsa_store_k(lds_c* K, const u32x4v v, int tid) { *(__attribute__((address_space(3))) u32x4v*)(K + (tid >> 3) * 144 + (tid & 7) * 16) = v; }
DI void nsa_store_v(lds_c* V, const u32x4v v, int tid) { lds_c* p = V + (tid >> 3) * 136 + (tid & 7) * 16; *(__attribute__((address_space(3))) u32x2v*)p = (u32x2v){v.x, v.y}; *(__attribute__((address_space(3))) u32x2v*)(p + 8) = (u32x2v){v.z, v.w}; }
#define NEG_INF (-__builtin_inff())
DI void nsa_finish(f32x16& y0, f32x16& y1, f32x16& o0, f32x16& o1, float& m, float& l, float gate) {
    float lt; { auto rr = __builtin_amdgcn_permlane32_swap(__float_as_uint(l), __float_as_uint(l), false, false); lt = __uint_as_float(rr[0]) + __uint_as_float(rr[1]); }
    const float f = lt > 0.f ? gate / lt : 0.f;
#pragma unroll
    for (int r = 0; r < 16; ++r) { y0[r] += f * o0[r]; y1[r] += f * o1[r]; o0[r] = 0.f; o1[r] = 0.f; }
    m = -1e30f; l = 0.f;
}

DI void nsa_unit(int bg, int qb, int tx, lds_c* lds, const bf16_t* __restrict__ Qb, const bf16_t* __restrict__ KVb, const bf16_t* __restrict__ VT, const bf16_t* __restrict__ kcb, const bf16_t* __restrict__ vcT,
                 const float* __restrict__ gates, bf16_t* __restrict__ Y) {
    const int lane = tx & 63, r32 = lane & 31, hi = lane >> 5, wave = __builtin_amdgcn_readfirstlane(tx >> 6), hh = wave >> 1, qs = wave & 1;
    const int b = bg >> 1, g = bg & 1, ql = 32 * qs + r32, tq = 64 * qb + ql;
    const size_t tok = (size_t)b * SEQ + tq; const int head = g * 4 + hh;
    const int nc = (4 * qb + 66) >> 6;
    const bool need_topk = qb >= 16;
    lds_c* KC = lds + NSA_KC; lds_c* VC = lds + NSA_VC; lds_c* KB = lds + NSA_KB; lds_c* VB = lds + NSA_VB;
    __attribute__((address_space(3))) float* imp = (__attribute__((address_space(3))) float*)(lds + NSA_IMP);
    __attribute__((address_space(3))) unsigned* msk = (__attribute__((address_space(3))) unsigned*)(lds + NSA_MASK);
    const bf16_t* kcsrc = kcb + (size_t)bg * 256 * 64; const bf16_t* vcsrc = vcT + (size_t)bg * 4 * 4096;
    const bf16_t* kssrc = KVb + (size_t)b * SEQ * 512 + 256 + g * 64; const bf16_t* kwsrc = KVb + (size_t)b * SEQ * 512 + 384 + g * 64;
    const bf16_t* vssrc = VT + (size_t)bg * 64 * 4096; const bf16_t* vwsrc = VT + (size_t)(8 + bg) * 64 * 4096;
    const int n_sel = qb + 1, n_win = qb + 1 < 9 ? qb + 1 : 9, ntile = n_sel + n_win;
    __syncthreads();
    for (int c = 0; c < nc; ++c) {
        nsa_store_k(KC + c * 9216, *(const u32x4v*)(kcsrc + (size_t)(c * 64 + (tx >> 3)) * 64 + (tx & 7) * 8), tx);
        nsa_store_v(VC + c * 8704, *(const u32x4v*)(vcsrc + (size_t)c * 4096 + (tx >> 3) * 64 + (tx & 7) * 8), tx);
    }
    nsa_store_k(KB, *(const u32x4v*)(kssrc + (size_t)(tx >> 3) * 512 + (tx & 7) * 8), tx);
    nsa_store_v(VB, *(const u32x4v*)(vssrc + (tx >> 3) * 64 + (tx & 7) * 8), tx);
    for (int i = tx; i < 64 * 65; i += 512) imp[i] = 0.f;
    bf16x8 qf[4];
#pragma unroll
    for (int ks = 0; ks < 4; ++ks) qf[ks] = *(const bf16x8*)(Qb + tok * 512 + head * 64 + ks * 16 + hi * 8);
    const float g_cmp = gates[tok * 24 + head * 3 + 0], g_sel = gates[tok * 24 + head * 3 + 1], g_win = gates[tok * 24 + head * 3 + 2];
    f32x16 y0, y1, o0, o1, p0, p1;
#pragma unroll
    for (int r = 0; r < 16; ++r) { y0[r] = 0.f; y1[r] = 0.f; o0[r] = 0.f; o1[r] = 0.f; }
    float m = -1e30f, l = 0.f;
    __syncthreads();
    const int nvq = tq >= 31 ? ((tq - 15) >> 4) : 0;
    for (int c = 0; c < nc; ++c) {
        nsa_qk(p0, p1, KC + c * 9216, qf, r32, hi);
        const int lim = nvq - 64 * c;
#pragma unroll
        for (int r = 0; r < 16; ++r) { const int kl = crow(r, hi); if (kl >= lim) p0[r] = NEG_INF; if (kl + 32 >= lim) p1[r] = NEG_INF; }
        nsa_softmax(p0, p1, m, l, o0, o1);
        nsa_pv(o0, o1, p0, p1, VC + c * 8704, r32, hi);
    }
    const float m_c = m; float l_c; { auto rr = __builtin_amdgcn_permlane32_swap(__float_as_uint(l), __float_as_uint(l), false, false); l_c = __uint_as_float(rr[0]) + __uint_as_float(rr[1]); }
    nsa_finish(y0, y1, o0, o1, m, l, g_cmp);
    unsigned mlo = 0xffffffffu, mhi = 0xffffffffu;
    if (need_topk) {
        const float invl = l_c > 0.f ? 1.f / l_c : 0.f;
        for (int c = 0; c < nc; ++c) {
            nsa_qk(p0, p1, KC + c * 9216, qf, r32, hi);
            const int lim = nvq - 64 * c;
#pragma unroll
            for (int r = 0; r < 16; ++r) { const int kl = crow(r, hi);
                p0[r] = kl < lim ? __builtin_amdgcn_exp2f(p0[r] - m_c) * invl : 0.f; p1[r] = kl + 32 < lim ? __builtin_amdgcn_exp2f(p1[r] - m_c) * invl : 0.f; }
            for (int h = 0; h < 4; ++h) {
                if (hh == h) {
#pragma unroll
                    for (int hf = 0; hf < 2; ++hf)
#pragma unroll
                        for (int i = 0; i < 4; ++i) {
                            const int a = 16 * c + 8 * hf + 2 * i + hi;
                            const float gsum = hf ? (p1[4 * i] + p1[4 * i + 1]) + (p1[4 * i + 2] + p1[4 * i + 3]) : (p0[4 * i] + p0[4 * i + 1]) + (p0[4 * i + 2] + p0[4 * i + 3]);
                            imp[ql * 65 + a] += gsum;
                        }
                    asm volatile("s_waitcnt lgkmcnt(0)" ::: "memory");
#pragma unroll
                    for (int hf = 0; hf < 2; ++hf)
#pragma unroll
                        for (int i = 0; i < 4; ++i) {
                            const int a = 16 * c + 8 * hf + 2 * i + hi;
                            const float last = hf ? p1[4 * i + 3] : p0[4 * i + 3];
                            if (a + 1 < 64) imp[ql * 65 + a + 1] += last;
                        }
                }
                __syncthreads();
            }
        }
        {
            const int q = tx >> 3, j8 = tx & 7, smax = qb - 2;
            unsigned blo = 0u, bhi = 0u;
#pragma unroll 1
            for (int k = 0; k < 8; ++k) {
                const int s = j8 + 8 * k;
                if (s >= 1 && s <= smax) {
                    const float v = imp[q * 65 + s]; int rank = 0;
                    for (int s2 = 1; s2 <= smax; ++s2) { const float u = imp[q * 65 + s2]; rank += (u > v || (u == v && s2 < s)) ? 1 : 0; }
                    if (rank < 13) { if (s < 32) blo |= 1u << s; else bhi |= 1u << (s - 32); }
                }
            }
            const int l_ = lane_id_opaque();
#pragma unroll
            for (int o = 1; o < 8; o <<= 1) { blo |= (unsigned)__builtin_amdgcn_ds_bpermute((l_ ^ o) << 2, (int)blo); bhi |= (unsigned)__builtin_amdgcn_ds_bpermute((l_ ^ o) << 2, (int)bhi); }
            unsigned long long mm = ((unsigned long long)bhi << 32) | blo;
            mm |= 1ull | (1ull << qb) | (1ull << (qb - 1));
            if (j8 == 0) { msk[q * 2] = (unsigned)mm; msk[q * 2 + 1] = (unsigned)(mm >> 32); }
        }
        __syncthreads();
        mlo = msk[ql * 2]; mhi = msk[ql * 2 + 1];
    }
    for (int i = 0; i < ntile; ++i) {
        const int cur = i & 1;
        const bool is_sel = i < n_sel; const int s = is_sel ? i : qb - n_win + 1 + (i - n_sel);
        u32x4v kreg = {0u, 0u, 0u, 0u}, vreg = {0u, 0u, 0u, 0u};
        if (i + 1 < ntile) {
            const bool nsel = i + 1 < n_sel; const int s2 = nsel ? i + 1 : qb - n_win + 1 + (i + 1 - n_sel);
            kreg = *(const u32x4v*)((nsel ? kssrc : kwsrc) + (size_t)(s2 * 64 + (tx >> 3)) * 512 + (tx & 7) * 8);
            vreg = *(const u32x4v*)((nsel ? vssrc : vwsrc) + (size_t)s2 * 4096 + (tx >> 3) * 64 + (tx & 7) * 8);
        }
        nsa_qk(p0, p1, KB + cur * 9216, qf, r32, hi);
        if (is_sel) {
            const bool on = ((s < 32 ? (mlo >> s) : (mhi >> (s - 32))) & 1u) != 0u;
#pragma unroll
            for (int r = 0; r < 16; ++r) { const int kl = crow(r, hi); if (!on || (s == qb && kl > ql)) p0[r] = NEG_INF; if (!on || (s == qb && kl + 32 > ql)) p1[r] = NEG_INF; }
        } else {
            const bool lowb = (qb >= 8) && (s == qb - 8), diag = (s == qb);
#pragma unroll
            for (int r = 0; r < 16; ++r) { const int kl = crow(r, hi);
                if ((lowb && kl <= ql) || (diag && kl > ql)) p0[r] = NEG_INF; if ((lowb && kl + 32 <= ql) || (diag && kl + 32 > ql)) p1[r] = NEG_INF; }
        }
        nsa_softmax(p0, p1, m, l, o0, o1);
        nsa_pv(o0, o1, p0, p1, VB + cur * 8704, r32, hi);
        if (i == n_sel - 1) nsa_finish(y0, y1, o0, o1, m, l, g_sel);
        if (i == ntile - 1) nsa_finish(y0, y1, o0, o1, m, l, g_win);
        if (i + 1 < ntile) { nsa_store_k(KB + (cur ^ 1) * 9216, kreg, tx); nsa_store_v(VB + (cur ^ 1) * 8704, vreg, tx); }
        __syncthreads();
    }
    bf16_t* yp = Y + tok * DM + head * 64;
#pragma unroll
    for (int i = 0; i < 4; ++i) {
        *(uint2*)(yp + 8 * i + 4 * hi) = make_uint2(cvtpk(y0[4 * i], y0[4 * i + 1]), cvtpk(y0[4 * i + 2], y0[4 * i + 3]));
        *(uint2*)(yp + 32 + 8 * i + 4 * hi) = make_uint2(cvtpk(y1[4 * i], y1[4 * i + 1]), cvtpk(y1[4 * i + 2], y1[4 * i + 3]));
    }
}

DI float log_sigmoid_(float x) { return x >= 0.f ? -__logf(1.f + __expf(-x)) : x - __logf(1.f + __expf(x)); }
DI float lane_shr_add(float v, int l) {
#pragma unroll
    for (int o = 1; o < 64; o <<= 1) { const float t = lane_get(v, l - o); if (l >= o) v += t; }
    return v;
}
DI float lane_shr_max(float v, int l) {
#pragma unroll
    for (int o = 1; o < 64; o <<= 1) { const float t = lane_get(v, l - o); if (l >= o) v = fmaxf(v, t); }
    return v;
}
DI float log_sigmoid_fast(float x) { return -__logf(1.f + __expf(-x)); }
DI void ml_mscan_all(const float* __restrict__ ifp, int bh, int lane, float* __restrict__ mtab) {
    const int b = bh >> 2, h = bh & 3;
    const float* gp = ifp + ((size_t)b * SEQ + 64 * lane) * 8 + h;
    float L = 0.f, mx = -3.0e38f;
#pragma unroll 16
    for (int s = 0; s < 64; ++s) { const float iv = gp[s * 8], fv = gp[s * 8 + 4]; L += log_sigmoid_fast(fv); mx = fmaxf(mx, iv - L); }
    const float G = L + mx;
    float m = 0.f, mine = 0.f;
#pragma unroll
    for (int k = 0; k < 64; ++k) {
        const float Lk = __builtin_bit_cast(float, __builtin_amdgcn_readlane(__builtin_bit_cast(int, L), k)), Gk = __builtin_bit_cast(float, __builtin_amdgcn_readlane(__builtin_bit_cast(int, G), k));
        if (k == lane) mine = m;
        m = fmaxf(Lk + m, Gk);
    }
    mtab[bh * 65 + lane] = mine;
    if (lane == 63) mtab[bh * 65 + 64] = m;
}
DI void ml_conv8(float (&o)[8], const bf16_t* __restrict__ MQK, size_t tok, int t_in_seq, int col, const float* __restrict__ wc, const float* __restrict__ bc, float scale) {
    const float4 b0 = *(const float4*)(bc + col), b1 = *(const float4*)(bc + col + 4);
    o[0] = b0.x; o[1] = b0.y; o[2] = b0.z; o[3] = b0.w; o[4] = b1.x; o[5] = b1.y; o[6] = b1.z; o[7] = b1.w;
#pragma unroll
    for (int j = 0; j < 4; ++j) {
        if (t_in_seq - 3 + j >= 0) {
            float u[8]; unpack8(*(const pg8::u32x4*)(MQK + (tok - 3 + j) * 1024 + col), u);
            const float4 w0 = *(const float4*)(wc + j * 1024 + col), w1 = *(const float4*)(wc + j * 1024 + col + 4);
            o[0] += w0.x * u[0]; o[1] += w0.y * u[1]; o[2] += w0.z * u[2]; o[3] += w0.w * u[3]; o[4] += w1.x * u[4]; o[5] += w1.y * u[5]; o[6] += w1.z * u[6]; o[7] += w1.w * u[7];
        }
    }
#pragma unroll
    for (int i = 0; i < 8; ++i) o[i] = o[i] * sigmoidf_(o[i]) * scale;
}
constexpr float ML_KSCALE = 0.08838834764831845f;
DI void ml_unit_c(int bh, int c, int tx, lds_c* lds, const bf16_t* __restrict__ MQK, const bf16_t* __restrict__ MV, const float* __restrict__ ifp, const float* __restrict__ wc, const float* __restrict__ bc,
                  bf16_t* __restrict__ dC, float* __restrict__ dn, float* __restrict__ wprev, const float* __restrict__ mtab) {
    const int b = bh >> 2, h = bh & 3, lane = tx & 63, r32 = lane & 31, hi = lane >> 5, wave = __builtin_amdgcn_readfirstlane(tx >> 6);
    lds_c* KT = lds; lds_c* VTw = lds + 128 * 144;
    __attribute__((address_space(3))) float* wsm = (__attribute__((address_space(3))) float*)(lds + 2 * 128 * 144);
    const size_t tok0 = (size_t)b * SEQ + 64 * c;
    __syncthreads();
    if (wave == 0) {
        const float m_c = mtab[bh * 65 + c], m_n = mtab[bh * 65 + c + 1];
        const float iv = ifp[(tok0 + lane) * 8 + h], lf = log_sigmoid_(ifp[(tok0 + lane) * 8 + 4 + h]);
        const int l_ = lane_id_opaque();
        const float bc_ = lane_shr_add(lf, l_), Lc = lane_get(bc_, 63);
        wsm[lane] = __expf(Lc - bc_ + iv - m_n);
        if (lane == 0) wprev[bh * 64 + c] = __expf(Lc + m_c - m_n);
    }
    __syncthreads();
#pragma unroll 1
    for (int it = tx; it < 1024; it += 512) {
        const int s = it >> 4, d0 = (it & 15) * 8; float kv[8];
        ml_conv8(kv, MQK, tok0 + s, 64 * c + s, 512 + h * 128 + d0, wc, bc, ML_KSCALE);
        float vv[8]; unpack8(*(const pg8::u32x4*)(MV + (tok0 + s) * 512 + h * 128 + d0), vv);
        const float w = wsm[s];
#pragma unroll
        for (int i = 0; i < 8; ++i) {
            *(__attribute__((address_space(3))) bf16_t*)(KT + (d0 + i) * 144 + s * 2) = f2bf(kv[i]);
            *(__attribute__((address_space(3))) bf16_t*)(VTw + (d0 + i) * 144 + s * 2) = f2bf(vv[i] * w);
        }
    }
    __syncthreads();
    if (tx < 128) {
        float a = 0.f;
        for (int s = 0; s < 64; ++s) a += wsm[s] * bf2f(*(const __attribute__((address_space(3))) bf16_t*)(KT + tx * 144 + s * 2));
        dn[((size_t)bh * 64 + c) * 128 + tx] = a;
    }
    {
        const int vb = wave >> 1, kh = wave & 1;
        f32x16 acc0, acc1;
#pragma unroll
        for (int r = 0; r < 16; ++r) { acc0[r] = 0.f; acc1[r] = 0.f; }
#pragma unroll
        for (int ks = 0; ks < 4; ++ks) {
            const bf16x8 a = *(const __attribute__((address_space(3))) bf16x8*)(VTw + (vb * 32 + r32) * 144 + ks * 32 + hi * 16);
            const bf16x8 b0 = *(const __attribute__((address_space(3))) bf16x8*)(KT + (kh * 64 + r32) * 144 + ks * 32 + hi * 16);
            const bf16x8 b1 = *(const __attribute__((address_space(3))) bf16x8*)(KT + (kh * 64 + 32 + r32) * 144 + ks * 32 + hi * 16);
            acc0 = MFMA32(a, b0, acc0); acc1 = MFMA32(a, b1, acc1);
        }
        bf16_t* o = dC + ((size_t)bh * 64 + c) * 16384;
#pragma unroll
        for (int r = 0; r < 16; ++r) { const int v = vb * 32 + crow(r, hi);
            o[v * 128 + kh * 64 + r32] = f2bf(acc0[r]); o[v * 128 + kh * 64 + 32 + r32] = f2bf(acc1[r]); }
    }
}
DI void ml_scan(int gtid, int nthreads, bf16_t* __restrict__ dC, float* __restrict__ dn, const float* __restrict__ wprev) {
    for (int p = gtid; p < 16 * 8192; p += nthreads) {
        const int bh = p >> 13, e2 = p & 8191;
        unsigned* base = (unsigned*)(dC + (size_t)bh * 64 * 16384) + e2;
        float r0 = 0.f, r1 = 0.f;
#pragma unroll 1
        for (int c0 = 0; c0 < 64; c0 += 16) {
            unsigned v[16];
#pragma unroll
            for (int j = 0; j < 16; ++j) v[j] = base[(size_t)(c0 + j) * 8192];
#pragma unroll
            for (int j = 0; j < 16; ++j) {
                const float w = wprev[bh * 64 + c0 + j];
                base[(size_t)(c0 + j) * 8192] = pk2(r0, r1);
                r0 = w * r0 + __uint_as_float(v[j] << 16); r1 = w * r1 + __uint_as_float(v[j] & 0xffff0000u);
            }
        }
    }
    for (int p = gtid; p < 16 * 128; p += nthreads) {
        const int bh = p >> 7, k = p & 127; float r = 0.f; float* q = dn + (size_t)bh * 64 * 128 + k;
#pragma unroll 1
        for (int c0 = 0; c0 < 64; c0 += 16) {
            float v[16];
#pragma unroll
            for (int j = 0; j < 16; ++j) v[j] = q[(c0 + j) * 128];
#pragma unroll
            for (int j = 0; j < 16; ++j) { q[(c0 + j) * 128] = r; r = wprev[bh * 64 + c0 + j] * r + v[j]; }
        }
    }
}
DI void ml_unit_e(int bh, int c, int tx, lds_c* lds, const bf16_t* __restrict__ MQK, const bf16_t* __restrict__ MV, const bf16_t* __restrict__ MO, const float* __restrict__ ifp,
                  const float* __restrict__ wc, const float* __restrict__ bc, const bf16_t* __restrict__ Sst, const float* __restrict__ nst, const float* __restrict__ mtab, const float* __restrict__ g_hn, bf16_t* __restrict__ Y) {
    const int b = bh >> 2, h = bh & 3, lane = tx & 63, r32 = lane & 31, hi = lane >> 5, wave = __builtin_amdgcn_readfirstlane(tx >> 6);
    lds_c* Qi = lds; lds_c* Ki = lds + 64 * 272; lds_c* VTi = lds + 2 * 64 * 272; lds_c* Si = VTi + 128 * 136;
    __attribute__((address_space(3))) float* fsm = (__attribute__((address_space(3))) float*)(Si + 128 * 272);
    const size_t tok0 = (size_t)b * SEQ + 64 * c;
    const float m_c = mtab[bh * 65 + c];
    __syncthreads();
    if (wave == 0) {
        const float iv = ifp[(tok0 + lane) * 8 + h], lf = log_sigmoid_(ifp[(tok0 + lane) * 8 + 4 + h]);
        const int l_ = lane_id_opaque();
        const float bc_ = lane_shr_add(lf, l_), u = iv - bc_, M = fmaxf(lane_shr_max(u, l_), m_c);
        fsm[lane] = u; fsm[64 + lane] = M; fsm[128 + lane] = __expf(-(bc_ + M));
    }
    if (wave == 1) { fsm[192 + lane] = nst[((size_t)bh * 64 + c) * 128 + lane]; fsm[192 + 64 + lane] = nst[((size_t)bh * 64 + c) * 128 + 64 + lane]; }
#pragma unroll 1
    for (int it = tx; it < 1024; it += 512) {
        const int s = it >> 4, d0 = (it & 15) * 8; float qv[8], kv[8];
        ml_conv8(qv, MQK, tok0 + s, 64 * c + s, h * 128 + d0, wc, bc, 1.f);
        ml_conv8(kv, MQK, tok0 + s, 64 * c + s, 512 + h * 128 + d0, wc, bc, ML_KSCALE);
        *(__attribute__((address_space(3))) pg8::u32x4*)(Qi + s * 272 + d0 * 2) = pack8(qv);
        *(__attribute__((address_space(3))) pg8::u32x4*)(Ki + s * 272 + d0 * 2) = pack8(kv);
        const pg8::u32x4 vw = *(const pg8::u32x4*)(MV + (tok0 + s) * 512 + h * 128 + d0);
        __attribute__((address_space(3))) bf16_t* vt = (__attribute__((address_space(3))) bf16_t*)(VTi + d0 * 136 + s * 2);
        vt[0] = (bf16_t)(vw.x & 0xffffu); vt[68] = (bf16_t)(vw.x >> 16); vt[136] = (bf16_t)(vw.y & 0xffffu); vt[204] = (bf16_t)(vw.y >> 16);
        vt[272] = (bf16_t)(vw.z & 0xffffu); vt[340] = (bf16_t)(vw.z >> 16); vt[408] = (bf16_t)(vw.w & 0xffffu); vt[476] = (bf16_t)(vw.w >> 16);
    }
    {
        const bf16_t* src = Sst + ((size_t)bh * 64 + c) * 16384;
#pragma unroll
        for (int j = 0; j < 4; ++j) { const int ch = tx + 512 * j, v = ch >> 4, k8 = (ch & 15) * 8;
            *(__attribute__((address_space(3))) pg8::u32x4*)(Si + v * 272 + k8 * 2) = *(const pg8::u32x4*)(src + v * 128 + k8); }
    }
    __syncthreads();
    const int tb = wave & 1, vb = wave >> 1, t = tb * 32 + r32;
    bf16x8 qf[8];
#pragma unroll
    for (int ks = 0; ks < 8; ++ks) qf[ks] = *(const __attribute__((address_space(3))) bf16x8*)(Qi + t * 272 + ks * 32 + hi * 16);
    f32x16 a0, a1;
#pragma unroll
    for (int r = 0; r < 16; ++r) { a0[r] = 0.f; a1[r] = 0.f; }
#pragma unroll
    for (int ks = 0; ks < 8; ++ks) {
        const bf16x8 k0 = *(const __attribute__((address_space(3))) bf16x8*)(Ki + r32 * 272 + ks * 32 + hi * 16);
        const bf16x8 k1 = *(const __attribute__((address_space(3))) bf16x8*)(Ki + (32 + r32) * 272 + ks * 32 + hi * 16);
        a0 = MFMA32(k0, qf[ks], a0); a1 = MFMA32(k1, qf[ks], a1);
    }
    const float Mt = fsm[64 + t], dec = __expf(m_c - Mt);
    float rs = 0.f;
#pragma unroll
    for (int r = 0; r < 16; ++r) {
        const int s0 = crow(r, hi), s1 = 32 + s0;
        a0[r] = s0 <= t ? __expf(fsm[s0] - Mt) * a0[r] : 0.f; a1[r] = s1 <= t ? __expf(fsm[s1] - Mt) * a1[r] : 0.f;
        rs += a0[r] + a1[r];
    }
    float nq = 0.f;
#pragma unroll
    for (int ks = 0; ks < 8; ++ks) { float qv[8]; unpack8(__builtin_bit_cast(pg8::u32x4, qf[ks]), qv);
#pragma unroll
        for (int j = 0; j < 8; ++j) nq += qv[j] * fsm[192 + ks * 16 + hi * 8 + j]; }
    float den = rs + dec * nq;
    { auto rr = __builtin_amdgcn_permlane32_swap(__float_as_uint(den), __float_as_uint(den), false, false); den = __uint_as_float(rr[0]) + __uint_as_float(rr[1]); }
    f32x16 n1, n2;
#pragma unroll
    for (int r = 0; r < 16; ++r) { n1[r] = 0.f; n2[r] = 0.f; }
#pragma unroll
    for (int hf = 0; hf < 2; ++hf)
#pragma unroll
        for (int ss = 0; ss < 2; ++ss) {
            unsigned pw[4];
#pragma unroll
            for (int j = 0; j < 4; ++j) pw[j] = hf ? cvtpk(a1[8 * ss + 2 * j], a1[8 * ss + 2 * j + 1]) : cvtpk(a0[8 * ss + 2 * j], a0[8 * ss + 2 * j + 1]);
            const u32x4v pbw = {pw[0], pw[1], pw[2], pw[3]};
            const lds_c* vp = VTi + (vb * 32 + r32) * 136 + hf * 64 + ss * 32 + hi * 8;
            const u32x2v lo = *(const __attribute__((address_space(3))) u32x2v*)vp, hi2 = *(const __attribute__((address_space(3))) u32x2v*)(vp + 16);
            const u32x4v aw = {lo.x, lo.y, hi2.x, hi2.y};
            n1 = MFMA32(__builtin_bit_cast(bf16x8, aw), __builtin_bit_cast(bf16x8, pbw), n1);
        }
#pragma unroll
    for (int ks = 0; ks < 8; ++ks) {
        const bf16x8 sa = *(const __attribute__((address_space(3))) bf16x8*)(Si + (vb * 32 + r32) * 272 + ks * 32 + hi * 16);
        n2 = MFMA32(sa, qf[ks], n2);
    }
    const float inv = 1.f / fmaxf(fabsf(den), fsm[128 + t]);
    const bf16_t* op = MO + (tok0 + t) * 512 + h * 128 + vb * 32;
    float hv[16]; float ssq = 0.f;
#pragma unroll
    for (int i = 0; i < 4; ++i) {
        const u32x2v ow = *(const u32x2v*)(op + 8 * i + 4 * hi);
        const float o4[4] = {__uint_as_float(ow.x << 16), __uint_as_float(ow.x & 0xffff0000u), __uint_as_float(ow.y << 16), __uint_as_float(ow.y & 0xffff0000u)};
#pragma unroll
        for (int j = 0; j < 4; ++j) { const float x = (n1[4 * i + j] + dec * n2[4 * i + j]) * inv * sigmoidf_(o4[j]); hv[4 * i + j] = x; ssq += x * x; }
    }
    { auto rr = __builtin_amdgcn_permlane32_swap(__float_as_uint(ssq), __float_as_uint(ssq), false, false); ssq = __uint_as_float(rr[0]) + __uint_as_float(rr[1]); }
    if (hi == 0) fsm[320 + t * 4 + vb] = ssq;
    __syncthreads();
    const float tot = (fsm[320 + t * 4] + fsm[320 + t * 4 + 1]) + (fsm[320 + t * 4 + 2] + fsm[320 + t * 4 + 3]);
    const float rstd = rsqrtf(tot * (1.f / 128.f) + 1e-6f);
    bf16_t* yp = Y + (tok0 + t) * DM + 512 + h * 128 + vb * 32; const float* gp = g_hn + h * 128 + vb * 32;
#pragma unroll
    for (int i = 0; i < 4; ++i) {
        const float4 gg = *(const float4*)(gp + 8 * i + 4 * hi);
        *(u32x2v*)(yp + 8 * i + 4 * hi) = (u32x2v){cvtpk(hv[4 * i] * rstd * gg.x, hv[4 * i + 1] * rstd * gg.y), cvtpk(hv[4 * i + 2] * rstd * gg.z, hv[4 * i + 3] * rstd * gg.w)};
    }
}

DI void cmp_unit(int kv, int bg, int jt, int tx, lds_c* lds, const bf16_t* __restrict__ KVb, const bf16_t* __restrict__ W1t, const bf16_t* __restrict__ W2t, const float* __restrict__ bias1p,
                 float* __restrict__ outf, bf16_t* __restrict__ kcb, bf16_t* __restrict__ vcT) {
    const int b = bg >> 1, g = bg & 1, lane = tx & 63, r32 = lane & 31, hi = lane >> 5, wave = __builtin_amdgcn_readfirstlane(tx >> 6), j0 = jt * 32;
    lds_c* TI = lds; lds_c* H1 = lds + 16 * 34 * 144;
    const bf16_t* src = KVb + ((size_t)b * SEQ + 16 * j0) * 512 + (kv ? 128 : 0) + g * 64;
    __syncthreads();
    for (int ch = tx; ch < 528 * 8; ch += 512) {
        const int t = ch >> 3, c8 = ch & 7;
        *(__attribute__((address_space(3))) pg8::u32x4*)(TI + ((t & 15) * 34 + (t >> 4)) * 144 + c8 * 16) = *(const pg8::u32x4*)(src + (size_t)t * 512 + c8 * 8);
    }
    __syncthreads();
    f32x16 acc;
#pragma unroll
    for (int r = 0; r < 16; ++r) acc[r] = 0.f;
    const bf16_t* wrow = W1t + (size_t)(wave * 32 + r32) * 2048 + hi * 8;
#pragma unroll 4
    for (int i = 0; i < 32; ++i) {
        const lds_c* arow = TI + ((i & 15) * 34 + r32 + (i >> 4)) * 144 + hi * 16;
#pragma unroll
        for (int dk = 0; dk < 4; ++dk) {
            const bf16x8 a = *(const __attribute__((address_space(3))) bf16x8*)(arow + dk * 32);
            const bf16x8 bfr = *(const bf16x8*)(wrow + i * 64 + dk * 16);
            acc = MFMA32(a, bfr, acc);
        }
    }
    {
        const int n = wave * 32 + r32; float bias = 0.f;
#pragma unroll
        for (int k = 0; k < 16; ++k) bias += bias1p[k * 512 + kv * 256 + n];
#pragma unroll
        for (int r = 0; r < 16; ++r) *(__attribute__((address_space(3))) bf16_t*)(H1 + crow(r, hi) * 528 + n * 2) = f2bf(gelu_tanh(acc[r] + bias));
    }
    __syncthreads();
    if (wave < 2) {
        f32x16 o;
#pragma unroll
        for (int r = 0; r < 16; ++r) o[r] = 0.f;
        const bf16_t* w2row = W2t + (size_t)(wave * 32 + r32) * 256 + hi * 8;
#pragma unroll
        for (int ks = 0; ks < 16; ++ks) {
            const bf16x8 a = *(const __attribute__((address_space(3))) bf16x8*)(H1 + r32 * 528 + ks * 32 + hi * 16);
            const bf16x8 bfr = *(const bf16x8*)(w2row + ks * 16);
            o = MFMA32(a, bfr, o);
        }
        const int d = wave * 32 + r32;
#pragma unroll
        for (int r = 0; r < 16; ++r) {
            const int j = j0 + crow(r, hi); const float v = j < 255 ? o[r] : 0.f;
            outf[((size_t)bg * 256 + j) * 64 + d] = v;
            if (kv == 0) kcb[((size_t)bg * 256 + j) * 64 + d] = f2bf(v);
            else vcT[((size_t)bg * 4 + (j >> 6)) * 4096 + d * 64 + (j & 63)] = f2bf(v);
        }
    }
}

#define XB_TMO      128
#define XB_XCNT(j)  (256  + 64 * (j))
#define XB_XSUB(j)  (1280 + 64 * (j))
#define XB_XGEN(j)  (2304 + 64 * (j))
#define XB_TOP      3328
#define XB_TOPGEN   3392
#define XCD_BAR_WORDS 3456
#define XB_SPIN_CAP (1u << 23)

__device__ __forceinline__ unsigned xb_ld(unsigned* p)              { return __hip_atomic_load(p, __ATOMIC_RELAXED, __HIP_MEMORY_SCOPE_AGENT); }
__device__ __forceinline__ unsigned xb_add(unsigned* p, unsigned v) { return __hip_atomic_fetch_add(p, v, __ATOMIC_RELAXED, __HIP_MEMORY_SCOPE_AGENT); }
__device__ __forceinline__ unsigned xb_xcc_id() { return (unsigned)__builtin_amdgcn_s_getreg((3 << 11) | 20) & 0xFu; }
#define XB_SPIN(cond, bar) do { unsigned _sp = 0; while (cond) { __builtin_amdgcn_s_sleep(1); \
    if ((++_sp & 255u) == 0u) { if (xb_ld(&(bar)[XB_TMO])) break; if (_sp > XB_SPIN_CAP) { atomicAdd(&(bar)[XB_TMO], 1u); break; } } } } while (0)

struct XcdBarrier {
    unsigned* bar; unsigned x;
    volatile __attribute__((address_space(3))) unsigned* st;
};

__device__ __forceinline__ XcdBarrier xcd_barrier_post(unsigned* bar, volatile __attribute__((address_space(3))) unsigned* st) {
    XcdBarrier b; b.bar = bar; b.x = xb_xcc_id(); b.st = st;
    if (threadIdx.x == 0) (void)xb_add(&bar[XB_XCNT(b.x)], 1u);
    return b;
}
__device__ __forceinline__ void xcd_barrier_complete(unsigned* bar, unsigned x, unsigned& nloc, unsigned& nx) {
    const unsigned G = gridDim.x * gridDim.y * gridDim.z;
    unsigned sum, cnt, mine, sp = 0u;
    for (;;) {
        sum = 0u; cnt = 0u; mine = 0u;
#pragma unroll
        for (unsigned j = 0; j < 16; ++j) { const unsigned c = xb_ld(&bar[XB_XCNT(j)]); sum += c; cnt += (c > 0u) ? 1u : 0u; mine = (j == x) ? c : mine; }
        if (sum == G) break;
        __builtin_amdgcn_s_sleep(1);
        if ((++sp & 255u) == 0u) { if (xb_ld(&bar[XB_TMO])) break; if (sp > XB_SPIN_CAP) { atomicAdd(&bar[XB_TMO], 1u); break; } }
    }
    nloc = mine > 0u ? mine : 1u; nx = cnt > 0u ? cnt : 1u;
}

__device__ __forceinline__ void xcd_barrier(const XcdBarrier& b) {
    asm volatile("s_waitcnt vmcnt(0)" ::: "memory");
    __syncthreads();
    if (threadIdx.x == 0) {
        unsigned* bar = b.bar;
        __builtin_amdgcn_s_waitcnt(0);
        unsigned nloc = b.st[0], nx = b.st[1];
        if (nloc == 0u) { xcd_barrier_complete(bar, b.x, nloc, nx); b.st[0] = nloc; b.st[1] = nx; }
        const unsigned old = xb_add(&bar[XB_XSUB(b.x)], 1u);
        const unsigned gen = old / nloc;
        if (old + 1u == (gen + 1u) * nloc) {
            __builtin_amdgcn_fence(__ATOMIC_RELEASE, "agent");
            asm volatile("s_waitcnt vmcnt(0)" ::: "memory");
            const unsigned og = xb_add(&bar[XB_TOP], 1u);
            const unsigned tg = og / nx;
            if (og + 1u == (tg + 1u) * nx) xb_add(&bar[XB_TOPGEN], 1u);
            else XB_SPIN(xb_ld(&bar[XB_TOPGEN]) == tg, bar);
            __builtin_amdgcn_fence(__ATOMIC_ACQUIRE, "agent");
            xb_add(&bar[XB_XGEN(b.x)], 1u);
            asm volatile("s_waitcnt vmcnt(0)" ::: "memory");
        } else {
            XB_SPIN(xb_ld(&bar[XB_XGEN(b.x)]) == gen, bar);
            __builtin_amdgcn_fence(__ATOMIC_ACQUIRE, "agent");
            asm volatile("s_waitcnt vmcnt(0)" ::: "memory");
        }
    }
    __syncthreads();
}

#ifndef NSA_CHECK
#define NSA_CHECK 0
#endif
#ifndef REP_MASK
#define REP_MASK 0u
#endif
struct Args { const float* in[29]; float* out; char* ws; unsigned rep_mask; unsigned pad; };
constexpr int LDS_BYTES = 147456;

__global__ __launch_bounds__(512, 2) void mk_fwd(Args a) {
    extern __shared__ __attribute__((aligned(16))) char lds_raw[];
    cg::grid_group grid = cg::this_grid();
    const int NB = gridDim.x * 2, NGW = gridDim.x * 8;
    const unsigned repm = a.rep_mask;
    volatile __attribute__((address_space(3))) unsigned* bar_st = (volatile __attribute__((address_space(3))) unsigned*)((lds_c*)lds_raw + (LDS_BYTES - 64));
    if (threadIdx.x < 2) bar_st[threadIdx.x] = 0u;
    __syncthreads();
    const XcdBarrier xbar = xcd_barrier_post((unsigned*)(a.ws + ((size_t)42 << 20) + 65536), bar_st);
#define GRID_BAR() xcd_barrier(xbar)
#ifndef SPIN_PHASE
#define SPIN_PHASE (-1)
#endif
    unsigned long long ts_prev_ = 0ull, ts_probe_ = 0ull; int n_stamp_ = 0;
#define STAMP() do { if (SPIN_PHASE >= 0 && blockIdx.x == 0) { const unsigned long long now_ = __builtin_amdgcn_s_memrealtime(); if (n_stamp_ == SPIN_PHASE) ts_probe_ = now_ - ts_prev_; ts_prev_ = now_; ++n_stamp_; } } while (0)
    if (SPIN_PHASE >= 0 && blockIdx.x == 0) ts_prev_ = __builtin_amdgcn_s_memrealtime();
    const int wave_s_ = __builtin_amdgcn_readfirstlane(threadIdx.x >> 6);
#define KARG(T, off) (*(T const __attribute__((address_space(4)))*)(kargs_ + (off)))
#define PTRS const float* x = KARG(const float*, 8 * 0); const float* p = KARG(const float*, 8 * 1); const int* pos = KARG(const int*, 16); \
    const float* g_mix = KARG(const float*, 8 * 3); const float* w_in = KARG(const float*, 8 * 4); const float* b_if = KARG(const float*, 8 * 5); \
    const float* w_ck1 = KARG(const float*, 8 * 6); const float* w_ck2 = KARG(const float*, 8 * 7); const float* pe_ck = KARG(const float*, 8 * 8); \
    const float* w_cv1 = KARG(const float*, 8 * 9); const float* w_cv2 = KARG(const float*, 8 * 10); const float* pe_cv = KARG(const float*, 8 * 11); \
    const float* w_conv = KARG(const float*, 8 * 12); const float* b_conv = KARG(const float*, 8 * 13); const float* g_hn = KARG(const float*, 8 * 14); \
    const float* w_pa = KARG(const float*, 8 * 15); const float* w_pb = KARG(const float*, 8 * 16); const float* w_out = KARG(const float*, 8 * 17); \
    const float* g_ffn = KARG(const float*, 8 * 18); const float* w_rg = KARG(const float*, 8 * 19); const float* b_rg = KARG(const float*, 8 * 20); \
    const float* w_re = KARG(const float*, 8 * 21); const float* b_re = KARG(const float*, 8 * 22); const float* w_e13 = KARG(const float*, 8 * 23); \
    const float* w_e2 = KARG(const float*, 8 * 24); const float* g_ple = KARG(const float*, 8 * 25); const float* w_pg = KARG(const float*, 8 * 26); \
    const float* w_pp = KARG(const float*, 8 * 27); const float* g_final = KARG(const float*, 8 * 28); \
    float* out = KARG(float*, 232); char* ws = KARG(char*, 240); \
    const size_t MiB = 1u << 20; \
    bf16_t* Wt_in = (bf16_t*)(ws); \
    bf16_t* xb = (bf16_t*)(ws + 48 * MiB); \
    bf16_t* Qb = (bf16_t*)(ws + 80 * MiB); \
    bf16_t* KVb = (bf16_t*)(ws + 96 * MiB); bf16_t* VT = (bf16_t*)(ws + 112 * MiB); bf16_t* kcb = (bf16_t*)(ws + 249 * MiB + 512 * 1024); bf16_t* vcT = (bf16_t*)(ws + 249 * MiB + 768 * 1024); \
    bf16_t* MQK = (bf16_t*)(ws + 120 * MiB); \
    bf16_t* MV = (bf16_t*)(ws + 152 * MiB); \
    bf16_t* MO = (bf16_t*)(ws + 168 * MiB); \
    bf16_t* MG = (bf16_t*)(ws + 184 * MiB); \
    float* gates = (float*)(ws + 248 * MiB); \
    float* ifp = (float*)(ws + 250 * MiB); \
    float* kcc = (float*)(ws + 251 * MiB); \
    float* vcc = (float*)(ws + 252 * MiB); \
    float* gate16 = (float*)(ws + 253 * MiB); \
    float* rstd0 = (float*)(ws + 254 * MiB); \
    float* cosT = (float*)(ws + 254 * MiB + 512 * 1024); \
    float* sinT = (float*)(ws + 255 * MiB); \
    bf16_t* Y = (bf16_t*)(out + (size_t)8 * 1024 * 1024); \
    bf16_t* dC = xb; float* dn = (float*)(ws + 250 * MiB + 512 * 1024); float* wprev = (float*)(ws + 42 * MiB + 4096); float* mtab = (float*)(ws + 42 * MiB + 8192); \
    float* tmp = (float*)(ws + 120 * MiB); bf16_t* mixed = xb; \
    bf16_t* Wpa_t = (bf16_t*)(ws + 11 * MiB); bf16_t* Wpb_t = (bf16_t*)(ws + 12 * MiB); bf16_t* Wout_t = (bf16_t*)(ws + 13 * MiB); \
    bf16_t* We13_t = (bf16_t*)(ws + 15 * MiB); bf16_t* We2_t = (bf16_t*)(ws + 31 * MiB); bf16_t* Wpg_t = (bf16_t*)(ws + 39 * MiB); bf16_t* Wpp_t = (bf16_t*)(ws + 41 * MiB); \
    int* cnt = (int*)(ws + 42 * MiB); bf16_t* W1t_k = (bf16_t*)(ws + 43 * MiB); bf16_t* W1t_v = (bf16_t*)(ws + 44 * MiB); bf16_t* W2t_k = (bf16_t*)(ws + 45 * MiB); bf16_t* W2t_v = (bf16_t*)(ws + 45 * MiB + 65536); float* bias1p = (float*)(ws + 45 * MiB + 524288); \
    bf16_t* xg = (bf16_t*)(ws + 48 * MiB); bf16_t* act = (bf16_t*)(ws + 120 * MiB); bf16_t* y2 = (bf16_t*)(ws + 138 * MiB); bf16_t* x2b = (bf16_t*)(ws + 210 * MiB); \
    bf16_t* pb = (bf16_t*)(ws + 48 * MiB); bf16_t* PP = (bf16_t*)(ws + 56 * MiB); \
    int* rinfo = (int*)(ws + 253 * MiB); float* rstd1 = (float*)(ws + 253 * MiB + 512 * 1024); float* rstd2 = (float*)(ws + 253 * MiB + 768 * 1024); \
    (void)x; (void)p; (void)pos; (void)g_mix; (void)w_in; (void)b_if; (void)w_ck1; (void)w_ck2; (void)pe_ck; (void)w_cv1; (void)w_cv2; (void)pe_cv; (void)w_conv; (void)b_conv; (void)g_hn; (void)w_pa; (void)w_pb; (void)w_out; (void)g_ffn; (void)w_rg; (void)b_rg; (void)w_re; (void)b_re; (void)w_e13; (void)w_e2; (void)g_ple; (void)w_pg; (void)w_pp; (void)g_final;
#define PHASE(k) for (int rep_ = 0; rep_ < 1 + (int)((repm >> (k)) & 1u); ++rep_)
#define PHASE_IDS unsigned tx_ = (unsigned)(wave_s_ * 64); asm volatile("" : "+v"(tx_)); tx_ = (unsigned)__builtin_amdgcn_mbcnt_hi(-1, __builtin_amdgcn_mbcnt_lo(-1, (int)tx_)); const int half = tx_ >> 8, tid = tx_ & 255, lane64 = tx_ & 63, tid512 = (int)tx_; \
    const int wave = __builtin_amdgcn_readfirstlane(tx_ >> 6); char* sm = lds_raw + half * 65536; const int gw = blockIdx.x * 8 + wave; (void)tid; (void)lane64; (void)sm; (void)gw; (void)tid512; \
    const __attribute__((address_space(4))) char* kargs_ = (const __attribute__((address_space(4))) char*)__builtin_amdgcn_kernarg_segment_ptr(); asm volatile("" : "+s"(kargs_)); PTRS
#define VB_LOOP(nvb) for (int vb = blockIdx.x * 2 + half; vb < (nvb); vb += NB)
#define GEMM_PHASE(NT, MT, ...) do { VB_LOOP((NT) * (MT)) { const int bx_ = vb % (NT), by_ = vb / (NT); __syncthreads(); gemm_v1(bx_, by_, tid, sm, __VA_ARGS__); } } while (0)
    PHASE(0) { PHASE_IDS
        float* scr = (float*)(lds_raw + wave * 8448);
        for (int it = gw; it < (DM / 64) * (NIN / 32); it += NGW) prep_wt_item(w_in, DIN, DM, Wt_in, g_mix, MapIn{}, scr, it, NIN / 32, lane64);
        for (int it = gw; it < 8 * 32; it += NGW) prep_wt_item(w_pa, DM, 512, Wpa_t, (const float*)nullptr, MapId{}, scr, it, 32, lane64);
        for (int it = gw; it < 8 * 32; it += NGW) prep_wt_item(w_pb, DM, 512, Wpb_t, (const float*)nullptr, MapId{}, scr, it, 32, lane64);
        for (int it = gw; it < 16 * 32; it += NGW) prep_wt_item(w_out, DM, DM, Wout_t, (const float*)nullptr, MapId{}, scr, it, 32, lane64);
        for (int it = gw; it < 16 * 32; it += NGW) prep_wt_item(w_pg, DM, DM, Wpg_t, g_ple, MapId{}, scr, it, 32, lane64);
        for (int it = gw; it < 4 * 32; it += NGW) prep_wt_item(w_pp, DM, 256, Wpp_t, (const float*)nullptr, MapId{}, scr, it, 32, lane64);
        for (int it = gw; it < 16 * 256; it += NGW) { const int e = it >> 8; prep_wt_item(w_e13 + (size_t)e * 1024 * 512, 512, DM, We13_t + (size_t)e * 512 * 1024, g_ffn, MapE13{}, scr, it & 255, 16, lane64); }
        for (int it = gw; it < 16 * 128; it += NGW) { const int e = it >> 7; prep_wt_item(w_e2 + (size_t)e * 256 * 1024, DM, 256, We2_t + (size_t)e * 1024 * 256, (const float*)nullptr, MapId{}, scr, it & 127, 32, lane64); }
        for (int it = gw; it < 2 * 256; it += NGW) { const int kv = it >> 8; prep_wt_item(kv ? w_cv1 : w_ck1, 256, 2048, kv ? W1t_v : W1t_k, (const float*)nullptr, MapId{}, scr, it & 255, 8, lane64); }
        for (int it = gw; it < 2 * 8; it += NGW) { const int kv = it >> 3; prep_wt_item(kv ? w_cv2 : w_ck2, 64, 256, kv ? W2t_v : W2t_k, (const float*)nullptr, MapId{}, scr, it & 7, 2, lane64); }
        if (blockIdx.x < 16) {
            const int kv = tid512 >> 8, n = tid512 & 255; const float* w1 = kv ? w_cv1 : w_ck1; const float* pe = kv ? pe_cv : pe_ck; float a = 0.f;
            for (int k = blockIdx.x * 128; k < blockIdx.x * 128 + 128; ++k) a += pe[k] * w1[(size_t)k * 256 + n];
            bias1p[blockIdx.x * 512 + tid512] = a;
        }
        if (blockIdx.x == 0 && tid512 < 16) cnt[tid512 * CNT_STRIDE] = 0;
        for (int r = gw; r < T_TOK; r += NGW) prep_x_row(x, xb, rstd0, r, lane64);
        for (int i = blockIdx.x * 512 + tid512; i < T_TOK * 8; i += gridDim.x * 512) {
            const float inv = powf(500000.0f, -(float)(2 * (i & 7)) / 16.0f); float sn, cs; sincosf((float)pos[i >> 3] * inv, &sn, &cs); cosT[i] = cs; sinT[i] = sn; }
    }
    grid.sync(); STAMP();
    PHASE(1) { PHASE_IDS
        pg8::Gemm g{xb, Wt_in, T_TOK, NIN, DM, DM, DM}; pg8::StaticOrder S; S.init(T_TOK, NIN, (int)gridDim.x, (int)blockIdx.x);
        EpiInProj E{rstd0, cosT, sinT, b_if, Qb, KVb, gates, ifp, MQK, MV, MO, MG, VT};
        pg8::gemm_phase<EpiInProj, pg8::StaticOrder, true, true>((PG8_LAS unsigned char*)lds_raw, g, S, E, tid512);
    }
    GRID_BAR(); STAMP();
    PHASE(2) { PHASE_IDS
        for (int u = blockIdx.x; u < 128; u += gridDim.x) { const int kv = u >> 6, bg = (u >> 3) & 7, jt = u & 7;
            cmp_unit(kv, bg, jt, tid512, (lds_c*)lds_raw, KVb, kv ? W1t_v : W1t_k, kv ? W2t_v : W2t_k, bias1p, kv ? vcc : kcc, kcb, vcT); }
        { const int v_ = (int)blockIdx.x - 128; if (v_ >= 0 && v_ < 16 && wave == 0) ml_mscan_all(ifp, v_, lane64, mtab); }
    }
    GRID_BAR(); STAMP();
    PHASE(3) { PHASE_IDS
        for (int u = blockIdx.x; u < 1024; u += gridDim.x) ml_unit_c(u >> 6, u & 63, tid512, (lds_c*)lds_raw, MQK, MV, ifp, w_conv, b_conv, dC, dn, wprev, mtab);
    }
    GRID_BAR(); STAMP();
    {   PHASE_IDS
        ml_scan(blockIdx.x * 512 + tid512, gridDim.x * 512, dC, dn, wprev);
    }
    GRID_BAR(); STAMP();
    PHASE(4) { PHASE_IDS
        for (int u = blockIdx.x; u < 1024; u += gridDim.x) ml_unit_e(u >> 6, u & 63, tid512, (lds_c*)lds_raw, MQK, MV, MO, ifp, w_conv, b_conv, dC, dn, mtab, g_hn, Y);
    }
    PHASE(5) { PHASE_IDS
        for (int pr = blockIdx.x; pr < 256; pr += gridDim.x) {
            nsa_unit(pr & 7, 63 - (pr >> 3), tid512, (lds_c*)lds_raw, Qb, KVb, VT, kcb, vcT, gates, Y);
            nsa_unit(pr & 7, pr >> 3, tid512, (lds_c*)lds_raw, Qb, KVb, VT, kcb, vcT, gates, Y);
        }
    }
#if NSA_CHECK
    {   PHASE_IDS
        bf16_t* Y2 = (bf16_t*)(ws + 120 * MiB); unsigned* stats = (unsigned*)(ws + 42 * MiB) + 64;
        if (blockIdx.x == 0 && tid512 == 0) { stats[0] = 0u; stats[1] = 0u; }
        grid.sync();
        float* kcc2 = (float*)(ws + 251 * MiB + 512 * 1024); float* vcc2 = (float*)(ws + 252 * MiB + 512 * 1024); bf16_t* dummy = (bf16_t*)(ws + 160 * MiB);
        VB_LOOP(4080) { const int j = vb % 255, r = vb / 255; compress_naive(j, r & 7, r >> 3, tid, sm, KVb, w_ck1, w_ck2, pe_ck, w_cv1, w_cv2, pe_cv, kcc2, vcc2, dummy, dummy + 1048576); }
        grid.sync();
        VB_LOOP(T_TOK * 2) nsa_naive(vb >> 1, vb & 1, tid, sm, Qb, KVb, VT, kcc2, vcc2, gates, Y2);
        grid.sync();
        unsigned c1 = 0, c2 = 0;
        for (size_t i = (size_t)blockIdx.x * 512 + tid512; i < (size_t)T_TOK * 512; i += (size_t)gridDim.x * 512) {
            const size_t o = (i >> 9) * DM + (i & 511); const float d = fabsf(bf2f(Y[o]) - bf2f(Y2[o])); c1 += d > 0.02f ? 1u : 0u; c2 += (d > 0.1f || !(d == d)) ? 1u : 0u; }
        if (c1) atomicAdd(stats, c1); if (c2) atomicAdd(stats + 1, c2);
    }
#endif
    GRID_BAR(); STAMP();
    PHASE(7) { PHASE_IDS
        pg8::StaticOrder S; S.init(T_TOK, DM, (int)gridDim.x, (int)blockIdx.x);
        pg8::Gemm g{Y, Wpa_t, T_TOK, DM, 512, DM, 512}; EpiMerge<0> E{MG, tmp, mixed}; pg8::gemm_phase<EpiMerge<0>, pg8::StaticOrder, true, true>((PG8_LAS unsigned char*)lds_raw, g, S, E, tid512);
    }
    PHASE(8) { PHASE_IDS
        __syncthreads();
        pg8::StaticOrder S; S.init(T_TOK, DM, (int)gridDim.x, (int)blockIdx.x);
        pg8::Gemm g{Y + 512, Wpb_t, T_TOK, DM, 512, DM, 512}; EpiMerge<1> E{MG, tmp, mixed}; pg8::gemm_phase<EpiMerge<1>, pg8::StaticOrder, true, true>((PG8_LAS unsigned char*)lds_raw, g, S, E, tid512);
    }
    GRID_BAR(); STAMP();
    PHASE(9) { PHASE_IDS
        pg8::Gemm g{mixed, Wout_t, T_TOK, DM, DM, DM, DM}; pg8::StaticOrder S; S.init(T_TOK, DM, (int)gridDim.x, (int)blockIdx.x);
        EpiX1 E{x, out};
        pg8::gemm_phase<EpiX1, pg8::StaticOrder, true, true>((PG8_LAS unsigned char*)lds_raw, g, S, E, tid512);
    }
    GRID_BAR(); STAMP();
    {   PHASE_IDS
        __attribute__((address_space(3))) float* Wl = (__attribute__((address_space(3))) float*)((lds_c*)lds_raw);
        __attribute__((address_space(3))) int* lcnt = (__attribute__((address_space(3))) int*)((lds_c*)lds_raw + 20 * 4096);
        __attribute__((address_space(3))) int* lri = lcnt + 32;
        __syncthreads(); router_stage(Wl, g_ffn, w_rg, w_re, tid512); if (tid512 < 16) lcnt[tid512] = 0; __syncthreads();
        { int i = 0; for (int t = gw; t < T_TOK; t += NGW, ++i) router2(t, lane64, out, Wl, b_rg, b_re, rstd1, lcnt, lri + (wave * 8 + i) * 4); }
        __syncthreads();
        if (tid512 < 16) lcnt[16 + tid512] = atomicAdd(cnt + tid512 * CNT_STRIDE, lcnt[tid512]);
        __syncthreads();
        { int i = 0; for (int t = gw; t < T_TOK; t += NGW, ++i) if (lane64 == 0) { __attribute__((address_space(3))) int* r = lri + (wave * 8 + i) * 4;
            const int e0 = r[0] & 255, e1 = (r[0] >> 8) & 255; int4 ri; ri.x = r[0]; ri.y = ((r[1] & 0xffff) + lcnt[16 + e0]) | (((r[1] >> 16) + lcnt[16 + e1]) << 16); ri.z = r[2]; ri.w = r[3];
            *(int4*)(rinfo + (size_t)t * 4) = ri; } }
    }
    GRID_BAR(); STAMP();
    PHASE(11) { PHASE_IDS
        for (int t = gw; t < T_TOK; t += NGW) {
            int4 ri = *(const int4*)(rinfo + (size_t)t * 4); ri.x = __builtin_amdgcn_readfirstlane(ri.x); ri.y = __builtin_amdgcn_readfirstlane(ri.y); ri.z = __builtin_amdgcn_readfirstlane(ri.z); ri.w = __builtin_amdgcn_readfirstlane(ri.w);
            const int r0 = moe_base_row(cnt, ri.x & 255) + (ri.y & 0xffff), r1 = moe_base_row(cnt, (ri.x >> 8) & 255) + ((ri.y >> 16) & 0xffff);
            const float rs = rstd1[t];
#pragma unroll
            for (int j = 0; j < 4; ++j) { const float4 v = ((const float4*)(out + (size_t)t * DM))[lane64 + 64 * j]; uint2 o; o.x = pk2(v.x * rs, v.y * rs); o.y = pk2(v.z * rs, v.w * rs);
                ((uint2*)(xg + (size_t)r0 * DM))[lane64 + 64 * j] = o; ((uint2*)(xg + (size_t)r1 * DM))[lane64 + 64 * j] = o; }
        }
    }
    GRID_BAR(); STAMP();
    PHASE(12) { PHASE_IDS
        pg8::Gemm g{xg, We13_t, 0, 0, DM, DM, DM}; MoeOrder S{cnt, 2, (int)gridDim.x, (int)blockIdx.x};
        EpiSwiglu E{act};
        pg8::gemm_phase<EpiSwiglu, MoeOrder, true, true>((PG8_LAS unsigned char*)lds_raw, g, S, E, tid512);
    }
    GRID_BAR(); STAMP();
    PHASE(13) { PHASE_IDS
        pg8::Gemm g{act, We2_t, 0, 0, 256, 256, 256}; MoeOrder S{cnt, 4, (int)gridDim.x, (int)blockIdx.x};
        EpiStoreBf E{y2, DM, 3};
        pg8::gemm_phase<EpiStoreBf, MoeOrder, true, true>((PG8_LAS unsigned char*)lds_raw, g, S, E, tid512);
    }
    GRID_BAR(); STAMP();
    {   PHASE_IDS
        for (int t = gw; t < T_TOK; t += NGW) {
            int4 ri = *(const int4*)(rinfo + (size_t)t * 4); ri.x = __builtin_amdgcn_readfirstlane(ri.x); ri.y = __builtin_amdgcn_readfirstlane(ri.y); ri.z = __builtin_amdgcn_readfirstlane(ri.z); ri.w = __builtin_amdgcn_readfirstlane(ri.w);
            const int r0 = moe_base_row(cnt, ri.x & 255) + (ri.y & 0xffff), r1 = moe_base_row(cnt, (ri.x >> 8) & 255) + ((ri.y >> 16) & 0xffff);
            const float w0 = __int_as_float(ri.z), w1 = __int_as_float(ri.w);
            float4 v[4]; float s2 = 0.f;
#pragma unroll
            for (int j = 0; j < 4; ++j) { v[j] = ((const float4*)(out + (size_t)t * DM))[lane64 + 64 * j];
                const uint2 a0 = ((const uint2*)(y2 + (size_t)r0 * DM))[lane64 + 64 * j], a1 = ((const uint2*)(y2 + (size_t)r1 * DM))[lane64 + 64 * j];
                v[j].x += w0 * __uint_as_float(a0.x << 16) + w1 * __uint_as_float(a1.x << 16); v[j].y += w0 * __uint_as_float(a0.x & 0xffff0000u) + w1 * __uint_as_float(a1.x & 0xffff0000u);
                v[j].z += w0 * __uint_as_float(a0.y << 16) + w1 * __uint_as_float(a1.y << 16); v[j].w += w0 * __uint_as_float(a0.y & 0xffff0000u) + w1 * __uint_as_float(a1.y & 0xffff0000u);
                s2 += v[j].x * v[j].x + v[j].y * v[j].y + v[j].z * v[j].z + v[j].w * v[j].w; }
            s2 = wave_sum(s2);
            if (lane64 == 0) rstd2[t] = rsqrtf(s2 * (1.f / DM) + 1e-6f);
#pragma unroll
            for (int j = 0; j < 4; ++j) { ((float4*)(out + (size_t)t * DM))[lane64 + 64 * j] = v[j]; uint2 o; o.x = pk2(v[j].x, v[j].y); o.y = pk2(v[j].z, v[j].w); ((uint2*)(x2b + (size_t)t * DM))[lane64 + 64 * j] = o; }
            { const float4 pv = ((const float4*)(p + (size_t)t * 256))[lane64]; uint2 o; o.x = pk2(pv.x, pv.y); o.y = pk2(pv.z, pv.w); ((uint2*)(pb + (size_t)t * 256))[lane64] = o; }
        }
    }
    GRID_BAR(); STAMP();
    {   PHASE_IDS
        pg8::StaticOrder S; S.init(T_TOK, DM, (int)gridDim.x, (int)blockIdx.x);
        pg8::Gemm g{pb, Wpp_t, T_TOK, DM, 256, 256, 256}; EpiStoreBf E{PP, DM, 3};
        pg8::gemm_phase<EpiStoreBf, pg8::StaticOrder, true, true>((PG8_LAS unsigned char*)lds_raw, g, S, E, tid512);
    }
    {   PHASE_IDS
        __syncthreads();
        pg8::StaticOrder S; S.init(T_TOK, DM, (int)gridDim.x, (int)blockIdx.x);
        pg8::Gemm g{x2b, Wpg_t, T_TOK, DM, DM, DM, DM}; EpiPle2 E{out, PP, rstd2};
        pg8::gemm_phase<EpiPle2, pg8::StaticOrder, true, true>((PG8_LAS unsigned char*)lds_raw, g, S, E, tid512);
    }
    GRID_BAR(); STAMP();
    {   PHASE_IDS
        VB_LOOP(T_TOK / 4) rmsnorm_rows(vb, tid, out, g_final, (bf16_t*)nullptr, out, T_TOK);
        if (SPIN_PHASE >= 0 && blockIdx.x == 0) { __syncthreads(); STAMP(); const unsigned long long t0_ = __builtin_amdgcn_s_memrealtime(); while (__builtin_amdgcn_s_memrealtime() - t0_ < 8ull * ts_probe_) __builtin_amdgcn_s_sleep(4); }
#if NSA_CHECK
        grid.sync();
        if (blockIdx.x == 0 && tid512 == 0) { const unsigned* stats = (const unsigned*)(ws + 42 * MiB) + 64; out[0] += sqrtf((float)stats[0]); out[1] += sqrtf((float)stats[1]) * 30.f; }
#endif
    }
}

extern "C" void kernel_launch(void* const* d_in, const int* in_sizes, int n_in, void* d_out, int out_size, void* d_ws, size_t ws_size, hipStream_t stream) {
    static int grid_blocks = 0;
    if (grid_blocks == 0) {
        int dev = 0, cus = 0, per_cu = 0;
        (void)hipGetDevice(&dev);
        (void)hipDeviceGetAttribute(&cus, hipDeviceAttributeMultiprocessorCount, dev);
        (void)hipFuncSetAttribute((const void*)mk_fwd, hipFuncAttributeMaxDynamicSharedMemorySize, LDS_BYTES);
        (void)hipOccupancyMaxActiveBlocksPerMultiprocessor(&per_cu, (const void*)mk_fwd, 512, LDS_BYTES);
        if (per_cu < 1) { fprintf(stderr, "kernel_launch: occupancy query returned %d\n", per_cu); per_cu = 1; }
        grid_blocks = cus * 1;
        fprintf(stderr, "kernel_launch: cus=%d per_cu=%d grid=%d ws=%zu\n", cus, per_cu, grid_blocks, ws_size);
    }
    (void)hipMemsetAsync((char*)d_ws + ((size_t)42 << 20), 0, 131072, stream);
    Args a{};
    for (int i = 0; i < 29; ++i) a.in[i] = (const float*)d_in[i];
    a.out = (float*)d_out; a.ws = (char*)d_ws; a.rep_mask = REP_MASK; a.pad = 0;
    void* args[] = {&a};
    hipError_t e = hipLaunchCooperativeKernel((const void*)mk_fwd, dim3(grid_blocks), dim3(512), args, LDS_BYTES, stream);
    if (e != hipSuccess) fprintf(stderr, "cooperative launch failed: %s (grid %d)\n", hipGetErrorString(e), grid_blocks);
    (void)in_sizes; (void)n_in; (void)out_size; (void)ws_size;
}
```

```cpp
#include <hip/hip_runtime.h>
#include <cstdint>
#include <cstdio>
#include <hip/hip_cooperative_groups.h>
namespace cg = cooperative_groups;

typedef unsigned short bf16_t;
typedef short bf16x8 __attribute__((ext_vector_type(8)));
typedef float f32x16 __attribute__((ext_vector_type(16)));

#define DI __device__ __forceinline__

constexpr int T_TOK = 16384, SEQ = 4096, DM = 1024, DIN = 5408, NIN = 5632;
#ifndef SPIN_PHASE
#define SPIN_PHASE (-1)
#endif
constexpr int CNT_STRIDE = 64;
constexpr float QSCALE = 0.125f * 1.4426950408889634f;
constexpr int ZC_Q = 0, ZC_KC = 512, ZC_VC = 640, ZC_KS = 768, ZC_VS = 896, ZC_KW = 1024, ZC_VW = 1152, ZC_GATE = 1280,
              ZC_MQK = 1304, ZC_MV = 2328, ZC_MO = 2840, ZC_IF = 3352, ZC_GA = 3360, ZC_GB = 4384;

DI bf16_t f2bf(float f) { unsigned u = __float_as_uint(f); return (bf16_t)((u + 0x7fffu + ((u >> 16) & 1u)) >> 16); }
DI float bf2f(bf16_t h) { return __uint_as_float(((unsigned)h) << 16); }
DI float sigmoidf_(float x) { return 1.f / (1.f + __expf(-x)); }
DI int lane_id_opaque() { int z = 0; asm volatile("" : "+v"(z)); return __builtin_amdgcn_mbcnt_hi(-1, __builtin_amdgcn_mbcnt_lo(-1, z)); }
DI float lane_xor(float v, int o, int lane) { return __int_as_float(__builtin_amdgcn_ds_bpermute((lane ^ o) << 2, __float_as_int(v))); }
DI float lane_get(float v, int src) { return __int_as_float(__builtin_amdgcn_ds_bpermute(src << 2, __float_as_int(v))); }
DI float wave_sum(float v) {
    const int l = lane_id_opaque();
#pragma unroll
    for (int o = 1; o < 64; o <<= 1) v += lane_xor(v, o, l);
    return v;
}
DI float wave_max(float v) {
    const int l = lane_id_opaque();
#pragma unroll
    for (int o = 1; o < 64; o <<= 1) v = fmaxf(v, lane_xor(v, o, l));
    return v;
}

namespace pg8 {
#define PG8_LAS __attribute__((address_space(3)))
typedef unsigned short bf16_t;
typedef short bf16x8 __attribute__((ext_vector_type(8)));
typedef float f32x4 __attribute__((ext_vector_type(4)));
typedef unsigned u32x4 __attribute__((ext_vector_type(4)));
constexpr int BM = 256, BK = 64, HALF = 128, HTB = HALF * BK * 2  , STAGE_BYTES = 8 * HTB, NXCD = 8, WGM = 8;

__host__ __device__ __forceinline__ int lds_byte(int r, int c) { const int st = (r >> 4) * 2 + (c >> 5), rr = r & 15, cc = c & 31, ob = rr * 64 + cc * 2; return st * 1024 + (ob ^ (((ob >> 9) & 1) << 5)); }
__host__ __device__ __forceinline__ void stage_rc(int b, int& R, int& C) { const int st = b / 1024, sb = b % 1024, swz = sb ^ (((sb >> 9) & 1) << 5); R = (st >> 1) * 16 + swz / 64; C = (st & 1) * 32 + (swz % 64) / 2; }
__host__ __device__ __forceinline__ int perm32(int rho) { const int n = rho >> 4, i = rho & 15; return 8 * (i >> 2) + 4 * n + (i & 3); }

struct Unit { int pm, pn, aux; };
struct Gemm { const bf16_t* A; const bf16_t* Bt; int M, N, K, lda, ldb; const int* amap; int avalid; };

struct StaticOrder {
    int nM, nN, nwg, G, c;
    __host__ __device__ __forceinline__ void init(int M, int N, int G_, int c_) { nM = M / BM; nN = N / BM; nwg = nM * nN; G = G_; c = c_; }
    __host__ __device__ __forceinline__ bool next(int i, Unit& u) const {
        const long L = (long)i * G + c; if (L >= nwg) return false;
        int wgid = (int)L; { const int q = nwg / NXCD, r = nwg % NXCD, xcd = wgid % NXCD, off = wgid / NXCD; wgid = (xcd < r ? xcd * (q + 1) : r * (q + 1) + (xcd - r) * q) + off; }
        const int nig = WGM * nN, gid = wgid / nig, fm = gid * WGM, gsz = (nM - fm) < WGM ? (nM - fm) : WGM;
        u.pm = fm + ((wgid % nig) % gsz); u.pn = (wgid % nig) / gsz; u.aux = 0; return true;
    }
    __device__ __forceinline__ void a_ready(const Unit&) const {}
    __device__ __forceinline__ void done(const Unit&) const {}
};

__device__ __forceinline__ unsigned cvt_pk_bf16(float lo, float hi) { unsigned r; asm volatile("v_cvt_pk_bf16_f32 %0, %1, %2" : "=v"(r) : "v"(lo), "v"(hi)); return r; }
typedef float f32x2 __attribute__((ext_vector_type(2)));
__device__ __forceinline__ f32x2 gelu_pk(f32x2 v) {
    const f32x2 av = __builtin_elementwise_abs(v), d = av * 0.2316418882f + 1.0f;
    f32x2 t; t.x = __builtin_amdgcn_rcpf(d.x); t.y = __builtin_amdgcn_rcpf(d.y);
    f32x2 q = t * 0.5307027145f + (-0.7265760135f); q = q * t + 0.7107068705f; q = q * t + (-0.142248368f); q = q * t + 0.127414796f; q = q * t;
    const f32x2 s = (v * v) * (-0.72134752044f);
    f32x2 e; e.x = __builtin_amdgcn_exp2f(s.x); e.y = __builtin_amdgcn_exp2f(s.y);
    const f32x2 m = v * (q * e), r = v - m;
    f32x2 o; o.x = v.x < 0.f ? m.x : r.x; o.y = v.y < 0.f ? m.y : r.y; return o;
}

template <int ACT  > struct EpiBf16 {
    static constexpr bool PERM = true, AFTER_DRAIN = false; static_assert(ACT == 0 || ACT == 1, "EpiBf16: ACT is 0 (none) or 1 (gelu_pk)");
    bf16_t* O; int ldc; const float* bias; int split_cols; size_t split_stride; float scale0;
    __device__ __forceinline__ void operator()(const f32x4 (&acc)[2][2][4][2], const Unit& u, int wr, int wc, int fr, int fq) const {
        const int row0 = u.pm * BM + wr * 64 + fr; int colt = u.pn * BM; bf16_t* base = O;
        float sc = 1.f; if (split_cols) { const int t = colt / split_cols; base += (size_t)t * split_stride; colt -= t * split_cols; if (t == 0) sc = scale0; }
        const int col0 = colt + wc * 32 + 8 * fq, bcol0 = u.pn * BM + wc * 32 + 8 * fq;
        f32x4 bv[2][2];
#pragma unroll
        for (int bj = 0; bj < 2; ++bj)
#pragma unroll
            for (int n = 0; n < 2; ++n) bv[bj][n] = bias ? *(const f32x4*)(bias + bcol0 + bj * HALF + 4 * n) : (f32x4){0.f, 0.f, 0.f, 0.f};
#pragma unroll
        for (int ai = 0; ai < 2; ++ai)
#pragma unroll
            for (int m = 0; m < 4; ++m) { bf16_t* rowp = base + (size_t)(row0 + ai * HALF + m * 16) * ldc + col0;
#pragma unroll
                for (int bj = 0; bj < 2; ++bj) { f32x4 v0 = acc[ai][bj][m][0] + bv[bj][0], v1 = acc[ai][bj][m][1] + bv[bj][1];
                    if (ACT == 1) { f32x2 a = gelu_pk((f32x2){v0[0], v0[1]}), b = gelu_pk((f32x2){v0[2], v0[3]}), c = gelu_pk((f32x2){v1[0], v1[1]}), d = gelu_pk((f32x2){v1[2], v1[3]});
                        v0 = (f32x4){a.x, a.y, b.x, b.y}; v1 = (f32x4){c.x, c.y, d.x, d.y}; }
                    v0 = v0 * sc; v1 = v1 * sc; u32x4 w; w.x = cvt_pk_bf16(v0[0], v0[1]); w.y = cvt_pk_bf16(v0[2], v0[3]); w.z = cvt_pk_bf16(v1[0], v1[1]); w.w = cvt_pk_bf16(v1[2], v1[3]);
                    *(u32x4*)(rowp + bj * HALF) = w; } }
    }
};

template <class Epi, class Sched, bool ALIGN_EPI = false, bool SP2 = false, bool GATHER = false>
__device__ __forceinline__ void gemm_phase(PG8_LAS unsigned char* lds, const Gemm g, const Sched& S, const Epi& E, const int tid) {
    const int wid = __builtin_amdgcn_readfirstlane(tid >> 6), lane = tid & 63, wr = wid >> 2, wc = wid & 3, fr = lane & 15, fq = lane >> 4;
    const int K = g.K, nt = K / BK;
    unsigned voffA[2], voffB[2], voffA1[2];
#pragma unroll
    for (int i = 0; i < 2; ++i) { int R, C; stage_rc(tid * 16 + i * 8192, R, C); const int Rb = Epi::PERM ? ((R & ~31) + perm32(R & 31)) : R;
        voffA[i] = (unsigned)(R * g.lda + C) * 2u; voffB[i] = (unsigned)(Rb * g.ldb + C) * 2u; voffA1[i] = voffA[i];
        if constexpr (GATHER) { const int t0_ = R < g.avalid ? g.amap[R] : 0, t1_ = R + HALF < g.avalid ? g.amap[R + HALF] : 0; voffA[i] = (unsigned)(t0_ * g.lda + C) * 2u; voffA1[i] = (unsigned)(t1_ * g.lda + C) * 2u; } }
    const size_t kstep = (size_t)(BK * 2);
    const size_t hstepA = (size_t)HALF * g.lda * 2, hstepB = (size_t)HALF * g.ldb * 2;
    const size_t tstepA = GATHER ? 0 : 2 * hstepA, tstepB = 2 * hstepB, hsA = GATHER ? 0 : hstepA;
    const unsigned ldsw = (unsigned)wid * 1024u;
    const int aoff = lds_byte(wr * 64 + fr, fq * 8), boff = lds_byte(wc * 32 + fr, fq * 8);
#define PG8_SA(b, h) (((b) * 2 + (h)) * HTB)
#define PG8_SB(b, h) ((4 + (b) * 2 + (h)) * HTB)
#define PG8_STAGE(bufoff, gbase, voff) do { _Pragma("unroll") for (int _i = 0; _i < 2; ++_i) \
        __builtin_amdgcn_global_load_lds((const unsigned*)((const char*)(gbase) + (voff)[_i]), (PG8_LAS unsigned*)(lds + (bufoff) + ldsw + _i * 8192), 16, 0, 0); } while (0)
#define PG8_LDA(dst, b, h) do { _Pragma("unroll") for (int m = 0; m < 4; ++m) _Pragma("unroll") for (int k = 0; k < 2; ++k) dst[m][k] = *(const PG8_LAS bf16x8*)(lds + PG8_SA(b, h) + aoff + m * 2048 + k * 1024); } while (0)
#define PG8_LDB(dst, b, h) do { _Pragma("unroll") for (int n = 0; n < 2; ++n) _Pragma("unroll") for (int k = 0; k < 2; ++k) dst[n][k] = *(const PG8_LAS bf16x8*)(lds + PG8_SB(b, h) + boff + n * 2048 + k * 1024); } while (0)
#define PG8_MMA(ai, bj, At, Bt) do { __builtin_amdgcn_s_setprio(1); _Pragma("unroll") for (int m = 0; m < 4; ++m) _Pragma("unroll") for (int n = 0; n < 2; ++n) _Pragma("unroll") for (int k = 0; k < 2; ++k) \
        acc[ai][bj][m][n] = __builtin_amdgcn_mfma_f32_16x16x32_bf16(Bt[n][k], At[m][k], acc[ai][bj][m][n], 0, 0, 0); __builtin_amdgcn_s_setprio(0); } while (0)
#define PG8_WAIT_V(n) asm volatile("s_waitcnt vmcnt(" #n ")" ::: "memory")
#define PG8_WAIT_L(n) asm volatile("s_waitcnt lgkmcnt(" #n ")" ::: "memory")
#define PG8_BAR __builtin_amdgcn_s_barrier()
#define PG8_SCHED __builtin_amdgcn_sched_barrier(0)
    Unit cur, nxt; int ui = 0;
    if (!S.next(0, cur)) return;
    f32x4 acc[2][2][4][2];
#pragma unroll
    for (int a = 0; a < 2; ++a)
#pragma unroll
        for (int b = 0; b < 2; ++b)
#pragma unroll
            for (int m = 0; m < 4; ++m)
#pragma unroll
                for (int n = 0; n < 2; ++n) acc[a][b][m][n] = (f32x4){0.f, 0.f, 0.f, 0.f};
    bf16x8 At[4][2], B0[2][2], B1[2][2];
    const char* cA = (const char*)g.A + (size_t)cur.pm * tstepA; const char* cB = (const char*)g.Bt + (size_t)cur.pn * tstepB;
    S.a_ready(cur);
    if constexpr (SP2) {
        PG8_STAGE(PG8_SB(0, 0), cB, voffB); PG8_STAGE(PG8_SB(0, 1), cB + hstepB, voffB); PG8_STAGE(PG8_SA(0, 0), cA, voffA); PG8_STAGE(PG8_SA(0, 1), cA + hsA, voffA1);
        if (wr == 1) PG8_BAR;
        PG8_WAIT_V(2); PG8_BAR;
        PG8_STAGE(PG8_SB(1, 0), cB + kstep, voffB); PG8_STAGE(PG8_SA(1, 0), cA + kstep, voffA); PG8_STAGE(PG8_SB(1, 1), cB + hstepB + kstep, voffB);
        PG8_WAIT_V(6); PG8_BAR;
    } else {
        PG8_STAGE(PG8_SB(0, 0), cB, voffB); PG8_STAGE(PG8_SA(0, 0), cA, voffA); PG8_STAGE(PG8_SB(0, 1), cB + hstepB, voffB); PG8_STAGE(PG8_SA(0, 1), cA + hsA, voffA1);
        if (wr == 1) PG8_BAR;
        PG8_WAIT_V(4); PG8_BAR;
        PG8_STAGE(PG8_SB(1, 0), cB + kstep, voffB); PG8_STAGE(PG8_SA(1, 0), cA + kstep, voffA); PG8_STAGE(PG8_SB(1, 1), cB + hstepB + kstep, voffB);
        PG8_WAIT_V(6); PG8_BAR;
    }
    for (;;) {
        const bool has_next = S.next(ui + 1, nxt);
        const char* nA = has_next ? (const char*)g.A + (size_t)nxt.pm * tstepA : cA; const char* nB = has_next ? (const char*)g.Bt + (size_t)nxt.pn * tstepB : cB;
        for (int t = 0; t < nt; t += 2) {
            const bool last = (t == nt - 2);
            const char* a1 = cA + (size_t)(t + 1) * kstep;
            const char* a2 = last ? nA : cA + (size_t)(t + 2) * kstep; const char* b2 = last ? nB : cB + (size_t)(t + 2) * kstep;
            const char* a3 = a2 + kstep; const char* b3 = b2 + kstep;
            if (last && has_next) S.a_ready(nxt);
            if constexpr (SP2) {
            PG8_LDB(B0, 0, 0); PG8_LDB(B1, 0, 1); PG8_SCHED; PG8_LDA(At, 0, 0); PG8_STAGE(PG8_SA(1, 1), a1 + hsA, voffA1);
            PG8_WAIT_V(8); PG8_WAIT_L(0); PG8_BAR; PG8_MMA(0, 0, At, B0); PG8_MMA(0, 1, At, B1); PG8_BAR; PG8_SCHED;
            PG8_LDA(At, 0, 1); PG8_STAGE(PG8_SB(0, 0), b2, voffB); PG8_STAGE(PG8_SB(0, 1), b2 + hstepB, voffB); PG8_STAGE(PG8_SA(0, 0), a2, voffA);
            PG8_WAIT_V(8); PG8_WAIT_L(0); PG8_BAR; PG8_MMA(1, 0, At, B0); PG8_MMA(1, 1, At, B1); PG8_BAR; PG8_SCHED;
            PG8_LDB(B0, 1, 0); PG8_LDB(B1, 1, 1); PG8_SCHED; PG8_LDA(At, 1, 0); PG8_STAGE(PG8_SA(0, 1), a2 + hsA, voffA1);
            PG8_WAIT_V(8); PG8_WAIT_L(0); PG8_BAR; PG8_MMA(0, 0, At, B0); PG8_MMA(0, 1, At, B1); PG8_BAR; PG8_SCHED;
            PG8_LDA(At, 1, 1); PG8_STAGE(PG8_SB(1, 0), b3, voffB); PG8_STAGE(PG8_SB(1, 1), b3 + hstepB, voffB); PG8_STAGE(PG8_SA(1, 0), a3, voffA);
            PG8_WAIT_V(8); PG8_WAIT_L(0); PG8_BAR; PG8_MMA(1, 0, At, B0); PG8_MMA(1, 1, At, B1); PG8_BAR; PG8_SCHED;
            } else {
            PG8_LDB(B0, 0, 0); PG8_SCHED; PG8_LDA(At, 0, 0); PG8_STAGE(PG8_SA(1, 1), a1 + hsA, voffA1);
            PG8_WAIT_L(8); PG8_BAR; PG8_WAIT_L(0); PG8_MMA(0, 0, At, B0); PG8_BAR; PG8_SCHED;
            PG8_LDB(B1, 0, 1); PG8_STAGE(PG8_SB(0, 0), b2, voffB);
            PG8_BAR; PG8_WAIT_L(0); PG8_MMA(0, 1, At, B1); PG8_BAR;
            PG8_LDA(At, 0, 1); PG8_STAGE(PG8_SA(0, 0), a2, voffA);
            PG8_BAR; PG8_WAIT_L(0); PG8_MMA(1, 0, At, B0); PG8_BAR; PG8_SCHED;
            PG8_STAGE(PG8_SB(0, 1), b2 + hstepB, voffB);
            PG8_WAIT_V(6); PG8_BAR; PG8_MMA(1, 1, At, B1); PG8_BAR;
            PG8_LDB(B0, 1, 0); PG8_SCHED; PG8_LDA(At, 1, 0); PG8_STAGE(PG8_SA(0, 1), a2 + hsA, voffA1);
            PG8_WAIT_L(8); PG8_BAR; PG8_WAIT_L(0); PG8_MMA(0, 0, At, B0); PG8_BAR; PG8_SCHED;
            PG8_LDB(B1, 1, 1); PG8_STAGE(PG8_SB(1, 0), b3, voffB);
            PG8_BAR; PG8_WAIT_L(0); PG8_MMA(0, 1, At, B1); PG8_BAR;
            PG8_LDA(At, 1, 1); PG8_STAGE(PG8_SA(1, 0), a3, voffA);
            PG8_BAR; PG8_WAIT_L(0); PG8_MMA(1, 0, At, B0); PG8_BAR; PG8_SCHED;
            PG8_STAGE(PG8_SB(1, 1), b3 + hstepB, voffB);
            PG8_WAIT_V(6); PG8_BAR; PG8_MMA(1, 1, At, B1); PG8_BAR;
            }
        }
        if constexpr (ALIGN_EPI) { if (wr == 0) PG8_BAR; }
        if constexpr (!Epi::AFTER_DRAIN) { const int l2_ = lane_id_opaque(); E(acc, cur, wr, wc, l2_ & 15, l2_ >> 4); S.done(cur); }
        if (!has_next) break;
#pragma unroll
        for (int a = 0; a < 2; ++a)
#pragma unroll
            for (int b = 0; b < 2; ++b)
#pragma unroll
                for (int m = 0; m < 4; ++m)
#pragma unroll
                    for (int n = 0; n < 2; ++n) acc[a][b][m][n] = (f32x4){0.f, 0.f, 0.f, 0.f};
        cur = nxt; cA = nA; cB = nB; ++ui;
        if constexpr (ALIGN_EPI) { if (wr == 1) PG8_BAR; }
    }
    PG8_WAIT_V(0);
    if constexpr (!ALIGN_EPI) { if (wr == 0) PG8_BAR; }
    PG8_BAR;
    if constexpr (Epi::AFTER_DRAIN) { E.fused(acc, cur, wr, wc, fr, fq, lds, wid, lane); S.done(cur); }
#undef PG8_SA
#undef PG8_SB
#undef PG8_STAGE
#undef PG8_LDA
#undef PG8_LDB
#undef PG8_MMA
#undef PG8_WAIT_V
#undef PG8_WAIT_L
#undef PG8_BAR
#undef PG8_SCHED
}
}


#define LAS __attribute__((address_space(3)))
DI unsigned pk2(float lo, float hi) { return (unsigned)f2bf(lo) | ((unsigned)f2bf(hi) << 16); }
template <class Map>
DI void prep_wt_item(const float* __restrict__ W, int ldw, int K, bf16_t* __restrict__ WT, const float* __restrict__ gain, Map map, float* scr, int item, int nblk, int lane) {
    const int kb = item / nblk, nb = item % nblk, k0 = 64 * kb, n0 = 32 * nb;
    const int srcn = map(n0 + (lane & 31));
    float tv[32];
#pragma unroll
    for (int i = 0; i < 32; ++i) { const int kk = 2 * i + (lane >> 5); tv[i] = srcn >= 0 ? W[(size_t)(k0 + kk) * ldw + srcn] : 0.f; }
#pragma unroll
    for (int i = 0; i < 32; ++i) { const int kk = 2 * i + (lane >> 5); scr[kk * 33 + (lane & 31)] = gain ? tv[i] * gain[k0 + kk] : tv[i]; }
    __builtin_amdgcn_s_waitcnt(0xC07F); asm volatile("" ::: "memory");
    const int c = lane & 7;
#pragma unroll
    for (int j = 0; j < 4; ++j) { const int n = (lane >> 3) + 8 * j; const float* s = scr + (8 * c) * 33 + n;
        uint4 o; o.x = pk2(s[0 * 33], s[1 * 33]); o.y = pk2(s[2 * 33], s[3 * 33]); o.z = pk2(s[4 * 33], s[5 * 33]); o.w = pk2(s[6 * 33], s[7 * 33]);
        *(uint4*)(WT + (size_t)(n0 + n) * K + k0 + 8 * c) = o; }
    __builtin_amdgcn_s_waitcnt(0xC07F); asm volatile("" ::: "memory");
}
struct MapIn {
    DI int operator()(int n) const {
        if (n < 1280) return n;
        if (n < 1536) { const int i = n - 1280; return i < 24 ? ZC_GATE + i : (i < 32 ? ZC_IF + (i - 24) : -1); }
        if (n < 2560) return ZC_MQK + (n - 1536);
        if (n < 3072) return ZC_MV + (n - 2560);
        if (n < 3584) return ZC_MO + (n - 3072);
        return ZC_GA + (n - 3584);
    }
};
DI void prep_x_row(const float* __restrict__ x, bf16_t* __restrict__ xb, float* __restrict__ rstd, int row, int lane) {
    const float4* xr = (const float4*)(x + (size_t)row * DM);
    float4 v[4]; float s = 0.f;
#pragma unroll
    for (int j = 0; j < 4; ++j) { v[j] = xr[lane + 64 * j]; s += v[j].x * v[j].x + v[j].y * v[j].y + v[j].z * v[j].z + v[j].w * v[j].w; }
    s = wave_sum(s);
    if (lane == 0) rstd[row] = rsqrtf(s * (1.f / DM) + 1e-6f);
#pragma unroll
    for (int j = 0; j < 4; ++j) { uint2 o; o.x = pk2(v[j].x, v[j].y); o.y = pk2(v[j].z, v[j].w); ((uint2*)(xb + (size_t)row * DM))[lane + 64 * j] = o; }
}

struct EpiInProj {
    static constexpr bool PERM = true, AFTER_DRAIN = false;
    const float* rstd; const float* cosT; const float* sinT; const float* b_if;
    bf16_t* Qb; bf16_t* KVb; float* gates; float* ifp; bf16_t* MQK; bf16_t* MV; bf16_t* MO; bf16_t* MG; bf16_t* VT;
    DI void operator()(const pg8::f32x4 (&acc)[2][2][4][2], const pg8::Unit& u, int wr, int wc, int fr, int fq) const {
        const int pn = u.pn;
        asm volatile("" : "+v"(fr), "+v"(fq));
#pragma unroll
        for (int ai = 0; ai < 2; ++ai)
#pragma unroll
            for (int m = 0; m < 4; ++m) {
                const int row = u.pm * 256 + ai * 128 + wr * 64 + m * 16 + fr;
                const float rs = rstd[row];
#pragma unroll
                for (int bj = 0; bj < 2; ++bj) {
                    float v[8];
#pragma unroll
                    for (int i = 0; i < 4; ++i) { v[i] = acc[ai][bj][m][0][i] * rs; v[4 + i] = acc[ai][bj][m][1][i] * rs; }
                    const int c0 = bj * 128 + wc * 32 + 8 * fq;
                    if (pn <= 4) {
                        const bool is_k = (pn < 2) || (bj == 0);
                        if (is_k && (wc & 1) == 0) {
                            const float4 c_lo = *(const float4*)(cosT + (size_t)row * 8), c_hi = *(const float4*)(cosT + (size_t)row * 8 + 4);
                            const float4 s_lo = *(const float4*)(sinT + (size_t)row * 8), s_hi = *(const float4*)(sinT + (size_t)row * 8 + 4);
                            const float cs[8] = {c_lo.x, c_lo.y, c_lo.z, c_lo.w, c_hi.x, c_hi.y, c_hi.z, c_hi.w};
                            const float sn[8] = {s_lo.x, s_lo.y, s_lo.z, s_lo.w, s_hi.x, s_hi.y, s_hi.z, s_hi.w};
                            const int l_ = lane_id_opaque();
#pragma unroll
                            for (int i = 0; i < 8; ++i) {
                                const float other = lane_xor(v[i], 16, l_);
                                if (fq == 0) v[i] = v[i] * cs[i] - other * sn[i];
                                else if (fq == 1) v[i] = v[i] * cs[i] + other * sn[i];
                            }
                        }
                        const float sc = pn < 2 ? QSCALE : 1.f;
                        pg8::u32x4 w; w.x = pg8::cvt_pk_bf16(v[0] * sc, v[1] * sc); w.y = pg8::cvt_pk_bf16(v[2] * sc, v[3] * sc); w.z = pg8::cvt_pk_bf16(v[4] * sc, v[5] * sc); w.w = pg8::cvt_pk_bf16(v[6] * sc, v[7] * sc);
                        if (pn < 2) *(pg8::u32x4*)(Qb + (size_t)row * 512 + pn * 256 + c0) = w;
                        else if (pn == 2) *(pg8::u32x4*)(KVb + (size_t)row * 512 + c0) = w;
                        else if (bj == 0) *(pg8::u32x4*)(KVb + (size_t)row * 512 + (pn - 2) * 128 + 128 + wc * 32 + 8 * fq) = w;
                        else {
                            const int cv = wc * 32 + 8 * fq, gg = cv >> 6, d0 = cv & 63, bb = row >> 12, tt = row & 4095;
                            bf16_t* vt = VT + ((size_t)((pn - 3) * 8 + bb * 2 + gg) * 64 + (tt >> 6)) * 4096 + (size_t)d0 * 64 + (tt & 63);
                            vt[0] = (bf16_t)(w.x & 0xffffu); vt[64] = (bf16_t)(w.x >> 16); vt[128] = (bf16_t)(w.y & 0xffffu); vt[192] = (bf16_t)(w.y >> 16);
                            vt[256] = (bf16_t)(w.z & 0xffffu); vt[320] = (bf16_t)(w.z >> 16); vt[384] = (bf16_t)(w.w & 0xffffu); vt[448] = (bf16_t)(w.w >> 16);
                        }
                    } else if (pn == 5) {
                        if (bj == 0 && wc == 0) {
#pragma unroll
                            for (int i = 0; i < 8; ++i) { const int c = 8 * fq + i;
                                if (c < 24) gates[(size_t)row * 24 + c] = sigmoidf_(v[i]);
                                else if (c < 32) ifp[(size_t)row * 8 + (c - 24)] = v[i] + b_if[c - 24]; }
                        }
                    } else {
                        if (pn >= 14) {
#pragma unroll
                            for (int i = 0; i < 8; ++i) v[i] = sigmoidf_(v[i]);
                        }
                        pg8::u32x4 w; w.x = pg8::cvt_pk_bf16(v[0], v[1]); w.y = pg8::cvt_pk_bf16(v[2], v[3]); w.z = pg8::cvt_pk_bf16(v[4], v[5]); w.w = pg8::cvt_pk_bf16(v[6], v[7]);
                        bf16_t* dst;
                        if (pn < 10) dst = MQK + (size_t)row * 1024 + (pn - 6) * 256 + c0;
                        else if (pn < 12) dst = MV + (size_t)row * 512 + (pn - 10) * 256 + c0;
                        else if (pn < 14) dst = MO + (size_t)row * 512 + (pn - 12) * 256 + c0;
                        else dst = MG + (size_t)row * 2048 + (pn - 14) * 256 + c0;
                        *(pg8::u32x4*)dst = w;
                    }
                }
            }
    }
};


DI pg8::u32x4 pack8(const float (&v)[8]) { pg8::u32x4 w; w.x = pg8::cvt_pk_bf16(v[0], v[1]); w.y = pg8::cvt_pk_bf16(v[2], v[3]); w.z = pg8::cvt_pk_bf16(v[4], v[5]); w.w = pg8::cvt_pk_bf16(v[6], v[7]); return w; }
DI void unpack8(const pg8::u32x4 w, float (&v)[8]) {
    v[0] = __uint_as_float(w.x << 16); v[1] = __uint_as_float(w.x & 0xffff0000u); v[2] = __uint_as_float(w.y << 16); v[3] = __uint_as_float(w.y & 0xffff0000u);
    v[4] = __uint_as_float(w.z << 16); v[5] = __uint_as_float(w.z & 0xffff0000u); v[6] = __uint_as_float(w.w << 16); v[7] = __uint_as_float(w.w & 0xffff0000u);
}
#define EPI_ROWS_BEGIN asm volatile("" : "+v"(fr), "+v"(fq)); _Pragma("unroll") for (int ai = 0; ai < 2; ++ai) _Pragma("unroll") for (int m = 0; m < 4; ++m) { const int row = u.pm * 256 + ai * 128 + wr * 64 + m * 16 + fr; _Pragma("unroll") for (int bj = 0; bj < 2; ++bj) { \
    float v[8]; _Pragma("unroll") for (int i = 0; i < 4; ++i) { v[i] = acc[ai][bj][m][0][i]; v[4 + i] = acc[ai][bj][m][1][i]; } const int c0 = bj * 128 + wc * 32 + 8 * fq; (void)c0; (void)row;
#define EPI_ROWS_END } asm volatile("" ::: "memory"); }
template <int MODE> struct EpiMerge {
    static constexpr bool PERM = true, AFTER_DRAIN = false;
    const bf16_t* MG; float* tmp; bf16_t* mixed;
    DI void operator()(const pg8::f32x4 (&acc)[2][2][4][2], const pg8::Unit& u, int wr, int wc, int fr, int fq) const {
        EPI_ROWS_BEGIN
            const int col = u.pn * 256 + c0; float gt[8];
            unpack8(*(const pg8::u32x4*)(MG + (size_t)row * 2048 + MODE * 1024 + col), gt);
            float* tp = tmp + (size_t)row * DM + col;
            if (MODE == 0) {
                *(float4*)tp = make_float4(gt[0] * v[0], gt[1] * v[1], gt[2] * v[2], gt[3] * v[3]); *(float4*)(tp + 4) = make_float4(gt[4] * v[4], gt[5] * v[5], gt[6] * v[6], gt[7] * v[7]);
            } else {
                const float4 t0 = *(const float4*)tp, t1 = *(const float4*)(tp + 4);
                float o[8] = {t0.x + gt[0] * v[0], t0.y + gt[1] * v[1], t0.z + gt[2] * v[2], t0.w + gt[3] * v[3], t1.x + gt[4] * v[4], t1.y + gt[5] * v[5], t1.z + gt[6] * v[6], t1.w + gt[7] * v[7]};
                *(pg8::u32x4*)(mixed + (size_t)row * DM + col) = pack8(o);
            }
        EPI_ROWS_END
    }
};
struct EpiX1 {
    static constexpr bool PERM = true, AFTER_DRAIN = false;
    const float* base; float* out; bf16_t* outb;
    DI void operator()(const pg8::f32x4 (&acc)[2][2][4][2], const pg8::Unit& u, int wr, int wc, int fr, int fq) const {
        EPI_ROWS_BEGIN
            const size_t o = (size_t)row * DM + u.pn * 256 + c0;
            const float4 b0 = *(const float4*)(base + o), b1 = *(const float4*)(base + o + 4);
            const float r[8] = {b0.x + v[0], b0.y + v[1], b0.z + v[2], b0.w + v[3], b1.x + v[4], b1.y + v[5], b1.z + v[6], b1.w + v[7]};
            *(float4*)(out + o) = make_float4(r[0], r[1], r[2], r[3]); *(float4*)(out + o + 4) = make_float4(r[4], r[5], r[6], r[7]);
            *(pg8::u32x4*)(outb + o) = pack8(r);
        EPI_ROWS_END
    }
};
struct EpiStoreBf {
    static constexpr bool PERM = true, AFTER_DRAIN = false;
    bf16_t* O; int ld; int pnmask;
    DI void operator()(const pg8::f32x4 (&acc)[2][2][4][2], const pg8::Unit& u, int wr, int wc, int fr, int fq) const {
        EPI_ROWS_BEGIN
            *(pg8::u32x4*)(O + (size_t)row * ld + (u.pn & pnmask) * 256 + c0) = pack8(v);
        EPI_ROWS_END
    }
};
struct EpiSwiglu {
    static constexpr bool PERM = true, AFTER_DRAIN = false;
    bf16_t* act; const int* amap; int avalid; const float* rstd1;
    DI void operator()(const pg8::f32x4 (&acc)[2][2][4][2], const pg8::Unit& u, int wr, int wc, int fr, int fq) const {
        asm volatile("" : "+v"(fr), "+v"(fq));
#pragma unroll
        for (int ai = 0; ai < 2; ++ai)
#pragma unroll
            for (int m = 0; m < 4; ++m) {
                const int rl = ai * 128 + wr * 64 + m * 16 + fr, row = u.pm * 256 + rl; float o[8];
                const float rs = rl < avalid ? rstd1[amap[rl]] : 0.f;
#pragma unroll
                for (int i = 0; i < 4; ++i) { const float g0 = rs * acc[ai][0][m][0][i], g1 = rs * acc[ai][0][m][1][i]; o[i] = g0 * sigmoidf_(g0) * (rs * acc[ai][1][m][0][i]); o[4 + i] = g1 * sigmoidf_(g1) * (rs * acc[ai][1][m][1][i]); }
                *(pg8::u32x4*)(act + (size_t)row * 256 + (u.pn & 1) * 128 + wc * 32 + 8 * fq) = pack8(o);
            }
    }
};
struct EpiPle2 {
    static constexpr bool PERM = true, AFTER_DRAIN = false;
    float* x; const bf16_t* PP; const float* rstd;
    DI void operator()(const pg8::f32x4 (&acc)[2][2][4][2], const pg8::Unit& u, int wr, int wc, int fr, int fq) const {
        EPI_ROWS_BEGIN
            const size_t o = (size_t)row * DM + u.pn * 256 + c0; const float rs = rstd[row]; float pp[8];
            unpack8(*(const pg8::u32x4*)(PP + o), pp);
            const float4 b0 = *(const float4*)(x + o), b1 = *(const float4*)(x + o + 4);
            *(float4*)(x + o) = make_float4(b0.x + sigmoidf_(rs * v[0]) * pp[0], b0.y + sigmoidf_(rs * v[1]) * pp[1], b0.z + sigmoidf_(rs * v[2]) * pp[2], b0.w + sigmoidf_(rs * v[3]) * pp[3]);
            *(float4*)(x + o + 4) = make_float4(b1.x + sigmoidf_(rs * v[4]) * pp[4], b1.y + sigmoidf_(rs * v[5]) * pp[5], b1.z + sigmoidf_(rs * v[6]) * pp[6], b1.w + sigmoidf_(rs * v[7]) * pp[7]);
        EPI_ROWS_END
    }
};
struct MoeOrder {
    const int* cnt; int NJ, G, c;
    DI bool next(int i, pg8::Unit& u) const {
        int L = i * G + c, tb = 0;
        for (int e = 0; e < 16; ++e) { const int mt = (cnt[e * CNT_STRIDE] + 255) >> 8, n = mt * NJ; if (L < n) { u.pm = tb + L / NJ; u.pn = e * NJ + L % NJ; u.aux = L / NJ; return true; } L -= n; tb += mt; }
        return false;
    }
    DI void a_ready(const pg8::Unit&) const {}
    DI void done(const pg8::Unit&) const {}
};
struct OneUnit { pg8::Unit u; DI bool next(int i, pg8::Unit& o) const { o = u; return i == 0; } DI void a_ready(const pg8::Unit&) const {} DI void done(const pg8::Unit&) const {} };
struct PPOrder { int extra, G, c; DI bool next(int i, pg8::Unit& u) const { const int nl = G - extra, li = c - extra; if (li < 0 || nl <= 0) return false; const int id = li + i * nl; if (id >= 256) return false; u.pm = id >> 2; u.pn = id & 3; u.aux = 0; return true; }
    DI void a_ready(const pg8::Unit&) const {} DI void done(const pg8::Unit&) const {} };
DI int moe_base_row(const int* cnt, int e) { int tb = 0; for (int k = 0; k < 16; ++k) { if (k < e) tb += (cnt[k * CNT_STRIDE] + 255) >> 8; } return tb * 256; }
struct MapId { DI int operator()(int n) const { return n; } };
struct MapE13 { DI int operator()(int n) const { return ((n >> 7) & 1) * 256 + (n >> 8) * 128 + (n & 127); } };

DI void router_stage(__attribute__((address_space(3))) float* Wl, const float* __restrict__ g, const float* __restrict__ w_rg, const float* __restrict__ w_re, int tx) {
    for (int e = tx; e < 4096; e += 512) { const int k = e >> 2, c = e & 3; Wl[c * 1024 + k] = w_rg[e] * g[k]; }
    for (int e = tx; e < 16384; e += 512) { const int k = e >> 4, c = e & 15; Wl[(4 + c) * 1024 + k] = w_re[e] * g[k]; }
}
DI void router2(int tok, int lane, const float* __restrict__ x, const __attribute__((address_space(3))) float* Wl, const float* __restrict__ b_rg, const float* __restrict__ b_re,
                float* __restrict__ rstd1, __attribute__((address_space(3))) int* lcnt, __attribute__((address_space(3))) int* lri) {
    typedef float f4v __attribute__((ext_vector_type(4)));
    f4v xv[4]; float s = 0.f;
#pragma unroll
    for (int j = 0; j < 4; ++j) { const float4 v = ((const float4*)(x + (size_t)tok * DM))[lane + 64 * j]; xv[j] = (f4v){v.x, v.y, v.z, v.w}; s += v.x * v.x + v.y * v.y + v.z * v.z + v.w * v.w; }
    const float rstd = rsqrtf(wave_sum(s) * (1.f / DM) + 1e-6f);
    float al[20];
#pragma unroll
    for (int c = 0; c < 20; ++c) {
        float a = 0.f;
#pragma unroll
        for (int j = 0; j < 4; ++j) { const f4v w = *(const __attribute__((address_space(3))) f4v*)(Wl + c * 1024 + 4 * (lane + 64 * j)); a += (xv[j].x * w.x + xv[j].y * w.y) + (xv[j].z * w.z + xv[j].w * w.w); }
        al[c] = a;
    }
    {
        const int l_ = lane_id_opaque();
#pragma unroll
        for (int o = 1; o < 64; o <<= 1) {
            float t[20];
#pragma unroll
            for (int c = 0; c < 20; ++c) t[c] = lane_xor(al[c], o, l_);
#pragma unroll
            for (int c = 0; c < 20; ++c) al[c] += t[c];
        }
    }
    float gl[4], el[16];
#pragma unroll
    for (int c = 0; c < 4; ++c) gl[c] = al[c] * rstd + b_rg[c];
#pragma unroll
    for (int c = 0; c < 16; ++c) el[c] = al[4 + c] * rstd + b_re[c];
    if (lane == 0) {
        int gs = 0; float gm = gl[0];
#pragma unroll
        for (int c = 1; c < 4; ++c) if (gl[c] > gm) { gm = gl[c]; gs = c; }
        float se = 0.f;
#pragma unroll
        for (int c = 0; c < 4; ++c) se += __expf(gl[c] - gm);
        const float pg = 1.f / se;
        float e4[4];
#pragma unroll
        for (int c = 0; c < 4; ++c) e4[c] = gs == 0 ? el[c] : gs == 1 ? el[4 + c] : gs == 2 ? el[8 + c] : el[12 + c];
        int i0 = 0; float v0 = e4[0];
#pragma unroll
        for (int c = 1; c < 4; ++c) if (e4[c] > v0) { v0 = e4[c]; i0 = c; }
        int i1 = -1; float v1 = -3.0e38f;
#pragma unroll
        for (int c = 0; c < 4; ++c) if (c != i0 && e4[c] > v1) { v1 = e4[c]; i1 = c; }
        const float ex = __expf(v1 - v0);
        const float w0 = pg / (1.f + ex), w1 = pg * ex / (1.f + ex);
        const int e0 = gs * 4 + i0, e1 = gs * 4 + i1;
        const int p0 = __hip_atomic_fetch_add(lcnt + e0, 1, __ATOMIC_RELAXED, __HIP_MEMORY_SCOPE_WORKGROUP), p1 = __hip_atomic_fetch_add(lcnt + e1, 1, __ATOMIC_RELAXED, __HIP_MEMORY_SCOPE_WORKGROUP);
        rstd1[tok] = rstd;
        lri[0] = e0 | (e1 << 8); lri[1] = p0 | (p1 << 16); lri[2] = __float_as_int(w0); lri[3] = __float_as_int(w1);
    }
}

struct BMapId { DI int operator()(int n) const { return n; } };
struct BMapMoe { DI int operator()(int n) const { const int t = n >> 7, c = n & 127, e = t >> 2, jt = t & 3; return e * (1024 * 512) + ((c >> 5) & 1) * 256 + jt * 64 + (c >> 6) * 32 + (c & 31); } };
template <class Epi, class BMap>
DI void gemm_v1(int bx, int by, int tid, char* sm, const bf16_t* __restrict__ A, int lda, const float* __restrict__ B, int ldb, int N, int K, Epi epi, BMap bmap) {
    bf16_t* As = (bf16_t*)sm;
    bf16_t* Bs = (bf16_t*)(sm + 128 * 40 * 2);
    const int lane = tid & 63, w = tid >> 6, wr = w >> 1, wc = w & 1, r32 = lane & 31, hi = lane >> 5;
    const int m0 = by * 128, n0 = bx * 128;
    f32x16 acc[2][2];
#pragma unroll
    for (int i = 0; i < 2; ++i)
#pragma unroll
        for (int j = 0; j < 2; ++j)
#pragma unroll
            for (int r = 0; r < 16; ++r) acc[i][j][r] = 0.f;
    for (int k0 = 0; k0 < K; k0 += 32) {
#pragma unroll
        for (int i = 0; i < 2; ++i) {
            const int c = tid + i * 256, row = c >> 2, col = (c & 3) * 8;
            const uint4 v = *(const uint4*)(A + (size_t)(m0 + row) * lda + k0 + col);
            *(uint4*)(As + row * 40 + col) = v;
        }
#pragma unroll
        for (int i = 0; i < 4; ++i) {
            const int idx = tid + i * 256, k = idx >> 5, n = (idx & 31) * 4;
            float4 v = make_float4(0.f, 0.f, 0.f, 0.f);
            if (n0 + n < N) v = *(const float4*)(B + (size_t)(k0 + k) * ldb + bmap(n0 + n));
            Bs[(n + 0) * 40 + k] = f2bf(v.x); Bs[(n + 1) * 40 + k] = f2bf(v.y); Bs[(n + 2) * 40 + k] = f2bf(v.z); Bs[(n + 3) * 40 + k] = f2bf(v.w);
        }
        __syncthreads();
#pragma unroll
        for (int kk = 0; kk < 32; kk += 16) {
            bf16x8 a[2], b[2];
#pragma unroll
            for (int i = 0; i < 2; ++i) a[i] = *(const bf16x8*)(As + (wr * 64 + i * 32 + r32) * 40 + kk + hi * 8);
#pragma unroll
            for (int j = 0; j < 2; ++j) b[j] = *(const bf16x8*)(Bs + (wc * 64 + j * 32 + r32) * 40 + kk + hi * 8);
#pragma unroll
            for (int i = 0; i < 2; ++i)
#pragma unroll
                for (int j = 0; j < 2; ++j) acc[i][j] = __builtin_amdgcn_mfma_f32_32x32x16_bf16(a[i], b[j], acc[i][j], 0, 0, 0);
        }
        __syncthreads();
    }
#pragma unroll
    for (int i = 0; i < 2; ++i)
#pragma unroll
        for (int j = 0; j < 2; ++j)
#pragma unroll
            for (int r = 0; r < 16; ++r) {
                const int row = m0 + wr * 64 + i * 32 + (r & 3) + 8 * (r >> 2) + 4 * hi;
                const int col = n0 + wc * 64 + j * 32 + r32;
                if constexpr (Epi::PAIR) { if (j == 0) epi.pair(row, col, acc[i][0][r], acc[i][1][r]); }
                else { if (col < N) epi(row, col, acc[i][j][r]); }
            }
}

struct EpiPa { static constexpr bool PAIR = false;
    const bf16_t* MG; float* tmp;
    DI void operator()(int row, int col, float v) const { tmp[(size_t)row * DM + col] = bf2f(MG[(size_t)row * 2048 + col]) * v; }
};
struct EpiPb { static constexpr bool PAIR = false;
    const bf16_t* MG; const float* tmp; bf16_t* mixed;
    DI void operator()(int row, int col, float v) const {
        mixed[(size_t)row * DM + col] = f2bf(tmp[(size_t)row * DM + col] + bf2f(MG[(size_t)row * 2048 + 1024 + col]) * v);
    }
};
struct EpiResid { static constexpr bool PAIR = false;
    const float* base; float* out;
    DI void operator()(int row, int col, float v) const { out[(size_t)row * DM + col] = base[(size_t)row * DM + col] + v; }
};
struct EpiBf { static constexpr bool PAIR = false;
    bf16_t* o; int ld;
    DI void operator()(int row, int col, float v) const { o[(size_t)row * ld + col] = f2bf(v); }
};
struct EpiF32 { static constexpr bool PAIR = false;
    float* o; int ld;
    DI void operator()(int row, int col, float v) const { o[(size_t)row * ld + col] = v; }
};
struct EpiPle { static constexpr bool PAIR = false;
    float* x; const float* pp;
    DI void operator()(int row, int col, float v) const { const size_t i = (size_t)row * DM + col; x[i] = x[i] + sigmoidf_(v) * pp[i]; }
};

DI void rmsnorm_rows(int bx, int tid, const float* x, const float* __restrict__ g, bf16_t* outb, float* outf, int rows) {
    const int row = bx * 4 + (tid >> 6), lane = tid & 63;
    if (row >= rows) return;
    const float4* xr = (const float4*)(x + (size_t)row * DM);
    float4 v[4]; float s = 0.f;
#pragma unroll
    for (int j = 0; j < 4; ++j) { v[j] = xr[lane + 64 * j]; s += v[j].x * v[j].x + v[j].y * v[j].y + v[j].z * v[j].z + v[j].w * v[j].w; }
    const float rstd = rsqrtf(wave_sum(s) * (1.f / DM) + 1e-6f);
#pragma unroll
    for (int j = 0; j < 4; ++j) {
        const float4 gg = ((const float4*)g)[lane + 64 * j];
        const float a = v[j].x * rstd * gg.x, b = v[j].y * rstd * gg.y, c = v[j].z * rstd * gg.z, d = v[j].w * rstd * gg.w;
        if (outf) ((float4*)(outf + (size_t)row * DM))[lane + 64 * j] = make_float4(a, b, c, d);
        else { ushort4 o; o.x = f2bf(a); o.y = f2bf(b); o.z = f2bf(c); o.w = f2bf(d); ((ushort4*)(outb + (size_t)row * DM))[lane + 64 * j] = o; }
    }
}

DI void cvt_bf16(int bx, int nb, int tid, const float* __restrict__ in, bf16_t* __restrict__ out, size_t n) {
    for (size_t i = bx * (size_t)256 + tid; i < n; i += (size_t)nb * 256) out[i] = f2bf(in[i]);
}

DI float gelu_tanh(float x) { const float u = 0.7978845608028654f * (x + 0.044715f * x * x * x); return 0.5f * x * (1.f + tanhf(u)); }

DI void compress_naive(int bx, int by, int bz, int tid, char* sm, const bf16_t* __restrict__ KVb, const float* __restrict__ w1k, const float* __restrict__ w2k, const float* __restrict__ pek,
                                                      const float* __restrict__ w1v, const float* __restrict__ w2v, const float* __restrict__ pev, float* __restrict__ outk, float* __restrict__ outv, bf16_t* __restrict__ kcb, bf16_t* __restrict__ vcT) {
    float* flat = (float*)sm;
    float* h1 = flat + 2048;
    __syncthreads();
    const int j = bx, bg = by, kv = bz, b = bg >> 1, g = bg & 1;
    const float* w1 = kv ? w1v : w1k; const float* w2 = kv ? w2v : w2k; const float* pe = kv ? pev : pek; float* out = kv ? outv : outk;
    const int colbase = (kv ? 128 : 0) + g * 64;
    for (int e = tid; e < 2048; e += 256) {
        const int i = e >> 6, d = e & 63;
        flat[e] = bf2f(KVb[(size_t)(b * SEQ + 16 * j + i) * 512 + colbase + d]) + pe[e];
    }
    __syncthreads();
    float s = 0.f;
    for (int k = 0; k < 2048; ++k) s += flat[k] * w1[(size_t)k * 256 + tid];
    h1[tid] = gelu_tanh(s);
    __syncthreads();
    if (tid < 64) {
        float o = 0.f;
        for (int n = 0; n < 256; ++n) o += h1[n] * w2[n * 64 + tid];
        out[((size_t)bg * 256 + j) * 64 + tid] = o;
        if (kv == 0) { kcb[((size_t)bg * 256 + j) * 64 + tid] = f2bf(o); if (j == 254) kcb[((size_t)bg * 256 + 255) * 64 + tid] = 0; }
        else { vcT[((size_t)bg * 4 + (j >> 6)) * 4096 + tid * 64 + (j & 63)] = f2bf(o); if (j == 254) vcT[((size_t)bg * 4 + 3) * 4096 + tid * 64 + 63] = 0; }
    }
}

DI void softmax_row(float* row, int n, int lane) {
    float m = -3.0e38f;
    for (int j = lane; j < n; j += 64) m = fmaxf(m, row[j]);
    m = wave_max(m);
    float s = 0.f;
    for (int j = lane; j < n; j += 64) { const float e = exp2f(row[j] - m); row[j] = e; s += e; }
    s = wave_sum(s);
    const float inv = 1.f / s;
    for (int j = lane; j < n; j += 64) row[j] *= inv;
}

DI void nsa_naive(int bx, int by, int tid, char* sm, const bf16_t* __restrict__ Qb, const bf16_t* __restrict__ KVb, const bf16_t* __restrict__ VT, const float* __restrict__ kcc, const float* __restrict__ vcc, const float* __restrict__ gates, bf16_t* __restrict__ Y) {
    float (*q)[64] = (float (*)[64])sm;
    float (*sc)[1024] = (float (*)[1024])(sm + 1024);
    float* impv = (float*)(sm + 1024 + 16384);
    int* sellist = (int*)(sm + 1024 + 16384 + 256);
    int* selflag = (int*)(sm + 1024 + 16384 + 256 + 64);
    int& nsel_s = *(int*)(sm + 1024 + 16384 + 256 + 64 + 256);
    __syncthreads();
    const int tok = bx, g = by, b = tok >> 12, t = tok & 4095, hh = tid >> 6, lane = tid & 63, d = lane;
    q[hh][d] = bf2f(Qb[(size_t)tok * 512 + (g * 4 + hh) * 64 + d]);
    __syncthreads();
    const int nv = (t >= 31) ? ((t - 15) >> 4) : 0;
    const float* kcb = kcc + (size_t)(b * 2 + g) * 256 * 64; const float* vcb = vcc + (size_t)(b * 2 + g) * 256 * 64;
    if (tid < nv) {
        float s0 = 0.f, s1 = 0.f, s2 = 0.f, s3 = 0.f;
#pragma unroll 8
        for (int dd = 0; dd < 64; ++dd) { const float kx = kcb[tid * 64 + dd]; s0 += q[0][dd] * kx; s1 += q[1][dd] * kx; s2 += q[2][dd] * kx; s3 += q[3][dd] * kx; }
        sc[0][tid] = s0; sc[1][tid] = s1; sc[2][tid] = s2; sc[3][tid] = s3;
    }
    __syncthreads();
    if (nv > 0) softmax_row(sc[hh], nv, lane);
    for (int j = nv + lane; j < 256; j += 64) sc[hh][j] = 0.f;
    __syncthreads();
    float o_cmp = 0.f;
    for (int j = 0; j < nv; ++j) o_cmp += sc[hh][j] * vcb[j * 64 + d];
    const int cur = t >> 6;
    if (tid < 64) {
        const int s = tid; int lo = 4 * s - 1; if (lo < 0) lo = 0; int hi2 = 4 * s + 3; if (hi2 > 254) hi2 = 254;
        float v = 0.f;
        for (int h2 = 0; h2 < 4; ++h2) for (int j = lo; j <= hi2; ++j) v += sc[h2][j];
        if (s == 0 || s == cur || s == cur - 1) v += 1000.0f;
        if (s > cur) v = -1e30f;
        impv[s] = v;
    }
    __syncthreads();
    if (tid < 64) {
        const float v = impv[tid]; int rank = 0;
        for (int s2 = 0; s2 < 64; ++s2) { const float u = impv[s2]; rank += (u > v || (u == v && s2 < tid)) ? 1 : 0; }
        selflag[tid] = (rank < 16 && tid <= cur) ? 1 : 0;
    }
    __syncthreads();
    if (tid == 0) { int n = 0; for (int s = 0; s < 64; ++s) if (selflag[s]) { if (n < 16) sellist[n] = s; ++n; } nsel_s = n < 16 ? n : 16; }
    __syncthreads();
    const int ns = nsel_s, ne = ns * 64;
    for (int e = tid; e < ne; e += 256) {
        const int kpos = sellist[e >> 6] * 64 + (e & 63);
        if (kpos <= t) {
            const bf16_t* kp = KVb + (size_t)(b * SEQ + kpos) * 512 + 256 + g * 64;
            float s0 = 0.f, s1 = 0.f, s2 = 0.f, s3 = 0.f;
    #pragma unroll 8
        for (int dd = 0; dd < 64; ++dd) { const float kx = bf2f(kp[dd]); s0 += q[0][dd] * kx; s1 += q[1][dd] * kx; s2 += q[2][dd] * kx; s3 += q[3][dd] * kx; }
            sc[0][e] = s0; sc[1][e] = s1; sc[2][e] = s2; sc[3][e] = s3;
        } else { sc[0][e] = -1e30f; sc[1][e] = -1e30f; sc[2][e] = -1e30f; sc[3][e] = -1e30f; }
    }
    __syncthreads();
    softmax_row(sc[hh], ne, lane);
    __syncthreads();
    float o_sel = 0.f;
    for (int e = 0; e < ne; ++e) {
        const int kpos = sellist[e >> 6] * 64 + (e & 63);
        o_sel += sc[hh][e] * bf2f(VT[((size_t)(b * 2 + g) * 64 + (kpos >> 6)) * 4096 + d * 64 + (kpos & 63)]);
    }
    __syncthreads();
    const int nw = (t + 1 < 512) ? (t + 1) : 512, w0 = t - nw + 1;
    for (int e = tid; e < nw; e += 256) {
        const bf16_t* kp = KVb + (size_t)(b * SEQ + w0 + e) * 512 + 384 + g * 64;
        float s0 = 0.f, s1 = 0.f, s2 = 0.f, s3 = 0.f;
#pragma unroll 8
        for (int dd = 0; dd < 64; ++dd) { const float kx = bf2f(kp[dd]); s0 += q[0][dd] * kx; s1 += q[1][dd] * kx; s2 += q[2][dd] * kx; s3 += q[3][dd] * kx; }
        sc[0][e] = s0; sc[1][e] = s1; sc[2][e] = s2; sc[3][e] = s3;
    }
    __syncthreads();
    softmax_row(sc[hh], nw, lane);
    __syncthreads();
    float o_win = 0.f;
    for (int e = 0; e < nw; ++e) { const int kpos = w0 + e; o_win += sc[hh][e] * bf2f(VT[((size_t)(8 + b * 2 + g) * 64 + (kpos >> 6)) * 4096 + d * 64 + (kpos & 63)]); }
    const float* gt = gates + (size_t)tok * 24 + (g * 4 + hh) * 3;
    Y[(size_t)tok * DM + (g * 4 + hh) * 64 + d] = f2bf(gt[0] * o_cmp + gt[1] * o_sel + gt[2] * o_win);
}

DI void conv_silu(int bx, int tid, const bf16_t* __restrict__ MQK, const float* __restrict__ wc, const float* __restrict__ bc, bf16_t* __restrict__ out) {
    const int idx = bx * 256 + tid;
    if (idx >= T_TOK * 1024) return;
    const int c = idx & 1023, tok = idx >> 10, t = tok & 4095;
    float y = bc[c];
#pragma unroll
    for (int j = 0; j < 4; ++j) { const int tt = t - 3 + j; if (tt >= 0) y += wc[j * 1024 + c] * bf2f(MQK[(size_t)(tok - 3 + j) * 1024 + c]); }
    y = y * sigmoidf_(y);
    if (c >= 512) y *= 0.08838834764831845f;
    out[idx] = f2bf(y);
}

DI void mlstm_naive(int bx, int tid, char* sm, const bf16_t* __restrict__ qkc, const bf16_t* __restrict__ MV, const bf16_t* __restrict__ MO, const float* __restrict__ ifp, float* __restrict__ hm) {
    float (*qs)[128] = (float (*)[128])sm;
    float (*ks)[128] = (float (*)[128])(sm + 16384);
    float (*vs)[16] = (float (*)[16])(sm + 32768);
    float (*os)[16] = (float (*)[16])(sm + 32768 + 2048);
    float* gi = (float*)(sm + 32768 + 4096); float* gf = gi + 32;
    const int bh = bx >> 3, vsl = bx & 7, b = bh >> 2, h = bh & 3, v = tid >> 4, kg = tid & 15;
    float C[8], n[8];
#pragma unroll
    for (int j = 0; j < 8; ++j) { C[j] = 0.f; n[j] = 0.f; }
    for (int c0 = 0; c0 < SEQ; c0 += 32) {
        __syncthreads();
        for (int e = tid; e < 32 * 128; e += 256) {
            const int s = e >> 7, k = e & 127; const size_t tok = (size_t)b * SEQ + c0 + s;
            qs[s][k] = bf2f(qkc[tok * 1024 + h * 128 + k]); ks[s][k] = bf2f(qkc[tok * 1024 + 512 + h * 128 + k]);
        }
        for (int e = tid; e < 32 * 16; e += 256) {
            const int s = e >> 4, vv = e & 15; const size_t tok = (size_t)b * SEQ + c0 + s;
            vs[s][vv] = bf2f(MV[tok * 512 + h * 128 + vsl * 16 + vv]);
            os[s][vv] = sigmoidf_(bf2f(MO[tok * 512 + h * 128 + vsl * 16 + vv]));
        }
        if (tid < 32) { const size_t tok = (size_t)b * SEQ + c0 + tid; gi[tid] = __expf(ifp[tok * 8 + h]); gf[tid] = sigmoidf_(ifp[tok * 8 + 4 + h]); }
        __syncthreads();
        for (int s = 0; s < 32; ++s) {
            const float f = gf[s], iv = gi[s] * vs[s][v], ig = gi[s];
            float num = 0.f, den = 0.f;
#pragma unroll
            for (int j = 0; j < 8; ++j) {
                const float kx = ks[s][kg * 8 + j], qx = qs[s][kg * 8 + j];
                C[j] = f * C[j] + iv * kx; n[j] = f * n[j] + ig * kx;
                num += C[j] * qx; den += n[j] * qx;
            }
            const int l_ = lane_id_opaque();
#pragma unroll
            for (int o = 1; o < 16; o <<= 1) { num += lane_xor(num, o, l_); den += lane_xor(den, o, l_); }
            if (kg == 0) hm[((size_t)b * SEQ + c0 + s) * 512 + h * 128 + vsl * 16 + v] = num / fmaxf(fabsf(den), 1.0f) * os[s][v];
        }
    }
}

DI void hnorm(int bx, int tid, const float* __restrict__ hm, const float* __restrict__ g_hn, bf16_t* __restrict__ Y) {
    const int item = bx * 4 + (tid >> 6), lane = tid & 63;
    const int tok = item >> 2, h = item & 3;
    const float a = hm[(size_t)tok * 512 + h * 128 + lane], b = hm[(size_t)tok * 512 + h * 128 + 64 + lane];
    const float rstd = rsqrtf(wave_sum(a * a + b * b) * (1.f / 128.f) + 1e-6f);
    Y[(size_t)tok * DM + 512 + h * 128 + lane] = f2bf(a * rstd * g_hn[h * 128 + lane]);
    Y[(size_t)tok * DM + 512 + h * 128 + 64 + lane] = f2bf(b * rstd * g_hn[h * 128 + 64 + lane]);
}

DI void router(int bx, int tid, const float* __restrict__ x, const float* __restrict__ g, const float* __restrict__ w_rg, const float* __restrict__ b_rg,
                                              const float* __restrict__ w_re, const float* __restrict__ b_re, bf16_t* __restrict__ xn, float* __restrict__ gate) {
    const int tok = bx * 4 + (tid >> 6), lane = tid & 63;
    float xv[16]; float s = 0.f;
#pragma unroll
    for (int j = 0; j < 4; ++j) { const float4 v = ((const float4*)(x + (size_t)tok * DM))[lane + 64 * j]; xv[4 * j] = v.x; xv[4 * j + 1] = v.y; xv[4 * j + 2] = v.z; xv[4 * j + 3] = v.w; s += v.x * v.x + v.y * v.y + v.z * v.z + v.w * v.w; }
    const float rstd = rsqrtf(wave_sum(s) * (1.f / DM) + 1e-6f);
#pragma unroll
    for (int j = 0; j < 4; ++j) { const float4 gg = ((const float4*)g)[lane + 64 * j]; xv[4 * j] *= rstd * gg.x; xv[4 * j + 1] *= rstd * gg.y; xv[4 * j + 2] *= rstd * gg.z; xv[4 * j + 3] *= rstd * gg.w;
        ushort4 o; o.x = f2bf(xv[4 * j]); o.y = f2bf(xv[4 * j + 1]); o.z = f2bf(xv[4 * j + 2]); o.w = f2bf(xv[4 * j + 3]); ((ushort4*)(xn + (size_t)tok * DM))[lane + 64 * j] = o; }
    float mylog = 0.f;
#pragma unroll 1
    for (int c = 0; c < 20; ++c) {
        const float* w = c < 4 ? w_rg + c : w_re + (c - 4); const int ld = c < 4 ? 4 : 16;
        float a = 0.f;
#pragma unroll
        for (int j = 0; j < 4; ++j)
#pragma unroll
            for (int i = 0; i < 4; ++i) a += xv[4 * j + i] * w[(size_t)(4 * (lane + 64 * j) + i) * ld];
        a = wave_sum(a) + (c < 4 ? b_rg[c] : b_re[c - 4]);
        if (lane == c) mylog = a;
    }
    float gl[4], el[16];
#pragma unroll
    for (int c = 0; c < 4; ++c) gl[c] = lane_get(mylog, c);
#pragma unroll
    for (int c = 0; c < 16; ++c) el[c] = lane_get(mylog, 4 + c);
    if (lane == 0) {
        int gs = 0; float gm = gl[0];
#pragma unroll
        for (int c = 1; c < 4; ++c) if (gl[c] > gm) { gm = gl[c]; gs = c; }
        float se = 0.f;
#pragma unroll
        for (int c = 0; c < 4; ++c) se += __expf(gl[c] - gm);
        const float pg = 1.f / se;
        float e4[4];
#pragma unroll
        for (int c = 0; c < 4; ++c) e4[c] = gs == 0 ? el[c] : gs == 1 ? el[4 + c] : gs == 2 ? el[8 + c] : el[12 + c];
        int i0 = 0; float v0 = e4[0];
#pragma unroll
        for (int c = 1; c < 4; ++c) if (e4[c] > v0) { v0 = e4[c]; i0 = c; }
        int i1 = -1; float v1 = -3.0e38f;
#pragma unroll
        for (int c = 0; c < 4; ++c) if (c != i0 && e4[c] > v1) { v1 = e4[c]; i1 = c; }
        const float ex = __expf(v1 - v0);
        const float w0 = pg / (1.f + ex), w1 = pg * ex / (1.f + ex);
#pragma unroll
        for (int c = 0; c < 16; ++c) gate[(size_t)tok * 16 + c] = (c == gs * 4 + i0) ? w0 : (c == gs * 4 + i1) ? w1 : 0.f;
    }
}


struct EpiMoe { static constexpr bool PAIR = true;
    const float* gate; bf16_t* act;
    DI void operator()(int, int, float) const {}
    DI void pair(int row, int col, float gg, float u) const {
        const int t = col >> 7, c = col & 127, e = t >> 2, jt = t & 3, f = jt * 64 + (c >> 6) * 32 + (c & 31);
        act[(size_t)row * 4096 + e * 256 + f] = f2bf(gg * sigmoidf_(gg) * u * gate[(size_t)row * 16 + e]);
    }
};

typedef float f32x2_t __attribute__((ext_vector_type(2))); typedef __bf16 bf16x2_t __attribute__((ext_vector_type(2)));
DI unsigned cvtpk(float lo, float hi) { f32x2_t v = {lo, hi}; bf16x2_t b = __builtin_convertvector(v, bf16x2_t); return __builtin_bit_cast(unsigned, b); }
typedef __attribute__((address_space(3))) char lds_c;
typedef unsigned u32x2v __attribute__((ext_vector_type(2))); typedef unsigned u32x4v __attribute__((ext_vector_type(4)));
constexpr int NSA_KC = 0, NSA_VC = 4 * 9216, NSA_KB = NSA_VC + 4 * 8704, NSA_VB = NSA_KB + 2 * 9216, NSA_IMP = NSA_VB + 2 * 8704, NSA_MASK = NSA_IMP + 64 * 65 * 4, NSA_END = NSA_MASK + 512;
static_assert(NSA_END <= 147456, "NSA LDS map");
DI int crow(int r, int hi) { return (r & 3) + 8 * (r >> 2) + 4 * hi; }
#define MFMA32(a, b, c) __builtin_amdgcn_mfma_f32_32x32x16_bf16((a), (b), (c), 0, 0, 0)

DI void nsa_qk(f32x16& p0, f32x16& p1, const lds_c* K, const bf16x8 (&qf)[4], float cin, int r32, int hi) {
    f32x16 c;
#pragma unroll
    for (int r = 0; r < 16; ++r) c[r] = cin;
#pragma unroll
    for (int ks = 0; ks < 4; ++ks) {
        const bf16x8 a0 = *(const __attribute__((address_space(3))) bf16x8*)(K + r32 * 144 + ks * 32 + hi * 16);
        const bf16x8 a1 = *(const __attribute__((address_space(3))) bf16x8*)(K + (32 + r32) * 144 + ks * 32 + hi * 16);
        if (ks == 0) { p0 = MFMA32(a0, qf[0], c); p1 = MFMA32(a1, qf[0], c); } else { p0 = MFMA32(a0, qf[ks], p0); p1 = MFMA32(a1, qf[ks], p1); }
    }
}
DI void nsa_softmax(f32x16& p0, f32x16& p1, float& mref, float& l, bool& started, f32x16& o0, f32x16& o1) {
    float mx = fmaxf(p0[0], p1[0]);
#pragma unroll
    for (int r = 1; r < 16; ++r) mx = fmaxf(mx, fmaxf(p0[r], p1[r]));
    { auto rr = __builtin_amdgcn_permlane32_swap(__float_as_uint(mx), __float_as_uint(mx), false, false); mx = fmaxf(__uint_as_float(rr[0]), __uint_as_float(rr[1])); }
    const bool need = started ? (mx > 8.f) : (mx > -3.0e38f);
    if (__any(need)) {
        const float delta = need ? mx : 0.f, f = started ? __builtin_amdgcn_exp2f(-delta) : 1.f;
        mref += delta;
#pragma unroll
        for (int r = 0; r < 16; ++r) { p0[r] -= delta; p1[r] -= delta; o0[r] *= f; o1[r] *= f; }
        l *= f; started = started || need;
    }
    float s = 0.f;
#pragma unroll
    for (int r = 0; r < 16; ++r) { p0[r] = __builtin_amdgcn_exp2f(p0[r]); p1[r] = __builtin_amdgcn_exp2f(p1[r]); s += p0[r] + p1[r]; }
    l += s;
}
DI void nsa_pv(f32x16& o0, f32x16& o1, const f32x16& p0, const f32x16& p1, const lds_c* V, int r32, int hi) {
#pragma unroll
    for (int hf = 0; hf < 2; ++hf)
#pragma unroll
        for (int s = 0; s < 2; ++s) {
            unsigned pw[4];
#pragma unroll
            for (int j = 0; j < 4; ++j) pw[j] = hf ? cvtpk(p1[8 * s + 2 * j], p1[8 * s + 2 * j + 1]) : cvtpk(p0[8 * s + 2 * j], p0[8 * s + 2 * j + 1]);
            const u32x4v pbw = {pw[0], pw[1], pw[2], pw[3]};
            const bf16x8 pb = __builtin_bit_cast(bf16x8, pbw);
            const lds_c* vp = V + r32 * 136 + hf * 64 + s * 32 + hi * 8;
            const u32x2v a0l = *(const __attribute__((address_space(3))) u32x2v*)(vp), a0h = *(const __attribute__((address_space(3))) u32x2v*)(vp + 16);
            const u32x2v a1l = *(const __attribute__((address_space(3))) u32x2v*)(vp + 32 * 136), a1h = *(const __attribute__((address_space(3))) u32x2v*)(vp + 32 * 136 + 16);
            const u32x4v A0w = {a0l.x, a0l.y, a0h.x, a0h.y}, A1w = {a1l.x, a1l.y, a1h.x, a1h.y};
            o0 = MFMA32(__builtin_bit_cast(bf16x8, A0w), pb, o0); o1 = MFMA32(__builtin_bit_cast(bf16x8, A1w), pb, o1);
        }
}
DI void nsa_store_k(lds_c* K, const u32x4v v, int tid) { *(__attribute__((address_space(3))) u32x4v*)(K + (tid >> 3) * 144 + (tid & 7) * 16) = v; }
DI void nsa_store_v(lds_c* V, const u32x4v v, int tid) { lds_c* p = V + (tid >> 3) * 136 + (tid & 7) * 16; *(__attribute__((address_space(3))) u32x2v*)p = (u32x2v){v.x, v.y}; *(__attribute__((address_space(3))) u32x2v*)(p + 8) = (u32x2v){v.z, v.w}; }
#define NEG_INF (-__builtin_inff())
DI void nsa_finish(f32x16& y0, f32x16& y1, f32x16& o0, f32x16& o1, float& m, float& l, bool& started, float gate) {
    float lt; { auto rr = __builtin_amdgcn_permlane32_swap(__float_as_uint(l), __float_as_uint(l), false, false); lt = __uint_as_float(rr[0]) + __uint_as_float(rr[1]); }
    const float f = lt > 0.f ? gate / lt : 0.f;
#pragma unroll
    for (int r = 0; r < 16; ++r) { y0[r] += f * o0[r]; y1[r] += f * o1[r]; o0[r] = 0.f; o1[r] = 0.f; }
    m = 0.f; l = 0.f; started = false;
}

DI void nsa_unit(int bg, int qb, int tx, lds_c* lds, const bf16_t* __restrict__ Qb, const bf16_t* __restrict__ KVb, const bf16_t* __restrict__ VT, const bf16_t* __restrict__ kcb, const bf16_t* __restrict__ vcT,
                 const float* __restrict__ gates, bf16_t* __restrict__ Y, unsigned long long& pacc) {
    const int lane = tx & 63, r32 = lane & 31, hi = lane >> 5, wave = __builtin_amdgcn_readfirstlane(tx >> 6), hh = wave >> 1, qs = wave & 1;
#define RG_BEGIN(id) unsigned long long rt0_##id = 0ull; if (SPIN_PHASE == (id) && blockIdx.x == 0) rt0_##id = __builtin_amdgcn_s_memrealtime();
#define RG_END(id) if (SPIN_PHASE == (id) && blockIdx.x == 0) pacc += __builtin_amdgcn_s_memrealtime() - rt0_##id;
    RG_BEGIN(100)
    const int b = bg >> 1, g = bg & 1, ql = 32 * qs + r32, tq = 64 * qb + ql;
    const size_t tok = (size_t)b * SEQ + tq; const int head = g * 4 + hh;
    const int nc = (4 * qb + 66) >> 6;
    const bool need_topk = qb >= 16;
    lds_c* KC = lds + NSA_KC; lds_c* VC = lds + NSA_VC; lds_c* KB = lds + NSA_KB; lds_c* VB = lds + NSA_VB;
    __attribute__((address_space(3))) float* imp = (__attribute__((address_space(3))) float*)(lds + NSA_IMP);
    __attribute__((address_space(3))) unsigned* msk = (__attribute__((address_space(3))) unsigned*)(lds + NSA_MASK);
    const bf16_t* kcsrc = kcb + (size_t)bg * 256 * 64; const bf16_t* vcsrc = vcT + (size_t)bg * 4 * 4096;
    const bf16_t* kssrc = KVb + (size_t)b * SEQ * 512 + 256 + g * 64; const bf16_t* kwsrc = KVb + (size_t)b * SEQ * 512 + 384 + g * 64;
    const bf16_t* vssrc = VT + (size_t)bg * 64 * 4096; const bf16_t* vwsrc = VT + (size_t)(8 + bg) * 64 * 4096;
    const int n_sel = qb + 1, n_win = qb + 1 < 9 ? qb + 1 : 9, ntile = n_sel + n_win;
    __syncthreads();
    for (int c = 0; c < nc; ++c) {
        nsa_store_k(KC + c * 9216, *(const u32x4v*)(kcsrc + (size_t)(c * 64 + (tx >> 3)) * 64 + (tx & 7) * 8), tx);
        nsa_store_v(VC + c * 8704, *(const u32x4v*)(vcsrc + (size_t)c * 4096 + (tx >> 3) * 64 + (tx & 7) * 8), tx);
    }
    nsa_store_k(KB, *(const u32x4v*)(kssrc + (size_t)(tx >> 3) * 512 + (tx & 7) * 8), tx);
    nsa_store_v(VB, *(const u32x4v*)(vssrc + (tx >> 3) * 64 + (tx & 7) * 8), tx);
    for (int i = tx; i < 64 * 65; i += 512) imp[i] = 0.f;
    bf16x8 qf[4];
#pragma unroll
    for (int ks = 0; ks < 4; ++ks) qf[ks] = *(const bf16x8*)(Qb + tok * 512 + head * 64 + ks * 16 + hi * 8);
    const float g_cmp = gates[tok * 24 + head * 3 + 0], g_sel = gates[tok * 24 + head * 3 + 1], g_win = gates[tok * 24 + head * 3 + 2];
    f32x16 y0, y1, o0, o1, p0, p1;
#pragma unroll
    for (int r = 0; r < 16; ++r) { y0[r] = 0.f; y1[r] = 0.f; o0[r] = 0.f; o1[r] = 0.f; }
    float m = 0.f, l = 0.f; bool started = false;
    __syncthreads();
    RG_END(100)
    RG_BEGIN(101)
    const int nvq = tq >= 31 ? ((tq - 15) >> 4) : 0;
    for (int c = 0; c < nc; ++c) {
        nsa_qk(p0, p1, KC + c * 9216, qf, -m, r32, hi);
        const int lim = nvq - 64 * c;
#pragma unroll
        for (int r = 0; r < 16; ++r) { const int kl = crow(r, hi); if (kl >= lim) p0[r] = NEG_INF; if (kl + 32 >= lim) p1[r] = NEG_INF; }
        nsa_softmax(p0, p1, m, l, started, o0, o1);
        nsa_pv(o0, o1, p0, p1, VC + c * 8704, r32, hi);
    }
    const float m_c = m; float l_c; { auto rr = __builtin_amdgcn_permlane32_swap(__float_as_uint(l), __float_as_uint(l), false, false); l_c = __uint_as_float(rr[0]) + __uint_as_float(rr[1]); }
    nsa_finish(y0, y1, o0, o1, m, l, started, g_cmp);
    RG_END(101)
    unsigned mlo = 0xffffffffu, mhi = 0xffffffffu;
    RG_BEGIN(102)
    if (need_topk) {
        const float invl = l_c > 0.f ? 16777216.f / l_c : 0.f;
        __attribute__((address_space(3))) unsigned* impu = (__attribute__((address_space(3))) unsigned*)imp;
        for (int c = 0; c < nc; ++c) {
            nsa_qk(p0, p1, KC + c * 9216, qf, -m_c, r32, hi);
            const int lim = nvq - 64 * c;
#pragma unroll
            for (int r = 0; r < 16; ++r) { const int kl = crow(r, hi);
                p0[r] = kl < lim ? __builtin_amdgcn_exp2f(p0[r]) * invl : 0.f; p1[r] = kl + 32 < lim ? __builtin_amdgcn_exp2f(p1[r]) * invl : 0.f; }
#pragma unroll
            for (int hf = 0; hf < 2; ++hf)
#pragma unroll
                for (int i = 0; i < 4; ++i) {
                    const int a = 16 * c + 8 * hf + 2 * i + hi;
                    const unsigned u0 = (unsigned)__float2uint_rn(hf ? p1[4 * i] : p0[4 * i]), u1 = (unsigned)__float2uint_rn(hf ? p1[4 * i + 1] : p0[4 * i + 1]);
                    const unsigned u2 = (unsigned)__float2uint_rn(hf ? p1[4 * i + 2] : p0[4 * i + 2]), u3 = (unsigned)__float2uint_rn(hf ? p1[4 * i + 3] : p0[4 * i + 3]);
                    __hip_atomic_fetch_add(impu + ql * 65 + a, u0 + u1 + u2 + u3, __ATOMIC_RELAXED, __HIP_MEMORY_SCOPE_WORKGROUP);
                    if (a + 1 < 64) __hip_atomic_fetch_add(impu + ql * 65 + a + 1, u3, __ATOMIC_RELAXED, __HIP_MEMORY_SCOPE_WORKGROUP);
                }
        }
        __syncthreads();
        RG_BEGIN(103)
        {
            const int q = tx >> 3, j8 = tx & 7, smax = qb - 2;
            unsigned key[8];
#pragma unroll
            for (int k = 0; k < 8; ++k) { const int sb = j8 + 8 * k; key[k] = (sb >= 1 && sb <= smax) ? ((impu[q * 65 + sb] & ~63u) | (unsigned)(63 - sb)) + 64u : 0u; }
            unsigned blo = 0u, bhi = 0u;
#pragma unroll 1
            for (int round = 0; round < 13; ++round) {
                unsigned mx = key[0];
#pragma unroll
                for (int k = 1; k < 8; ++k) mx = mx > key[k] ? mx : key[k];
                { const unsigned t = (unsigned)__builtin_amdgcn_update_dpp(0, (int)mx, 0xB1, 0xf, 0xf, true); mx = mx > t ? mx : t; }
                { const unsigned t = (unsigned)__builtin_amdgcn_update_dpp(0, (int)mx, 0x4E, 0xf, 0xf, true); mx = mx > t ? mx : t; }
                { const unsigned t = (unsigned)__builtin_amdgcn_update_dpp(0, (int)mx, 0x141, 0xf, 0xf, true); mx = mx > t ? mx : t; }
#pragma unroll
                for (int k = 0; k < 8; ++k) if (key[k] == mx && mx != 0u) { key[k] = 0u; const int sb = j8 + 8 * k; if (sb < 32) blo |= 1u << sb; else bhi |= 1u << (sb - 32); }
            }
            const int l_ = lane_id_opaque();
#pragma unroll
            for (int o = 1; o < 8; o <<= 1) { blo |= (unsigned)__builtin_amdgcn_ds_bpermute((l_ ^ o) << 2, (int)blo); bhi |= (unsigned)__builtin_amdgcn_ds_bpermute((l_ ^ o) << 2, (int)bhi); }
            unsigned long long mm = ((unsigned long long)bhi << 32) | blo;
            mm |= 1ull | (1ull << qb) | (1ull << (qb - 1));
            if (j8 == 0) { msk[q * 2] = (unsigned)mm; msk[q * 2 + 1] = (unsigned)(mm >> 32); }
        }
        __syncthreads();
        RG_END(103)
        mlo = msk[ql * 2]; mhi = msk[ql * 2 + 1];
    }
    RG_END(102)
    RG_BEGIN(104)
#define NSA_SRC(i_, KP, VP) do { const bool nsel_ = (i_) < n_sel; const int s2_ = nsel_ ? (i_) : qb - n_win + 1 + ((i_) - n_sel); \
        KP = (nsel_ ? kssrc : kwsrc) + (size_t)(s2_ * 64 + (tx >> 3)) * 512 + (tx & 7) * 8; VP = (nsel_ ? vssrc : vwsrc) + (size_t)s2_ * 4096 + (tx >> 3) * 64 + (tx & 7) * 8; } while (0)
#define NSA_TILE(i_, cur_, KLD, VLD, KST, VST) do { \
        const bool is_sel = (i_) < n_sel; const int s = is_sel ? (i_) : qb - n_win + 1 + ((i_) - n_sel); \
        if ((i_) + 2 < ntile) { const bf16_t* kp_; const bf16_t* vp_; NSA_SRC((i_) + 2, kp_, vp_); KLD = *(const u32x4v*)kp_; VLD = *(const u32x4v*)vp_; } \
        const bool on = !is_sel || ((s < 32 ? (mlo >> s) : (mhi >> (s - 32))) & 1u) != 0u; \
        nsa_qk(p0, p1, KB + (cur_) * 9216, qf, on ? -m : NEG_INF, r32, hi); \
        const bool lowb = !is_sel && (qb >= 8) && (s == qb - 8), diag = (s == qb); \
        if (lowb || diag) { \
            _Pragma("unroll") for (int r = 0; r < 16; ++r) { const int kl = crow(r, hi); \
                if ((lowb && kl <= ql) || (diag && kl > ql)) p0[r] = NEG_INF; if ((lowb && kl + 32 <= ql) || (diag && kl + 32 > ql)) p1[r] = NEG_INF; } \
        } \
        nsa_softmax(p0, p1, m, l, started, o0, o1); \
        nsa_pv(o0, o1, p0, p1, VB + (cur_) * 8704, r32, hi); \
        if ((i_) == n_sel - 1) nsa_finish(y0, y1, o0, o1, m, l, started, g_sel); \
        if ((i_) == ntile - 1) nsa_finish(y0, y1, o0, o1, m, l, started, g_win); \
        if ((i_) + 1 < ntile) { nsa_store_k(KB + ((cur_) ^ 1) * 9216, KST, tx); nsa_store_v(VB + ((cur_) ^ 1) * 8704, VST, tx); } \
        __syncthreads(); } while (0)
    u32x4v kA = {0u, 0u, 0u, 0u}, vA = kA, kB2 = kA, vB2 = kA;
    if (ntile > 1) { const bf16_t* kp_; const bf16_t* vp_; NSA_SRC(1, kp_, vp_); kA = *(const u32x4v*)kp_; vA = *(const u32x4v*)vp_; }
    {
        int i = 0;
        for (; i + 1 < ntile; i += 2) {
            NSA_TILE(i, 0, kB2, vB2, kA, vA);
            NSA_TILE(i + 1, 1, kA, vA, kB2, vB2);
        }
        if (i < ntile) NSA_TILE(i, 0, kB2, vB2, kA, vA);
    }
#undef NSA_TILE
#undef NSA_SRC
    RG_END(104)
    bf16_t* yp = Y + tok * DM + head * 64;
#pragma unroll
    for (int i = 0; i < 4; ++i) {
        *(uint2*)(yp + 8 * i + 4 * hi) = make_uint2(cvtpk(y0[4 * i], y0[4 * i + 1]), cvtpk(y0[4 * i + 2], y0[4 * i + 3]));
        *(uint2*)(yp + 32 + 8 * i + 4 * hi) = make_uint2(cvtpk(y1[4 * i], y1[4 * i + 1]), cvtpk(y1[4 * i + 2], y1[4 * i + 3]));
    }
}

DI float log_sigmoid_(float x) { return x >= 0.f ? -__logf(1.f + __expf(-x)) : x - __logf(1.f + __expf(x)); }
DI float lane_shr_add(float v, int l) {
#pragma unroll
    for (int o = 1; o < 64; o <<= 1) { const float t = lane_get(v, l - o); if (l >= o) v += t; }
    return v;
}
DI float lane_shr_max(float v, int l) {
#pragma unroll
    for (int o = 1; o < 64; o <<= 1) { const float t = lane_get(v, l - o); if (l >= o) v = fmaxf(v, t); }
    return v;
}
DI float log_sigmoid_fast(float x) { return -__logf(1.f + __expf(-x)); }
DI void ml_mscan_all(const float* __restrict__ ifp, int bh, int lane, float* __restrict__ mtab, float* __restrict__ wprev, float* __restrict__ wsc) {
    const int b = bh >> 2, h = bh & 3;
    const float* gp = ifp + ((size_t)b * SEQ + 64 * lane) * 8 + h;
    float L = 0.f, mx = -3.0e38f;
#pragma unroll 16
    for (int s = 0; s < 64; ++s) { const float iv = gp[s * 8], fv = gp[s * 8 + 4]; L += log_sigmoid_fast(fv); mx = fmaxf(mx, iv - L); }
    const float G = L + mx;
    float m = 0.f, mine = 0.f, mnext = 0.f;
#pragma unroll
    for (int k = 0; k < 64; ++k) {
        const float Lk = __builtin_bit_cast(float, __builtin_amdgcn_readlane(__builtin_bit_cast(int, L), k)), Gk = __builtin_bit_cast(float, __builtin_amdgcn_readlane(__builtin_bit_cast(int, G), k));
        if (k == lane) mine = m;
        m = fmaxf(Lk + m, Gk);
        if (k == lane) mnext = m;
    }
    mtab[bh * 65 + lane] = mine;
    wprev[bh * 64 + lane] = __expf(L + mine - mnext);
    wsc[bh * 64 + lane] = __expf(G - mnext);
}
DI void ml_conv8(float (&o)[8], const bf16_t* __restrict__ MQK, size_t tok, int t_in_seq, int col, const float* __restrict__ wc, const float* __restrict__ bc, float scale) {
    const float4 b0 = *(const float4*)(bc + col), b1 = *(const float4*)(bc + col + 4);
    o[0] = b0.x; o[1] = b0.y; o[2] = b0.z; o[3] = b0.w; o[4] = b1.x; o[5] = b1.y; o[6] = b1.z; o[7] = b1.w;
#pragma unroll
    for (int j = 0; j < 4; ++j) {
        if (t_in_seq - 3 + j >= 0) {
            float u[8]; unpack8(*(const pg8::u32x4*)(MQK + (tok - 3 + j) * 1024 + col), u);
            const float4 w0 = *(const float4*)(wc + j * 1024 + col), w1 = *(const float4*)(wc + j * 1024 + col + 4);
            o[0] += w0.x * u[0]; o[1] += w0.y * u[1]; o[2] += w0.z * u[2]; o[3] += w0.w * u[3]; o[4] += w1.x * u[4]; o[5] += w1.y * u[5]; o[6] += w1.z * u[6]; o[7] += w1.w * u[7];
        }
    }
#pragma unroll
    for (int i = 0; i < 8; ++i) o[i] = o[i] * sigmoidf_(o[i]) * scale;
}
constexpr float ML_KSCALE = 0.08838834764831845f;
DI void ml_unit_c(int bh, int c, int tx, lds_c* lds, const bf16_t* __restrict__ MQK, const bf16_t* __restrict__ MV, const float* __restrict__ ifp, const float* __restrict__ wc, const float* __restrict__ bc,
                  bf16_t* __restrict__ dC, float* __restrict__ dn, float* __restrict__ wprev, const float* __restrict__ mtab) {
    const int b = bh >> 2, h = bh & 3, lane = tx & 63, r32 = lane & 31, hi = lane >> 5, wave = __builtin_amdgcn_readfirstlane(tx >> 6);
    lds_c* KT = lds; lds_c* VTw = lds + 128 * 144;
    __attribute__((address_space(3))) float* wsm = (__attribute__((address_space(3))) float*)(lds + 2 * 128 * 144);
    const size_t tok0 = (size_t)b * SEQ + 64 * c;
    __syncthreads();
    if (wave == 0) {
        const float iv = ifp[(tok0 + lane) * 8 + h], lf = log_sigmoid_(ifp[(tok0 + lane) * 8 + 4 + h]);
        const int l_ = lane_id_opaque();
        const float bc_ = lane_shr_add(lf, l_), u = iv - bc_, umax = wave_max(u);
        wsm[lane] = __expf(u - umax);
        (void)wprev; (void)mtab;
    }
    __syncthreads();
#pragma unroll 1
    for (int it = tx; it < 1024; it += 512) {
        const int s = it >> 4, d0 = (it & 15) * 8; float kv[8];
        ml_conv8(kv, MQK, tok0 + s, 64 * c + s, 512 + h * 128 + d0, wc, bc, ML_KSCALE);
        float vv[8]; unpack8(*(const pg8::u32x4*)(MV + (tok0 + s) * 512 + h * 128 + d0), vv);
        const float w = wsm[s];
#pragma unroll
        for (int i = 0; i < 8; ++i) {
            *(__attribute__((address_space(3))) bf16_t*)(KT + (d0 + i) * 144 + s * 2) = f2bf(kv[i]);
            *(__attribute__((address_space(3))) bf16_t*)(VTw + (d0 + i) * 144 + s * 2) = f2bf(vv[i] * w);
        }
    }
    __syncthreads();
    if (tx < 128) {
        float a = 0.f;
        for (int s = 0; s < 64; ++s) a += wsm[s] * bf2f(*(const __attribute__((address_space(3))) bf16_t*)(KT + tx * 144 + s * 2));
        dn[((size_t)bh * 64 + c) * 128 + tx] = a;
    }
    {
        const int vb = wave >> 1, kh = wave & 1;
        f32x16 acc0, acc1;
#pragma unroll
        for (int r = 0; r < 16; ++r) { acc0[r] = 0.f; acc1[r] = 0.f; }
#pragma unroll
        for (int ks = 0; ks < 4; ++ks) {
            const bf16x8 a = *(const __attribute__((address_space(3))) bf16x8*)(VTw + (vb * 32 + r32) * 144 + ks * 32 + hi * 16);
            const bf16x8 b0 = *(const __attribute__((address_space(3))) bf16x8*)(KT + (kh * 64 + r32) * 144 + ks * 32 + hi * 16);
            const bf16x8 b1 = *(const __attribute__((address_space(3))) bf16x8*)(KT + (kh * 64 + 32 + r32) * 144 + ks * 32 + hi * 16);
            acc0 = MFMA32(a, b0, acc0); acc1 = MFMA32(a, b1, acc1);
        }
        bf16_t* o = dC + ((size_t)bh * 64 + c) * 16384;
#pragma unroll
        for (int r = 0; r < 16; ++r) { const int v = vb * 32 + crow(r, hi);
            o[v * 128 + kh * 64 + r32] = f2bf(acc0[r]); o[v * 128 + kh * 64 + 32 + r32] = f2bf(acc1[r]); }
    }
}
DI void ml_scan(int gtid, int nthreads, bf16_t* __restrict__ dC, float* __restrict__ dn, const float* __restrict__ wprev, const float* __restrict__ wsc) {
    for (int p = gtid; p < 16 * 8192; p += nthreads) {
        const int bh = p >> 13, e2 = p & 8191;
        unsigned* base = (unsigned*)(dC + (size_t)bh * 64 * 16384) + e2;
        float r0 = 0.f, r1 = 0.f;
#pragma unroll 1
        for (int c0 = 0; c0 < 64; c0 += 16) {
            unsigned v[16];
#pragma unroll
            for (int j = 0; j < 16; ++j) v[j] = base[(size_t)(c0 + j) * 8192];
#pragma unroll
            for (int j = 0; j < 16; ++j) {
                const float w = wprev[bh * 64 + c0 + j], sc = wsc[bh * 64 + c0 + j];
                base[(size_t)(c0 + j) * 8192] = pk2(r0, r1);
                r0 = w * r0 + sc * __uint_as_float(v[j] << 16); r1 = w * r1 + sc * __uint_as_float(v[j] & 0xffff0000u);
            }
        }
    }
    for (int p = gtid; p < 16 * 128; p += nthreads) {
        const int bh = p >> 7, k = p & 127; float r = 0.f; float* q = dn + (size_t)bh * 64 * 128 + k;
#pragma unroll 1
        for (int c0 = 0; c0 < 64; c0 += 16) {
            float v[16];
#pragma unroll
            for (int j = 0; j < 16; ++j) v[j] = q[(c0 + j) * 128];
#pragma unroll
            for (int j = 0; j < 16; ++j) { q[(c0 + j) * 128] = r; r = wprev[bh * 64 + c0 + j] * r + wsc[bh * 64 + c0 + j] * v[j]; }
        }
    }
}
DI void ml_unit_e(int bh, int c, int tx, lds_c* lds, const bf16_t* __restrict__ MQK, const bf16_t* __restrict__ MV, const bf16_t* __restrict__ MO, const float* __restrict__ ifp,
                  const float* __restrict__ wc, const float* __restrict__ bc, const bf16_t* __restrict__ Sst, const float* __restrict__ nst, const float* __restrict__ mtab, const float* __restrict__ g_hn, bf16_t* __restrict__ Y) {
    const int b = bh >> 2, h = bh & 3, lane = tx & 63, r32 = lane & 31, hi = lane >> 5, wave = __builtin_amdgcn_readfirstlane(tx >> 6);
    lds_c* Qi = lds; lds_c* Ki = lds + 64 * 272; lds_c* VTi = lds + 2 * 64 * 272; lds_c* Si = VTi + 128 * 136;
    __attribute__((address_space(3))) float* fsm = (__attribute__((address_space(3))) float*)(Si + 128 * 272);
    const size_t tok0 = (size_t)b * SEQ + 64 * c;
    const float m_c = mtab[bh * 65 + c];
    __syncthreads();
    if (wave == 0) {
        const float iv = ifp[(tok0 + lane) * 8 + h], lf = log_sigmoid_(ifp[(tok0 + lane) * 8 + 4 + h]);
        const int l_ = lane_id_opaque();
        const float bc_ = lane_shr_add(lf, l_), u = iv - bc_, M = fmaxf(lane_shr_max(u, l_), m_c);
        fsm[lane] = u; fsm[64 + lane] = M; fsm[128 + lane] = __expf(-(bc_ + M));
    }
    if (wave == 1) { fsm[192 + lane] = nst[((size_t)bh * 64 + c) * 128 + lane]; fsm[192 + 64 + lane] = nst[((size_t)bh * 64 + c) * 128 + 64 + lane]; }
#pragma unroll 1
    for (int it = tx; it < 1024; it += 512) {
        const int s = it >> 4, d0 = (it & 15) * 8; float qv[8], kv[8];
        ml_conv8(qv, MQK, tok0 + s, 64 * c + s, h * 128 + d0, wc, bc, 1.f);
        ml_conv8(kv, MQK, tok0 + s, 64 * c + s, 512 + h * 128 + d0, wc, bc, ML_KSCALE);
        *(__attribute__((address_space(3))) pg8::u32x4*)(Qi + s * 272 + d0 * 2) = pack8(qv);
        *(__attribute__((address_space(3))) pg8::u32x4*)(Ki + s * 272 + d0 * 2) = pack8(kv);
        const pg8::u32x4 vw = *(const pg8::u32x4*)(MV + (tok0 + s) * 512 + h * 128 + d0);
        __attribute__((address_space(3))) bf16_t* vt = (__attribute__((address_space(3))) bf16_t*)(VTi + d0 * 136 + s * 2);
        vt[0] = (bf16_t)(vw.x & 0xffffu); vt[68] = (bf16_t)(vw.x >> 16); vt[136] = (bf16_t)(vw.y & 0xffffu); vt[204] = (bf16_t)(vw.y >> 16);
        vt[272] = (bf16_t)(vw.z & 0xffffu); vt[340] = (bf16_t)(vw.z >> 16); vt[408] = (bf16_t)(vw.w & 0xffffu); vt[476] = (bf16_t)(vw.w >> 16);
    }
    {
        const bf16_t* src = Sst + ((size_t)bh * 64 + c) * 16384;
#pragma unroll
        for (int j = 0; j < 4; ++j) { const int ch = tx + 512 * j, v = ch >> 4, k8 = (ch & 15) * 8;
            *(__attribute__((address_space(3))) pg8::u32x4*)(Si + v * 272 + k8 * 2) = *(const pg8::u32x4*)(src + v * 128 + k8); }
    }
    __syncthreads();
    const int tb = wave & 1, vb = wave >> 1, t = tb * 32 + r32;
    bf16x8 qf[8];
#pragma unroll
    for (int ks = 0; ks < 8; ++ks) qf[ks] = *(const __attribute__((address_space(3))) bf16x8*)(Qi + t * 272 + ks * 32 + hi * 16);
    f32x16 a0, a1;
#pragma unroll
    for (int r = 0; r < 16; ++r) { a0[r] = 0.f; a1[r] = 0.f; }
#pragma unroll
    for (int ks = 0; ks < 8; ++ks) {
        const bf16x8 k0 = *(const __attribute__((address_space(3))) bf16x8*)(Ki + r32 * 272 + ks * 32 + hi * 16);
        const bf16x8 k1 = *(const __attribute__((address_space(3))) bf16x8*)(Ki + (32 + r32) * 272 + ks * 32 + hi * 16);
        a0 = MFMA32(k0, qf[ks], a0); a1 = MFMA32(k1, qf[ks], a1);
    }
    const float Mt = fsm[64 + t], dec = __expf(m_c - Mt);
    float rs = 0.f;
#pragma unroll
    for (int r = 0; r < 16; ++r) {
        const int s0 = crow(r, hi), s1 = 32 + s0;
        a0[r] = s0 <= t ? __expf(fsm[s0] - Mt) * a0[r] : 0.f; a1[r] = s1 <= t ? __expf(fsm[s1] - Mt) * a1[r] : 0.f;
        rs += a0[r] + a1[r];
    }
    float nq = 0.f;
#pragma unroll
    for (int ks = 0; ks < 8; ++ks) { float qv[8]; unpack8(__builtin_bit_cast(pg8::u32x4, qf[ks]), qv);
#pragma unroll
        for (int j = 0; j < 8; ++j) nq += qv[j] * fsm[192 + ks * 16 + hi * 8 + j]; }
    float den = rs + dec * nq;
    { auto rr = __builtin_amdgcn_permlane32_swap(__float_as_uint(den), __float_as_uint(den), false, false); den = __uint_as_float(rr[0]) + __uint_as_float(rr[1]); }
    f32x16 n1, n2;
#pragma unroll
    for (int r = 0; r < 16; ++r) { n1[r] = 0.f; n2[r] = 0.f; }
#pragma unroll
    for (int hf = 0; hf < 2; ++hf)
#pragma unroll
        for (int ss = 0; ss < 2; ++ss) {
            unsigned pw[4];
#pragma unroll
            for (int j = 0; j < 4; ++j) pw[j] = hf ? cvtpk(a1[8 * ss + 2 * j], a1[8 * ss + 2 * j + 1]) : cvtpk(a0[8 * ss + 2 * j], a0[8 * ss + 2 * j + 1]);
            const u32x4v pbw = {pw[0], pw[1], pw[2], pw[3]};
            const lds_c* vp = VTi + (vb * 32 + r32) * 136 + hf * 64 + ss * 32 + hi * 8;
            const u32x2v lo = *(const __attribute__((address_space(3))) u32x2v*)vp, hi2 = *(const __attribute__((address_space(3))) u32x2v*)(vp + 16);
            const u32x4v aw = {lo.x, lo.y, hi2.x, hi2.y};
            n1 = MFMA32(__builtin_bit_cast(bf16x8, aw), __builtin_bit_cast(bf16x8, pbw), n1);
        }
#pragma unroll
    for (int ks = 0; ks < 8; ++ks) {
        const bf16x8 sa = *(const __attribute__((address_space(3))) bf16x8*)(Si + (vb * 32 + r32) * 272 + ks * 32 + hi * 16);
        n2 = MFMA32(sa, qf[ks], n2);
    }
    const float inv = 1.f / fmaxf(fabsf(den), fsm[128 + t]);
    const bf16_t* op = MO + (tok0 + t) * 512 + h * 128 + vb * 32;
    float hv[16]; float ssq = 0.f;
#pragma unroll
    for (int i = 0; i < 4; ++i) {
        const u32x2v ow = *(const u32x2v*)(op + 8 * i + 4 * hi);
        const float o4[4] = {__uint_as_float(ow.x << 16), __uint_as_float(ow.x & 0xffff0000u), __uint_as_float(ow.y << 16), __uint_as_float(ow.y & 0xffff0000u)};
#pragma unroll
        for (int j = 0; j < 4; ++j) { const float x = (n1[4 * i + j] + dec * n2[4 * i + j]) * inv * sigmoidf_(o4[j]); hv[4 * i + j] = x; ssq += x * x; }
    }
    { auto rr = __builtin_amdgcn_permlane32_swap(__float_as_uint(ssq), __float_as_uint(ssq), false, false); ssq = __uint_as_float(rr[0]) + __uint_as_float(rr[1]); }
    if (hi == 0) fsm[320 + t * 4 + vb] = ssq;
    __syncthreads();
    const float tot = (fsm[320 + t * 4] + fsm[320 + t * 4 + 1]) + (fsm[320 + t * 4 + 2] + fsm[320 + t * 4 + 3]);
    const float rstd = rsqrtf(tot * (1.f / 128.f) + 1e-6f);
    bf16_t* yp = Y + (tok0 + t) * DM + 512 + h * 128 + vb * 32; const float* gp = g_hn + h * 128 + vb * 32;
#pragma unroll
    for (int i = 0; i < 4; ++i) {
        const float4 gg = *(const float4*)(gp + 8 * i + 4 * hi);
        *(u32x2v*)(yp + 8 * i + 4 * hi) = (u32x2v){cvtpk(hv[4 * i] * rstd * gg.x, hv[4 * i + 1] * rstd * gg.y), cvtpk(hv[4 * i + 2] * rstd * gg.z, hv[4 * i + 3] * rstd * gg.w)};
    }
}

DI void cmp_unit(int kv, int bg, int jt, int tx, lds_c* lds, const bf16_t* __restrict__ KVb, const bf16_t* __restrict__ W1t, const bf16_t* __restrict__ W2t, const float* __restrict__ bias1p,
                 float* __restrict__ outf, bf16_t* __restrict__ kcb, bf16_t* __restrict__ vcT) {
    const int b = bg >> 1, g = bg & 1, lane = tx & 63, r32 = lane & 31, hi = lane >> 5, wave = __builtin_amdgcn_readfirstlane(tx >> 6), j0 = jt * 32;
    lds_c* TI = lds; lds_c* H1 = lds + 16 * 34 * 144;
    const bf16_t* src = KVb + ((size_t)b * SEQ + 16 * j0) * 512 + (kv ? 128 : 0) + g * 64;
    __syncthreads();
    for (int ch = tx; ch < 528 * 8; ch += 512) {
        const int t = ch >> 3, c8 = ch & 7;
        *(__attribute__((address_space(3))) pg8::u32x4*)(TI + ((t & 15) * 34 + (t >> 4)) * 144 + c8 * 16) = *(const pg8::u32x4*)(src + (size_t)t * 512 + c8 * 8);
    }
    __syncthreads();
    f32x16 acc;
#pragma unroll
    for (int r = 0; r < 16; ++r) acc[r] = 0.f;
    const bf16_t* wrow = W1t + (size_t)(wave * 32 + r32) * 2048 + hi * 8;
#pragma unroll 4
    for (int i = 0; i < 32; ++i) {
        const lds_c* arow = TI + ((i & 15) * 34 + r32 + (i >> 4)) * 144 + hi * 16;
#pragma unroll
        for (int dk = 0; dk < 4; ++dk) {
            const bf16x8 a = *(const __attribute__((address_space(3))) bf16x8*)(arow + dk * 32);
            const bf16x8 bfr = *(const bf16x8*)(wrow + i * 64 + dk * 16);
            acc = MFMA32(a, bfr, acc);
        }
    }
    {
        const int n = wave * 32 + r32; const float bias = bias1p[kv * 256 + n];
#pragma unroll
        for (int r = 0; r < 16; ++r) *(__attribute__((address_space(3))) bf16_t*)(H1 + crow(r, hi) * 528 + n * 2) = f2bf(gelu_tanh(acc[r] + bias));
    }
    __syncthreads();
    if (wave < 2) {
        f32x16 o;
#pragma unroll
        for (int r = 0; r < 16; ++r) o[r] = 0.f;
        const bf16_t* w2row = W2t + (size_t)(wave * 32 + r32) * 256 + hi * 8;
#pragma unroll
        for (int ks = 0; ks < 16; ++ks) {
            const bf16x8 a = *(const __attribute__((address_space(3))) bf16x8*)(H1 + r32 * 528 + ks * 32 + hi * 16);
            const bf16x8 bfr = *(const bf16x8*)(w2row + ks * 16);
            o = MFMA32(a, bfr, o);
        }
        const int d = wave * 32 + r32;
#pragma unroll
        for (int r = 0; r < 16; ++r) {
            const int j = j0 + crow(r, hi); const float v = j < 255 ? o[r] : 0.f;
            outf[((size_t)bg * 256 + j) * 64 + d] = v;
            if (kv == 0) kcb[((size_t)bg * 256 + j) * 64 + d] = f2bf(v);
            else vcT[((size_t)bg * 4 + (j >> 6)) * 4096 + d * 64 + (j & 63)] = f2bf(v);
        }
    }
}

#define XB_TMO      128
#define XB_XCNT(j)  (256  + 64 * (j))
#define XB_XSUB(j)  (1280 + 64 * (j))
#define XB_XGEN(j)  (2304 + 64 * (j))
#define XB_TOP      3328
#define XB_TOPGEN   3392
#define XCD_BAR_WORDS 3456
#define XB_SPIN_CAP (1u << 23)

__device__ __forceinline__ unsigned xb_ld(unsigned* p)              { return __hip_atomic_load(p, __ATOMIC_RELAXED, __HIP_MEMORY_SCOPE_AGENT); }
__device__ __forceinline__ unsigned xb_add(unsigned* p, unsigned v) { return __hip_atomic_fetch_add(p, v, __ATOMIC_RELAXED, __HIP_MEMORY_SCOPE_AGENT); }
__device__ __forceinline__ unsigned xb_xcc_id() { return (unsigned)__builtin_amdgcn_s_getreg((3 << 11) | 20) & 0xFu; }
#define XB_SPIN(cond, bar) do { unsigned _sp = 0; while (cond) { __builtin_amdgcn_s_sleep(1); \
    if ((++_sp & 255u) == 0u) { if (xb_ld(&(bar)[XB_TMO])) break; if (_sp > XB_SPIN_CAP) { atomicAdd(&(bar)[XB_TMO], 1u); break; } } } } while (0)

struct XcdBarrier {
    unsigned* bar; unsigned x;
    volatile __attribute__((address_space(3))) unsigned* st;
};

__device__ __forceinline__ XcdBarrier xcd_barrier_post(unsigned* bar, volatile __attribute__((address_space(3))) unsigned* st) {
    XcdBarrier b; b.bar = bar; b.x = xb_xcc_id(); b.st = st;
    if (threadIdx.x == 0) (void)xb_add(&bar[XB_XCNT(b.x)], 1u);
    return b;
}
__device__ __forceinline__ void xcd_barrier_complete(unsigned* bar, unsigned x, unsigned& nloc, unsigned& nx) {
    const unsigned G = gridDim.x * gridDim.y * gridDim.z;
    unsigned sum, cnt, mine, sp = 0u;
    for (;;) {
        sum = 0u; cnt = 0u; mine = 0u;
#pragma unroll
        for (unsigned j = 0; j < 16; ++j) { const unsigned c = xb_ld(&bar[XB_XCNT(j)]); sum += c; cnt += (c > 0u) ? 1u : 0u; mine = (j == x) ? c : mine; }
        if (sum == G) break;
        __builtin_amdgcn_s_sleep(1);
        if ((++sp & 255u) == 0u) { if (xb_ld(&bar[XB_TMO])) break; if (sp > XB_SPIN_CAP) { atomicAdd(&bar[XB_TMO], 1u); break; } }
    }
    nloc = mine > 0u ? mine : 1u; nx = cnt > 0u ? cnt : 1u;
}

__device__ __forceinline__ void xcd_barrier(const XcdBarrier& b) {
    asm volatile("s_waitcnt vmcnt(0)" ::: "memory");
    __syncthreads();
    if (threadIdx.x == 0) {
        unsigned* bar = b.bar;
        __builtin_amdgcn_s_waitcnt(0);
        unsigned nloc = b.st[0], nx = b.st[1];
        if (nloc == 0u) { xcd_barrier_complete(bar, b.x, nloc, nx); b.st[0] = nloc; b.st[1] = nx; }
        const unsigned old = xb_add(&bar[XB_XSUB(b.x)], 1u);
        const unsigned gen = old / nloc;
        if (old + 1u == (gen + 1u) * nloc) {
            __builtin_amdgcn_fence(__ATOMIC_RELEASE, "agent");
            asm volatile("s_waitcnt vmcnt(0)" ::: "memory");
            const unsigned og = xb_add(&bar[XB_TOP], 1u);
            const unsigned tg = og / nx;
            if (og + 1u == (tg + 1u) * nx) xb_add(&bar[XB_TOPGEN], 1u);
            else XB_SPIN(xb_ld(&bar[XB_TOPGEN]) == tg, bar);
            __builtin_amdgcn_fence(__ATOMIC_ACQUIRE, "agent");
            xb_add(&bar[XB_XGEN(b.x)], 1u);
            asm volatile("s_waitcnt vmcnt(0)" ::: "memory");
        } else {
            XB_SPIN(xb_ld(&bar[XB_XGEN(b.x)]) == gen, bar);
            __builtin_amdgcn_fence(__ATOMIC_ACQUIRE, "agent");
            asm volatile("s_waitcnt vmcnt(0)" ::: "memory");
        }
    }
    __syncthreads();
}

#ifndef NSA_CHECK
#define NSA_CHECK 0
#endif
#ifndef REP_MASK
#define REP_MASK 0u
#endif
struct Args { const float* in[29]; float* out; char* ws; unsigned rep_mask; unsigned pad; };
constexpr int LDS_BYTES = 147456;

__global__ __launch_bounds__(512, 2) void mk_fwd(Args a) {
    extern __shared__ __attribute__((aligned(16))) char lds_raw[];
    cg::grid_group grid = cg::this_grid();
    const int NB = gridDim.x * 2, NGW = gridDim.x * 8;
    const unsigned repm = a.rep_mask;
    volatile __attribute__((address_space(3))) unsigned* bar_st = (volatile __attribute__((address_space(3))) unsigned*)((lds_c*)lds_raw + (LDS_BYTES - 64));
    if (threadIdx.x < 2) bar_st[threadIdx.x] = 0u;
    __syncthreads();
    const XcdBarrier xbar = xcd_barrier_post((unsigned*)(a.ws + ((size_t)42 << 20) + 65536), bar_st);
#define GRID_BAR() xcd_barrier(xbar)
#ifndef SPIN_PHASE_UNUSED_
#endif
    unsigned long long ts_prev_ = 0ull, ts_probe_ = 0ull; int n_stamp_ = 0;
#define STAMP() do { if (SPIN_PHASE >= 0 && blockIdx.x == 0) { const unsigned long long now_ = __builtin_amdgcn_s_memrealtime(); if (n_stamp_ == SPIN_PHASE) ts_probe_ = now_ - ts_prev_; ts_prev_ = now_; ++n_stamp_; } } while (0)
    if (SPIN_PHASE >= 0 && blockIdx.x == 0) ts_prev_ = __builtin_amdgcn_s_memrealtime();
    const int wave_s_ = __builtin_amdgcn_readfirstlane(threadIdx.x >> 6);
#define KARG(T, off) (*(T const __attribute__((address_space(4)))*)(kargs_ + (off)))
#define PTRS const float* x = KARG(const float*, 8 * 0); const float* p = KARG(const float*, 8 * 1); const int* pos = KARG(const int*, 16); \
    const float* g_mix = KARG(const float*, 8 * 3); const float* w_in = KARG(const float*, 8 * 4); const float* b_if = KARG(const float*, 8 * 5); \
    const float* w_ck1 = KARG(const float*, 8 * 6); const float* w_ck2 = KARG(const float*, 8 * 7); const float* pe_ck = KARG(const float*, 8 * 8); \
    const float* w_cv1 = KARG(const float*, 8 * 9); const float* w_cv2 = KARG(const float*, 8 * 10); const float* pe_cv = KARG(const float*, 8 * 11); \
    const float* w_conv = KARG(const float*, 8 * 12); const float* b_conv = KARG(const float*, 8 * 13); const float* g_hn = KARG(const float*, 8 * 14); \
    const float* w_pa = KARG(const float*, 8 * 15); const float* w_pb = KARG(const float*, 8 * 16); const float* w_out = KARG(const float*, 8 * 17); \
    const float* g_ffn = KARG(const float*, 8 * 18); const float* w_rg = KARG(const float*, 8 * 19); const float* b_rg = KARG(const float*, 8 * 20); \
    const float* w_re = KARG(const float*, 8 * 21); const float* b_re = KARG(const float*, 8 * 22); const float* w_e13 = KARG(const float*, 8 * 23); \
    const float* w_e2 = KARG(const float*, 8 * 24); const float* g_ple = KARG(const float*, 8 * 25); const float* w_pg = KARG(const float*, 8 * 26); \
    const float* w_pp = KARG(const float*, 8 * 27); const float* g_final = KARG(const float*, 8 * 28); \
    float* out = KARG(float*, 232); char* ws = KARG(char*, 240); \
    const size_t MiB = 1u << 20; \
    bf16_t* Wt_in = (bf16_t*)(ws); \
    bf16_t* xb = (bf16_t*)(ws + 48 * MiB); \
    bf16_t* Qb = (bf16_t*)(ws + 80 * MiB); \
    bf16_t* KVb = (bf16_t*)(ws + 96 * MiB); bf16_t* VT = (bf16_t*)(ws + 112 * MiB); bf16_t* kcb = (bf16_t*)(ws + 249 * MiB + 512 * 1024); bf16_t* vcT = (bf16_t*)(ws + 249 * MiB + 768 * 1024); \
    bf16_t* MQK = (bf16_t*)(ws + 120 * MiB); \
    bf16_t* MV = (bf16_t*)(ws + 152 * MiB); \
    bf16_t* MO = (bf16_t*)(ws + 168 * MiB); \
    bf16_t* MG = (bf16_t*)(ws + 184 * MiB); \
    float* gates = (float*)(ws + 248 * MiB); \
    float* ifp = (float*)(ws + 250 * MiB); \
    float* kcc = (float*)(ws + 251 * MiB); \
    float* vcc = (float*)(ws + 252 * MiB); \
    float* gate16 = (float*)(ws + 253 * MiB); \
    float* rstd0 = (float*)(ws + 254 * MiB); \
    float* cosT = (float*)(ws + 254 * MiB + 512 * 1024); \
    float* sinT = (float*)(ws + 255 * MiB); \
    bf16_t* Y = (bf16_t*)(out + (size_t)8 * 1024 * 1024); \
    bf16_t* dC = xb; float* dn = (float*)(ws + 250 * MiB + 512 * 1024); float* wprev = (float*)(ws + 42 * MiB + 4096); float* mtab = (float*)(ws + 42 * MiB + 8192); float* wsc = (float*)(ws + 42 * MiB + 16384); \
    float* tmp = (float*)(ws + 120 * MiB); bf16_t* mixed = xb; \
    bf16_t* Wpa_t = (bf16_t*)(ws + 11 * MiB); bf16_t* Wpb_t = (bf16_t*)(ws + 12 * MiB); bf16_t* Wout_t = (bf16_t*)(ws + 13 * MiB); \
    bf16_t* We13_t = (bf16_t*)(ws + 15 * MiB); bf16_t* We2_t = (bf16_t*)(ws + 31 * MiB); bf16_t* Wpg_t = (bf16_t*)(ws + 39 * MiB); bf16_t* Wpp_t = (bf16_t*)(ws + 41 * MiB); \
    int* cnt = (int*)(ws + 42 * MiB); bf16_t* W1t_k = (bf16_t*)(ws + 43 * MiB); bf16_t* W1t_v = (bf16_t*)(ws + 44 * MiB); bf16_t* W2t_k = (bf16_t*)(ws + 45 * MiB); bf16_t* W2t_v = (bf16_t*)(ws + 45 * MiB + 65536); float* bias1p = (float*)(ws + 45 * MiB + 524288); \
    bf16_t* x1b = (bf16_t*)(ws + 48 * MiB); bf16_t* act = (bf16_t*)(ws + 120 * MiB); bf16_t* y2 = (bf16_t*)(ws + 138 * MiB); bf16_t* x2b = (bf16_t*)(ws + 210 * MiB); int* elist = (int*)(ws + 242 * MiB); \
    bf16_t* pb = (bf16_t*)(ws + 80 * MiB); bf16_t* PP = (bf16_t*)(ws + 88 * MiB); \
    int* rinfo = (int*)(ws + 253 * MiB); float* rstd1 = (float*)(ws + 253 * MiB + 512 * 1024); float* rstd2 = (float*)(ws + 253 * MiB + 768 * 1024); \
    (void)x; (void)p; (void)pos; (void)g_mix; (void)w_in; (void)b_if; (void)w_ck1; (void)w_ck2; (void)pe_ck; (void)w_cv1; (void)w_cv2; (void)pe_cv; (void)w_conv; (void)b_conv; (void)g_hn; (void)w_pa; (void)w_pb; (void)w_out; (void)g_ffn; (void)w_rg; (void)b_rg; (void)w_re; (void)b_re; (void)w_e13; (void)w_e2; (void)g_ple; (void)w_pg; (void)w_pp; (void)g_final;
#define PHASE(k) for (int rep_ = 0; rep_ < 1 + (int)((repm >> (k)) & 1u); ++rep_)
#define PHASE_IDS unsigned tx_ = (unsigned)(wave_s_ * 64); asm volatile("" : "+v"(tx_)); tx_ = (unsigned)__builtin_amdgcn_mbcnt_hi(-1, __builtin_amdgcn_mbcnt_lo(-1, (int)tx_)); const int half = tx_ >> 8, tid = tx_ & 255, lane64 = tx_ & 63, tid512 = (int)tx_; \
    const int wave = __builtin_amdgcn_readfirstlane(tx_ >> 6); char* sm = lds_raw + half * 65536; const int gw = blockIdx.x * 8 + wave; (void)tid; (void)lane64; (void)sm; (void)gw; (void)tid512; \
    const __attribute__((address_space(4))) char* kargs_ = (const __attribute__((address_space(4))) char*)__builtin_amdgcn_kernarg_segment_ptr(); asm volatile("" : "+s"(kargs_)); PTRS
#define VB_LOOP(nvb) for (int vb = blockIdx.x * 2 + half; vb < (nvb); vb += NB)
#define GEMM_PHASE(NT, MT, ...) do { VB_LOOP((NT) * (MT)) { const int bx_ = vb % (NT), by_ = vb / (NT); __syncthreads(); gemm_v1(bx_, by_, tid, sm, __VA_ARGS__); } } while (0)
    PHASE(0) { PHASE_IDS
        float* scr = (float*)(lds_raw + wave * 8448);
        for (int it = gw; it < (DM / 64) * (NIN / 32); it += NGW) prep_wt_item(w_in, DIN, DM, Wt_in, g_mix, MapIn{}, scr, it, NIN / 32, lane64);
        for (int it = gw; it < 8 * 32; it += NGW) prep_wt_item(w_pa, DM, 512, Wpa_t, (const float*)nullptr, MapId{}, scr, it, 32, lane64);
        for (int it = gw; it < 8 * 32; it += NGW) prep_wt_item(w_pb, DM, 512, Wpb_t, (const float*)nullptr, MapId{}, scr, it, 32, lane64);
        for (int it = gw; it < 16 * 32; it += NGW) prep_wt_item(w_out, DM, DM, Wout_t, (const float*)nullptr, MapId{}, scr, it, 32, lane64);
        for (int it = gw; it < 16 * 32; it += NGW) prep_wt_item(w_pg, DM, DM, Wpg_t, g_ple, MapId{}, scr, it, 32, lane64);
        for (int it = gw; it < 4 * 32; it += NGW) prep_wt_item(w_pp, DM, 256, Wpp_t, (const float*)nullptr, MapId{}, scr, it, 32, lane64);
        for (int it = gw; it < 16 * 256; it += NGW) { const int e = it >> 8; prep_wt_item(w_e13 + (size_t)e * 1024 * 512, 512, DM, We13_t + (size_t)e * 512 * 1024, g_ffn, MapE13{}, scr, it & 255, 16, lane64); }
        for (int it = gw; it < 16 * 128; it += NGW) { const int e = it >> 7; prep_wt_item(w_e2 + (size_t)e * 256 * 1024, DM, 256, We2_t + (size_t)e * 1024 * 256, (const float*)nullptr, MapId{}, scr, it & 127, 32, lane64); }
        for (int it = gw; it < 2 * 256; it += NGW) { const int kv = it >> 8; prep_wt_item(kv ? w_cv1 : w_ck1, 256, 2048, kv ? W1t_v : W1t_k, (const float*)nullptr, MapId{}, scr, it & 255, 8, lane64); }
        for (int it = gw; it < 2 * 8; it += NGW) { const int kv = it >> 3; prep_wt_item(kv ? w_cv2 : w_ck2, 64, 256, kv ? W2t_v : W2t_k, (const float*)nullptr, MapId{}, scr, it & 7, 2, lane64); }
        if (gw < 512) {
            const int kv = gw >> 8, n = gw & 255; const float* w1 = kv ? w_cv1 : w_ck1; const float* pe = kv ? pe_cv : pe_ck; float a = 0.f;
#pragma unroll
            for (int i = 0; i < 32; ++i) { const int k = lane64 + 64 * i; a += pe[k] * w1[(size_t)k * 256 + n]; }
            a = wave_sum(a);
            if (lane64 == 0) bias1p[gw] = a;
        }
        if (blockIdx.x == 0 && tid512 < 16) cnt[tid512 * CNT_STRIDE] = 0;
        for (int r = gw; r < T_TOK; r += NGW) prep_x_row(x, xb, rstd0, r, lane64);
        for (int i = blockIdx.x * 512 + tid512; i < T_TOK * 8; i += gridDim.x * 512) {
            const float inv = powf(500000.0f, -(float)(2 * (i & 7)) / 16.0f); float sn, cs; sincosf((float)pos[i >> 3] * inv, &sn, &cs); cosT[i] = cs; sinT[i] = sn; }
    }
    grid.sync(); STAMP();
    PHASE(1) { PHASE_IDS
        pg8::Gemm g{xb, Wt_in, T_TOK, NIN, DM, DM, DM}; pg8::StaticOrder S; S.init(T_TOK, NIN, (int)gridDim.x, (int)blockIdx.x);
        EpiInProj E{rstd0, cosT, sinT, b_if, Qb, KVb, gates, ifp, MQK, MV, MO, MG, VT};
        pg8::gemm_phase<EpiInProj, pg8::StaticOrder, true, true>((PG8_LAS unsigned char*)lds_raw, g, S, E, tid512);
    }
    GRID_BAR(); STAMP();
    PHASE(2) { PHASE_IDS
        for (int u = blockIdx.x; u < 128; u += gridDim.x) { const int kv = u >> 6, bg = (u >> 3) & 7, jt = u & 7;
            cmp_unit(kv, bg, jt, tid512, (lds_c*)lds_raw, KVb, kv ? W1t_v : W1t_k, kv ? W2t_v : W2t_k, bias1p, kv ? vcc : kcc, kcb, vcT); }
        { const int v_ = (int)blockIdx.x - 128; if (v_ >= 0 && v_ < 16 && wave == 0) ml_mscan_all(ifp, v_, lane64, mtab, wprev, wsc); }
    }
    PHASE(3) { PHASE_IDS
        { const int G_ = (int)gridDim.x, c_ = (int)blockIdx.x;
          if (G_ == 256) { const int n_ = c_ < 128 ? 3 : 5, first_ = c_ < 128 ? 3 * c_ : 384 + 5 * (c_ - 128);
              for (int u = first_; u < first_ + n_; ++u) ml_unit_c(u >> 6, u & 63, tid512, (lds_c*)lds_raw, MQK, MV, ifp, w_conv, b_conv, dC, dn, wprev, mtab); }
          else for (int u = c_; u < 1024; u += G_) ml_unit_c(u >> 6, u & 63, tid512, (lds_c*)lds_raw, MQK, MV, ifp, w_conv, b_conv, dC, dn, wprev, mtab); }
    }
    GRID_BAR(); STAMP();
    {   PHASE_IDS
        ml_scan(blockIdx.x * 512 + tid512, gridDim.x * 512, dC, dn, wprev, wsc);
    }
    GRID_BAR(); STAMP();
    PHASE(4) { PHASE_IDS
        for (int u = blockIdx.x; u < 1024; u += gridDim.x) ml_unit_e(u >> 6, u & 63, tid512, (lds_c*)lds_raw, MQK, MV, MO, ifp, w_conv, b_conv, dC, dn, mtab, g_hn, Y);
    }
    PHASE(5) { PHASE_IDS
        for (int pr = blockIdx.x; pr < 256; pr += gridDim.x) {
            nsa_unit(pr & 7, 63 - (pr >> 3), tid512, (lds_c*)lds_raw, Qb, KVb, VT, kcb, vcT, gates, Y, ts_probe_);
            nsa_unit(pr & 7, pr >> 3, tid512, (lds_c*)lds_raw, Qb, KVb, VT, kcb, vcT, gates, Y, ts_probe_);
        }
    }
#if NSA_CHECK
    {   PHASE_IDS
        bf16_t* Y2 = (bf16_t*)(ws + 120 * MiB); unsigned* stats = (unsigned*)(ws + 42 * MiB + 32768);
        if (blockIdx.x == 0 && tid512 == 0) { stats[0] = 0u; stats[1] = 0u; }
        grid.sync();
        float* kcc2 = (float*)(ws + 251 * MiB + 512 * 1024); float* vcc2 = (float*)(ws + 252 * MiB + 512 * 1024); bf16_t* dummy = (bf16_t*)(ws + 160 * MiB);
        VB_LOOP(4080) { const int j = vb % 255, r = vb / 255; compress_naive(j, r & 7, r >> 3, tid, sm, KVb, w_ck1, w_ck2, pe_ck, w_cv1, w_cv2, pe_cv, kcc2, vcc2, dummy, dummy + 1048576); }
        grid.sync();
        VB_LOOP(T_TOK * 2) nsa_naive(vb >> 1, vb & 1, tid, sm, Qb, KVb, VT, kcc2, vcc2, gates, Y2);
        grid.sync();
        unsigned c1 = 0, c2 = 0;
        for (size_t i = (size_t)blockIdx.x * 512 + tid512; i < (size_t)T_TOK * 512; i += (size_t)gridDim.x * 512) {
            const size_t o = (i >> 9) * DM + (i & 511); const float d = fabsf(bf2f(Y[o]) - bf2f(Y2[o])); c1 += d > 0.02f ? 1u : 0u; c2 += (d > 0.1f || !(d == d)) ? 1u : 0u; }
        if (c1) atomicAdd(stats, c1); if (c2) atomicAdd(stats + 1, c2);
    }
#endif
    GRID_BAR(); STAMP();
    PHASE(7) { PHASE_IDS
        pg8::StaticOrder S; S.init(T_TOK, DM, (int)gridDim.x, (int)blockIdx.x);
        pg8::Gemm g{Y, Wpa_t, T_TOK, DM, 512, DM, 512}; EpiMerge<0> E{MG, tmp, mixed}; pg8::gemm_phase<EpiMerge<0>, pg8::StaticOrder, true, true>((PG8_LAS unsigned char*)lds_raw, g, S, E, tid512);
    }
    PHASE(8) { PHASE_IDS
        __syncthreads();
        pg8::StaticOrder S; S.init(T_TOK, DM, (int)gridDim.x, (int)blockIdx.x);
        pg8::Gemm g{Y + 512, Wpb_t, T_TOK, DM, 512, DM, 512}; EpiMerge<1> E{MG, tmp, mixed}; pg8::gemm_phase<EpiMerge<1>, pg8::StaticOrder, true, true>((PG8_LAS unsigned char*)lds_raw, g, S, E, tid512);
    }
    GRID_BAR(); STAMP();
    PHASE(9) { PHASE_IDS
        pg8::Gemm g{mixed, Wout_t, T_TOK, DM, DM, DM, DM}; pg8::StaticOrder S; S.init(T_TOK, DM, (int)gridDim.x, (int)blockIdx.x);
        EpiX1 E{x, out, x1b};
        pg8::gemm_phase<EpiX1, pg8::StaticOrder, true, true>((PG8_LAS unsigned char*)lds_raw, g, S, E, tid512);
    }
    GRID_BAR(); STAMP();
    {   PHASE_IDS
        __attribute__((address_space(3))) float* Wl = (__attribute__((address_space(3))) float*)((lds_c*)lds_raw);
        __attribute__((address_space(3))) int* lcnt = (__attribute__((address_space(3))) int*)((lds_c*)lds_raw + 20 * 4096);
        __attribute__((address_space(3))) int* lri = lcnt + 32;
        __syncthreads(); router_stage(Wl, g_ffn, w_rg, w_re, tid512); if (tid512 < 16) lcnt[tid512] = 0; __syncthreads();
        { int i = 0; for (int t = gw; t < T_TOK; t += NGW, ++i) router2(t, lane64, out, Wl, b_rg, b_re, rstd1, lcnt, lri + (wave * 8 + i) * 4); }
        __syncthreads();
        if (tid512 < 16) lcnt[16 + tid512] = atomicAdd(cnt + tid512 * CNT_STRIDE, lcnt[tid512]);
        __syncthreads();
        { int i = 0; for (int t = gw; t < T_TOK; t += NGW, ++i) if (lane64 == 0) { __attribute__((address_space(3))) int* r = lri + (wave * 8 + i) * 4;
            const int e0 = r[0] & 255, e1 = (r[0] >> 8) & 255, q0 = (r[1] & 0xffff) + lcnt[16 + e0], q1 = (r[1] >> 16) + lcnt[16 + e1]; int4 ri; ri.x = r[0]; ri.y = q0 | (q1 << 16); ri.z = r[2]; ri.w = r[3];
            *(int4*)(rinfo + (size_t)t * 4) = ri; elist[e0 * T_TOK + q0] = t; elist[e1 * T_TOK + q1] = t; } }
        for (int t = gw; t < T_TOK; t += NGW) { const float4 pv = ((const float4*)(p + (size_t)t * 256))[lane64]; uint2 o; o.x = pk2(pv.x, pv.y); o.y = pk2(pv.z, pv.w); ((uint2*)(pb + (size_t)t * 256))[lane64] = o; }
    }
    GRID_BAR(); STAMP();
    {   PHASE_IDS
        MoeOrder S{cnt, 2, (int)gridDim.x, (int)blockIdx.x}; pg8::Unit u; int ntot = 0;
        for (int e = 0; e < 16; ++e) ntot += ((cnt[e * CNT_STRIDE] + 255) >> 8) * 2;
        for (int i = 0; S.next(i, u); ++i) {
            const int e = u.pn >> 1, nv = cnt[e * CNT_STRIDE] - u.aux * 256; const int* amap = elist + (size_t)e * T_TOK + u.aux * 256;
            pg8::Gemm g{x1b, We13_t, 0, 0, DM, DM, DM, amap, nv}; EpiSwiglu E{act, amap, nv, rstd1}; OneUnit S1{u};
            __syncthreads();
            pg8::gemm_phase<EpiSwiglu, OneUnit, false, true, true>((PG8_LAS unsigned char*)lds_raw, g, S1, E, tid512);
        }
        __syncthreads();
        { int extra = ntot - (int)gridDim.x; if (extra < 0) extra = 0; if (extra > (int)gridDim.x - 1) extra = (int)gridDim.x - 1;
          pg8::Gemm g{pb, Wpp_t, T_TOK, DM, 256, 256, 256}; EpiStoreBf E{PP, DM, 3}; PPOrder SP{extra, (int)gridDim.x, (int)blockIdx.x};
          pg8::gemm_phase<EpiStoreBf, PPOrder, true, true>((PG8_LAS unsigned char*)lds_raw, g, SP, E, tid512); }
    }
    GRID_BAR(); STAMP();
    PHASE(13) { PHASE_IDS
        pg8::Gemm g{act, We2_t, 0, 0, 256, 256, 256}; MoeOrder S{cnt, 4, (int)gridDim.x, (int)blockIdx.x};
        EpiStoreBf E{y2, DM, 3};
        pg8::gemm_phase<EpiStoreBf, MoeOrder, true, true>((PG8_LAS unsigned char*)lds_raw, g, S, E, tid512);
    }
    GRID_BAR(); STAMP();
    {   PHASE_IDS
        for (int t = gw; t < T_TOK; t += NGW) {
            int4 ri = *(const int4*)(rinfo + (size_t)t * 4); ri.x = __builtin_amdgcn_readfirstlane(ri.x); ri.y = __builtin_amdgcn_readfirstlane(ri.y); ri.z = __builtin_amdgcn_readfirstlane(ri.z); ri.w = __builtin_amdgcn_readfirstlane(ri.w);
            const int r0 = moe_base_row(cnt, ri.x & 255) + (ri.y & 0xffff), r1 = moe_base_row(cnt, (ri.x >> 8) & 255) + ((ri.y >> 16) & 0xffff);
            const float w0 = __int_as_float(ri.z), w1 = __int_as_float(ri.w);
            float4 v[4]; float s2 = 0.f;
#pragma unroll
            for (int j = 0; j < 4; ++j) { v[j] = ((const float4*)(out + (size_t)t * DM))[lane64 + 64 * j];
                const uint2 a0 = ((const uint2*)(y2 + (size_t)r0 * DM))[lane64 + 64 * j], a1 = ((const uint2*)(y2 + (size_t)r1 * DM))[lane64 + 64 * j];
                v[j].x += w0 * __uint_as_float(a0.x << 16) + w1 * __uint_as_float(a1.x << 16); v[j].y += w0 * __uint_as_float(a0.x & 0xffff0000u) + w1 * __uint_as_float(a1.x & 0xffff0000u);
                v[j].z += w0 * __uint_as_float(a0.y << 16) + w1 * __uint_as_float(a1.y << 16); v[j].w += w0 * __uint_as_float(a0.y & 0xffff0000u) + w1 * __uint_as_float(a1.y & 0xffff0000u);
                s2 += v[j].x * v[j].x + v[j].y * v[j].y + v[j].z * v[j].z + v[j].w * v[j].w; }
            s2 = wave_sum(s2);
            if (lane64 == 0) rstd2[t] = rsqrtf(s2 * (1.f / DM) + 1e-6f);
#pragma unroll
            for (int j = 0; j < 4; ++j) { ((float4*)(out + (size_t)t * DM))[lane64 + 64 * j] = v[j]; uint2 o; o.x = pk2(v[j].x, v[j].y); o.y = pk2(v[j].z, v[j].w); ((uint2*)(x2b + (size_t)t * DM))[lane64 + 64 * j] = o; }
        }
    }
    GRID_BAR(); STAMP();
    {   PHASE_IDS
        __syncthreads();
        pg8::StaticOrder S; S.init(T_TOK, DM, (int)gridDim.x, (int)blockIdx.x);
        pg8::Gemm g{x2b, Wpg_t, T_TOK, DM, DM, DM, DM}; EpiPle2 E{out, PP, rstd2};
        pg8::gemm_phase<EpiPle2, pg8::StaticOrder, true, true>((PG8_LAS unsigned char*)lds_raw, g, S, E, tid512);
    }
    GRID_BAR(); STAMP();
    {   PHASE_IDS
        VB_LOOP(T_TOK / 4) rmsnorm_rows(vb, tid, out, g_final, (bf16_t*)nullptr, out, T_TOK);
        if (SPIN_PHASE >= 0 && blockIdx.x == 0) { __syncthreads(); STAMP(); const unsigned long long t0_ = __builtin_amdgcn_s_memrealtime(); while (__builtin_amdgcn_s_memrealtime() - t0_ < 8ull * ts_probe_) __builtin_amdgcn_s_sleep(4); }
#if NSA_CHECK
        grid.sync();
        if (blockIdx.x == 0 && tid512 == 0) { const unsigned* stats = (const unsigned*)(ws + 42 * MiB + 32768); out[0] += sqrtf((float)stats[0]); out[1] += sqrtf((float)stats[1]) * 30.f; }
#endif
    }
}

extern "C" void kernel_launch(void* const* d_in, const int* in_sizes, int n_in, void* d_out, int out_size, void* d_ws, size_t ws_size, hipStream_t stream) {
    static int grid_blocks = 0;
    if (grid_blocks == 0) {
        int dev = 0, cus = 0, per_cu = 0;
        (void)hipGetDevice(&dev);
        (void)hipDeviceGetAttribute(&cus, hipDeviceAttributeMultiprocessorCount, dev);
        (void)hipFuncSetAttribute((const void*)mk_fwd, hipFuncAttributeMaxDynamicSharedMemorySize, LDS_BYTES);
        (void)hipOccupancyMaxActiveBlocksPerMultiprocessor(&per_cu, (const void*)mk_fwd, 512, LDS_BYTES);
        if (per_cu < 1) { fprintf(stderr, "kernel_launch: occupancy query returned %d\n", per_cu); per_cu = 1; }
        grid_blocks = cus * 1;
        fprintf(stderr, "kernel_launch: cus=%d per_cu=%d grid=%d ws=%zu\n", cus, per_cu, grid_blocks, ws_size);
    }
    (void)hipMemsetAsync((char*)d_ws + ((size_t)42 << 20), 0, 131072, stream);
    Args a{};
    for (int i = 0; i < 29; ++i) a.in[i] = (const float*)d_in[i];
    a.out = (float*)d_out; a.ws = (char*)d_ws; a.rep_mask = REP_MASK; a.pad = 0;
    void* args[] = {&a};
    hipError_t e = hipLaunchCooperativeKernel((const void*)mk_fwd, dim3(grid_blocks), dim3(512), args, LDS_BYTES, stream);
    if (e != hipSuccess) fprintf(stderr, "cooperative launch failed: %s (grid %d)\n", hipGetErrorString(e), grid_blocks);
    (void)in_sizes; (void)n_in; (void)out_size; (void)ws_size;
}
```

```cpp
#include <hip/hip_runtime.h>
#include <cstdint>
#include <cstdio>
#include <hip/hip_cooperative_groups.h>
namespace cg = cooperative_groups;

typedef unsigned short bf16_t;
typedef short bf16x8 __attribute__((ext_vector_type(8)));
typedef float f32x16 __attribute__((ext_vector_type(16)));

#define DI __device__ __forceinline__

constexpr int T_TOK = 16384, SEQ = 4096, DM = 1024, DIN = 5408, NIN = 5632;
#ifndef SPIN_PHASE
#define SPIN_PHASE (-1)
#endif
constexpr int CNT_STRIDE = 64;
constexpr float QSCALE = 0.125f * 1.4426950408889634f;
constexpr int ZC_Q = 0, ZC_KC = 512, ZC_VC = 640, ZC_KS = 768, ZC_VS = 896, ZC_KW = 1024, ZC_VW = 1152, ZC_GATE = 1280,
              ZC_MQK = 1304, ZC_MV = 2328, ZC_MO = 2840, ZC_IF = 3352, ZC_GA = 3360, ZC_GB = 4384;

DI bf16_t f2bf(float f) { unsigned u = __float_as_uint(f); return (bf16_t)((u + 0x7fffu + ((u >> 16) & 1u)) >> 16); }
DI float bf2f(bf16_t h) { return __uint_as_float(((unsigned)h) << 16); }
DI float sigmoidf_(float x) { return 1.f / (1.f + __expf(-x)); }
DI int lane_id_opaque() { int z = 0; asm volatile("" : "+v"(z)); return __builtin_amdgcn_mbcnt_hi(-1, __builtin_amdgcn_mbcnt_lo(-1, z)); }
DI float lane_xor(float v, int o, int lane) { return __int_as_float(__builtin_amdgcn_ds_bpermute((lane ^ o) << 2, __float_as_int(v))); }
DI float lane_get(float v, int src) { return __int_as_float(__builtin_amdgcn_ds_bpermute(src << 2, __float_as_int(v))); }
DI float wave_sum(float v) {
    const int l = lane_id_opaque();
#pragma unroll
    for (int o = 1; o < 64; o <<= 1) v += lane_xor(v, o, l);
    return v;
}
DI float wave_max(float v) {
    const int l = lane_id_opaque();
#pragma unroll
    for (int o = 1; o < 64; o <<= 1) v = fmaxf(v, lane_xor(v, o, l));
    return v;
}

namespace pg8 {
#define PG8_LAS __attribute__((address_space(3)))
typedef unsigned short bf16_t;
typedef short bf16x8 __attribute__((ext_vector_type(8)));
typedef float f32x4 __attribute__((ext_vector_type(4)));
typedef unsigned u32x4 __attribute__((ext_vector_type(4)));
constexpr int BM = 256, BK = 64, HALF = 128, HTB = HALF * BK * 2  , STAGE_BYTES = 8 * HTB, NXCD = 8, WGM = 8;

__host__ __device__ __forceinline__ int lds_byte(int r, int c) { const int st = (r >> 4) * 2 + (c >> 5), rr = r & 15, cc = c & 31, ob = rr * 64 + cc * 2; return st * 1024 + (ob ^ (((ob >> 9) & 1) << 5)); }
__host__ __device__ __forceinline__ void stage_rc(int b, int& R, int& C) { const int st = b / 1024, sb = b % 1024, swz = sb ^ (((sb >> 9) & 1) << 5); R = (st >> 1) * 16 + swz / 64; C = (st & 1) * 32 + (swz % 64) / 2; }
__host__ __device__ __forceinline__ int perm32(int rho) { const int n = rho >> 4, i = rho & 15; return 8 * (i >> 2) + 4 * n + (i & 3); }

struct Unit { int pm, pn, aux; };
struct Gemm { const bf16_t* A; const bf16_t* Bt; int M, N, K, lda, ldb; const int* amap; int avalid; };

struct StaticOrder {
    int nM, nN, nwg, G, c;
    __host__ __device__ __forceinline__ void init(int M, int N, int G_, int c_) { nM = M / BM; nN = N / BM; nwg = nM * nN; G = G_; c = c_; }
    __host__ __device__ __forceinline__ bool next(int i, Unit& u) const {
        const long L = (long)i * G + c; if (L >= nwg) return false;
        int wgid = (int)L; { const int q = nwg / NXCD, r = nwg % NXCD, xcd = wgid % NXCD, off = wgid / NXCD; wgid = (xcd < r ? xcd * (q + 1) : r * (q + 1) + (xcd - r) * q) + off; }
        const int nig = WGM * nN, gid = wgid / nig, fm = gid * WGM, gsz = (nM - fm) < WGM ? (nM - fm) : WGM;
        u.pm = fm + ((wgid % nig) % gsz); u.pn = (wgid % nig) / gsz; u.aux = 0; return true;
    }
    __device__ __forceinline__ void a_ready(const Unit&) const {}
    __device__ __forceinline__ void done(const Unit&) const {}
};

__device__ __forceinline__ unsigned cvt_pk_bf16(float lo, float hi) { unsigned r; asm volatile("v_cvt_pk_bf16_f32 %0, %1, %2" : "=v"(r) : "v"(lo), "v"(hi)); return r; }
typedef float f32x2 __attribute__((ext_vector_type(2)));
__device__ __forceinline__ f32x2 gelu_pk(f32x2 v) {
    const f32x2 av = __builtin_elementwise_abs(v), d = av * 0.2316418882f + 1.0f;
    f32x2 t; t.x = __builtin_amdgcn_rcpf(d.x); t.y = __builtin_amdgcn_rcpf(d.y);
    f32x2 q = t * 0.5307027145f + (-0.7265760135f); q = q * t + 0.7107068705f; q = q * t + (-0.142248368f); q = q * t + 0.127414796f; q = q * t;
    const f32x2 s = (v * v) * (-0.72134752044f);
    f32x2 e; e.x = __builtin_amdgcn_exp2f(s.x); e.y = __builtin_amdgcn_exp2f(s.y);
    const f32x2 m = v * (q * e), r = v - m;
    f32x2 o; o.x = v.x < 0.f ? m.x : r.x; o.y = v.y < 0.f ? m.y : r.y; return o;
}

template <int ACT  > struct EpiBf16 {
    static constexpr bool PERM = true, AFTER_DRAIN = false; static_assert(ACT == 0 || ACT == 1, "EpiBf16: ACT is 0 (none) or 1 (gelu_pk)");
    bf16_t* O; int ldc; const float* bias; int split_cols; size_t split_stride; float scale0;
    __device__ __forceinline__ void operator()(const f32x4 (&acc)[2][2][4][2], const Unit& u, int wr, int wc, int fr, int fq) const {
        const int row0 = u.pm * BM + wr * 64 + fr; int colt = u.pn * BM; bf16_t* base = O;
        float sc = 1.f; if (split_cols) { const int t = colt / split_cols; base += (size_t)t * split_stride; colt -= t * split_cols; if (t == 0) sc = scale0; }
        const int col0 = colt + wc * 32 + 8 * fq, bcol0 = u.pn * BM + wc * 32 + 8 * fq;
        f32x4 bv[2][2];
#pragma unroll
        for (int bj = 0; bj < 2; ++bj)
#pragma unroll
            for (int n = 0; n < 2; ++n) bv[bj][n] = bias ? *(const f32x4*)(bias + bcol0 + bj * HALF + 4 * n) : (f32x4){0.f, 0.f, 0.f, 0.f};
#pragma unroll
        for (int ai = 0; ai < 2; ++ai)
#pragma unroll
            for (int m = 0; m < 4; ++m) { bf16_t* rowp = base + (size_t)(row0 + ai * HALF + m * 16) * ldc + col0;
#pragma unroll
                for (int bj = 0; bj < 2; ++bj) { f32x4 v0 = acc[ai][bj][m][0] + bv[bj][0], v1 = acc[ai][bj][m][1] + bv[bj][1];
                    if (ACT == 1) { f32x2 a = gelu_pk((f32x2){v0[0], v0[1]}), b = gelu_pk((f32x2){v0[2], v0[3]}), c = gelu_pk((f32x2){v1[0], v1[1]}), d = gelu_pk((f32x2){v1[2], v1[3]});
                        v0 = (f32x4){a.x, a.y, b.x, b.y}; v1 = (f32x4){c.x, c.y, d.x, d.y}; }
                    v0 = v0 * sc; v1 = v1 * sc; u32x4 w; w.x = cvt_pk_bf16(v0[0], v0[1]); w.y = cvt_pk_bf16(v0[2], v0[3]); w.z = cvt_pk_bf16(v1[0], v1[1]); w.w = cvt_pk_bf16(v1[2], v1[3]);
                    *(u32x4*)(rowp + bj * HALF) = w; } }
    }
};

template <class Epi, class Sched, bool ALIGN_EPI = false, bool SP2 = false, bool GATHER = false>
__device__ __forceinline__ void gemm_phase(PG8_LAS unsigned char* lds, const Gemm g, const Sched& S, const Epi& E, const int tid) {
    const int wid = __builtin_amdgcn_readfirstlane(tid >> 6), lane = tid & 63, wr = wid >> 2, wc = wid & 3, fr = lane & 15, fq = lane >> 4;
    const int K = g.K, nt = K / BK;
    unsigned voffA[2], voffB[2], voffA1[2];
#pragma unroll
    for (int i = 0; i < 2; ++i) { int R, C; stage_rc(tid * 16 + i * 8192, R, C); const int Rb = Epi::PERM ? ((R & ~31) + perm32(R & 31)) : R;
        voffA[i] = (unsigned)(R * g.lda + C) * 2u; voffB[i] = (unsigned)(Rb * g.ldb + C) * 2u; voffA1[i] = voffA[i];
        if constexpr (GATHER) { const int t0_ = R < g.avalid ? g.amap[R] : 0, t1_ = R + HALF < g.avalid ? g.amap[R + HALF] : 0; voffA[i] = (unsigned)(t0_ * g.lda + C) * 2u; voffA1[i] = (unsigned)(t1_ * g.lda + C) * 2u; } }
    const size_t kstep = (size_t)(BK * 2);
    const size_t hstepA = (size_t)HALF * g.lda * 2, hstepB = (size_t)HALF * g.ldb * 2;
    const size_t tstepA = GATHER ? 0 : 2 * hstepA, tstepB = 2 * hstepB, hsA = GATHER ? 0 : hstepA;
    const unsigned ldsw = (unsigned)wid * 1024u;
    const int aoff = lds_byte(wr * 64 + fr, fq * 8), boff = lds_byte(wc * 32 + fr, fq * 8);
#define PG8_SA(b, h) (((b) * 2 + (h)) * HTB)
#define PG8_SB(b, h) ((4 + (b) * 2 + (h)) * HTB)
#define PG8_STAGE(bufoff, gbase, voff) do { _Pragma("unroll") for (int _i = 0; _i < 2; ++_i) \
        __builtin_amdgcn_global_load_lds((const unsigned*)((const char*)(gbase) + (voff)[_i]), (PG8_LAS unsigned*)(lds + (bufoff) + ldsw + _i * 8192), 16, 0, 0); } while (0)
#define PG8_LDA(dst, b, h) do { _Pragma("unroll") for (int m = 0; m < 4; ++m) _Pragma("unroll") for (int k = 0; k < 2; ++k) dst[m][k] = *(const PG8_LAS bf16x8*)(lds + PG8_SA(b, h) + aoff + m * 2048 + k * 1024); } while (0)
#define PG8_LDB(dst, b, h) do { _Pragma("unroll") for (int n = 0; n < 2; ++n) _Pragma("unroll") for (int k = 0; k < 2; ++k) dst[n][k] = *(const PG8_LAS bf16x8*)(lds + PG8_SB(b, h) + boff + n * 2048 + k * 1024); } while (0)
#define PG8_MMA(ai, bj, At, Bt) do { __builtin_amdgcn_s_setprio(1); _Pragma("unroll") for (int m = 0; m < 4; ++m) _Pragma("unroll") for (int n = 0; n < 2; ++n) _Pragma("unroll") for (int k = 0; k < 2; ++k) \
        acc[ai][bj][m][n] = __builtin_amdgcn_mfma_f32_16x16x32_bf16(Bt[n][k], At[m][k], acc[ai][bj][m][n], 0, 0, 0); __builtin_amdgcn_s_setprio(0); } while (0)
#define PG8_WAIT_V(n) asm volatile("s_waitcnt vmcnt(" #n ")" ::: "memory")
#define PG8_WAIT_L(n) asm volatile("s_waitcnt lgkmcnt(" #n ")" ::: "memory")
#define PG8_BAR __builtin_amdgcn_s_barrier()
#define PG8_SCHED __builtin_amdgcn_sched_barrier(0)
    Unit cur, nxt; int ui = 0;
    if (!S.next(0, cur)) return;
    f32x4 acc[2][2][4][2];
#pragma unroll
    for (int a = 0; a < 2; ++a)
#pragma unroll
        for (int b = 0; b < 2; ++b)
#pragma unroll
            for (int m = 0; m < 4; ++m)
#pragma unroll
                for (int n = 0; n < 2; ++n) acc[a][b][m][n] = (f32x4){0.f, 0.f, 0.f, 0.f};
    bf16x8 At[4][2], B0[2][2], B1[2][2];
    const char* cA = (const char*)g.A + (size_t)cur.pm * tstepA; const char* cB = (const char*)g.Bt + (size_t)cur.pn * tstepB;
    S.a_ready(cur);
    if constexpr (SP2) {
        PG8_STAGE(PG8_SB(0, 0), cB, voffB); PG8_STAGE(PG8_SB(0, 1), cB + hstepB, voffB); PG8_STAGE(PG8_SA(0, 0), cA, voffA); PG8_STAGE(PG8_SA(0, 1), cA + hsA, voffA1);
        if (wr == 1) PG8_BAR;
        PG8_WAIT_V(2); PG8_BAR;
        PG8_STAGE(PG8_SB(1, 0), cB + kstep, voffB); PG8_STAGE(PG8_SA(1, 0), cA + kstep, voffA); PG8_STAGE(PG8_SB(1, 1), cB + hstepB + kstep, voffB);
        PG8_WAIT_V(6); PG8_BAR;
    } else {
        PG8_STAGE(PG8_SB(0, 0), cB, voffB); PG8_STAGE(PG8_SA(0, 0), cA, voffA); PG8_STAGE(PG8_SB(0, 1), cB + hstepB, voffB); PG8_STAGE(PG8_SA(0, 1), cA + hsA, voffA1);
        if (wr == 1) PG8_BAR;
        PG8_WAIT_V(4); PG8_BAR;
        PG8_STAGE(PG8_SB(1, 0), cB + kstep, voffB); PG8_STAGE(PG8_SA(1, 0), cA + kstep, voffA); PG8_STAGE(PG8_SB(1, 1), cB + hstepB + kstep, voffB);
        PG8_WAIT_V(6); PG8_BAR;
    }
    for (;;) {
        const bool has_next = S.next(ui + 1, nxt);
        const char* nA = has_next ? (const char*)g.A + (size_t)nxt.pm * tstepA : cA; const char* nB = has_next ? (const char*)g.Bt + (size_t)nxt.pn * tstepB : cB;
        for (int t = 0; t < nt; t += 2) {
            const bool last = (t == nt - 2);
            const char* a1 = cA + (size_t)(t + 1) * kstep;
            const char* a2 = last ? nA : cA + (size_t)(t + 2) * kstep; const char* b2 = last ? nB : cB + (size_t)(t + 2) * kstep;
            const char* a3 = a2 + kstep; const char* b3 = b2 + kstep;
            if (last && has_next) S.a_ready(nxt);
            if constexpr (SP2) {
            PG8_LDB(B0, 0, 0); PG8_LDB(B1, 0, 1); PG8_SCHED; PG8_LDA(At, 0, 0); PG8_STAGE(PG8_SA(1, 1), a1 + hsA, voffA1);
            PG8_WAIT_V(8); PG8_WAIT_L(0); PG8_BAR; PG8_MMA(0, 0, At, B0); PG8_MMA(0, 1, At, B1); PG8_BAR; PG8_SCHED;
            PG8_LDA(At, 0, 1); PG8_STAGE(PG8_SB(0, 0), b2, voffB); PG8_STAGE(PG8_SB(0, 1), b2 + hstepB, voffB); PG8_STAGE(PG8_SA(0, 0), a2, voffA);
            PG8_WAIT_V(8); PG8_WAIT_L(0); PG8_BAR; PG8_MMA(1, 0, At, B0); PG8_MMA(1, 1, At, B1); PG8_BAR; PG8_SCHED;
            PG8_LDB(B0, 1, 0); PG8_LDB(B1, 1, 1); PG8_SCHED; PG8_LDA(At, 1, 0); PG8_STAGE(PG8_SA(0, 1), a2 + hsA, voffA1);
            PG8_WAIT_V(8); PG8_WAIT_L(0); PG8_BAR; PG8_MMA(0, 0, At, B0); PG8_MMA(0, 1, At, B1); PG8_BAR; PG8_SCHED;
            PG8_LDA(At, 1, 1); PG8_STAGE(PG8_SB(1, 0), b3, voffB); PG8_STAGE(PG8_SB(1, 1), b3 + hstepB, voffB); PG8_STAGE(PG8_SA(1, 0), a3, voffA);
            PG8_WAIT_V(8); PG8_WAIT_L(0); PG8_BAR; PG8_MMA(1, 0, At, B0); PG8_MMA(1, 1, At, B1); PG8_BAR; PG8_SCHED;
            } else {
            PG8_LDB(B0, 0, 0); PG8_SCHED; PG8_LDA(At, 0, 0); PG8_STAGE(PG8_SA(1, 1), a1 + hsA, voffA1);
            PG8_WAIT_L(8); PG8_BAR; PG8_WAIT_L(0); PG8_MMA(0, 0, At, B0); PG8_BAR; PG8_SCHED;
            PG8_LDB(B1, 0, 1); PG8_STAGE(PG8_SB(0, 0), b2, voffB);
            PG8_BAR; PG8_WAIT_L(0); PG8_MMA(0, 1, At, B1); PG8_BAR;
            PG8_LDA(At, 0, 1); PG8_STAGE(PG8_SA(0, 0), a2, voffA);
            PG8_BAR; PG8_WAIT_L(0); PG8_MMA(1, 0, At, B0); PG8_BAR; PG8_SCHED;
            PG8_STAGE(PG8_SB(0, 1), b2 + hstepB, voffB);
            PG8_WAIT_V(6); PG8_BAR; PG8_MMA(1, 1, At, B1); PG8_BAR;
            PG8_LDB(B0, 1, 0); PG8_SCHED; PG8_LDA(At, 1, 0); PG8_STAGE(PG8_SA(0, 1), a2 + hsA, voffA1);
            PG8_WAIT_L(8); PG8_BAR; PG8_WAIT_L(0); PG8_MMA(0, 0, At, B0); PG8_BAR; PG8_SCHED;
            PG8_LDB(B1, 1, 1); PG8_STAGE(PG8_SB(1, 0), b3, voffB);
            PG8_BAR; PG8_WAIT_L(0); PG8_MMA(0, 1, At, B1); PG8_BAR;
            PG8_LDA(At, 1, 1); PG8_STAGE(PG8_SA(1, 0), a3, voffA);
            PG8_BAR; PG8_WAIT_L(0); PG8_MMA(1, 0, At, B0); PG8_BAR; PG8_SCHED;
            PG8_STAGE(PG8_SB(1, 1), b3 + hstepB, voffB);
            PG8_WAIT_V(6); PG8_BAR; PG8_MMA(1, 1, At, B1); PG8_BAR;
            }
        }
        if constexpr (ALIGN_EPI) { if (wr == 0) PG8_BAR; }
        if constexpr (!Epi::AFTER_DRAIN) { const int l2_ = lane_id_opaque(); E(acc, cur, wr, wc, l2_ & 15, l2_ >> 4); S.done(cur); }
        if (!has_next) break;
#pragma unroll
        for (int a = 0; a < 2; ++a)
#pragma unroll
            for (int b = 0; b < 2; ++b)
#pragma unroll
                for (int m = 0; m < 4; ++m)
#pragma unroll
                    for (int n = 0; n < 2; ++n) acc[a][b][m][n] = (f32x4){0.f, 0.f, 0.f, 0.f};
        cur = nxt; cA = nA; cB = nB; ++ui;
        if constexpr (ALIGN_EPI) { if (wr == 1) PG8_BAR; }
    }
    PG8_WAIT_V(0);
    if constexpr (!ALIGN_EPI) { if (wr == 0) PG8_BAR; }
    PG8_BAR;
    if constexpr (Epi::AFTER_DRAIN) { E.fused(acc, cur, wr, wc, fr, fq, lds, wid, lane); S.done(cur); }
#undef PG8_SA
#undef PG8_SB
#undef PG8_STAGE
#undef PG8_LDA
#undef PG8_LDB
#undef PG8_MMA
#undef PG8_WAIT_V
#undef PG8_WAIT_L
#undef PG8_BAR
#undef PG8_SCHED
}
}


#define LAS __attribute__((address_space(3)))
DI unsigned pk2(float lo, float hi) { return (unsigned)f2bf(lo) | ((unsigned)f2bf(hi) << 16); }
template <class Map>
DI void prep_wt_item(const float* __restrict__ W, int ldw, int K, bf16_t* __restrict__ WT, const float* __restrict__ gain, Map map, float* scr, int item, int nblk, int lane) {
    const int kb = item / nblk, nb = item % nblk, k0 = 64 * kb, n0 = 32 * nb;
    const int srcn = map(n0 + (lane & 31));
    float tv[32];
#pragma unroll
    for (int i = 0; i < 32; ++i) { const int kk = 2 * i + (lane >> 5); tv[i] = srcn >= 0 ? W[(size_t)(k0 + kk) * ldw + srcn] : 0.f; }
#pragma unroll
    for (int i = 0; i < 32; ++i) { const int kk = 2 * i + (lane >> 5); scr[kk * 33 + (lane & 31)] = gain ? tv[i] * gain[k0 + kk] : tv[i]; }
    __builtin_amdgcn_s_waitcnt(0xC07F); asm volatile("" ::: "memory");
    const int c = lane & 7;
#pragma unroll
    for (int j = 0; j < 4; ++j) { const int n = (lane >> 3) + 8 * j; const float* s = scr + (8 * c) * 33 + n;
        uint4 o; o.x = pk2(s[0 * 33], s[1 * 33]); o.y = pk2(s[2 * 33], s[3 * 33]); o.z = pk2(s[4 * 33], s[5 * 33]); o.w = pk2(s[6 * 33], s[7 * 33]);
        *(uint4*)(WT + (size_t)(n0 + n) * K + k0 + 8 * c) = o; }
    __builtin_amdgcn_s_waitcnt(0xC07F); asm volatile("" ::: "memory");
}
struct MapIn {
    DI int operator()(int n) const {
        if (n < 1280) return n;
        if (n < 1536) { const int i = n - 1280; return i < 24 ? ZC_GATE + i : (i < 32 ? ZC_IF + (i - 24) : -1); }
        if (n < 2560) return ZC_MQK + (n - 1536);
        if (n < 3072) return ZC_MV + (n - 2560);
        if (n < 3584) return ZC_MO + (n - 3072);
        return ZC_GA + (n - 3584);
    }
};
DI void prep_x_row(const float* __restrict__ x, bf16_t* __restrict__ xb, float* __restrict__ rstd, int row, int lane) {
    const float4* xr = (const float4*)(x + (size_t)row * DM);
    float4 v[4]; float s = 0.f;
#pragma unroll
    for (int j = 0; j < 4; ++j) { v[j] = xr[lane + 64 * j]; s += v[j].x * v[j].x + v[j].y * v[j].y + v[j].z * v[j].z + v[j].w * v[j].w; }
    s = wave_sum(s);
    if (lane == 0) rstd[row] = rsqrtf(s * (1.f / DM) + 1e-6f);
#pragma unroll
    for (int j = 0; j < 4; ++j) { uint2 o; o.x = pk2(v[j].x, v[j].y); o.y = pk2(v[j].z, v[j].w); ((uint2*)(xb + (size_t)row * DM))[lane + 64 * j] = o; }
}

struct EpiInProj {
    static constexpr bool PERM = true, AFTER_DRAIN = false;
    const float* rstd; const float* cosT; const float* sinT; const float* b_if;
    bf16_t* Qb; bf16_t* KVb; float* gates; float* ifp; bf16_t* MQK; bf16_t* MV; bf16_t* MO; bf16_t* MG; bf16_t* VT;
    DI void operator()(const pg8::f32x4 (&acc)[2][2][4][2], const pg8::Unit& u, int wr, int wc, int fr, int fq) const {
        const int pn = u.pn;
        asm volatile("" : "+v"(fr), "+v"(fq));
#pragma unroll
        for (int ai = 0; ai < 2; ++ai)
#pragma unroll
            for (int m = 0; m < 4; ++m) {
                const int row = u.pm * 256 + ai * 128 + wr * 64 + m * 16 + fr;
                const float rs = rstd[row];
#pragma unroll
                for (int bj = 0; bj < 2; ++bj) {
                    float v[8];
#pragma unroll
                    for (int i = 0; i < 4; ++i) { v[i] = acc[ai][bj][m][0][i] * rs; v[4 + i] = acc[ai][bj][m][1][i] * rs; }
                    const int c0 = bj * 128 + wc * 32 + 8 * fq;
                    if (pn <= 4) {
                        const bool is_k = (pn < 2) || (bj == 0);
                        if (is_k && (wc & 1) == 0) {
                            const float4 c_lo = *(const float4*)(cosT + (size_t)row * 8), c_hi = *(const float4*)(cosT + (size_t)row * 8 + 4);
                            const float4 s_lo = *(const float4*)(sinT + (size_t)row * 8), s_hi = *(const float4*)(sinT + (size_t)row * 8 + 4);
                            const float cs[8] = {c_lo.x, c_lo.y, c_lo.z, c_lo.w, c_hi.x, c_hi.y, c_hi.z, c_hi.w};
                            const float sn[8] = {s_lo.x, s_lo.y, s_lo.z, s_lo.w, s_hi.x, s_hi.y, s_hi.z, s_hi.w};
                            const int l_ = lane_id_opaque();
#pragma unroll
                            for (int i = 0; i < 8; ++i) {
                                const float other = lane_xor(v[i], 16, l_);
                                if (fq == 0) v[i] = v[i] * cs[i] - other * sn[i];
                                else if (fq == 1) v[i] = v[i] * cs[i] + other * sn[i];
                            }
                        }
                        const float sc = pn < 2 ? QSCALE : 1.f;
                        pg8::u32x4 w; w.x = pg8::cvt_pk_bf16(v[0] * sc, v[1] * sc); w.y = pg8::cvt_pk_bf16(v[2] * sc, v[3] * sc); w.z = pg8::cvt_pk_bf16(v[4] * sc, v[5] * sc); w.w = pg8::cvt_pk_bf16(v[6] * sc, v[7] * sc);
                        if (pn < 2) *(pg8::u32x4*)(Qb + (size_t)row * 512 + pn * 256 + c0) = w;
                        else if (pn == 2) *(pg8::u32x4*)(KVb + (size_t)row * 512 + c0) = w;
                        else if (bj == 0) *(pg8::u32x4*)(KVb + (size_t)row * 512 + (pn - 2) * 128 + 128 + wc * 32 + 8 * fq) = w;
                        else {
                            const int cv = wc * 32 + 8 * fq, gg = cv >> 6, d0 = cv & 63, bb = row >> 12, tt = row & 4095;
                            bf16_t* vt = VT + ((size_t)((pn - 3) * 8 + bb * 2 + gg) * 64 + (tt >> 6)) * 4096 + (size_t)d0 * 64 + (tt & 63);
                            vt[0] = (bf16_t)(w.x & 0xffffu); vt[64] = (bf16_t)(w.x >> 16); vt[128] = (bf16_t)(w.y & 0xffffu); vt[192] = (bf16_t)(w.y >> 16);
                            vt[256] = (bf16_t)(w.z & 0xffffu); vt[320] = (bf16_t)(w.z >> 16); vt[384] = (bf16_t)(w.w & 0xffffu); vt[448] = (bf16_t)(w.w >> 16);
                        }
                    } else if (pn == 5) {
                        if (bj == 0 && wc == 0) {
#pragma unroll
                            for (int i = 0; i < 8; ++i) { const int c = 8 * fq + i;
                                if (c < 24) gates[(size_t)row * 24 + c] = sigmoidf_(v[i]);
                                else if (c < 32) ifp[(size_t)row * 8 + (c - 24)] = v[i] + b_if[c - 24]; }
                        }
                    } else {
                        if (pn >= 14) {
#pragma unroll
                            for (int i = 0; i < 8; ++i) v[i] = sigmoidf_(v[i]);
                        }
                        pg8::u32x4 w; w.x = pg8::cvt_pk_bf16(v[0], v[1]); w.y = pg8::cvt_pk_bf16(v[2], v[3]); w.z = pg8::cvt_pk_bf16(v[4], v[5]); w.w = pg8::cvt_pk_bf16(v[6], v[7]);
                        bf16_t* dst;
                        if (pn < 10) dst = MQK + (size_t)row * 1024 + (pn - 6) * 256 + c0;
                        else if (pn < 12) dst = MV + (size_t)row * 512 + (pn - 10) * 256 + c0;
                        else if (pn < 14) dst = MO + (size_t)row * 512 + (pn - 12) * 256 + c0;
                        else dst = MG + (size_t)row * 2048 + (pn - 14) * 256 + c0;
                        *(pg8::u32x4*)dst = w;
                    }
                }
            }
    }
};


DI pg8::u32x4 pack8(const float (&v)[8]) { pg8::u32x4 w; w.x = pg8::cvt_pk_bf16(v[0], v[1]); w.y = pg8::cvt_pk_bf16(v[2], v[3]); w.z = pg8::cvt_pk_bf16(v[4], v[5]); w.w = pg8::cvt_pk_bf16(v[6], v[7]); return w; }
DI void unpack8(const pg8::u32x4 w, float (&v)[8]) {
    v[0] = __uint_as_float(w.x << 16); v[1] = __uint_as_float(w.x & 0xffff0000u); v[2] = __uint_as_float(w.y << 16); v[3] = __uint_as_float(w.y & 0xffff0000u);
    v[4] = __uint_as_float(w.z << 16); v[5] = __uint_as_float(w.z & 0xffff0000u); v[6] = __uint_as_float(w.w << 16); v[7] = __uint_as_float(w.w & 0xffff0000u);
}
#define EPI_ROWS_BEGIN asm volatile("" : "+v"(fr), "+v"(fq)); _Pragma("unroll") for (int ai = 0; ai < 2; ++ai) _Pragma("unroll") for (int m = 0; m < 4; ++m) { const int row = u.pm * 256 + ai * 128 + wr * 64 + m * 16 + fr; _Pragma("unroll") for (int bj = 0; bj < 2; ++bj) { \
    float v[8]; _Pragma("unroll") for (int i = 0; i < 4; ++i) { v[i] = acc[ai][bj][m][0][i]; v[4 + i] = acc[ai][bj][m][1][i]; } const int c0 = bj * 128 + wc * 32 + 8 * fq; (void)c0; (void)row;
#define EPI_ROWS_END } asm volatile("" ::: "memory"); }
template <int MODE> struct EpiMerge {
    static constexpr bool PERM = true, AFTER_DRAIN = false;
    const bf16_t* MG; float* tmp; bf16_t* mixed;
    DI void operator()(const pg8::f32x4 (&acc)[2][2][4][2], const pg8::Unit& u, int wr, int wc, int fr, int fq) const {
        EPI_ROWS_BEGIN
            const int col = u.pn * 256 + c0; float gt[8];
            unpack8(*(const pg8::u32x4*)(MG + (size_t)row * 2048 + MODE * 1024 + col), gt);
            float* tp = tmp + (size_t)row * DM + col;
            if (MODE == 0) {
                *(float4*)tp = make_float4(gt[0] * v[0], gt[1] * v[1], gt[2] * v[2], gt[3] * v[3]); *(float4*)(tp + 4) = make_float4(gt[4] * v[4], gt[5] * v[5], gt[6] * v[6], gt[7] * v[7]);
            } else {
                const float4 t0 = *(const float4*)tp, t1 = *(const float4*)(tp + 4);
                float o[8] = {t0.x + gt[0] * v[0], t0.y + gt[1] * v[1], t0.z + gt[2] * v[2], t0.w + gt[3] * v[3], t1.x + gt[4] * v[4], t1.y + gt[5] * v[5], t1.z + gt[6] * v[6], t1.w + gt[7] * v[7]};
                *(pg8::u32x4*)(mixed + (size_t)row * DM + col) = pack8(o);
            }
        EPI_ROWS_END
    }
};
struct EpiX1 {
    static constexpr bool PERM = true, AFTER_DRAIN = false;
    const float* base; float* out; bf16_t* outb;
    DI void operator()(const pg8::f32x4 (&acc)[2][2][4][2], const pg8::Unit& u, int wr, int wc, int fr, int fq) const {
        EPI_ROWS_BEGIN
            const size_t o = (size_t)row * DM + u.pn * 256 + c0;
            const float4 b0 = *(const float4*)(base + o), b1 = *(const float4*)(base + o + 4);
            const float r[8] = {b0.x + v[0], b0.y + v[1], b0.z + v[2], b0.w + v[3], b1.x + v[4], b1.y + v[5], b1.z + v[6], b1.w + v[7]};
            *(float4*)(out + o) = make_float4(r[0], r[1], r[2], r[3]); *(float4*)(out + o + 4) = make_float4(r[4], r[5], r[6], r[7]);
            *(pg8::u32x4*)(outb + o) = pack8(r);
        EPI_ROWS_END
    }
};
struct EpiStoreBf {
    static constexpr bool PERM = true, AFTER_DRAIN = false;
    bf16_t* O; int ld; int pnmask;
    DI void operator()(const pg8::f32x4 (&acc)[2][2][4][2], const pg8::Unit& u, int wr, int wc, int fr, int fq) const {
        EPI_ROWS_BEGIN
            *(pg8::u32x4*)(O + (size_t)row * ld + (u.pn & pnmask) * 256 + c0) = pack8(v);
        EPI_ROWS_END
    }
};
struct EpiSwiglu {
    static constexpr bool PERM = true, AFTER_DRAIN = false;
    bf16_t* act; const int* amap; int avalid; const float* rstd1;
    DI void operator()(const pg8::f32x4 (&acc)[2][2][4][2], const pg8::Unit& u, int wr, int wc, int fr, int fq) const {
        asm volatile("" : "+v"(fr), "+v"(fq));
#pragma unroll
        for (int ai = 0; ai < 2; ++ai)
#pragma unroll
            for (int m = 0; m < 4; ++m) {
                const int rl = ai * 128 + wr * 64 + m * 16 + fr, row = u.pm * 256 + rl; float o[8];
                const float rs = rl < avalid ? rstd1[amap[rl]] : 0.f;
#pragma unroll
                for (int i = 0; i < 4; ++i) { const float g0 = rs * acc[ai][0][m][0][i], g1 = rs * acc[ai][0][m][1][i]; o[i] = g0 * sigmoidf_(g0) * (rs * acc[ai][1][m][0][i]); o[4 + i] = g1 * sigmoidf_(g1) * (rs * acc[ai][1][m][1][i]); }
                *(pg8::u32x4*)(act + (size_t)row * 256 + (u.pn & 1) * 128 + wc * 32 + 8 * fq) = pack8(o);
            }
    }
};
struct EpiPle2 {
    static constexpr bool PERM = true, AFTER_DRAIN = false;
    float* x; const bf16_t* PP; const float* rstd;
    DI void operator()(const pg8::f32x4 (&acc)[2][2][4][2], const pg8::Unit& u, int wr, int wc, int fr, int fq) const {
        EPI_ROWS_BEGIN
            const size_t o = (size_t)row * DM + u.pn * 256 + c0; const float rs = rstd[row]; float pp[8];
            unpack8(*(const pg8::u32x4*)(PP + o), pp);
            const float4 b0 = *(const float4*)(x + o), b1 = *(const float4*)(x + o + 4);
            *(float4*)(x + o) = make_float4(b0.x + sigmoidf_(rs * v[0]) * pp[0], b0.y + sigmoidf_(rs * v[1]) * pp[1], b0.z + sigmoidf_(rs * v[2]) * pp[2], b0.w + sigmoidf_(rs * v[3]) * pp[3]);
            *(float4*)(x + o + 4) = make_float4(b1.x + sigmoidf_(rs * v[4]) * pp[4], b1.y + sigmoidf_(rs * v[5]) * pp[5], b1.z + sigmoidf_(rs * v[6]) * pp[6], b1.w + sigmoidf_(rs * v[7]) * pp[7]);
        EPI_ROWS_END
    }
};

struct EpiPleFinal {
    static constexpr bool PERM = true, AFTER_DRAIN = true;
    const float* x2; const bf16_t* PP; const float* rstd2; const float* g_final; float* out; float* xbuf; unsigned* pcnt;
    DI void fused(pg8::f32x4 (&acc)[2][2][4][2], const pg8::Unit& u, int wr, int wc, int fr, int fq, PG8_LAS unsigned char* lds, int wid, int lane) const {
        __attribute__((address_space(3))) float* P = (__attribute__((address_space(3))) float*)lds;
        __attribute__((address_space(3))) float* S = P + 1024;
        const int l_ = lane_id_opaque();
#pragma unroll
        for (int ai = 0; ai < 2; ++ai)
#pragma unroll
            for (int m = 0; m < 4; ++m) {
                const int rl = ai * 128 + wr * 64 + m * 16 + fr, row = u.pm * 256 + rl; const float rs = rstd2[row]; float sq = 0.f;
#pragma unroll
                for (int bj = 0; bj < 2; ++bj) {
                    const size_t o = (size_t)row * DM + u.pn * 256 + bj * 128 + wc * 32 + 8 * fq; float pp[8];
                    unpack8(*(const pg8::u32x4*)(PP + o), pp);
                    const float4 b0 = *(const float4*)(x2 + o), b1 = *(const float4*)(x2 + o + 4);
                    const float bx[8] = {b0.x, b0.y, b0.z, b0.w, b1.x, b1.y, b1.z, b1.w};
#pragma unroll
                    for (int i = 0; i < 4; ++i) {
                        const float v0 = bx[i] + sigmoidf_(rs * acc[ai][bj][m][0][i]) * pp[i], v1 = bx[4 + i] + sigmoidf_(rs * acc[ai][bj][m][1][i]) * pp[4 + i];
                        acc[ai][bj][m][0][i] = v0; acc[ai][bj][m][1][i] = v1; sq += v0 * v0 + v1 * v1;
                    }
                }
                sq += lane_xor(sq, 16, l_); sq += lane_xor(sq, 32, l_);
                if (fq == 0) P[rl * 4 + wc] = sq;
                asm volatile("" ::: "memory");
            }
        __syncthreads();
        const int t = wid * 64 + lane;
        if (t < 256) { const float ps = (P[t * 4] + P[t * 4 + 1]) + (P[t * 4 + 2] + P[t * 4 + 3]);
            __hip_atomic_store(xbuf + ((size_t)u.pm * 256 + t) * 4 + u.pn, ps, __ATOMIC_RELAXED, __HIP_MEMORY_SCOPE_AGENT); }
        asm volatile("s_waitcnt vmcnt(0)" ::: "memory");
        __syncthreads();
        if (t == 0) __hip_atomic_fetch_add(pcnt + 64 * u.pm, 1u, __ATOMIC_RELAXED, __HIP_MEMORY_SCOPE_AGENT);
        if (wid == 0) { unsigned spins = 0; while (__hip_atomic_load(pcnt + 64 * u.pm, __ATOMIC_RELAXED, __HIP_MEMORY_SCOPE_AGENT) < 4u && ++spins < (1u << 22)) __builtin_amdgcn_s_sleep(2); }
        __syncthreads();
        if (t < 256) { const float* xb = xbuf + ((size_t)u.pm * 256 + t) * 4;
            const float tot = (__hip_atomic_load(xb, __ATOMIC_RELAXED, __HIP_MEMORY_SCOPE_AGENT) + __hip_atomic_load(xb + 1, __ATOMIC_RELAXED, __HIP_MEMORY_SCOPE_AGENT))
                            + (__hip_atomic_load(xb + 2, __ATOMIC_RELAXED, __HIP_MEMORY_SCOPE_AGENT) + __hip_atomic_load(xb + 3, __ATOMIC_RELAXED, __HIP_MEMORY_SCOPE_AGENT));
            S[t] = rsqrtf(tot * (1.f / DM) + 1e-6f); }
        __syncthreads();
#pragma unroll
        for (int ai = 0; ai < 2; ++ai)
#pragma unroll
            for (int m = 0; m < 4; ++m) {
                const int rl = ai * 128 + wr * 64 + m * 16 + fr, row = u.pm * 256 + rl; const float r3 = S[rl];
#pragma unroll
                for (int bj = 0; bj < 2; ++bj) {
                    const int col = u.pn * 256 + bj * 128 + wc * 32 + 8 * fq; const size_t o = (size_t)row * DM + col;
                    const float4 g0 = *(const float4*)(g_final + col), g1 = *(const float4*)(g_final + col + 4);
                    *(float4*)(out + o) = make_float4(acc[ai][bj][m][0][0] * r3 * g0.x, acc[ai][bj][m][0][1] * r3 * g0.y, acc[ai][bj][m][0][2] * r3 * g0.z, acc[ai][bj][m][0][3] * r3 * g0.w);
                    *(float4*)(out + o + 4) = make_float4(acc[ai][bj][m][1][0] * r3 * g1.x, acc[ai][bj][m][1][1] * r3 * g1.y, acc[ai][bj][m][1][2] * r3 * g1.z, acc[ai][bj][m][1][3] * r3 * g1.w);
                }
            }
    }
};
struct MoeOrder {
    const int* cnt; int NJ, G, c;
    DI bool next(int i, pg8::Unit& u) const {
        int L = i * G + c, tb = 0;
        for (int e = 0; e < 16; ++e) { const int mt = (cnt[e * CNT_STRIDE] + 255) >> 8, n = mt * NJ; if (L < n) { u.pm = tb + L / NJ; u.pn = e * NJ + L % NJ; u.aux = L / NJ; return true; } L -= n; tb += mt; }
        return false;
    }
    DI void a_ready(const pg8::Unit&) const {}
    DI void done(const pg8::Unit&) const {}
};
struct OneUnit { pg8::Unit u; DI bool next(int i, pg8::Unit& o) const { o = u; return i == 0; } DI void a_ready(const pg8::Unit&) const {} DI void done(const pg8::Unit&) const {} };
struct PPOrder { int extra, G, c; DI bool next(int i, pg8::Unit& u) const { const int nl = G - extra, li = c - extra; if (li < 0 || nl <= 0) return false; const int id = li + i * nl; if (id >= 256) return false; u.pm = id >> 2; u.pn = id & 3; u.aux = 0; return true; }
    DI void a_ready(const pg8::Unit&) const {} DI void done(const pg8::Unit&) const {} };
DI int moe_base_row(const int* cnt, int e) { int tb = 0; for (int k = 0; k < 16; ++k) { if (k < e) tb += (cnt[k * CNT_STRIDE] + 255) >> 8; } return tb * 256; }
struct MapId { DI int operator()(int n) const { return n; } };
struct MapE13 { DI int operator()(int n) const { return ((n >> 7) & 1) * 256 + (n >> 8) * 128 + (n & 127); } };

DI void router_stage(__attribute__((address_space(3))) float* Wl, const float* __restrict__ g, const float* __restrict__ w_rg, const float* __restrict__ w_re, int tx) {
    for (int e = tx; e < 4096; e += 512) { const int k = e >> 2, c = e & 3; Wl[c * 1024 + k] = w_rg[e] * g[k]; }
    for (int e = tx; e < 16384; e += 512) { const int k = e >> 4, c = e & 15; Wl[(4 + c) * 1024 + k] = w_re[e] * g[k]; }
}
typedef float f4v __attribute__((ext_vector_type(4)));
DI void router2(int tok, int lane, const f4v (&xv)[4], const __attribute__((address_space(3))) float* Wl, const float* __restrict__ b_rg, const float* __restrict__ b_re,
                float* __restrict__ rstd1, __attribute__((address_space(3))) int* lcnt, __attribute__((address_space(3))) int* lri) {
    float s = 0.f;
#pragma unroll
    for (int j = 0; j < 4; ++j) s += (xv[j].x * xv[j].x + xv[j].y * xv[j].y) + (xv[j].z * xv[j].z + xv[j].w * xv[j].w);
    const float rstd = rsqrtf(wave_sum(s) * (1.f / DM) + 1e-6f);
    float al[20];
#pragma unroll
    for (int c = 0; c < 20; ++c) {
        float a = 0.f;
#pragma unroll
        for (int j = 0; j < 4; ++j) { const f4v w = *(const __attribute__((address_space(3))) f4v*)(Wl + c * 1024 + 4 * (lane + 64 * j)); a += (xv[j].x * w.x + xv[j].y * w.y) + (xv[j].z * w.z + xv[j].w * w.w); }
        al[c] = a;
    }
    {
        const int l_ = lane_id_opaque();
#pragma unroll
        for (int o = 1; o < 64; o <<= 1) {
            float t[20];
#pragma unroll
            for (int c = 0; c < 20; ++c) t[c] = lane_xor(al[c], o, l_);
#pragma unroll
            for (int c = 0; c < 20; ++c) al[c] += t[c];
        }
    }
    float gl[4], el[16];
#pragma unroll
    for (int c = 0; c < 4; ++c) gl[c] = al[c] * rstd + b_rg[c];
#pragma unroll
    for (int c = 0; c < 16; ++c) el[c] = al[4 + c] * rstd + b_re[c];
    if (lane == 0) {
        int gs = 0; float gm = gl[0];
#pragma unroll
        for (int c = 1; c < 4; ++c) if (gl[c] > gm) { gm = gl[c]; gs = c; }
        float se = 0.f;
#pragma unroll
        for (int c = 0; c < 4; ++c) se += __expf(gl[c] - gm);
        const float pg = 1.f / se;
        float e4[4];
#pragma unroll
        for (int c = 0; c < 4; ++c) e4[c] = gs == 0 ? el[c] : gs == 1 ? el[4 + c] : gs == 2 ? el[8 + c] : el[12 + c];
        int i0 = 0; float v0 = e4[0];
#pragma unroll
        for (int c = 1; c < 4; ++c) if (e4[c] > v0) { v0 = e4[c]; i0 = c; }
        int i1 = -1; float v1 = -3.0e38f;
#pragma unroll
        for (int c = 0; c < 4; ++c) if (c != i0 && e4[c] > v1) { v1 = e4[c]; i1 = c; }
        const float ex = __expf(v1 - v0);
        const float w0 = pg / (1.f + ex), w1 = pg * ex / (1.f + ex);
        const int e0 = gs * 4 + i0, e1 = gs * 4 + i1;
        const int p0 = __hip_atomic_fetch_add(lcnt + e0, 1, __ATOMIC_RELAXED, __HIP_MEMORY_SCOPE_WORKGROUP), p1 = __hip_atomic_fetch_add(lcnt + e1, 1, __ATOMIC_RELAXED, __HIP_MEMORY_SCOPE_WORKGROUP);
        rstd1[tok] = rstd;
        lri[0] = e0 | (e1 << 8); lri[1] = p0 | (p1 << 16); lri[2] = __float_as_int(w0); lri[3] = __float_as_int(w1);
    }
}

struct BMapId { DI int operator()(int n) const { return n; } };
struct BMapMoe { DI int operator()(int n) const { const int t = n >> 7, c = n & 127, e = t >> 2, jt = t & 3; return e * (1024 * 512) + ((c >> 5) & 1) * 256 + jt * 64 + (c >> 6) * 32 + (c & 31); } };
template <class Epi, class BMap>
DI void gemm_v1(int bx, int by, int tid, char* sm, const bf16_t* __restrict__ A, int lda, const float* __restrict__ B, int ldb, int N, int K, Epi epi, BMap bmap) {
    bf16_t* As = (bf16_t*)sm;
    bf16_t* Bs = (bf16_t*)(sm + 128 * 40 * 2);
    const int lane = tid & 63, w = tid >> 6, wr = w >> 1, wc = w & 1, r32 = lane & 31, hi = lane >> 5;
    const int m0 = by * 128, n0 = bx * 128;
    f32x16 acc[2][2];
#pragma unroll
    for (int i = 0; i < 2; ++i)
#pragma unroll
        for (int j = 0; j < 2; ++j)
#pragma unroll
            for (int r = 0; r < 16; ++r) acc[i][j][r] = 0.f;
    for (int k0 = 0; k0 < K; k0 += 32) {
#pragma unroll
        for (int i = 0; i < 2; ++i) {
            const int c = tid + i * 256, row = c >> 2, col = (c & 3) * 8;
            const uint4 v = *(const uint4*)(A + (size_t)(m0 + row) * lda + k0 + col);
            *(uint4*)(As + row * 40 + col) = v;
        }
#pragma unroll
        for (int i = 0; i < 4; ++i) {
            const int idx = tid + i * 256, k = idx >> 5, n = (idx & 31) * 4;
            float4 v = make_float4(0.f, 0.f, 0.f, 0.f);
            if (n0 + n < N) v = *(const float4*)(B + (size_t)(k0 + k) * ldb + bmap(n0 + n));
            Bs[(n + 0) * 40 + k] = f2bf(v.x); Bs[(n + 1) * 40 + k] = f2bf(v.y); Bs[(n + 2) * 40 + k] = f2bf(v.z); Bs[(n + 3) * 40 + k] = f2bf(v.w);
        }
        __syncthreads();
#pragma unroll
        for (int kk = 0; kk < 32; kk += 16) {
            bf16x8 a[2], b[2];
#pragma unroll
            for (int i = 0; i < 2; ++i) a[i] = *(const bf16x8*)(As + (wr * 64 + i * 32 + r32) * 40 + kk + hi * 8);
#pragma unroll
            for (int j = 0; j < 2; ++j) b[j] = *(const bf16x8*)(Bs + (wc * 64 + j * 32 + r32) * 40 + kk + hi * 8);
#pragma unroll
            for (int i = 0; i < 2; ++i)
#pragma unroll
                for (int j = 0; j < 2; ++j) acc[i][j] = __builtin_amdgcn_mfma_f32_32x32x16_bf16(a[i], b[j], acc[i][j], 0, 0, 0);
        }
        __syncthreads();
    }
#pragma unroll
    for (int i = 0; i < 2; ++i)
#pragma unroll
        for (int j = 0; j < 2; ++j)
#pragma unroll
            for (int r = 0; r < 16; ++r) {
                const int row = m0 + wr * 64 + i * 32 + (r & 3) + 8 * (r >> 2) + 4 * hi;
                const int col = n0 + wc * 64 + j * 32 + r32;
                if constexpr (Epi::PAIR) { if (j == 0) epi.pair(row, col, acc[i][0][r], acc[i][1][r]); }
                else { if (col < N) epi(row, col, acc[i][j][r]); }
            }
}

struct EpiPa { static constexpr bool PAIR = false;
    const bf16_t* MG; float* tmp;
    DI void operator()(int row, int col, float v) const { tmp[(size_t)row * DM + col] = bf2f(MG[(size_t)row * 2048 + col]) * v; }
};
struct EpiPb { static constexpr bool PAIR = false;
    const bf16_t* MG; const float* tmp; bf16_t* mixed;
    DI void operator()(int row, int col, float v) const {
        mixed[(size_t)row * DM + col] = f2bf(tmp[(size_t)row * DM + col] + bf2f(MG[(size_t)row * 2048 + 1024 + col]) * v);
    }
};
struct EpiResid { static constexpr bool PAIR = false;
    const float* base; float* out;
    DI void operator()(int row, int col, float v) const { out[(size_t)row * DM + col] = base[(size_t)row * DM + col] + v; }
};
struct EpiBf { static constexpr bool PAIR = false;
    bf16_t* o; int ld;
    DI void operator()(int row, int col, float v) const { o[(size_t)row * ld + col] = f2bf(v); }
};
struct EpiF32 { static constexpr bool PAIR = false;
    float* o; int ld;
    DI void operator()(int row, int col, float v) const { o[(size_t)row * ld + col] = v; }
};
struct EpiPle { static constexpr bool PAIR = false;
    float* x; const float* pp;
    DI void operator()(int row, int col, float v) const { const size_t i = (size_t)row * DM + col; x[i] = x[i] + sigmoidf_(v) * pp[i]; }
};

DI void rmsnorm_rows(int bx, int tid, const float* x, const float* __restrict__ g, bf16_t* outb, float* outf, int rows) {
    const int row = bx * 4 + (tid >> 6), lane = tid & 63;
    if (row >= rows) return;
    const float4* xr = (const float4*)(x + (size_t)row * DM);
    float4 v[4]; float s = 0.f;
#pragma unroll
    for (int j = 0; j < 4; ++j) { v[j] = xr[lane + 64 * j]; s += v[j].x * v[j].x + v[j].y * v[j].y + v[j].z * v[j].z + v[j].w * v[j].w; }
    const float rstd = rsqrtf(wave_sum(s) * (1.f / DM) + 1e-6f);
#pragma unroll
    for (int j = 0; j < 4; ++j) {
        const float4 gg = ((const float4*)g)[lane + 64 * j];
        const float a = v[j].x * rstd * gg.x, b = v[j].y * rstd * gg.y, c = v[j].z * rstd * gg.z, d = v[j].w * rstd * gg.w;
        if (outf) ((float4*)(outf + (size_t)row * DM))[lane + 64 * j] = make_float4(a, b, c, d);
        else { ushort4 o; o.x = f2bf(a); o.y = f2bf(b); o.z = f2bf(c); o.w = f2bf(d); ((ushort4*)(outb + (size_t)row * DM))[lane + 64 * j] = o; }
    }
}

DI void cvt_bf16(int bx, int nb, int tid, const float* __restrict__ in, bf16_t* __restrict__ out, size_t n) {
    for (size_t i = bx * (size_t)256 + tid; i < n; i += (size_t)nb * 256) out[i] = f2bf(in[i]);
}

DI float gelu_tanh(float x) { const float u = 0.7978845608028654f * (x + 0.044715f * x * x * x); return 0.5f * x * (1.f + tanhf(u)); }

DI void compress_naive(int bx, int by, int bz, int tid, char* sm, const bf16_t* __restrict__ KVb, const float* __restrict__ w1k, const float* __restrict__ w2k, const float* __restrict__ pek,
                                                      const float* __restrict__ w1v, const float* __restrict__ w2v, const float* __restrict__ pev, float* __restrict__ outk, float* __restrict__ outv, bf16_t* __restrict__ kcb, bf16_t* __restrict__ vcT) {
    float* flat = (float*)sm;
    float* h1 = flat + 2048;
    __syncthreads();
    const int j = bx, bg = by, kv = bz, b = bg >> 1, g = bg & 1;
    const float* w1 = kv ? w1v : w1k; const float* w2 = kv ? w2v : w2k; const float* pe = kv ? pev : pek; float* out = kv ? outv : outk;
    const int colbase = (kv ? 128 : 0) + g * 64;
    for (int e = tid; e < 2048; e += 256) {
        const int i = e >> 6, d = e & 63;
        flat[e] = bf2f(KVb[(size_t)(b * SEQ + 16 * j + i) * 512 + colbase + d]) + pe[e];
    }
    __syncthreads();
    float s = 0.f;
    for (int k = 0; k < 2048; ++k) s += flat[k] * w1[(size_t)k * 256 + tid];
    h1[tid] = gelu_tanh(s);
    __syncthreads();
    if (tid < 64) {
        float o = 0.f;
        for (int n = 0; n < 256; ++n) o += h1[n] * w2[n * 64 + tid];
        out[((size_t)bg * 256 + j) * 64 + tid] = o;
        if (kv == 0) { kcb[((size_t)bg * 256 + j) * 64 + tid] = f2bf(o); if (j == 254) kcb[((size_t)bg * 256 + 255) * 64 + tid] = 0; }
        else { vcT[((size_t)bg * 4 + (j >> 6)) * 4096 + tid * 64 + (j & 63)] = f2bf(o); if (j == 254) vcT[((size_t)bg * 4 + 3) * 4096 + tid * 64 + 63] = 0; }
    }
}

DI void softmax_row(float* row, int n, int lane) {
    float m = -3.0e38f;
    for (int j = lane; j < n; j += 64) m = fmaxf(m, row[j]);
    m = wave_max(m);
    float s = 0.f;
    for (int j = lane; j < n; j += 64) { const float e = exp2f(row[j] - m); row[j] = e; s += e; }
    s = wave_sum(s);
    const float inv = 1.f / s;
    for (int j = lane; j < n; j += 64) row[j] *= inv;
}

DI void nsa_naive(int bx, int by, int tid, char* sm, const bf16_t* __restrict__ Qb, const bf16_t* __restrict__ KVb, const bf16_t* __restrict__ VT, const float* __restrict__ kcc, const float* __restrict__ vcc, const float* __restrict__ gates, bf16_t* __restrict__ Y) {
    float (*q)[64] = (float (*)[64])sm;
    float (*sc)[1024] = (float (*)[1024])(sm + 1024);
    float* impv = (float*)(sm + 1024 + 16384);
    int* sellist = (int*)(sm + 1024 + 16384 + 256);
    int* selflag = (int*)(sm + 1024 + 16384 + 256 + 64);
    int& nsel_s = *(int*)(sm + 1024 + 16384 + 256 + 64 + 256);
    __syncthreads();
    const int tok = bx, g = by, b = tok >> 12, t = tok & 4095, hh = tid >> 6, lane = tid & 63, d = lane;
    q[hh][d] = bf2f(Qb[(size_t)tok * 512 + (g * 4 + hh) * 64 + d]);
    __syncthreads();
    const int nv = (t >= 31) ? ((t - 15) >> 4) : 0;
    const float* kcb = kcc + (size_t)(b * 2 + g) * 256 * 64; const float* vcb = vcc + (size_t)(b * 2 + g) * 256 * 64;
    if (tid < nv) {
        float s0 = 0.f, s1 = 0.f, s2 = 0.f, s3 = 0.f;
#pragma unroll 8
        for (int dd = 0; dd < 64; ++dd) { const float kx = kcb[tid * 64 + dd]; s0 += q[0][dd] * kx; s1 += q[1][dd] * kx; s2 += q[2][dd] * kx; s3 += q[3][dd] * kx; }
        sc[0][tid] = s0; sc[1][tid] = s1; sc[2][tid] = s2; sc[3][tid] = s3;
    }
    __syncthreads();
    if (nv > 0) softmax_row(sc[hh], nv, lane);
    for (int j = nv + lane; j < 256; j += 64) sc[hh][j] = 0.f;
    __syncthreads();
    float o_cmp = 0.f;
    for (int j = 0; j < nv; ++j) o_cmp += sc[hh][j] * vcb[j * 64 + d];
    const int cur = t >> 6;
    if (tid < 64) {
        const int s = tid; int lo = 4 * s - 1; if (lo < 0) lo = 0; int hi2 = 4 * s + 3; if (hi2 > 254) hi2 = 254;
        float v = 0.f;
        for (int h2 = 0; h2 < 4; ++h2) for (int j = lo; j <= hi2; ++j) v += sc[h2][j];
        if (s == 0 || s == cur || s == cur - 1) v += 1000.0f;
        if (s > cur) v = -1e30f;
        impv[s] = v;
    }
    __syncthreads();
    if (tid < 64) {
        const float v = impv[tid]; int rank = 0;
        for (int s2 = 0; s2 < 64; ++s2) { const float u = impv[s2]; rank += (u > v || (u == v && s2 < tid)) ? 1 : 0; }
        selflag[tid] = (rank < 16 && tid <= cur) ? 1 : 0;
    }
    __syncthreads();
    if (tid == 0) { int n = 0; for (int s = 0; s < 64; ++s) if (selflag[s]) { if (n < 16) sellist[n] = s; ++n; } nsel_s = n < 16 ? n : 16; }
    __syncthreads();
    const int ns = nsel_s, ne = ns * 64;
    for (int e = tid; e < ne; e += 256) {
        const int kpos = sellist[e >> 6] * 64 + (e & 63);
        if (kpos <= t) {
            const bf16_t* kp = KVb + (size_t)(b * SEQ + kpos) * 512 + 256 + g * 64;
            float s0 = 0.f, s1 = 0.f, s2 = 0.f, s3 = 0.f;
    #pragma unroll 8
        for (int dd = 0; dd < 64; ++dd) { const float kx = bf2f(kp[dd]); s0 += q[0][dd] * kx; s1 += q[1][dd] * kx; s2 += q[2][dd] * kx; s3 += q[3][dd] * kx; }
            sc[0][e] = s0; sc[1][e] = s1; sc[2][e] = s2; sc[3][e] = s3;
        } else { sc[0][e] = -1e30f; sc[1][e] = -1e30f; sc[2][e] = -1e30f; sc[3][e] = -1e30f; }
    }
    __syncthreads();
    softmax_row(sc[hh], ne, lane);
    __syncthreads();
    float o_sel = 0.f;
    for (int e = 0; e < ne; ++e) {
        const int kpos = sellist[e >> 6] * 64 + (e & 63);
        o_sel += sc[hh][e] * bf2f(VT[((size_t)(b * 2 + g) * 64 + (kpos >> 6)) * 4096 + d * 64 + (kpos & 63)]);
    }
    __syncthreads();
    const int nw = (t + 1 < 512) ? (t + 1) : 512, w0 = t - nw + 1;
    for (int e = tid; e < nw; e += 256) {
        const bf16_t* kp = KVb + (size_t)(b * SEQ + w0 + e) * 512 + 384 + g * 64;
        float s0 = 0.f, s1 = 0.f, s2 = 0.f, s3 = 0.f;
#pragma unroll 8
        for (int dd = 0; dd < 64; ++dd) { const float kx = bf2f(kp[dd]); s0 += q[0][dd] * kx; s1 += q[1][dd] * kx; s2 += q[2][dd] * kx; s3 += q[3][dd] * kx; }
        sc[0][e] = s0; sc[1][e] = s1; sc[2][e] = s2; sc[3][e] = s3;
    }
    __syncthreads();
    softmax_row(sc[hh], nw, lane);
    __syncthreads();
    float o_win = 0.f;
    for (int e = 0; e < nw; ++e) { const int kpos = w0 + e; o_win += sc[hh][e] * bf2f(VT[((size_t)(8 + b * 2 + g) * 64 + (kpos >> 6)) * 4096 + d * 64 + (kpos & 63)]); }
    const float* gt = gates + (size_t)tok * 24 + (g * 4 + hh) * 3;
    Y[(size_t)tok * DM + (g * 4 + hh) * 64 + d] = f2bf(gt[0] * o_cmp + gt[1] * o_sel + gt[2] * o_win);
}

DI void conv_silu(int bx, int tid, const bf16_t* __restrict__ MQK, const float* __restrict__ wc, const float* __restrict__ bc, bf16_t* __restrict__ out) {
    const int idx = bx * 256 + tid;
    if (idx >= T_TOK * 1024) return;
    const int c = idx & 1023, tok = idx >> 10, t = tok & 4095;
    float y = bc[c];
#pragma unroll
    for (int j = 0; j < 4; ++j) { const int tt = t - 3 + j; if (tt >= 0) y += wc[j * 1024 + c] * bf2f(MQK[(size_t)(tok - 3 + j) * 1024 + c]); }
    y = y * sigmoidf_(y);
    if (c >= 512) y *= 0.08838834764831845f;
    out[idx] = f2bf(y);
}

DI void mlstm_naive(int bx, int tid, char* sm, const bf16_t* __restrict__ qkc, const bf16_t* __restrict__ MV, const bf16_t* __restrict__ MO, const float* __restrict__ ifp, float* __restrict__ hm) {
    float (*qs)[128] = (float (*)[128])sm;
    float (*ks)[128] = (float (*)[128])(sm + 16384);
    float (*vs)[16] = (float (*)[16])(sm + 32768);
    float (*os)[16] = (float (*)[16])(sm + 32768 + 2048);
    float* gi = (float*)(sm + 32768 + 4096); float* gf = gi + 32;
    const int bh = bx >> 3, vsl = bx & 7, b = bh >> 2, h = bh & 3, v = tid >> 4, kg = tid & 15;
    float C[8], n[8];
#pragma unroll
    for (int j = 0; j < 8; ++j) { C[j] = 0.f; n[j] = 0.f; }
    for (int c0 = 0; c0 < SEQ; c0 += 32) {
        __syncthreads();
        for (int e = tid; e < 32 * 128; e += 256) {
            const int s = e >> 7, k = e & 127; const size_t tok = (size_t)b * SEQ + c0 + s;
            qs[s][k] = bf2f(qkc[tok * 1024 + h * 128 + k]); ks[s][k] = bf2f(qkc[tok * 1024 + 512 + h * 128 + k]);
        }
        for (int e = tid; e < 32 * 16; e += 256) {
            const int s = e >> 4, vv = e & 15; const size_t tok = (size_t)b * SEQ + c0 + s;
            vs[s][vv] = bf2f(MV[tok * 512 + h * 128 + vsl * 16 + vv]);
            os[s][vv] = sigmoidf_(bf2f(MO[tok * 512 + h * 128 + vsl * 16 + vv]));
        }
        if (tid < 32) { const size_t tok = (size_t)b * SEQ + c0 + tid; gi[tid] = __expf(ifp[tok * 8 + h]); gf[tid] = sigmoidf_(ifp[tok * 8 + 4 + h]); }
        __syncthreads();
        for (int s = 0; s < 32; ++s) {
            const float f = gf[s], iv = gi[s] * vs[s][v], ig = gi[s];
            float num = 0.f, den = 0.f;
#pragma unroll
            for (int j = 0; j < 8; ++j) {
                const float kx = ks[s][kg * 8 + j], qx = qs[s][kg * 8 + j];
                C[j] = f * C[j] + iv * kx; n[j] = f * n[j] + ig * kx;
                num += C[j] * qx; den += n[j] * qx;
            }
            const int l_ = lane_id_opaque();
#pragma unroll
            for (int o = 1; o < 16; o <<= 1) { num += lane_xor(num, o, l_); den += lane_xor(den, o, l_); }
            if (kg == 0) hm[((size_t)b * SEQ + c0 + s) * 512 + h * 128 + vsl * 16 + v] = num / fmaxf(fabsf(den), 1.0f) * os[s][v];
        }
    }
}

DI void hnorm(int bx, int tid, const float* __restrict__ hm, const float* __restrict__ g_hn, bf16_t* __restrict__ Y) {
    const int item = bx * 4 + (tid >> 6), lane = tid & 63;
    const int tok = item >> 2, h = item & 3;
    const float a = hm[(size_t)tok * 512 + h * 128 + lane], b = hm[(size_t)tok * 512 + h * 128 + 64 + lane];
    const float rstd = rsqrtf(wave_sum(a * a + b * b) * (1.f / 128.f) + 1e-6f);
    Y[(size_t)tok * DM + 512 + h * 128 + lane] = f2bf(a * rstd * g_hn[h * 128 + lane]);
    Y[(size_t)tok * DM + 512 + h * 128 + 64 + lane] = f2bf(b * rstd * g_hn[h * 128 + 64 + lane]);
}

DI void router(int bx, int tid, const float* __restrict__ x, const float* __restrict__ g, const float* __restrict__ w_rg, const float* __restrict__ b_rg,
                                              const float* __restrict__ w_re, const float* __restrict__ b_re, bf16_t* __restrict__ xn, float* __restrict__ gate) {
    const int tok = bx * 4 + (tid >> 6), lane = tid & 63;
    float xv[16]; float s = 0.f;
#pragma unroll
    for (int j = 0; j < 4; ++j) { const float4 v = ((const float4*)(x + (size_t)tok * DM))[lane + 64 * j]; xv[4 * j] = v.x; xv[4 * j + 1] = v.y; xv[4 * j + 2] = v.z; xv[4 * j + 3] = v.w; s += v.x * v.x + v.y * v.y + v.z * v.z + v.w * v.w; }
    const float rstd = rsqrtf(wave_sum(s) * (1.f / DM) + 1e-6f);
#pragma unroll
    for (int j = 0; j < 4; ++j) { const float4 gg = ((const float4*)g)[lane + 64 * j]; xv[4 * j] *= rstd * gg.x; xv[4 * j + 1] *= rstd * gg.y; xv[4 * j + 2] *= rstd * gg.z; xv[4 * j + 3] *= rstd * gg.w;
        ushort4 o; o.x = f2bf(xv[4 * j]); o.y = f2bf(xv[4 * j + 1]); o.z = f2bf(xv[4 * j + 2]); o.w = f2bf(xv[4 * j + 3]); ((ushort4*)(xn + (size_t)tok * DM))[lane + 64 * j] = o; }
    float mylog = 0.f;
#pragma unroll 1
    for (int c = 0; c < 20; ++c) {
        const float* w = c < 4 ? w_rg + c : w_re + (c - 4); const int ld = c < 4 ? 4 : 16;
        float a = 0.f;
#pragma unroll
        for (int j = 0; j < 4; ++j)
#pragma unroll
            for (int i = 0; i < 4; ++i) a += xv[4 * j + i] * w[(size_t)(4 * (lane + 64 * j) + i) * ld];
        a = wave_sum(a) + (c < 4 ? b_rg[c] : b_re[c - 4]);
        if (lane == c) mylog = a;
    }
    float gl[4], el[16];
#pragma unroll
    for (int c = 0; c < 4; ++c) gl[c] = lane_get(mylog, c);
#pragma unroll
    for (int c = 0; c < 16; ++c) el[c] = lane_get(mylog, 4 + c);
    if (lane == 0) {
        int gs = 0; float gm = gl[0];
#pragma unroll
        for (int c = 1; c < 4; ++c) if (gl[c] > gm) { gm = gl[c]; gs = c; }
        float se = 0.f;
#pragma unroll
        for (int c = 0; c < 4; ++c) se += __expf(gl[c] - gm);
        const float pg = 1.f / se;
        float e4[4];
#pragma unroll
        for (int c = 0; c < 4; ++c) e4[c] = gs == 0 ? el[c] : gs == 1 ? el[4 + c] : gs == 2 ? el[8 + c] : el[12 + c];
        int i0 = 0; float v0 = e4[0];
#pragma unroll
        for (int c = 1; c < 4; ++c) if (e4[c] > v0) { v0 = e4[c]; i0 = c; }
        int i1 = -1; float v1 = -3.0e38f;
#pragma unroll
        for (int c = 0; c < 4; ++c) if (c != i0 && e4[c] > v1) { v1 = e4[c]; i1 = c; }
        const float ex = __expf(v1 - v0);
        const float w0 = pg / (1.f + ex), w1 = pg * ex / (1.f + ex);
#pragma unroll
        for (int c = 0; c < 16; ++c) gate[(size_t)tok * 16 + c] = (c == gs * 4 + i0) ? w0 : (c == gs * 4 + i1) ? w1 : 0.f;
    }
}


struct EpiMoe { static constexpr bool PAIR = true;
    const float* gate; bf16_t* act;
    DI void operator()(int, int, float) const {}
    DI void pair(int row, int col, float gg, float u) const {
        const int t = col >> 7, c = col & 127, e = t >> 2, jt = t & 3, f = jt * 64 + (c >> 6) * 32 + (c & 31);
        act[(size_t)row * 4096 + e * 256 + f] = f2bf(gg * sigmoidf_(gg) * u * gate[(size_t)row * 16 + e]);
    }
};

typedef float f32x2_t __attribute__((ext_vector_type(2))); typedef __bf16 bf16x2_t __attribute__((ext_vector_type(2)));
DI unsigned cvtpk(float lo, float hi) { f32x2_t v = {lo, hi}; bf16x2_t b = __builtin_convertvector(v, bf16x2_t); return __builtin_bit_cast(unsigned, b); }
typedef __attribute__((address_space(3))) char lds_c;
typedef unsigned u32x2v __attribute__((ext_vector_type(2))); typedef unsigned u32x4v __attribute__((ext_vector_type(4)));
constexpr int NSA_KC = 0, NSA_VC = 4 * 9216, NSA_KB = NSA_VC + 4 * 8704, NSA_VB = NSA_KB + 2 * 9216, NSA_IMP = NSA_VB + 2 * 8704, NSA_MASK = NSA_IMP + 64 * 65 * 4, NSA_END = NSA_MASK + 512;
static_assert(NSA_END <= 147456, "NSA LDS map");
DI int crow(int r, int hi) { return (r & 3) + 8 * (r >> 2) + 4 * hi; }
#define MFMA32(a, b, c) __builtin_amdgcn_mfma_f32_32x32x16_bf16((a), (b), (c), 0, 0, 0)

DI void nsa_qk(f32x16& p0, f32x16& p1, const lds_c* K, const bf16x8 (&qf)[4], float cin, int r32, int hi) {
    f32x16 c;
#pragma unroll
    for (int r = 0; r < 16; ++r) c[r] = cin;
#pragma unroll
    for (int ks = 0; ks < 4; ++ks) {
        const bf16x8 a0 = *(const __attribute__((address_space(3))) bf16x8*)(K + r32 * 144 + ks * 32 + hi * 16);
        const bf16x8 a1 = *(const __attribute__((address_space(3))) bf16x8*)(K + (32 + r32) * 144 + ks * 32 + hi * 16);
        if (ks == 0) { p0 = MFMA32(a0, qf[0], c); p1 = MFMA32(a1, qf[0], c); } else { p0 = MFMA32(a0, qf[ks], p0); p1 = MFMA32(a1, qf[ks], p1); }
    }
}
DI void nsa_softmax(f32x16& p0, f32x16& p1, float& mref, float& l, bool& started, f32x16& o0, f32x16& o1) {
    float mx = fmaxf(p0[0], p1[0]);
#pragma unroll
    for (int r = 1; r < 16; ++r) mx = fmaxf(mx, fmaxf(p0[r], p1[r]));
    { auto rr = __builtin_amdgcn_permlane32_swap(__float_as_uint(mx), __float_as_uint(mx), false, false); mx = fmaxf(__uint_as_float(rr[0]), __uint_as_float(rr[1])); }
    const bool need = started ? (mx > 8.f) : (mx > -3.0e38f);
    if (__any(need)) {
        const float delta = need ? mx : 0.f, f = started ? __builtin_amdgcn_exp2f(-delta) : 1.f;
        mref += delta;
#pragma unroll
        for (int r = 0; r < 16; ++r) { p0[r] -= delta; p1[r] -= delta; o0[r] *= f; o1[r] *= f; }
        l *= f; started = started || need;
    }
    float s = 0.f;
#pragma unroll
    for (int r = 0; r < 16; ++r) { p0[r] = __builtin_amdgcn_exp2f(p0[r]); p1[r] = __builtin_amdgcn_exp2f(p1[r]); s += p0[r] + p1[r]; }
    l += s;
}
DI void nsa_pv(f32x16& o0, f32x16& o1, const f32x16& p0, const f32x16& p1, const lds_c* V, int r32, int hi) {
#pragma unroll
    for (int hf = 0; hf < 2; ++hf)
#pragma unroll
        for (int s = 0; s < 2; ++s) {
            unsigned pw[4];
#pragma unroll
            for (int j = 0; j < 4; ++j) pw[j] = hf ? cvtpk(p1[8 * s + 2 * j], p1[8 * s + 2 * j + 1]) : cvtpk(p0[8 * s + 2 * j], p0[8 * s + 2 * j + 1]);
            const u32x4v pbw = {pw[0], pw[1], pw[2], pw[3]};
            const bf16x8 pb = __builtin_bit_cast(bf16x8, pbw);
            const lds_c* vp = V + r32 * 136 + hf * 64 + s * 32 + hi * 8;
            const u32x2v a0l = *(const __attribute__((address_space(3))) u32x2v*)(vp), a0h = *(const __attribute__((address_space(3))) u32x2v*)(vp + 16);
            const u32x2v a1l = *(const __attribute__((address_space(3))) u32x2v*)(vp + 32 * 136), a1h = *(const __attribute__((address_space(3))) u32x2v*)(vp + 32 * 136 + 16);
            const u32x4v A0w = {a0l.x, a0l.y, a0h.x, a0h.y}, A1w = {a1l.x, a1l.y, a1h.x, a1h.y};
            o0 = MFMA32(__builtin_bit_cast(bf16x8, A0w), pb, o0); o1 = MFMA32(__builtin_bit_cast(bf16x8, A1w), pb, o1);
        }
}
DI void nsa_store_k(lds_c* K, const u32x4v v, int tid) { *(__attribute__((address_space(3))) u32x4v*)(K + (tid >> 3) * 144 + (tid & 7) * 16) = v; }
DI void nsa_store_v(lds_c* V, const u32x4v v, int tid) { lds_c* p = V + (tid >> 3) * 136 + (tid & 7) * 16; *(__attribute__((address_space(3))) u32x2v*)p = (u32x2v){v.x, v.y}; *(__attribute__((address_space(3))) u32x2v*)(p + 8) = (u32x2v){v.z, v.w}; }
#define NEG_INF (-__builtin_inff())
DI void nsa_finish(f32x16& y0, f32x16& y1, f32x16& o0, f32x16& o1, float& m, float& l, bool& started, float gate) {
    float lt; { auto rr = __builtin_amdgcn_permlane32_swap(__float_as_uint(l), __float_as_uint(l), false, false); lt = __uint_as_float(rr[0]) + __uint_as_float(rr[1]); }
    const float f = lt > 0.f ? gate / lt : 0.f;
#pragma unroll
    for (int r = 0; r < 16; ++r) { y0[r] += f * o0[r]; y1[r] += f * o1[r]; o0[r] = 0.f; o1[r] = 0.f; }
    m = 0.f; l = 0.f; started = false;
}

DI void nsa_unit(int bg, int qb, int tx, lds_c* lds, const bf16_t* __restrict__ Qb, const bf16_t* __restrict__ KVb, const bf16_t* __restrict__ VT, const bf16_t* __restrict__ kcb, const bf16_t* __restrict__ vcT,
                 const float* __restrict__ gates, bf16_t* __restrict__ Y, unsigned long long& pacc) {
    const int lane = tx & 63, r32 = lane & 31, hi = lane >> 5, wave = __builtin_amdgcn_readfirstlane(tx >> 6), hh = wave >> 1, qs = wave & 1;
#define RG_BEGIN(id) unsigned long long rt0_##id = 0ull; if (SPIN_PHASE == (id) && blockIdx.x == 0) rt0_##id = __builtin_amdgcn_s_memrealtime();
#define RG_END(id) if (SPIN_PHASE == (id) && blockIdx.x == 0) pacc += __builtin_amdgcn_s_memrealtime() - rt0_##id;
    RG_BEGIN(100)
    const int b = bg >> 1, g = bg & 1, ql = 32 * qs + r32, tq = 64 * qb + ql;
    const size_t tok = (size_t)b * SEQ + tq; const int head = g * 4 + hh;
    const int nc = (4 * qb + 66) >> 6;
    const bool need_topk = qb >= 16;
    lds_c* KC = lds + NSA_KC; lds_c* VC = lds + NSA_VC; lds_c* KB = lds + NSA_KB; lds_c* VB = lds + NSA_VB;
    __attribute__((address_space(3))) float* imp = (__attribute__((address_space(3))) float*)(lds + NSA_IMP);
    __attribute__((address_space(3))) unsigned* msk = (__attribute__((address_space(3))) unsigned*)(lds + NSA_MASK);
    const bf16_t* kcsrc = kcb + (size_t)bg * 256 * 64; const bf16_t* vcsrc = vcT + (size_t)bg * 4 * 4096;
    const bf16_t* kssrc = KVb + (size_t)b * SEQ * 512 + 256 + g * 64; const bf16_t* kwsrc = KVb + (size_t)b * SEQ * 512 + 384 + g * 64;
    const bf16_t* vssrc = VT + (size_t)bg * 64 * 4096; const bf16_t* vwsrc = VT + (size_t)(8 + bg) * 64 * 4096;
    const int n_sel = qb + 1, n_win = qb + 1 < 9 ? qb + 1 : 9, ntile = n_sel + n_win;
    __syncthreads();
    for (int c = 0; c < nc; ++c) {
        nsa_store_k(KC + c * 9216, *(const u32x4v*)(kcsrc + (size_t)(c * 64 + (tx >> 3)) * 64 + (tx & 7) * 8), tx);
        nsa_store_v(VC + c * 8704, *(const u32x4v*)(vcsrc + (size_t)c * 4096 + (tx >> 3) * 64 + (tx & 7) * 8), tx);
    }
    nsa_store_k(KB, *(const u32x4v*)(kssrc + (size_t)(tx >> 3) * 512 + (tx & 7) * 8), tx);
    nsa_store_v(VB, *(const u32x4v*)(vssrc + (tx >> 3) * 64 + (tx & 7) * 8), tx);
    for (int i = tx; i < 64 * 65; i += 512) imp[i] = 0.f;
    bf16x8 qf[4];
#pragma unroll
    for (int ks = 0; ks < 4; ++ks) qf[ks] = *(const bf16x8*)(Qb + tok * 512 + head * 64 + ks * 16 + hi * 8);
    const float g_cmp = gates[tok * 24 + head * 3 + 0], g_sel = gates[tok * 24 + head * 3 + 1], g_win = gates[tok * 24 + head * 3 + 2];
    f32x16 y0, y1, o0, o1, p0, p1;
#pragma unroll
    for (int r = 0; r < 16; ++r) { y0[r] = 0.f; y1[r] = 0.f; o0[r] = 0.f; o1[r] = 0.f; }
    float m = 0.f, l = 0.f; bool started = false;
    __syncthreads();
    RG_END(100)
    RG_BEGIN(101)
    const int nvq = tq >= 31 ? ((tq - 15) >> 4) : 0;
    for (int c = 0; c < nc; ++c) {
        nsa_qk(p0, p1, KC + c * 9216, qf, -m, r32, hi);
        const int lim = nvq - 64 * c;
#pragma unroll
        for (int r = 0; r < 16; ++r) { const int kl = crow(r, hi); if (kl >= lim) p0[r] = NEG_INF; if (kl + 32 >= lim) p1[r] = NEG_INF; }
        nsa_softmax(p0, p1, m, l, started, o0, o1);
        nsa_pv(o0, o1, p0, p1, VC + c * 8704, r32, hi);
    }
    const float m_c = m; float l_c; { auto rr = __builtin_amdgcn_permlane32_swap(__float_as_uint(l), __float_as_uint(l), false, false); l_c = __uint_as_float(rr[0]) + __uint_as_float(rr[1]); }
    nsa_finish(y0, y1, o0, o1, m, l, started, g_cmp);
    RG_END(101)
    unsigned mlo = 0xffffffffu, mhi = 0xffffffffu;
    RG_BEGIN(102)
    if (need_topk) {
        const float invl = l_c > 0.f ? 16777216.f / l_c : 0.f;
        __attribute__((address_space(3))) unsigned* impu = (__attribute__((address_space(3))) unsigned*)imp;
        for (int c = 0; c < nc; ++c) {
            nsa_qk(p0, p1, KC + c * 9216, qf, -m_c, r32, hi);
            const int lim = nvq - 64 * c;
#pragma unroll
            for (int r = 0; r < 16; ++r) { const int kl = crow(r, hi);
                p0[r] = kl < lim ? __builtin_amdgcn_exp2f(p0[r]) * invl : 0.f; p1[r] = kl + 32 < lim ? __builtin_amdgcn_exp2f(p1[r]) * invl : 0.f; }
#pragma unroll
            for (int hf = 0; hf < 2; ++hf)
#pragma unroll
                for (int i = 0; i < 4; ++i) {
                    const int a = 16 * c + 8 * hf + 2 * i + hi;
                    const unsigned u0 = (unsigned)__float2uint_rn(hf ? p1[4 * i] : p0[4 * i]), u1 = (unsigned)__float2uint_rn(hf ? p1[4 * i + 1] : p0[4 * i + 1]);
                    const unsigned u2 = (unsigned)__float2uint_rn(hf ? p1[4 * i + 2] : p0[4 * i + 2]), u3 = (unsigned)__float2uint_rn(hf ? p1[4 * i + 3] : p0[4 * i + 3]);
                    __hip_atomic_fetch_add(impu + ql * 65 + a, u0 + u1 + u2 + u3, __ATOMIC_RELAXED, __HIP_MEMORY_SCOPE_WORKGROUP);
                    if (a + 1 < 64) __hip_atomic_fetch_add(impu + ql * 65 + a + 1, u3, __ATOMIC_RELAXED, __HIP_MEMORY_SCOPE_WORKGROUP);
                }
        }
        __syncthreads();
        RG_BEGIN(103)
        {
            const int q = tx >> 3, j8 = tx & 7, smax = qb - 2;
            unsigned key[8];
#pragma unroll
            for (int k = 0; k < 8; ++k) { const int sb = j8 + 8 * k; key[k] = (sb >= 1 && sb <= smax) ? ((impu[q * 65 + sb] & ~63u) | (unsigned)(63 - sb)) + 64u : 0u; }
            unsigned blo = 0u, bhi = 0u;
#pragma unroll 1
            for (int round = 0; round < 13; ++round) {
                unsigned mx = key[0];
#pragma unroll
                for (int k = 1; k < 8; ++k) mx = mx > key[k] ? mx : key[k];
                { const unsigned t = (unsigned)__builtin_amdgcn_update_dpp(0, (int)mx, 0xB1, 0xf, 0xf, true); mx = mx > t ? mx : t; }
                { const unsigned t = (unsigned)__builtin_amdgcn_update_dpp(0, (int)mx, 0x4E, 0xf, 0xf, true); mx = mx > t ? mx : t; }
                { const unsigned t = (unsigned)__builtin_amdgcn_update_dpp(0, (int)mx, 0x141, 0xf, 0xf, true); mx = mx > t ? mx : t; }
#pragma unroll
                for (int k = 0; k < 8; ++k) if (key[k] == mx && mx != 0u) { key[k] = 0u; const int sb = j8 + 8 * k; if (sb < 32) blo |= 1u << sb; else bhi |= 1u << (sb - 32); }
            }
            const int l_ = lane_id_opaque();
#pragma unroll
            for (int o = 1; o < 8; o <<= 1) { blo |= (unsigned)__builtin_amdgcn_ds_bpermute((l_ ^ o) << 2, (int)blo); bhi |= (unsigned)__builtin_amdgcn_ds_bpermute((l_ ^ o) << 2, (int)bhi); }
            unsigned long long mm = ((unsigned long long)bhi << 32) | blo;
            mm |= 1ull | (1ull << qb) | (1ull << (qb - 1));
            if (j8 == 0) { msk[q * 2] = (unsigned)mm; msk[q * 2 + 1] = (unsigned)(mm >> 32); }
        }
        __syncthreads();
        RG_END(103)
        mlo = msk[ql * 2]; mhi = msk[ql * 2 + 1];
    }
    RG_END(102)
    RG_BEGIN(104)
#define NSA_SRC(i_, KP, VP) do { const bool nsel_ = (i_) < n_sel; const int s2_ = nsel_ ? (i_) : qb - n_win + 1 + ((i_) - n_sel); \
        KP = (nsel_ ? kssrc : kwsrc) + (size_t)(s2_ * 64 + (tx >> 3)) * 512 + (tx & 7) * 8; VP = (nsel_ ? vssrc : vwsrc) + (size_t)s2_ * 4096 + (tx >> 3) * 64 + (tx & 7) * 8; } while (0)
#define NSA_TILE(i_, cur_, KLD, VLD, KST, VST) do { \
        const bool is_sel = (i_) < n_sel; const int s = is_sel ? (i_) : qb - n_win + 1 + ((i_) - n_sel); \
        if ((i_) + 2 < ntile) { const bf16_t* kp_; const bf16_t* vp_; NSA_SRC((i_) + 2, kp_, vp_); KLD = *(const u32x4v*)kp_; VLD = *(const u32x4v*)vp_; } \
        const bool on = !is_sel || ((s < 32 ? (mlo >> s) : (mhi >> (s - 32))) & 1u) != 0u; \
        nsa_qk(p0, p1, KB + (cur_) * 9216, qf, on ? -m : NEG_INF, r32, hi); \
        const bool lowb = !is_sel && (qb >= 8) && (s == qb - 8), diag = (s == qb); \
        if (lowb || diag) { \
            _Pragma("unroll") for (int r = 0; r < 16; ++r) { const int kl = crow(r, hi); \
                if ((lowb && kl <= ql) || (diag && kl > ql)) p0[r] = NEG_INF; if ((lowb && kl + 32 <= ql) || (diag && kl + 32 > ql)) p1[r] = NEG_INF; } \
        } \
        nsa_softmax(p0, p1, m, l, started, o0, o1); \
        nsa_pv(o0, o1, p0, p1, VB + (cur_) * 8704, r32, hi); \
        if ((i_) == n_sel - 1) nsa_finish(y0, y1, o0, o1, m, l, started, g_sel); \
        if ((i_) == ntile - 1) nsa_finish(y0, y1, o0, o1, m, l, started, g_win); \
        if ((i_) + 1 < ntile) { nsa_store_k(KB + ((cur_) ^ 1) * 9216, KST, tx); nsa_store_v(VB + ((cur_) ^ 1) * 8704, VST, tx); } \
        __syncthreads(); } while (0)
    u32x4v kA = {0u, 0u, 0u, 0u}, vA = kA, kB2 = kA, vB2 = kA;
    if (ntile > 1) { const bf16_t* kp_; const bf16_t* vp_; NSA_SRC(1, kp_, vp_); kA = *(const u32x4v*)kp_; vA = *(const u32x4v*)vp_; }
    {
        int i = 0;
        for (; i + 1 < ntile; i += 2) {
            NSA_TILE(i, 0, kB2, vB2, kA, vA);
            NSA_TILE(i + 1, 1, kA, vA, kB2, vB2);
        }
        if (i < ntile) NSA_TILE(i, 0, kB2, vB2, kA, vA);
    }
#undef NSA_TILE
#undef NSA_SRC
    RG_END(104)
    bf16_t* yp = Y + tok * DM + head * 64;
#pragma unroll
    for (int i = 0; i < 4; ++i) {
        *(uint2*)(yp + 8 * i + 4 * hi) = make_uint2(cvtpk(y0[4 * i], y0[4 * i + 1]), cvtpk(y0[4 * i + 2], y0[4 * i + 3]));
        *(uint2*)(yp + 32 + 8 * i + 4 * hi) = make_uint2(cvtpk(y1[4 * i], y1[4 * i + 1]), cvtpk(y1[4 * i + 2], y1[4 * i + 3]));
    }
}

DI float log_sigmoid_(float x) { return x >= 0.f ? -__logf(1.f + __expf(-x)) : x - __logf(1.f + __expf(x)); }
DI float lane_shr_add(float v, int l) {
#pragma unroll
    for (int o = 1; o < 64; o <<= 1) { const float t = lane_get(v, l - o); if (l >= o) v += t; }
    return v;
}
DI float lane_shr_max(float v, int l) {
#pragma unroll
    for (int o = 1; o < 64; o <<= 1) { const float t = lane_get(v, l - o); if (l >= o) v = fmaxf(v, t); }
    return v;
}
DI float log_sigmoid_fast(float x) { return -__logf(1.f + __expf(-x)); }
DI void ml_mscan_all(const float* __restrict__ ifp, int bh, int lane, float* __restrict__ mtab, float* __restrict__ wprev, float* __restrict__ wsc) {
    const int b = bh >> 2, h = bh & 3;
    const float* gp = ifp + ((size_t)b * SEQ + 64 * lane) * 8 + h;
    float L = 0.f, mx = -3.0e38f;
#pragma unroll 16
    for (int s = 0; s < 64; ++s) { const float iv = gp[s * 8], fv = gp[s * 8 + 4]; L += log_sigmoid_fast(fv); mx = fmaxf(mx, iv - L); }
    const float G = L + mx;
    float m = 0.f, mine = 0.f, mnext = 0.f;
#pragma unroll
    for (int k = 0; k < 64; ++k) {
        const float Lk = __builtin_bit_cast(float, __builtin_amdgcn_readlane(__builtin_bit_cast(int, L), k)), Gk = __builtin_bit_cast(float, __builtin_amdgcn_readlane(__builtin_bit_cast(int, G), k));
        if (k == lane) mine = m;
        m = fmaxf(Lk + m, Gk);
        if (k == lane) mnext = m;
    }
    mtab[bh * 65 + lane] = mine;
    wprev[bh * 64 + lane] = __expf(L + mine - mnext);
    wsc[bh * 64 + lane] = __expf(G - mnext);
}
DI void ml_conv8(float (&o)[8], const bf16_t* __restrict__ MQK, size_t tok, int t_in_seq, int col, const float* __restrict__ wc, const float* __restrict__ bc, float scale) {
    const float4 b0 = *(const float4*)(bc + col), b1 = *(const float4*)(bc + col + 4);
    o[0] = b0.x; o[1] = b0.y; o[2] = b0.z; o[3] = b0.w; o[4] = b1.x; o[5] = b1.y; o[6] = b1.z; o[7] = b1.w;
#pragma unroll
    for (int j = 0; j < 4; ++j) {
        if (t_in_seq - 3 + j >= 0) {
            float u[8]; unpack8(*(const pg8::u32x4*)(MQK + (tok - 3 + j) * 1024 + col), u);
            const float4 w0 = *(const float4*)(wc + j * 1024 + col), w1 = *(const float4*)(wc + j * 1024 + col + 4);
            o[0] += w0.x * u[0]; o[1] += w0.y * u[1]; o[2] += w0.z * u[2]; o[3] += w0.w * u[3]; o[4] += w1.x * u[4]; o[5] += w1.y * u[5]; o[6] += w1.z * u[6]; o[7] += w1.w * u[7];
        }
    }
#pragma unroll
    for (int i = 0; i < 8; ++i) o[i] = o[i] * sigmoidf_(o[i]) * scale;
}
constexpr float ML_KSCALE = 0.08838834764831845f;
DI void ml_unit_c(int bh, int c, int tx, lds_c* lds, const bf16_t* __restrict__ MQK, const bf16_t* __restrict__ MV, const float* __restrict__ ifp, const float* __restrict__ wc, const float* __restrict__ bc,
                  bf16_t* __restrict__ dC, float* __restrict__ dn, float* __restrict__ wprev, const float* __restrict__ mtab) {
    const int b = bh >> 2, h = bh & 3, lane = tx & 63, r32 = lane & 31, hi = lane >> 5, wave = __builtin_amdgcn_readfirstlane(tx >> 6);
    lds_c* KT = lds; lds_c* VTw = lds + 128 * 144;
    __attribute__((address_space(3))) float* wsm = (__attribute__((address_space(3))) float*)(lds + 2 * 128 * 144);
    const size_t tok0 = (size_t)b * SEQ + 64 * c;
    __syncthreads();
    if (wave == 0) {
        const float iv = ifp[(tok0 + lane) * 8 + h], lf = log_sigmoid_(ifp[(tok0 + lane) * 8 + 4 + h]);
        const int l_ = lane_id_opaque();
        const float bc_ = lane_shr_add(lf, l_), u = iv - bc_, umax = wave_max(u);
        wsm[lane] = __expf(u - umax);
        (void)wprev; (void)mtab;
    }
    __syncthreads();
#pragma unroll 1
    for (int it = tx; it < 1024; it += 512) {
        const int s = it >> 4, d0 = (it & 15) * 8; float kv[8];
        ml_conv8(kv, MQK, tok0 + s, 64 * c + s, 512 + h * 128 + d0, wc, bc, ML_KSCALE);
        float vv[8]; unpack8(*(const pg8::u32x4*)(MV + (tok0 + s) * 512 + h * 128 + d0), vv);
        const float w = wsm[s];
#pragma unroll
        for (int i = 0; i < 8; ++i) {
            *(__attribute__((address_space(3))) bf16_t*)(KT + (d0 + i) * 144 + s * 2) = f2bf(kv[i]);
            *(__attribute__((address_space(3))) bf16_t*)(VTw + (d0 + i) * 144 + s * 2) = f2bf(vv[i] * w);
        }
    }
    __syncthreads();
    if (tx < 128) {
        float a = 0.f;
        for (int s = 0; s < 64; ++s) a += wsm[s] * bf2f(*(const __attribute__((address_space(3))) bf16_t*)(KT + tx * 144 + s * 2));
        dn[((size_t)bh * 64 + c) * 128 + tx] = a;
    }
    {
        const int vb = wave >> 1, kh = wave & 1;
        f32x16 acc0, acc1;
#pragma unroll
        for (int r = 0; r < 16; ++r) { acc0[r] = 0.f; acc1[r] = 0.f; }
#pragma unroll
        for (int ks = 0; ks < 4; ++ks) {
            const bf16x8 a = *(const __attribute__((address_space(3))) bf16x8*)(VTw + (vb * 32 + r32) * 144 + ks * 32 + hi * 16);
            const bf16x8 b0 = *(const __attribute__((address_space(3))) bf16x8*)(KT + (kh * 64 + r32) * 144 + ks * 32 + hi * 16);
            const bf16x8 b1 = *(const __attribute__((address_space(3))) bf16x8*)(KT + (kh * 64 + 32 + r32) * 144 + ks * 32 + hi * 16);
            acc0 = MFMA32(a, b0, acc0); acc1 = MFMA32(a, b1, acc1);
        }
        bf16_t* o = dC + ((size_t)bh * 64 + c) * 16384;
#pragma unroll
        for (int r = 0; r < 16; ++r) { const int v = vb * 32 + crow(r, hi);
            o[v * 128 + kh * 64 + r32] = f2bf(acc0[r]); o[v * 128 + kh * 64 + 32 + r32] = f2bf(acc1[r]); }
    }
}
DI void ml_scan(int gtid, int nthreads, bf16_t* __restrict__ dC, float* __restrict__ dn, const float* __restrict__ wprev, const float* __restrict__ wsc) {
    for (int p = gtid; p < 16 * 8192; p += nthreads) {
        const int bh = p >> 13, e2 = p & 8191;
        unsigned* base = (unsigned*)(dC + (size_t)bh * 64 * 16384) + e2;
        float r0 = 0.f, r1 = 0.f;
#pragma unroll 1
        for (int c0 = 0; c0 < 64; c0 += 16) {
            unsigned v[16];
#pragma unroll
            for (int j = 0; j < 16; ++j) v[j] = base[(size_t)(c0 + j) * 8192];
#pragma unroll
            for (int j = 0; j < 16; ++j) {
                const float w = wprev[bh * 64 + c0 + j], sc = wsc[bh * 64 + c0 + j];
                base[(size_t)(c0 + j) * 8192] = pk2(r0, r1);
                r0 = w * r0 + sc * __uint_as_float(v[j] << 16); r1 = w * r1 + sc * __uint_as_float(v[j] & 0xffff0000u);
            }
        }
    }
    for (int p = gtid; p < 16 * 128; p += nthreads) {
        const int bh = p >> 7, k = p & 127; float r = 0.f; float* q = dn + (size_t)bh * 64 * 128 + k;
#pragma unroll 1
        for (int c0 = 0; c0 < 64; c0 += 16) {
            float v[16];
#pragma unroll
            for (int j = 0; j < 16; ++j) v[j] = q[(c0 + j) * 128];
#pragma unroll
            for (int j = 0; j < 16; ++j) { q[(c0 + j) * 128] = r; r = wprev[bh * 64 + c0 + j] * r + wsc[bh * 64 + c0 + j] * v[j]; }
        }
    }
}
DI void ml_unit_e(int bh, int c, int tx, lds_c* lds, const bf16_t* __restrict__ MQK, const bf16_t* __restrict__ MV, const bf16_t* __restrict__ MO, const float* __restrict__ ifp,
                  const float* __restrict__ wc, const float* __restrict__ bc, const bf16_t* __restrict__ Sst, const float* __restrict__ nst, const float* __restrict__ mtab, const float* __restrict__ g_hn, bf16_t* __restrict__ Y) {
    const int b = bh >> 2, h = bh & 3, lane = tx & 63, r32 = lane & 31, hi = lane >> 5, wave = __builtin_amdgcn_readfirstlane(tx >> 6);
    lds_c* Qi = lds; lds_c* Ki = lds + 64 * 272; lds_c* VTi = lds + 2 * 64 * 272; lds_c* Si = VTi + 128 * 136;
    __attribute__((address_space(3))) float* fsm = (__attribute__((address_space(3))) float*)(Si + 128 * 272);
    const size_t tok0 = (size_t)b * SEQ + 64 * c;
    const float m_c = mtab[bh * 65 + c];
    __syncthreads();
    if (wave == 0) {
        const float iv = ifp[(tok0 + lane) * 8 + h], lf = log_sigmoid_(ifp[(tok0 + lane) * 8 + 4 + h]);
        const int l_ = lane_id_opaque();
        const float bc_ = lane_shr_add(lf, l_), u = iv - bc_, M = fmaxf(lane_shr_max(u, l_), m_c);
        fsm[lane] = u; fsm[64 + lane] = M; fsm[128 + lane] = __expf(-(bc_ + M));
    }
    if (wave == 1) { fsm[192 + lane] = nst[((size_t)bh * 64 + c) * 128 + lane]; fsm[192 + 64 + lane] = nst[((size_t)bh * 64 + c) * 128 + 64 + lane]; }
#pragma unroll 1
    for (int it = tx; it < 1024; it += 512) {
        const int s = it >> 4, d0 = (it & 15) * 8; float qv[8], kv[8];
        ml_conv8(qv, MQK, tok0 + s, 64 * c + s, h * 128 + d0, wc, bc, 1.f);
        ml_conv8(kv, MQK, tok0 + s, 64 * c + s, 512 + h * 128 + d0, wc, bc, ML_KSCALE);
        *(__attribute__((address_space(3))) pg8::u32x4*)(Qi + s * 272 + d0 * 2) = pack8(qv);
        *(__attribute__((address_space(3))) pg8::u32x4*)(Ki + s * 272 + d0 * 2) = pack8(kv);
        const pg8::u32x4 vw = *(const pg8::u32x4*)(MV + (tok0 + s) * 512 + h * 128 + d0);
        __attribute__((address_space(3))) bf16_t* vt = (__attribute__((address_space(3))) bf16_t*)(VTi + d0 * 136 + s * 2);
        vt[0] = (bf16_t)(vw.x & 0xffffu); vt[68] = (bf16_t)(vw.x >> 16); vt[136] = (bf16_t)(vw.y & 0xffffu); vt[204] = (bf16_t)(vw.y >> 16);
        vt[272] = (bf16_t)(vw.z & 0xffffu); vt[340] = (bf16_t)(vw.z >> 16); vt[408] = (bf16_t)(vw.w & 0xffffu); vt[476] = (bf16_t)(vw.w >> 16);
    }
    {
        const bf16_t* src = Sst + ((size_t)bh * 64 + c) * 16384;
#pragma unroll
        for (int j = 0; j < 4; ++j) { const int ch = tx + 512 * j, v = ch >> 4, k8 = (ch & 15) * 8;
            *(__attribute__((address_space(3))) pg8::u32x4*)(Si + v * 272 + k8 * 2) = *(const pg8::u32x4*)(src + v * 128 + k8); }
    }
    __syncthreads();
    const int tb = wave & 1, vb = wave >> 1, t = tb * 32 + r32;
    bf16x8 qf[8];
#pragma unroll
    for (int ks = 0; ks < 8; ++ks) qf[ks] = *(const __attribute__((address_space(3))) bf16x8*)(Qi + t * 272 + ks * 32 + hi * 16);
    f32x16 a0, a1;
#pragma unroll
    for (int r = 0; r < 16; ++r) { a0[r] = 0.f; a1[r] = 0.f; }
#pragma unroll
    for (int ks = 0; ks < 8; ++ks) {
        const bf16x8 k0 = *(const __attribute__((address_space(3))) bf16x8*)(Ki + r32 * 272 + ks * 32 + hi * 16);
        const bf16x8 k1 = *(const __attribute__((address_space(3))) bf16x8*)(Ki + (32 + r32) * 272 + ks * 32 + hi * 16);
        a0 = MFMA32(k0, qf[ks], a0); a1 = MFMA32(k1, qf[ks], a1);
    }
    const float Mt = fsm[64 + t], dec = __expf(m_c - Mt);
    float rs = 0.f;
#pragma unroll
    for (int r = 0; r < 16; ++r) {
        const int s0 = crow(r, hi), s1 = 32 + s0;
        a0[r] = s0 <= t ? __expf(fsm[s0] - Mt) * a0[r] : 0.f; a1[r] = s1 <= t ? __expf(fsm[s1] - Mt) * a1[r] : 0.f;
        rs += a0[r] + a1[r];
    }
    float nq = 0.f;
#pragma unroll
    for (int ks = 0; ks < 8; ++ks) { float qv[8]; unpack8(__builtin_bit_cast(pg8::u32x4, qf[ks]), qv);
#pragma unroll
        for (int j = 0; j < 8; ++j) nq += qv[j] * fsm[192 + ks * 16 + hi * 8 + j]; }
    float den = rs + dec * nq;
    { auto rr = __builtin_amdgcn_permlane32_swap(__float_as_uint(den), __float_as_uint(den), false, false); den = __uint_as_float(rr[0]) + __uint_as_float(rr[1]); }
    f32x16 n1, n2;
#pragma unroll
    for (int r = 0; r < 16; ++r) { n1[r] = 0.f; n2[r] = 0.f; }
#pragma unroll
    for (int hf = 0; hf < 2; ++hf)
#pragma unroll
        for (int ss = 0; ss < 2; ++ss) {
            unsigned pw[4];
#pragma unroll
            for (int j = 0; j < 4; ++j) pw[j] = hf ? cvtpk(a1[8 * ss + 2 * j], a1[8 * ss + 2 * j + 1]) : cvtpk(a0[8 * ss + 2 * j], a0[8 * ss + 2 * j + 1]);
            const u32x4v pbw = {pw[0], pw[1], pw[2], pw[3]};
            const lds_c* vp = VTi + (vb * 32 + r32) * 136 + hf * 64 + ss * 32 + hi * 8;
            const u32x2v lo = *(const __attribute__((address_space(3))) u32x2v*)vp, hi2 = *(const __attribute__((address_space(3))) u32x2v*)(vp + 16);
            const u32x4v aw = {lo.x, lo.y, hi2.x, hi2.y};
            n1 = MFMA32(__builtin_bit_cast(bf16x8, aw), __builtin_bit_cast(bf16x8, pbw), n1);
        }
#pragma unroll
    for (int ks = 0; ks < 8; ++ks) {
        const bf16x8 sa = *(const __attribute__((address_space(3))) bf16x8*)(Si + (vb * 32 + r32) * 272 + ks * 32 + hi * 16);
        n2 = MFMA32(sa, qf[ks], n2);
    }
    const float inv = 1.f / fmaxf(fabsf(den), fsm[128 + t]);
    const bf16_t* op = MO + (tok0 + t) * 512 + h * 128 + vb * 32;
    float hv[16]; float ssq = 0.f;
#pragma unroll
    for (int i = 0; i < 4; ++i) {
        const u32x2v ow = *(const u32x2v*)(op + 8 * i + 4 * hi);
        const float o4[4] = {__uint_as_float(ow.x << 16), __uint_as_float(ow.x & 0xffff0000u), __uint_as_float(ow.y << 16), __uint_as_float(ow.y & 0xffff0000u)};
#pragma unroll
        for (int j = 0; j < 4; ++j) { const float x = (n1[4 * i + j] + dec * n2[4 * i + j]) * inv * sigmoidf_(o4[j]); hv[4 * i + j] = x; ssq += x * x; }
    }
    { auto rr = __builtin_amdgcn_permlane32_swap(__float_as_uint(ssq), __float_as_uint(ssq), false, false); ssq = __uint_as_float(rr[0]) + __uint_as_float(rr[1]); }
    if (hi == 0) fsm[320 + t * 4 + vb] = ssq;
    __syncthreads();
    const float tot = (fsm[320 + t * 4] + fsm[320 + t * 4 + 1]) + (fsm[320 + t * 4 + 2] + fsm[320 + t * 4 + 3]);
    const float rstd = rsqrtf(tot * (1.f / 128.f) + 1e-6f);
    bf16_t* yp = Y + (tok0 + t) * DM + 512 + h * 128 + vb * 32; const float* gp = g_hn + h * 128 + vb * 32;
#pragma unroll
    for (int i = 0; i < 4; ++i) {
        const float4 gg = *(const float4*)(gp + 8 * i + 4 * hi);
        *(u32x2v*)(yp + 8 * i + 4 * hi) = (u32x2v){cvtpk(hv[4 * i] * rstd * gg.x, hv[4 * i + 1] * rstd * gg.y), cvtpk(hv[4 * i + 2] * rstd * gg.z, hv[4 * i + 3] * rstd * gg.w)};
    }
}

DI void cmp_unit(int kv, int bg, int jt, int tx, lds_c* lds, const bf16_t* __restrict__ KVb, const bf16_t* __restrict__ W1t, const bf16_t* __restrict__ W2t, const float* __restrict__ bias1p,
                 float* __restrict__ outf, bf16_t* __restrict__ kcb, bf16_t* __restrict__ vcT) {
    const int b = bg >> 1, g = bg & 1, lane = tx & 63, r32 = lane & 31, hi = lane >> 5, wave = __builtin_amdgcn_readfirstlane(tx >> 6), j0 = jt * 32;
    lds_c* TI = lds; lds_c* H1 = lds + 16 * 34 * 144;
    const bf16_t* src = KVb + ((size_t)b * SEQ + 16 * j0) * 512 + (kv ? 128 : 0) + g * 64;
    __syncthreads();
    for (int ch = tx; ch < 528 * 8; ch += 512) {
        const int t = ch >> 3, c8 = ch & 7;
        *(__attribute__((address_space(3))) pg8::u32x4*)(TI + ((t & 15) * 34 + (t >> 4)) * 144 + c8 * 16) = *(const pg8::u32x4*)(src + (size_t)t * 512 + c8 * 8);
    }
    __syncthreads();
    f32x16 acc;
#pragma unroll
    for (int r = 0; r < 16; ++r) acc[r] = 0.f;
    const bf16_t* wrow = W1t + (size_t)(wave * 32 + r32) * 2048 + hi * 8;
#pragma unroll 4
    for (int i = 0; i < 32; ++i) {
        const lds_c* arow = TI + ((i & 15) * 34 + r32 + (i >> 4)) * 144 + hi * 16;
#pragma unroll
        for (int dk = 0; dk < 4; ++dk) {
            const bf16x8 a = *(const __attribute__((address_space(3))) bf16x8*)(arow + dk * 32);
            const bf16x8 bfr = *(const bf16x8*)(wrow + i * 64 + dk * 16);
            acc = MFMA32(a, bfr, acc);
        }
    }
    {
        const int n = wave * 32 + r32; const float bias = bias1p[kv * 256 + n];
#pragma unroll
        for (int r = 0; r < 16; ++r) *(__attribute__((address_space(3))) bf16_t*)(H1 + crow(r, hi) * 528 + n * 2) = f2bf(gelu_tanh(acc[r] + bias));
    }
    __syncthreads();
    if (wave < 2) {
        f32x16 o;
#pragma unroll
        for (int r = 0; r < 16; ++r) o[r] = 0.f;
        const bf16_t* w2row = W2t + (size_t)(wave * 32 + r32) * 256 + hi * 8;
#pragma unroll
        for (int ks = 0; ks < 16; ++ks) {
            const bf16x8 a = *(const __attribute__((address_space(3))) bf16x8*)(H1 + r32 * 528 + ks * 32 + hi * 16);
            const bf16x8 bfr = *(const bf16x8*)(w2row + ks * 16);
            o = MFMA32(a, bfr, o);
        }
        const int d = wave * 32 + r32;
#pragma unroll
        for (int r = 0; r < 16; ++r) {
            const int j = j0 + crow(r, hi); const float v = j < 255 ? o[r] : 0.f;
            outf[((size_t)bg * 256 + j) * 64 + d] = v;
            if (kv == 0) kcb[((size_t)bg * 256 + j) * 64 + d] = f2bf(v);
            else vcT[((size_t)bg * 4 + (j >> 6)) * 4096 + d * 64 + (j & 63)] = f2bf(v);
        }
    }
}

#define XB_TMO      128
#define XB_XCNT(j)  (256  + 64 * (j))
#define XB_XSUB(j)  (1280 + 64 * (j))
#define XB_XGEN(j)  (2304 + 64 * (j))
#define XB_TOP      3328
#define XB_TOPGEN   3392
#define XCD_BAR_WORDS 3456
#define XB_SPIN_CAP (1u << 23)

__device__ __forceinline__ unsigned xb_ld(unsigned* p)              { return __hip_atomic_load(p, __ATOMIC_RELAXED, __HIP_MEMORY_SCOPE_AGENT); }
__device__ __forceinline__ unsigned xb_add(unsigned* p, unsigned v) { return __hip_atomic_fetch_add(p, v, __ATOMIC_RELAXED, __HIP_MEMORY_SCOPE_AGENT); }
__device__ __forceinline__ unsigned xb_xcc_id() { return (unsigned)__builtin_amdgcn_s_getreg((3 << 11) | 20) & 0xFu; }
#define XB_SPIN(cond, bar) do { unsigned _sp = 0; while (cond) { __builtin_amdgcn_s_sleep(1); \
    if ((++_sp & 255u) == 0u) { if (xb_ld(&(bar)[XB_TMO])) break; if (_sp > XB_SPIN_CAP) { atomicAdd(&(bar)[XB_TMO], 1u); break; } } } } while (0)

struct XcdBarrier {
    unsigned* bar; unsigned x;
    volatile __attribute__((address_space(3))) unsigned* st;
};

__device__ __forceinline__ XcdBarrier xcd_barrier_post(unsigned* bar, volatile __attribute__((address_space(3))) unsigned* st) {
    XcdBarrier b; b.bar = bar; b.x = xb_xcc_id(); b.st = st;
    if (threadIdx.x == 0) (void)xb_add(&bar[XB_XCNT(b.x)], 1u);
    return b;
}
__device__ __forceinline__ void xcd_barrier_complete(unsigned* bar, unsigned x, unsigned& nloc, unsigned& nx) {
    const unsigned G = gridDim.x * gridDim.y * gridDim.z;
    unsigned sum, cnt, mine, sp = 0u;
    for (;;) {
        sum = 0u; cnt = 0u; mine = 0u;
#pragma unroll
        for (unsigned j = 0; j < 16; ++j) { const unsigned c = xb_ld(&bar[XB_XCNT(j)]); sum += c; cnt += (c > 0u) ? 1u : 0u; mine = (j == x) ? c : mine; }
        if (sum == G) break;
        __builtin_amdgcn_s_sleep(1);
        if ((++sp & 255u) == 0u) { if (xb_ld(&bar[XB_TMO])) break; if (sp > XB_SPIN_CAP) { atomicAdd(&bar[XB_TMO], 1u); break; } }
    }
    nloc = mine > 0u ? mine : 1u; nx = cnt > 0u ? cnt : 1u;
}

__device__ __forceinline__ void xcd_barrier(const XcdBarrier& b) {
    asm volatile("s_waitcnt vmcnt(0)" ::: "memory");
    __syncthreads();
    if (threadIdx.x == 0) {
        unsigned* bar = b.bar;
        __builtin_amdgcn_s_waitcnt(0);
        unsigned nloc = b.st[0], nx = b.st[1];
        if (nloc == 0u) { xcd_barrier_complete(bar, b.x, nloc, nx); b.st[0] = nloc; b.st[1] = nx; }
        const unsigned old = xb_add(&bar[XB_XSUB(b.x)], 1u);
        const unsigned gen = old / nloc;
        if (old + 1u == (gen + 1u) * nloc) {
            __builtin_amdgcn_fence(__ATOMIC_RELEASE, "agent");
            asm volatile("s_waitcnt vmcnt(0)" ::: "memory");
            const unsigned og = xb_add(&bar[XB_TOP], 1u);
            const unsigned tg = og / nx;
            if (og + 1u == (tg + 1u) * nx) xb_add(&bar[XB_TOPGEN], 1u);
            else XB_SPIN(xb_ld(&bar[XB_TOPGEN]) == tg, bar);
            __builtin_amdgcn_fence(__ATOMIC_ACQUIRE, "agent");
            xb_add(&bar[XB_XGEN(b.x)], 1u);
            asm volatile("s_waitcnt vmcnt(0)" ::: "memory");
        } else {
            XB_SPIN(xb_ld(&bar[XB_XGEN(b.x)]) == gen, bar);
            __builtin_amdgcn_fence(__ATOMIC_ACQUIRE, "agent");
            asm volatile("s_waitcnt vmcnt(0)" ::: "memory");
        }
    }
    __syncthreads();
}

#ifndef NSA_CHECK
#define NSA_CHECK 0
#endif
#ifndef REP_MASK
#define REP_MASK 0u
#endif
struct Args { const float* in[29]; float* out; char* ws; unsigned rep_mask; unsigned pad; };
constexpr int LDS_BYTES = 147456;

__global__ __launch_bounds__(512, 2) void mk_fwd(Args a) {
    extern __shared__ __attribute__((aligned(16))) char lds_raw[];
    cg::grid_group grid = cg::this_grid();
    const int NB = gridDim.x * 2, NGW = gridDim.x * 8;
    const unsigned repm = a.rep_mask;
    volatile __attribute__((address_space(3))) unsigned* bar_st = (volatile __attribute__((address_space(3))) unsigned*)((lds_c*)lds_raw + (LDS_BYTES - 64));
    if (threadIdx.x < 2) bar_st[threadIdx.x] = 0u;
    __syncthreads();
    const XcdBarrier xbar = xcd_barrier_post((unsigned*)(a.ws + ((size_t)42 << 20) + 65536), bar_st);
#define GRID_BAR() xcd_barrier(xbar)
#ifndef SPIN_PHASE_UNUSED_
#endif
    unsigned long long ts_prev_ = 0ull, ts_probe_ = 0ull; int n_stamp_ = 0;
#define STAMP() do { if (SPIN_PHASE >= 0 && blockIdx.x == 0) { const unsigned long long now_ = __builtin_amdgcn_s_memrealtime(); if (n_stamp_ == SPIN_PHASE) ts_probe_ = now_ - ts_prev_; ts_prev_ = now_; ++n_stamp_; } } while (0)
    if (SPIN_PHASE >= 0 && blockIdx.x == 0) ts_prev_ = __builtin_amdgcn_s_memrealtime();
    const int wave_s_ = __builtin_amdgcn_readfirstlane(threadIdx.x >> 6);
#define KARG(T, off) (*(T const __attribute__((address_space(4)))*)(kargs_ + (off)))
#define PTRS const float* x = KARG(const float*, 8 * 0); const float* p = KARG(const float*, 8 * 1); const int* pos = KARG(const int*, 16); \
    const float* g_mix = KARG(const float*, 8 * 3); const float* w_in = KARG(const float*, 8 * 4); const float* b_if = KARG(const float*, 8 * 5); \
    const float* w_ck1 = KARG(const float*, 8 * 6); const float* w_ck2 = KARG(const float*, 8 * 7); const float* pe_ck = KARG(const float*, 8 * 8); \
    const float* w_cv1 = KARG(const float*, 8 * 9); const float* w_cv2 = KARG(const float*, 8 * 10); const float* pe_cv = KARG(const float*, 8 * 11); \
    const float* w_conv = KARG(const float*, 8 * 12); const float* b_conv = KARG(const float*, 8 * 13); const float* g_hn = KARG(const float*, 8 * 14); \
    const float* w_pa = KARG(const float*, 8 * 15); const float* w_pb = KARG(const float*, 8 * 16); const float* w_out = KARG(const float*, 8 * 17); \
    const float* g_ffn = KARG(const float*, 8 * 18); const float* w_rg = KARG(const float*, 8 * 19); const float* b_rg = KARG(const float*, 8 * 20); \
    const float* w_re = KARG(const float*, 8 * 21); const float* b_re = KARG(const float*, 8 * 22); const float* w_e13 = KARG(const float*, 8 * 23); \
    const float* w_e2 = KARG(const float*, 8 * 24); const float* g_ple = KARG(const float*, 8 * 25); const float* w_pg = KARG(const float*, 8 * 26); \
    const float* w_pp = KARG(const float*, 8 * 27); const float* g_final = KARG(const float*, 8 * 28); \
    float* out = KARG(float*, 232); char* ws = KARG(char*, 240); \
    const size_t MiB = 1u << 20; \
    bf16_t* Wt_in = (bf16_t*)(ws); \
    bf16_t* xb = (bf16_t*)(ws + 48 * MiB); \
    bf16_t* Qb = (bf16_t*)(ws + 80 * MiB); \
    bf16_t* KVb = (bf16_t*)(ws + 96 * MiB); bf16_t* VT = (bf16_t*)(ws + 112 * MiB); bf16_t* kcb = (bf16_t*)(ws + 249 * MiB + 512 * 1024); bf16_t* vcT = (bf16_t*)(ws + 249 * MiB + 768 * 1024); \
    bf16_t* MQK = (bf16_t*)(ws + 120 * MiB); \
    bf16_t* MV = (bf16_t*)(ws + 152 * MiB); \
    bf16_t* MO = (bf16_t*)(ws + 168 * MiB); \
    bf16_t* MG = (bf16_t*)(ws + 184 * MiB); \
    float* gates = (float*)(ws + 248 * MiB); \
    float* ifp = (float*)(ws + 250 * MiB); \
    float* kcc = (float*)(ws + 251 * MiB); \
    float* vcc = (float*)(ws + 252 * MiB); \
    float* gate16 = (float*)(ws + 253 * MiB); \
    float* rstd0 = (float*)(ws + 254 * MiB); \
    float* cosT = (float*)(ws + 254 * MiB + 512 * 1024); \
    float* sinT = (float*)(ws + 255 * MiB); \
    bf16_t* Y = (bf16_t*)(out + (size_t)8 * 1024 * 1024); \
    bf16_t* dC = xb; float* dn = (float*)(ws + 250 * MiB + 512 * 1024); float* wprev = (float*)(ws + 42 * MiB + 4096); float* mtab = (float*)(ws + 42 * MiB + 8192); float* wsc = (float*)(ws + 42 * MiB + 16384); \
    float* tmp = (float*)(ws + 120 * MiB); bf16_t* mixed = xb; \
    bf16_t* Wpa_t = (bf16_t*)(ws + 11 * MiB); bf16_t* Wpb_t = (bf16_t*)(ws + 12 * MiB); bf16_t* Wout_t = (bf16_t*)(ws + 13 * MiB); \
    bf16_t* We13_t = (bf16_t*)(ws + 15 * MiB); bf16_t* We2_t = (bf16_t*)(ws + 31 * MiB); bf16_t* Wpg_t = (bf16_t*)(ws + 39 * MiB); bf16_t* Wpp_t = (bf16_t*)(ws + 41 * MiB); \
    int* cnt = (int*)(ws + 42 * MiB); bf16_t* W1t_k = (bf16_t*)(ws + 43 * MiB); bf16_t* W1t_v = (bf16_t*)(ws + 44 * MiB); bf16_t* W2t_k = (bf16_t*)(ws + 45 * MiB); bf16_t* W2t_v = (bf16_t*)(ws + 45 * MiB + 65536); float* bias1p = (float*)(ws + 45 * MiB + 524288); \
    bf16_t* x1b = (bf16_t*)(ws + 48 * MiB); bf16_t* act = (bf16_t*)(ws + 120 * MiB); bf16_t* y2 = (bf16_t*)(ws + 138 * MiB); bf16_t* x2b = (bf16_t*)(ws + 210 * MiB); int* elist = (int*)(ws + 242 * MiB); \
    bf16_t* pb = (bf16_t*)(ws + 80 * MiB); bf16_t* PP = (bf16_t*)(ws + 88 * MiB); \
    int* rinfo = (int*)(ws + 253 * MiB); float* rstd1 = (float*)(ws + 253 * MiB + 512 * 1024); float* rstd2 = (float*)(ws + 253 * MiB + 768 * 1024); \
    (void)x; (void)p; (void)pos; (void)g_mix; (void)w_in; (void)b_if; (void)w_ck1; (void)w_ck2; (void)pe_ck; (void)w_cv1; (void)w_cv2; (void)pe_cv; (void)w_conv; (void)b_conv; (void)g_hn; (void)w_pa; (void)w_pb; (void)w_out; (void)g_ffn; (void)w_rg; (void)b_rg; (void)w_re; (void)b_re; (void)w_e13; (void)w_e2; (void)g_ple; (void)w_pg; (void)w_pp; (void)g_final;
#define PHASE(k) for (int rep_ = 0; rep_ < 1 + (int)((repm >> (k)) & 1u); ++rep_)
#define PHASE_IDS unsigned tx_ = (unsigned)(wave_s_ * 64); asm volatile("" : "+v"(tx_)); tx_ = (unsigned)__builtin_amdgcn_mbcnt_hi(-1, __builtin_amdgcn_mbcnt_lo(-1, (int)tx_)); const int half = tx_ >> 8, tid = tx_ & 255, lane64 = tx_ & 63, tid512 = (int)tx_; \
    const int wave = __builtin_amdgcn_readfirstlane(tx_ >> 6); char* sm = lds_raw + half * 65536; const int gw = blockIdx.x * 8 + wave; (void)tid; (void)lane64; (void)sm; (void)gw; (void)tid512; \
    const __attribute__((address_space(4))) char* kargs_ = (const __attribute__((address_space(4))) char*)__builtin_amdgcn_kernarg_segment_ptr(); asm volatile("" : "+s"(kargs_)); PTRS
#define VB_LOOP(nvb) for (int vb = blockIdx.x * 2 + half; vb < (nvb); vb += NB)
#define GEMM_PHASE(NT, MT, ...) do { VB_LOOP((NT) * (MT)) { const int bx_ = vb % (NT), by_ = vb / (NT); __syncthreads(); gemm_v1(bx_, by_, tid, sm, __VA_ARGS__); } } while (0)
    PHASE(0) { PHASE_IDS
        float* scr = (float*)(lds_raw + wave * 8448);
        for (int it = gw; it < (DM / 64) * (NIN / 32); it += NGW) prep_wt_item(w_in, DIN, DM, Wt_in, g_mix, MapIn{}, scr, it, NIN / 32, lane64);
        for (int it = gw; it < 2 * 256; it += NGW) { const int kv = it >> 8; prep_wt_item(kv ? w_cv1 : w_ck1, 256, 2048, kv ? W1t_v : W1t_k, (const float*)nullptr, MapId{}, scr, it & 255, 8, lane64); }
        for (int it = gw; it < 2 * 8; it += NGW) { const int kv = it >> 3; prep_wt_item(kv ? w_cv2 : w_ck2, 64, 256, kv ? W2t_v : W2t_k, (const float*)nullptr, MapId{}, scr, it & 7, 2, lane64); }
        if (gw < 512) {
            const int kv = gw >> 8, n = gw & 255; const float* w1 = kv ? w_cv1 : w_ck1; const float* pe = kv ? pe_cv : pe_ck; float a = 0.f;
#pragma unroll
            for (int i = 0; i < 32; ++i) { const int k = lane64 + 64 * i; a += pe[k] * w1[(size_t)k * 256 + n]; }
            a = wave_sum(a);
            if (lane64 == 0) bias1p[gw] = a;
        }
        if (blockIdx.x == 0 && tid512 < 16) cnt[tid512 * CNT_STRIDE] = 0;
        for (int r = gw; r < T_TOK; r += NGW) prep_x_row(x, xb, rstd0, r, lane64);
        for (int i = blockIdx.x * 512 + tid512; i < T_TOK * 8; i += gridDim.x * 512) {
            const float inv = powf(500000.0f, -(float)(2 * (i & 7)) / 16.0f); float sn, cs; sincosf((float)pos[i >> 3] * inv, &sn, &cs); cosT[i] = cs; sinT[i] = sn; }
    }
    grid.sync(); STAMP();
    PHASE(1) { PHASE_IDS
        pg8::Gemm g{xb, Wt_in, T_TOK, NIN, DM, DM, DM}; pg8::StaticOrder S; S.init(T_TOK, NIN, (int)gridDim.x, (int)blockIdx.x);
        EpiInProj E{rstd0, cosT, sinT, b_if, Qb, KVb, gates, ifp, MQK, MV, MO, MG, VT};
        pg8::gemm_phase<EpiInProj, pg8::StaticOrder, true, true>((PG8_LAS unsigned char*)lds_raw, g, S, E, tid512);
    }
    {   PHASE_IDS
        const int G_ = (int)gridDim.x, nfull_ = (64 * (NIN / 256)) % G_;
        const int nl_ = G_ - nfull_, lw_ = (int)blockIdx.x - nfull_;
        if (nfull_ == 0 || lw_ >= 0) {
            const int lgw = (nfull_ == 0 ? (int)blockIdx.x : lw_) * 8 + wave, LNGW = (nfull_ == 0 ? G_ : nl_) * 8;
            float* scr = (float*)(lds_raw + wave * 8448);
            __syncthreads();
            for (int it = lgw; it < 16 * 256; it += LNGW) { const int e = it >> 8; prep_wt_item(w_e13 + (size_t)e * 1024 * 512, 512, DM, We13_t + (size_t)e * 512 * 1024, g_ffn, MapE13{}, scr, it & 255, 16, lane64); }
            if ((int)gridDim.x != 256) {
                for (int it = lgw; it < 8 * 32; it += LNGW) prep_wt_item(w_pa, DM, 512, Wpa_t, (const float*)nullptr, MapId{}, scr, it, 32, lane64);
                for (int it = lgw; it < 8 * 32; it += LNGW) prep_wt_item(w_pb, DM, 512, Wpb_t, (const float*)nullptr, MapId{}, scr, it, 32, lane64);
                for (int it = lgw; it < 16 * 32; it += LNGW) prep_wt_item(w_out, DM, DM, Wout_t, (const float*)nullptr, MapId{}, scr, it, 32, lane64);
                for (int it = lgw; it < 16 * 32; it += LNGW) prep_wt_item(w_pg, DM, DM, Wpg_t, g_ple, MapId{}, scr, it, 32, lane64);
                for (int it = lgw; it < 4 * 32; it += LNGW) prep_wt_item(w_pp, DM, 256, Wpp_t, (const float*)nullptr, MapId{}, scr, it, 32, lane64);
                for (int it = lgw; it < 16 * 128; it += LNGW) { const int e = it >> 7; prep_wt_item(w_e2 + (size_t)e * 256 * 1024, DM, 256, We2_t + (size_t)e * 1024 * 256, (const float*)nullptr, MapId{}, scr, it & 127, 32, lane64); }
            }
        }
    }
    GRID_BAR(); STAMP();
    PHASE(2) { PHASE_IDS
        for (int u = blockIdx.x; u < 128; u += gridDim.x) { const int kv = u >> 6, bg = (u >> 3) & 7, jt = u & 7;
            cmp_unit(kv, bg, jt, tid512, (lds_c*)lds_raw, KVb, kv ? W1t_v : W1t_k, kv ? W2t_v : W2t_k, bias1p, kv ? vcc : kcc, kcb, vcT); }
        { const int v_ = (int)blockIdx.x - 128; if (v_ >= 0 && v_ < 16 && wave == 0) ml_mscan_all(ifp, v_, lane64, mtab, wprev, wsc); }
    }
    PHASE(3) { PHASE_IDS
        { const int G_ = (int)gridDim.x, c_ = (int)blockIdx.x;
          if (G_ == 256) { const int n_ = c_ < 128 ? 3 : 5, first_ = c_ < 128 ? 3 * c_ : 384 + 5 * (c_ - 128);
              for (int u = first_; u < first_ + n_; ++u) ml_unit_c(u >> 6, u & 63, tid512, (lds_c*)lds_raw, MQK, MV, ifp, w_conv, b_conv, dC, dn, wprev, mtab); }
          else for (int u = c_; u < 1024; u += G_) ml_unit_c(u >> 6, u & 63, tid512, (lds_c*)lds_raw, MQK, MV, ifp, w_conv, b_conv, dC, dn, wprev, mtab); }
        if ((int)gridDim.x == 256 && (int)blockIdx.x >= 128) {
            const int lgw = ((int)blockIdx.x - 128) * 8 + wave, LNGW = 128 * 8; float* scr = (float*)(lds_raw + wave * 8448);
            __syncthreads();
            for (int it = lgw; it < 8 * 32; it += LNGW) prep_wt_item(w_pa, DM, 512, Wpa_t, (const float*)nullptr, MapId{}, scr, it, 32, lane64);
            for (int it = lgw; it < 8 * 32; it += LNGW) prep_wt_item(w_pb, DM, 512, Wpb_t, (const float*)nullptr, MapId{}, scr, it, 32, lane64);
            for (int it = lgw; it < 16 * 32; it += LNGW) prep_wt_item(w_out, DM, DM, Wout_t, (const float*)nullptr, MapId{}, scr, it, 32, lane64);
            for (int it = lgw; it < 16 * 32; it += LNGW) prep_wt_item(w_pg, DM, DM, Wpg_t, g_ple, MapId{}, scr, it, 32, lane64);
            for (int it = lgw; it < 4 * 32; it += LNGW) prep_wt_item(w_pp, DM, 256, Wpp_t, (const float*)nullptr, MapId{}, scr, it, 32, lane64);
            for (int it = lgw; it < 16 * 128; it += LNGW) { const int e = it >> 7; prep_wt_item(w_e2 + (size_t)e * 256 * 1024, DM, 256, We2_t + (size_t)e * 1024 * 256, (const float*)nullptr, MapId{}, scr, it & 127, 32, lane64); }
        }
    }
    GRID_BAR(); STAMP();
    {   PHASE_IDS
        ml_scan(blockIdx.x * 512 + tid512, gridDim.x * 512, dC, dn, wprev, wsc);
    }
    GRID_BAR(); STAMP();
    PHASE(4) { PHASE_IDS
        for (int u = blockIdx.x; u < 1024; u += gridDim.x) ml_unit_e(u >> 6, u & 63, tid512, (lds_c*)lds_raw, MQK, MV, MO, ifp, w_conv, b_conv, dC, dn, mtab, g_hn, Y);
    }
    PHASE(5) { PHASE_IDS
        for (int pr = blockIdx.x; pr < 256; pr += gridDim.x) {
            nsa_unit(pr & 7, 63 - (pr >> 3), tid512, (lds_c*)lds_raw, Qb, KVb, VT, kcb, vcT, gates, Y, ts_probe_);
            nsa_unit(pr & 7, pr >> 3, tid512, (lds_c*)lds_raw, Qb, KVb, VT, kcb, vcT, gates, Y, ts_probe_);
        }
    }
#if NSA_CHECK
    {   PHASE_IDS
        bf16_t* Y2 = (bf16_t*)(ws + 120 * MiB); unsigned* stats = (unsigned*)(ws + 42 * MiB + 32768);
        if (blockIdx.x == 0 && tid512 == 0) { stats[0] = 0u; stats[1] = 0u; }
        grid.sync();
        float* kcc2 = (float*)(ws + 251 * MiB + 512 * 1024); float* vcc2 = (float*)(ws + 252 * MiB + 512 * 1024); bf16_t* dummy = (bf16_t*)(ws + 160 * MiB);
        VB_LOOP(4080) { const int j = vb % 255, r = vb / 255; compress_naive(j, r & 7, r >> 3, tid, sm, KVb, w_ck1, w_ck2, pe_ck, w_cv1, w_cv2, pe_cv, kcc2, vcc2, dummy, dummy + 1048576); }
        grid.sync();
        VB_LOOP(T_TOK * 2) nsa_naive(vb >> 1, vb & 1, tid, sm, Qb, KVb, VT, kcc2, vcc2, gates, Y2);
        grid.sync();
        unsigned c1 = 0, c2 = 0;
        for (size_t i = (size_t)blockIdx.x * 512 + tid512; i < (size_t)T_TOK * 512; i += (size_t)gridDim.x * 512) {
            const size_t o = (i >> 9) * DM + (i & 511); const float d = fabsf(bf2f(Y[o]) - bf2f(Y2[o])); c1 += d > 0.02f ? 1u : 0u; c2 += (d > 0.1f || !(d == d)) ? 1u : 0u; }
        if (c1) atomicAdd(stats, c1); if (c2) atomicAdd(stats + 1, c2);
    }
#endif
    GRID_BAR(); STAMP();
    PHASE(7) { PHASE_IDS
        pg8::StaticOrder S; S.init(T_TOK, DM, (int)gridDim.x, (int)blockIdx.x);
        pg8::Gemm g{Y, Wpa_t, T_TOK, DM, 512, DM, 512}; EpiMerge<0> E{MG, tmp, mixed}; pg8::gemm_phase<EpiMerge<0>, pg8::StaticOrder, true, true>((PG8_LAS unsigned char*)lds_raw, g, S, E, tid512);
    }
    PHASE(8) { PHASE_IDS
        __syncthreads();
        pg8::StaticOrder S; S.init(T_TOK, DM, (int)gridDim.x, (int)blockIdx.x);
        pg8::Gemm g{Y + 512, Wpb_t, T_TOK, DM, 512, DM, 512}; EpiMerge<1> E{MG, tmp, mixed}; pg8::gemm_phase<EpiMerge<1>, pg8::StaticOrder, true, true>((PG8_LAS unsigned char*)lds_raw, g, S, E, tid512);
    }
    GRID_BAR(); STAMP();
    PHASE(9) { PHASE_IDS
        pg8::Gemm g{mixed, Wout_t, T_TOK, DM, DM, DM, DM}; pg8::StaticOrder S; S.init(T_TOK, DM, (int)gridDim.x, (int)blockIdx.x);
        EpiX1 E{x, out, x1b};
        pg8::gemm_phase<EpiX1, pg8::StaticOrder, true, true>((PG8_LAS unsigned char*)lds_raw, g, S, E, tid512);
    }
    GRID_BAR(); STAMP();
    {   PHASE_IDS
        __attribute__((address_space(3))) float* Wl = (__attribute__((address_space(3))) float*)((lds_c*)lds_raw);
        __attribute__((address_space(3))) int* lcnt = (__attribute__((address_space(3))) int*)((lds_c*)lds_raw + 20 * 4096);
        __attribute__((address_space(3))) int* lri = lcnt + 32;
        __syncthreads(); router_stage(Wl, g_ffn, w_rg, w_re, tid512); if (tid512 < 16) lcnt[tid512] = 0; __syncthreads();
        {   typedef float f4v_ __attribute__((ext_vector_type(4))); f4v_ xn_[4];
#pragma unroll
            for (int j = 0; j < 4; ++j) xn_[j] = *(const f4v_*)(out + (size_t)gw * DM + 4 * (lane64 + 64 * j));
            int i = 0; for (int t = gw; t < T_TOK; t += NGW, ++i) { f4v_ xc_[4];
#pragma unroll
                for (int j = 0; j < 4; ++j) xc_[j] = xn_[j];
                if (t + NGW < T_TOK) {
#pragma unroll
                    for (int j = 0; j < 4; ++j) xn_[j] = *(const f4v_*)(out + (size_t)(t + NGW) * DM + 4 * (lane64 + 64 * j)); }
                router2(t, lane64, xc_, Wl, b_rg, b_re, rstd1, lcnt, lri + (wave * 8 + i) * 4); } }
        __syncthreads();
        if (tid512 < 16) lcnt[16 + tid512] = atomicAdd(cnt + tid512 * CNT_STRIDE, lcnt[tid512]);
        __syncthreads();
        { int i = 0; for (int t = gw; t < T_TOK; t += NGW, ++i) if (lane64 == 0) { __attribute__((address_space(3))) int* r = lri + (wave * 8 + i) * 4;
            const int e0 = r[0] & 255, e1 = (r[0] >> 8) & 255, q0 = (r[1] & 0xffff) + lcnt[16 + e0], q1 = (r[1] >> 16) + lcnt[16 + e1]; int4 ri; ri.x = r[0]; ri.y = q0 | (q1 << 16); ri.z = r[2]; ri.w = r[3];
            *(int4*)(rinfo + (size_t)t * 4) = ri; elist[e0 * T_TOK + q0] = t; elist[e1 * T_TOK + q1] = t; } }
        for (int t = gw; t < T_TOK; t += NGW) { const float4 pv = ((const float4*)(p + (size_t)t * 256))[lane64]; uint2 o; o.x = pk2(pv.x, pv.y); o.y = pk2(pv.z, pv.w); ((uint2*)(pb + (size_t)t * 256))[lane64] = o; }
    }
    GRID_BAR(); STAMP();
    {   PHASE_IDS
        MoeOrder S{cnt, 2, (int)gridDim.x, (int)blockIdx.x}; pg8::Unit u; int ntot = 0;
        for (int e = 0; e < 16; ++e) ntot += ((cnt[e * CNT_STRIDE] + 255) >> 8) * 2;
        for (int i = 0; S.next(i, u); ++i) {
            const int e = u.pn >> 1, nv = cnt[e * CNT_STRIDE] - u.aux * 256; const int* amap = elist + (size_t)e * T_TOK + u.aux * 256;
            pg8::Gemm g{x1b, We13_t, 0, 0, DM, DM, DM, amap, nv}; EpiSwiglu E{act, amap, nv, rstd1}; OneUnit S1{u};
            __syncthreads();
            pg8::gemm_phase<EpiSwiglu, OneUnit, false, true, true>((PG8_LAS unsigned char*)lds_raw, g, S1, E, tid512);
        }
        __syncthreads();
        { int extra = ntot - (int)gridDim.x; if (extra < 0) extra = 0; if (extra > (int)gridDim.x - 1) extra = (int)gridDim.x - 1;
          pg8::Gemm g{pb, Wpp_t, T_TOK, DM, 256, 256, 256}; EpiStoreBf E{PP, DM, 3}; PPOrder SP{extra, (int)gridDim.x, (int)blockIdx.x};
          pg8::gemm_phase<EpiStoreBf, PPOrder, true, true>((PG8_LAS unsigned char*)lds_raw, g, SP, E, tid512); }
    }
    GRID_BAR(); STAMP();
    PHASE(13) { PHASE_IDS
        pg8::Gemm g{act, We2_t, 0, 0, 256, 256, 256}; MoeOrder S{cnt, 4, (int)gridDim.x, (int)blockIdx.x};
        EpiStoreBf E{y2, DM, 3};
        pg8::gemm_phase<EpiStoreBf, MoeOrder, true, true>((PG8_LAS unsigned char*)lds_raw, g, S, E, tid512);
    }
    GRID_BAR(); STAMP();
    {   PHASE_IDS
        for (int t = gw; t < T_TOK; t += NGW) {
            int4 ri = *(const int4*)(rinfo + (size_t)t * 4); ri.x = __builtin_amdgcn_readfirstlane(ri.x); ri.y = __builtin_amdgcn_readfirstlane(ri.y); ri.z = __builtin_amdgcn_readfirstlane(ri.z); ri.w = __builtin_amdgcn_readfirstlane(ri.w);
            const int r0 = moe_base_row(cnt, ri.x & 255) + (ri.y & 0xffff), r1 = moe_base_row(cnt, (ri.x >> 8) & 255) + ((ri.y >> 16) & 0xffff);
            const float w0 = __int_as_float(ri.z), w1 = __int_as_float(ri.w);
            float4 v[4]; float s2 = 0.f;
#pragma unroll
            for (int j = 0; j < 4; ++j) { v[j] = ((const float4*)(out + (size_t)t * DM))[lane64 + 64 * j];
                const uint2 a0 = ((const uint2*)(y2 + (size_t)r0 * DM))[lane64 + 64 * j], a1 = ((const uint2*)(y2 + (size_t)r1 * DM))[lane64 + 64 * j];
                v[j].x += w0 * __uint_as_float(a0.x << 16) + w1 * __uint_as_float(a1.x << 16); v[j].y += w0 * __uint_as_float(a0.x & 0xffff0000u) + w1 * __uint_as_float(a1.x & 0xffff0000u);
                v[j].z += w0 * __uint_as_float(a0.y << 16) + w1 * __uint_as_float(a1.y << 16); v[j].w += w0 * __uint_as_float(a0.y & 0xffff0000u) + w1 * __uint_as_float(a1.y & 0xffff0000u);
                s2 += v[j].x * v[j].x + v[j].y * v[j].y + v[j].z * v[j].z + v[j].w * v[j].w; }
            s2 = wave_sum(s2);
            if (lane64 == 0) rstd2[t] = rsqrtf(s2 * (1.f / DM) + 1e-6f);
#pragma unroll
            for (int j = 0; j < 4; ++j) { ((float4*)(out + (size_t)t * DM))[lane64 + 64 * j] = v[j]; uint2 o; o.x = pk2(v[j].x, v[j].y); o.y = pk2(v[j].z, v[j].w); ((uint2*)(x2b + (size_t)t * DM))[lane64 + 64 * j] = o; }
        }
    }
    GRID_BAR(); STAMP();
    if ((int)gridDim.x == 256) {
        PHASE_IDS
        __syncthreads();
        pg8::StaticOrder S; S.init(T_TOK, DM, (int)gridDim.x, (int)blockIdx.x);
        pg8::Gemm g{x2b, Wpg_t, T_TOK, DM, DM, DM, DM}; EpiPleFinal E{out, PP, rstd2, g_final, out, (float*)(ws + 251 * MiB), (unsigned*)(ws + 42 * MiB + 40960)};
        pg8::gemm_phase<EpiPleFinal, pg8::StaticOrder, false, true>((PG8_LAS unsigned char*)lds_raw, g, S, E, tid512);
        if (SPIN_PHASE >= 0 && blockIdx.x == 0) { __syncthreads(); STAMP(); const unsigned long long t0_ = __builtin_amdgcn_s_memrealtime(); while (__builtin_amdgcn_s_memrealtime() - t0_ < 8ull * ts_probe_) __builtin_amdgcn_s_sleep(4); }
    } else {
        {   PHASE_IDS
            __syncthreads();
            pg8::StaticOrder S; S.init(T_TOK, DM, (int)gridDim.x, (int)blockIdx.x);
            pg8::Gemm g{x2b, Wpg_t, T_TOK, DM, DM, DM, DM}; EpiPle2 E{out, PP, rstd2};
            pg8::gemm_phase<EpiPle2, pg8::StaticOrder, true, true>((PG8_LAS unsigned char*)lds_raw, g, S, E, tid512);
        }
        GRID_BAR();
        {   PHASE_IDS
            VB_LOOP(T_TOK / 4) rmsnorm_rows(vb, tid, out, g_final, (bf16_t*)nullptr, out, T_TOK);
        }
    }
}

extern "C" void kernel_launch(void* const* d_in, const int* in_sizes, int n_in, void* d_out, int out_size, void* d_ws, size_t ws_size, hipStream_t stream) {
    static int grid_blocks = 0;
    if (grid_blocks == 0) {
        int dev = 0, cus = 0, per_cu = 0;
        (void)hipGetDevice(&dev);
        (void)hipDeviceGetAttribute(&cus, hipDeviceAttributeMultiprocessorCount, dev);
        (void)hipFuncSetAttribute((const void*)mk_fwd, hipFuncAttributeMaxDynamicSharedMemorySize, LDS_BYTES);
        (void)hipOccupancyMaxActiveBlocksPerMultiprocessor(&per_cu, (const void*)mk_fwd, 512, LDS_BYTES);
        if (per_cu < 1) { fprintf(stderr, "kernel_launch: occupancy query returned %d\n", per_cu); per_cu = 1; }
        grid_blocks = cus * 1;
        fprintf(stderr, "kernel_launch: cus=%d per_cu=%d grid=%d ws=%zu\n", cus, per_cu, grid_blocks, ws_size);
    }
    (void)hipMemsetAsync((char*)d_ws + ((size_t)42 << 20), 0, 131072, stream);
    Args a{};
    for (int i = 0; i < 29; ++i) a.in[i] = (const float*)d_in[i];
    a.out = (float*)d_out; a.ws = (char*)d_ws; a.rep_mask = REP_MASK; a.pad = 0;
    void* args[] = {&a};
    hipError_t e = hipLaunchCooperativeKernel((const void*)mk_fwd, dim3(grid_blocks), dim3(512), args, LDS_BYTES, stream);
    if (e != hipSuccess) fprintf(stderr, "cooperative launch failed: %s (grid %d)\n", hipGetErrorString(e), grid_blocks);
    (void)in_sizes; (void)n_in; (void)out_size; (void)ws_size;
}
```

```cpp
#include <hip/hip_runtime.h>
#include <cstdint>
#include <cstdio>
#include <hip/hip_cooperative_groups.h>
namespace cg = cooperative_groups;

typedef unsigned short bf16_t;
typedef short bf16x8 __attribute__((ext_vector_type(8)));
typedef float f32x16 __attribute__((ext_vector_type(16)));

#define DI __device__ __forceinline__

constexpr int T_TOK = 16384, SEQ = 4096, DM = 1024, DIN = 5408, NIN = 5632;
#ifndef SPIN_PHASE
#define SPIN_PHASE (-1)
#endif
#define RG_BEGIN(id) unsigned long long rt0_##id = 0ull; if (SPIN_PHASE == (id) && blockIdx.x == 0) rt0_##id = __builtin_amdgcn_s_memrealtime();
#define RG_END(id) if (SPIN_PHASE == (id) && blockIdx.x == 0) pacc += __builtin_amdgcn_s_memrealtime() - rt0_##id;
constexpr int CNT_STRIDE = 64;
constexpr float QSCALE = 0.125f * 1.4426950408889634f;
constexpr int ZC_Q = 0, ZC_KC = 512, ZC_VC = 640, ZC_KS = 768, ZC_VS = 896, ZC_KW = 1024, ZC_VW = 1152, ZC_GATE = 1280,
              ZC_MQK = 1304, ZC_MV = 2328, ZC_MO = 2840, ZC_IF = 3352, ZC_GA = 3360, ZC_GB = 4384;

DI bf16_t f2bf(float f) { unsigned u = __float_as_uint(f); return (bf16_t)((u + 0x7fffu + ((u >> 16) & 1u)) >> 16); }
DI float bf2f(bf16_t h) { return __uint_as_float(((unsigned)h) << 16); }
DI float sigmoidf_(float x) { return 1.f / (1.f + __expf(-x)); }
DI int lane_id_opaque() { int z = 0; asm volatile("" : "+v"(z)); return __builtin_amdgcn_mbcnt_hi(-1, __builtin_amdgcn_mbcnt_lo(-1, z)); }
DI float lane_xor(float v, int o, int lane) { return __int_as_float(__builtin_amdgcn_ds_bpermute((lane ^ o) << 2, __float_as_int(v))); }
DI float lane_get(float v, int src) { return __int_as_float(__builtin_amdgcn_ds_bpermute(src << 2, __float_as_int(v))); }
DI float wave_sum(float v) {
    const int l = lane_id_opaque();
#pragma unroll
    for (int o = 1; o < 64; o <<= 1) v += lane_xor(v, o, l);
    return v;
}
DI float wave_max(float v) {
    const int l = lane_id_opaque();
#pragma unroll
    for (int o = 1; o < 64; o <<= 1) v = fmaxf(v, lane_xor(v, o, l));
    return v;
}

namespace pg8 {
#define PG8_LAS __attribute__((address_space(3)))
typedef unsigned short bf16_t;
typedef short bf16x8 __attribute__((ext_vector_type(8)));
typedef float f32x4 __attribute__((ext_vector_type(4)));
typedef unsigned u32x4 __attribute__((ext_vector_type(4)));
constexpr int BM = 256, BK = 64, HALF = 128, HTB = HALF * BK * 2  , STAGE_BYTES = 8 * HTB, NXCD = 8, WGM = 8;

__host__ __device__ __forceinline__ int lds_byte(int r, int c) { const int st = (r >> 4) * 2 + (c >> 5), rr = r & 15, cc = c & 31, ob = rr * 64 + cc * 2; return st * 1024 + (ob ^ (((ob >> 9) & 1) << 5)); }
__host__ __device__ __forceinline__ void stage_rc(int b, int& R, int& C) { const int st = b / 1024, sb = b % 1024, swz = sb ^ (((sb >> 9) & 1) << 5); R = (st >> 1) * 16 + swz / 64; C = (st & 1) * 32 + (swz % 64) / 2; }
__host__ __device__ __forceinline__ int perm32(int rho) { const int n = rho >> 4, i = rho & 15; return 8 * (i >> 2) + 4 * n + (i & 3); }

struct Unit { int pm, pn, aux; };
struct Gemm { const bf16_t* A; const bf16_t* Bt; int M, N, K, lda, ldb; const int* amap; int avalid; };

struct StaticOrder {
    int nM, nN, nwg, G, c;
    __host__ __device__ __forceinline__ void init(int M, int N, int G_, int c_) { nM = M / BM; nN = N / BM; nwg = nM * nN; G = G_; c = c_; }
    __host__ __device__ __forceinline__ bool next(int i, Unit& u) const {
        const long L = (long)i * G + c; if (L >= nwg) return false;
        int wgid = (int)L; { const int q = nwg / NXCD, r = nwg % NXCD, xcd = wgid % NXCD, off = wgid / NXCD; wgid = (xcd < r ? xcd * (q + 1) : r * (q + 1) + (xcd - r) * q) + off; }
        const int nig = WGM * nN, gid = wgid / nig, fm = gid * WGM, gsz = (nM - fm) < WGM ? (nM - fm) : WGM;
        u.pm = fm + ((wgid % nig) % gsz); u.pn = (wgid % nig) / gsz; u.aux = 0; return true;
    }
    __device__ __forceinline__ void a_ready(const Unit&) const {}
    __device__ __forceinline__ void done(const Unit&) const {}
};

__device__ __forceinline__ unsigned cvt_pk_bf16(float lo, float hi) { unsigned r; asm volatile("v_cvt_pk_bf16_f32 %0, %1, %2" : "=v"(r) : "v"(lo), "v"(hi)); return r; }
typedef float f32x2 __attribute__((ext_vector_type(2)));
__device__ __forceinline__ f32x2 gelu_pk(f32x2 v) {
    const f32x2 av = __builtin_elementwise_abs(v), d = av * 0.2316418882f + 1.0f;
    f32x2 t; t.x = __builtin_amdgcn_rcpf(d.x); t.y = __builtin_amdgcn_rcpf(d.y);
    f32x2 q = t * 0.5307027145f + (-0.7265760135f); q = q * t + 0.7107068705f; q = q * t + (-0.142248368f); q = q * t + 0.127414796f; q = q * t;
    const f32x2 s = (v * v) * (-0.72134752044f);
    f32x2 e; e.x = __builtin_amdgcn_exp2f(s.x); e.y = __builtin_amdgcn_exp2f(s.y);
    const f32x2 m = v * (q * e), r = v - m;
    f32x2 o; o.x = v.x < 0.f ? m.x : r.x; o.y = v.y < 0.f ? m.y : r.y; return o;
}

template <int ACT  > struct EpiBf16 {
    static constexpr bool PERM = true, AFTER_DRAIN = false; static constexpr int MIDK = 0; static_assert(ACT == 0 || ACT == 1, "EpiBf16: ACT is 0 (none) or 1 (gelu_pk)");
    bf16_t* O; int ldc; const float* bias; int split_cols; size_t split_stride; float scale0;
    __device__ __forceinline__ void operator()(const f32x4 (&acc)[2][2][4][2], const Unit& u, int wr, int wc, int fr, int fq) const {
        const int row0 = u.pm * BM + wr * 64 + fr; int colt = u.pn * BM; bf16_t* base = O;
        float sc = 1.f; if (split_cols) { const int t = colt / split_cols; base += (size_t)t * split_stride; colt -= t * split_cols; if (t == 0) sc = scale0; }
        const int col0 = colt + wc * 32 + 8 * fq, bcol0 = u.pn * BM + wc * 32 + 8 * fq;
        f32x4 bv[2][2];
#pragma unroll
        for (int bj = 0; bj < 2; ++bj)
#pragma unroll
            for (int n = 0; n < 2; ++n) bv[bj][n] = bias ? *(const f32x4*)(bias + bcol0 + bj * HALF + 4 * n) : (f32x4){0.f, 0.f, 0.f, 0.f};
#pragma unroll
        for (int ai = 0; ai < 2; ++ai)
#pragma unroll
            for (int m = 0; m < 4; ++m) { bf16_t* rowp = base + (size_t)(row0 + ai * HALF + m * 16) * ldc + col0;
#pragma unroll
                for (int bj = 0; bj < 2; ++bj) { f32x4 v0 = acc[ai][bj][m][0] + bv[bj][0], v1 = acc[ai][bj][m][1] + bv[bj][1];
                    if (ACT == 1) { f32x2 a = gelu_pk((f32x2){v0[0], v0[1]}), b = gelu_pk((f32x2){v0[2], v0[3]}), c = gelu_pk((f32x2){v1[0], v1[1]}), d = gelu_pk((f32x2){v1[2], v1[3]});
                        v0 = (f32x4){a.x, a.y, b.x, b.y}; v1 = (f32x4){c.x, c.y, d.x, d.y}; }
                    v0 = v0 * sc; v1 = v1 * sc; u32x4 w; w.x = cvt_pk_bf16(v0[0], v0[1]); w.y = cvt_pk_bf16(v0[2], v0[3]); w.z = cvt_pk_bf16(v1[0], v1[1]); w.w = cvt_pk_bf16(v1[2], v1[3]);
                    *(u32x4*)(rowp + bj * HALF) = w; } }
    }
};

template <class Epi, class Sched, bool ALIGN_EPI = false, bool SP2 = false, bool GATHER = false>
__device__ __forceinline__ void gemm_phase(PG8_LAS unsigned char* lds, const Gemm g, const Sched& S, const Epi& E, const int tid) {
    const int wid = __builtin_amdgcn_readfirstlane(tid >> 6), lane = tid & 63, wr = wid >> 2, wc = wid & 3, fr = lane & 15, fq = lane >> 4;
    const int K = g.K, nt = K / BK;
    unsigned voffA[2], voffB[2], voffA1[2];
#pragma unroll
    for (int i = 0; i < 2; ++i) { int R, C; stage_rc(tid * 16 + i * 8192, R, C); const int Rb = Epi::PERM ? ((R & ~31) + perm32(R & 31)) : R;
        voffA[i] = (unsigned)(R * g.lda + C) * 2u; voffB[i] = (unsigned)(Rb * g.ldb + C) * 2u; voffA1[i] = voffA[i];
        if constexpr (GATHER) { const int t0_ = R < g.avalid ? g.amap[R] : 0, t1_ = R + HALF < g.avalid ? g.amap[R + HALF] : 0; voffA[i] = (unsigned)(t0_ * g.lda + C) * 2u; voffA1[i] = (unsigned)(t1_ * g.lda + C) * 2u; } }
    const size_t kstep = (size_t)(BK * 2);
    const size_t hstepA = (size_t)HALF * g.lda * 2, hstepB = (size_t)HALF * g.ldb * 2;
    const size_t tstepA = GATHER ? 0 : 2 * hstepA, tstepB = 2 * hstepB, hsA = GATHER ? 0 : hstepA;
    const unsigned ldsw = (unsigned)wid * 1024u;
    const int aoff = lds_byte(wr * 64 + fr, fq * 8), boff = lds_byte(wc * 32 + fr, fq * 8);
#define PG8_SA(b, h) (((b) * 2 + (h)) * HTB)
#define PG8_SB(b, h) ((4 + (b) * 2 + (h)) * HTB)
#define PG8_STAGE(bufoff, gbase, voff) do { _Pragma("unroll") for (int _i = 0; _i < 2; ++_i) \
        __builtin_amdgcn_global_load_lds((const unsigned*)((const char*)(gbase) + (voff)[_i]), (PG8_LAS unsigned*)(lds + (bufoff) + ldsw + _i * 8192), 16, 0, 0); } while (0)
#define PG8_LDA(dst, b, h) do { _Pragma("unroll") for (int m = 0; m < 4; ++m) _Pragma("unroll") for (int k = 0; k < 2; ++k) dst[m][k] = *(const PG8_LAS bf16x8*)(lds + PG8_SA(b, h) + aoff + m * 2048 + k * 1024); } while (0)
#define PG8_LDB(dst, b, h) do { _Pragma("unroll") for (int n = 0; n < 2; ++n) _Pragma("unroll") for (int k = 0; k < 2; ++k) dst[n][k] = *(const PG8_LAS bf16x8*)(lds + PG8_SB(b, h) + boff + n * 2048 + k * 1024); } while (0)
#define PG8_MMA(ai, bj, At, Bt) do { __builtin_amdgcn_s_setprio(1); _Pragma("unroll") for (int m = 0; m < 4; ++m) _Pragma("unroll") for (int n = 0; n < 2; ++n) _Pragma("unroll") for (int k = 0; k < 2; ++k) \
        acc[ai][bj][m][n] = __builtin_amdgcn_mfma_f32_16x16x32_bf16(Bt[n][k], At[m][k], acc[ai][bj][m][n], 0, 0, 0); __builtin_amdgcn_s_setprio(0); } while (0)
#define PG8_WAIT_V(n) asm volatile("s_waitcnt vmcnt(" #n ")" ::: "memory")
#define PG8_WAIT_L(n) asm volatile("s_waitcnt lgkmcnt(" #n ")" ::: "memory")
#define PG8_BAR __builtin_amdgcn_s_barrier()
#define PG8_SCHED __builtin_amdgcn_sched_barrier(0)
    Unit cur, nxt; int ui = 0;
    if (!S.next(0, cur)) return;
    f32x4 acc[2][2][4][2];
#pragma unroll
    for (int a = 0; a < 2; ++a)
#pragma unroll
        for (int b = 0; b < 2; ++b)
#pragma unroll
            for (int m = 0; m < 4; ++m)
#pragma unroll
                for (int n = 0; n < 2; ++n) acc[a][b][m][n] = (f32x4){0.f, 0.f, 0.f, 0.f};
    bf16x8 At[4][2], B0[2][2], B1[2][2];
    const char* cA = (const char*)g.A + (size_t)cur.pm * tstepA; const char* cB = (const char*)g.Bt + (size_t)cur.pn * tstepB;
    S.a_ready(cur);
    if constexpr (SP2) {
        PG8_STAGE(PG8_SB(0, 0), cB, voffB); PG8_STAGE(PG8_SB(0, 1), cB + hstepB, voffB); PG8_STAGE(PG8_SA(0, 0), cA, voffA); PG8_STAGE(PG8_SA(0, 1), cA + hsA, voffA1);
        if (wr == 1) PG8_BAR;
        PG8_WAIT_V(2); PG8_BAR;
        PG8_STAGE(PG8_SB(1, 0), cB + kstep, voffB); PG8_STAGE(PG8_SA(1, 0), cA + kstep, voffA); PG8_STAGE(PG8_SB(1, 1), cB + hstepB + kstep, voffB);
        PG8_WAIT_V(6); PG8_BAR;
    } else {
        PG8_STAGE(PG8_SB(0, 0), cB, voffB); PG8_STAGE(PG8_SA(0, 0), cA, voffA); PG8_STAGE(PG8_SB(0, 1), cB + hstepB, voffB); PG8_STAGE(PG8_SA(0, 1), cA + hsA, voffA1);
        if (wr == 1) PG8_BAR;
        PG8_WAIT_V(4); PG8_BAR;
        PG8_STAGE(PG8_SB(1, 0), cB + kstep, voffB); PG8_STAGE(PG8_SA(1, 0), cA + kstep, voffA); PG8_STAGE(PG8_SB(1, 1), cB + hstepB + kstep, voffB);
        PG8_WAIT_V(6); PG8_BAR;
    }
    for (;;) {
        const bool has_next = S.next(ui + 1, nxt);
        const char* nA = has_next ? (const char*)g.A + (size_t)nxt.pm * tstepA : cA; const char* nB = has_next ? (const char*)g.Bt + (size_t)nxt.pn * tstepB : cB;
        for (int t = 0; t < nt; t += 2) {
            const bool last = (t == nt - 2);
            const char* a1 = cA + (size_t)(t + 1) * kstep;
            const char* a2 = last ? nA : cA + (size_t)(t + 2) * kstep; const char* b2 = last ? nB : cB + (size_t)(t + 2) * kstep;
            const char* a3 = a2 + kstep; const char* b3 = b2 + kstep;
            if (last && has_next) S.a_ready(nxt);
            if constexpr (SP2) {
            PG8_LDB(B0, 0, 0); PG8_LDB(B1, 0, 1); PG8_SCHED; PG8_LDA(At, 0, 0); PG8_STAGE(PG8_SA(1, 1), a1 + hsA, voffA1);
            PG8_WAIT_V(8); PG8_WAIT_L(0); PG8_BAR; PG8_MMA(0, 0, At, B0); PG8_MMA(0, 1, At, B1); PG8_BAR; PG8_SCHED;
            PG8_LDA(At, 0, 1); PG8_STAGE(PG8_SB(0, 0), b2, voffB); PG8_STAGE(PG8_SB(0, 1), b2 + hstepB, voffB); PG8_STAGE(PG8_SA(0, 0), a2, voffA);
            PG8_WAIT_V(8); PG8_WAIT_L(0); PG8_BAR; PG8_MMA(1, 0, At, B0); PG8_MMA(1, 1, At, B1); PG8_BAR; PG8_SCHED;
            PG8_LDB(B0, 1, 0); PG8_LDB(B1, 1, 1); PG8_SCHED; PG8_LDA(At, 1, 0); PG8_STAGE(PG8_SA(0, 1), a2 + hsA, voffA1);
            PG8_WAIT_V(8); PG8_WAIT_L(0); PG8_BAR; PG8_MMA(0, 0, At, B0); PG8_MMA(0, 1, At, B1); PG8_BAR; PG8_SCHED;
            PG8_LDA(At, 1, 1); PG8_STAGE(PG8_SB(1, 0), b3, voffB); PG8_STAGE(PG8_SB(1, 1), b3 + hstepB, voffB); PG8_STAGE(PG8_SA(1, 0), a3, voffA);
            PG8_WAIT_V(8); PG8_WAIT_L(0); PG8_BAR; PG8_MMA(1, 0, At, B0); PG8_MMA(1, 1, At, B1); PG8_BAR; PG8_SCHED;
            if constexpr (Epi::MIDK > 0) { if (t + 2 == Epi::MIDK / BK) { const int l3_ = lane_id_opaque(); E.mid(acc, cur, wr, wc, l3_ & 15, l3_ >> 4); } }
            } else {
            PG8_LDB(B0, 0, 0); PG8_SCHED; PG8_LDA(At, 0, 0); PG8_STAGE(PG8_SA(1, 1), a1 + hsA, voffA1);
            PG8_WAIT_L(8); PG8_BAR; PG8_WAIT_L(0); PG8_MMA(0, 0, At, B0); PG8_BAR; PG8_SCHED;
            PG8_LDB(B1, 0, 1); PG8_STAGE(PG8_SB(0, 0), b2, voffB);
            PG8_BAR; PG8_WAIT_L(0); PG8_MMA(0, 1, At, B1); PG8_BAR;
            PG8_LDA(At, 0, 1); PG8_STAGE(PG8_SA(0, 0), a2, voffA);
            PG8_BAR; PG8_WAIT_L(0); PG8_MMA(1, 0, At, B0); PG8_BAR; PG8_SCHED;
            PG8_STAGE(PG8_SB(0, 1), b2 + hstepB, voffB);
            PG8_WAIT_V(6); PG8_BAR; PG8_MMA(1, 1, At, B1); PG8_BAR;
            PG8_LDB(B0, 1, 0); PG8_SCHED; PG8_LDA(At, 1, 0); PG8_STAGE(PG8_SA(0, 1), a2 + hsA, voffA1);
            PG8_WAIT_L(8); PG8_BAR; PG8_WAIT_L(0); PG8_MMA(0, 0, At, B0); PG8_BAR; PG8_SCHED;
            PG8_LDB(B1, 1, 1); PG8_STAGE(PG8_SB(1, 0), b3, voffB);
            PG8_BAR; PG8_WAIT_L(0); PG8_MMA(0, 1, At, B1); PG8_BAR;
            PG8_LDA(At, 1, 1); PG8_STAGE(PG8_SA(1, 0), a3, voffA);
            PG8_BAR; PG8_WAIT_L(0); PG8_MMA(1, 0, At, B0); PG8_BAR; PG8_SCHED;
            PG8_STAGE(PG8_SB(1, 1), b3 + hstepB, voffB);
            PG8_WAIT_V(6); PG8_BAR; PG8_MMA(1, 1, At, B1); PG8_BAR;
            }
        }
        if constexpr (ALIGN_EPI) { if (wr == 0) PG8_BAR; }
        if constexpr (!Epi::AFTER_DRAIN) { const int l2_ = lane_id_opaque(); E(acc, cur, wr, wc, l2_ & 15, l2_ >> 4); S.done(cur); }
        if (!has_next) break;
#pragma unroll
        for (int a = 0; a < 2; ++a)
#pragma unroll
            for (int b = 0; b < 2; ++b)
#pragma unroll
                for (int m = 0; m < 4; ++m)
#pragma unroll
                    for (int n = 0; n < 2; ++n) acc[a][b][m][n] = (f32x4){0.f, 0.f, 0.f, 0.f};
        cur = nxt; cA = nA; cB = nB; ++ui;
        if constexpr (ALIGN_EPI) { if (wr == 1) PG8_BAR; }
    }
    PG8_WAIT_V(0);
    if constexpr (!ALIGN_EPI) { if (wr == 0) PG8_BAR; }
    PG8_BAR;
    if constexpr (Epi::AFTER_DRAIN) { E.fused(acc, cur, wr, wc, fr, fq, lds, wid, lane); S.done(cur); }
#undef PG8_SA
#undef PG8_SB
#undef PG8_STAGE
#undef PG8_LDA
#undef PG8_LDB
#undef PG8_MMA
#undef PG8_WAIT_V
#undef PG8_WAIT_L
#undef PG8_BAR
#undef PG8_SCHED
}
}


#define LAS __attribute__((address_space(3)))
DI unsigned pk2(float lo, float hi) { return (unsigned)f2bf(lo) | ((unsigned)f2bf(hi) << 16); }
template <class Map>
DI void prep_wt_item(const float* __restrict__ W, int ldw, int K, bf16_t* __restrict__ WT, const float* __restrict__ gain, Map map, float* scr, int item, int nblk, int lane) {
    const int kb = item / nblk, nb = item % nblk, k0 = 64 * kb, n0 = 32 * nb;
    const int srcn = map(n0 + (lane & 31));
    float tv[32];
#pragma unroll
    for (int i = 0; i < 32; ++i) { const int kk = 2 * i + (lane >> 5); tv[i] = srcn >= 0 ? W[(size_t)(k0 + kk) * ldw + srcn] : 0.f; }
#pragma unroll
    for (int i = 0; i < 32; ++i) { const int kk = 2 * i + (lane >> 5); scr[kk * 33 + (lane & 31)] = gain ? tv[i] * gain[k0 + kk] : tv[i]; }
    __builtin_amdgcn_s_waitcnt(0xC07F); asm volatile("" ::: "memory");
    const int c = lane & 7;
#pragma unroll
    for (int j = 0; j < 4; ++j) { const int n = (lane >> 3) + 8 * j; const float* s = scr + (8 * c) * 33 + n;
        uint4 o; o.x = pk2(s[0 * 33], s[1 * 33]); o.y = pk2(s[2 * 33], s[3 * 33]); o.z = pk2(s[4 * 33], s[5 * 33]); o.w = pk2(s[6 * 33], s[7 * 33]);
        *(uint4*)(WT + (size_t)(n0 + n) * K + k0 + 8 * c) = o; }
    __builtin_amdgcn_s_waitcnt(0xC07F); asm volatile("" ::: "memory");
}
template <class Map>
DI void prep_wt_item2(const float* __restrict__ Wa, const float* __restrict__ Wb, int ldw, int K, bf16_t* __restrict__ WTa, bf16_t* __restrict__ WTb, const float* __restrict__ gain, Map map, float* scr, int itemA, int itemB, int nblk, int lane) {
    const int ka = 64 * (itemA / nblk), na = 32 * (itemA % nblk), kb = 64 * (itemB / nblk), nb = 32 * (itemB % nblk);
    const int sa = map(na + (lane & 31)), sb = map(nb + (lane & 31));
    float ta[32], tb[32];
#pragma unroll
    for (int i = 0; i < 32; ++i) { const int kk = 2 * i + (lane >> 5); ta[i] = sa >= 0 ? Wa[(size_t)(ka + kk) * ldw + sa] : 0.f; }
#pragma unroll
    for (int i = 0; i < 32; ++i) { const int kk = 2 * i + (lane >> 5); tb[i] = sb >= 0 ? Wb[(size_t)(kb + kk) * ldw + sb] : 0.f; }
#pragma unroll
    for (int i = 0; i < 32; ++i) { const int kk = 2 * i + (lane >> 5); scr[kk * 33 + (lane & 31)] = gain ? ta[i] * gain[ka + kk] : ta[i]; }
#pragma unroll
    for (int i = 0; i < 32; ++i) { const int kk = 2 * i + (lane >> 5); scr[2112 + kk * 33 + (lane & 31)] = gain ? tb[i] * gain[kb + kk] : tb[i]; }
    __builtin_amdgcn_s_waitcnt(0xC07F); asm volatile("" ::: "memory");
    const int c = lane & 7;
#pragma unroll
    for (int j = 0; j < 4; ++j) { const int n = (lane >> 3) + 8 * j; const float* s = scr + (8 * c) * 33 + n;
        uint4 o; o.x = pk2(s[0 * 33], s[1 * 33]); o.y = pk2(s[2 * 33], s[3 * 33]); o.z = pk2(s[4 * 33], s[5 * 33]); o.w = pk2(s[6 * 33], s[7 * 33]);
        *(uint4*)(WTa + (size_t)(na + n) * K + ka + 8 * c) = o;
        const float* s2 = s + 2112;
        uint4 o2; o2.x = pk2(s2[0 * 33], s2[1 * 33]); o2.y = pk2(s2[2 * 33], s2[3 * 33]); o2.z = pk2(s2[4 * 33], s2[5 * 33]); o2.w = pk2(s2[6 * 33], s2[7 * 33]);
        *(uint4*)(WTb + (size_t)(nb + n) * K + kb + 8 * c) = o2; }
    __builtin_amdgcn_s_waitcnt(0xC07F); asm volatile("" ::: "memory");
}
struct MapIn {
    DI int operator()(int n) const {
        if (n < 1280) return n;
        if (n < 1536) { const int i = n - 1280; return i < 24 ? ZC_GATE + i : (i < 32 ? ZC_IF + (i - 24) : -1); }
        if (n < 2560) return ZC_MQK + (n - 1536);
        if (n < 3072) return ZC_MV + (n - 2560);
        if (n < 3584) return ZC_MO + (n - 3072);
        return ZC_GA + (n - 3584);
    }
};
DI void prep_x_row(const float* __restrict__ x, bf16_t* __restrict__ xb, float* __restrict__ rstd, int row, int lane) {
    const float4* xr = (const float4*)(x + (size_t)row * DM);
    float4 v[4]; float s = 0.f;
#pragma unroll
    for (int j = 0; j < 4; ++j) { v[j] = xr[lane + 64 * j]; s += v[j].x * v[j].x + v[j].y * v[j].y + v[j].z * v[j].z + v[j].w * v[j].w; }
    s = wave_sum(s);
    if (lane == 0) rstd[row] = rsqrtf(s * (1.f / DM) + 1e-6f);
#pragma unroll
    for (int j = 0; j < 4; ++j) { uint2 o; o.x = pk2(v[j].x, v[j].y); o.y = pk2(v[j].z, v[j].w); ((uint2*)(xb + (size_t)row * DM))[lane + 64 * j] = o; }
}

struct EpiInProj {
    static constexpr bool PERM = true, AFTER_DRAIN = false; static constexpr int MIDK = 0;
    const float* rstd; const float* cosT; const float* sinT; const float* b_if;
    bf16_t* Qb; bf16_t* KVb; float* gates; float* ifp; bf16_t* MQK; bf16_t* MV; bf16_t* MO; bf16_t* MG; bf16_t* VT;
    DI void operator()(const pg8::f32x4 (&acc)[2][2][4][2], const pg8::Unit& u, int wr, int wc, int fr, int fq) const {
        const int pn = u.pn;
        asm volatile("" : "+v"(fr), "+v"(fq));
#pragma unroll
        for (int ai = 0; ai < 2; ++ai)
#pragma unroll
            for (int m = 0; m < 4; ++m) {
                const int row = u.pm * 256 + ai * 128 + wr * 64 + m * 16 + fr;
                const float rs = rstd[row];
#pragma unroll
                for (int bj = 0; bj < 2; ++bj) {
                    float v[8];
#pragma unroll
                    for (int i = 0; i < 4; ++i) { v[i] = acc[ai][bj][m][0][i] * rs; v[4 + i] = acc[ai][bj][m][1][i] * rs; }
                    const int c0 = bj * 128 + wc * 32 + 8 * fq;
                    if (pn <= 4) {
                        const bool is_k = (pn < 2) || (bj == 0);
                        if (is_k && (wc & 1) == 0) {
                            const float4 c_lo = *(const float4*)(cosT + (size_t)row * 8), c_hi = *(const float4*)(cosT + (size_t)row * 8 + 4);
                            const float4 s_lo = *(const float4*)(sinT + (size_t)row * 8), s_hi = *(const float4*)(sinT + (size_t)row * 8 + 4);
                            const float cs[8] = {c_lo.x, c_lo.y, c_lo.z, c_lo.w, c_hi.x, c_hi.y, c_hi.z, c_hi.w};
                            const float sn[8] = {s_lo.x, s_lo.y, s_lo.z, s_lo.w, s_hi.x, s_hi.y, s_hi.z, s_hi.w};
                            const int l_ = lane_id_opaque();
#pragma unroll
                            for (int i = 0; i < 8; ++i) {
                                const float other = lane_xor(v[i], 16, l_);
                                if (fq == 0) v[i] = v[i] * cs[i] - other * sn[i];
                                else if (fq == 1) v[i] = v[i] * cs[i] + other * sn[i];
                            }
                        }
                        const float sc = pn < 2 ? QSCALE : 1.f;
                        pg8::u32x4 w; w.x = pg8::cvt_pk_bf16(v[0] * sc, v[1] * sc); w.y = pg8::cvt_pk_bf16(v[2] * sc, v[3] * sc); w.z = pg8::cvt_pk_bf16(v[4] * sc, v[5] * sc); w.w = pg8::cvt_pk_bf16(v[6] * sc, v[7] * sc);
                        if (pn < 2) *(pg8::u32x4*)(Qb + (size_t)row * 512 + pn * 256 + c0) = w;
                        else if (pn == 2) *(pg8::u32x4*)(KVb + (size_t)row * 512 + c0) = w;
                        else if (bj == 0) *(pg8::u32x4*)(KVb + (size_t)row * 512 + (pn - 2) * 128 + 128 + wc * 32 + 8 * fq) = w;
                        else {
                            const int cv = wc * 32 + 8 * fq, gg = cv >> 6, d0 = cv & 63, bb = row >> 12, tt = row & 4095;
                            bf16_t* vt = VT + ((size_t)((pn - 3) * 8 + bb * 2 + gg) * 64 + (tt >> 6)) * 4096 + (size_t)d0 * 64 + (tt & 63);
                            vt[0] = (bf16_t)(w.x & 0xffffu); vt[64] = (bf16_t)(w.x >> 16); vt[128] = (bf16_t)(w.y & 0xffffu); vt[192] = (bf16_t)(w.y >> 16);
                            vt[256] = (bf16_t)(w.z & 0xffffu); vt[320] = (bf16_t)(w.z >> 16); vt[384] = (bf16_t)(w.w & 0xffffu); vt[448] = (bf16_t)(w.w >> 16);
                        }
                    } else if (pn == 5) {
                        if (bj == 0 && wc == 0) {
#pragma unroll
                            for (int i = 0; i < 8; ++i) { const int c = 8 * fq + i;
                                if (c < 24) gates[(size_t)row * 24 + c] = sigmoidf_(v[i]);
                                else if (c < 32) ifp[(size_t)row * 8 + (c - 24)] = v[i] + b_if[c - 24]; }
                        }
                    } else {
                        if (pn >= 14) {
#pragma unroll
                            for (int i = 0; i < 8; ++i) v[i] = sigmoidf_(v[i]);
                        }
                        pg8::u32x4 w; w.x = pg8::cvt_pk_bf16(v[0], v[1]); w.y = pg8::cvt_pk_bf16(v[2], v[3]); w.z = pg8::cvt_pk_bf16(v[4], v[5]); w.w = pg8::cvt_pk_bf16(v[6], v[7]);
                        bf16_t* dst;
                        if (pn < 10) dst = MQK + (size_t)row * 1024 + (pn - 6) * 256 + c0;
                        else if (pn < 12) dst = MV + (size_t)row * 512 + (pn - 10) * 256 + c0;
                        else if (pn < 14) dst = MO + (size_t)row * 512 + (pn - 12) * 256 + c0;
                        else dst = MG + (size_t)row * 2048 + (pn - 14) * 256 + c0;
                        *(pg8::u32x4*)dst = w;
                    }
                }
            }
    }
};


DI pg8::u32x4 pack8(const float (&v)[8]) { pg8::u32x4 w; w.x = pg8::cvt_pk_bf16(v[0], v[1]); w.y = pg8::cvt_pk_bf16(v[2], v[3]); w.z = pg8::cvt_pk_bf16(v[4], v[5]); w.w = pg8::cvt_pk_bf16(v[6], v[7]); return w; }
DI void unpack8(const pg8::u32x4 w, float (&v)[8]) {
    v[0] = __uint_as_float(w.x << 16); v[1] = __uint_as_float(w.x & 0xffff0000u); v[2] = __uint_as_float(w.y << 16); v[3] = __uint_as_float(w.y & 0xffff0000u);
    v[4] = __uint_as_float(w.z << 16); v[5] = __uint_as_float(w.z & 0xffff0000u); v[6] = __uint_as_float(w.w << 16); v[7] = __uint_as_float(w.w & 0xffff0000u);
}
#define EPI_ROWS_BEGIN asm volatile("" : "+v"(fr), "+v"(fq)); _Pragma("unroll") for (int ai = 0; ai < 2; ++ai) _Pragma("unroll") for (int m = 0; m < 4; ++m) { const int row = u.pm * 256 + ai * 128 + wr * 64 + m * 16 + fr; _Pragma("unroll") for (int bj = 0; bj < 2; ++bj) { \
    float v[8]; _Pragma("unroll") for (int i = 0; i < 4; ++i) { v[i] = acc[ai][bj][m][0][i]; v[4 + i] = acc[ai][bj][m][1][i]; } const int c0 = bj * 128 + wc * 32 + 8 * fq; (void)c0; (void)row;
#define EPI_ROWS_END } asm volatile("" ::: "memory"); }
template <int MODE> struct EpiMerge {
    static constexpr bool PERM = true, AFTER_DRAIN = false; static constexpr int MIDK = 0;
    const bf16_t* MG; float* tmp; bf16_t* mixed;
    DI void operator()(const pg8::f32x4 (&acc)[2][2][4][2], const pg8::Unit& u, int wr, int wc, int fr, int fq) const {
        EPI_ROWS_BEGIN
            const int col = u.pn * 256 + c0; float gt[8];
            unpack8(*(const pg8::u32x4*)(MG + (size_t)row * 2048 + MODE * 1024 + col), gt);
            float* tp = tmp + (size_t)row * DM + col;
            if (MODE == 0) {
                *(float4*)tp = make_float4(gt[0] * v[0], gt[1] * v[1], gt[2] * v[2], gt[3] * v[3]); *(float4*)(tp + 4) = make_float4(gt[4] * v[4], gt[5] * v[5], gt[6] * v[6], gt[7] * v[7]);
            } else {
                const float4 t0 = *(const float4*)tp, t1 = *(const float4*)(tp + 4);
                float o[8] = {t0.x + gt[0] * v[0], t0.y + gt[1] * v[1], t0.z + gt[2] * v[2], t0.w + gt[3] * v[3], t1.x + gt[4] * v[4], t1.y + gt[5] * v[5], t1.z + gt[6] * v[6], t1.w + gt[7] * v[7]};
                *(pg8::u32x4*)(mixed + (size_t)row * DM + col) = pack8(o);
            }
        EPI_ROWS_END
    }
};
struct EpiMerge2 {
    static constexpr bool PERM = true, AFTER_DRAIN = false; static constexpr int MIDK = 512;
    const bf16_t* MG; bf16_t* mixed;
    DI void mid(pg8::f32x4 (&acc)[2][2][4][2], const pg8::Unit& u, int wr, int wc, int fr, int fq) const {
#pragma unroll
        for (int ai = 0; ai < 2; ++ai)
#pragma unroll
            for (int m = 0; m < 4; ++m) { const int row = u.pm * 256 + ai * 128 + wr * 64 + m * 16 + fr;
#pragma unroll
                for (int bj = 0; bj < 2; ++bj) {
                    const int col = u.pn * 256 + bj * 128 + wc * 32 + 8 * fq; float ga[8], gb[8];
                    unpack8(*(const pg8::u32x4*)(MG + (size_t)row * 2048 + col), ga); unpack8(*(const pg8::u32x4*)(MG + (size_t)row * 2048 + 1024 + col), gb);
#pragma unroll
                    for (int i = 0; i < 4; ++i) { acc[ai][bj][m][0][i] *= ga[i] * __builtin_amdgcn_rcpf(gb[i]); acc[ai][bj][m][1][i] *= ga[4 + i] * __builtin_amdgcn_rcpf(gb[4 + i]); }
                }
                asm volatile("" ::: "memory"); }
    }
    DI void operator()(const pg8::f32x4 (&acc)[2][2][4][2], const pg8::Unit& u, int wr, int wc, int fr, int fq) const {
        EPI_ROWS_BEGIN
            const int col = u.pn * 256 + c0; float gb[8];
            unpack8(*(const pg8::u32x4*)(MG + (size_t)row * 2048 + 1024 + col), gb);
            float o[8] = {gb[0] * v[0], gb[1] * v[1], gb[2] * v[2], gb[3] * v[3], gb[4] * v[4], gb[5] * v[5], gb[6] * v[6], gb[7] * v[7]};
            *(pg8::u32x4*)(mixed + (size_t)row * DM + col) = pack8(o);
        EPI_ROWS_END
    }
};
struct EpiX1 {
    static constexpr bool PERM = true, AFTER_DRAIN = false; static constexpr int MIDK = 0;
    const float* base; float* out; bf16_t* outb;
    DI void operator()(const pg8::f32x4 (&acc)[2][2][4][2], const pg8::Unit& u, int wr, int wc, int fr, int fq) const {
        EPI_ROWS_BEGIN
            const size_t o = (size_t)row * DM + u.pn * 256 + c0;
            const float4 b0 = *(const float4*)(base + o), b1 = *(const float4*)(base + o + 4);
            const float r[8] = {b0.x + v[0], b0.y + v[1], b0.z + v[2], b0.w + v[3], b1.x + v[4], b1.y + v[5], b1.z + v[6], b1.w + v[7]};
            *(float4*)(out + o) = make_float4(r[0], r[1], r[2], r[3]); *(float4*)(out + o + 4) = make_float4(r[4], r[5], r[6], r[7]);
            *(pg8::u32x4*)(outb + o) = pack8(r);
        EPI_ROWS_END
    }
};
struct EpiStoreBf {
    static constexpr bool PERM = true, AFTER_DRAIN = false; static constexpr int MIDK = 0;
    bf16_t* O; int ld; int pnmask;
    DI void operator()(const pg8::f32x4 (&acc)[2][2][4][2], const pg8::Unit& u, int wr, int wc, int fr, int fq) const {
        EPI_ROWS_BEGIN
            *(pg8::u32x4*)(O + (size_t)row * ld + (u.pn & pnmask) * 256 + c0) = pack8(v);
        EPI_ROWS_END
    }
};
struct EpiSwiglu {
    static constexpr bool PERM = true, AFTER_DRAIN = false; static constexpr int MIDK = 0;
    bf16_t* act; const int* amap; int avalid; const float* rstd1;
    DI void operator()(const pg8::f32x4 (&acc)[2][2][4][2], const pg8::Unit& u, int wr, int wc, int fr, int fq) const {
        asm volatile("" : "+v"(fr), "+v"(fq));
#pragma unroll
        for (int ai = 0; ai < 2; ++ai)
#pragma unroll
            for (int m = 0; m < 4; ++m) {
                const int rl = ai * 128 + wr * 64 + m * 16 + fr, row = u.pm * 256 + rl; float o[8];
                const float rs = rl < avalid ? rstd1[amap[rl]] : 0.f;
#pragma unroll
                for (int i = 0; i < 4; ++i) { const float g0 = rs * acc[ai][0][m][0][i], g1 = rs * acc[ai][0][m][1][i]; o[i] = g0 * sigmoidf_(g0) * (rs * acc[ai][1][m][0][i]); o[4 + i] = g1 * sigmoidf_(g1) * (rs * acc[ai][1][m][1][i]); }
                *(pg8::u32x4*)(act + (size_t)row * 256 + (u.pn & 1) * 128 + wc * 32 + 8 * fq) = pack8(o);
            }
    }
};
struct EpiPle2 {
    static constexpr bool PERM = true, AFTER_DRAIN = false; static constexpr int MIDK = 0;
    float* x; const bf16_t* PP; const float* rstd;
    DI void operator()(const pg8::f32x4 (&acc)[2][2][4][2], const pg8::Unit& u, int wr, int wc, int fr, int fq) const {
        EPI_ROWS_BEGIN
            const size_t o = (size_t)row * DM + u.pn * 256 + c0; const float rs = rstd[row]; float pp[8];
            unpack8(*(const pg8::u32x4*)(PP + o), pp);
            const float4 b0 = *(const float4*)(x + o), b1 = *(const float4*)(x + o + 4);
            *(float4*)(x + o) = make_float4(b0.x + sigmoidf_(rs * v[0]) * pp[0], b0.y + sigmoidf_(rs * v[1]) * pp[1], b0.z + sigmoidf_(rs * v[2]) * pp[2], b0.w + sigmoidf_(rs * v[3]) * pp[3]);
            *(float4*)(x + o + 4) = make_float4(b1.x + sigmoidf_(rs * v[4]) * pp[4], b1.y + sigmoidf_(rs * v[5]) * pp[5], b1.z + sigmoidf_(rs * v[6]) * pp[6], b1.w + sigmoidf_(rs * v[7]) * pp[7]);
        EPI_ROWS_END
    }
};

struct EpiPleFinal {
    static constexpr bool PERM = true, AFTER_DRAIN = true; static constexpr int MIDK = 0;
    const float* x2; const bf16_t* PP; const float* rstd2; const float* g_final; float* out; float* xbuf; unsigned* pcnt;
    DI void fused(pg8::f32x4 (&acc)[2][2][4][2], const pg8::Unit& u, int wr, int wc, int fr, int fq, PG8_LAS unsigned char* lds, int wid, int lane) const {
        __attribute__((address_space(3))) float* P = (__attribute__((address_space(3))) float*)lds;
        __attribute__((address_space(3))) float* S = P + 1024;
        const int l_ = lane_id_opaque();
#pragma unroll
        for (int ai = 0; ai < 2; ++ai)
#pragma unroll
            for (int m = 0; m < 4; ++m) {
                const int rl = ai * 128 + wr * 64 + m * 16 + fr, row = u.pm * 256 + rl; const float rs = rstd2[row]; float sq = 0.f;
#pragma unroll
                for (int bj = 0; bj < 2; ++bj) {
                    const size_t o = (size_t)row * DM + u.pn * 256 + bj * 128 + wc * 32 + 8 * fq; float pp[8];
                    unpack8(*(const pg8::u32x4*)(PP + o), pp);
                    const float4 b0 = *(const float4*)(x2 + o), b1 = *(const float4*)(x2 + o + 4);
                    const float bx[8] = {b0.x, b0.y, b0.z, b0.w, b1.x, b1.y, b1.z, b1.w};
#pragma unroll
                    for (int i = 0; i < 4; ++i) {
                        const float v0 = bx[i] + sigmoidf_(rs * acc[ai][bj][m][0][i]) * pp[i], v1 = bx[4 + i] + sigmoidf_(rs * acc[ai][bj][m][1][i]) * pp[4 + i];
                        acc[ai][bj][m][0][i] = v0; acc[ai][bj][m][1][i] = v1; sq += v0 * v0 + v1 * v1;
                    }
                }
                sq += lane_xor(sq, 16, l_); sq += lane_xor(sq, 32, l_);
                if (fq == 0) P[rl * 4 + wc] = sq;
                asm volatile("" ::: "memory");
            }
        __syncthreads();
        const int t = wid * 64 + lane;
        if (t < 256) { const float ps = (P[t * 4] + P[t * 4 + 1]) + (P[t * 4 + 2] + P[t * 4 + 3]);
            __hip_atomic_store(xbuf + ((size_t)u.pm * 256 + t) * 4 + u.pn, ps, __ATOMIC_RELAXED, __HIP_MEMORY_SCOPE_AGENT); }
        asm volatile("s_waitcnt vmcnt(0)" ::: "memory");
        __syncthreads();
        if (t == 0) __hip_atomic_fetch_add(pcnt + 64 * u.pm, 1u, __ATOMIC_RELAXED, __HIP_MEMORY_SCOPE_AGENT);
        if (wid == 0) { unsigned spins = 0; while (__hip_atomic_load(pcnt + 64 * u.pm, __ATOMIC_RELAXED, __HIP_MEMORY_SCOPE_AGENT) < 4u && ++spins < (1u << 22)) __builtin_amdgcn_s_sleep(2); }
        __syncthreads();
        if (t < 256) { const float* xb = xbuf + ((size_t)u.pm * 256 + t) * 4;
            const float tot = (__hip_atomic_load(xb, __ATOMIC_RELAXED, __HIP_MEMORY_SCOPE_AGENT) + __hip_atomic_load(xb + 1, __ATOMIC_RELAXED, __HIP_MEMORY_SCOPE_AGENT))
                            + (__hip_atomic_load(xb + 2, __ATOMIC_RELAXED, __HIP_MEMORY_SCOPE_AGENT) + __hip_atomic_load(xb + 3, __ATOMIC_RELAXED, __HIP_MEMORY_SCOPE_AGENT));
            S[t] = rsqrtf(tot * (1.f / DM) + 1e-6f); }
        __syncthreads();
#pragma unroll
        for (int ai = 0; ai < 2; ++ai)
#pragma unroll
            for (int m = 0; m < 4; ++m) {
                const int rl = ai * 128 + wr * 64 + m * 16 + fr, row = u.pm * 256 + rl; const float r3 = S[rl];
#pragma unroll
                for (int bj = 0; bj < 2; ++bj) {
                    const int col = u.pn * 256 + bj * 128 + wc * 32 + 8 * fq; const size_t o = (size_t)row * DM + col;
                    const float4 g0 = *(const float4*)(g_final + col), g1 = *(const float4*)(g_final + col + 4);
                    *(float4*)(out + o) = make_float4(acc[ai][bj][m][0][0] * r3 * g0.x, acc[ai][bj][m][0][1] * r3 * g0.y, acc[ai][bj][m][0][2] * r3 * g0.z, acc[ai][bj][m][0][3] * r3 * g0.w);
                    *(float4*)(out + o + 4) = make_float4(acc[ai][bj][m][1][0] * r3 * g1.x, acc[ai][bj][m][1][1] * r3 * g1.y, acc[ai][bj][m][1][2] * r3 * g1.z, acc[ai][bj][m][1][3] * r3 * g1.w);
                }
            }
    }
};
struct MoeOrder {
    const int* cnt; int NJ, G, c;
    DI bool next(int i, pg8::Unit& u) const {
        int L = i * G + c, tb = 0;
        for (int e = 0; e < 16; ++e) { const int mt = (cnt[e * CNT_STRIDE] + 255) >> 8, n = mt * NJ; if (L < n) { u.pm = tb + L / NJ; u.pn = e * NJ + L % NJ; u.aux = L / NJ; return true; } L -= n; tb += mt; }
        return false;
    }
    DI void a_ready(const pg8::Unit&) const {}
    DI void done(const pg8::Unit&) const {}
};
struct TwoUnits { int pm, pn0, aux; DI bool next(int i, pg8::Unit& o) const { o.pm = pm; o.pn = pn0 + i; o.aux = aux; return i < 2; } DI void a_ready(const pg8::Unit&) const {} DI void done(const pg8::Unit&) const {} };
struct FourUnits { int pm, pn0; DI bool next(int i, pg8::Unit& o) const { o.pm = pm; o.pn = pn0 + i; o.aux = 0; return i < 4; } DI void a_ready(const pg8::Unit&) const {} DI void done(const pg8::Unit&) const {} };
struct OneUnit { pg8::Unit u; DI bool next(int i, pg8::Unit& o) const { o = u; return i == 0; } DI void a_ready(const pg8::Unit&) const {} DI void done(const pg8::Unit&) const {} };
struct PPOrder { int extra, G, c; DI bool next(int i, pg8::Unit& u) const { const int nl = G - extra, li = c - extra; if (li < 0 || nl <= 0) return false; const int id = li + i * nl; if (id >= 256) return false; u.pm = id >> 2; u.pn = id & 3; u.aux = 0; return true; }
    DI void a_ready(const pg8::Unit&) const {} DI void done(const pg8::Unit&) const {} };
DI int moe_base_row(const int* cnt, int e) { int tb = 0; for (int k = 0; k < 16; ++k) { if (k < e) tb += (cnt[k * CNT_STRIDE] + 255) >> 8; } return tb * 256; }
struct MapId { DI int operator()(int n) const { return n; } };
struct MapE13 { DI int operator()(int n) const { return ((n >> 7) & 1) * 256 + (n >> 8) * 128 + (n & 127); } };

DI void router_stage(__attribute__((address_space(3))) float* Wl, const float* __restrict__ g, const float* __restrict__ w_rg, const float* __restrict__ w_re, int tx) {
    for (int e = tx; e < 4096; e += 512) { const int k = e >> 2, c = e & 3; Wl[c * 1024 + k] = w_rg[e] * g[k]; }
    for (int e = tx; e < 16384; e += 512) { const int k = e >> 4, c = e & 15; Wl[(4 + c) * 1024 + k] = w_re[e] * g[k]; }
}
typedef float f4v __attribute__((ext_vector_type(4)));
DI float dpp_row_sum(float v) {
    v += __builtin_bit_cast(float, __builtin_amdgcn_update_dpp(0, __builtin_bit_cast(int, v), 0xB1, 0xf, 0xf, true));
    v += __builtin_bit_cast(float, __builtin_amdgcn_update_dpp(0, __builtin_bit_cast(int, v), 0x4E, 0xf, 0xf, true));
    v += __builtin_bit_cast(float, __builtin_amdgcn_update_dpp(0, __builtin_bit_cast(int, v), 0x141, 0xf, 0xf, true));
    v += __builtin_bit_cast(float, __builtin_amdgcn_update_dpp(0, __builtin_bit_cast(int, v), 0x140, 0xf, 0xf, true));
    return v;
}
DI void router4(const int (&tok)[4], int lane, const f4v (&xv)[16], const __attribute__((address_space(3))) float* Wl, const float* __restrict__ b_rg, const float* __restrict__ b_re,
                float* __restrict__ rstd1, __attribute__((address_space(3))) int* lcnt, __attribute__((address_space(3))) int* lri) {
    const int g = lane >> 4, p = lane & 15;
    float s = 0.f;
#pragma unroll
    for (int j = 0; j < 16; ++j) s += (xv[j].x * xv[j].x + xv[j].y * xv[j].y) + (xv[j].z * xv[j].z + xv[j].w * xv[j].w);
    const float rstd = rsqrtf(dpp_row_sum(s) * (1.f / DM) + 1e-6f);
    float al[20];
#pragma unroll
    for (int c = 0; c < 20; ++c) {
        float a = 0.f;
#pragma unroll
        for (int j = 0; j < 16; ++j) { const f4v w = *(const __attribute__((address_space(3))) f4v*)(Wl + c * 1024 + 4 * (p + 16 * j)); a += (xv[j].x * w.x + xv[j].y * w.y) + (xv[j].z * w.z + xv[j].w * w.w); }
        al[c] = dpp_row_sum(a);
    }
    float gl[4], el[16];
#pragma unroll
    for (int c = 0; c < 4; ++c) gl[c] = al[c] * rstd + b_rg[c];
#pragma unroll
    for (int c = 0; c < 16; ++c) el[c] = al[4 + c] * rstd + b_re[c];
    if (p == 0) {
        int gs = 0; float gm = gl[0];
#pragma unroll
        for (int c = 1; c < 4; ++c) if (gl[c] > gm) { gm = gl[c]; gs = c; }
        float se = 0.f;
#pragma unroll
        for (int c = 0; c < 4; ++c) se += __expf(gl[c] - gm);
        const float pg = 1.f / se;
        float e4[4];
#pragma unroll
        for (int c = 0; c < 4; ++c) e4[c] = gs == 0 ? el[c] : gs == 1 ? el[4 + c] : gs == 2 ? el[8 + c] : el[12 + c];
        int i0 = 0; float v0 = e4[0];
#pragma unroll
        for (int c = 1; c < 4; ++c) if (e4[c] > v0) { v0 = e4[c]; i0 = c; }
        int i1 = -1; float v1 = -3.0e38f;
#pragma unroll
        for (int c = 0; c < 4; ++c) if (c != i0 && e4[c] > v1) { v1 = e4[c]; i1 = c; }
        const float ex = __expf(v1 - v0);
        const float w0 = pg / (1.f + ex), w1 = pg * ex / (1.f + ex);
        const int e0 = gs * 4 + i0, e1 = gs * 4 + i1;
        const int p0 = __hip_atomic_fetch_add(lcnt + e0, 1, __ATOMIC_RELAXED, __HIP_MEMORY_SCOPE_WORKGROUP), p1 = __hip_atomic_fetch_add(lcnt + e1, 1, __ATOMIC_RELAXED, __HIP_MEMORY_SCOPE_WORKGROUP);
        const int tk = g == 0 ? tok[0] : g == 1 ? tok[1] : g == 2 ? tok[2] : tok[3];
        rstd1[tk] = rstd;
        lri[g * 4 + 0] = e0 | (e1 << 8); lri[g * 4 + 1] = p0 | (p1 << 16); lri[g * 4 + 2] = __float_as_int(w0); lri[g * 4 + 3] = __float_as_int(w1);
    }
}

struct BMapId { DI int operator()(int n) const { return n; } };
struct BMapMoe { DI int operator()(int n) const { const int t = n >> 7, c = n & 127, e = t >> 2, jt = t & 3; return e * (1024 * 512) + ((c >> 5) & 1) * 256 + jt * 64 + (c >> 6) * 32 + (c & 31); } };
template <class Epi, class BMap>
DI void gemm_v1(int bx, int by, int tid, char* sm, const bf16_t* __restrict__ A, int lda, const float* __restrict__ B, int ldb, int N, int K, Epi epi, BMap bmap) {
    bf16_t* As = (bf16_t*)sm;
    bf16_t* Bs = (bf16_t*)(sm + 128 * 40 * 2);
    const int lane = tid & 63, w = tid >> 6, wr = w >> 1, wc = w & 1, r32 = lane & 31, hi = lane >> 5;
    const int m0 = by * 128, n0 = bx * 128;
    f32x16 acc[2][2];
#pragma unroll
    for (int i = 0; i < 2; ++i)
#pragma unroll
        for (int j = 0; j < 2; ++j)
#pragma unroll
            for (int r = 0; r < 16; ++r) acc[i][j][r] = 0.f;
    for (int k0 = 0; k0 < K; k0 += 32) {
#pragma unroll
        for (int i = 0; i < 2; ++i) {
            const int c = tid + i * 256, row = c >> 2, col = (c & 3) * 8;
            const uint4 v = *(const uint4*)(A + (size_t)(m0 + row) * lda + k0 + col);
            *(uint4*)(As + row * 40 + col) = v;
        }
#pragma unroll
        for (int i = 0; i < 4; ++i) {
            const int idx = tid + i * 256, k = idx >> 5, n = (idx & 31) * 4;
            float4 v = make_float4(0.f, 0.f, 0.f, 0.f);
            if (n0 + n < N) v = *(const float4*)(B + (size_t)(k0 + k) * ldb + bmap(n0 + n));
            Bs[(n + 0) * 40 + k] = f2bf(v.x); Bs[(n + 1) * 40 + k] = f2bf(v.y); Bs[(n + 2) * 40 + k] = f2bf(v.z); Bs[(n + 3) * 40 + k] = f2bf(v.w);
        }
        __syncthreads();
#pragma unroll
        for (int kk = 0; kk < 32; kk += 16) {
            bf16x8 a[2], b[2];
#pragma unroll
            for (int i = 0; i < 2; ++i) a[i] = *(const bf16x8*)(As + (wr * 64 + i * 32 + r32) * 40 + kk + hi * 8);
#pragma unroll
            for (int j = 0; j < 2; ++j) b[j] = *(const bf16x8*)(Bs + (wc * 64 + j * 32 + r32) * 40 + kk + hi * 8);
#pragma unroll
            for (int i = 0; i < 2; ++i)
#pragma unroll
                for (int j = 0; j < 2; ++j) acc[i][j] = __builtin_amdgcn_mfma_f32_32x32x16_bf16(a[i], b[j], acc[i][j], 0, 0, 0);
        }
        __syncthreads();
    }
#pragma unroll
    for (int i = 0; i < 2; ++i)
#pragma unroll
        for (int j = 0; j < 2; ++j)
#pragma unroll
            for (int r = 0; r < 16; ++r) {
                const int row = m0 + wr * 64 + i * 32 + (r & 3) + 8 * (r >> 2) + 4 * hi;
                const int col = n0 + wc * 64 + j * 32 + r32;
                if constexpr (Epi::PAIR) { if (j == 0) epi.pair(row, col, acc[i][0][r], acc[i][1][r]); }
                else { if (col < N) epi(row, col, acc[i][j][r]); }
            }
}

struct EpiPa { static constexpr bool PAIR = false;
    const bf16_t* MG; float* tmp;
    DI void operator()(int row, int col, float v) const { tmp[(size_t)row * DM + col] = bf2f(MG[(size_t)row * 2048 + col]) * v; }
};
struct EpiPb { static constexpr bool PAIR = false;
    const bf16_t* MG; const float* tmp; bf16_t* mixed;
    DI void operator()(int row, int col, float v) const {
        mixed[(size_t)row * DM + col] = f2bf(tmp[(size_t)row * DM + col] + bf2f(MG[(size_t)row * 2048 + 1024 + col]) * v);
    }
};
struct EpiResid { static constexpr bool PAIR = false;
    const float* base; float* out;
    DI void operator()(int row, int col, float v) const { out[(size_t)row * DM + col] = base[(size_t)row * DM + col] + v; }
};
struct EpiBf { static constexpr bool PAIR = false;
    bf16_t* o; int ld;
    DI void operator()(int row, int col, float v) const { o[(size_t)row * ld + col] = f2bf(v); }
};
struct EpiF32 { static constexpr bool PAIR = false;
    float* o; int ld;
    DI void operator()(int row, int col, float v) const { o[(size_t)row * ld + col] = v; }
};
struct EpiPle { static constexpr bool PAIR = false;
    float* x; const float* pp;
    DI void operator()(int row, int col, float v) const { const size_t i = (size_t)row * DM + col; x[i] = x[i] + sigmoidf_(v) * pp[i]; }
};

DI void rmsnorm_rows(int bx, int tid, const float* x, const float* __restrict__ g, bf16_t* outb, float* outf, int rows) {
    const int row = bx * 4 + (tid >> 6), lane = tid & 63;
    if (row >= rows) return;
    const float4* xr = (const float4*)(x + (size_t)row * DM);
    float4 v[4]; float s = 0.f;
#pragma unroll
    for (int j = 0; j < 4; ++j) { v[j] = xr[lane + 64 * j]; s += v[j].x * v[j].x + v[j].y * v[j].y + v[j].z * v[j].z + v[j].w * v[j].w; }
    const float rstd = rsqrtf(wave_sum(s) * (1.f / DM) + 1e-6f);
#pragma unroll
    for (int j = 0; j < 4; ++j) {
        const float4 gg = ((const float4*)g)[lane + 64 * j];
        const float a = v[j].x * rstd * gg.x, b = v[j].y * rstd * gg.y, c = v[j].z * rstd * gg.z, d = v[j].w * rstd * gg.w;
        if (outf) ((float4*)(outf + (size_t)row * DM))[lane + 64 * j] = make_float4(a, b, c, d);
        else { ushort4 o; o.x = f2bf(a); o.y = f2bf(b); o.z = f2bf(c); o.w = f2bf(d); ((ushort4*)(outb + (size_t)row * DM))[lane + 64 * j] = o; }
    }
}

DI void cvt_bf16(int bx, int nb, int tid, const float* __restrict__ in, bf16_t* __restrict__ out, size_t n) {
    for (size_t i = bx * (size_t)256 + tid; i < n; i += (size_t)nb * 256) out[i] = f2bf(in[i]);
}

DI float gelu_tanh(float x) { const float u = 0.7978845608028654f * (x + 0.044715f * x * x * x); return 0.5f * x * (1.f + tanhf(u)); }

DI void compress_naive(int bx, int by, int bz, int tid, char* sm, const bf16_t* __restrict__ KVb, const float* __restrict__ w1k, const float* __restrict__ w2k, const float* __restrict__ pek,
                                                      const float* __restrict__ w1v, const float* __restrict__ w2v, const float* __restrict__ pev, float* __restrict__ outk, float* __restrict__ outv, bf16_t* __restrict__ kcb, bf16_t* __restrict__ vcT) {
    float* flat = (float*)sm;
    float* h1 = flat + 2048;
    __syncthreads();
    const int j = bx, bg = by, kv = bz, b = bg >> 1, g = bg & 1;
    const float* w1 = kv ? w1v : w1k; const float* w2 = kv ? w2v : w2k; const float* pe = kv ? pev : pek; float* out = kv ? outv : outk;
    const int colbase = (kv ? 128 : 0) + g * 64;
    for (int e = tid; e < 2048; e += 256) {
        const int i = e >> 6, d = e & 63;
        flat[e] = bf2f(KVb[(size_t)(b * SEQ + 16 * j + i) * 512 + colbase + d]) + pe[e];
    }
    __syncthreads();
    float s = 0.f;
    for (int k = 0; k < 2048; ++k) s += flat[k] * w1[(size_t)k * 256 + tid];
    h1[tid] = gelu_tanh(s);
    __syncthreads();
    if (tid < 64) {
        float o = 0.f;
        for (int n = 0; n < 256; ++n) o += h1[n] * w2[n * 64 + tid];
        out[((size_t)bg * 256 + j) * 64 + tid] = o;
        if (kv == 0) { kcb[((size_t)bg * 256 + j) * 64 + tid] = f2bf(o); if (j == 254) kcb[((size_t)bg * 256 + 255) * 64 + tid] = 0; }
        else { vcT[((size_t)bg * 4 + (j >> 6)) * 4096 + tid * 64 + (j & 63)] = f2bf(o); if (j == 254) vcT[((size_t)bg * 4 + 3) * 4096 + tid * 64 + 63] = 0; }
    }
}

DI void softmax_row(float* row, int n, int lane) {
    float m = -3.0e38f;
    for (int j = lane; j < n; j += 64) m = fmaxf(m, row[j]);
    m = wave_max(m);
    float s = 0.f;
    for (int j = lane; j < n; j += 64) { const float e = exp2f(row[j] - m); row[j] = e; s += e; }
    s = wave_sum(s);
    const float inv = 1.f / s;
    for (int j = lane; j < n; j += 64) row[j] *= inv;
}

DI void nsa_naive(int bx, int by, int tid, char* sm, const bf16_t* __restrict__ Qb, const bf16_t* __restrict__ KVb, const bf16_t* __restrict__ VT, const float* __restrict__ kcc, const float* __restrict__ vcc, const float* __restrict__ gates, bf16_t* __restrict__ Y) {
    float (*q)[64] = (float (*)[64])sm;
    float (*sc)[1024] = (float (*)[1024])(sm + 1024);
    float* impv = (float*)(sm + 1024 + 16384);
    int* sellist = (int*)(sm + 1024 + 16384 + 256);
    int* selflag = (int*)(sm + 1024 + 16384 + 256 + 64);
    int& nsel_s = *(int*)(sm + 1024 + 16384 + 256 + 64 + 256);
    __syncthreads();
    const int tok = bx, g = by, b = tok >> 12, t = tok & 4095, hh = tid >> 6, lane = tid & 63, d = lane;
    q[hh][d] = bf2f(Qb[(size_t)tok * 512 + (g * 4 + hh) * 64 + d]);
    __syncthreads();
    const int nv = (t >= 31) ? ((t - 15) >> 4) : 0;
    const float* kcb = kcc + (size_t)(b * 2 + g) * 256 * 64; const float* vcb = vcc + (size_t)(b * 2 + g) * 256 * 64;
    if (tid < nv) {
        float s0 = 0.f, s1 = 0.f, s2 = 0.f, s3 = 0.f;
#pragma unroll 8
        for (int dd = 0; dd < 64; ++dd) { const float kx = kcb[tid * 64 + dd]; s0 += q[0][dd] * kx; s1 += q[1][dd] * kx; s2 += q[2][dd] * kx; s3 += q[3][dd] * kx; }
        sc[0][tid] = s0; sc[1][tid] = s1; sc[2][tid] = s2; sc[3][tid] = s3;
    }
    __syncthreads();
    if (nv > 0) softmax_row(sc[hh], nv, lane);
    for (int j = nv + lane; j < 256; j += 64) sc[hh][j] = 0.f;
    __syncthreads();
    float o_cmp = 0.f;
    for (int j = 0; j < nv; ++j) o_cmp += sc[hh][j] * vcb[j * 64 + d];
    const int cur = t >> 6;
    if (tid < 64) {
        const int s = tid; int lo = 4 * s - 1; if (lo < 0) lo = 0; int hi2 = 4 * s + 3; if (hi2 > 254) hi2 = 254;
        float v = 0.f;
        for (int h2 = 0; h2 < 4; ++h2) for (int j = lo; j <= hi2; ++j) v += sc[h2][j];
        if (s == 0 || s == cur || s == cur - 1) v += 1000.0f;
        if (s > cur) v = -1e30f;
        impv[s] = v;
    }
    __syncthreads();
    if (tid < 64) {
        const float v = impv[tid]; int rank = 0;
        for (int s2 = 0; s2 < 64; ++s2) { const float u = impv[s2]; rank += (u > v || (u == v && s2 < tid)) ? 1 : 0; }
        selflag[tid] = (rank < 16 && tid <= cur) ? 1 : 0;
    }
    __syncthreads();
    if (tid == 0) { int n = 0; for (int s = 0; s < 64; ++s) if (selflag[s]) { if (n < 16) sellist[n] = s; ++n; } nsel_s = n < 16 ? n : 16; }
    __syncthreads();
    const int ns = nsel_s, ne = ns * 64;
    for (int e = tid; e < ne; e += 256) {
        const int kpos = sellist[e >> 6] * 64 + (e & 63);
        if (kpos <= t) {
            const bf16_t* kp = KVb + (size_t)(b * SEQ + kpos) * 512 + 256 + g * 64;
            float s0 = 0.f, s1 = 0.f, s2 = 0.f, s3 = 0.f;
    #pragma unroll 8
        for (int dd = 0; dd < 64; ++dd) { const float kx = bf2f(kp[dd]); s0 += q[0][dd] * kx; s1 += q[1][dd] * kx; s2 += q[2][dd] * kx; s3 += q[3][dd] * kx; }
            sc[0][e] = s0; sc[1][e] = s1; sc[2][e] = s2; sc[3][e] = s3;
        } else { sc[0][e] = -1e30f; sc[1][e] = -1e30f; sc[2][e] = -1e30f; sc[3][e] = -1e30f; }
    }
    __syncthreads();
    softmax_row(sc[hh], ne, lane);
    __syncthreads();
    float o_sel = 0.f;
    for (int e = 0; e < ne; ++e) {
        const int kpos = sellist[e >> 6] * 64 + (e & 63);
        o_sel += sc[hh][e] * bf2f(VT[((size_t)(b * 2 + g) * 64 + (kpos >> 6)) * 4096 + d * 64 + (kpos & 63)]);
    }
    __syncthreads();
    const int nw = (t + 1 < 512) ? (t + 1) : 512, w0 = t - nw + 1;
    for (int e = tid; e < nw; e += 256) {
        const bf16_t* kp = KVb + (size_t)(b * SEQ + w0 + e) * 512 + 384 + g * 64;
        float s0 = 0.f, s1 = 0.f, s2 = 0.f, s3 = 0.f;
#pragma unroll 8
        for (int dd = 0; dd < 64; ++dd) { const float kx = bf2f(kp[dd]); s0 += q[0][dd] * kx; s1 += q[1][dd] * kx; s2 += q[2][dd] * kx; s3 += q[3][dd] * kx; }
        sc[0][e] = s0; sc[1][e] = s1; sc[2][e] = s2; sc[3][e] = s3;
    }
    __syncthreads();
    softmax_row(sc[hh], nw, lane);
    __syncthreads();
    float o_win = 0.f;
    for (int e = 0; e < nw; ++e) { const int kpos = w0 + e; o_win += sc[hh][e] * bf2f(VT[((size_t)(8 + b * 2 + g) * 64 + (kpos >> 6)) * 4096 + d * 64 + (kpos & 63)]); }
    const float* gt = gates + (size_t)tok * 24 + (g * 4 + hh) * 3;
    Y[(size_t)tok * DM + (g * 4 + hh) * 64 + d] = f2bf(gt[0] * o_cmp + gt[1] * o_sel + gt[2] * o_win);
}

DI void conv_silu(int bx, int tid, const bf16_t* __restrict__ MQK, const float* __restrict__ wc, const float* __restrict__ bc, bf16_t* __restrict__ out) {
    const int idx = bx * 256 + tid;
    if (idx >= T_TOK * 1024) return;
    const int c = idx & 1023, tok = idx >> 10, t = tok & 4095;
    float y = bc[c];
#pragma unroll
    for (int j = 0; j < 4; ++j) { const int tt = t - 3 + j; if (tt >= 0) y += wc[j * 1024 + c] * bf2f(MQK[(size_t)(tok - 3 + j) * 1024 + c]); }
    y = y * sigmoidf_(y);
    if (c >= 512) y *= 0.08838834764831845f;
    out[idx] = f2bf(y);
}

DI void mlstm_naive(int bx, int tid, char* sm, const bf16_t* __restrict__ qkc, const bf16_t* __restrict__ MV, const bf16_t* __restrict__ MO, const float* __restrict__ ifp, float* __restrict__ hm) {
    float (*qs)[128] = (float (*)[128])sm;
    float (*ks)[128] = (float (*)[128])(sm + 16384);
    float (*vs)[16] = (float (*)[16])(sm + 32768);
    float (*os)[16] = (float (*)[16])(sm + 32768 + 2048);
    float* gi = (float*)(sm + 32768 + 4096); float* gf = gi + 32;
    const int bh = bx >> 3, vsl = bx & 7, b = bh >> 2, h = bh & 3, v = tid >> 4, kg = tid & 15;
    float C[8], n[8];
#pragma unroll
    for (int j = 0; j < 8; ++j) { C[j] = 0.f; n[j] = 0.f; }
    for (int c0 = 0; c0 < SEQ; c0 += 32) {
        __syncthreads();
        for (int e = tid; e < 32 * 128; e += 256) {
            const int s = e >> 7, k = e & 127; const size_t tok = (size_t)b * SEQ + c0 + s;
            qs[s][k] = bf2f(qkc[tok * 1024 + h * 128 + k]); ks[s][k] = bf2f(qkc[tok * 1024 + 512 + h * 128 + k]);
        }
        for (int e = tid; e < 32 * 16; e += 256) {
            const int s = e >> 4, vv = e & 15; const size_t tok = (size_t)b * SEQ + c0 + s;
            vs[s][vv] = bf2f(MV[tok * 512 + h * 128 + vsl * 16 + vv]);
            os[s][vv] = sigmoidf_(bf2f(MO[tok * 512 + h * 128 + vsl * 16 + vv]));
        }
        if (tid < 32) { const size_t tok = (size_t)b * SEQ + c0 + tid; gi[tid] = __expf(ifp[tok * 8 + h]); gf[tid] = sigmoidf_(ifp[tok * 8 + 4 + h]); }
        __syncthreads();
        for (int s = 0; s < 32; ++s) {
            const float f = gf[s], iv = gi[s] * vs[s][v], ig = gi[s];
            float num = 0.f, den = 0.f;
#pragma unroll
            for (int j = 0; j < 8; ++j) {
                const float kx = ks[s][kg * 8 + j], qx = qs[s][kg * 8 + j];
                C[j] = f * C[j] + iv * kx; n[j] = f * n[j] + ig * kx;
                num += C[j] * qx; den += n[j] * qx;
            }
            const int l_ = lane_id_opaque();
#pragma unroll
            for (int o = 1; o < 16; o <<= 1) { num += lane_xor(num, o, l_); den += lane_xor(den, o, l_); }
            if (kg == 0) hm[((size_t)b * SEQ + c0 + s) * 512 + h * 128 + vsl * 16 + v] = num / fmaxf(fabsf(den), 1.0f) * os[s][v];
        }
    }
}

DI void hnorm(int bx, int tid, const float* __restrict__ hm, const float* __restrict__ g_hn, bf16_t* __restrict__ Y) {
    const int item = bx * 4 + (tid >> 6), lane = tid & 63;
    const int tok = item >> 2, h = item & 3;
    const float a = hm[(size_t)tok * 512 + h * 128 + lane], b = hm[(size_t)tok * 512 + h * 128 + 64 + lane];
    const float rstd = rsqrtf(wave_sum(a * a + b * b) * (1.f / 128.f) + 1e-6f);
    Y[(size_t)tok * DM + 512 + h * 128 + lane] = f2bf(a * rstd * g_hn[h * 128 + lane]);
    Y[(size_t)tok * DM + 512 + h * 128 + 64 + lane] = f2bf(b * rstd * g_hn[h * 128 + 64 + lane]);
}

DI void router(int bx, int tid, const float* __restrict__ x, const float* __restrict__ g, const float* __restrict__ w_rg, const float* __restrict__ b_rg,
                                              const float* __restrict__ w_re, const float* __restrict__ b_re, bf16_t* __restrict__ xn, float* __restrict__ gate) {
    const int tok = bx * 4 + (tid >> 6), lane = tid & 63;
    float xv[16]; float s = 0.f;
#pragma unroll
    for (int j = 0; j < 4; ++j) { const float4 v = ((const float4*)(x + (size_t)tok * DM))[lane + 64 * j]; xv[4 * j] = v.x; xv[4 * j + 1] = v.y; xv[4 * j + 2] = v.z; xv[4 * j + 3] = v.w; s += v.x * v.x + v.y * v.y + v.z * v.z + v.w * v.w; }
    const float rstd = rsqrtf(wave_sum(s) * (1.f / DM) + 1e-6f);
#pragma unroll
    for (int j = 0; j < 4; ++j) { const float4 gg = ((const float4*)g)[lane + 64 * j]; xv[4 * j] *= rstd * gg.x; xv[4 * j + 1] *= rstd * gg.y; xv[4 * j + 2] *= rstd * gg.z; xv[4 * j + 3] *= rstd * gg.w;
        ushort4 o; o.x = f2bf(xv[4 * j]); o.y = f2bf(xv[4 * j + 1]); o.z = f2bf(xv[4 * j + 2]); o.w = f2bf(xv[4 * j + 3]); ((ushort4*)(xn + (size_t)tok * DM))[lane + 64 * j] = o; }
    float mylog = 0.f;
#pragma unroll 1
    for (int c = 0; c < 20; ++c) {
        const float* w = c < 4 ? w_rg + c : w_re + (c - 4); const int ld = c < 4 ? 4 : 16;
        float a = 0.f;
#pragma unroll
        for (int j = 0; j < 4; ++j)
#pragma unroll
            for (int i = 0; i < 4; ++i) a += xv[4 * j + i] * w[(size_t)(4 * (lane + 64 * j) + i) * ld];
        a = wave_sum(a) + (c < 4 ? b_rg[c] : b_re[c - 4]);
        if (lane == c) mylog = a;
    }
    float gl[4], el[16];
#pragma unroll
    for (int c = 0; c < 4; ++c) gl[c] = lane_get(mylog, c);
#pragma unroll
    for (int c = 0; c < 16; ++c) el[c] = lane_get(mylog, 4 + c);
    if (lane == 0) {
        int gs = 0; float gm = gl[0];
#pragma unroll
        for (int c = 1; c < 4; ++c) if (gl[c] > gm) { gm = gl[c]; gs = c; }
        float se = 0.f;
#pragma unroll
        for (int c = 0; c < 4; ++c) se += __expf(gl[c] - gm);
        const float pg = 1.f / se;
        float e4[4];
#pragma unroll
        for (int c = 0; c < 4; ++c) e4[c] = gs == 0 ? el[c] : gs == 1 ? el[4 + c] : gs == 2 ? el[8 + c] : el[12 + c];
        int i0 = 0; float v0 = e4[0];
#pragma unroll
        for (int c = 1; c < 4; ++c) if (e4[c] > v0) { v0 = e4[c]; i0 = c; }
        int i1 = -1; float v1 = -3.0e38f;
#pragma unroll
        for (int c = 0; c < 4; ++c) if (c != i0 && e4[c] > v1) { v1 = e4[c]; i1 = c; }
        const float ex = __expf(v1 - v0);
        const float w0 = pg / (1.f + ex), w1 = pg * ex / (1.f + ex);
#pragma unroll
        for (int c = 0; c < 16; ++c) gate[(size_t)tok * 16 + c] = (c == gs * 4 + i0) ? w0 : (c == gs * 4 + i1) ? w1 : 0.f;
    }
}


struct EpiMoe { static constexpr bool PAIR = true;
    const float* gate; bf16_t* act;
    DI void operator()(int, int, float) const {}
    DI void pair(int row, int col, float gg, float u) const {
        const int t = col >> 7, c = col & 127, e = t >> 2, jt = t & 3, f = jt * 64 + (c >> 6) * 32 + (c & 31);
        act[(size_t)row * 4096 + e * 256 + f] = f2bf(gg * sigmoidf_(gg) * u * gate[(size_t)row * 16 + e]);
    }
};

typedef float f32x2_t __attribute__((ext_vector_type(2))); typedef __bf16 bf16x2_t __attribute__((ext_vector_type(2)));
DI unsigned cvtpk(float lo, float hi) { f32x2_t v = {lo, hi}; bf16x2_t b = __builtin_convertvector(v, bf16x2_t); return __builtin_bit_cast(unsigned, b); }
typedef __attribute__((address_space(3))) char lds_c;
typedef unsigned u32x2v __attribute__((ext_vector_type(2))); typedef unsigned u32x4v __attribute__((ext_vector_type(4)));
constexpr int NSA_KC = 0, NSA_VC = 4 * 9216, NSA_KB = NSA_VC + 4 * 8704, NSA_VB = NSA_KB + 2 * 9216, NSA_IMP = NSA_VB + 2 * 8704, NSA_MASK = NSA_IMP + 64 * 65 * 4, NSA_END = NSA_MASK + 512;
static_assert(NSA_END <= 147456, "NSA LDS map");
DI int crow(int r, int hi) { return (r & 3) + 8 * (r >> 2) + 4 * hi; }
#define MFMA32(a, b, c) __builtin_amdgcn_mfma_f32_32x32x16_bf16((a), (b), (c), 0, 0, 0)

DI void nsa_qk(f32x16& p0, f32x16& p1, const lds_c* K, const bf16x8 (&qf)[4], float cin, int r32, int hi) {
    f32x16 c;
#pragma unroll
    for (int r = 0; r < 16; ++r) c[r] = cin;
#pragma unroll
    for (int ks = 0; ks < 4; ++ks) {
        const bf16x8 a0 = *(const __attribute__((address_space(3))) bf16x8*)(K + r32 * 144 + ks * 32 + hi * 16);
        const bf16x8 a1 = *(const __attribute__((address_space(3))) bf16x8*)(K + (32 + r32) * 144 + ks * 32 + hi * 16);
        if (ks == 0) { p0 = MFMA32(a0, qf[0], c); p1 = MFMA32(a1, qf[0], c); } else { p0 = MFMA32(a0, qf[ks], p0); p1 = MFMA32(a1, qf[ks], p1); }
    }
}
DI void nsa_softmax(f32x16& p0, f32x16& p1, float& mref, float& l, bool& started, f32x16& o0, f32x16& o1) {
    float mx = fmaxf(p0[0], p1[0]);
#pragma unroll
    for (int r = 1; r < 16; ++r) mx = fmaxf(mx, fmaxf(p0[r], p1[r]));
    { auto rr = __builtin_amdgcn_permlane32_swap(__float_as_uint(mx), __float_as_uint(mx), false, false); mx = fmaxf(__uint_as_float(rr[0]), __uint_as_float(rr[1])); }
    const bool need = started ? (mx > 8.f) : (mx > -3.0e38f);
    if (__any(need)) {
        const float delta = need ? mx : 0.f, f = started ? __builtin_amdgcn_exp2f(-delta) : 1.f;
        mref += delta;
#pragma unroll
        for (int r = 0; r < 16; ++r) { p0[r] -= delta; p1[r] -= delta; o0[r] *= f; o1[r] *= f; }
        l *= f; started = started || need;
    }
    float s = 0.f;
#pragma unroll
    for (int r = 0; r < 16; ++r) { p0[r] = __builtin_amdgcn_exp2f(p0[r]); p1[r] = __builtin_amdgcn_exp2f(p1[r]); s += p0[r] + p1[r]; }
    l += s;
}
DI void nsa_pv(f32x16& o0, f32x16& o1, const f32x16& p0, const f32x16& p1, const lds_c* V, int r32, int hi) {
#pragma unroll
    for (int hf = 0; hf < 2; ++hf)
#pragma unroll
        for (int s = 0; s < 2; ++s) {
            unsigned pw[4];
#pragma unroll
            for (int j = 0; j < 4; ++j) pw[j] = hf ? cvtpk(p1[8 * s + 2 * j], p1[8 * s + 2 * j + 1]) : cvtpk(p0[8 * s + 2 * j], p0[8 * s + 2 * j + 1]);
            const u32x4v pbw = {pw[0], pw[1], pw[2], pw[3]};
            const bf16x8 pb = __builtin_bit_cast(bf16x8, pbw);
            const lds_c* vp = V + r32 * 136 + hf * 64 + s * 32 + hi * 8;
            const u32x2v a0l = *(const __attribute__((address_space(3))) u32x2v*)(vp), a0h = *(const __attribute__((address_space(3))) u32x2v*)(vp + 16);
            const u32x2v a1l = *(const __attribute__((address_space(3))) u32x2v*)(vp + 32 * 136), a1h = *(const __attribute__((address_space(3))) u32x2v*)(vp + 32 * 136 + 16);
            const u32x4v A0w = {a0l.x, a0l.y, a0h.x, a0h.y}, A1w = {a1l.x, a1l.y, a1h.x, a1h.y};
            o0 = MFMA32(__builtin_bit_cast(bf16x8, A0w), pb, o0); o1 = MFMA32(__builtin_bit_cast(bf16x8, A1w), pb, o1);
        }
}
DI void nsa_store_k(lds_c* K, const u32x4v v, int tid) { *(__attribute__((address_space(3))) u32x4v*)(K + (tid >> 3) * 144 + (tid & 7) * 16) = v; }
DI void nsa_store_v(lds_c* V, const u32x4v v, int tid) { lds_c* p = V + (tid >> 3) * 136 + (tid & 7) * 16; *(__attribute__((address_space(3))) u32x2v*)p = (u32x2v){v.x, v.y}; *(__attribute__((address_space(3))) u32x2v*)(p + 8) = (u32x2v){v.z, v.w}; }
#define NEG_INF (-__builtin_inff())
DI void nsa_finish(f32x16& y0, f32x16& y1, f32x16& o0, f32x16& o1, float& m, float& l, bool& started, float gate) {
    float lt; { auto rr = __builtin_amdgcn_permlane32_swap(__float_as_uint(l), __float_as_uint(l), false, false); lt = __uint_as_float(rr[0]) + __uint_as_float(rr[1]); }
    const float f = lt > 0.f ? gate / lt : 0.f;
#pragma unroll
    for (int r = 0; r < 16; ++r) { y0[r] += f * o0[r]; y1[r] += f * o1[r]; o0[r] = 0.f; o1[r] = 0.f; }
    m = 0.f; l = 0.f; started = false;
}

DI void nsa_unit(int bg, int qb, int tx, lds_c* lds, const bf16_t* __restrict__ Qb, const bf16_t* __restrict__ KVb, const bf16_t* __restrict__ VT, const bf16_t* __restrict__ kcb, const bf16_t* __restrict__ vcT,
                 const float* __restrict__ gates, bf16_t* __restrict__ Y, unsigned long long& pacc) {
    const int lane = tx & 63, r32 = lane & 31, hi = lane >> 5, wave = __builtin_amdgcn_readfirstlane(tx >> 6), hh = wave >> 1, qs = wave & 1;
    RG_BEGIN(100)
    const int b = bg >> 1, g = bg & 1, ql = 32 * qs + r32, tq = 64 * qb + ql;
    const size_t tok = (size_t)b * SEQ + tq; const int head = g * 4 + hh;
    const int nc = (4 * qb + 66) >> 6;
    const bool need_topk = qb >= 16;
    lds_c* KC = lds + NSA_KC; lds_c* VC = lds + NSA_VC; lds_c* KB = lds + NSA_KB; lds_c* VB = lds + NSA_VB;
    __attribute__((address_space(3))) float* imp = (__attribute__((address_space(3))) float*)(lds + NSA_IMP);
    __attribute__((address_space(3))) unsigned* msk = (__attribute__((address_space(3))) unsigned*)(lds + NSA_MASK);
    const bf16_t* kcsrc = kcb + (size_t)bg * 256 * 64; const bf16_t* vcsrc = vcT + (size_t)bg * 4 * 4096;
    const bf16_t* kssrc = KVb + (size_t)b * SEQ * 512 + 256 + g * 64; const bf16_t* kwsrc = KVb + (size_t)b * SEQ * 512 + 384 + g * 64;
    const bf16_t* vssrc = VT + (size_t)bg * 64 * 4096; const bf16_t* vwsrc = VT + (size_t)(8 + bg) * 64 * 4096;
    const int n_sel = qb + 1, n_win = qb + 1 < 9 ? qb + 1 : 9, ntile = n_sel + n_win;
    __syncthreads();
    for (int c = 0; c < nc; ++c) {
        nsa_store_k(KC + c * 9216, *(const u32x4v*)(kcsrc + (size_t)(c * 64 + (tx >> 3)) * 64 + (tx & 7) * 8), tx);
        nsa_store_v(VC + c * 8704, *(const u32x4v*)(vcsrc + (size_t)c * 4096 + (tx >> 3) * 64 + (tx & 7) * 8), tx);
    }
    nsa_store_k(KB, *(const u32x4v*)(kssrc + (size_t)(tx >> 3) * 512 + (tx & 7) * 8), tx);
    nsa_store_v(VB, *(const u32x4v*)(vssrc + (tx >> 3) * 64 + (tx & 7) * 8), tx);
    for (int i = tx; i < 64 * 65; i += 512) imp[i] = 0.f;
    bf16x8 qf[4];
#pragma unroll
    for (int ks = 0; ks < 4; ++ks) qf[ks] = *(const bf16x8*)(Qb + tok * 512 + head * 64 + ks * 16 + hi * 8);
    const float g_cmp = gates[tok * 24 + head * 3 + 0], g_sel = gates[tok * 24 + head * 3 + 1], g_win = gates[tok * 24 + head * 3 + 2];
    f32x16 y0, y1, o0, o1, p0, p1;
#pragma unroll
    for (int r = 0; r < 16; ++r) { y0[r] = 0.f; y1[r] = 0.f; o0[r] = 0.f; o1[r] = 0.f; }
    float m = 0.f, l = 0.f; bool started = false;
    __syncthreads();
    RG_END(100)
    RG_BEGIN(101)
    const int nvq = tq >= 31 ? ((tq - 15) >> 4) : 0;
    for (int c = 0; c < nc; ++c) {
        nsa_qk(p0, p1, KC + c * 9216, qf, -m, r32, hi);
        const int lim = nvq - 64 * c;
#pragma unroll
        for (int r = 0; r < 16; ++r) { const int kl = crow(r, hi); if (kl >= lim) p0[r] = NEG_INF; if (kl + 32 >= lim) p1[r] = NEG_INF; }
        nsa_softmax(p0, p1, m, l, started, o0, o1);
        nsa_pv(o0, o1, p0, p1, VC + c * 8704, r32, hi);
    }
    const float m_c = m; float l_c; { auto rr = __builtin_amdgcn_permlane32_swap(__float_as_uint(l), __float_as_uint(l), false, false); l_c = __uint_as_float(rr[0]) + __uint_as_float(rr[1]); }
    nsa_finish(y0, y1, o0, o1, m, l, started, g_cmp);
    RG_END(101)
    unsigned mlo = 0xffffffffu, mhi = 0xffffffffu;
    RG_BEGIN(102)
    if (need_topk) {
        const float invl = l_c > 0.f ? 16777216.f / l_c : 0.f;
        __attribute__((address_space(3))) unsigned* impu = (__attribute__((address_space(3))) unsigned*)imp;
        for (int c = 0; c < nc; ++c) {
            nsa_qk(p0, p1, KC + c * 9216, qf, -m_c, r32, hi);
            const int lim = nvq - 64 * c;
#pragma unroll
            for (int r = 0; r < 16; ++r) { const int kl = crow(r, hi);
                p0[r] = kl < lim ? __builtin_amdgcn_exp2f(p0[r]) * invl : 0.f; p1[r] = kl + 32 < lim ? __builtin_amdgcn_exp2f(p1[r]) * invl : 0.f; }
#pragma unroll
            for (int hf = 0; hf < 2; ++hf)
#pragma unroll
                for (int i = 0; i < 4; ++i) {
                    const int a = 16 * c + 8 * hf + 2 * i + hi;
                    const unsigned u0 = (unsigned)__float2uint_rn(hf ? p1[4 * i] : p0[4 * i]), u1 = (unsigned)__float2uint_rn(hf ? p1[4 * i + 1] : p0[4 * i + 1]);
                    const unsigned u2 = (unsigned)__float2uint_rn(hf ? p1[4 * i + 2] : p0[4 * i + 2]), u3 = (unsigned)__float2uint_rn(hf ? p1[4 * i + 3] : p0[4 * i + 3]);
                    __hip_atomic_fetch_add(impu + ql * 65 + a, u0 + u1 + u2 + u3, __ATOMIC_RELAXED, __HIP_MEMORY_SCOPE_WORKGROUP);
                    if (a + 1 < 64) __hip_atomic_fetch_add(impu + ql * 65 + a + 1, u3, __ATOMIC_RELAXED, __HIP_MEMORY_SCOPE_WORKGROUP);
                }
        }
        __syncthreads();
        RG_BEGIN(103)
        {
            const int q = tx >> 3, j8 = tx & 7, smax = qb - 2;
            unsigned key[8];
#pragma unroll
            for (int k = 0; k < 8; ++k) { const int sb = j8 + 8 * k; key[k] = (sb >= 1 && sb <= smax) ? ((impu[q * 65 + sb] & ~63u) | (unsigned)(63 - sb)) + 64u : 0u; }
            unsigned blo = 0u, bhi = 0u;
#pragma unroll 1
            for (int round = 0; round < 13; ++round) {
                unsigned mx = key[0];
#pragma unroll
                for (int k = 1; k < 8; ++k) mx = mx > key[k] ? mx : key[k];
                { const unsigned t = (unsigned)__builtin_amdgcn_update_dpp(0, (int)mx, 0xB1, 0xf, 0xf, true); mx = mx > t ? mx : t; }
                { const unsigned t = (unsigned)__builtin_amdgcn_update_dpp(0, (int)mx, 0x4E, 0xf, 0xf, true); mx = mx > t ? mx : t; }
                { const unsigned t = (unsigned)__builtin_amdgcn_update_dpp(0, (int)mx, 0x141, 0xf, 0xf, true); mx = mx > t ? mx : t; }
#pragma unroll
                for (int k = 0; k < 8; ++k) if (key[k] == mx && mx != 0u) { key[k] = 0u; const int sb = j8 + 8 * k; if (sb < 32) blo |= 1u << sb; else bhi |= 1u << (sb - 32); }
            }
            const int l_ = lane_id_opaque();
#pragma unroll
            for (int o = 1; o < 8; o <<= 1) { blo |= (unsigned)__builtin_amdgcn_ds_bpermute((l_ ^ o) << 2, (int)blo); bhi |= (unsigned)__builtin_amdgcn_ds_bpermute((l_ ^ o) << 2, (int)bhi); }
            unsigned long long mm = ((unsigned long long)bhi << 32) | blo;
            mm |= 1ull | (1ull << qb) | (1ull << (qb - 1));
            if (j8 == 0) { msk[q * 2] = (unsigned)mm; msk[q * 2 + 1] = (unsigned)(mm >> 32); }
        }
        __syncthreads();
        RG_END(103)
        mlo = msk[ql * 2]; mhi = msk[ql * 2 + 1];
    }
    RG_END(102)
    RG_BEGIN(104)
#define NSA_SRC(i_, KP, VP) do { const bool nsel_ = (i_) < n_sel; const int s2_ = nsel_ ? (i_) : qb - n_win + 1 + ((i_) - n_sel); \
        KP = (nsel_ ? kssrc : kwsrc) + (size_t)(s2_ * 64 + (tx >> 3)) * 512 + (tx & 7) * 8; VP = (nsel_ ? vssrc : vwsrc) + (size_t)s2_ * 4096 + (tx >> 3) * 64 + (tx & 7) * 8; } while (0)
#define NSA_TILE(i_, cur_, KLD, VLD, KST, VST) do { \
        const bool is_sel = (i_) < n_sel; const int s = is_sel ? (i_) : qb - n_win + 1 + ((i_) - n_sel); \
        if ((i_) + 2 < ntile) { const bf16_t* kp_; const bf16_t* vp_; NSA_SRC((i_) + 2, kp_, vp_); KLD = *(const u32x4v*)kp_; VLD = *(const u32x4v*)vp_; } \
        const bool on = !is_sel || ((s < 32 ? (mlo >> s) : (mhi >> (s - 32))) & 1u) != 0u; \
        nsa_qk(p0, p1, KB + (cur_) * 9216, qf, on ? -m : NEG_INF, r32, hi); \
        const bool lowb = !is_sel && (qb >= 8) && (s == qb - 8), diag = (s == qb); \
        if (lowb || diag) { \
            _Pragma("unroll") for (int r = 0; r < 16; ++r) { const int kl = crow(r, hi); \
                if ((lowb && kl <= ql) || (diag && kl > ql)) p0[r] = NEG_INF; if ((lowb && kl + 32 <= ql) || (diag && kl + 32 > ql)) p1[r] = NEG_INF; } \
        } \
        nsa_softmax(p0, p1, m, l, started, o0, o1); \
        nsa_pv(o0, o1, p0, p1, VB + (cur_) * 8704, r32, hi); \
        if ((i_) == n_sel - 1) nsa_finish(y0, y1, o0, o1, m, l, started, g_sel); \
        if ((i_) == ntile - 1) nsa_finish(y0, y1, o0, o1, m, l, started, g_win); \
        if ((i_) + 1 < ntile) { nsa_store_k(KB + ((cur_) ^ 1) * 9216, KST, tx); nsa_store_v(VB + ((cur_) ^ 1) * 8704, VST, tx); } \
        __syncthreads(); } while (0)
    u32x4v kA = {0u, 0u, 0u, 0u}, vA = kA, kB2 = kA, vB2 = kA;
    if (ntile > 1) { const bf16_t* kp_; const bf16_t* vp_; NSA_SRC(1, kp_, vp_); kA = *(const u32x4v*)kp_; vA = *(const u32x4v*)vp_; }
    {
        int i = 0;
        for (; i + 1 < ntile; i += 2) {
            NSA_TILE(i, 0, kB2, vB2, kA, vA);
            NSA_TILE(i + 1, 1, kA, vA, kB2, vB2);
        }
        if (i < ntile) NSA_TILE(i, 0, kB2, vB2, kA, vA);
    }
#undef NSA_TILE
#undef NSA_SRC
    RG_END(104)
    bf16_t* yp = Y + tok * DM + head * 64;
#pragma unroll
    for (int i = 0; i < 4; ++i) {
        *(uint2*)(yp + 8 * i + 4 * hi) = make_uint2(cvtpk(y0[4 * i], y0[4 * i + 1]), cvtpk(y0[4 * i + 2], y0[4 * i + 3]));
        *(uint2*)(yp + 32 + 8 * i + 4 * hi) = make_uint2(cvtpk(y1[4 * i], y1[4 * i + 1]), cvtpk(y1[4 * i + 2], y1[4 * i + 3]));
    }
}

DI float log_sigmoid_(float x) { return x >= 0.f ? -__logf(1.f + __expf(-x)) : x - __logf(1.f + __expf(x)); }
DI float lane_shr_add(float v, int l) {
#pragma unroll
    for (int o = 1; o < 64; o <<= 1) { const float t = lane_get(v, l - o); if (l >= o) v += t; }
    return v;
}
DI float lane_shr_max(float v, int l) {
#pragma unroll
    for (int o = 1; o < 64; o <<= 1) { const float t = lane_get(v, l - o); if (l >= o) v = fmaxf(v, t); }
    return v;
}
DI float log_sigmoid_fast(float x) { return -__logf(1.f + __expf(-x)); }
DI void ml_mscan_all(const float* __restrict__ ifp, int bh, int lane, float* __restrict__ mtab, float* __restrict__ wprev, float* __restrict__ wsc) {
    const int b = bh >> 2, h = bh & 3;
    const float* gp = ifp + ((size_t)b * SEQ + 64 * lane) * 8 + h;
    float L = 0.f, mx = -3.0e38f;
#pragma unroll 16
    for (int s = 0; s < 64; ++s) { const float iv = gp[s * 8], fv = gp[s * 8 + 4]; L += log_sigmoid_fast(fv); mx = fmaxf(mx, iv - L); }
    const float G = L + mx;
    float m = 0.f, mine = 0.f, mnext = 0.f;
#pragma unroll
    for (int k = 0; k < 64; ++k) {
        const float Lk = __builtin_bit_cast(float, __builtin_amdgcn_readlane(__builtin_bit_cast(int, L), k)), Gk = __builtin_bit_cast(float, __builtin_amdgcn_readlane(__builtin_bit_cast(int, G), k));
        if (k == lane) mine = m;
        m = fmaxf(Lk + m, Gk);
        if (k == lane) mnext = m;
    }
    mtab[bh * 65 + lane] = mine;
    wprev[bh * 64 + lane] = __expf(L + mine - mnext);
    wsc[bh * 64 + lane] = __expf(G - mnext);
}
DI void ml_conv8(float (&o)[8], const bf16_t* __restrict__ MQK, size_t tok, int t_in_seq, int col, const float* __restrict__ wc, const float* __restrict__ bc, float scale) {
    const float4 b0 = *(const float4*)(bc + col), b1 = *(const float4*)(bc + col + 4);
    o[0] = b0.x; o[1] = b0.y; o[2] = b0.z; o[3] = b0.w; o[4] = b1.x; o[5] = b1.y; o[6] = b1.z; o[7] = b1.w;
#pragma unroll
    for (int j = 0; j < 4; ++j) {
        if (t_in_seq - 3 + j >= 0) {
            float u[8]; unpack8(*(const pg8::u32x4*)(MQK + (tok - 3 + j) * 1024 + col), u);
            const float4 w0 = *(const float4*)(wc + j * 1024 + col), w1 = *(const float4*)(wc + j * 1024 + col + 4);
            o[0] += w0.x * u[0]; o[1] += w0.y * u[1]; o[2] += w0.z * u[2]; o[3] += w0.w * u[3]; o[4] += w1.x * u[4]; o[5] += w1.y * u[5]; o[6] += w1.z * u[6]; o[7] += w1.w * u[7];
        }
    }
#pragma unroll
    for (int i = 0; i < 8; ++i) o[i] = o[i] * sigmoidf_(o[i]) * scale;
}
constexpr float ML_KSCALE = 0.08838834764831845f;
DI void ml_unit_c(int bh, int c, int tx, lds_c* lds, const bf16_t* __restrict__ MQK, const bf16_t* __restrict__ MV, const float* __restrict__ ifp, const float* __restrict__ wc, const float* __restrict__ bc,
                  bf16_t* __restrict__ dC, float* __restrict__ dn, float* __restrict__ wprev, const float* __restrict__ mtab) {
    const int b = bh >> 2, h = bh & 3, lane = tx & 63, r32 = lane & 31, hi = lane >> 5, wave = __builtin_amdgcn_readfirstlane(tx >> 6);
    lds_c* KT = lds; lds_c* VTw = lds + 128 * 144;
    __attribute__((address_space(3))) float* wsm = (__attribute__((address_space(3))) float*)(lds + 2 * 128 * 144);
    const size_t tok0 = (size_t)b * SEQ + 64 * c;
    __syncthreads();
    if (wave == 0) {
        const float iv = ifp[(tok0 + lane) * 8 + h], lf = log_sigmoid_(ifp[(tok0 + lane) * 8 + 4 + h]);
        const int l_ = lane_id_opaque();
        const float bc_ = lane_shr_add(lf, l_), u = iv - bc_, umax = wave_max(u);
        wsm[lane] = __expf(u - umax);
        (void)wprev; (void)mtab;
    }
    __syncthreads();
#pragma unroll 1
    for (int it = tx; it < 1024; it += 512) {
        const int s = it >> 4, d0 = (it & 15) * 8; float kv[8];
        ml_conv8(kv, MQK, tok0 + s, 64 * c + s, 512 + h * 128 + d0, wc, bc, ML_KSCALE);
        float vv[8]; unpack8(*(const pg8::u32x4*)(MV + (tok0 + s) * 512 + h * 128 + d0), vv);
        const float w = wsm[s];
#pragma unroll
        for (int i = 0; i < 8; ++i) {
            *(__attribute__((address_space(3))) bf16_t*)(KT + (d0 + i) * 144 + s * 2) = f2bf(kv[i]);
            *(__attribute__((address_space(3))) bf16_t*)(VTw + (d0 + i) * 144 + s * 2) = f2bf(vv[i] * w);
        }
    }
    __syncthreads();
    if (tx < 128) {
        float a = 0.f;
        for (int s = 0; s < 64; ++s) a += wsm[s] * bf2f(*(const __attribute__((address_space(3))) bf16_t*)(KT + tx * 144 + s * 2));
        dn[((size_t)bh * 64 + c) * 128 + tx] = a;
    }
    {
        const int vb = wave >> 1, kh = wave & 1;
        f32x16 acc0, acc1;
#pragma unroll
        for (int r = 0; r < 16; ++r) { acc0[r] = 0.f; acc1[r] = 0.f; }
#pragma unroll
        for (int ks = 0; ks < 4; ++ks) {
            const bf16x8 a = *(const __attribute__((address_space(3))) bf16x8*)(VTw + (vb * 32 + r32) * 144 + ks * 32 + hi * 16);
            const bf16x8 b0 = *(const __attribute__((address_space(3))) bf16x8*)(KT + (kh * 64 + r32) * 144 + ks * 32 + hi * 16);
            const bf16x8 b1 = *(const __attribute__((address_space(3))) bf16x8*)(KT + (kh * 64 + 32 + r32) * 144 + ks * 32 + hi * 16);
            acc0 = MFMA32(a, b0, acc0); acc1 = MFMA32(a, b1, acc1);
        }
        bf16_t* o = dC + ((size_t)bh * 64 + c) * 16384;
#pragma unroll
        for (int r = 0; r < 16; ++r) { const int v = vb * 32 + crow(r, hi);
            o[v * 128 + kh * 64 + r32] = f2bf(acc0[r]); o[v * 128 + kh * 64 + 32 + r32] = f2bf(acc1[r]); }
    }
}
DI void ml_scan(int gtid, int nthreads, bf16_t* __restrict__ dC, float* __restrict__ dn, const float* __restrict__ wprev, const float* __restrict__ wsc) {
    for (int p = gtid; p < 16 * 8192; p += nthreads) {
        const int bh = p >> 13, e2 = p & 8191;
        unsigned* base = (unsigned*)(dC + (size_t)bh * 64 * 16384) + e2;
        float r0 = 0.f, r1 = 0.f;
#pragma unroll 1
        for (int c0 = 0; c0 < 64; c0 += 16) {
            unsigned v[16];
#pragma unroll
            for (int j = 0; j < 16; ++j) v[j] = base[(size_t)(c0 + j) * 8192];
#pragma unroll
            for (int j = 0; j < 16; ++j) {
                const float w = wprev[bh * 64 + c0 + j], sc = wsc[bh * 64 + c0 + j];
                base[(size_t)(c0 + j) * 8192] = pk2(r0, r1);
                r0 = w * r0 + sc * __uint_as_float(v[j] << 16); r1 = w * r1 + sc * __uint_as_float(v[j] & 0xffff0000u);
            }
        }
    }
    for (int p = gtid; p < 16 * 128; p += nthreads) {
        const int bh = p >> 7, k = p & 127; float r = 0.f; float* q = dn + (size_t)bh * 64 * 128 + k;
#pragma unroll 1
        for (int c0 = 0; c0 < 64; c0 += 16) {
            float v[16];
#pragma unroll
            for (int j = 0; j < 16; ++j) v[j] = q[(c0 + j) * 128];
#pragma unroll
            for (int j = 0; j < 16; ++j) { q[(c0 + j) * 128] = r; r = wprev[bh * 64 + c0 + j] * r + wsc[bh * 64 + c0 + j] * v[j]; }
        }
    }
}
DI void ml_unit_e(int bh, int c, int tx, lds_c* lds, const bf16_t* __restrict__ MQK, const bf16_t* __restrict__ MV, const bf16_t* __restrict__ MO, const float* __restrict__ ifp,
                  const float* __restrict__ wc, const float* __restrict__ bc, const bf16_t* __restrict__ Sst, const float* __restrict__ nst, const float* __restrict__ mtab, const float* __restrict__ g_hn, bf16_t* __restrict__ Y) {
    const int b = bh >> 2, h = bh & 3, lane = tx & 63, r32 = lane & 31, hi = lane >> 5, wave = __builtin_amdgcn_readfirstlane(tx >> 6);
    lds_c* Qi = lds; lds_c* Ki = lds + 64 * 272; lds_c* VTi = lds + 2 * 64 * 272; lds_c* Si = VTi + 128 * 136;
    __attribute__((address_space(3))) float* fsm = (__attribute__((address_space(3))) float*)(Si + 128 * 272);
    const size_t tok0 = (size_t)b * SEQ + 64 * c;
    const float m_c = mtab[bh * 65 + c];
    __syncthreads();
    if (wave == 0) {
        const float iv = ifp[(tok0 + lane) * 8 + h], lf = log_sigmoid_(ifp[(tok0 + lane) * 8 + 4 + h]);
        const int l_ = lane_id_opaque();
        const float bc_ = lane_shr_add(lf, l_), u = iv - bc_, M = fmaxf(lane_shr_max(u, l_), m_c);
        fsm[lane] = u; fsm[64 + lane] = M; fsm[128 + lane] = __expf(-(bc_ + M));
    }
    if (wave == 1) { fsm[192 + lane] = nst[((size_t)bh * 64 + c) * 128 + lane]; fsm[192 + 64 + lane] = nst[((size_t)bh * 64 + c) * 128 + 64 + lane]; }
#pragma unroll 1
    for (int it = tx; it < 1024; it += 512) {
        const int s = it >> 4, d0 = (it & 15) * 8; float qv[8], kv[8];
        ml_conv8(qv, MQK, tok0 + s, 64 * c + s, h * 128 + d0, wc, bc, 1.f);
        ml_conv8(kv, MQK, tok0 + s, 64 * c + s, 512 + h * 128 + d0, wc, bc, ML_KSCALE);
        *(__attribute__((address_space(3))) pg8::u32x4*)(Qi + s * 272 + d0 * 2) = pack8(qv);
        *(__attribute__((address_space(3))) pg8::u32x4*)(Ki + s * 272 + d0 * 2) = pack8(kv);
        const pg8::u32x4 vw = *(const pg8::u32x4*)(MV + (tok0 + s) * 512 + h * 128 + d0);
        __attribute__((address_space(3))) bf16_t* vt = (__attribute__((address_space(3))) bf16_t*)(VTi + d0 * 136 + s * 2);
        vt[0] = (bf16_t)(vw.x & 0xffffu); vt[68] = (bf16_t)(vw.x >> 16); vt[136] = (bf16_t)(vw.y & 0xffffu); vt[204] = (bf16_t)(vw.y >> 16);
        vt[272] = (bf16_t)(vw.z & 0xffffu); vt[340] = (bf16_t)(vw.z >> 16); vt[408] = (bf16_t)(vw.w & 0xffffu); vt[476] = (bf16_t)(vw.w >> 16);
    }
    {
        const bf16_t* src = Sst + ((size_t)bh * 64 + c) * 16384;
#pragma unroll
        for (int j = 0; j < 4; ++j) { const int ch = tx + 512 * j, v = ch >> 4, k8 = (ch & 15) * 8;
            *(__attribute__((address_space(3))) pg8::u32x4*)(Si + v * 272 + k8 * 2) = *(const pg8::u32x4*)(src + v * 128 + k8); }
    }
    __syncthreads();
    const int tb = wave & 1, vb = wave >> 1, t = tb * 32 + r32;
    bf16x8 qf[8];
#pragma unroll
    for (int ks = 0; ks < 8; ++ks) qf[ks] = *(const __attribute__((address_space(3))) bf16x8*)(Qi + t * 272 + ks * 32 + hi * 16);
    f32x16 a0, a1;
#pragma unroll
    for (int r = 0; r < 16; ++r) { a0[r] = 0.f; a1[r] = 0.f; }
#pragma unroll
    for (int ks = 0; ks < 8; ++ks) {
        const bf16x8 k0 = *(const __attribute__((address_space(3))) bf16x8*)(Ki + r32 * 272 + ks * 32 + hi * 16);
        const bf16x8 k1 = *(const __attribute__((address_space(3))) bf16x8*)(Ki + (32 + r32) * 272 + ks * 32 + hi * 16);
        a0 = MFMA32(k0, qf[ks], a0); a1 = MFMA32(k1, qf[ks], a1);
    }
    const float Mt = fsm[64 + t], dec = __expf(m_c - Mt);
    float rs = 0.f;
#pragma unroll
    for (int r = 0; r < 16; ++r) {
        const int s0 = crow(r, hi), s1 = 32 + s0;
        a0[r] = s0 <= t ? __expf(fsm[s0] - Mt) * a0[r] : 0.f; a1[r] = s1 <= t ? __expf(fsm[s1] - Mt) * a1[r] : 0.f;
        rs += a0[r] + a1[r];
    }
    float nq = 0.f;
#pragma unroll
    for (int ks = 0; ks < 8; ++ks) { float qv[8]; unpack8(__builtin_bit_cast(pg8::u32x4, qf[ks]), qv);
#pragma unroll
        for (int j = 0; j < 8; ++j) nq += qv[j] * fsm[192 + ks * 16 + hi * 8 + j]; }
    float den = rs + dec * nq;
    { auto rr = __builtin_amdgcn_permlane32_swap(__float_as_uint(den), __float_as_uint(den), false, false); den = __uint_as_float(rr[0]) + __uint_as_float(rr[1]); }
    f32x16 n1, n2;
#pragma unroll
    for (int r = 0; r < 16; ++r) { n1[r] = 0.f; n2[r] = 0.f; }
#pragma unroll
    for (int hf = 0; hf < 2; ++hf)
#pragma unroll
        for (int ss = 0; ss < 2; ++ss) {
            unsigned pw[4];
#pragma unroll
            for (int j = 0; j < 4; ++j) pw[j] = hf ? cvtpk(a1[8 * ss + 2 * j], a1[8 * ss + 2 * j + 1]) : cvtpk(a0[8 * ss + 2 * j], a0[8 * ss + 2 * j + 1]);
            const u32x4v pbw = {pw[0], pw[1], pw[2], pw[3]};
            const lds_c* vp = VTi + (vb * 32 + r32) * 136 + hf * 64 + ss * 32 + hi * 8;
            const u32x2v lo = *(const __attribute__((address_space(3))) u32x2v*)vp, hi2 = *(const __attribute__((address_space(3))) u32x2v*)(vp + 16);
            const u32x4v aw = {lo.x, lo.y, hi2.x, hi2.y};
            n1 = MFMA32(__builtin_bit_cast(bf16x8, aw), __builtin_bit_cast(bf16x8, pbw), n1);
        }
#pragma unroll
    for (int ks = 0; ks < 8; ++ks) {
        const bf16x8 sa = *(const __attribute__((address_space(3))) bf16x8*)(Si + (vb * 32 + r32) * 272 + ks * 32 + hi * 16);
        n2 = MFMA32(sa, qf[ks], n2);
    }
    const float inv = 1.f / fmaxf(fabsf(den), fsm[128 + t]);
    const bf16_t* op = MO + (tok0 + t) * 512 + h * 128 + vb * 32;
    float hv[16]; float ssq = 0.f;
#pragma unroll
    for (int i = 0; i < 4; ++i) {
        const u32x2v ow = *(const u32x2v*)(op + 8 * i + 4 * hi);
        const float o4[4] = {__uint_as_float(ow.x << 16), __uint_as_float(ow.x & 0xffff0000u), __uint_as_float(ow.y << 16), __uint_as_float(ow.y & 0xffff0000u)};
#pragma unroll
        for (int j = 0; j < 4; ++j) { const float x = (n1[4 * i + j] + dec * n2[4 * i + j]) * inv * sigmoidf_(o4[j]); hv[4 * i + j] = x; ssq += x * x; }
    }
    { auto rr = __builtin_amdgcn_permlane32_swap(__float_as_uint(ssq), __float_as_uint(ssq), false, false); ssq = __uint_as_float(rr[0]) + __uint_as_float(rr[1]); }
    if (hi == 0) fsm[320 + t * 4 + vb] = ssq;
    __syncthreads();
    const float tot = (fsm[320 + t * 4] + fsm[320 + t * 4 + 1]) + (fsm[320 + t * 4 + 2] + fsm[320 + t * 4 + 3]);
    const float rstd = rsqrtf(tot * (1.f / 128.f) + 1e-6f);
    bf16_t* yp = Y + (tok0 + t) * DM + 512 + h * 128 + vb * 32; const float* gp = g_hn + h * 128 + vb * 32;
#pragma unroll
    for (int i = 0; i < 4; ++i) {
        const float4 gg = *(const float4*)(gp + 8 * i + 4 * hi);
        *(u32x2v*)(yp + 8 * i + 4 * hi) = (u32x2v){cvtpk(hv[4 * i] * rstd * gg.x, hv[4 * i + 1] * rstd * gg.y), cvtpk(hv[4 * i + 2] * rstd * gg.z, hv[4 * i + 3] * rstd * gg.w)};
    }
}

DI void cmp_unit(int kv, int bg, int jt, int tx, lds_c* lds, const bf16_t* __restrict__ KVb, const bf16_t* __restrict__ W1t, const bf16_t* __restrict__ W2t, const float* __restrict__ bias1p,
                 float* __restrict__ outf, bf16_t* __restrict__ kcb, bf16_t* __restrict__ vcT) {
    const int b = bg >> 1, g = bg & 1, lane = tx & 63, r32 = lane & 31, hi = lane >> 5, wave = __builtin_amdgcn_readfirstlane(tx >> 6), j0 = jt * 32;
    lds_c* TI = lds; lds_c* H1 = lds + 16 * 34 * 144;
    const bf16_t* src = KVb + ((size_t)b * SEQ + 16 * j0) * 512 + (kv ? 128 : 0) + g * 64;
    __syncthreads();
    for (int ch = tx; ch < 528 * 8; ch += 512) {
        const int t = ch >> 3, c8 = ch & 7;
        *(__attribute__((address_space(3))) pg8::u32x4*)(TI + ((t & 15) * 34 + (t >> 4)) * 144 + c8 * 16) = *(const pg8::u32x4*)(src + (size_t)t * 512 + c8 * 8);
    }
    __syncthreads();
    f32x16 acc;
#pragma unroll
    for (int r = 0; r < 16; ++r) acc[r] = 0.f;
    const bf16_t* wrow = W1t + (size_t)(wave * 32 + r32) * 2048 + hi * 8;
#pragma unroll 4
    for (int i = 0; i < 32; ++i) {
        const lds_c* arow = TI + ((i & 15) * 34 + r32 + (i >> 4)) * 144 + hi * 16;
#pragma unroll
        for (int dk = 0; dk < 4; ++dk) {
            const bf16x8 a = *(const __attribute__((address_space(3))) bf16x8*)(arow + dk * 32);
            const bf16x8 bfr = *(const bf16x8*)(wrow + i * 64 + dk * 16);
            acc = MFMA32(a, bfr, acc);
        }
    }
    {
        const int n = wave * 32 + r32; const float bias = bias1p[kv * 256 + n];
#pragma unroll
        for (int r = 0; r < 16; ++r) *(__attribute__((address_space(3))) bf16_t*)(H1 + crow(r, hi) * 528 + n * 2) = f2bf(gelu_tanh(acc[r] + bias));
    }
    __syncthreads();
    if (wave < 2) {
        f32x16 o;
#pragma unroll
        for (int r = 0; r < 16; ++r) o[r] = 0.f;
        const bf16_t* w2row = W2t + (size_t)(wave * 32 + r32) * 256 + hi * 8;
#pragma unroll
        for (int ks = 0; ks < 16; ++ks) {
            const bf16x8 a = *(const __attribute__((address_space(3))) bf16x8*)(H1 + r32 * 528 + ks * 32 + hi * 16);
            const bf16x8 bfr = *(const bf16x8*)(w2row + ks * 16);
            o = MFMA32(a, bfr, o);
        }
        const int d = wave * 32 + r32;
#pragma unroll
        for (int r = 0; r < 16; ++r) {
            const int j = j0 + crow(r, hi); const float v = j < 255 ? o[r] : 0.f;
            outf[((size_t)bg * 256 + j) * 64 + d] = v;
            if (kv == 0) kcb[((size_t)bg * 256 + j) * 64 + d] = f2bf(v);
            else vcT[((size_t)bg * 4 + (j >> 6)) * 4096 + d * 64 + (j & 63)] = f2bf(v);
        }
    }
}

#define XB_TMO      128
#define XB_XCNT(j)  (256  + 64 * (j))
#define XB_XSUB(j)  (1280 + 64 * (j))
#define XB_XGEN(j)  (2304 + 64 * (j))
#define XB_TOP      3328
#define XB_TOPGEN   3392
#define XCD_BAR_WORDS 3456
#define XB_SPIN_CAP (1u << 23)

__device__ __forceinline__ unsigned xb_ld(unsigned* p)              { return __hip_atomic_load(p, __ATOMIC_RELAXED, __HIP_MEMORY_SCOPE_AGENT); }
__device__ __forceinline__ unsigned xb_add(unsigned* p, unsigned v) { return __hip_atomic_fetch_add(p, v, __ATOMIC_RELAXED, __HIP_MEMORY_SCOPE_AGENT); }
__device__ __forceinline__ unsigned xb_xcc_id() { return (unsigned)__builtin_amdgcn_s_getreg((3 << 11) | 20) & 0xFu; }
#define XB_SPIN(cond, bar) do { unsigned _sp = 0; while (cond) { __builtin_amdgcn_s_sleep(1); \
    if ((++_sp & 255u) == 0u) { if (xb_ld(&(bar)[XB_TMO])) break; if (_sp > XB_SPIN_CAP) { atomicAdd(&(bar)[XB_TMO], 1u); break; } } } } while (0)

struct XcdBarrier {
    unsigned* bar; unsigned x;
    volatile __attribute__((address_space(3))) unsigned* st;
};

__device__ __forceinline__ XcdBarrier xcd_barrier_post(unsigned* bar, volatile __attribute__((address_space(3))) unsigned* st) {
    XcdBarrier b; b.bar = bar; b.x = xb_xcc_id(); b.st = st;
    if (threadIdx.x == 0) (void)xb_add(&bar[XB_XCNT(b.x)], 1u);
    return b;
}
__device__ __forceinline__ void xcd_barrier_complete(unsigned* bar, unsigned x, unsigned& nloc, unsigned& nx) {
    const unsigned G = gridDim.x * gridDim.y * gridDim.z;
    unsigned sum, cnt, mine, sp = 0u;
    for (;;) {
        sum = 0u; cnt = 0u; mine = 0u;
#pragma unroll
        for (unsigned j = 0; j < 16; ++j) { const unsigned c = xb_ld(&bar[XB_XCNT(j)]); sum += c; cnt += (c > 0u) ? 1u : 0u; mine = (j == x) ? c : mine; }
        if (sum == G) break;
        __builtin_amdgcn_s_sleep(1);
        if ((++sp & 255u) == 0u) { if (xb_ld(&bar[XB_TMO])) break; if (sp > XB_SPIN_CAP) { atomicAdd(&bar[XB_TMO], 1u); break; } }
    }
    nloc = mine > 0u ? mine : 1u; nx = cnt > 0u ? cnt : 1u;
}

__device__ __forceinline__ void xcd_barrier(const XcdBarrier& b) {
    asm volatile("s_waitcnt vmcnt(0)" ::: "memory");
    __syncthreads();
    if (threadIdx.x == 0) {
        unsigned* bar = b.bar;
        __builtin_amdgcn_s_waitcnt(0);
        unsigned nloc = b.st[0], nx = b.st[1];
        if (nloc == 0u) { xcd_barrier_complete(bar, b.x, nloc, nx); b.st[0] = nloc; b.st[1] = nx; }
        const unsigned old = xb_add(&bar[XB_XSUB(b.x)], 1u);
        const unsigned gen = old / nloc;
        if (old + 1u == (gen + 1u) * nloc) {
            __builtin_amdgcn_fence(__ATOMIC_RELEASE, "agent");
            asm volatile("s_waitcnt vmcnt(0)" ::: "memory");
            const unsigned og = xb_add(&bar[XB_TOP], 1u);
            const unsigned tg = og / nx;
            if (og + 1u == (tg + 1u) * nx) xb_add(&bar[XB_TOPGEN], 1u);
            else XB_SPIN(xb_ld(&bar[XB_TOPGEN]) == tg, bar);
            __builtin_amdgcn_fence(__ATOMIC_ACQUIRE, "agent");
            xb_add(&bar[XB_XGEN(b.x)], 1u);
            asm volatile("s_waitcnt vmcnt(0)" ::: "memory");
        } else {
            XB_SPIN(xb_ld(&bar[XB_XGEN(b.x)]) == gen, bar);
            __builtin_amdgcn_fence(__ATOMIC_ACQUIRE, "agent");
            asm volatile("s_waitcnt vmcnt(0)" ::: "memory");
        }
    }
    __syncthreads();
}

#ifndef NSA_CHECK
#define NSA_CHECK 0
#endif
#ifndef REP_MASK
#define REP_MASK 0u
#endif
struct Args { const float* in[29]; float* out; char* ws; unsigned rep_mask; unsigned pad; };
constexpr int LDS_BYTES = 147456;

__global__ __launch_bounds__(512, 2) void mk_fwd(Args a) {
    extern __shared__ __attribute__((aligned(16))) char lds_raw[];
    cg::grid_group grid = cg::this_grid();
    const int NB = gridDim.x * 2, NGW = gridDim.x * 8;
    const unsigned repm = a.rep_mask;
    volatile __attribute__((address_space(3))) unsigned* bar_st = (volatile __attribute__((address_space(3))) unsigned*)((lds_c*)lds_raw + (LDS_BYTES - 64));
    if (threadIdx.x < 2) bar_st[threadIdx.x] = 0u;
    __syncthreads();
    const XcdBarrier xbar = xcd_barrier_post((unsigned*)(a.ws + ((size_t)42 << 20) + 65536), bar_st);
#define GRID_BAR() xcd_barrier(xbar)
#ifndef SPIN_PHASE_UNUSED_
#endif
    unsigned long long ts_prev_ = 0ull, ts_probe_ = 0ull; int n_stamp_ = 0;
#define STAMP() do { if (SPIN_PHASE >= 0 && blockIdx.x == 0) { const unsigned long long now_ = __builtin_amdgcn_s_memrealtime(); if (n_stamp_ == SPIN_PHASE) ts_probe_ = now_ - ts_prev_; ts_prev_ = now_; ++n_stamp_; } } while (0)
    if (SPIN_PHASE >= 0 && blockIdx.x == 0) ts_prev_ = __builtin_amdgcn_s_memrealtime();
    const int wave_s_ = __builtin_amdgcn_readfirstlane(threadIdx.x >> 6);
#define KARG(T, off) (*(T const __attribute__((address_space(4)))*)(kargs_ + (off)))
#define PTRS const float* x = KARG(const float*, 8 * 0); const float* p = KARG(const float*, 8 * 1); const int* pos = KARG(const int*, 16); \
    const float* g_mix = KARG(const float*, 8 * 3); const float* w_in = KARG(const float*, 8 * 4); const float* b_if = KARG(const float*, 8 * 5); \
    const float* w_ck1 = KARG(const float*, 8 * 6); const float* w_ck2 = KARG(const float*, 8 * 7); const float* pe_ck = KARG(const float*, 8 * 8); \
    const float* w_cv1 = KARG(const float*, 8 * 9); const float* w_cv2 = KARG(const float*, 8 * 10); const float* pe_cv = KARG(const float*, 8 * 11); \
    const float* w_conv = KARG(const float*, 8 * 12); const float* b_conv = KARG(const float*, 8 * 13); const float* g_hn = KARG(const float*, 8 * 14); \
    const float* w_pa = KARG(const float*, 8 * 15); const float* w_pb = KARG(const float*, 8 * 16); const float* w_out = KARG(const float*, 8 * 17); \
    const float* g_ffn = KARG(const float*, 8 * 18); const float* w_rg = KARG(const float*, 8 * 19); const float* b_rg = KARG(const float*, 8 * 20); \
    const float* w_re = KARG(const float*, 8 * 21); const float* b_re = KARG(const float*, 8 * 22); const float* w_e13 = KARG(const float*, 8 * 23); \
    const float* w_e2 = KARG(const float*, 8 * 24); const float* g_ple = KARG(const float*, 8 * 25); const float* w_pg = KARG(const float*, 8 * 26); \
    const float* w_pp = KARG(const float*, 8 * 27); const float* g_final = KARG(const float*, 8 * 28); \
    float* out = KARG(float*, 232); char* ws = KARG(char*, 240); \
    const size_t MiB = 1u << 20; \
    bf16_t* Wt_in = (bf16_t*)(ws); \
    bf16_t* xb = (bf16_t*)(ws + 48 * MiB); \
    bf16_t* Qb = (bf16_t*)(ws + 80 * MiB); \
    bf16_t* KVb = (bf16_t*)(ws + 96 * MiB); bf16_t* VT = (bf16_t*)(ws + 112 * MiB); bf16_t* kcb = (bf16_t*)(ws + 249 * MiB + 512 * 1024); bf16_t* vcT = (bf16_t*)(ws + 249 * MiB + 768 * 1024); \
    bf16_t* MQK = (bf16_t*)(ws + 120 * MiB); \
    bf16_t* MV = (bf16_t*)(ws + 152 * MiB); \
    bf16_t* MO = (bf16_t*)(ws + 168 * MiB); \
    bf16_t* MG = (bf16_t*)(ws + 184 * MiB); \
    float* gates = (float*)(ws + 248 * MiB); \
    float* ifp = (float*)(ws + 250 * MiB); \
    float* kcc = (float*)(ws + 251 * MiB); \
    float* vcc = (float*)(ws + 252 * MiB); \
    float* gate16 = (float*)(ws + 253 * MiB); \
    float* rstd0 = (float*)(ws + 254 * MiB); \
    float* cosT = (float*)(ws + 254 * MiB + 512 * 1024); \
    float* sinT = (float*)(ws + 255 * MiB); \
    bf16_t* Y = (bf16_t*)(out + (size_t)8 * 1024 * 1024); \
    bf16_t* dC = xb; float* dn = (float*)(ws + 250 * MiB + 512 * 1024); float* wprev = (float*)(ws + 42 * MiB + 4096); float* mtab = (float*)(ws + 42 * MiB + 8192); float* wsc = (float*)(ws + 42 * MiB + 16384); \
    float* tmp = (float*)(ws + 120 * MiB); bf16_t* mixed = xb; \
    bf16_t* Wpa_t = (bf16_t*)(ws + 11 * MiB); bf16_t* Wpb_t = (bf16_t*)(ws + 12 * MiB); bf16_t* Wout_t = (bf16_t*)(ws + 13 * MiB); \
    bf16_t* We13_t = (bf16_t*)(ws + 15 * MiB); bf16_t* We2_t = (bf16_t*)(ws + 31 * MiB); bf16_t* Wpg_t = (bf16_t*)(ws + 39 * MiB); bf16_t* Wpp_t = (bf16_t*)(ws + 41 * MiB); \
    int* cnt = (int*)(ws + 42 * MiB); bf16_t* W1t_k = (bf16_t*)(ws + 43 * MiB); bf16_t* W1t_v = (bf16_t*)(ws + 44 * MiB); bf16_t* W2t_k = (bf16_t*)(ws + 45 * MiB); bf16_t* W2t_v = (bf16_t*)(ws + 45 * MiB + 65536); float* bias1p = (float*)(ws + 45 * MiB + 524288); \
    bf16_t* x1b = (bf16_t*)(ws + 48 * MiB); bf16_t* act = (bf16_t*)(ws + 120 * MiB); bf16_t* y2 = (bf16_t*)(ws + 138 * MiB); bf16_t* x2b = (bf16_t*)(ws + 210 * MiB); int* elist = (int*)(ws + 242 * MiB); \
    bf16_t* pb = (bf16_t*)(ws + 80 * MiB); bf16_t* PP = (bf16_t*)(ws + 88 * MiB); \
    int* rinfo = (int*)(ws + 253 * MiB); float* rstd1 = (float*)(ws + 253 * MiB + 512 * 1024); float* rstd2 = (float*)(ws + 253 * MiB + 768 * 1024); \
    (void)x; (void)p; (void)pos; (void)g_mix; (void)w_in; (void)b_if; (void)w_ck1; (void)w_ck2; (void)pe_ck; (void)w_cv1; (void)w_cv2; (void)pe_cv; (void)w_conv; (void)b_conv; (void)g_hn; (void)w_pa; (void)w_pb; (void)w_out; (void)g_ffn; (void)w_rg; (void)b_rg; (void)w_re; (void)b_re; (void)w_e13; (void)w_e2; (void)g_ple; (void)w_pg; (void)w_pp; (void)g_final;
#define PHASE(k) for (int rep_ = 0; rep_ < 1 + (int)((repm >> (k)) & 1u); ++rep_)
#define PHASE_IDS unsigned tx_ = (unsigned)(wave_s_ * 64); asm volatile("" : "+v"(tx_)); tx_ = (unsigned)__builtin_amdgcn_mbcnt_hi(-1, __builtin_amdgcn_mbcnt_lo(-1, (int)tx_)); const int half = tx_ >> 8, tid = tx_ & 255, lane64 = tx_ & 63, tid512 = (int)tx_; \
    const int wave = __builtin_amdgcn_readfirstlane(tx_ >> 6); char* sm = lds_raw + half * 65536; const int gw = blockIdx.x * 8 + wave; (void)tid; (void)lane64; (void)sm; (void)gw; (void)tid512; \
    const __attribute__((address_space(4))) char* kargs_ = (const __attribute__((address_space(4))) char*)__builtin_amdgcn_kernarg_segment_ptr(); asm volatile("" : "+s"(kargs_)); PTRS
#define VB_LOOP(nvb) for (int vb = blockIdx.x * 2 + half; vb < (nvb); vb += NB)
#define GEMM_PHASE(NT, MT, ...) do { VB_LOOP((NT) * (MT)) { const int bx_ = vb % (NT), by_ = vb / (NT); __syncthreads(); gemm_v1(bx_, by_, tid, sm, __VA_ARGS__); } } while (0)
    PHASE(0) { PHASE_IDS
        float* scr = (float*)(lds_raw + wave * 8448);
        for (int it = gw; it < (DM / 64) * (NIN / 32); it += NGW) prep_wt_item(w_in, DIN, DM, Wt_in, g_mix, MapIn{}, scr, it, NIN / 32, lane64);
        for (int it = gw; it < 2 * 256; it += NGW) { const int kv = it >> 8; prep_wt_item(kv ? w_cv1 : w_ck1, 256, 2048, kv ? W1t_v : W1t_k, (const float*)nullptr, MapId{}, scr, it & 255, 8, lane64); }
        for (int it = gw; it < 2 * 8; it += NGW) { const int kv = it >> 3; prep_wt_item(kv ? w_cv2 : w_ck2, 64, 256, kv ? W2t_v : W2t_k, (const float*)nullptr, MapId{}, scr, it & 7, 2, lane64); }
        if (gw < 512) {
            const int kv = gw >> 8, n = gw & 255; const float* w1 = kv ? w_cv1 : w_ck1; const float* pe = kv ? pe_cv : pe_ck; float a = 0.f;
#pragma unroll
            for (int i = 0; i < 32; ++i) { const int k = lane64 + 64 * i; a += pe[k] * w1[(size_t)k * 256 + n]; }
            a = wave_sum(a);
            if (lane64 == 0) bias1p[gw] = a;
        }
        if (blockIdx.x == 0 && tid512 < 16) cnt[tid512 * CNT_STRIDE] = 0;
        for (int r = gw; r < T_TOK; r += NGW) prep_x_row(x, xb, rstd0, r, lane64);
        for (int i = blockIdx.x * 512 + tid512; i < T_TOK * 8; i += gridDim.x * 512) {
            const float inv = powf(500000.0f, -(float)(2 * (i & 7)) / 16.0f); float sn, cs; sincosf((float)pos[i >> 3] * inv, &sn, &cs); cosT[i] = cs; sinT[i] = sn; }
    }
    if (repm == 0x80000000u) grid.sync();
    GRID_BAR(); STAMP();
    PHASE(1) { PHASE_IDS
        pg8::Gemm g{xb, Wt_in, T_TOK, NIN, DM, DM, DM}; pg8::StaticOrder S; S.init(T_TOK, NIN, (int)gridDim.x, (int)blockIdx.x);
        EpiInProj E{rstd0, cosT, sinT, b_if, Qb, KVb, gates, ifp, MQK, MV, MO, MG, VT};
        pg8::gemm_phase<EpiInProj, pg8::StaticOrder, true, true>((PG8_LAS unsigned char*)lds_raw, g, S, E, tid512);
    }
    {   PHASE_IDS
        const int G_ = (int)gridDim.x, nfull_ = (64 * (NIN / 256)) % G_;
        const int nl_ = G_ - nfull_, lw_ = (int)blockIdx.x - nfull_;
        if (nfull_ == 0 || lw_ >= 0) {
            const int lgw = (nfull_ == 0 ? (int)blockIdx.x : lw_) * 8 + wave, LNGW = (nfull_ == 0 ? G_ : nl_) * 8;
            float* scr = (float*)(lds_raw + wave * 8448); float* scr2 = (float*)(lds_raw + wave * 16896); (void)scr;
            __syncthreads();
            for (int it = lgw; it < 16 * 128; it += LNGW) { const int e = it >> 7, i2 = (it & 127) * 2; const float* w_ = w_e13 + (size_t)e * 1024 * 512; bf16_t* t_ = We13_t + (size_t)e * 512 * 1024;
                prep_wt_item2(w_, w_, 512, DM, t_, t_, g_ffn, MapE13{}, scr2, i2, i2 + 1, 16, lane64); }
            if ((int)gridDim.x != 256) {
                for (int it = lgw; it < 8 * 32; it += LNGW) prep_wt_item(w_pa, DM, DM, Wpa_t, (const float*)nullptr, MapId{}, scr, it, 32, lane64);
                for (int it = lgw; it < 8 * 32; it += LNGW) prep_wt_item(w_pb, DM, DM, Wpa_t + 512, (const float*)nullptr, MapId{}, scr, it, 32, lane64);
                for (int it = lgw; it < 16 * 32; it += LNGW) prep_wt_item(w_out, DM, DM, Wout_t, (const float*)nullptr, MapId{}, scr, it, 32, lane64);
                for (int it = lgw; it < 16 * 32; it += LNGW) prep_wt_item(w_pg, DM, DM, Wpg_t, g_ple, MapId{}, scr, it, 32, lane64);
                for (int it = lgw; it < 4 * 32; it += LNGW) prep_wt_item(w_pp, DM, 256, Wpp_t, (const float*)nullptr, MapId{}, scr, it, 32, lane64);
                for (int it = lgw; it < 16 * 64; it += LNGW) { const int e = it >> 6, i2 = (it & 63) * 2; const float* w_ = w_e2 + (size_t)e * 256 * 1024; bf16_t* t_ = We2_t + (size_t)e * 1024 * 256;
                prep_wt_item2(w_, w_, DM, 256, t_, t_, (const float*)nullptr, MapId{}, scr2, i2, i2 + 1, 32, lane64); }
            }
        }
    }
    GRID_BAR(); STAMP();
    PHASE(2) { PHASE_IDS
        for (int u = blockIdx.x; u < 128; u += gridDim.x) { const int kv = u >> 6, bg = (u >> 3) & 7, jt = u & 7;
            cmp_unit(kv, bg, jt, tid512, (lds_c*)lds_raw, KVb, kv ? W1t_v : W1t_k, kv ? W2t_v : W2t_k, bias1p, kv ? vcc : kcc, kcb, vcT); }
        { const int v_ = (int)blockIdx.x - 128; if (v_ >= 0 && v_ < 16 && wave == 0) ml_mscan_all(ifp, v_, lane64, mtab, wprev, wsc); }
    }
    PHASE(3) { PHASE_IDS
        { const int G_ = (int)gridDim.x, c_ = (int)blockIdx.x;
          if (G_ == 256) { const int n_ = c_ < 128 ? 3 : 5, first_ = c_ < 128 ? 3 * c_ : 384 + 5 * (c_ - 128);
              for (int u = first_; u < first_ + n_; ++u) ml_unit_c(u >> 6, u & 63, tid512, (lds_c*)lds_raw, MQK, MV, ifp, w_conv, b_conv, dC, dn, wprev, mtab); }
          else for (int u = c_; u < 1024; u += G_) ml_unit_c(u >> 6, u & 63, tid512, (lds_c*)lds_raw, MQK, MV, ifp, w_conv, b_conv, dC, dn, wprev, mtab); }
        if ((int)gridDim.x == 256 && (int)blockIdx.x >= 128) {
            const int lgw = ((int)blockIdx.x - 128) * 8 + wave, LNGW = 128 * 8; float* scr = (float*)(lds_raw + wave * 16896); float* scr2 = scr;
            __syncthreads();
            for (int it = lgw; it < 8 * 32; it += LNGW) prep_wt_item(w_pa, DM, DM, Wpa_t, (const float*)nullptr, MapId{}, scr, it, 32, lane64);
            for (int it = lgw; it < 8 * 32; it += LNGW) prep_wt_item(w_pb, DM, DM, Wpa_t + 512, (const float*)nullptr, MapId{}, scr, it, 32, lane64);
            for (int it = lgw; it < 16 * 32; it += LNGW) prep_wt_item(w_out, DM, DM, Wout_t, (const float*)nullptr, MapId{}, scr, it, 32, lane64);
            for (int it = lgw; it < 16 * 32; it += LNGW) prep_wt_item(w_pg, DM, DM, Wpg_t, g_ple, MapId{}, scr, it, 32, lane64);
            for (int it = lgw; it < 4 * 32; it += LNGW) prep_wt_item(w_pp, DM, 256, Wpp_t, (const float*)nullptr, MapId{}, scr, it, 32, lane64);
            for (int it = lgw; it < 16 * 64; it += LNGW) { const int e = it >> 6, i2 = (it & 63) * 2; const float* w_ = w_e2 + (size_t)e * 256 * 1024; bf16_t* t_ = We2_t + (size_t)e * 1024 * 256;
                prep_wt_item2(w_, w_, DM, 256, t_, t_, (const float*)nullptr, MapId{}, scr2, i2, i2 + 1, 32, lane64); }
        }
    }
    GRID_BAR(); STAMP();
    {   PHASE_IDS
        ml_scan(blockIdx.x * 512 + tid512, gridDim.x * 512, dC, dn, wprev, wsc);
    }
    GRID_BAR(); STAMP();
    PHASE(4) { PHASE_IDS
        for (int u = blockIdx.x; u < 1024; u += gridDim.x) ml_unit_e(u >> 6, u & 63, tid512, (lds_c*)lds_raw, MQK, MV, MO, ifp, w_conv, b_conv, dC, dn, mtab, g_hn, Y);
    }
    PHASE(5) { PHASE_IDS
        for (int pr = blockIdx.x; pr < 256; pr += gridDim.x) {
            nsa_unit(pr & 7, 63 - (pr >> 3), tid512, (lds_c*)lds_raw, Qb, KVb, VT, kcb, vcT, gates, Y, ts_probe_);
            nsa_unit(pr & 7, pr >> 3, tid512, (lds_c*)lds_raw, Qb, KVb, VT, kcb, vcT, gates, Y, ts_probe_);
        }
    }
#if NSA_CHECK
    {   PHASE_IDS
        bf16_t* Y2 = (bf16_t*)(ws + 120 * MiB); unsigned* stats = (unsigned*)(ws + 42 * MiB + 32768);
        if (blockIdx.x == 0 && tid512 == 0) { stats[0] = 0u; stats[1] = 0u; }
        grid.sync();
        float* kcc2 = (float*)(ws + 251 * MiB + 512 * 1024); float* vcc2 = (float*)(ws + 252 * MiB + 512 * 1024); bf16_t* dummy = (bf16_t*)(ws + 160 * MiB);
        VB_LOOP(4080) { const int j = vb % 255, r = vb / 255; compress_naive(j, r & 7, r >> 3, tid, sm, KVb, w_ck1, w_ck2, pe_ck, w_cv1, w_cv2, pe_cv, kcc2, vcc2, dummy, dummy + 1048576); }
        grid.sync();
        VB_LOOP(T_TOK * 2) nsa_naive(vb >> 1, vb & 1, tid, sm, Qb, KVb, VT, kcc2, vcc2, gates, Y2);
        grid.sync();
        unsigned c1 = 0, c2 = 0;
        for (size_t i = (size_t)blockIdx.x * 512 + tid512; i < (size_t)T_TOK * 512; i += (size_t)gridDim.x * 512) {
            const size_t o = (i >> 9) * DM + (i & 511); const float d = fabsf(bf2f(Y[o]) - bf2f(Y2[o])); c1 += d > 0.02f ? 1u : 0u; c2 += (d > 0.1f || !(d == d)) ? 1u : 0u; }
        if (c1) atomicAdd(stats, c1); if (c2) atomicAdd(stats + 1, c2);
    }
#endif
    GRID_BAR(); STAMP();
    PHASE(7) { PHASE_IDS
        pg8::StaticOrder S; S.init(T_TOK, DM, (int)gridDim.x, (int)blockIdx.x);
        pg8::Gemm g{Y, Wpa_t, T_TOK, DM, DM, DM, DM}; EpiMerge2 E{MG, mixed}; pg8::gemm_phase<EpiMerge2, pg8::StaticOrder, true, true>((PG8_LAS unsigned char*)lds_raw, g, S, E, tid512);
    }
    GRID_BAR(); STAMP();
    PHASE(9) { PHASE_IDS
        pg8::Gemm g{mixed, Wout_t, T_TOK, DM, DM, DM, DM}; pg8::StaticOrder S; S.init(T_TOK, DM, (int)gridDim.x, (int)blockIdx.x);
        EpiX1 E{x, out, x1b};
        pg8::gemm_phase<EpiX1, pg8::StaticOrder, true, true>((PG8_LAS unsigned char*)lds_raw, g, S, E, tid512);
    }
    GRID_BAR(); STAMP();
    {   PHASE_IDS
        unsigned long long& pacc = ts_probe_;
        RG_BEGIN(110)
        __attribute__((address_space(3))) float* Wl = (__attribute__((address_space(3))) float*)((lds_c*)lds_raw);
        __attribute__((address_space(3))) int* lcnt = (__attribute__((address_space(3))) int*)((lds_c*)lds_raw + 20 * 4096);
        __attribute__((address_space(3))) int* lri = lcnt + 32;
        for (int t = gw * 4; t < T_TOK; t += NGW * 4) {
            float4 pv[4];
#pragma unroll
            for (int j = 0; j < 4; ++j) pv[j] = ((const float4*)(p + (size_t)(t + j) * 256))[lane64];
#pragma unroll
            for (int j = 0; j < 4; ++j) { uint2 o; o.x = pk2(pv[j].x, pv[j].y); o.y = pk2(pv[j].z, pv[j].w); ((uint2*)(pb + (size_t)(t + j) * 256))[lane64] = o; } }
        __syncthreads(); router_stage(Wl, g_ffn, w_rg, w_re, tid512); if (tid512 < 16) lcnt[tid512] = 0; __syncthreads();
        RG_END(110)
        RG_BEGIN(111)
        for (int r_ = 0; r_ < T_TOK / (NGW * 4); ++r_) {
            int tk_[4]; f4v xv_[16];
#pragma unroll
            for (int g_ = 0; g_ < 4; ++g_) tk_[g_] = gw + NGW * (4 * r_ + g_);
            const int mytok_ = gw + NGW * (4 * r_ + (lane64 >> 4));
#pragma unroll
            for (int j = 0; j < 16; ++j) xv_[j] = *(const f4v*)(out + (size_t)mytok_ * DM + 4 * ((lane64 & 15) + 16 * j));
            router4(tk_, lane64, xv_, Wl, b_rg, b_re, rstd1, lcnt, lri + (wave * 8 + r_ * 4) * 4);
        }
        __syncthreads();
        RG_END(111)
        RG_BEGIN(112)
        if (tid512 < 16) lcnt[16 + tid512] = atomicAdd(cnt + tid512 * CNT_STRIDE, lcnt[tid512]);
        __syncthreads();
        { int i = 0; for (int t = gw; t < T_TOK; t += NGW, ++i) if (lane64 == 0) { __attribute__((address_space(3))) int* r = lri + (wave * 8 + i) * 4;
            const int e0 = r[0] & 255, e1 = (r[0] >> 8) & 255, q0 = (r[1] & 0xffff) + lcnt[16 + e0], q1 = (r[1] >> 16) + lcnt[16 + e1]; int4 ri; ri.x = r[0]; ri.y = q0 | (q1 << 16); ri.z = r[2]; ri.w = r[3];
            *(int4*)(rinfo + (size_t)t * 4) = ri; elist[e0 * T_TOK + q0] = t; elist[e1 * T_TOK + q1] = t; } }
        RG_END(112)
    }
    GRID_BAR(); STAMP();
    {
        int ntile_ = 0;
        {   PHASE_IDS
            for (int e = 0; e < 16; ++e) ntile_ += (cnt[e * CNT_STRIDE] + 255) >> 8; }
#pragma unroll 1
        for (int ti = (int)blockIdx.x; ti < ntile_; ti += (int)gridDim.x) {
            {   PHASE_IDS
                MoeOrder S{cnt, 1, 1, ti}; pg8::Unit u; S.next(0, u);
                const int e = u.pn, nv = cnt[e * CNT_STRIDE] - u.aux * 256; const int* amap = elist + (size_t)e * T_TOK + u.aux * 256;
                pg8::Gemm g{x1b, We13_t, 0, 0, DM, DM, DM, amap, nv}; EpiSwiglu E{act, amap, nv, rstd1}; TwoUnits S2{u.pm, e * 2, u.aux};
                __syncthreads();
                pg8::gemm_phase<EpiSwiglu, TwoUnits, false, true, true>((PG8_LAS unsigned char*)lds_raw, g, S2, E, tid512);
                asm volatile("s_waitcnt vmcnt(0)" ::: "memory");
                __syncthreads();
                if (tid512 == 0) { __builtin_amdgcn_fence(__ATOMIC_ACQUIRE, "agent"); asm volatile("s_waitcnt vmcnt(0)" ::: "memory"); }
                __syncthreads();
            }
            {   PHASE_IDS
                MoeOrder S{cnt, 1, 1, ti}; pg8::Unit u; S.next(0, u);
                int k2_ = 256; asm volatile("" : "+s"(k2_));
                pg8::Gemm g{act, We2_t, 0, 0, k2_, k2_, k2_}; FourUnits S4{u.pm, u.pn * 4}; EpiStoreBf E{y2, DM, 3};
                pg8::gemm_phase<EpiStoreBf, FourUnits, true, true>((PG8_LAS unsigned char*)lds_raw, g, S4, E, tid512);
            }
        }
        {   PHASE_IDS
            __syncthreads();
            const int extra = ntile_ < (int)gridDim.x - 1 ? ntile_ : (int)gridDim.x - 1;
            pg8::Gemm g{pb, Wpp_t, T_TOK, DM, 256, 256, 256}; EpiStoreBf E{PP, DM, 3}; PPOrder SP{extra, (int)gridDim.x, (int)blockIdx.x};
            pg8::gemm_phase<EpiStoreBf, PPOrder, true, true>((PG8_LAS unsigned char*)lds_raw, g, SP, E, tid512);
        }
    }
    GRID_BAR(); STAMP();
    {   PHASE_IDS
        for (int t = gw; t < T_TOK; t += NGW) {
            int4 ri = *(const int4*)(rinfo + (size_t)t * 4); ri.x = __builtin_amdgcn_readfirstlane(ri.x); ri.y = __builtin_amdgcn_readfirstlane(ri.y); ri.z = __builtin_amdgcn_readfirstlane(ri.z); ri.w = __builtin_amdgcn_readfirstlane(ri.w);
            const int r0 = moe_base_row(cnt, ri.x & 255) + (ri.y & 0xffff), r1 = moe_base_row(cnt, (ri.x >> 8) & 255) + ((ri.y >> 16) & 0xffff);
            const float w0 = __int_as_float(ri.z), w1 = __int_as_float(ri.w);
            float4 v[4]; float s2 = 0.f;
#pragma unroll
            for (int j = 0; j < 4; ++j) { v[j] = ((const float4*)(out + (size_t)t * DM))[lane64 + 64 * j];
                const uint2 a0 = ((const uint2*)(y2 + (size_t)r0 * DM))[lane64 + 64 * j], a1 = ((const uint2*)(y2 + (size_t)r1 * DM))[lane64 + 64 * j];
                v[j].x += w0 * __uint_as_float(a0.x << 16) + w1 * __uint_as_float(a1.x << 16); v[j].y += w0 * __uint_as_float(a0.x & 0xffff0000u) + w1 * __uint_as_float(a1.x & 0xffff0000u);
                v[j].z += w0 * __uint_as_float(a0.y << 16) + w1 * __uint_as_float(a1.y << 16); v[j].w += w0 * __uint_as_float(a0.y & 0xffff0000u) + w1 * __uint_as_float(a1.y & 0xffff0000u);
                s2 += v[j].x * v[j].x + v[j].y * v[j].y + v[j].z * v[j].z + v[j].w * v[j].w; }
            s2 = wave_sum(s2);
            if (lane64 == 0) rstd2[t] = rsqrtf(s2 * (1.f / DM) + 1e-6f);
#pragma unroll
            for (int j = 0; j < 4; ++j) { ((float4*)(out + (size_t)t * DM))[lane64 + 64 * j] = v[j]; uint2 o; o.x = pk2(v[j].x, v[j].y); o.y = pk2(v[j].z, v[j].w); ((uint2*)(x2b + (size_t)t * DM))[lane64 + 64 * j] = o; }
        }
    }
    GRID_BAR(); STAMP();
    if ((int)gridDim.x == 256) {
        PHASE_IDS
        __syncthreads();
        pg8::StaticOrder S; S.init(T_TOK, DM, (int)gridDim.x, (int)blockIdx.x);
        pg8::Gemm g{x2b, Wpg_t, T_TOK, DM, DM, DM, DM}; EpiPleFinal E{out, PP, rstd2, g_final, out, (float*)(ws + 251 * MiB), (unsigned*)(ws + 42 * MiB + 40960)};
        pg8::gemm_phase<EpiPleFinal, pg8::StaticOrder, false, true>((PG8_LAS unsigned char*)lds_raw, g, S, E, tid512);
        if (SPIN_PHASE >= 0 && blockIdx.x == 0) { __syncthreads(); STAMP(); const unsigned long long t0_ = __builtin_amdgcn_s_memrealtime(); while (__builtin_amdgcn_s_memrealtime() - t0_ < 8ull * ts_probe_) __builtin_amdgcn_s_sleep(4); }
    } else {
        {   PHASE_IDS
            __syncthreads();
            pg8::StaticOrder S; S.init(T_TOK, DM, (int)gridDim.x, (int)blockIdx.x);
            pg8::Gemm g{x2b, Wpg_t, T_TOK, DM, DM, DM, DM}; EpiPle2 E{out, PP, rstd2};
            pg8::gemm_phase<EpiPle2, pg8::StaticOrder, true, true>((PG8_LAS unsigned char*)lds_raw, g, S, E, tid512);
        }
        GRID_BAR();
        {   PHASE_IDS
            VB_LOOP(T_TOK / 4) rmsnorm_rows(vb, tid, out, g_final, (bf16_t*)nullptr, out, T_TOK);
        }
    }
}

extern "C" void kernel_launch(void* const* d_in, const int* in_sizes, int n_in, void* d_out, int out_size, void* d_ws, size_t ws_size, hipStream_t stream) {
    static int grid_blocks = 0;
    if (grid_blocks == 0) {
        int dev = 0, cus = 0, per_cu = 0;
        (void)hipGetDevice(&dev);
        (void)hipDeviceGetAttribute(&cus, hipDeviceAttributeMultiprocessorCount, dev);
        (void)hipFuncSetAttribute((const void*)mk_fwd, hipFuncAttributeMaxDynamicSharedMemorySize, LDS_BYTES);
        (void)hipOccupancyMaxActiveBlocksPerMultiprocessor(&per_cu, (const void*)mk_fwd, 512, LDS_BYTES);
        if (per_cu < 1) { fprintf(stderr, "kernel_launch: occupancy query returned %d\n", per_cu); per_cu = 1; }
        grid_blocks = cus * 1;
        fprintf(stderr, "kernel_launch: cus=%d per_cu=%d grid=%d ws=%zu\n", cus, per_cu, grid_blocks, ws_size);
    }
    (void)hipMemsetAsync((char*)d_ws + ((size_t)42 << 20), 0, 131072, stream);
    Args a{};
    for (int i = 0; i < 29; ++i) a.in[i] = (const float*)d_in[i];
    a.out = (float*)d_out; a.ws = (char*)d_ws; a.rep_mask = REP_MASK; a.pad = 0;
    void* args[] = {&a};
    hipError_t e = hipLaunchCooperativeKernel((const void*)mk_fwd, dim3(grid_blocks), dim3(512), args, LDS_BYTES, stream);
    if (e != hipSuccess) fprintf(stderr, "cooperative launch failed: %s (grid %d)\n", hipGetErrorString(e), grid_blocks);
    (void)in_sizes; (void)n_in; (void)out_size; (void)ws_size;
}
```

```cpp
#include <hip/hip_runtime.h>
#include <cstdint>
#include <cstdio>
#include <hip/hip_cooperative_groups.h>
namespace cg = cooperative_groups;

typedef unsigned short bf16_t;
typedef short bf16x8 __attribute__((ext_vector_type(8)));
typedef float f32x16 __attribute__((ext_vector_type(16)));

#define DI __device__ __forceinline__

constexpr int T_TOK = 16384, SEQ = 4096, DM = 1024, DIN = 5408, NIN = 5632;
#ifndef SPIN_PHASE
#define SPIN_PHASE (-1)
#endif
#define RG_BEGIN(id) unsigned long long rt0_##id = 0ull; if (SPIN_PHASE == (id) && blockIdx.x == 0) rt0_##id = __builtin_amdgcn_s_memrealtime();
#define RG_END(id) if (SPIN_PHASE == (id) && blockIdx.x == 0) pacc += __builtin_amdgcn_s_memrealtime() - rt0_##id;
constexpr int CNT_STRIDE = 64;
constexpr float QSCALE = 0.125f * 1.4426950408889634f;
constexpr int ZC_Q = 0, ZC_KC = 512, ZC_VC = 640, ZC_KS = 768, ZC_VS = 896, ZC_KW = 1024, ZC_VW = 1152, ZC_GATE = 1280,
              ZC_MQK = 1304, ZC_MV = 2328, ZC_MO = 2840, ZC_IF = 3352, ZC_GA = 3360, ZC_GB = 4384;

DI bf16_t f2bf(float f) { unsigned u = __float_as_uint(f); return (bf16_t)((u + 0x7fffu + ((u >> 16) & 1u)) >> 16); }
DI float bf2f(bf16_t h) { return __uint_as_float(((unsigned)h) << 16); }
DI float sigmoidf_(float x) { return 1.f / (1.f + __expf(-x)); }
DI int lane_id_opaque() { int z = 0; asm volatile("" : "+v"(z)); return __builtin_amdgcn_mbcnt_hi(-1, __builtin_amdgcn_mbcnt_lo(-1, z)); }
DI float lane_xor(float v, int o, int lane) { return __int_as_float(__builtin_amdgcn_ds_bpermute((lane ^ o) << 2, __float_as_int(v))); }
DI float lane_get(float v, int src) { return __int_as_float(__builtin_amdgcn_ds_bpermute(src << 2, __float_as_int(v))); }
DI float wave_sum(float v) {
    const int l = lane_id_opaque();
#pragma unroll
    for (int o = 1; o < 64; o <<= 1) v += lane_xor(v, o, l);
    return v;
}
DI float wave_max(float v) {
    const int l = lane_id_opaque();
#pragma unroll
    for (int o = 1; o < 64; o <<= 1) v = fmaxf(v, lane_xor(v, o, l));
    return v;
}

namespace pg8 {
#define PG8_LAS __attribute__((address_space(3)))
typedef unsigned short bf16_t;
typedef short bf16x8 __attribute__((ext_vector_type(8)));
typedef float f32x4 __attribute__((ext_vector_type(4)));
typedef unsigned u32x4 __attribute__((ext_vector_type(4)));
constexpr int BM = 256, BK = 64, HALF = 128, HTB = HALF * BK * 2  , STAGE_BYTES = 8 * HTB, NXCD = 8, WGM = 8;

__host__ __device__ __forceinline__ int lds_byte(int r, int c) { const int st = (r >> 4) * 2 + (c >> 5), rr = r & 15, cc = c & 31, ob = rr * 64 + cc * 2; return st * 1024 + (ob ^ (((ob >> 9) & 1) << 5)); }
__host__ __device__ __forceinline__ void stage_rc(int b, int& R, int& C) { const int st = b / 1024, sb = b % 1024, swz = sb ^ (((sb >> 9) & 1) << 5); R = (st >> 1) * 16 + swz / 64; C = (st & 1) * 32 + (swz % 64) / 2; }
__host__ __device__ __forceinline__ int perm32(int rho) { const int n = rho >> 4, i = rho & 15; return 8 * (i >> 2) + 4 * n + (i & 3); }

struct Unit { int pm, pn, aux; };
struct Gemm { const bf16_t* A; const bf16_t* Bt; int M, N, K, lda, ldb; const int* amap; int avalid; };

struct StaticOrder {
    int nM, nN, nwg, G, c;
    __host__ __device__ __forceinline__ void init(int M, int N, int G_, int c_) { nM = M / BM; nN = N / BM; nwg = nM * nN; G = G_; c = c_; }
    __host__ __device__ __forceinline__ bool next(int i, Unit& u) const {
        const long L = (long)i * G + c; if (L >= nwg) return false;
        int wgid = (int)L; { const int q = nwg / NXCD, r = nwg % NXCD, xcd = wgid % NXCD, off = wgid / NXCD; wgid = (xcd < r ? xcd * (q + 1) : r * (q + 1) + (xcd - r) * q) + off; }
        const int nig = WGM * nN, gid = wgid / nig, fm = gid * WGM, gsz = (nM - fm) < WGM ? (nM - fm) : WGM;
        u.pm = fm + ((wgid % nig) % gsz); u.pn = (wgid % nig) / gsz; u.aux = 0; return true;
    }
    __device__ __forceinline__ void a_ready(const Unit&) const {}
    __device__ __forceinline__ void done(const Unit&) const {}
};

__device__ __forceinline__ unsigned cvt_pk_bf16(float lo, float hi) { unsigned r; asm volatile("v_cvt_pk_bf16_f32 %0, %1, %2" : "=v"(r) : "v"(lo), "v"(hi)); return r; }
typedef float f32x2 __attribute__((ext_vector_type(2)));
__device__ __forceinline__ f32x2 gelu_pk(f32x2 v) {
    const f32x2 av = __builtin_elementwise_abs(v), d = av * 0.2316418882f + 1.0f;
    f32x2 t; t.x = __builtin_amdgcn_rcpf(d.x); t.y = __builtin_amdgcn_rcpf(d.y);
    f32x2 q = t * 0.5307027145f + (-0.7265760135f); q = q * t + 0.7107068705f; q = q * t + (-0.142248368f); q = q * t + 0.127414796f; q = q * t;
    const f32x2 s = (v * v) * (-0.72134752044f);
    f32x2 e; e.x = __builtin_amdgcn_exp2f(s.x); e.y = __builtin_amdgcn_exp2f(s.y);
    const f32x2 m = v * (q * e), r = v - m;
    f32x2 o; o.x = v.x < 0.f ? m.x : r.x; o.y = v.y < 0.f ? m.y : r.y; return o;
}

template <int ACT  > struct EpiBf16 {
    static constexpr bool PERM = true, AFTER_DRAIN = false; static constexpr int MIDK = 0; static_assert(ACT == 0 || ACT == 1, "EpiBf16: ACT is 0 (none) or 1 (gelu_pk)");
    bf16_t* O; int ldc; const float* bias; int split_cols; size_t split_stride; float scale0;
    __device__ __forceinline__ void operator()(const f32x4 (&acc)[2][2][4][2], const Unit& u, int wr, int wc, int fr, int fq) const {
        const int row0 = u.pm * BM + wr * 64 + fr; int colt = u.pn * BM; bf16_t* base = O;
        float sc = 1.f; if (split_cols) { const int t = colt / split_cols; base += (size_t)t * split_stride; colt -= t * split_cols; if (t == 0) sc = scale0; }
        const int col0 = colt + wc * 32 + 8 * fq, bcol0 = u.pn * BM + wc * 32 + 8 * fq;
        f32x4 bv[2][2];
#pragma unroll
        for (int bj = 0; bj < 2; ++bj)
#pragma unroll
            for (int n = 0; n < 2; ++n) bv[bj][n] = bias ? *(const f32x4*)(bias + bcol0 + bj * HALF + 4 * n) : (f32x4){0.f, 0.f, 0.f, 0.f};
#pragma unroll
        for (int ai = 0; ai < 2; ++ai)
#pragma unroll
            for (int m = 0; m < 4; ++m) { bf16_t* rowp = base + (size_t)(row0 + ai * HALF + m * 16) * ldc + col0;
#pragma unroll
                for (int bj = 0; bj < 2; ++bj) { f32x4 v0 = acc[ai][bj][m][0] + bv[bj][0], v1 = acc[ai][bj][m][1] + bv[bj][1];
                    if (ACT == 1) { f32x2 a = gelu_pk((f32x2){v0[0], v0[1]}), b = gelu_pk((f32x2){v0[2], v0[3]}), c = gelu_pk((f32x2){v1[0], v1[1]}), d = gelu_pk((f32x2){v1[2], v1[3]});
                        v0 = (f32x4){a.x, a.y, b.x, b.y}; v1 = (f32x4){c.x, c.y, d.x, d.y}; }
                    v0 = v0 * sc; v1 = v1 * sc; u32x4 w; w.x = cvt_pk_bf16(v0[0], v0[1]); w.y = cvt_pk_bf16(v0[2], v0[3]); w.z = cvt_pk_bf16(v1[0], v1[1]); w.w = cvt_pk_bf16(v1[2], v1[3]);
                    *(u32x4*)(rowp + bj * HALF) = w; } }
    }
};

template <class Epi, class Sched, bool ALIGN_EPI = false, bool SP2 = false, bool GATHER = false>
__device__ __forceinline__ void gemm_phase(PG8_LAS unsigned char* lds, const Gemm g, const Sched& S, const Epi& E, const int tid) {
    const int wid = __builtin_amdgcn_readfirstlane(tid >> 6), lane = tid & 63, wr = wid >> 2, wc = wid & 3, fr = lane & 15, fq = lane >> 4;
    const int K = g.K, nt = K / BK;
    unsigned voffA[2], voffB[2], voffA1[2];
#pragma unroll
    for (int i = 0; i < 2; ++i) { int R, C; stage_rc(tid * 16 + i * 8192, R, C); const int Rb = Epi::PERM ? ((R & ~31) + perm32(R & 31)) : R;
        voffA[i] = (unsigned)(R * g.lda + C) * 2u; voffB[i] = (unsigned)(Rb * g.ldb + C) * 2u; voffA1[i] = voffA[i];
        if constexpr (GATHER) { const int t0_ = R < g.avalid ? g.amap[R] : 0, t1_ = R + HALF < g.avalid ? g.amap[R + HALF] : 0; voffA[i] = (unsigned)(t0_ * g.lda + C) * 2u; voffA1[i] = (unsigned)(t1_ * g.lda + C) * 2u; } }
    const size_t kstep = (size_t)(BK * 2);
    const size_t hstepA = (size_t)HALF * g.lda * 2, hstepB = (size_t)HALF * g.ldb * 2;
    const size_t tstepA = GATHER ? 0 : 2 * hstepA, tstepB = 2 * hstepB, hsA = GATHER ? 0 : hstepA;
    const unsigned ldsw = (unsigned)wid * 1024u;
    const int aoff = lds_byte(wr * 64 + fr, fq * 8), boff = lds_byte(wc * 32 + fr, fq * 8);
#define PG8_SA(b, h) (((b) * 2 + (h)) * HTB)
#define PG8_SB(b, h) ((4 + (b) * 2 + (h)) * HTB)
#define PG8_STAGE(bufoff, gbase, voff) do { _Pragma("unroll") for (int _i = 0; _i < 2; ++_i) \
        __builtin_amdgcn_global_load_lds((const unsigned*)((const char*)(gbase) + (voff)[_i]), (PG8_LAS unsigned*)(lds + (bufoff) + ldsw + _i * 8192), 16, 0, 0); } while (0)
#define PG8_LDA(dst, b, h) do { _Pragma("unroll") for (int m = 0; m < 4; ++m) _Pragma("unroll") for (int k = 0; k < 2; ++k) dst[m][k] = *(const PG8_LAS bf16x8*)(lds + PG8_SA(b, h) + aoff + m * 2048 + k * 1024); } while (0)
#define PG8_LDB(dst, b, h) do { _Pragma("unroll") for (int n = 0; n < 2; ++n) _Pragma("unroll") for (int k = 0; k < 2; ++k) dst[n][k] = *(const PG8_LAS bf16x8*)(lds + PG8_SB(b, h) + boff + n * 2048 + k * 1024); } while (0)
#define PG8_MMA(ai, bj, At, Bt) do { __builtin_amdgcn_s_setprio(1); _Pragma("unroll") for (int m = 0; m < 4; ++m) _Pragma("unroll") for (int n = 0; n < 2; ++n) _Pragma("unroll") for (int k = 0; k < 2; ++k) \
        acc[ai][bj][m][n] = __builtin_amdgcn_mfma_f32_16x16x32_bf16(Bt[n][k], At[m][k], acc[ai][bj][m][n], 0, 0, 0); __builtin_amdgcn_s_setprio(0); } while (0)
#define PG8_WAIT_V(n) asm volatile("s_waitcnt vmcnt(" #n ")" ::: "memory")
#define PG8_WAIT_L(n) asm volatile("s_waitcnt lgkmcnt(" #n ")" ::: "memory")
#define PG8_BAR __builtin_amdgcn_s_barrier()
#define PG8_SCHED __builtin_amdgcn_sched_barrier(0)
    Unit cur, nxt; int ui = 0;
    if (!S.next(0, cur)) return;
    f32x4 acc[2][2][4][2];
#pragma unroll
    for (int a = 0; a < 2; ++a)
#pragma unroll
        for (int b = 0; b < 2; ++b)
#pragma unroll
            for (int m = 0; m < 4; ++m)
#pragma unroll
                for (int n = 0; n < 2; ++n) acc[a][b][m][n] = (f32x4){0.f, 0.f, 0.f, 0.f};
    bf16x8 At[4][2], B0[2][2], B1[2][2];
    const char* cA = (const char*)g.A + (size_t)cur.pm * tstepA; const char* cB = (const char*)g.Bt + (size_t)cur.pn * tstepB;
    S.a_ready(cur);
    if constexpr (SP2) {
        PG8_STAGE(PG8_SB(0, 0), cB, voffB); PG8_STAGE(PG8_SB(0, 1), cB + hstepB, voffB); PG8_STAGE(PG8_SA(0, 0), cA, voffA); PG8_STAGE(PG8_SA(0, 1), cA + hsA, voffA1);
        if (wr == 1) PG8_BAR;
        PG8_WAIT_V(2); PG8_BAR;
        PG8_STAGE(PG8_SB(1, 0), cB + kstep, voffB); PG8_STAGE(PG8_SA(1, 0), cA + kstep, voffA); PG8_STAGE(PG8_SB(1, 1), cB + hstepB + kstep, voffB);
        PG8_WAIT_V(6); PG8_BAR;
    } else {
        PG8_STAGE(PG8_SB(0, 0), cB, voffB); PG8_STAGE(PG8_SA(0, 0), cA, voffA); PG8_STAGE(PG8_SB(0, 1), cB + hstepB, voffB); PG8_STAGE(PG8_SA(0, 1), cA + hsA, voffA1);
        if (wr == 1) PG8_BAR;
        PG8_WAIT_V(4); PG8_BAR;
        PG8_STAGE(PG8_SB(1, 0), cB + kstep, voffB); PG8_STAGE(PG8_SA(1, 0), cA + kstep, voffA); PG8_STAGE(PG8_SB(1, 1), cB + hstepB + kstep, voffB);
        PG8_WAIT_V(6); PG8_BAR;
    }
    for (;;) {
        const bool has_next = S.next(ui + 1, nxt);
        const char* nA = has_next ? (const char*)g.A + (size_t)nxt.pm * tstepA : cA; const char* nB = has_next ? (const char*)g.Bt + (size_t)nxt.pn * tstepB : cB;
        for (int t = 0; t < nt; t += 2) {
            const bool last = (t == nt - 2);
            const char* a1 = cA + (size_t)(t + 1) * kstep;
            const char* a2 = last ? nA : cA + (size_t)(t + 2) * kstep; const char* b2 = last ? nB : cB + (size_t)(t + 2) * kstep;
            const char* a3 = a2 + kstep; const char* b3 = b2 + kstep;
            if (last && has_next) S.a_ready(nxt);
            if constexpr (SP2) {
            PG8_LDB(B0, 0, 0); PG8_LDB(B1, 0, 1); PG8_SCHED; PG8_LDA(At, 0, 0); PG8_STAGE(PG8_SA(1, 1), a1 + hsA, voffA1);
            PG8_WAIT_V(8); PG8_WAIT_L(0); PG8_BAR; PG8_MMA(0, 0, At, B0); PG8_MMA(0, 1, At, B1); PG8_BAR; PG8_SCHED;
            PG8_LDA(At, 0, 1); PG8_STAGE(PG8_SB(0, 0), b2, voffB); PG8_STAGE(PG8_SB(0, 1), b2 + hstepB, voffB); PG8_STAGE(PG8_SA(0, 0), a2, voffA);
            PG8_WAIT_V(8); PG8_WAIT_L(0); PG8_BAR; PG8_MMA(1, 0, At, B0); PG8_MMA(1, 1, At, B1); PG8_BAR; PG8_SCHED;
            PG8_LDB(B0, 1, 0); PG8_LDB(B1, 1, 1); PG8_SCHED; PG8_LDA(At, 1, 0); PG8_STAGE(PG8_SA(0, 1), a2 + hsA, voffA1);
            PG8_WAIT_V(8); PG8_WAIT_L(0); PG8_BAR; PG8_MMA(0, 0, At, B0); PG8_MMA(0, 1, At, B1); PG8_BAR; PG8_SCHED;
            PG8_LDA(At, 1, 1); PG8_STAGE(PG8_SB(1, 0), b3, voffB); PG8_STAGE(PG8_SB(1, 1), b3 + hstepB, voffB); PG8_STAGE(PG8_SA(1, 0), a3, voffA);
            PG8_WAIT_V(8); PG8_WAIT_L(0); PG8_BAR; PG8_MMA(1, 0, At, B0); PG8_MMA(1, 1, At, B1); PG8_BAR; PG8_SCHED;
            if constexpr (Epi::MIDK > 0) { if (t + 2 == Epi::MIDK / BK) { const int l3_ = lane_id_opaque(); E.mid(acc, cur, wr, wc, l3_ & 15, l3_ >> 4); } }
            } else {
            PG8_LDB(B0, 0, 0); PG8_SCHED; PG8_LDA(At, 0, 0); PG8_STAGE(PG8_SA(1, 1), a1 + hsA, voffA1);
            PG8_WAIT_L(8); PG8_BAR; PG8_WAIT_L(0); PG8_MMA(0, 0, At, B0); PG8_BAR; PG8_SCHED;
            PG8_LDB(B1, 0, 1); PG8_STAGE(PG8_SB(0, 0), b2, voffB);
            PG8_BAR; PG8_WAIT_L(0); PG8_MMA(0, 1, At, B1); PG8_BAR;
            PG8_LDA(At, 0, 1); PG8_STAGE(PG8_SA(0, 0), a2, voffA);
            PG8_BAR; PG8_WAIT_L(0); PG8_MMA(1, 0, At, B0); PG8_BAR; PG8_SCHED;
            PG8_STAGE(PG8_SB(0, 1), b2 + hstepB, voffB);
            PG8_WAIT_V(6); PG8_BAR; PG8_MMA(1, 1, At, B1); PG8_BAR;
            PG8_LDB(B0, 1, 0); PG8_SCHED; PG8_LDA(At, 1, 0); PG8_STAGE(PG8_SA(0, 1), a2 + hsA, voffA1);
            PG8_WAIT_L(8); PG8_BAR; PG8_WAIT_L(0); PG8_MMA(0, 0, At, B0); PG8_BAR; PG8_SCHED;
            PG8_LDB(B1, 1, 1); PG8_STAGE(PG8_SB(1, 0), b3, voffB);
            PG8_BAR; PG8_WAIT_L(0); PG8_MMA(0, 1, At, B1); PG8_BAR;
            PG8_LDA(At, 1, 1); PG8_STAGE(PG8_SA(1, 0), a3, voffA);
            PG8_BAR; PG8_WAIT_L(0); PG8_MMA(1, 0, At, B0); PG8_BAR; PG8_SCHED;
            PG8_STAGE(PG8_SB(1, 1), b3 + hstepB, voffB);
            PG8_WAIT_V(6); PG8_BAR; PG8_MMA(1, 1, At, B1); PG8_BAR;
            }
        }
        if constexpr (ALIGN_EPI) { if (wr == 0) PG8_BAR; }
        if constexpr (!Epi::AFTER_DRAIN) { const int l2_ = lane_id_opaque(); E(acc, cur, wr, wc, l2_ & 15, l2_ >> 4); S.done(cur); }
        if (!has_next) break;
#pragma unroll
        for (int a = 0; a < 2; ++a)
#pragma unroll
            for (int b = 0; b < 2; ++b)
#pragma unroll
                for (int m = 0; m < 4; ++m)
#pragma unroll
                    for (int n = 0; n < 2; ++n) acc[a][b][m][n] = (f32x4){0.f, 0.f, 0.f, 0.f};
        cur = nxt; cA = nA; cB = nB; ++ui;
        if constexpr (ALIGN_EPI) { if (wr == 1) PG8_BAR; }
    }
    PG8_WAIT_V(0);
    if constexpr (!ALIGN_EPI) { if (wr == 0) PG8_BAR; }
    PG8_BAR;
    if constexpr (Epi::AFTER_DRAIN) { E.fused(acc, cur, wr, wc, fr, fq, lds, wid, lane); S.done(cur); }
#undef PG8_SA
#undef PG8_SB
#undef PG8_STAGE
#undef PG8_LDA
#undef PG8_LDB
#undef PG8_MMA
#undef PG8_WAIT_V
#undef PG8_WAIT_L
#undef PG8_BAR
#undef PG8_SCHED
}
}


#define LAS __attribute__((address_space(3)))
DI unsigned pk2(float lo, float hi) { return (unsigned)f2bf(lo) | ((unsigned)f2bf(hi) << 16); }
template <class Map>
DI void prep_wt_item(const float* __restrict__ W, int ldw, int K, bf16_t* __restrict__ WT, const float* __restrict__ gain, Map map, float* scr, int item, int nblk, int lane) {
    const int kb = item / nblk, nb = item % nblk, k0 = 64 * kb, n0 = 32 * nb;
    const int srcn = map(n0 + (lane & 31));
    float tv[32];
#pragma unroll
    for (int i = 0; i < 32; ++i) { const int kk = 2 * i + (lane >> 5); tv[i] = srcn >= 0 ? W[(size_t)(k0 + kk) * ldw + srcn] : 0.f; }
#pragma unroll
    for (int i = 0; i < 32; ++i) { const int kk = 2 * i + (lane >> 5); scr[kk * 33 + (lane & 31)] = gain ? tv[i] * gain[k0 + kk] : tv[i]; }
    __builtin_amdgcn_s_waitcnt(0xC07F); asm volatile("" ::: "memory");
    const int c = lane & 7;
#pragma unroll
    for (int j = 0; j < 4; ++j) { const int n = (lane >> 3) + 8 * j; const float* s = scr + (8 * c) * 33 + n;
        uint4 o; o.x = pk2(s[0 * 33], s[1 * 33]); o.y = pk2(s[2 * 33], s[3 * 33]); o.z = pk2(s[4 * 33], s[5 * 33]); o.w = pk2(s[6 * 33], s[7 * 33]);
        *(uint4*)(WT + (size_t)(n0 + n) * K + k0 + 8 * c) = o; }
    __builtin_amdgcn_s_waitcnt(0xC07F); asm volatile("" ::: "memory");
}
template <class Map>
DI void prep_wt_item2(const float* __restrict__ Wa, const float* __restrict__ Wb, int ldw, int K, bf16_t* __restrict__ WTa, bf16_t* __restrict__ WTb, const float* __restrict__ gain, Map map, float* scr, int itemA, int itemB, int nblk, int lane) {
    const int ka = 64 * (itemA / nblk), na = 32 * (itemA % nblk), kb = 64 * (itemB / nblk), nb = 32 * (itemB % nblk);
    const int sa = map(na + (lane & 31)), sb = map(nb + (lane & 31));
    float ta[32], tb[32];
#pragma unroll
    for (int i = 0; i < 32; ++i) { const int kk = 2 * i + (lane >> 5); ta[i] = sa >= 0 ? Wa[(size_t)(ka + kk) * ldw + sa] : 0.f; }
#pragma unroll
    for (int i = 0; i < 32; ++i) { const int kk = 2 * i + (lane >> 5); tb[i] = sb >= 0 ? Wb[(size_t)(kb + kk) * ldw + sb] : 0.f; }
#pragma unroll
    for (int i = 0; i < 32; ++i) { const int kk = 2 * i + (lane >> 5); scr[kk * 33 + (lane & 31)] = gain ? ta[i] * gain[ka + kk] : ta[i]; }
#pragma unroll
    for (int i = 0; i < 32; ++i) { const int kk = 2 * i + (lane >> 5); scr[2112 + kk * 33 + (lane & 31)] = gain ? tb[i] * gain[kb + kk] : tb[i]; }
    __builtin_amdgcn_s_waitcnt(0xC07F); asm volatile("" ::: "memory");
    const int c = lane & 7;
#pragma unroll
    for (int j = 0; j < 4; ++j) { const int n = (lane >> 3) + 8 * j; const float* s = scr + (8 * c) * 33 + n;
        uint4 o; o.x = pk2(s[0 * 33], s[1 * 33]); o.y = pk2(s[2 * 33], s[3 * 33]); o.z = pk2(s[4 * 33], s[5 * 33]); o.w = pk2(s[6 * 33], s[7 * 33]);
        *(uint4*)(WTa + (size_t)(na + n) * K + ka + 8 * c) = o;
        const float* s2 = s + 2112;
        uint4 o2; o2.x = pk2(s2[0 * 33], s2[1 * 33]); o2.y = pk2(s2[2 * 33], s2[3 * 33]); o2.z = pk2(s2[4 * 33], s2[5 * 33]); o2.w = pk2(s2[6 * 33], s2[7 * 33]);
        *(uint4*)(WTb + (size_t)(nb + n) * K + kb + 8 * c) = o2; }
    __builtin_amdgcn_s_waitcnt(0xC07F); asm volatile("" ::: "memory");
}
struct MapIn {
    DI int operator()(int n) const {
        if (n < 1280) return n;
        if (n < 1536) { const int i = n - 1280; return i < 24 ? ZC_GATE + i : (i < 32 ? ZC_IF + (i - 24) : -1); }
        if (n < 2560) return ZC_MQK + (n - 1536);
        if (n < 3072) return ZC_MV + (n - 2560);
        if (n < 3584) return ZC_MO + (n - 3072);
        return ZC_GA + (n - 3584);
    }
};
DI void prep_x_row(const float* __restrict__ x, bf16_t* __restrict__ xb, float* __restrict__ rstd, int row, int lane) {
    const float4* xr = (const float4*)(x + (size_t)row * DM);
    float4 v[4]; float s = 0.f;
#pragma unroll
    for (int j = 0; j < 4; ++j) { v[j] = xr[lane + 64 * j]; s += v[j].x * v[j].x + v[j].y * v[j].y + v[j].z * v[j].z + v[j].w * v[j].w; }
    s = wave_sum(s);
    if (lane == 0) rstd[row] = rsqrtf(s * (1.f / DM) + 1e-6f);
#pragma unroll
    for (int j = 0; j < 4; ++j) { uint2 o; o.x = pk2(v[j].x, v[j].y); o.y = pk2(v[j].z, v[j].w); ((uint2*)(xb + (size_t)row * DM))[lane + 64 * j] = o; }
}

struct EpiInProj {
    static constexpr bool PERM = true, AFTER_DRAIN = false; static constexpr int MIDK = 0;
    const float* rstd; const float* cosT; const float* sinT; const float* b_if;
    bf16_t* Qb; bf16_t* KVb; float* gates; float* ifp; bf16_t* MQK; bf16_t* MV; bf16_t* MO; bf16_t* MG; bf16_t* VT;
    DI void operator()(const pg8::f32x4 (&acc)[2][2][4][2], const pg8::Unit& u, int wr, int wc, int fr, int fq) const {
        const int pn = u.pn;
        asm volatile("" : "+v"(fr), "+v"(fq));
#pragma unroll
        for (int ai = 0; ai < 2; ++ai)
#pragma unroll
            for (int m = 0; m < 4; ++m) {
                const int row = u.pm * 256 + ai * 128 + wr * 64 + m * 16 + fr;
                const float rs = rstd[row];
#pragma unroll
                for (int bj = 0; bj < 2; ++bj) {
                    float v[8];
#pragma unroll
                    for (int i = 0; i < 4; ++i) { v[i] = acc[ai][bj][m][0][i] * rs; v[4 + i] = acc[ai][bj][m][1][i] * rs; }
                    const int c0 = bj * 128 + wc * 32 + 8 * fq;
                    if (pn <= 4) {
                        const bool is_k = (pn < 2) || (bj == 0);
                        if (is_k && (wc & 1) == 0) {
                            const float4 c_lo = *(const float4*)(cosT + (size_t)row * 8), c_hi = *(const float4*)(cosT + (size_t)row * 8 + 4);
                            const float4 s_lo = *(const float4*)(sinT + (size_t)row * 8), s_hi = *(const float4*)(sinT + (size_t)row * 8 + 4);
                            const float cs[8] = {c_lo.x, c_lo.y, c_lo.z, c_lo.w, c_hi.x, c_hi.y, c_hi.z, c_hi.w};
                            const float sn[8] = {s_lo.x, s_lo.y, s_lo.z, s_lo.w, s_hi.x, s_hi.y, s_hi.z, s_hi.w};
                            const int l_ = lane_id_opaque();
#pragma unroll
                            for (int i = 0; i < 8; ++i) {
                                const float other = lane_xor(v[i], 16, l_);
                                if (fq == 0) v[i] = v[i] * cs[i] - other * sn[i];
                                else if (fq == 1) v[i] = v[i] * cs[i] + other * sn[i];
                            }
                        }
                        const float sc = pn < 2 ? QSCALE : 1.f;
                        pg8::u32x4 w; w.x = pg8::cvt_pk_bf16(v[0] * sc, v[1] * sc); w.y = pg8::cvt_pk_bf16(v[2] * sc, v[3] * sc); w.z = pg8::cvt_pk_bf16(v[4] * sc, v[5] * sc); w.w = pg8::cvt_pk_bf16(v[6] * sc, v[7] * sc);
                        if (pn < 2) *(pg8::u32x4*)(Qb + (size_t)row * 512 + pn * 256 + c0) = w;
                        else if (pn == 2) *(pg8::u32x4*)(KVb + (size_t)row * 512 + c0) = w;
                        else if (bj == 0) *(pg8::u32x4*)(KVb + (size_t)row * 512 + (pn - 2) * 128 + 128 + wc * 32 + 8 * fq) = w;
                        else {
                            const int cv = wc * 32 + 8 * fq, gg = cv >> 6, d0 = cv & 63, bb = row >> 12, tt = row & 4095;
                            bf16_t* vt = VT + ((size_t)((pn - 3) * 8 + bb * 2 + gg) * 64 + (tt >> 6)) * 4096 + (size_t)d0 * 64 + (tt & 63);
                            vt[0] = (bf16_t)(w.x & 0xffffu); vt[64] = (bf16_t)(w.x >> 16); vt[128] = (bf16_t)(w.y & 0xffffu); vt[192] = (bf16_t)(w.y >> 16);
                            vt[256] = (bf16_t)(w.z & 0xffffu); vt[320] = (bf16_t)(w.z >> 16); vt[384] = (bf16_t)(w.w & 0xffffu); vt[448] = (bf16_t)(w.w >> 16);
                        }
                    } else if (pn == 5) {
                        if (bj == 0 && wc == 0) {
#pragma unroll
                            for (int i = 0; i < 8; ++i) { const int c = 8 * fq + i;
                                if (c < 24) gates[(size_t)row * 24 + c] = sigmoidf_(v[i]);
                                else if (c < 32) ifp[(size_t)row * 8 + (c - 24)] = v[i] + b_if[c - 24]; }
                        }
                    } else {
                        if (pn >= 14) {
#pragma unroll
                            for (int i = 0; i < 8; ++i) v[i] = sigmoidf_(v[i]);
                        }
                        pg8::u32x4 w; w.x = pg8::cvt_pk_bf16(v[0], v[1]); w.y = pg8::cvt_pk_bf16(v[2], v[3]); w.z = pg8::cvt_pk_bf16(v[4], v[5]); w.w = pg8::cvt_pk_bf16(v[6], v[7]);
                        bf16_t* dst;
                        if (pn < 10) dst = MQK + (size_t)row * 1024 + (pn - 6) * 256 + c0;
                        else if (pn < 12) dst = MV + (size_t)row * 512 + (pn - 10) * 256 + c0;
                        else if (pn < 14) dst = MO + (size_t)row * 512 + (pn - 12) * 256 + c0;
                        else dst = MG + (size_t)row * 2048 + (pn - 14) * 256 + c0;
                        *(pg8::u32x4*)dst = w;
                    }
                }
            }
    }
};


DI pg8::u32x4 pack8(const float (&v)[8]) { pg8::u32x4 w; w.x = pg8::cvt_pk_bf16(v[0], v[1]); w.y = pg8::cvt_pk_bf16(v[2], v[3]); w.z = pg8::cvt_pk_bf16(v[4], v[5]); w.w = pg8::cvt_pk_bf16(v[6], v[7]); return w; }
DI void unpack8(const pg8::u32x4 w, float (&v)[8]) {
    v[0] = __uint_as_float(w.x << 16); v[1] = __uint_as_float(w.x & 0xffff0000u); v[2] = __uint_as_float(w.y << 16); v[3] = __uint_as_float(w.y & 0xffff0000u);
    v[4] = __uint_as_float(w.z << 16); v[5] = __uint_as_float(w.z & 0xffff0000u); v[6] = __uint_as_float(w.w << 16); v[7] = __uint_as_float(w.w & 0xffff0000u);
}
#define EPI_ROWS_BEGIN asm volatile("" : "+v"(fr), "+v"(fq)); _Pragma("unroll") for (int ai = 0; ai < 2; ++ai) _Pragma("unroll") for (int m = 0; m < 4; ++m) { const int row = u.pm * 256 + ai * 128 + wr * 64 + m * 16 + fr; _Pragma("unroll") for (int bj = 0; bj < 2; ++bj) { \
    float v[8]; _Pragma("unroll") for (int i = 0; i < 4; ++i) { v[i] = acc[ai][bj][m][0][i]; v[4 + i] = acc[ai][bj][m][1][i]; } const int c0 = bj * 128 + wc * 32 + 8 * fq; (void)c0; (void)row;
#define EPI_ROWS_END } asm volatile("" ::: "memory"); }
template <int MODE> struct EpiMerge {
    static constexpr bool PERM = true, AFTER_DRAIN = false; static constexpr int MIDK = 0;
    const bf16_t* MG; float* tmp; bf16_t* mixed;
    DI void operator()(const pg8::f32x4 (&acc)[2][2][4][2], const pg8::Unit& u, int wr, int wc, int fr, int fq) const {
        EPI_ROWS_BEGIN
            const int col = u.pn * 256 + c0; float gt[8];
            unpack8(*(const pg8::u32x4*)(MG + (size_t)row * 2048 + MODE * 1024 + col), gt);
            float* tp = tmp + (size_t)row * DM + col;
            if (MODE == 0) {
                *(float4*)tp = make_float4(gt[0] * v[0], gt[1] * v[1], gt[2] * v[2], gt[3] * v[3]); *(float4*)(tp + 4) = make_float4(gt[4] * v[4], gt[5] * v[5], gt[6] * v[6], gt[7] * v[7]);
            } else {
                const float4 t0 = *(const float4*)tp, t1 = *(const float4*)(tp + 4);
                float o[8] = {t0.x + gt[0] * v[0], t0.y + gt[1] * v[1], t0.z + gt[2] * v[2], t0.w + gt[3] * v[3], t1.x + gt[4] * v[4], t1.y + gt[5] * v[5], t1.z + gt[6] * v[6], t1.w + gt[7] * v[7]};
                *(pg8::u32x4*)(mixed + (size_t)row * DM + col) = pack8(o);
            }
        EPI_ROWS_END
    }
};
struct EpiMerge2 {
    static constexpr bool PERM = true, AFTER_DRAIN = false; static constexpr int MIDK = 512;
    const bf16_t* MG; bf16_t* mixed;
    DI void mid(pg8::f32x4 (&acc)[2][2][4][2], const pg8::Unit& u, int wr, int wc, int fr, int fq) const {
#pragma unroll
        for (int ai = 0; ai < 2; ++ai)
#pragma unroll
            for (int m = 0; m < 4; ++m) { const int row = u.pm * 256 + ai * 128 + wr * 64 + m * 16 + fr;
#pragma unroll
                for (int bj = 0; bj < 2; ++bj) {
                    const int col = u.pn * 256 + bj * 128 + wc * 32 + 8 * fq; float ga[8], gb[8];
                    unpack8(*(const pg8::u32x4*)(MG + (size_t)row * 2048 + col), ga); unpack8(*(const pg8::u32x4*)(MG + (size_t)row * 2048 + 1024 + col), gb);
#pragma unroll
                    for (int i = 0; i < 4; ++i) { acc[ai][bj][m][0][i] *= ga[i] * __builtin_amdgcn_rcpf(gb[i]); acc[ai][bj][m][1][i] *= ga[4 + i] * __builtin_amdgcn_rcpf(gb[4 + i]); }
                }
                asm volatile("" ::: "memory"); }
    }
    DI void operator()(const pg8::f32x4 (&acc)[2][2][4][2], const pg8::Unit& u, int wr, int wc, int fr, int fq) const {
        EPI_ROWS_BEGIN
            const int col = u.pn * 256 + c0; float gb[8];
            unpack8(*(const pg8::u32x4*)(MG + (size_t)row * 2048 + 1024 + col), gb);
            float o[8] = {gb[0] * v[0], gb[1] * v[1], gb[2] * v[2], gb[3] * v[3], gb[4] * v[4], gb[5] * v[5], gb[6] * v[6], gb[7] * v[7]};
            *(pg8::u32x4*)(mixed + (size_t)row * DM + col) = pack8(o);
        EPI_ROWS_END
    }
};
struct EpiX1 {
    static constexpr bool PERM = true, AFTER_DRAIN = false; static constexpr int MIDK = 0;
    const float* base; float* out; bf16_t* outb;
    DI void operator()(const pg8::f32x4 (&acc)[2][2][4][2], const pg8::Unit& u, int wr, int wc, int fr, int fq) const {
        EPI_ROWS_BEGIN
            const size_t o = (size_t)row * DM + u.pn * 256 + c0;
            const float4 b0 = *(const float4*)(base + o), b1 = *(const float4*)(base + o + 4);
            const float r[8] = {b0.x + v[0], b0.y + v[1], b0.z + v[2], b0.w + v[3], b1.x + v[4], b1.y + v[5], b1.z + v[6], b1.w + v[7]};
            *(float4*)(out + o) = make_float4(r[0], r[1], r[2], r[3]); *(float4*)(out + o + 4) = make_float4(r[4], r[5], r[6], r[7]);
            *(pg8::u32x4*)(outb + o) = pack8(r);
        EPI_ROWS_END
    }
};
struct EpiStoreBf {
    static constexpr bool PERM = true, AFTER_DRAIN = false; static constexpr int MIDK = 0;
    bf16_t* O; int ld; int pnmask;
    DI void operator()(const pg8::f32x4 (&acc)[2][2][4][2], const pg8::Unit& u, int wr, int wc, int fr, int fq) const {
        EPI_ROWS_BEGIN
            *(pg8::u32x4*)(O + (size_t)row * ld + (u.pn & pnmask) * 256 + c0) = pack8(v);
        EPI_ROWS_END
    }
};
struct EpiSwiglu {
    static constexpr bool PERM = true, AFTER_DRAIN = false; static constexpr int MIDK = 0;
    bf16_t* act; const int* amap; int avalid; const float* rstd1;
    DI void operator()(const pg8::f32x4 (&acc)[2][2][4][2], const pg8::Unit& u, int wr, int wc, int fr, int fq) const {
        asm volatile("" : "+v"(fr), "+v"(fq));
#pragma unroll
        for (int ai = 0; ai < 2; ++ai)
#pragma unroll
            for (int m = 0; m < 4; ++m) {
                const int rl = ai * 128 + wr * 64 + m * 16 + fr, row = u.pm * 256 + rl; float o[8];
                const float rs = rl < avalid ? rstd1[amap[rl]] : 0.f;
#pragma unroll
                for (int i = 0; i < 4; ++i) { const float g0 = rs * acc[ai][0][m][0][i], g1 = rs * acc[ai][0][m][1][i]; o[i] = g0 * sigmoidf_(g0) * (rs * acc[ai][1][m][0][i]); o[4 + i] = g1 * sigmoidf_(g1) * (rs * acc[ai][1][m][1][i]); }
                *(pg8::u32x4*)(act + (size_t)row * 256 + (u.pn & 1) * 128 + wc * 32 + 8 * fq) = pack8(o);
            }
    }
};
struct EpiPle2 {
    static constexpr bool PERM = true, AFTER_DRAIN = false; static constexpr int MIDK = 0;
    float* x; const bf16_t* PP; const float* rstd;
    DI void operator()(const pg8::f32x4 (&acc)[2][2][4][2], const pg8::Unit& u, int wr, int wc, int fr, int fq) const {
        EPI_ROWS_BEGIN
            const size_t o = (size_t)row * DM + u.pn * 256 + c0; const float rs = rstd[row]; float pp[8];
            unpack8(*(const pg8::u32x4*)(PP + o), pp);
            const float4 b0 = *(const float4*)(x + o), b1 = *(const float4*)(x + o + 4);
            *(float4*)(x + o) = make_float4(b0.x + sigmoidf_(rs * v[0]) * pp[0], b0.y + sigmoidf_(rs * v[1]) * pp[1], b0.z + sigmoidf_(rs * v[2]) * pp[2], b0.w + sigmoidf_(rs * v[3]) * pp[3]);
            *(float4*)(x + o + 4) = make_float4(b1.x + sigmoidf_(rs * v[4]) * pp[4], b1.y + sigmoidf_(rs * v[5]) * pp[5], b1.z + sigmoidf_(rs * v[6]) * pp[6], b1.w + sigmoidf_(rs * v[7]) * pp[7]);
        EPI_ROWS_END
    }
};

struct EpiPleFinal {
    static constexpr bool PERM = true, AFTER_DRAIN = true; static constexpr int MIDK = 0;
    const float* x2; const bf16_t* PP; const float* rstd2; const float* g_final; float* out; float* xbuf; unsigned* pcnt;
    DI void fused(pg8::f32x4 (&acc)[2][2][4][2], const pg8::Unit& u, int wr, int wc, int fr, int fq, PG8_LAS unsigned char* lds, int wid, int lane) const {
        __attribute__((address_space(3))) float* P = (__attribute__((address_space(3))) float*)lds;
        __attribute__((address_space(3))) float* S = P + 1024;
        const int l_ = lane_id_opaque();
#pragma unroll
        for (int ai = 0; ai < 2; ++ai)
#pragma unroll
            for (int m = 0; m < 4; ++m) {
                const int rl = ai * 128 + wr * 64 + m * 16 + fr, row = u.pm * 256 + rl; const float rs = rstd2[row]; float sq = 0.f;
#pragma unroll
                for (int bj = 0; bj < 2; ++bj) {
                    const size_t o = (size_t)row * DM + u.pn * 256 + bj * 128 + wc * 32 + 8 * fq; float pp[8];
                    unpack8(*(const pg8::u32x4*)(PP + o), pp);
                    const float4 b0 = *(const float4*)(x2 + o), b1 = *(const float4*)(x2 + o + 4);
                    const float bx[8] = {b0.x, b0.y, b0.z, b0.w, b1.x, b1.y, b1.z, b1.w};
#pragma unroll
                    for (int i = 0; i < 4; ++i) {
                        const float v0 = bx[i] + sigmoidf_(rs * acc[ai][bj][m][0][i]) * pp[i], v1 = bx[4 + i] + sigmoidf_(rs * acc[ai][bj][m][1][i]) * pp[4 + i];
                        acc[ai][bj][m][0][i] = v0; acc[ai][bj][m][1][i] = v1; sq += v0 * v0 + v1 * v1;
                    }
                }
                sq += lane_xor(sq, 16, l_); sq += lane_xor(sq, 32, l_);
                if (fq == 0) P[rl * 4 + wc] = sq;
                asm volatile("" ::: "memory");
            }
        __syncthreads();
        const int t = wid * 64 + lane;
        if (t < 256) { const float ps = (P[t * 4] + P[t * 4 + 1]) + (P[t * 4 + 2] + P[t * 4 + 3]);
            __hip_atomic_store(xbuf + ((size_t)u.pm * 256 + t) * 4 + u.pn, ps, __ATOMIC_RELAXED, __HIP_MEMORY_SCOPE_AGENT); }
        asm volatile("s_waitcnt vmcnt(0)" ::: "memory");
        __syncthreads();
        if (t == 0) __hip_atomic_fetch_add(pcnt + 64 * u.pm, 1u, __ATOMIC_RELAXED, __HIP_MEMORY_SCOPE_AGENT);
        if (wid == 0) { unsigned spins = 0; while (__hip_atomic_load(pcnt + 64 * u.pm, __ATOMIC_RELAXED, __HIP_MEMORY_SCOPE_AGENT) < 4u && ++spins < (1u << 22)) __builtin_amdgcn_s_sleep(2); }
        __syncthreads();
        if (t < 256) { const float* xb = xbuf + ((size_t)u.pm * 256 + t) * 4;
            const float tot = (__hip_atomic_load(xb, __ATOMIC_RELAXED, __HIP_MEMORY_SCOPE_AGENT) + __hip_atomic_load(xb + 1, __ATOMIC_RELAXED, __HIP_MEMORY_SCOPE_AGENT))
                            + (__hip_atomic_load(xb + 2, __ATOMIC_RELAXED, __HIP_MEMORY_SCOPE_AGENT) + __hip_atomic_load(xb + 3, __ATOMIC_RELAXED, __HIP_MEMORY_SCOPE_AGENT));
            S[t] = rsqrtf(tot * (1.f / DM) + 1e-6f); }
        __syncthreads();
#pragma unroll
        for (int ai = 0; ai < 2; ++ai)
#pragma unroll
            for (int m = 0; m < 4; ++m) {
                const int rl = ai * 128 + wr * 64 + m * 16 + fr, row = u.pm * 256 + rl; const float r3 = S[rl];
#pragma unroll
                for (int bj = 0; bj < 2; ++bj) {
                    const int col = u.pn * 256 + bj * 128 + wc * 32 + 8 * fq; const size_t o = (size_t)row * DM + col;
                    const float4 g0 = *(const float4*)(g_final + col), g1 = *(const float4*)(g_final + col + 4);
                    *(float4*)(out + o) = make_float4(acc[ai][bj][m][0][0] * r3 * g0.x, acc[ai][bj][m][0][1] * r3 * g0.y, acc[ai][bj][m][0][2] * r3 * g0.z, acc[ai][bj][m][0][3] * r3 * g0.w);
                    *(float4*)(out + o + 4) = make_float4(acc[ai][bj][m][1][0] * r3 * g1.x, acc[ai][bj][m][1][1] * r3 * g1.y, acc[ai][bj][m][1][2] * r3 * g1.z, acc[ai][bj][m][1][3] * r3 * g1.w);
                }
            }
    }
};
struct MoeOrder {
    const int* cnt; int NJ, G, c;
    DI bool next(int i, pg8::Unit& u) const {
        int L = i * G + c, tb = 0;
        for (int e = 0; e < 16; ++e) { const int mt = (cnt[e * CNT_STRIDE] + 255) >> 8, n = mt * NJ; if (L < n) { u.pm = tb + L / NJ; u.pn = e * NJ + L % NJ; u.aux = L / NJ; return true; } L -= n; tb += mt; }
        return false;
    }
    DI void a_ready(const pg8::Unit&) const {}
    DI void done(const pg8::Unit&) const {}
};
struct TwoUnits { int pm, pn0, aux; DI bool next(int i, pg8::Unit& o) const { o.pm = pm; o.pn = pn0 + i; o.aux = aux; return i < 2; } DI void a_ready(const pg8::Unit&) const {} DI void done(const pg8::Unit&) const {} };
struct FourUnits { int pm, pn0; DI bool next(int i, pg8::Unit& o) const { o.pm = pm; o.pn = pn0 + i; o.aux = 0; return i < 4; } DI void a_ready(const pg8::Unit&) const {} DI void done(const pg8::Unit&) const {} };
struct OneUnit { pg8::Unit u; DI bool next(int i, pg8::Unit& o) const { o = u; return i == 0; } DI void a_ready(const pg8::Unit&) const {} DI void done(const pg8::Unit&) const {} };
struct PPOrder { int extra, G, c; DI bool next(int i, pg8::Unit& u) const { const int nl = G - extra, li = c - extra; if (li < 0 || nl <= 0) return false; const int id = li + i * nl; if (id >= 256) return false; u.pm = id >> 2; u.pn = id & 3; u.aux = 0; return true; }
    DI void a_ready(const pg8::Unit&) const {} DI void done(const pg8::Unit&) const {} };
DI int moe_base_row(const int* cnt, int e) { int tb = 0; for (int k = 0; k < 16; ++k) { if (k < e) tb += (cnt[k * CNT_STRIDE] + 255) >> 8; } return tb * 256; }
struct MapId { DI int operator()(int n) const { return n; } };
struct MapE13 { DI int operator()(int n) const { return ((n >> 7) & 1) * 256 + (n >> 8) * 128 + (n & 127); } };

DI void router_stage(__attribute__((address_space(3))) float* Wl, const float* __restrict__ g, const float* __restrict__ w_rg, const float* __restrict__ w_re, int tx) {
    for (int e = tx; e < 4096; e += 512) { const int k = e >> 2, c = e & 3; Wl[c * 1024 + k] = w_rg[e] * g[k]; }
    for (int e = tx; e < 16384; e += 512) { const int k = e >> 4, c = e & 15; Wl[(4 + c) * 1024 + k] = w_re[e] * g[k]; }
}
typedef float f4v __attribute__((ext_vector_type(4)));
DI float dpp_row_sum(float v) {
    v += __builtin_bit_cast(float, __builtin_amdgcn_update_dpp(0, __builtin_bit_cast(int, v), 0xB1, 0xf, 0xf, true));
    v += __builtin_bit_cast(float, __builtin_amdgcn_update_dpp(0, __builtin_bit_cast(int, v), 0x4E, 0xf, 0xf, true));
    v += __builtin_bit_cast(float, __builtin_amdgcn_update_dpp(0, __builtin_bit_cast(int, v), 0x141, 0xf, 0xf, true));
    v += __builtin_bit_cast(float, __builtin_amdgcn_update_dpp(0, __builtin_bit_cast(int, v), 0x140, 0xf, 0xf, true));
    return v;
}
DI void router4(const int (&tok)[4], int lane, const f4v (&xv)[16], const __attribute__((address_space(3))) float* Wl, const float* __restrict__ b_rg, const float* __restrict__ b_re,
                float* __restrict__ rstd1, __attribute__((address_space(3))) int* lcnt, __attribute__((address_space(3))) int* lri) {
    const int g = lane >> 4, p = lane & 15;
    float s = 0.f;
#pragma unroll
    for (int j = 0; j < 16; ++j) s += (xv[j].x * xv[j].x + xv[j].y * xv[j].y) + (xv[j].z * xv[j].z + xv[j].w * xv[j].w);
    const float rstd = rsqrtf(dpp_row_sum(s) * (1.f / DM) + 1e-6f);
    float al[20];
#pragma unroll
    for (int c = 0; c < 20; ++c) {
        float a = 0.f;
#pragma unroll
        for (int j = 0; j < 16; ++j) { const f4v w = *(const __attribute__((address_space(3))) f4v*)(Wl + c * 1024 + 4 * (p + 16 * j)); a += (xv[j].x * w.x + xv[j].y * w.y) + (xv[j].z * w.z + xv[j].w * w.w); }
        al[c] = dpp_row_sum(a);
    }
    float gl[4], el[16];
#pragma unroll
    for (int c = 0; c < 4; ++c) gl[c] = al[c] * rstd + b_rg[c];
#pragma unroll
    for (int c = 0; c < 16; ++c) el[c] = al[4 + c] * rstd + b_re[c];
    if (p == 0) {
        int gs = 0; float gm = gl[0];
#pragma unroll
        for (int c = 1; c < 4; ++c) if (gl[c] > gm) { gm = gl[c]; gs = c; }
        float se = 0.f;
#pragma unroll
        for (int c = 0; c < 4; ++c) se += __expf(gl[c] - gm);
        const float pg = 1.f / se;
        float e4[4];
#pragma unroll
        for (int c = 0; c < 4; ++c) e4[c] = gs == 0 ? el[c] : gs == 1 ? el[4 + c] : gs == 2 ? el[8 + c] : el[12 + c];
        int i0 = 0; float v0 = e4[0];
#pragma unroll
        for (int c = 1; c < 4; ++c) if (e4[c] > v0) { v0 = e4[c]; i0 = c; }
        int i1 = -1; float v1 = -3.0e38f;
#pragma unroll
        for (int c = 0; c < 4; ++c) if (c != i0 && e4[c] > v1) { v1 = e4[c]; i1 = c; }
        const float ex = __expf(v1 - v0);
        const float w0 = pg / (1.f + ex), w1 = pg * ex / (1.f + ex);
        const int e0 = gs * 4 + i0, e1 = gs * 4 + i1;
        const int p0 = __hip_atomic_fetch_add(lcnt + e0, 1, __ATOMIC_RELAXED, __HIP_MEMORY_SCOPE_WORKGROUP), p1 = __hip_atomic_fetch_add(lcnt + e1, 1, __ATOMIC_RELAXED, __HIP_MEMORY_SCOPE_WORKGROUP);
        const int tk = g == 0 ? tok[0] : g == 1 ? tok[1] : g == 2 ? tok[2] : tok[3];
        rstd1[tk] = rstd;
        lri[g * 4 + 0] = e0 | (e1 << 8); lri[g * 4 + 1] = p0 | (p1 << 16); lri[g * 4 + 2] = __float_as_int(w0); lri[g * 4 + 3] = __float_as_int(w1);
    }
}

struct BMapId { DI int operator()(int n) const { return n; } };
struct BMapMoe { DI int operator()(int n) const { const int t = n >> 7, c = n & 127, e = t >> 2, jt = t & 3; return e * (1024 * 512) + ((c >> 5) & 1) * 256 + jt * 64 + (c >> 6) * 32 + (c & 31); } };
template <class Epi, class BMap>
DI void gemm_v1(int bx, int by, int tid, char* sm, const bf16_t* __restrict__ A, int lda, const float* __restrict__ B, int ldb, int N, int K, Epi epi, BMap bmap) {
    bf16_t* As = (bf16_t*)sm;
    bf16_t* Bs = (bf16_t*)(sm + 128 * 40 * 2);
    const int lane = tid & 63, w = tid >> 6, wr = w >> 1, wc = w & 1, r32 = lane & 31, hi = lane >> 5;
    const int m0 = by * 128, n0 = bx * 128;
    f32x16 acc[2][2];
#pragma unroll
    for (int i = 0; i < 2; ++i)
#pragma unroll
        for (int j = 0; j < 2; ++j)
#pragma unroll
            for (int r = 0; r < 16; ++r) acc[i][j][r] = 0.f;
    for (int k0 = 0; k0 < K; k0 += 32) {
#pragma unroll
        for (int i = 0; i < 2; ++i) {
            const int c = tid + i * 256, row = c >> 2, col = (c & 3) * 8;
            const uint4 v = *(const uint4*)(A + (size_t)(m0 + row) * lda + k0 + col);
            *(uint4*)(As + row * 40 + col) = v;
        }
#pragma unroll
        for (int i = 0; i < 4; ++i) {
            const int idx = tid + i * 256, k = idx >> 5, n = (idx & 31) * 4;
            float4 v = make_float4(0.f, 0.f, 0.f, 0.f);
            if (n0 + n < N) v = *(const float4*)(B + (size_t)(k0 + k) * ldb + bmap(n0 + n));
            Bs[(n + 0) * 40 + k] = f2bf(v.x); Bs[(n + 1) * 40 + k] = f2bf(v.y); Bs[(n + 2) * 40 + k] = f2bf(v.z); Bs[(n + 3) * 40 + k] = f2bf(v.w);
        }
        __syncthreads();
#pragma unroll
        for (int kk = 0; kk < 32; kk += 16) {
            bf16x8 a[2], b[2];
#pragma unroll
            for (int i = 0; i < 2; ++i) a[i] = *(const bf16x8*)(As + (wr * 64 + i * 32 + r32) * 40 + kk + hi * 8);
#pragma unroll
            for (int j = 0; j < 2; ++j) b[j] = *(const bf16x8*)(Bs + (wc * 64 + j * 32 + r32) * 40 + kk + hi * 8);
#pragma unroll
            for (int i = 0; i < 2; ++i)
#pragma unroll
                for (int j = 0; j < 2; ++j) acc[i][j] = __builtin_amdgcn_mfma_f32_32x32x16_bf16(a[i], b[j], acc[i][j], 0, 0, 0);
        }
        __syncthreads();
    }
#pragma unroll
    for (int i = 0; i < 2; ++i)
#pragma unroll
        for (int j = 0; j < 2; ++j)
#pragma unroll
            for (int r = 0; r < 16; ++r) {
                const int row = m0 + wr * 64 + i * 32 + (r & 3) + 8 * (r >> 2) + 4 * hi;
                const int col = n0 + wc * 64 + j * 32 + r32;
                if constexpr (Epi::PAIR) { if (j == 0) epi.pair(row, col, acc[i][0][r], acc[i][1][r]); }
                else { if (col < N) epi(row, col, acc[i][j][r]); }
            }
}

struct EpiPa { static constexpr bool PAIR = false;
    const bf16_t* MG; float* tmp;
    DI void operator()(int row, int col, float v) const { tmp[(size_t)row * DM + col] = bf2f(MG[(size_t)row * 2048 + col]) * v; }
};
struct EpiPb { static constexpr bool PAIR = false;
    const bf16_t* MG; const float* tmp; bf16_t* mixed;
    DI void operator()(int row, int col, float v) const {
        mixed[(size_t)row * DM + col] = f2bf(tmp[(size_t)row * DM + col] + bf2f(MG[(size_t)row * 2048 + 1024 + col]) * v);
    }
};
struct EpiResid { static constexpr bool PAIR = false;
    const float* base; float* out;
    DI void operator()(int row, int col, float v) const { out[(size_t)row * DM + col] = base[(size_t)row * DM + col] + v; }
};
struct EpiBf { static constexpr bool PAIR = false;
    bf16_t* o; int ld;
    DI void operator()(int row, int col, float v) const { o[(size_t)row * ld + col] = f2bf(v); }
};
struct EpiF32 { static constexpr bool PAIR = false;
    float* o; int ld;
    DI void operator()(int row, int col, float v) const { o[(size_t)row * ld + col] = v; }
};
struct EpiPle { static constexpr bool PAIR = false;
    float* x; const float* pp;
    DI void operator()(int row, int col, float v) const { const size_t i = (size_t)row * DM + col; x[i] = x[i] + sigmoidf_(v) * pp[i]; }
};

DI void rmsnorm_rows(int bx, int tid, const float* x, const float* __restrict__ g, bf16_t* outb, float* outf, int rows) {
    const int row = bx * 4 + (tid >> 6), lane = tid & 63;
    if (row >= rows) return;
    const float4* xr = (const float4*)(x + (size_t)row * DM);
    float4 v[4]; float s = 0.f;
#pragma unroll
    for (int j = 0; j < 4; ++j) { v[j] = xr[lane + 64 * j]; s += v[j].x * v[j].x + v[j].y * v[j].y + v[j].z * v[j].z + v[j].w * v[j].w; }
    const float rstd = rsqrtf(wave_sum(s) * (1.f / DM) + 1e-6f);
#pragma unroll
    for (int j = 0; j < 4; ++j) {
        const float4 gg = ((const float4*)g)[lane + 64 * j];
        const float a = v[j].x * rstd * gg.x, b = v[j].y * rstd * gg.y, c = v[j].z * rstd * gg.z, d = v[j].w * rstd * gg.w;
        if (outf) ((float4*)(outf + (size_t)row * DM))[lane + 64 * j] = make_float4(a, b, c, d);
        else { ushort4 o; o.x = f2bf(a); o.y = f2bf(b); o.z = f2bf(c); o.w = f2bf(d); ((ushort4*)(outb + (size_t)row * DM))[lane + 64 * j] = o; }
    }
}

DI void cvt_bf16(int bx, int nb, int tid, const float* __restrict__ in, bf16_t* __restrict__ out, size_t n) {
    for (size_t i = bx * (size_t)256 + tid; i < n; i += (size_t)nb * 256) out[i] = f2bf(in[i]);
}

DI float gelu_tanh(float x) { const float u = 0.7978845608028654f * (x + 0.044715f * x * x * x); return 0.5f * x * (1.f + tanhf(u)); }

DI void compress_naive(int bx, int by, int bz, int tid, char* sm, const bf16_t* __restrict__ KVb, const float* __restrict__ w1k, const float* __restrict__ w2k, const float* __restrict__ pek,
                                                      const float* __restrict__ w1v, const float* __restrict__ w2v, const float* __restrict__ pev, float* __restrict__ outk, float* __restrict__ outv, bf16_t* __restrict__ kcb, bf16_t* __restrict__ vcT) {
    float* flat = (float*)sm;
    float* h1 = flat + 2048;
    __syncthreads();
    const int j = bx, bg = by, kv = bz, b = bg >> 1, g = bg & 1;
    const float* w1 = kv ? w1v : w1k; const float* w2 = kv ? w2v : w2k; const float* pe = kv ? pev : pek; float* out = kv ? outv : outk;
    const int colbase = (kv ? 128 : 0) + g * 64;
    for (int e = tid; e < 2048; e += 256) {
        const int i = e >> 6, d = e & 63;
        flat[e] = bf2f(KVb[(size_t)(b * SEQ + 16 * j + i) * 512 + colbase + d]) + pe[e];
    }
    __syncthreads();
    float s = 0.f;
    for (int k = 0; k < 2048; ++k) s += flat[k] * w1[(size_t)k * 256 + tid];
    h1[tid] = gelu_tanh(s);
    __syncthreads();
    if (tid < 64) {
        float o = 0.f;
        for (int n = 0; n < 256; ++n) o += h1[n] * w2[n * 64 + tid];
        out[((size_t)bg * 256 + j) * 64 + tid] = o;
        if (kv == 0) { kcb[((size_t)bg * 256 + j) * 64 + tid] = f2bf(o); if (j == 254) kcb[((size_t)bg * 256 + 255) * 64 + tid] = 0; }
        else { vcT[((size_t)bg * 4 + (j >> 6)) * 4096 + tid * 64 + (j & 63)] = f2bf(o); if (j == 254) vcT[((size_t)bg * 4 + 3) * 4096 + tid * 64 + 63] = 0; }
    }
}

DI void softmax_row(float* row, int n, int lane) {
    float m = -3.0e38f;
    for (int j = lane; j < n; j += 64) m = fmaxf(m, row[j]);
    m = wave_max(m);
    float s = 0.f;
    for (int j = lane; j < n; j += 64) { const float e = exp2f(row[j] - m); row[j] = e; s += e; }
    s = wave_sum(s);
    const float inv = 1.f / s;
    for (int j = lane; j < n; j += 64) row[j] *= inv;
}

DI void nsa_naive(int bx, int by, int tid, char* sm, const bf16_t* __restrict__ Qb, const bf16_t* __restrict__ KVb, const bf16_t* __restrict__ VT, const float* __restrict__ kcc, const float* __restrict__ vcc, const float* __restrict__ gates, bf16_t* __restrict__ Y) {
    float (*q)[64] = (float (*)[64])sm;
    float (*sc)[1024] = (float (*)[1024])(sm + 1024);
    float* impv = (float*)(sm + 1024 + 16384);
    int* sellist = (int*)(sm + 1024 + 16384 + 256);
    int* selflag = (int*)(sm + 1024 + 16384 + 256 + 64);
    int& nsel_s = *(int*)(sm + 1024 + 16384 + 256 + 64 + 256);
    __syncthreads();
    const int tok = bx, g = by, b = tok >> 12, t = tok & 4095, hh = tid >> 6, lane = tid & 63, d = lane;
    q[hh][d] = bf2f(Qb[(size_t)tok * 512 + (g * 4 + hh) * 64 + d]);
    __syncthreads();
    const int nv = (t >= 31) ? ((t - 15) >> 4) : 0;
    const float* kcb = kcc + (size_t)(b * 2 + g) * 256 * 64; const float* vcb = vcc + (size_t)(b * 2 + g) * 256 * 64;
    if (tid < nv) {
        float s0 = 0.f, s1 = 0.f, s2 = 0.f, s3 = 0.f;
#pragma unroll 8
        for (int dd = 0; dd < 64; ++dd) { const float kx = kcb[tid * 64 + dd]; s0 += q[0][dd] * kx; s1 += q[1][dd] * kx; s2 += q[2][dd] * kx; s3 += q[3][dd] * kx; }
        sc[0][tid] = s0; sc[1][tid] = s1; sc[2][tid] = s2; sc[3][tid] = s3;
    }
    __syncthreads();
    if (nv > 0) softmax_row(sc[hh], nv, lane);
    for (int j = nv + lane; j < 256; j += 64) sc[hh][j] = 0.f;
    __syncthreads();
    float o_cmp = 0.f;
    for (int j = 0; j < nv; ++j) o_cmp += sc[hh][j] * vcb[j * 64 + d];
    const int cur = t >> 6;
    if (tid < 64) {
        const int s = tid; int lo = 4 * s - 1; if (lo < 0) lo = 0; int hi2 = 4 * s + 3; if (hi2 > 254) hi2 = 254;
        float v = 0.f;
        for (int h2 = 0; h2 < 4; ++h2) for (int j = lo; j <= hi2; ++j) v += sc[h2][j];
        if (s == 0 || s == cur || s == cur - 1) v += 1000.0f;
        if (s > cur) v = -1e30f;
        impv[s] = v;
    }
    __syncthreads();
    if (tid < 64) {
        const float v = impv[tid]; int rank = 0;
        for (int s2 = 0; s2 < 64; ++s2) { const float u = impv[s2]; rank += (u > v || (u == v && s2 < tid)) ? 1 : 0; }
        selflag[tid] = (rank < 16 && tid <= cur) ? 1 : 0;
    }
    __syncthreads();
    if (tid == 0) { int n = 0; for (int s = 0; s < 64; ++s) if (selflag[s]) { if (n < 16) sellist[n] = s; ++n; } nsel_s = n < 16 ? n : 16; }
    __syncthreads();
    const int ns = nsel_s, ne = ns * 64;
    for (int e = tid; e < ne; e += 256) {
        const int kpos = sellist[e >> 6] * 64 + (e & 63);
        if (kpos <= t) {
            const bf16_t* kp = KVb + (size_t)(b * SEQ + kpos) * 512 + 256 + g * 64;
            float s0 = 0.f, s1 = 0.f, s2 = 0.f, s3 = 0.f;
    #pragma unroll 8
        for (int dd = 0; dd < 64; ++dd) { const float kx = bf2f(kp[dd]); s0 += q[0][dd] * kx; s1 += q[1][dd] * kx; s2 += q[2][dd] * kx; s3 += q[3][dd] * kx; }
            sc[0][e] = s0; sc[1][e] = s1; sc[2][e] = s2; sc[3][e] = s3;
        } else { sc[0][e] = -1e30f; sc[1][e] = -1e30f; sc[2][e] = -1e30f; sc[3][e] = -1e30f; }
    }
    __syncthreads();
    softmax_row(sc[hh], ne, lane);
    __syncthreads();
    float o_sel = 0.f;
    for (int e = 0; e < ne; ++e) {
        const int kpos = sellist[e >> 6] * 64 + (e & 63);
        o_sel += sc[hh][e] * bf2f(VT[((size_t)(b * 2 + g) * 64 + (kpos >> 6)) * 4096 + d * 64 + (kpos & 63)]);
    }
    __syncthreads();
    const int nw = (t + 1 < 512) ? (t + 1) : 512, w0 = t - nw + 1;
    for (int e = tid; e < nw; e += 256) {
        const bf16_t* kp = KVb + (size_t)(b * SEQ + w0 + e) * 512 + 384 + g * 64;
        float s0 = 0.f, s1 = 0.f, s2 = 0.f, s3 = 0.f;
#pragma unroll 8
        for (int dd = 0; dd < 64; ++dd) { const float kx = bf2f(kp[dd]); s0 += q[0][dd] * kx; s1 += q[1][dd] * kx; s2 += q[2][dd] * kx; s3 += q[3][dd] * kx; }
        sc[0][e] = s0; sc[1][e] = s1; sc[2][e] = s2; sc[3][e] = s3;
    }
    __syncthreads();
    softmax_row(sc[hh], nw, lane);
    __syncthreads();
    float o_win = 0.f;
    for (int e = 0; e < nw; ++e) { const int kpos = w0 + e; o_win += sc[hh][e] * bf2f(VT[((size_t)(8 + b * 2 + g) * 64 + (kpos >> 6)) * 4096 + d * 64 + (kpos & 63)]); }
    const float* gt = gates + (size_t)tok * 24 + (g * 4 + hh) * 3;
    Y[(size_t)tok * DM + (g * 4 + hh) * 64 + d] = f2bf(gt[0] * o_cmp + gt[1] * o_sel + gt[2] * o_win);
}

DI void conv_silu(int bx, int tid, const bf16_t* __restrict__ MQK, const float* __restrict__ wc, const float* __restrict__ bc, bf16_t* __restrict__ out) {
    const int idx = bx * 256 + tid;
    if (idx >= T_TOK * 1024) return;
    const int c = idx & 1023, tok = idx >> 10, t = tok & 4095;
    float y = bc[c];
#pragma unroll
    for (int j = 0; j < 4; ++j) { const int tt = t - 3 + j; if (tt >= 0) y += wc[j * 1024 + c] * bf2f(MQK[(size_t)(tok - 3 + j) * 1024 + c]); }
    y = y * sigmoidf_(y);
    if (c >= 512) y *= 0.08838834764831845f;
    out[idx] = f2bf(y);
}

DI void mlstm_naive(int bx, int tid, char* sm, const bf16_t* __restrict__ qkc, const bf16_t* __restrict__ MV, const bf16_t* __restrict__ MO, const float* __restrict__ ifp, float* __restrict__ hm) {
    float (*qs)[128] = (float (*)[128])sm;
    float (*ks)[128] = (float (*)[128])(sm + 16384);
    float (*vs)[16] = (float (*)[16])(sm + 32768);
    float (*os)[16] = (float (*)[16])(sm + 32768 + 2048);
    float* gi = (float*)(sm + 32768 + 4096); float* gf = gi + 32;
    const int bh = bx >> 3, vsl = bx & 7, b = bh >> 2, h = bh & 3, v = tid >> 4, kg = tid & 15;
    float C[8], n[8];
#pragma unroll
    for (int j = 0; j < 8; ++j) { C[j] = 0.f; n[j] = 0.f; }
    for (int c0 = 0; c0 < SEQ; c0 += 32) {
        __syncthreads();
        for (int e = tid; e < 32 * 128; e += 256) {
            const int s = e >> 7, k = e & 127; const size_t tok = (size_t)b * SEQ + c0 + s;
            qs[s][k] = bf2f(qkc[tok * 1024 + h * 128 + k]); ks[s][k] = bf2f(qkc[tok * 1024 + 512 + h * 128 + k]);
        }
        for (int e = tid; e < 32 * 16; e += 256) {
            const int s = e >> 4, vv = e & 15; const size_t tok = (size_t)b * SEQ + c0 + s;
            vs[s][vv] = bf2f(MV[tok * 512 + h * 128 + vsl * 16 + vv]);
            os[s][vv] = sigmoidf_(bf2f(MO[tok * 512 + h * 128 + vsl * 16 + vv]));
        }
        if (tid < 32) { const size_t tok = (size_t)b * SEQ + c0 + tid; gi[tid] = __expf(ifp[tok * 8 + h]); gf[tid] = sigmoidf_(ifp[tok * 8 + 4 + h]); }
        __syncthreads();
        for (int s = 0; s < 32; ++s) {
            const float f = gf[s], iv = gi[s] * vs[s][v], ig = gi[s];
            float num = 0.f, den = 0.f;
#pragma unroll
            for (int j = 0; j < 8; ++j) {
                const float kx = ks[s][kg * 8 + j], qx = qs[s][kg * 8 + j];
                C[j] = f * C[j] + iv * kx; n[j] = f * n[j] + ig * kx;
                num += C[j] * qx; den += n[j] * qx;
            }
            const int l_ = lane_id_opaque();
#pragma unroll
            for (int o = 1; o < 16; o <<= 1) { num += lane_xor(num, o, l_); den += lane_xor(den, o, l_); }
            if (kg == 0) hm[((size_t)b * SEQ + c0 + s) * 512 + h * 128 + vsl * 16 + v] = num / fmaxf(fabsf(den), 1.0f) * os[s][v];
        }
    }
}

DI void hnorm(int bx, int tid, const float* __restrict__ hm, const float* __restrict__ g_hn, bf16_t* __restrict__ Y) {
    const int item = bx * 4 + (tid >> 6), lane = tid & 63;
    const int tok = item >> 2, h = item & 3;
    const float a = hm[(size_t)tok * 512 + h * 128 + lane], b = hm[(size_t)tok * 512 + h * 128 + 64 + lane];
    const float rstd = rsqrtf(wave_sum(a * a + b * b) * (1.f / 128.f) + 1e-6f);
    Y[(size_t)tok * DM + 512 + h * 128 + lane] = f2bf(a * rstd * g_hn[h * 128 + lane]);
    Y[(size_t)tok * DM + 512 + h * 128 + 64 + lane] = f2bf(b * rstd * g_hn[h * 128 + 64 + lane]);
}

DI void router(int bx, int tid, const float* __restrict__ x, const float* __restrict__ g, const float* __restrict__ w_rg, const float* __restrict__ b_rg,
                                              const float* __restrict__ w_re, const float* __restrict__ b_re, bf16_t* __restrict__ xn, float* __restrict__ gate) {
    const int tok = bx * 4 + (tid >> 6), lane = tid & 63;
    float xv[16]; float s = 0.f;
#pragma unroll
    for (int j = 0; j < 4; ++j) { const float4 v = ((const float4*)(x + (size_t)tok * DM))[lane + 64 * j]; xv[4 * j] = v.x; xv[4 * j + 1] = v.y; xv[4 * j + 2] = v.z; xv[4 * j + 3] = v.w; s += v.x * v.x + v.y * v.y + v.z * v.z + v.w * v.w; }
    const float rstd = rsqrtf(wave_sum(s) * (1.f / DM) + 1e-6f);
#pragma unroll
    for (int j = 0; j < 4; ++j) { const float4 gg = ((const float4*)g)[lane + 64 * j]; xv[4 * j] *= rstd * gg.x; xv[4 * j + 1] *= rstd * gg.y; xv[4 * j + 2] *= rstd * gg.z; xv[4 * j + 3] *= rstd * gg.w;
        ushort4 o; o.x = f2bf(xv[4 * j]); o.y = f2bf(xv[4 * j + 1]); o.z = f2bf(xv[4 * j + 2]); o.w = f2bf(xv[4 * j + 3]); ((ushort4*)(xn + (size_t)tok * DM))[lane + 64 * j] = o; }
    float mylog = 0.f;
#pragma unroll 1
    for (int c = 0; c < 20; ++c) {
        const float* w = c < 4 ? w_rg + c : w_re + (c - 4); const int ld = c < 4 ? 4 : 16;
        float a = 0.f;
#pragma unroll
        for (int j = 0; j < 4; ++j)
#pragma unroll
            for (int i = 0; i < 4; ++i) a += xv[4 * j + i] * w[(size_t)(4 * (lane + 64 * j) + i) * ld];
        a = wave_sum(a) + (c < 4 ? b_rg[c] : b_re[c - 4]);
        if (lane == c) mylog = a;
    }
    float gl[4], el[16];
#pragma unroll
    for (int c = 0; c < 4; ++c) gl[c] = lane_get(mylog, c);
#pragma unroll
    for (int c = 0; c < 16; ++c) el[c] = lane_get(mylog, 4 + c);
    if (lane == 0) {
        int gs = 0; float gm = gl[0];
#pragma unroll
        for (int c = 1; c < 4; ++c) if (gl[c] > gm) { gm = gl[c]; gs = c; }
        float se = 0.f;
#pragma unroll
        for (int c = 0; c < 4; ++c) se += __expf(gl[c] - gm);
        const float pg = 1.f / se;
        float e4[4];
#pragma unroll
        for (int c = 0; c < 4; ++c) e4[c] = gs == 0 ? el[c] : gs == 1 ? el[4 + c] : gs == 2 ? el[8 + c] : el[12 + c];
        int i0 = 0; float v0 = e4[0];
#pragma unroll
        for (int c = 1; c < 4; ++c) if (e4[c] > v0) { v0 = e4[c]; i0 = c; }
        int i1 = -1; float v1 = -3.0e38f;
#pragma unroll
        for (int c = 0; c < 4; ++c) if (c != i0 && e4[c] > v1) { v1 = e4[c]; i1 = c; }
        const float ex = __expf(v1 - v0);
        const float w0 = pg / (1.f + ex), w1 = pg * ex / (1.f + ex);
#pragma unroll
        for (int c = 0; c < 16; ++c) gate[(size_t)tok * 16 + c] = (c == gs * 4 + i0) ? w0 : (c == gs * 4 + i1) ? w1 : 0.f;
    }
}


struct EpiMoe { static constexpr bool PAIR = true;
    const float* gate; bf16_t* act;
    DI void operator()(int, int, float) const {}
    DI void pair(int row, int col, float gg, float u) const {
        const int t = col >> 7, c = col & 127, e = t >> 2, jt = t & 3, f = jt * 64 + (c >> 6) * 32 + (c & 31);
        act[(size_t)row * 4096 + e * 256 + f] = f2bf(gg * sigmoidf_(gg) * u * gate[(size_t)row * 16 + e]);
    }
};

typedef float f32x2_t __attribute__((ext_vector_type(2))); typedef __bf16 bf16x2_t __attribute__((ext_vector_type(2)));
DI unsigned cvtpk(float lo, float hi) { f32x2_t v = {lo, hi}; bf16x2_t b = __builtin_convertvector(v, bf16x2_t); return __builtin_bit_cast(unsigned, b); }
typedef __attribute__((address_space(3))) char lds_c;
typedef unsigned u32x2v __attribute__((ext_vector_type(2))); typedef unsigned u32x4v __attribute__((ext_vector_type(4)));
constexpr int NSA_KC = 0, NSA_VC = 4 * 9216, NSA_KB = NSA_VC + 4 * 8704, NSA_VB = NSA_KB + 2 * 9216, NSA_IMP = NSA_VB + 2 * 8704, NSA_MASK = NSA_IMP + 64 * 65 * 4, NSA_END = NSA_MASK + 512;
static_assert(NSA_END <= 147456, "NSA LDS map");
DI int crow(int r, int hi) { return (r & 3) + 8 * (r >> 2) + 4 * hi; }
#define MFMA32(a, b, c) __builtin_amdgcn_mfma_f32_32x32x16_bf16((a), (b), (c), 0, 0, 0)

DI void nsa_qk(f32x16& p0, f32x16& p1, const lds_c* K, const bf16x8 (&qf)[4], float cin, int r32, int hi) {
    f32x16 c;
#pragma unroll
    for (int r = 0; r < 16; ++r) c[r] = cin;
#pragma unroll
    for (int ks = 0; ks < 4; ++ks) {
        const bf16x8 a0 = *(const __attribute__((address_space(3))) bf16x8*)(K + r32 * 144 + ks * 32 + hi * 16);
        const bf16x8 a1 = *(const __attribute__((address_space(3))) bf16x8*)(K + (32 + r32) * 144 + ks * 32 + hi * 16);
        if (ks == 0) { p0 = MFMA32(a0, qf[0], c); p1 = MFMA32(a1, qf[0], c); } else { p0 = MFMA32(a0, qf[ks], p0); p1 = MFMA32(a1, qf[ks], p1); }
    }
}
DI void nsa_softmax(f32x16& p0, f32x16& p1, float& mref, float& l, bool& started, f32x16& o0, f32x16& o1) {
    float mx = fmaxf(p0[0], p1[0]);
#pragma unroll
    for (int r = 1; r < 16; ++r) mx = fmaxf(mx, fmaxf(p0[r], p1[r]));
    { auto rr = __builtin_amdgcn_permlane32_swap(__float_as_uint(mx), __float_as_uint(mx), false, false); mx = fmaxf(__uint_as_float(rr[0]), __uint_as_float(rr[1])); }
    const bool need = started ? (mx > 8.f) : (mx > -3.0e38f);
    if (__any(need)) {
        const float delta = need ? mx : 0.f, f = started ? __builtin_amdgcn_exp2f(-delta) : 1.f;
        mref += delta;
#pragma unroll
        for (int r = 0; r < 16; ++r) { p0[r] -= delta; p1[r] -= delta; o0[r] *= f; o1[r] *= f; }
        l *= f; started = started || need;
    }
    float s = 0.f;
#pragma unroll
    for (int r = 0; r < 16; ++r) { p0[r] = __builtin_amdgcn_exp2f(p0[r]); p1[r] = __builtin_amdgcn_exp2f(p1[r]); s += p0[r] + p1[r]; }
    l += s;
}
DI void nsa_pv(f32x16& o0, f32x16& o1, const f32x16& p0, const f32x16& p1, const lds_c* V, int r32, int hi) {
#pragma unroll
    for (int hf = 0; hf < 2; ++hf)
#pragma unroll
        for (int s = 0; s < 2; ++s) {
            unsigned pw[4];
#pragma unroll
            for (int j = 0; j < 4; ++j) pw[j] = hf ? cvtpk(p1[8 * s + 2 * j], p1[8 * s + 2 * j + 1]) : cvtpk(p0[8 * s + 2 * j], p0[8 * s + 2 * j + 1]);
            const u32x4v pbw = {pw[0], pw[1], pw[2], pw[3]};
            const bf16x8 pb = __builtin_bit_cast(bf16x8, pbw);
            const lds_c* vp = V + r32 * 136 + hf * 64 + s * 32 + hi * 8;
            const u32x2v a0l = *(const __attribute__((address_space(3))) u32x2v*)(vp), a0h = *(const __attribute__((address_space(3))) u32x2v*)(vp + 16);
            const u32x2v a1l = *(const __attribute__((address_space(3))) u32x2v*)(vp + 32 * 136), a1h = *(const __attribute__((address_space(3))) u32x2v*)(vp + 32 * 136 + 16);
            const u32x4v A0w = {a0l.x, a0l.y, a0h.x, a0h.y}, A1w = {a1l.x, a1l.y, a1h.x, a1h.y};
            o0 = MFMA32(__builtin_bit_cast(bf16x8, A0w), pb, o0); o1 = MFMA32(__builtin_bit_cast(bf16x8, A1w), pb, o1);
        }
}
DI void nsa_store_k(lds_c* K, const u32x4v v, int tid) { *(__attribute__((address_space(3))) u32x4v*)(K + (tid >> 3) * 144 + (tid & 7) * 16) = v; }
DI void nsa_store_v(lds_c* V, const u32x4v v, int tid) { lds_c* p = V + (tid >> 3) * 136 + (tid & 7) * 16; *(__attribute__((address_space(3))) u32x2v*)p = (u32x2v){v.x, v.y}; *(__attribute__((address_space(3))) u32x2v*)(p + 8) = (u32x2v){v.z, v.w}; }
#define NEG_INF (-__builtin_inff())
DI void nsa_finish(f32x16& y0, f32x16& y1, f32x16& o0, f32x16& o1, float& m, float& l, bool& started, float gate) {
    float lt; { auto rr = __builtin_amdgcn_permlane32_swap(__float_as_uint(l), __float_as_uint(l), false, false); lt = __uint_as_float(rr[0]) + __uint_as_float(rr[1]); }
    const float f = lt > 0.f ? gate / lt : 0.f;
#pragma unroll
    for (int r = 0; r < 16; ++r) { y0[r] += f * o0[r]; y1[r] += f * o1[r]; o0[r] = 0.f; o1[r] = 0.f; }
    m = 0.f; l = 0.f; started = false;
}

DI void nsa_unit(int bg, int qb, int tx, lds_c* lds, const bf16_t* __restrict__ Qb, const bf16_t* __restrict__ KVb, const bf16_t* __restrict__ VT, const bf16_t* __restrict__ kcb, const bf16_t* __restrict__ vcT,
                 const float* __restrict__ gates, bf16_t* __restrict__ Y, unsigned long long& pacc) {
    const int lane = tx & 63, r32 = lane & 31, hi = lane >> 5, wave = __builtin_amdgcn_readfirstlane(tx >> 6), hh = wave >> 1, qs = wave & 1;
    RG_BEGIN(100)
    const int b = bg >> 1, g = bg & 1, ql = 32 * qs + r32, tq = 64 * qb + ql;
    const size_t tok = (size_t)b * SEQ + tq; const int head = g * 4 + hh;
    const int nc = (4 * qb + 66) >> 6;
    const bool need_topk = qb >= 16;
    lds_c* KC = lds + NSA_KC; lds_c* VC = lds + NSA_VC; lds_c* KB = lds + NSA_KB; lds_c* VB = lds + NSA_VB;
    __attribute__((address_space(3))) float* imp = (__attribute__((address_space(3))) float*)(lds + NSA_IMP);
    __attribute__((address_space(3))) unsigned* msk = (__attribute__((address_space(3))) unsigned*)(lds + NSA_MASK);
    const bf16_t* kcsrc = kcb + (size_t)bg * 256 * 64; const bf16_t* vcsrc = vcT + (size_t)bg * 4 * 4096;
    const bf16_t* kssrc = KVb + (size_t)b * SEQ * 512 + 256 + g * 64; const bf16_t* kwsrc = KVb + (size_t)b * SEQ * 512 + 384 + g * 64;
    const bf16_t* vssrc = VT + (size_t)bg * 64 * 4096; const bf16_t* vwsrc = VT + (size_t)(8 + bg) * 64 * 4096;
    const int n_sel = qb + 1, n_win = qb + 1 < 9 ? qb + 1 : 9, ntile = n_sel + n_win;
    __syncthreads();
    for (int c = 0; c < nc; ++c) {
        nsa_store_k(KC + c * 9216, *(const u32x4v*)(kcsrc + (size_t)(c * 64 + (tx >> 3)) * 64 + (tx & 7) * 8), tx);
        nsa_store_v(VC + c * 8704, *(const u32x4v*)(vcsrc + (size_t)c * 4096 + (tx >> 3) * 64 + (tx & 7) * 8), tx);
    }
    nsa_store_k(KB, *(const u32x4v*)(kssrc + (size_t)(tx >> 3) * 512 + (tx & 7) * 8), tx);
    nsa_store_v(VB, *(const u32x4v*)(vssrc + (tx >> 3) * 64 + (tx & 7) * 8), tx);
    for (int i = tx; i < 64 * 65; i += 512) imp[i] = 0.f;
    bf16x8 qf[4];
#pragma unroll
    for (int ks = 0; ks < 4; ++ks) qf[ks] = *(const bf16x8*)(Qb + tok * 512 + head * 64 + ks * 16 + hi * 8);
    const float g_cmp = gates[tok * 24 + head * 3 + 0], g_sel = gates[tok * 24 + head * 3 + 1], g_win = gates[tok * 24 + head * 3 + 2];
    f32x16 y0, y1, o0, o1, p0, p1;
#pragma unroll
    for (int r = 0; r < 16; ++r) { y0[r] = 0.f; y1[r] = 0.f; o0[r] = 0.f; o1[r] = 0.f; }
    float m = 0.f, l = 0.f; bool started = false;
    __syncthreads();
    RG_END(100)
    RG_BEGIN(101)
    const int nvq = tq >= 31 ? ((tq - 15) >> 4) : 0;
    for (int c = 0; c < nc; ++c) {
        nsa_qk(p0, p1, KC + c * 9216, qf, -m, r32, hi);
        const int lim = nvq - 64 * c;
#pragma unroll
        for (int r = 0; r < 16; ++r) { const int kl = crow(r, hi); if (kl >= lim) p0[r] = NEG_INF; if (kl + 32 >= lim) p1[r] = NEG_INF; }
        nsa_softmax(p0, p1, m, l, started, o0, o1);
        nsa_pv(o0, o1, p0, p1, VC + c * 8704, r32, hi);
    }
    const float m_c = m; float l_c; { auto rr = __builtin_amdgcn_permlane32_swap(__float_as_uint(l), __float_as_uint(l), false, false); l_c = __uint_as_float(rr[0]) + __uint_as_float(rr[1]); }
    nsa_finish(y0, y1, o0, o1, m, l, started, g_cmp);
    RG_END(101)
    unsigned mlo = 0xffffffffu, mhi = 0xffffffffu;
    RG_BEGIN(102)
    if (need_topk) {
        const float invl = l_c > 0.f ? 16777216.f / l_c : 0.f;
        __attribute__((address_space(3))) unsigned* impu = (__attribute__((address_space(3))) unsigned*)imp;
        for (int c = 0; c < nc; ++c) {
            nsa_qk(p0, p1, KC + c * 9216, qf, -m_c, r32, hi);
            const int lim = nvq - 64 * c;
#pragma unroll
            for (int r = 0; r < 16; ++r) { const int kl = crow(r, hi);
                p0[r] = kl < lim ? __builtin_amdgcn_exp2f(p0[r]) * invl : 0.f; p1[r] = kl + 32 < lim ? __builtin_amdgcn_exp2f(p1[r]) * invl : 0.f; }
#pragma unroll
            for (int hf = 0; hf < 2; ++hf)
#pragma unroll
                for (int i = 0; i < 4; ++i) {
                    const int a = 16 * c + 8 * hf + 2 * i + hi;
                    const unsigned u0 = (unsigned)__float2uint_rn(hf ? p1[4 * i] : p0[4 * i]), u1 = (unsigned)__float2uint_rn(hf ? p1[4 * i + 1] : p0[4 * i + 1]);
                    const unsigned u2 = (unsigned)__float2uint_rn(hf ? p1[4 * i + 2] : p0[4 * i + 2]), u3 = (unsigned)__float2uint_rn(hf ? p1[4 * i + 3] : p0[4 * i + 3]);
                    __hip_atomic_fetch_add(impu + ql * 65 + a, u0 + u1 + u2 + u3, __ATOMIC_RELAXED, __HIP_MEMORY_SCOPE_WORKGROUP);
                    if (a + 1 < 64) __hip_atomic_fetch_add(impu + ql * 65 + a + 1, u3, __ATOMIC_RELAXED, __HIP_MEMORY_SCOPE_WORKGROUP);
                }
        }
        __syncthreads();
        RG_BEGIN(103)
        {
            const int q = tx >> 3, j8 = tx & 7, smax = qb - 2;
            unsigned key[8];
#pragma unroll
            for (int k = 0; k < 8; ++k) { const int sb = j8 + 8 * k; key[k] = (sb >= 1 && sb <= smax) ? ((impu[q * 65 + sb] & ~63u) | (unsigned)(63 - sb)) + 64u : 0u; }
            unsigned blo = 0u, bhi = 0u;
#pragma unroll 1
            for (int round = 0; round < 13; ++round) {
                unsigned mx = key[0];
#pragma unroll
                for (int k = 1; k < 8; ++k) mx = mx > key[k] ? mx : key[k];
                { const unsigned t = (unsigned)__builtin_amdgcn_update_dpp(0, (int)mx, 0xB1, 0xf, 0xf, true); mx = mx > t ? mx : t; }
                { const unsigned t = (unsigned)__builtin_amdgcn_update_dpp(0, (int)mx, 0x4E, 0xf, 0xf, true); mx = mx > t ? mx : t; }
                { const unsigned t = (unsigned)__builtin_amdgcn_update_dpp(0, (int)mx, 0x141, 0xf, 0xf, true); mx = mx > t ? mx : t; }
#pragma unroll
                for (int k = 0; k < 8; ++k) if (key[k] == mx && mx != 0u) { key[k] = 0u; const int sb = j8 + 8 * k; if (sb < 32) blo |= 1u << sb; else bhi |= 1u << (sb - 32); }
            }
            const int l_ = lane_id_opaque();
#pragma unroll
            for (int o = 1; o < 8; o <<= 1) { blo |= (unsigned)__builtin_amdgcn_ds_bpermute((l_ ^ o) << 2, (int)blo); bhi |= (unsigned)__builtin_amdgcn_ds_bpermute((l_ ^ o) << 2, (int)bhi); }
            unsigned long long mm = ((unsigned long long)bhi << 32) | blo;
            mm |= 1ull | (1ull << qb) | (1ull << (qb - 1));
            if (j8 == 0) { msk[q * 2] = (unsigned)mm; msk[q * 2 + 1] = (unsigned)(mm >> 32); }
        }
        __syncthreads();
        RG_END(103)
        mlo = msk[ql * 2]; mhi = msk[ql * 2 + 1];
    }
    RG_END(102)
    RG_BEGIN(104)
#define NSA_SRC(i_, KP, VP) do { const bool nsel_ = (i_) < n_sel; const int s2_ = nsel_ ? (i_) : qb - n_win + 1 + ((i_) - n_sel); \
        KP = (nsel_ ? kssrc : kwsrc) + (size_t)(s2_ * 64 + (tx >> 3)) * 512 + (tx & 7) * 8; VP = (nsel_ ? vssrc : vwsrc) + (size_t)s2_ * 4096 + (tx >> 3) * 64 + (tx & 7) * 8; } while (0)
#define NSA_TILE(i_, cur_, KLD, VLD, KST, VST) do { \
        const bool is_sel = (i_) < n_sel; const int s = is_sel ? (i_) : qb - n_win + 1 + ((i_) - n_sel); \
        if ((i_) + 2 < ntile) { const bf16_t* kp_; const bf16_t* vp_; NSA_SRC((i_) + 2, kp_, vp_); KLD = *(const u32x4v*)kp_; VLD = *(const u32x4v*)vp_; } \
        const bool on = !is_sel || ((s < 32 ? (mlo >> s) : (mhi >> (s - 32))) & 1u) != 0u; \
        nsa_qk(p0, p1, KB + (cur_) * 9216, qf, on ? -m : NEG_INF, r32, hi); \
        const bool lowb = !is_sel && (qb >= 8) && (s == qb - 8), diag = (s == qb); \
        if (lowb || diag) { \
            _Pragma("unroll") for (int r = 0; r < 16; ++r) { const int kl = crow(r, hi); \
                if ((lowb && kl <= ql) || (diag && kl > ql)) p0[r] = NEG_INF; if ((lowb && kl + 32 <= ql) || (diag && kl + 32 > ql)) p1[r] = NEG_INF; } \
        } \
        nsa_softmax(p0, p1, m, l, started, o0, o1); \
        nsa_pv(o0, o1, p0, p1, VB + (cur_) * 8704, r32, hi); \
        if ((i_) == n_sel - 1) nsa_finish(y0, y1, o0, o1, m, l, started, g_sel); \
        if ((i_) == ntile - 1) nsa_finish(y0, y1, o0, o1, m, l, started, g_win); \
        if ((i_) + 1 < ntile) { nsa_store_k(KB + ((cur_) ^ 1) * 9216, KST, tx); nsa_store_v(VB + ((cur_) ^ 1) * 8704, VST, tx); } \
        __syncthreads(); } while (0)
    u32x4v kA = {0u, 0u, 0u, 0u}, vA = kA, kB2 = kA, vB2 = kA;
    if (ntile > 1) { const bf16_t* kp_; const bf16_t* vp_; NSA_SRC(1, kp_, vp_); kA = *(const u32x4v*)kp_; vA = *(const u32x4v*)vp_; }
    {
        int i = 0;
        for (; i + 1 < ntile; i += 2) {
            NSA_TILE(i, 0, kB2, vB2, kA, vA);
            NSA_TILE(i + 1, 1, kA, vA, kB2, vB2);
        }
        if (i < ntile) NSA_TILE(i, 0, kB2, vB2, kA, vA);
    }
#undef NSA_TILE
#undef NSA_SRC
    RG_END(104)
    bf16_t* yp = Y + tok * DM + head * 64;
#pragma unroll
    for (int i = 0; i < 4; ++i) {
        *(uint2*)(yp + 8 * i + 4 * hi) = make_uint2(cvtpk(y0[4 * i], y0[4 * i + 1]), cvtpk(y0[4 * i + 2], y0[4 * i + 3]));
        *(uint2*)(yp + 32 + 8 * i + 4 * hi) = make_uint2(cvtpk(y1[4 * i], y1[4 * i + 1]), cvtpk(y1[4 * i + 2], y1[4 * i + 3]));
    }
}

DI float log_sigmoid_(float x) { return x >= 0.f ? -__logf(1.f + __expf(-x)) : x - __logf(1.f + __expf(x)); }
DI float lane_shr_add(float v, int l) {
#pragma unroll
    for (int o = 1; o < 64; o <<= 1) { const float t = lane_get(v, l - o); if (l >= o) v += t; }
    return v;
}
DI float lane_shr_max(float v, int l) {
#pragma unroll
    for (int o = 1; o < 64; o <<= 1) { const float t = lane_get(v, l - o); if (l >= o) v = fmaxf(v, t); }
    return v;
}
DI float log_sigmoid_fast(float x) { return -__logf(1.f + __expf(-x)); }
DI void ml_mscan_all(const float* __restrict__ ifp, int bh, int lane, float* __restrict__ mtab, float* __restrict__ wprev, float* __restrict__ wsc) {
    const int b = bh >> 2, h = bh & 3;
    const float* gp = ifp + ((size_t)b * SEQ + 64 * lane) * 8 + h;
    float L = 0.f, mx = -3.0e38f;
#pragma unroll 16
    for (int s = 0; s < 64; ++s) { const float iv = gp[s * 8], fv = gp[s * 8 + 4]; L += log_sigmoid_fast(fv); mx = fmaxf(mx, iv - L); }
    const float G = L + mx;
    float m = 0.f, mine = 0.f, mnext = 0.f;
#pragma unroll
    for (int k = 0; k < 64; ++k) {
        const float Lk = __builtin_bit_cast(float, __builtin_amdgcn_readlane(__builtin_bit_cast(int, L), k)), Gk = __builtin_bit_cast(float, __builtin_amdgcn_readlane(__builtin_bit_cast(int, G), k));
        if (k == lane) mine = m;
        m = fmaxf(Lk + m, Gk);
        if (k == lane) mnext = m;
    }
    mtab[bh * 65 + lane] = mine;
    wprev[bh * 64 + lane] = __expf(L + mine - mnext);
    wsc[bh * 64 + lane] = __expf(G - mnext);
}
DI void ml_conv8(float (&o)[8], const bf16_t* __restrict__ MQK, size_t tok, int t_in_seq, int col, const float* __restrict__ wc, const float* __restrict__ bc, float scale) {
    const float4 b0 = *(const float4*)(bc + col), b1 = *(const float4*)(bc + col + 4);
    o[0] = b0.x; o[1] = b0.y; o[2] = b0.z; o[3] = b0.w; o[4] = b1.x; o[5] = b1.y; o[6] = b1.z; o[7] = b1.w;
#pragma unroll
    for (int j = 0; j < 4; ++j) {
        if (t_in_seq - 3 + j >= 0) {
            float u[8]; unpack8(*(const pg8::u32x4*)(MQK + (tok - 3 + j) * 1024 + col), u);
            const float4 w0 = *(const float4*)(wc + j * 1024 + col), w1 = *(const float4*)(wc + j * 1024 + col + 4);
            o[0] += w0.x * u[0]; o[1] += w0.y * u[1]; o[2] += w0.z * u[2]; o[3] += w0.w * u[3]; o[4] += w1.x * u[4]; o[5] += w1.y * u[5]; o[6] += w1.z * u[6]; o[7] += w1.w * u[7];
        }
    }
#pragma unroll
    for (int i = 0; i < 8; ++i) o[i] = o[i] * sigmoidf_(o[i]) * scale;
}
constexpr float ML_KSCALE = 0.08838834764831845f;
DI void ml_unit_c(int bh, int c, int tx, lds_c* lds, const bf16_t* __restrict__ MQK, const bf16_t* __restrict__ MV, const float* __restrict__ ifp, const float* __restrict__ wc, const float* __restrict__ bc,
                  bf16_t* __restrict__ dC, float* __restrict__ dn, float* __restrict__ wprev, const float* __restrict__ mtab) {
    const int b = bh >> 2, h = bh & 3, lane = tx & 63, r32 = lane & 31, hi = lane >> 5, wave = __builtin_amdgcn_readfirstlane(tx >> 6);
    lds_c* KT = lds; lds_c* VTw = lds + 128 * 144;
    __attribute__((address_space(3))) float* wsm = (__attribute__((address_space(3))) float*)(lds + 2 * 128 * 144);
    const size_t tok0 = (size_t)b * SEQ + 64 * c;
    __syncthreads();
    if (wave == 0) {
        const float iv = ifp[(tok0 + lane) * 8 + h], lf = log_sigmoid_(ifp[(tok0 + lane) * 8 + 4 + h]);
        const int l_ = lane_id_opaque();
        const float bc_ = lane_shr_add(lf, l_), u = iv - bc_, umax = wave_max(u);
        wsm[lane] = __expf(u - umax);
        (void)wprev; (void)mtab;
    }
    __syncthreads();
#pragma unroll 1
    for (int it = tx; it < 1024; it += 512) {
        const int s = it >> 4, d0 = (it & 15) * 8; float kv[8];
        ml_conv8(kv, MQK, tok0 + s, 64 * c + s, 512 + h * 128 + d0, wc, bc, ML_KSCALE);
        float vv[8]; unpack8(*(const pg8::u32x4*)(MV + (tok0 + s) * 512 + h * 128 + d0), vv);
        const float w = wsm[s];
#pragma unroll
        for (int i = 0; i < 8; ++i) {
            *(__attribute__((address_space(3))) bf16_t*)(KT + (d0 + i) * 144 + s * 2) = f2bf(kv[i]);
            *(__attribute__((address_space(3))) bf16_t*)(VTw + (d0 + i) * 144 + s * 2) = f2bf(vv[i] * w);
        }
    }
    __syncthreads();
    if (tx < 128) {
        float a = 0.f;
        for (int s = 0; s < 64; ++s) a += wsm[s] * bf2f(*(const __attribute__((address_space(3))) bf16_t*)(KT + tx * 144 + s * 2));
        dn[((size_t)bh * 64 + c) * 128 + tx] = a;
    }
    {
        const int vb = wave >> 1, kh = wave & 1;
        f32x16 acc0, acc1;
#pragma unroll
        for (int r = 0; r < 16; ++r) { acc0[r] = 0.f; acc1[r] = 0.f; }
#pragma unroll
        for (int ks = 0; ks < 4; ++ks) {
            const bf16x8 a = *(const __attribute__((address_space(3))) bf16x8*)(VTw + (vb * 32 + r32) * 144 + ks * 32 + hi * 16);
            const bf16x8 b0 = *(const __attribute__((address_space(3))) bf16x8*)(KT + (kh * 64 + r32) * 144 + ks * 32 + hi * 16);
            const bf16x8 b1 = *(const __attribute__((address_space(3))) bf16x8*)(KT + (kh * 64 + 32 + r32) * 144 + ks * 32 + hi * 16);
            acc0 = MFMA32(a, b0, acc0); acc1 = MFMA32(a, b1, acc1);
        }
        bf16_t* o = dC + ((size_t)bh * 64 + c) * 16384;
#pragma unroll
        for (int r = 0; r < 16; ++r) { const int v = vb * 32 + crow(r, hi);
            o[v * 128 + kh * 64 + r32] = f2bf(acc0[r]); o[v * 128 + kh * 64 + 32 + r32] = f2bf(acc1[r]); }
    }
}
DI void ml_scan(int gtid, int nthreads, bf16_t* __restrict__ dC, float* __restrict__ dn, const float* __restrict__ wprev, const float* __restrict__ wsc) {
    for (int p = gtid; p < 16 * 8192; p += nthreads) {
        const int bh = p >> 13, e2 = p & 8191;
        unsigned* base = (unsigned*)(dC + (size_t)bh * 64 * 16384) + e2;
        float r0 = 0.f, r1 = 0.f;
#pragma unroll 1
        for (int c0 = 0; c0 < 64; c0 += 16) {
            unsigned v[16];
#pragma unroll
            for (int j = 0; j < 16; ++j) v[j] = base[(size_t)(c0 + j) * 8192];
#pragma unroll
            for (int j = 0; j < 16; ++j) {
                const float w = wprev[bh * 64 + c0 + j], sc = wsc[bh * 64 + c0 + j];
                base[(size_t)(c0 + j) * 8192] = pk2(r0, r1);
                r0 = w * r0 + sc * __uint_as_float(v[j] << 16); r1 = w * r1 + sc * __uint_as_float(v[j] & 0xffff0000u);
            }
        }
    }
    for (int p = gtid; p < 16 * 128; p += nthreads) {
        const int bh = p >> 7, k = p & 127; float r = 0.f; float* q = dn + (size_t)bh * 64 * 128 + k;
#pragma unroll 1
        for (int c0 = 0; c0 < 64; c0 += 16) {
            float v[16];
#pragma unroll
            for (int j = 0; j < 16; ++j) v[j] = q[(c0 + j) * 128];
#pragma unroll
            for (int j = 0; j < 16; ++j) { q[(c0 + j) * 128] = r; r = wprev[bh * 64 + c0 + j] * r + wsc[bh * 64 + c0 + j] * v[j]; }
        }
    }
}
DI void ml_unit_e(int bh, int c, int tx, lds_c* lds, const bf16_t* __restrict__ MQK, const bf16_t* __restrict__ MV, const bf16_t* __restrict__ MO, const float* __restrict__ ifp,
                  const float* __restrict__ wc, const float* __restrict__ bc, const bf16_t* __restrict__ Sst, const float* __restrict__ nst, const float* __restrict__ mtab, const float* __restrict__ g_hn, bf16_t* __restrict__ Y) {
    const int b = bh >> 2, h = bh & 3, lane = tx & 63, r32 = lane & 31, hi = lane >> 5, wave = __builtin_amdgcn_readfirstlane(tx >> 6);
    lds_c* Qi = lds; lds_c* Ki = lds + 64 * 272; lds_c* VTi = lds + 2 * 64 * 272; lds_c* Si = VTi + 128 * 136;
    __attribute__((address_space(3))) float* fsm = (__attribute__((address_space(3))) float*)(Si + 128 * 272);
    const size_t tok0 = (size_t)b * SEQ + 64 * c;
    const float m_c = mtab[bh * 65 + c];
    __syncthreads();
    if (wave == 0) {
        const float iv = ifp[(tok0 + lane) * 8 + h], lf = log_sigmoid_(ifp[(tok0 + lane) * 8 + 4 + h]);
        const int l_ = lane_id_opaque();
        const float bc_ = lane_shr_add(lf, l_), u = iv - bc_, M = fmaxf(lane_shr_max(u, l_), m_c);
        fsm[lane] = u; fsm[64 + lane] = M; fsm[128 + lane] = __expf(-(bc_ + M));
    }
    if (wave == 1) { fsm[192 + lane] = nst[((size_t)bh * 64 + c) * 128 + lane]; fsm[192 + 64 + lane] = nst[((size_t)bh * 64 + c) * 128 + 64 + lane]; }
#pragma unroll 1
    for (int it = tx; it < 1024; it += 512) {
        const int s = it >> 4, d0 = (it & 15) * 8; float qv[8], kv[8];
        ml_conv8(qv, MQK, tok0 + s, 64 * c + s, h * 128 + d0, wc, bc, 1.f);
        ml_conv8(kv, MQK, tok0 + s, 64 * c + s, 512 + h * 128 + d0, wc, bc, ML_KSCALE);
        *(__attribute__((address_space(3))) pg8::u32x4*)(Qi + s * 272 + d0 * 2) = pack8(qv);
        *(__attribute__((address_space(3))) pg8::u32x4*)(Ki + s * 272 + d0 * 2) = pack8(kv);
        const pg8::u32x4 vw = *(const pg8::u32x4*)(MV + (tok0 + s) * 512 + h * 128 + d0);
        __attribute__((address_space(3))) bf16_t* vt = (__attribute__((address_space(3))) bf16_t*)(VTi + d0 * 136 + s * 2);
        vt[0] = (bf16_t)(vw.x & 0xffffu); vt[68] = (bf16_t)(vw.x >> 16); vt[136] = (bf16_t)(vw.y & 0xffffu); vt[204] = (bf16_t)(vw.y >> 16);
        vt[272] = (bf16_t)(vw.z & 0xffffu); vt[340] = (bf16_t)(vw.z >> 16); vt[408] = (bf16_t)(vw.w & 0xffffu); vt[476] = (bf16_t)(vw.w >> 16);
    }
    {
        const bf16_t* src = Sst + ((size_t)bh * 64 + c) * 16384;
#pragma unroll
        for (int j = 0; j < 4; ++j) { const int ch = tx + 512 * j, v = ch >> 4, k8 = (ch & 15) * 8;
            *(__attribute__((address_space(3))) pg8::u32x4*)(Si + v * 272 + k8 * 2) = *(const pg8::u32x4*)(src + v * 128 + k8); }
    }
    __syncthreads();
    const int tb = wave & 1, vb = wave >> 1, t = tb * 32 + r32;
    bf16x8 qf[8];
#pragma unroll
    for (int ks = 0; ks < 8; ++ks) qf[ks] = *(const __attribute__((address_space(3))) bf16x8*)(Qi + t * 272 + ks * 32 + hi * 16);
    f32x16 a0, a1;
#pragma unroll
    for (int r = 0; r < 16; ++r) { a0[r] = 0.f; a1[r] = 0.f; }
#pragma unroll
    for (int ks = 0; ks < 8; ++ks) {
        const bf16x8 k0 = *(const __attribute__((address_space(3))) bf16x8*)(Ki + r32 * 272 + ks * 32 + hi * 16);
        const bf16x8 k1 = *(const __attribute__((address_space(3))) bf16x8*)(Ki + (32 + r32) * 272 + ks * 32 + hi * 16);
        a0 = MFMA32(k0, qf[ks], a0); a1 = MFMA32(k1, qf[ks], a1);
    }
    const float Mt = fsm[64 + t], dec = __expf(m_c - Mt);
    float rs = 0.f;
#pragma unroll
    for (int r = 0; r < 16; ++r) {
        const int s0 = crow(r, hi), s1 = 32 + s0;
        a0[r] = s0 <= t ? __expf(fsm[s0] - Mt) * a0[r] : 0.f; a1[r] = s1 <= t ? __expf(fsm[s1] - Mt) * a1[r] : 0.f;
        rs += a0[r] + a1[r];
    }
    float nq = 0.f;
#pragma unroll
    for (int ks = 0; ks < 8; ++ks) { float qv[8]; unpack8(__builtin_bit_cast(pg8::u32x4, qf[ks]), qv);
#pragma unroll
        for (int j = 0; j < 8; ++j) nq += qv[j] * fsm[192 + ks * 16 + hi * 8 + j]; }
    float den = rs + dec * nq;
    { auto rr = __builtin_amdgcn_permlane32_swap(__float_as_uint(den), __float_as_uint(den), false, false); den = __uint_as_float(rr[0]) + __uint_as_float(rr[1]); }
    f32x16 n1, n2;
#pragma unroll
    for (int r = 0; r < 16; ++r) { n1[r] = 0.f; n2[r] = 0.f; }
#pragma unroll
    for (int hf = 0; hf < 2; ++hf)
#pragma unroll
        for (int ss = 0; ss < 2; ++ss) {
            unsigned pw[4];
#pragma unroll
            for (int j = 0; j < 4; ++j) pw[j] = hf ? cvtpk(a1[8 * ss + 2 * j], a1[8 * ss + 2 * j + 1]) : cvtpk(a0[8 * ss + 2 * j], a0[8 * ss + 2 * j + 1]);
            const u32x4v pbw = {pw[0], pw[1], pw[2], pw[3]};
            const lds_c* vp = VTi + (vb * 32 + r32) * 136 + hf * 64 + ss * 32 + hi * 8;
            const u32x2v lo = *(const __attribute__((address_space(3))) u32x2v*)vp, hi2 = *(const __attribute__((address_space(3))) u32x2v*)(vp + 16);
            const u32x4v aw = {lo.x, lo.y, hi2.x, hi2.y};
            n1 = MFMA32(__builtin_bit_cast(bf16x8, aw), __builtin_bit_cast(bf16x8, pbw), n1);
        }
#pragma unroll
    for (int ks = 0; ks < 8; ++ks) {
        const bf16x8 sa = *(const __attribute__((address_space(3))) bf16x8*)(Si + (vb * 32 + r32) * 272 + ks * 32 + hi * 16);
        n2 = MFMA32(sa, qf[ks], n2);
    }
    const float inv = 1.f / fmaxf(fabsf(den), fsm[128 + t]);
    const bf16_t* op = MO + (tok0 + t) * 512 + h * 128 + vb * 32;
    float hv[16]; float ssq = 0.f;
#pragma unroll
    for (int i = 0; i < 4; ++i) {
        const u32x2v ow = *(const u32x2v*)(op + 8 * i + 4 * hi);
        const float o4[4] = {__uint_as_float(ow.x << 16), __uint_as_float(ow.x & 0xffff0000u), __uint_as_float(ow.y << 16), __uint_as_float(ow.y & 0xffff0000u)};
#pragma unroll
        for (int j = 0; j < 4; ++j) { const float x = (n1[4 * i + j] + dec * n2[4 * i + j]) * inv * sigmoidf_(o4[j]); hv[4 * i + j] = x; ssq += x * x; }
    }
    { auto rr = __builtin_amdgcn_permlane32_swap(__float_as_uint(ssq), __float_as_uint(ssq), false, false); ssq = __uint_as_float(rr[0]) + __uint_as_float(rr[1]); }
    if (hi == 0) fsm[320 + t * 4 + vb] = ssq;
    __syncthreads();
    const float tot = (fsm[320 + t * 4] + fsm[320 + t * 4 + 1]) + (fsm[320 + t * 4 + 2] + fsm[320 + t * 4 + 3]);
    const float rstd = rsqrtf(tot * (1.f / 128.f) + 1e-6f);
    bf16_t* yp = Y + (tok0 + t) * DM + 512 + h * 128 + vb * 32; const float* gp = g_hn + h * 128 + vb * 32;
#pragma unroll
    for (int i = 0; i < 4; ++i) {
        const float4 gg = *(const float4*)(gp + 8 * i + 4 * hi);
        *(u32x2v*)(yp + 8 * i + 4 * hi) = (u32x2v){cvtpk(hv[4 * i] * rstd * gg.x, hv[4 * i + 1] * rstd * gg.y), cvtpk(hv[4 * i + 2] * rstd * gg.z, hv[4 * i + 3] * rstd * gg.w)};
    }
}

DI void cmp_unit(int kv, int bg, int jt, int tx, lds_c* lds, const bf16_t* __restrict__ KVb, const bf16_t* __restrict__ W1t, const bf16_t* __restrict__ W2t, const float* __restrict__ bias1p,
                 float* __restrict__ outf, bf16_t* __restrict__ kcb, bf16_t* __restrict__ vcT) {
    const int b = bg >> 1, g = bg & 1, lane = tx & 63, r32 = lane & 31, hi = lane >> 5, wave = __builtin_amdgcn_readfirstlane(tx >> 6), j0 = jt * 32;
    lds_c* TI = lds; lds_c* H1 = lds + 16 * 34 * 144;
    const bf16_t* src = KVb + ((size_t)b * SEQ + 16 * j0) * 512 + (kv ? 128 : 0) + g * 64;
    __syncthreads();
    for (int ch = tx; ch < 528 * 8; ch += 512) {
        const int t = ch >> 3, c8 = ch & 7;
        *(__attribute__((address_space(3))) pg8::u32x4*)(TI + ((t & 15) * 34 + (t >> 4)) * 144 + c8 * 16) = *(const pg8::u32x4*)(src + (size_t)t * 512 + c8 * 8);
    }
    __syncthreads();
    f32x16 acc;
#pragma unroll
    for (int r = 0; r < 16; ++r) acc[r] = 0.f;
    const bf16_t* wrow = W1t + (size_t)(wave * 32 + r32) * 2048 + hi * 8;
#pragma unroll 4
    for (int i = 0; i < 32; ++i) {
        const lds_c* arow = TI + ((i & 15) * 34 + r32 + (i >> 4)) * 144 + hi * 16;
#pragma unroll
        for (int dk = 0; dk < 4; ++dk) {
            const bf16x8 a = *(const __attribute__((address_space(3))) bf16x8*)(arow + dk * 32);
            const bf16x8 bfr = *(const bf16x8*)(wrow + i * 64 + dk * 16);
            acc = MFMA32(a, bfr, acc);
        }
    }
    {
        const int n = wave * 32 + r32; const float bias = bias1p[kv * 256 + n];
#pragma unroll
        for (int r = 0; r < 16; ++r) *(__attribute__((address_space(3))) bf16_t*)(H1 + crow(r, hi) * 528 + n * 2) = f2bf(gelu_tanh(acc[r] + bias));
    }
    __syncthreads();
    if (wave < 2) {
        f32x16 o;
#pragma unroll
        for (int r = 0; r < 16; ++r) o[r] = 0.f;
        const bf16_t* w2row = W2t + (size_t)(wave * 32 + r32) * 256 + hi * 8;
#pragma unroll
        for (int ks = 0; ks < 16; ++ks) {
            const bf16x8 a = *(const __attribute__((address_space(3))) bf16x8*)(H1 + r32 * 528 + ks * 32 + hi * 16);
            const bf16x8 bfr = *(const bf16x8*)(w2row + ks * 16);
            o = MFMA32(a, bfr, o);
        }
        const int d = wave * 32 + r32;
#pragma unroll
        for (int r = 0; r < 16; ++r) {
            const int j = j0 + crow(r, hi); const float v = j < 255 ? o[r] : 0.f;
            outf[((size_t)bg * 256 + j) * 64 + d] = v;
            if (kv == 0) kcb[((size_t)bg * 256 + j) * 64 + d] = f2bf(v);
            else vcT[((size_t)bg * 4 + (j >> 6)) * 4096 + d * 64 + (j & 63)] = f2bf(v);
        }
    }
}

#define XB_TMO      128
#define XB_XCNT(j)  (256  + 64 * (j))
#define XB_XSUB(j)  (1280 + 64 * (j))
#define XB_XGEN(j)  (2304 + 64 * (j))
#define XB_TOP      3328
#define XB_TOPGEN   3392
#define XCD_BAR_WORDS 3456
#define XB_SPIN_CAP (1u << 23)

__device__ __forceinline__ unsigned xb_ld(unsigned* p)              { return __hip_atomic_load(p, __ATOMIC_RELAXED, __HIP_MEMORY_SCOPE_AGENT); }
__device__ __forceinline__ unsigned xb_add(unsigned* p, unsigned v) { return __hip_atomic_fetch_add(p, v, __ATOMIC_RELAXED, __HIP_MEMORY_SCOPE_AGENT); }
__device__ __forceinline__ unsigned xb_xcc_id() { return (unsigned)__builtin_amdgcn_s_getreg((3 << 11) | 20) & 0xFu; }
#define XB_SPIN(cond, bar) do { unsigned _sp = 0; while (cond) { __builtin_amdgcn_s_sleep(1); \
    if ((++_sp & 255u) == 0u) { if (xb_ld(&(bar)[XB_TMO])) break; if (_sp > XB_SPIN_CAP) { atomicAdd(&(bar)[XB_TMO], 1u); break; } } } } while (0)

struct XcdBarrier {
    unsigned* bar; unsigned x;
    volatile __attribute__((address_space(3))) unsigned* st;
};

__device__ __forceinline__ XcdBarrier xcd_barrier_post(unsigned* bar, volatile __attribute__((address_space(3))) unsigned* st) {
    XcdBarrier b; b.bar = bar; b.x = xb_xcc_id(); b.st = st;
    if (threadIdx.x == 0) (void)xb_add(&bar[XB_XCNT(b.x)], 1u);
    return b;
}
__device__ __forceinline__ void xcd_barrier_complete(unsigned* bar, unsigned x, unsigned& nloc, unsigned& nx) {
    const unsigned G = gridDim.x * gridDim.y * gridDim.z;
    unsigned sum, cnt, mine, sp = 0u;
    for (;;) {
        sum = 0u; cnt = 0u; mine = 0u;
#pragma unroll
        for (unsigned j = 0; j < 16; ++j) { const unsigned c = xb_ld(&bar[XB_XCNT(j)]); sum += c; cnt += (c > 0u) ? 1u : 0u; mine = (j == x) ? c : mine; }
        if (sum == G) break;
        __builtin_amdgcn_s_sleep(1);
        if ((++sp & 255u) == 0u) { if (xb_ld(&bar[XB_TMO])) break; if (sp > XB_SPIN_CAP) { atomicAdd(&bar[XB_TMO], 1u); break; } }
    }
    nloc = mine > 0u ? mine : 1u; nx = cnt > 0u ? cnt : 1u;
}

__device__ __forceinline__ void xcd_barrier(const XcdBarrier& b) {
    asm volatile("s_waitcnt vmcnt(0)" ::: "memory");
    __syncthreads();
    if (threadIdx.x == 0) {
        unsigned* bar = b.bar;
        __builtin_amdgcn_s_waitcnt(0);
        unsigned nloc = b.st[0], nx = b.st[1];
        if (nloc == 0u) { xcd_barrier_complete(bar, b.x, nloc, nx); b.st[0] = nloc; b.st[1] = nx; }
        const unsigned old = xb_add(&bar[XB_XSUB(b.x)], 1u);
        const unsigned gen = old / nloc;
        if (old + 1u == (gen + 1u) * nloc) {
            __builtin_amdgcn_fence(__ATOMIC_RELEASE, "agent");
            asm volatile("s_waitcnt vmcnt(0)" ::: "memory");
            const unsigned og = xb_add(&bar[XB_TOP], 1u);
            const unsigned tg = og / nx;
            if (og + 1u == (tg + 1u) * nx) xb_add(&bar[XB_TOPGEN], 1u);
            else XB_SPIN(xb_ld(&bar[XB_TOPGEN]) == tg, bar);
            __builtin_amdgcn_fence(__ATOMIC_ACQUIRE, "agent");
            xb_add(&bar[XB_XGEN(b.x)], 1u);
            asm volatile("s_waitcnt vmcnt(0)" ::: "memory");
        } else {
            XB_SPIN(xb_ld(&bar[XB_XGEN(b.x)]) == gen, bar);
            __builtin_amdgcn_fence(__ATOMIC_ACQUIRE, "agent");
            asm volatile("s_waitcnt vmcnt(0)" ::: "memory");
        }
    }
    __syncthreads();
}

#ifndef NSA_CHECK
#define NSA_CHECK 0
#endif
#ifndef REP_MASK
#define REP_MASK 0u
#endif
struct Args { const float* in[29]; float* out; char* ws; unsigned rep_mask; unsigned pad; };
constexpr int LDS_BYTES = 147456;

__global__ __launch_bounds__(512, 2) void mk_fwd(Args a) {
    extern __shared__ __attribute__((aligned(16))) char lds_raw[];
    cg::grid_group grid = cg::this_grid();
    const int NB = gridDim.x * 2, NGW = gridDim.x * 8;
    const unsigned repm = a.rep_mask;
    volatile __attribute__((address_space(3))) unsigned* bar_st = (volatile __attribute__((address_space(3))) unsigned*)((lds_c*)lds_raw + (LDS_BYTES - 64));
    if (threadIdx.x < 2) bar_st[threadIdx.x] = 0u;
    __syncthreads();
    const XcdBarrier xbar = xcd_barrier_post((unsigned*)(a.ws + ((size_t)42 << 20) + 65536), bar_st);
#define GRID_BAR() xcd_barrier(xbar)
#ifndef SPIN_PHASE_UNUSED_
#endif
    unsigned long long ts_prev_ = 0ull, ts_probe_ = 0ull; int n_stamp_ = 0;
#define STAMP() do { if (SPIN_PHASE >= 0 && blockIdx.x == 0) { const unsigned long long now_ = __builtin_amdgcn_s_memrealtime(); if (n_stamp_ == SPIN_PHASE) ts_probe_ = now_ - ts_prev_; ts_prev_ = now_; ++n_stamp_; } } while (0)
    if (SPIN_PHASE >= 0 && blockIdx.x == 0) ts_prev_ = __builtin_amdgcn_s_memrealtime();
    const int wave_s_ = __builtin_amdgcn_readfirstlane(threadIdx.x >> 6);
#define KARG(T, off) (*(T const __attribute__((address_space(4)))*)(kargs_ + (off)))
#define PTRS const float* x = KARG(const float*, 8 * 0); const float* p = KARG(const float*, 8 * 1); const int* pos = KARG(const int*, 16); \
    const float* g_mix = KARG(const float*, 8 * 3); const float* w_in = KARG(const float*, 8 * 4); const float* b_if = KARG(const float*, 8 * 5); \
    const float* w_ck1 = KARG(const float*, 8 * 6); const float* w_ck2 = KARG(const float*, 8 * 7); const float* pe_ck = KARG(const float*, 8 * 8); \
    const float* w_cv1 = KARG(const float*, 8 * 9); const float* w_cv2 = KARG(const float*, 8 * 10); const float* pe_cv = KARG(const float*, 8 * 11); \
    const float* w_conv = KARG(const float*, 8 * 12); const float* b_conv = KARG(const float*, 8 * 13); const float* g_hn = KARG(const float*, 8 * 14); \
    const float* w_pa = KARG(const float*, 8 * 15); const float* w_pb = KARG(const float*, 8 * 16); const float* w_out = KARG(const float*, 8 * 17); \
    const float* g_ffn = KARG(const float*, 8 * 18); const float* w_rg = KARG(const float*, 8 * 19); const float* b_rg = KARG(const float*, 8 * 20); \
    const float* w_re = KARG(const float*, 8 * 21); const float* b_re = KARG(const float*, 8 * 22); const float* w_e13 = KARG(const float*, 8 * 23); \
    const float* w_e2 = KARG(const float*, 8 * 24); const float* g_ple = KARG(const float*, 8 * 25); const float* w_pg = KARG(const float*, 8 * 26); \
    const float* w_pp = KARG(const float*, 8 * 27); const float* g_final = KARG(const float*, 8 * 28); \
    float* out = KARG(float*, 232); char* ws = KARG(char*, 240); \
    const size_t MiB = 1u << 20; \
    bf16_t* Wt_in = (bf16_t*)(ws); \
    bf16_t* xb = (bf16_t*)(ws + 48 * MiB); \
    bf16_t* Qb = (bf16_t*)(ws + 80 * MiB); \
    bf16_t* KVb = (bf16_t*)(ws + 96 * MiB); bf16_t* VT = (bf16_t*)(ws + 112 * MiB); bf16_t* kcb = (bf16_t*)(ws + 249 * MiB + 512 * 1024); bf16_t* vcT = (bf16_t*)(ws + 249 * MiB + 768 * 1024); \
    bf16_t* MQK = (bf16_t*)(ws + 120 * MiB); \
    bf16_t* MV = (bf16_t*)(ws + 152 * MiB); \
    bf16_t* MO = (bf16_t*)(ws + 168 * MiB); \
    bf16_t* MG = (bf16_t*)(ws + 184 * MiB); \
    float* gates = (float*)(ws + 248 * MiB); \
    float* ifp = (float*)(ws + 250 * MiB); \
    float* kcc = (float*)(ws + 251 * MiB); \
    float* vcc = (float*)(ws + 252 * MiB); \
    float* gate16 = (float*)(ws + 253 * MiB); \
    float* rstd0 = (float*)(ws + 254 * MiB); \
    float* cosT = (float*)(ws + 254 * MiB + 512 * 1024); \
    float* sinT = (float*)(ws + 255 * MiB); \
    bf16_t* Y = (bf16_t*)(out + (size_t)8 * 1024 * 1024); \
    bf16_t* dC = xb; float* dn = (float*)(ws + 250 * MiB + 512 * 1024); float* wprev = (float*)(ws + 42 * MiB + 4096); float* mtab = (float*)(ws + 42 * MiB + 8192); float* wsc = (float*)(ws + 42 * MiB + 16384); \
    float* tmp = (float*)(ws + 120 * MiB); bf16_t* mixed = xb; \
    bf16_t* Wpa_t = (bf16_t*)(ws + 11 * MiB); bf16_t* Wpb_t = (bf16_t*)(ws + 12 * MiB); bf16_t* Wout_t = (bf16_t*)(ws + 13 * MiB); \
    bf16_t* We13_t = (bf16_t*)(ws + 15 * MiB); bf16_t* We2_t = (bf16_t*)(ws + 31 * MiB); bf16_t* Wpg_t = (bf16_t*)(ws + 39 * MiB); bf16_t* Wpp_t = (bf16_t*)(ws + 41 * MiB); \
    int* cnt = (int*)(ws + 42 * MiB); bf16_t* W1t_k = (bf16_t*)(ws + 43 * MiB); bf16_t* W1t_v = (bf16_t*)(ws + 44 * MiB); bf16_t* W2t_k = (bf16_t*)(ws + 45 * MiB); bf16_t* W2t_v = (bf16_t*)(ws + 45 * MiB + 65536); float* bias1p = (float*)(ws + 45 * MiB + 524288); \
    bf16_t* x1b = (bf16_t*)(ws + 48 * MiB); bf16_t* act = (bf16_t*)(ws + 120 * MiB); bf16_t* y2 = (bf16_t*)(ws + 138 * MiB); bf16_t* x2b = (bf16_t*)(ws + 210 * MiB); int* elist = (int*)(ws + 242 * MiB); \
    bf16_t* pb = (bf16_t*)(ws + 80 * MiB); bf16_t* PP = (bf16_t*)(ws + 88 * MiB); \
    int* rinfo = (int*)(ws + 253 * MiB); float* rstd1 = (float*)(ws + 253 * MiB + 512 * 1024); float* rstd2 = (float*)(ws + 253 * MiB + 768 * 1024); \
    (void)x; (void)p; (void)pos; (void)g_mix; (void)w_in; (void)b_if; (void)w_ck1; (void)w_ck2; (void)pe_ck; (void)w_cv1; (void)w_cv2; (void)pe_cv; (void)w_conv; (void)b_conv; (void)g_hn; (void)w_pa; (void)w_pb; (void)w_out; (void)g_ffn; (void)w_rg; (void)b_rg; (void)w_re; (void)b_re; (void)w_e13; (void)w_e2; (void)g_ple; (void)w_pg; (void)w_pp; (void)g_final;
#define PHASE(k) for (int rep_ = 0; rep_ < 1 + (int)((repm >> (k)) & 1u); ++rep_)
#define PHASE_IDS unsigned tx_ = (unsigned)(wave_s_ * 64); asm volatile("" : "+v"(tx_)); tx_ = (unsigned)__builtin_amdgcn_mbcnt_hi(-1, __builtin_amdgcn_mbcnt_lo(-1, (int)tx_)); const int half = tx_ >> 8, tid = tx_ & 255, lane64 = tx_ & 63, tid512 = (int)tx_; \
    const int wave = __builtin_amdgcn_readfirstlane(tx_ >> 6); char* sm = lds_raw + half * 65536; const int gw = blockIdx.x * 8 + wave; (void)tid; (void)lane64; (void)sm; (void)gw; (void)tid512; \
    const __attribute__((address_space(4))) char* kargs_ = (const __attribute__((address_space(4))) char*)__builtin_amdgcn_kernarg_segment_ptr(); asm volatile("" : "+s"(kargs_)); PTRS
#define VB_LOOP(nvb) for (int vb = blockIdx.x * 2 + half; vb < (nvb); vb += NB)
#define GEMM_PHASE(NT, MT, ...) do { VB_LOOP((NT) * (MT)) { const int bx_ = vb % (NT), by_ = vb / (NT); __syncthreads(); gemm_v1(bx_, by_, tid, sm, __VA_ARGS__); } } while (0)
    PHASE(0) { PHASE_IDS
        float* scr = (float*)(lds_raw + wave * 8448);
        for (int it = gw; it < (DM / 64) * (NIN / 32); it += NGW) prep_wt_item(w_in, DIN, DM, Wt_in, g_mix, MapIn{}, scr, it, NIN / 32, lane64);
        for (int it = gw; it < 2 * 256; it += NGW) { const int kv = it >> 8; prep_wt_item(kv ? w_cv1 : w_ck1, 256, 2048, kv ? W1t_v : W1t_k, (const float*)nullptr, MapId{}, scr, it & 255, 8, lane64); }
        for (int it = gw; it < 2 * 8; it += NGW) { const int kv = it >> 3; prep_wt_item(kv ? w_cv2 : w_ck2, 64, 256, kv ? W2t_v : W2t_k, (const float*)nullptr, MapId{}, scr, it & 7, 2, lane64); }
        if (gw < 512) {
            const int kv = gw >> 8, n = gw & 255; const float* w1 = kv ? w_cv1 : w_ck1; const float* pe = kv ? pe_cv : pe_ck; float a = 0.f;
#pragma unroll
            for (int i = 0; i < 32; ++i) { const int k = lane64 + 64 * i; a += pe[k] * w1[(size_t)k * 256 + n]; }
            a = wave_sum(a);
            if (lane64 == 0) bias1p[gw] = a;
        }
        if (blockIdx.x == 0 && tid512 < 16) cnt[tid512 * CNT_STRIDE] = 0;
        for (int r = gw; r < T_TOK; r += NGW) prep_x_row(x, xb, rstd0, r, lane64);
        for (int i = blockIdx.x * 512 + tid512; i < T_TOK * 8; i += gridDim.x * 512) {
            const float inv = powf(500000.0f, -(float)(2 * (i & 7)) / 16.0f); float sn, cs; sincosf((float)pos[i >> 3] * inv, &sn, &cs); cosT[i] = cs; sinT[i] = sn; }
    }
    if (repm == 0x80000000u) grid.sync();
    GRID_BAR(); STAMP();
    PHASE(1) { PHASE_IDS
        pg8::Gemm g{xb, Wt_in, T_TOK, NIN, DM, DM, DM}; pg8::StaticOrder S; S.init(T_TOK, NIN, (int)gridDim.x, (int)blockIdx.x);
        EpiInProj E{rstd0, cosT, sinT, b_if, Qb, KVb, gates, ifp, MQK, MV, MO, MG, VT};
        pg8::gemm_phase<EpiInProj, pg8::StaticOrder, true, true>((PG8_LAS unsigned char*)lds_raw, g, S, E, tid512);
    }
    {   PHASE_IDS
        const int G_ = (int)gridDim.x, nfull_ = (64 * (NIN / 256)) % G_;
        const int nl_ = G_ - nfull_, lw_ = (int)blockIdx.x - nfull_;
        if (nfull_ == 0 || lw_ >= 0) {
            const int lgw = (nfull_ == 0 ? (int)blockIdx.x : lw_) * 8 + wave, LNGW = (nfull_ == 0 ? G_ : nl_) * 8;
            float* scr = (float*)(lds_raw + wave * 8448); float* scr2 = (float*)(lds_raw + wave * 16896); (void)scr;
            __syncthreads();
            for (int it = lgw; it < 16 * 128; it += LNGW) { const int e = it >> 7, i2 = (it & 127) * 2; const float* w_ = w_e13 + (size_t)e * 1024 * 512; bf16_t* t_ = We13_t + (size_t)e * 512 * 1024;
                prep_wt_item2(w_, w_, 512, DM, t_, t_, g_ffn, MapE13{}, scr2, i2, i2 + 1, 16, lane64); }
            if ((int)gridDim.x != 256) {
                for (int it = lgw; it < 8 * 32; it += LNGW) prep_wt_item(w_pa, DM, DM, Wpa_t, (const float*)nullptr, MapId{}, scr, it, 32, lane64);
                for (int it = lgw; it < 8 * 32; it += LNGW) prep_wt_item(w_pb, DM, DM, Wpa_t + 512, (const float*)nullptr, MapId{}, scr, it, 32, lane64);
                for (int it = lgw; it < 16 * 32; it += LNGW) prep_wt_item(w_out, DM, DM, Wout_t, (const float*)nullptr, MapId{}, scr, it, 32, lane64);
                for (int it = lgw; it < 16 * 32; it += LNGW) prep_wt_item(w_pg, DM, DM, Wpg_t, g_ple, MapId{}, scr, it, 32, lane64);
                for (int it = lgw; it < 4 * 32; it += LNGW) prep_wt_item(w_pp, DM, 256, Wpp_t, (const float*)nullptr, MapId{}, scr, it, 32, lane64);
                for (int it = lgw; it < 16 * 64; it += LNGW) { const int e = it >> 6, i2 = (it & 63) * 2; const float* w_ = w_e2 + (size_t)e * 256 * 1024; bf16_t* t_ = We2_t + (size_t)e * 1024 * 256;
                prep_wt_item2(w_, w_, DM, 256, t_, t_, (const float*)nullptr, MapId{}, scr2, i2, i2 + 1, 32, lane64); }
            }
        }
    }
    GRID_BAR(); STAMP();
    PHASE(2) { PHASE_IDS
        for (int u = blockIdx.x; u < 128; u += gridDim.x) { const int kv = u >> 6, bg = (u >> 3) & 7, jt = u & 7;
            cmp_unit(kv, bg, jt, tid512, (lds_c*)lds_raw, KVb, kv ? W1t_v : W1t_k, kv ? W2t_v : W2t_k, bias1p, kv ? vcc : kcc, kcb, vcT); }
        { const int v_ = (int)blockIdx.x - 128; if (v_ >= 0 && v_ < 16 && wave == 0) ml_mscan_all(ifp, v_, lane64, mtab, wprev, wsc); }
    }
    PHASE(3) { PHASE_IDS
        { const int G_ = (int)gridDim.x, c_ = (int)blockIdx.x;
          if (G_ == 256) { const int n_ = c_ < 128 ? 3 : 5, first_ = c_ < 128 ? 3 * c_ : 384 + 5 * (c_ - 128);
              for (int u = first_; u < first_ + n_; ++u) ml_unit_c(u >> 6, u & 63, tid512, (lds_c*)lds_raw, MQK, MV, ifp, w_conv, b_conv, dC, dn, wprev, mtab); }
          else for (int u = c_; u < 1024; u += G_) ml_unit_c(u >> 6, u & 63, tid512, (lds_c*)lds_raw, MQK, MV, ifp, w_conv, b_conv, dC, dn, wprev, mtab); }
        if ((int)gridDim.x == 256 && (int)blockIdx.x >= 128) {
            const int lgw = ((int)blockIdx.x - 128) * 8 + wave, LNGW = 128 * 8; float* scr = (float*)(lds_raw + wave * 16896); float* scr2 = scr;
            __syncthreads();
            for (int it = lgw; it < 8 * 32; it += LNGW) prep_wt_item(w_pa, DM, DM, Wpa_t, (const float*)nullptr, MapId{}, scr, it, 32, lane64);
            for (int it = lgw; it < 8 * 32; it += LNGW) prep_wt_item(w_pb, DM, DM, Wpa_t + 512, (const float*)nullptr, MapId{}, scr, it, 32, lane64);
            for (int it = lgw; it < 16 * 32; it += LNGW) prep_wt_item(w_out, DM, DM, Wout_t, (const float*)nullptr, MapId{}, scr, it, 32, lane64);
            for (int it = lgw; it < 16 * 32; it += LNGW) prep_wt_item(w_pg, DM, DM, Wpg_t, g_ple, MapId{}, scr, it, 32, lane64);
            for (int it = lgw; it < 4 * 32; it += LNGW) prep_wt_item(w_pp, DM, 256, Wpp_t, (const float*)nullptr, MapId{}, scr, it, 32, lane64);
            for (int it = lgw; it < 16 * 64; it += LNGW) { const int e = it >> 6, i2 = (it & 63) * 2; const float* w_ = w_e2 + (size_t)e * 256 * 1024; bf16_t* t_ = We2_t + (size_t)e * 1024 * 256;
                prep_wt_item2(w_, w_, DM, 256, t_, t_, (const float*)nullptr, MapId{}, scr2, i2, i2 + 1, 32, lane64); }
        }
    }
    GRID_BAR(); STAMP();
    {   PHASE_IDS
        ml_scan(blockIdx.x * 512 + tid512, gridDim.x * 512, dC, dn, wprev, wsc);
    }
    GRID_BAR(); STAMP();
    PHASE(4) { PHASE_IDS
        for (int u = blockIdx.x; u < 1024; u += gridDim.x) ml_unit_e(u >> 6, u & 63, tid512, (lds_c*)lds_raw, MQK, MV, MO, ifp, w_conv, b_conv, dC, dn, mtab, g_hn, Y);
    }
    PHASE(5) { PHASE_IDS
        for (int pr = blockIdx.x; pr < 256; pr += gridDim.x) {
            nsa_unit(pr & 7, 63 - (pr >> 3), tid512, (lds_c*)lds_raw, Qb, KVb, VT, kcb, vcT, gates, Y, ts_probe_);
            nsa_unit(pr & 7, pr >> 3, tid512, (lds_c*)lds_raw, Qb, KVb, VT, kcb, vcT, gates, Y, ts_probe_);
        }
    }
#if NSA_CHECK
    {   PHASE_IDS
        bf16_t* Y2 = (bf16_t*)(ws + 120 * MiB); unsigned* stats = (unsigned*)(ws + 42 * MiB + 32768);
        if (blockIdx.x == 0 && tid512 == 0) { stats[0] = 0u; stats[1] = 0u; }
        grid.sync();
        float* kcc2 = (float*)(ws + 251 * MiB + 512 * 1024); float* vcc2 = (float*)(ws + 252 * MiB + 512 * 1024); bf16_t* dummy = (bf16_t*)(ws + 160 * MiB);
        VB_LOOP(4080) { const int j = vb % 255, r = vb / 255; compress_naive(j, r & 7, r >> 3, tid, sm, KVb, w_ck1, w_ck2, pe_ck, w_cv1, w_cv2, pe_cv, kcc2, vcc2, dummy, dummy + 1048576); }
        grid.sync();
        VB_LOOP(T_TOK * 2) nsa_naive(vb >> 1, vb & 1, tid, sm, Qb, KVb, VT, kcc2, vcc2, gates, Y2);
        grid.sync();
        unsigned c1 = 0, c2 = 0;
        for (size_t i = (size_t)blockIdx.x * 512 + tid512; i < (size_t)T_TOK * 512; i += (size_t)gridDim.x * 512) {
            const size_t o = (i >> 9) * DM + (i & 511); const float d = fabsf(bf2f(Y[o]) - bf2f(Y2[o])); c1 += d > 0.02f ? 1u : 0u; c2 += (d > 0.1f || !(d == d)) ? 1u : 0u; }
        if (c1) atomicAdd(stats, c1); if (c2) atomicAdd(stats + 1, c2);
    }
#endif
    GRID_BAR(); STAMP();
    PHASE(7) { PHASE_IDS
        pg8::StaticOrder S; S.init(T_TOK, DM, (int)gridDim.x, (int)blockIdx.x);
        pg8::Gemm g{Y, Wpa_t, T_TOK, DM, DM, DM, DM}; EpiMerge2 E{MG, mixed}; pg8::gemm_phase<EpiMerge2, pg8::StaticOrder, true, true>((PG8_LAS unsigned char*)lds_raw, g, S, E, tid512);
    }
    GRID_BAR(); STAMP();
    PHASE(9) { PHASE_IDS
        pg8::Gemm g{mixed, Wout_t, T_TOK, DM, DM, DM, DM}; pg8::StaticOrder S; S.init(T_TOK, DM, (int)gridDim.x, (int)blockIdx.x);
        EpiX1 E{x, out, x1b};
        pg8::gemm_phase<EpiX1, pg8::StaticOrder, true, true>((PG8_LAS unsigned char*)lds_raw, g, S, E, tid512);
    }
    GRID_BAR(); STAMP();
    {   PHASE_IDS
        unsigned long long& pacc = ts_probe_;
        RG_BEGIN(110)
        __attribute__((address_space(3))) float* Wl = (__attribute__((address_space(3))) float*)((lds_c*)lds_raw);
        __attribute__((address_space(3))) int* lcnt = (__attribute__((address_space(3))) int*)((lds_c*)lds_raw + 20 * 4096);
        __attribute__((address_space(3))) int* lri = lcnt + 32;
        for (int t = gw * 4; t < T_TOK; t += NGW * 4) {
            float4 pv[4];
#pragma unroll
            for (int j = 0; j < 4; ++j) pv[j] = ((const float4*)(p + (size_t)(t + j) * 256))[lane64];
#pragma unroll
            for (int j = 0; j < 4; ++j) { uint2 o; o.x = pk2(pv[j].x, pv[j].y); o.y = pk2(pv[j].z, pv[j].w); ((uint2*)(pb + (size_t)(t + j) * 256))[lane64] = o; } }
        __syncthreads(); router_stage(Wl, g_ffn, w_rg, w_re, tid512); if (tid512 < 16) lcnt[tid512] = 0; __syncthreads();
        RG_END(110)
        RG_BEGIN(111)
        for (int r_ = 0; r_ < T_TOK / (NGW * 4); ++r_) {
            int tk_[4]; f4v xv_[16];
#pragma unroll
            for (int g_ = 0; g_ < 4; ++g_) tk_[g_] = gw + NGW * (4 * r_ + g_);
            const int mytok_ = gw + NGW * (4 * r_ + (lane64 >> 4));
#pragma unroll
            for (int j = 0; j < 16; ++j) xv_[j] = *(const f4v*)(out + (size_t)mytok_ * DM + 4 * ((lane64 & 15) + 16 * j));
            router4(tk_, lane64, xv_, Wl, b_rg, b_re, rstd1, lcnt, lri + (wave * 8 + r_ * 4) * 4);
        }
        __syncthreads();
        RG_END(111)
        RG_BEGIN(112)
        if (tid512 < 16) lcnt[16 + tid512] = atomicAdd(cnt + tid512 * CNT_STRIDE, lcnt[tid512]);
        __syncthreads();
        { int i = 0; for (int t = gw; t < T_TOK; t += NGW, ++i) if (lane64 == 0) { __attribute__((address_space(3))) int* r = lri + (wave * 8 + i) * 4;
            const int e0 = r[0] & 255, e1 = (r[0] >> 8) & 255, q0 = (r[1] & 0xffff) + lcnt[16 + e0], q1 = (r[1] >> 16) + lcnt[16 + e1]; int4 ri; ri.x = r[0]; ri.y = q0 | (q1 << 16); ri.z = r[2]; ri.w = r[3];
            *(int4*)(rinfo + (size_t)t * 4) = ri; elist[e0 * T_TOK + q0] = t; elist[e1 * T_TOK + q1] = t; } }
        RG_END(112)
    }
    GRID_BAR(); STAMP();
    {
        int ntile_ = 0;
        {   PHASE_IDS
            for (int e = 0; e < 16; ++e) ntile_ += (cnt[e * CNT_STRIDE] + 255) >> 8; }
        const int G_ = (int)gridDim.x, c_ = (int)blockIdx.x, per_ = (G_ % 8 == 0) ? (ntile_ + 7) / 8 : 0;
#pragma unroll 1
        for (int rnd = 0; ; ++rnd) {
            int ti;
            if (per_ > 0 && per_ * 8 <= G_) { if (rnd > 0) break; ti = ((c_ >> 3) < per_) ? (c_ & 7) * per_ + (c_ >> 3) : ntile_; }
            else ti = c_ + rnd * G_;
            if (ti >= ntile_) break;
            {   PHASE_IDS
                MoeOrder S{cnt, 1, 1, ti}; pg8::Unit u; S.next(0, u);
                const int e = u.pn, nv = cnt[e * CNT_STRIDE] - u.aux * 256; const int* amap = elist + (size_t)e * T_TOK + u.aux * 256;
                pg8::Gemm g{x1b, We13_t, 0, 0, DM, DM, DM, amap, nv}; EpiSwiglu E{act, amap, nv, rstd1}; TwoUnits S2{u.pm, e * 2, u.aux};
                __syncthreads();
                pg8::gemm_phase<EpiSwiglu, TwoUnits, false, true, true>((PG8_LAS unsigned char*)lds_raw, g, S2, E, tid512);
                asm volatile("s_waitcnt vmcnt(0)" ::: "memory");
                __syncthreads();
                if (tid512 == 0) { __builtin_amdgcn_fence(__ATOMIC_ACQUIRE, "agent"); asm volatile("s_waitcnt vmcnt(0)" ::: "memory"); }
                __syncthreads();
            }
            {   PHASE_IDS
                MoeOrder S{cnt, 1, 1, ti}; pg8::Unit u; S.next(0, u);
                int k2_ = 256; asm volatile("" : "+s"(k2_));
                pg8::Gemm g{act, We2_t, 0, 0, k2_, k2_, k2_}; FourUnits S4{u.pm, u.pn * 4}; EpiStoreBf E{y2, DM, 3};
                pg8::gemm_phase<EpiStoreBf, FourUnits, true, true>((PG8_LAS unsigned char*)lds_raw, g, S4, E, tid512);
            }
        }
        {   unsigned* mq = (unsigned*)(a.ws + ((size_t)42 << 20) + 36864);
            volatile __attribute__((address_space(3))) unsigned* idw = (volatile __attribute__((address_space(3))) unsigned*)((lds_c*)lds_raw + (LDS_BYTES - 32));
#pragma unroll 1
            for (;;) {
                PHASE_IDS
                __syncthreads();
                if (tid512 == 0) idw[0] = __hip_atomic_fetch_add(mq, 1u, __ATOMIC_RELAXED, __HIP_MEMORY_SCOPE_AGENT);
                __syncthreads();
                const int up = (int)idw[0];
                if (up >= 256) break;
                pg8::Unit uu; uu.pm = up >> 2; uu.pn = up & 3; uu.aux = 0;
                int k2_ = 256; asm volatile("" : "+s"(k2_));
                pg8::Gemm g{pb, Wpp_t, T_TOK, DM, k2_, k2_, k2_}; EpiStoreBf E{PP, DM, 3}; OneUnit S1{uu};
                pg8::gemm_phase<EpiStoreBf, OneUnit, false, true>((PG8_LAS unsigned char*)lds_raw, g, S1, E, tid512);
            }
        }
    }
    GRID_BAR(); STAMP();
    {   PHASE_IDS
        for (int t = gw; t < T_TOK; t += NGW) {
            int4 ri = *(const int4*)(rinfo + (size_t)t * 4); ri.x = __builtin_amdgcn_readfirstlane(ri.x); ri.y = __builtin_amdgcn_readfirstlane(ri.y); ri.z = __builtin_amdgcn_readfirstlane(ri.z); ri.w = __builtin_amdgcn_readfirstlane(ri.w);
            const int r0 = moe_base_row(cnt, ri.x & 255) + (ri.y & 0xffff), r1 = moe_base_row(cnt, (ri.x >> 8) & 255) + ((ri.y >> 16) & 0xffff);
            const float w0 = __int_as_float(ri.z), w1 = __int_as_float(ri.w);
            float4 v[4]; float s2 = 0.f;
#pragma unroll
            for (int j = 0; j < 4; ++j) { v[j] = ((const float4*)(out + (size_t)t * DM))[lane64 + 64 * j];
                const uint2 a0 = ((const uint2*)(y2 + (size_t)r0 * DM))[lane64 + 64 * j], a1 = ((const uint2*)(y2 + (size_t)r1 * DM))[lane64 + 64 * j];
                v[j].x += w0 * __uint_as_float(a0.x << 16) + w1 * __uint_as_float(a1.x << 16); v[j].y += w0 * __uint_as_float(a0.x & 0xffff0000u) + w1 * __uint_as_float(a1.x & 0xffff0000u);
                v[j].z += w0 * __uint_as_float(a0.y << 16) + w1 * __uint_as_float(a1.y << 16); v[j].w += w0 * __uint_as_float(a0.y & 0xffff0000u) + w1 * __uint_as_float(a1.y & 0xffff0000u);
                s2 += v[j].x * v[j].x + v[j].y * v[j].y + v[j].z * v[j].z + v[j].w * v[j].w; }
            s2 = wave_sum(s2);
            if (lane64 == 0) rstd2[t] = rsqrtf(s2 * (1.f / DM) + 1e-6f);
#pragma unroll
            for (int j = 0; j < 4; ++j) { ((float4*)(out + (size_t)t * DM))[lane64 + 64 * j] = v[j]; uint2 o; o.x = pk2(v[j].x, v[j].y); o.y = pk2(v[j].z, v[j].w); ((uint2*)(x2b + (size_t)t * DM))[lane64 + 64 * j] = o; }
        }
    }
    GRID_BAR(); STAMP();
    if ((int)gridDim.x == 256) {
        PHASE_IDS
        __syncthreads();
        pg8::StaticOrder S; S.init(T_TOK, DM, (int)gridDim.x, (int)blockIdx.x);
        pg8::Gemm g{x2b, Wpg_t, T_TOK, DM, DM, DM, DM}; EpiPleFinal E{out, PP, rstd2, g_final, out, (float*)(ws + 251 * MiB), (unsigned*)(ws + 42 * MiB + 40960)};
        pg8::gemm_phase<EpiPleFinal, pg8::StaticOrder, false, true>((PG8_LAS unsigned char*)lds_raw, g, S, E, tid512);
        if (SPIN_PHASE >= 0 && blockIdx.x == 0) { __syncthreads(); STAMP(); const unsigned long long t0_ = __builtin_amdgcn_s_memrealtime(); while (__builtin_amdgcn_s_memrealtime() - t0_ < 8ull * ts_probe_) __builtin_amdgcn_s_sleep(4); }
    } else {
        {   PHASE_IDS
            __syncthreads();
            pg8::StaticOrder S; S.init(T_TOK, DM, (int)gridDim.x, (int)blockIdx.x);
            pg8::Gemm g{x2b, Wpg_t, T_TOK, DM, DM, DM, DM}; EpiPle2 E{out, PP, rstd2};
            pg8::gemm_phase<EpiPle2, pg8::StaticOrder, true, true>((PG8_LAS unsigned char*)lds_raw, g, S, E, tid512);
        }
        GRID_BAR();
        {   PHASE_IDS
            VB_LOOP(T_TOK / 4) rmsnorm_rows(vb, tid, out, g_final, (bf16_t*)nullptr, out, T_TOK);
        }
    }
}

extern "C" void kernel_launch(void* const* d_in, const int* in_sizes, int n_in, void* d_out, int out_size, void* d_ws, size_t ws_size, hipStream_t stream) {
    static int grid_blocks = 0;
    if (grid_blocks == 0) {
        int dev = 0, cus = 0, per_cu = 0;
        (void)hipGetDevice(&dev);
        (void)hipDeviceGetAttribute(&cus, hipDeviceAttributeMultiprocessorCount, dev);
        (void)hipFuncSetAttribute((const void*)mk_fwd, hipFuncAttributeMaxDynamicSharedMemorySize, LDS_BYTES);
        (void)hipOccupancyMaxActiveBlocksPerMultiprocessor(&per_cu, (const void*)mk_fwd, 512, LDS_BYTES);
        if (per_cu < 1) { fprintf(stderr, "kernel_launch: occupancy query returned %d\n", per_cu); per_cu = 1; }
        grid_blocks = cus * 1;
        fprintf(stderr, "kernel_launch: cus=%d per_cu=%d grid=%d ws=%zu\n", cus, per_cu, grid_blocks, ws_size);
    }
    (void)hipMemsetAsync((char*)d_ws + ((size_t)42 << 20), 0, 131072, stream);
    Args a{};
    for (int i = 0; i < 29; ++i) a.in[i] = (const float*)d_in[i];
    a.out = (float*)d_out; a.ws = (char*)d_ws; a.rep_mask = REP_MASK; a.pad = 0;
    void* args[] = {&a};
    hipError_t e = hipLaunchCooperativeKernel((const void*)mk_fwd, dim3(grid_blocks), dim3(512), args, LDS_BYTES, stream);
    if (e != hipSuccess) fprintf(stderr, "cooperative launch failed: %s (grid %d)\n", hipGetErrorString(e), grid_blocks);
    (void)in_sizes; (void)n_in; (void)out_size; (void)ws_size;
}
```

```cpp
#include <hip/hip_runtime.h>
#include <cstdint>
#include <cstdio>
#include <hip/hip_cooperative_groups.h>
namespace cg = cooperative_groups;

typedef unsigned short bf16_t;
typedef short bf16x8 __attribute__((ext_vector_type(8)));
typedef float f32x16 __attribute__((ext_vector_type(16)));

#define DI __device__ __forceinline__

constexpr int T_TOK = 16384, SEQ = 4096, DM = 1024, DIN = 5408, NIN = 5632;
#ifndef SPIN_PHASE
#define SPIN_PHASE (-1)
#endif
#define RG_BEGIN(id) unsigned long long rt0_##id = 0ull; if (SPIN_PHASE == (id) && blockIdx.x == 0) rt0_##id = __builtin_amdgcn_s_memrealtime();
#define RG_END(id) if (SPIN_PHASE == (id) && blockIdx.x == 0) pacc += __builtin_amdgcn_s_memrealtime() - rt0_##id;
constexpr int CNT_STRIDE = 64;
constexpr float QSCALE = 0.125f * 1.4426950408889634f;
constexpr int ZC_Q = 0, ZC_KC = 512, ZC_VC = 640, ZC_KS = 768, ZC_VS = 896, ZC_KW = 1024, ZC_VW = 1152, ZC_GATE = 1280,
              ZC_MQK = 1304, ZC_MV = 2328, ZC_MO = 2840, ZC_IF = 3352, ZC_GA = 3360, ZC_GB = 4384;

DI bf16_t f2bf(float f) { unsigned u = __float_as_uint(f); return (bf16_t)((u + 0x7fffu + ((u >> 16) & 1u)) >> 16); }
DI float bf2f(bf16_t h) { return __uint_as_float(((unsigned)h) << 16); }
DI float sigmoidf_(float x) { return 1.f / (1.f + __expf(-x)); }
DI int lane_id_opaque() { int z = 0; asm volatile("" : "+v"(z)); return __builtin_amdgcn_mbcnt_hi(-1, __builtin_amdgcn_mbcnt_lo(-1, z)); }
DI float lane_xor(float v, int o, int lane) { return __int_as_float(__builtin_amdgcn_ds_bpermute((lane ^ o) << 2, __float_as_int(v))); }
DI float lane_get(float v, int src) { return __int_as_float(__builtin_amdgcn_ds_bpermute(src << 2, __float_as_int(v))); }
DI float wave_sum(float v) {
    const int l = lane_id_opaque();
#pragma unroll
    for (int o = 1; o < 64; o <<= 1) v += lane_xor(v, o, l);
    return v;
}
DI float wave_max(float v) {
    const int l = lane_id_opaque();
#pragma unroll
    for (int o = 1; o < 64; o <<= 1) v = fmaxf(v, lane_xor(v, o, l));
    return v;
}

namespace pg8 {
#define PG8_LAS __attribute__((address_space(3)))
typedef unsigned short bf16_t;
typedef short bf16x8 __attribute__((ext_vector_type(8)));
typedef float f32x4 __attribute__((ext_vector_type(4)));
typedef unsigned u32x4 __attribute__((ext_vector_type(4)));
constexpr int BM = 256, BK = 64, HALF = 128, HTB = HALF * BK * 2  , STAGE_BYTES = 8 * HTB, NXCD = 8, WGM = 8;

__host__ __device__ __forceinline__ int lds_byte(int r, int c) { const int st = (r >> 4) * 2 + (c >> 5), rr = r & 15, cc = c & 31, ob = rr * 64 + cc * 2; return st * 1024 + (ob ^ (((ob >> 9) & 1) << 5)); }
__host__ __device__ __forceinline__ void stage_rc(int b, int& R, int& C) { const int st = b / 1024, sb = b % 1024, swz = sb ^ (((sb >> 9) & 1) << 5); R = (st >> 1) * 16 + swz / 64; C = (st & 1) * 32 + (swz % 64) / 2; }
__host__ __device__ __forceinline__ int perm32(int rho) { const int n = rho >> 4, i = rho & 15; return 8 * (i >> 2) + 4 * n + (i & 3); }

struct Unit { int pm, pn, aux; };
struct Gemm { const bf16_t* A; const bf16_t* Bt; int M, N, K, lda, ldb; const int* amap; int avalid; };

struct StaticOrder {
    int nM, nN, nwg, G, c;
    __host__ __device__ __forceinline__ void init(int M, int N, int G_, int c_) { nM = M / BM; nN = N / BM; nwg = nM * nN; G = G_; c = c_; }
    __host__ __device__ __forceinline__ bool next(int i, Unit& u) const {
        const long L = (long)i * G + c; if (L >= nwg) return false;
        int wgid = (int)L; { const int q = nwg / NXCD, r = nwg % NXCD, xcd = wgid % NXCD, off = wgid / NXCD; wgid = (xcd < r ? xcd * (q + 1) : r * (q + 1) + (xcd - r) * q) + off; }
        const int nig = WGM * nN, gid = wgid / nig, fm = gid * WGM, gsz = (nM - fm) < WGM ? (nM - fm) : WGM;
        u.pm = fm + ((wgid % nig) % gsz); u.pn = (wgid % nig) / gsz; u.aux = 0; return true;
    }
    __device__ __forceinline__ void a_ready(const Unit&) const {}
    __device__ __forceinline__ void done(const Unit&) const {}
};

__device__ __forceinline__ unsigned cvt_pk_bf16(float lo, float hi) { unsigned r; asm volatile("v_cvt_pk_bf16_f32 %0, %1, %2" : "=v"(r) : "v"(lo), "v"(hi)); return r; }
typedef float f32x2 __attribute__((ext_vector_type(2)));
__device__ __forceinline__ f32x2 gelu_pk(f32x2 v) {
    const f32x2 av = __builtin_elementwise_abs(v), d = av * 0.2316418882f + 1.0f;
    f32x2 t; t.x = __builtin_amdgcn_rcpf(d.x); t.y = __builtin_amdgcn_rcpf(d.y);
    f32x2 q = t * 0.5307027145f + (-0.7265760135f); q = q * t + 0.7107068705f; q = q * t + (-0.142248368f); q = q * t + 0.127414796f; q = q * t;
    const f32x2 s = (v * v) * (-0.72134752044f);
    f32x2 e; e.x = __builtin_amdgcn_exp2f(s.x); e.y = __builtin_amdgcn_exp2f(s.y);
    const f32x2 m = v * (q * e), r = v - m;
    f32x2 o; o.x = v.x < 0.f ? m.x : r.x; o.y = v.y < 0.f ? m.y : r.y; return o;
}

template <int ACT  > struct EpiBf16 {
    static constexpr bool PERM = true, AFTER_DRAIN = false; static constexpr int MIDK = 0; static_assert(ACT == 0 || ACT == 1, "EpiBf16: ACT is 0 (none) or 1 (gelu_pk)");
    bf16_t* O; int ldc; const float* bias; int split_cols; size_t split_stride; float scale0;
    __device__ __forceinline__ void operator()(const f32x4 (&acc)[2][2][4][2], const Unit& u, int wr, int wc, int fr, int fq) const {
        const int row0 = u.pm * BM + wr * 64 + fr; int colt = u.pn * BM; bf16_t* base = O;
        float sc = 1.f; if (split_cols) { const int t = colt / split_cols; base += (size_t)t * split_stride; colt -= t * split_cols; if (t == 0) sc = scale0; }
        const int col0 = colt + wc * 32 + 8 * fq, bcol0 = u.pn * BM + wc * 32 + 8 * fq;
        f32x4 bv[2][2];
#pragma unroll
        for (int bj = 0; bj < 2; ++bj)
#pragma unroll
            for (int n = 0; n < 2; ++n) bv[bj][n] = bias ? *(const f32x4*)(bias + bcol0 + bj * HALF + 4 * n) : (f32x4){0.f, 0.f, 0.f, 0.f};
#pragma unroll
        for (int ai = 0; ai < 2; ++ai)
#pragma unroll
            for (int m = 0; m < 4; ++m) { bf16_t* rowp = base + (size_t)(row0 + ai * HALF + m * 16) * ldc + col0;
#pragma unroll
                for (int bj = 0; bj < 2; ++bj) { f32x4 v0 = acc[ai][bj][m][0] + bv[bj][0], v1 = acc[ai][bj][m][1] + bv[bj][1];
                    if (ACT == 1) { f32x2 a = gelu_pk((f32x2){v0[0], v0[1]}), b = gelu_pk((f32x2){v0[2], v0[3]}), c = gelu_pk((f32x2){v1[0], v1[1]}), d = gelu_pk((f32x2){v1[2], v1[3]});
                        v0 = (f32x4){a.x, a.y, b.x, b.y}; v1 = (f32x4){c.x, c.y, d.x, d.y}; }
                    v0 = v0 * sc; v1 = v1 * sc; u32x4 w; w.x = cvt_pk_bf16(v0[0], v0[1]); w.y = cvt_pk_bf16(v0[2], v0[3]); w.z = cvt_pk_bf16(v1[0], v1[1]); w.w = cvt_pk_bf16(v1[2], v1[3]);
                    *(u32x4*)(rowp + bj * HALF) = w; } }
    }
};

template <class Epi, class Sched, bool ALIGN_EPI = false, bool SP2 = false, bool GATHER = false>
__device__ __forceinline__ void gemm_phase(PG8_LAS unsigned char* lds, const Gemm g, const Sched& S, const Epi& E, const int tid) {
    const int wid = __builtin_amdgcn_readfirstlane(tid >> 6), lane = tid & 63, wr = wid >> 2, wc = wid & 3, fr = lane & 15, fq = lane >> 4;
    const int K = g.K, nt = K / BK;
    unsigned voffA[2], voffB[2], voffA1[2];
#pragma unroll
    for (int i = 0; i < 2; ++i) { int R, C; stage_rc(tid * 16 + i * 8192, R, C); const int Rb = Epi::PERM ? ((R & ~31) + perm32(R & 31)) : R;
        voffA[i] = (unsigned)(R * g.lda + C) * 2u; voffB[i] = (unsigned)(Rb * g.ldb + C) * 2u; voffA1[i] = voffA[i];
        if constexpr (GATHER) { const int t0_ = R < g.avalid ? g.amap[R] : 0, t1_ = R + HALF < g.avalid ? g.amap[R + HALF] : 0; voffA[i] = (unsigned)(t0_ * g.lda + C) * 2u; voffA1[i] = (unsigned)(t1_ * g.lda + C) * 2u; } }
    const size_t kstep = (size_t)(BK * 2);
    const size_t hstepA = (size_t)HALF * g.lda * 2, hstepB = (size_t)HALF * g.ldb * 2;
    const size_t tstepA = GATHER ? 0 : 2 * hstepA, tstepB = 2 * hstepB, hsA = GATHER ? 0 : hstepA;
    const unsigned ldsw = (unsigned)wid * 1024u;
    const int aoff = lds_byte(wr * 64 + fr, fq * 8), boff = lds_byte(wc * 32 + fr, fq * 8);
#define PG8_SA(b, h) (((b) * 2 + (h)) * HTB)
#define PG8_SB(b, h) ((4 + (b) * 2 + (h)) * HTB)
#define PG8_STAGE(bufoff, gbase, voff) do { _Pragma("unroll") for (int _i = 0; _i < 2; ++_i) \
        __builtin_amdgcn_global_load_lds((const unsigned*)((const char*)(gbase) + (voff)[_i]), (PG8_LAS unsigned*)(lds + (bufoff) + ldsw + _i * 8192), 16, 0, 0); } while (0)
#define PG8_LDA(dst, b, h) do { _Pragma("unroll") for (int m = 0; m < 4; ++m) _Pragma("unroll") for (int k = 0; k < 2; ++k) dst[m][k] = *(const PG8_LAS bf16x8*)(lds + PG8_SA(b, h) + aoff + m * 2048 + k * 1024); } while (0)
#define PG8_LDB(dst, b, h) do { _Pragma("unroll") for (int n = 0; n < 2; ++n) _Pragma("unroll") for (int k = 0; k < 2; ++k) dst[n][k] = *(const PG8_LAS bf16x8*)(lds + PG8_SB(b, h) + boff + n * 2048 + k * 1024); } while (0)
#define PG8_MMA(ai, bj, At, Bt) do { __builtin_amdgcn_s_setprio(1); _Pragma("unroll") for (int m = 0; m < 4; ++m) _Pragma("unroll") for (int n = 0; n < 2; ++n) _Pragma("unroll") for (int k = 0; k < 2; ++k) \
        acc[ai][bj][m][n] = __builtin_amdgcn_mfma_f32_16x16x32_bf16(Bt[n][k], At[m][k], acc[ai][bj][m][n], 0, 0, 0); __builtin_amdgcn_s_setprio(0); } while (0)
#define PG8_WAIT_V(n) asm volatile("s_waitcnt vmcnt(" #n ")" ::: "memory")
#define PG8_WAIT_L(n) asm volatile("s_waitcnt lgkmcnt(" #n ")" ::: "memory")
#define PG8_BAR __builtin_amdgcn_s_barrier()
#define PG8_SCHED __builtin_amdgcn_sched_barrier(0)
    Unit cur, nxt; int ui = 0;
    if (!S.next(0, cur)) return;
    f32x4 acc[2][2][4][2];
#pragma unroll
    for (int a = 0; a < 2; ++a)
#pragma unroll
        for (int b = 0; b < 2; ++b)
#pragma unroll
            for (int m = 0; m < 4; ++m)
#pragma unroll
                for (int n = 0; n < 2; ++n) acc[a][b][m][n] = (f32x4){0.f, 0.f, 0.f, 0.f};
    bf16x8 At[4][2], B0[2][2], B1[2][2];
    const char* cA = (const char*)g.A + (size_t)cur.pm * tstepA; const char* cB = (const char*)g.Bt + (size_t)cur.pn * tstepB;
    S.a_ready(cur);
    if constexpr (SP2) {
        PG8_STAGE(PG8_SB(0, 0), cB, voffB); PG8_STAGE(PG8_SB(0, 1), cB + hstepB, voffB); PG8_STAGE(PG8_SA(0, 0), cA, voffA); PG8_STAGE(PG8_SA(0, 1), cA + hsA, voffA1);
        if (wr == 1) PG8_BAR;
        PG8_WAIT_V(2); PG8_BAR;
        PG8_STAGE(PG8_SB(1, 0), cB + kstep, voffB); PG8_STAGE(PG8_SA(1, 0), cA + kstep, voffA); PG8_STAGE(PG8_SB(1, 1), cB + hstepB + kstep, voffB);
        PG8_WAIT_V(6); PG8_BAR;
    } else {
        PG8_STAGE(PG8_SB(0, 0), cB, voffB); PG8_STAGE(PG8_SA(0, 0), cA, voffA); PG8_STAGE(PG8_SB(0, 1), cB + hstepB, voffB); PG8_STAGE(PG8_SA(0, 1), cA + hsA, voffA1);
        if (wr == 1) PG8_BAR;
        PG8_WAIT_V(4); PG8_BAR;
        PG8_STAGE(PG8_SB(1, 0), cB + kstep, voffB); PG8_STAGE(PG8_SA(1, 0), cA + kstep, voffA); PG8_STAGE(PG8_SB(1, 1), cB + hstepB + kstep, voffB);
        PG8_WAIT_V(6); PG8_BAR;
    }
    for (;;) {
        const bool has_next = S.next(ui + 1, nxt);
        const char* nA = has_next ? (const char*)g.A + (size_t)nxt.pm * tstepA : cA; const char* nB = has_next ? (const char*)g.Bt + (size_t)nxt.pn * tstepB : cB;
        for (int t = 0; t < nt; t += 2) {
            const bool last = (t == nt - 2);
            const char* a1 = cA + (size_t)(t + 1) * kstep;
            const char* a2 = last ? nA : cA + (size_t)(t + 2) * kstep; const char* b2 = last ? nB : cB + (size_t)(t + 2) * kstep;
            const char* a3 = a2 + kstep; const char* b3 = b2 + kstep;
            if (last && has_next) S.a_ready(nxt);
            if constexpr (SP2) {
            PG8_LDB(B0, 0, 0); PG8_LDB(B1, 0, 1); PG8_SCHED; PG8_LDA(At, 0, 0); PG8_STAGE(PG8_SA(1, 1), a1 + hsA, voffA1);
            PG8_WAIT_V(8); PG8_WAIT_L(0); PG8_BAR; PG8_MMA(0, 0, At, B0); PG8_MMA(0, 1, At, B1); PG8_BAR; PG8_SCHED;
            PG8_LDA(At, 0, 1); PG8_STAGE(PG8_SB(0, 0), b2, voffB); PG8_STAGE(PG8_SB(0, 1), b2 + hstepB, voffB); PG8_STAGE(PG8_SA(0, 0), a2, voffA);
            PG8_WAIT_V(8); PG8_WAIT_L(0); PG8_BAR; PG8_MMA(1, 0, At, B0); PG8_MMA(1, 1, At, B1); PG8_BAR; PG8_SCHED;
            PG8_LDB(B0, 1, 0); PG8_LDB(B1, 1, 1); PG8_SCHED; PG8_LDA(At, 1, 0); PG8_STAGE(PG8_SA(0, 1), a2 + hsA, voffA1);
            PG8_WAIT_V(8); PG8_WAIT_L(0); PG8_BAR; PG8_MMA(0, 0, At, B0); PG8_MMA(0, 1, At, B1); PG8_BAR; PG8_SCHED;
            PG8_LDA(At, 1, 1); PG8_STAGE(PG8_SB(1, 0), b3, voffB); PG8_STAGE(PG8_SB(1, 1), b3 + hstepB, voffB); PG8_STAGE(PG8_SA(1, 0), a3, voffA);
            PG8_WAIT_V(8); PG8_WAIT_L(0); PG8_BAR; PG8_MMA(1, 0, At, B0); PG8_MMA(1, 1, At, B1); PG8_BAR; PG8_SCHED;
            if constexpr (Epi::MIDK > 0) { if (t + 2 == Epi::MIDK / BK) { const int l3_ = lane_id_opaque(); E.mid(acc, cur, wr, wc, l3_ & 15, l3_ >> 4); } }
            } else {
            PG8_LDB(B0, 0, 0); PG8_SCHED; PG8_LDA(At, 0, 0); PG8_STAGE(PG8_SA(1, 1), a1 + hsA, voffA1);
            PG8_WAIT_L(8); PG8_BAR; PG8_WAIT_L(0); PG8_MMA(0, 0, At, B0); PG8_BAR; PG8_SCHED;
            PG8_LDB(B1, 0, 1); PG8_STAGE(PG8_SB(0, 0), b2, voffB);
            PG8_BAR; PG8_WAIT_L(0); PG8_MMA(0, 1, At, B1); PG8_BAR;
            PG8_LDA(At, 0, 1); PG8_STAGE(PG8_SA(0, 0), a2, voffA);
            PG8_BAR; PG8_WAIT_L(0); PG8_MMA(1, 0, At, B0); PG8_BAR; PG8_SCHED;
            PG8_STAGE(PG8_SB(0, 1), b2 + hstepB, voffB);
            PG8_WAIT_V(6); PG8_BAR; PG8_MMA(1, 1, At, B1); PG8_BAR;
            PG8_LDB(B0, 1, 0); PG8_SCHED; PG8_LDA(At, 1, 0); PG8_STAGE(PG8_SA(0, 1), a2 + hsA, voffA1);
            PG8_WAIT_L(8); PG8_BAR; PG8_WAIT_L(0); PG8_MMA(0, 0, At, B0); PG8_BAR; PG8_SCHED;
            PG8_LDB(B1, 1, 1); PG8_STAGE(PG8_SB(1, 0), b3, voffB);
            PG8_BAR; PG8_WAIT_L(0); PG8_MMA(0, 1, At, B1); PG8_BAR;
            PG8_LDA(At, 1, 1); PG8_STAGE(PG8_SA(1, 0), a3, voffA);
            PG8_BAR; PG8_WAIT_L(0); PG8_MMA(1, 0, At, B0); PG8_BAR; PG8_SCHED;
            PG8_STAGE(PG8_SB(1, 1), b3 + hstepB, voffB);
            PG8_WAIT_V(6); PG8_BAR; PG8_MMA(1, 1, At, B1); PG8_BAR;
            }
        }
        if constexpr (ALIGN_EPI) { if (wr == 0) PG8_BAR; }
        if constexpr (!Epi::AFTER_DRAIN) { const int l2_ = lane_id_opaque(); E(acc, cur, wr, wc, l2_ & 15, l2_ >> 4); S.done(cur); }
        if (!has_next) break;
#pragma unroll
        for (int a = 0; a < 2; ++a)
#pragma unroll
            for (int b = 0; b < 2; ++b)
#pragma unroll
                for (int m = 0; m < 4; ++m)
#pragma unroll
                    for (int n = 0; n < 2; ++n) acc[a][b][m][n] = (f32x4){0.f, 0.f, 0.f, 0.f};
        cur = nxt; cA = nA; cB = nB; ++ui;
        if constexpr (ALIGN_EPI) { if (wr == 1) PG8_BAR; }
    }
    PG8_WAIT_V(0);
    if constexpr (!ALIGN_EPI) { if (wr == 0) PG8_BAR; }
    PG8_BAR;
    if constexpr (Epi::AFTER_DRAIN) { E.fused(acc, cur, wr, wc, fr, fq, lds, wid, lane); S.done(cur); }
#undef PG8_SA
#undef PG8_SB
#undef PG8_STAGE
#undef PG8_LDA
#undef PG8_LDB
#undef PG8_MMA
#undef PG8_WAIT_V
#undef PG8_WAIT_L
#undef PG8_BAR
#undef PG8_SCHED
}
}


#define LAS __attribute__((address_space(3)))
DI unsigned pk2(float lo, float hi) { return (unsigned)f2bf(lo) | ((unsigned)f2bf(hi) << 16); }
template <class Map>
DI void prep_wt_item(const float* __restrict__ W, int ldw, int K, bf16_t* __restrict__ WT, const float* __restrict__ gain, Map map, float* scr, int item, int nblk, int lane) {
    const int kb = item / nblk, nb = item % nblk, k0 = 64 * kb, n0 = 32 * nb;
    const int srcn = map(n0 + (lane & 31));
    float tv[32];
#pragma unroll
    for (int i = 0; i < 32; ++i) { const int kk = 2 * i + (lane >> 5); tv[i] = srcn >= 0 ? W[(size_t)(k0 + kk) * ldw + srcn] : 0.f; }
#pragma unroll
    for (int i = 0; i < 32; ++i) { const int kk = 2 * i + (lane >> 5); scr[kk * 33 + (lane & 31)] = gain ? tv[i] * gain[k0 + kk] : tv[i]; }
    __builtin_amdgcn_s_waitcnt(0xC07F); asm volatile("" ::: "memory");
    const int c = lane & 7;
#pragma unroll
    for (int j = 0; j < 4; ++j) { const int n = (lane >> 3) + 8 * j; const float* s = scr + (8 * c) * 33 + n;
        uint4 o; o.x = pk2(s[0 * 33], s[1 * 33]); o.y = pk2(s[2 * 33], s[3 * 33]); o.z = pk2(s[4 * 33], s[5 * 33]); o.w = pk2(s[6 * 33], s[7 * 33]);
        *(uint4*)(WT + (size_t)(n0 + n) * K + k0 + 8 * c) = o; }
    __builtin_amdgcn_s_waitcnt(0xC07F); asm volatile("" ::: "memory");
}
template <class Map>
DI void prep_wt_item2(const float* __restrict__ Wa, const float* __restrict__ Wb, int ldw, int K, bf16_t* __restrict__ WTa, bf16_t* __restrict__ WTb, const float* __restrict__ gain, Map map, float* scr, int itemA, int itemB, int nblk, int lane) {
    const int ka = 64 * (itemA / nblk), na = 32 * (itemA % nblk), kb = 64 * (itemB / nblk), nb = 32 * (itemB % nblk);
    const int sa = map(na + (lane & 31)), sb = map(nb + (lane & 31));
    float ta[32], tb[32];
#pragma unroll
    for (int i = 0; i < 32; ++i) { const int kk = 2 * i + (lane >> 5); ta[i] = sa >= 0 ? Wa[(size_t)(ka + kk) * ldw + sa] : 0.f; }
#pragma unroll
    for (int i = 0; i < 32; ++i) { const int kk = 2 * i + (lane >> 5); tb[i] = sb >= 0 ? Wb[(size_t)(kb + kk) * ldw + sb] : 0.f; }
#pragma unroll
    for (int i = 0; i < 32; ++i) { const int kk = 2 * i + (lane >> 5); scr[kk * 33 + (lane & 31)] = gain ? ta[i] * gain[ka + kk] : ta[i]; }
#pragma unroll
    for (int i = 0; i < 32; ++i) { const int kk = 2 * i + (lane >> 5); scr[2112 + kk * 33 + (lane & 31)] = gain ? tb[i] * gain[kb + kk] : tb[i]; }
    __builtin_amdgcn_s_waitcnt(0xC07F); asm volatile("" ::: "memory");
    const int c = lane & 7;
#pragma unroll
    for (int j = 0; j < 4; ++j) { const int n = (lane >> 3) + 8 * j; const float* s = scr + (8 * c) * 33 + n;
        uint4 o; o.x = pk2(s[0 * 33], s[1 * 33]); o.y = pk2(s[2 * 33], s[3 * 33]); o.z = pk2(s[4 * 33], s[5 * 33]); o.w = pk2(s[6 * 33], s[7 * 33]);
        *(uint4*)(WTa + (size_t)(na + n) * K + ka + 8 * c) = o;
        const float* s2 = s + 2112;
        uint4 o2; o2.x = pk2(s2[0 * 33], s2[1 * 33]); o2.y = pk2(s2[2 * 33], s2[3 * 33]); o2.z = pk2(s2[4 * 33], s2[5 * 33]); o2.w = pk2(s2[6 * 33], s2[7 * 33]);
        *(uint4*)(WTb + (size_t)(nb + n) * K + kb + 8 * c) = o2; }
    __builtin_amdgcn_s_waitcnt(0xC07F); asm volatile("" ::: "memory");
}
struct MapIn {
    DI int operator()(int n) const {
        if (n < 1280) return n;
        if (n < 1536) { const int i = n - 1280; return i < 24 ? ZC_GATE + i : (i < 32 ? ZC_IF + (i - 24) : -1); }
        if (n < 2560) return ZC_MQK + (n - 1536);
        if (n < 3072) return ZC_MV + (n - 2560);
        if (n < 3584) return ZC_MO + (n - 3072);
        return ZC_GA + (n - 3584);
    }
};
DI void prep_x_row(const float* __restrict__ x, bf16_t* __restrict__ xb, float* __restrict__ rstd, int row, int lane) {
    const float4* xr = (const float4*)(x + (size_t)row * DM);
    float4 v[4]; float s = 0.f;
#pragma unroll
    for (int j = 0; j < 4; ++j) { v[j] = xr[lane + 64 * j]; s += v[j].x * v[j].x + v[j].y * v[j].y + v[j].z * v[j].z + v[j].w * v[j].w; }
    s = wave_sum(s);
    if (lane == 0) rstd[row] = rsqrtf(s * (1.f / DM) + 1e-6f);
#pragma unroll
    for (int j = 0; j < 4; ++j) { uint2 o; o.x = pk2(v[j].x, v[j].y); o.y = pk2(v[j].z, v[j].w); ((uint2*)(xb + (size_t)row * DM))[lane + 64 * j] = o; }
}

struct EpiInProj {
    static constexpr bool PERM = true, AFTER_DRAIN = false; static constexpr int MIDK = 0;
    const float* rstd; const float* cosT; const float* sinT; const float* b_if;
    bf16_t* Qb; bf16_t* KVb; float* gates; float* ifp; bf16_t* MQK; bf16_t* MV; bf16_t* MO; bf16_t* MG; bf16_t* VT;
    DI void operator()(const pg8::f32x4 (&acc)[2][2][4][2], const pg8::Unit& u, int wr, int wc, int fr, int fq) const {
        const int pn = u.pn;
        asm volatile("" : "+v"(fr), "+v"(fq));
#pragma unroll
        for (int ai = 0; ai < 2; ++ai)
#pragma unroll
            for (int m = 0; m < 4; ++m) {
                const int row = u.pm * 256 + ai * 128 + wr * 64 + m * 16 + fr;
                const float rs = rstd[row];
#pragma unroll
                for (int bj = 0; bj < 2; ++bj) {
                    float v[8];
#pragma unroll
                    for (int i = 0; i < 4; ++i) { v[i] = acc[ai][bj][m][0][i] * rs; v[4 + i] = acc[ai][bj][m][1][i] * rs; }
                    const int c0 = bj * 128 + wc * 32 + 8 * fq;
                    if (pn <= 4) {
                        const bool is_k = (pn < 2) || (bj == 0);
                        if (is_k && (wc & 1) == 0) {
                            const float4 c_lo = *(const float4*)(cosT + (size_t)row * 8), c_hi = *(const float4*)(cosT + (size_t)row * 8 + 4);
                            const float4 s_lo = *(const float4*)(sinT + (size_t)row * 8), s_hi = *(const float4*)(sinT + (size_t)row * 8 + 4);
                            const float cs[8] = {c_lo.x, c_lo.y, c_lo.z, c_lo.w, c_hi.x, c_hi.y, c_hi.z, c_hi.w};
                            const float sn[8] = {s_lo.x, s_lo.y, s_lo.z, s_lo.w, s_hi.x, s_hi.y, s_hi.z, s_hi.w};
                            const int l_ = lane_id_opaque();
#pragma unroll
                            for (int i = 0; i < 8; ++i) {
                                const float other = lane_xor(v[i], 16, l_);
                                if (fq == 0) v[i] = v[i] * cs[i] - other * sn[i];
                                else if (fq == 1) v[i] = v[i] * cs[i] + other * sn[i];
                            }
                        }
                        const float sc = pn < 2 ? QSCALE : 1.f;
                        pg8::u32x4 w; w.x = pg8::cvt_pk_bf16(v[0] * sc, v[1] * sc); w.y = pg8::cvt_pk_bf16(v[2] * sc, v[3] * sc); w.z = pg8::cvt_pk_bf16(v[4] * sc, v[5] * sc); w.w = pg8::cvt_pk_bf16(v[6] * sc, v[7] * sc);
                        if (pn < 2) *(pg8::u32x4*)(Qb + (size_t)row * 512 + pn * 256 + c0) = w;
                        else if (pn == 2) *(pg8::u32x4*)(KVb + (size_t)row * 512 + c0) = w;
                        else if (bj == 0) *(pg8::u32x4*)(KVb + (size_t)row * 512 + (pn - 2) * 128 + 128 + wc * 32 + 8 * fq) = w;
                        else {
                            const int cv = wc * 32 + 8 * fq, gg = cv >> 6, d0 = cv & 63, bb = row >> 12, tt = row & 4095;
                            bf16_t* vt = VT + ((size_t)((pn - 3) * 8 + bb * 2 + gg) * 64 + (tt >> 6)) * 4096 + (size_t)d0 * 64 + (tt & 63);
                            vt[0] = (bf16_t)(w.x & 0xffffu); vt[64] = (bf16_t)(w.x >> 16); vt[128] = (bf16_t)(w.y & 0xffffu); vt[192] = (bf16_t)(w.y >> 16);
                            vt[256] = (bf16_t)(w.z & 0xffffu); vt[320] = (bf16_t)(w.z >> 16); vt[384] = (bf16_t)(w.w & 0xffffu); vt[448] = (bf16_t)(w.w >> 16);
                        }
                    } else if (pn == 5) {
                        if (bj == 0 && wc == 0) {
#pragma unroll
                            for (int i = 0; i < 8; ++i) { const int c = 8 * fq + i;
                                if (c < 24) gates[(size_t)row * 24 + c] = sigmoidf_(v[i]);
                                else if (c < 32) ifp[(size_t)row * 8 + (c - 24)] = v[i] + b_if[c - 24]; }
                        }
                    } else {
                        if (pn >= 14) {
#pragma unroll
                            for (int i = 0; i < 8; ++i) v[i] = sigmoidf_(v[i]);
                        }
                        pg8::u32x4 w; w.x = pg8::cvt_pk_bf16(v[0], v[1]); w.y = pg8::cvt_pk_bf16(v[2], v[3]); w.z = pg8::cvt_pk_bf16(v[4], v[5]); w.w = pg8::cvt_pk_bf16(v[6], v[7]);
                        bf16_t* dst;
                        if (pn < 10) dst = MQK + (size_t)row * 1024 + (pn - 6) * 256 + c0;
                        else if (pn < 12) dst = MV + (size_t)row * 512 + (pn - 10) * 256 + c0;
                        else if (pn < 14) dst = MO + (size_t)row * 512 + (pn - 12) * 256 + c0;
                        else dst = MG + (size_t)row * 2048 + (pn - 14) * 256 + c0;
                        *(pg8::u32x4*)dst = w;
                    }
                }
            }
    }
};


DI pg8::u32x4 pack8(const float (&v)[8]) { pg8::u32x4 w; w.x = pg8::cvt_pk_bf16(v[0], v[1]); w.y = pg8::cvt_pk_bf16(v[2], v[3]); w.z = pg8::cvt_pk_bf16(v[4], v[5]); w.w = pg8::cvt_pk_bf16(v[6], v[7]); return w; }
DI void unpack8(const pg8::u32x4 w, float (&v)[8]) {
    v[0] = __uint_as_float(w.x << 16); v[1] = __uint_as_float(w.x & 0xffff0000u); v[2] = __uint_as_float(w.y << 16); v[3] = __uint_as_float(w.y & 0xffff0000u);
    v[4] = __uint_as_float(w.z << 16); v[5] = __uint_as_float(w.z & 0xffff0000u); v[6] = __uint_as_float(w.w << 16); v[7] = __uint_as_float(w.w & 0xffff0000u);
}
#define EPI_ROWS_BEGIN asm volatile("" : "+v"(fr), "+v"(fq)); _Pragma("unroll") for (int ai = 0; ai < 2; ++ai) _Pragma("unroll") for (int m = 0; m < 4; ++m) { const int row = u.pm * 256 + ai * 128 + wr * 64 + m * 16 + fr; _Pragma("unroll") for (int bj = 0; bj < 2; ++bj) { \
    float v[8]; _Pragma("unroll") for (int i = 0; i < 4; ++i) { v[i] = acc[ai][bj][m][0][i]; v[4 + i] = acc[ai][bj][m][1][i]; } const int c0 = bj * 128 + wc * 32 + 8 * fq; (void)c0; (void)row;
#define EPI_ROWS_END } asm volatile("" ::: "memory"); }
template <int MODE> struct EpiMerge {
    static constexpr bool PERM = true, AFTER_DRAIN = false; static constexpr int MIDK = 0;
    const bf16_t* MG; float* tmp; bf16_t* mixed;
    DI void operator()(const pg8::f32x4 (&acc)[2][2][4][2], const pg8::Unit& u, int wr, int wc, int fr, int fq) const {
        EPI_ROWS_BEGIN
            const int col = u.pn * 256 + c0; float gt[8];
            unpack8(*(const pg8::u32x4*)(MG + (size_t)row * 2048 + MODE * 1024 + col), gt);
            float* tp = tmp + (size_t)row * DM + col;
            if (MODE == 0) {
                *(float4*)tp = make_float4(gt[0] * v[0], gt[1] * v[1], gt[2] * v[2], gt[3] * v[3]); *(float4*)(tp + 4) = make_float4(gt[4] * v[4], gt[5] * v[5], gt[6] * v[6], gt[7] * v[7]);
            } else {
                const float4 t0 = *(const float4*)tp, t1 = *(const float4*)(tp + 4);
                float o[8] = {t0.x + gt[0] * v[0], t0.y + gt[1] * v[1], t0.z + gt[2] * v[2], t0.w + gt[3] * v[3], t1.x + gt[4] * v[4], t1.y + gt[5] * v[5], t1.z + gt[6] * v[6], t1.w + gt[7] * v[7]};
                *(pg8::u32x4*)(mixed + (size_t)row * DM + col) = pack8(o);
            }
        EPI_ROWS_END
    }
};
struct EpiMerge2 {
    static constexpr bool PERM = true, AFTER_DRAIN = false; static constexpr int MIDK = 512;
    const bf16_t* MG; bf16_t* mixed;
    DI void mid(pg8::f32x4 (&acc)[2][2][4][2], const pg8::Unit& u, int wr, int wc, int fr, int fq) const {
#pragma unroll
        for (int ai = 0; ai < 2; ++ai)
#pragma unroll
            for (int m = 0; m < 4; ++m) { const int row = u.pm * 256 + ai * 128 + wr * 64 + m * 16 + fr;
#pragma unroll
                for (int bj = 0; bj < 2; ++bj) {
                    const int col = u.pn * 256 + bj * 128 + wc * 32 + 8 * fq; float ga[8], gb[8];
                    unpack8(*(const pg8::u32x4*)(MG + (size_t)row * 2048 + col), ga); unpack8(*(const pg8::u32x4*)(MG + (size_t)row * 2048 + 1024 + col), gb);
#pragma unroll
                    for (int i = 0; i < 4; ++i) { acc[ai][bj][m][0][i] *= ga[i] * __builtin_amdgcn_rcpf(gb[i]); acc[ai][bj][m][1][i] *= ga[4 + i] * __builtin_amdgcn_rcpf(gb[4 + i]); }
                }
                asm volatile("" ::: "memory"); }
    }
    DI void operator()(const pg8::f32x4 (&acc)[2][2][4][2], const pg8::Unit& u, int wr, int wc, int fr, int fq) const {
        EPI_ROWS_BEGIN
            const int col = u.pn * 256 + c0; float gb[8];
            unpack8(*(const pg8::u32x4*)(MG + (size_t)row * 2048 + 1024 + col), gb);
            float o[8] = {gb[0] * v[0], gb[1] * v[1], gb[2] * v[2], gb[3] * v[3], gb[4] * v[4], gb[5] * v[5], gb[6] * v[6], gb[7] * v[7]};
            *(pg8::u32x4*)(mixed + (size_t)row * DM + col) = pack8(o);
        EPI_ROWS_END
    }
};
struct EpiX1 {
    static constexpr bool PERM = true, AFTER_DRAIN = false; static constexpr int MIDK = 0;
    const float* base; float* out; bf16_t* outb;
    DI void operator()(const pg8::f32x4 (&acc)[2][2][4][2], const pg8::Unit& u, int wr, int wc, int fr, int fq) const {
        EPI_ROWS_BEGIN
            const size_t o = (size_t)row * DM + u.pn * 256 + c0;
            const float4 b0 = *(const float4*)(base + o), b1 = *(const float4*)(base + o + 4);
            const float r[8] = {b0.x + v[0], b0.y + v[1], b0.z + v[2], b0.w + v[3], b1.x + v[4], b1.y + v[5], b1.z + v[6], b1.w + v[7]};
            *(float4*)(out + o) = make_float4(r[0], r[1], r[2], r[3]); *(float4*)(out + o + 4) = make_float4(r[4], r[5], r[6], r[7]);
            *(pg8::u32x4*)(outb + o) = pack8(r);
        EPI_ROWS_END
    }
};
struct EpiStoreBf {
    static constexpr bool PERM = true, AFTER_DRAIN = false; static constexpr int MIDK = 0;
    bf16_t* O; int ld; int pnmask;
    DI void operator()(const pg8::f32x4 (&acc)[2][2][4][2], const pg8::Unit& u, int wr, int wc, int fr, int fq) const {
        EPI_ROWS_BEGIN
            *(pg8::u32x4*)(O + (size_t)row * ld + (u.pn & pnmask) * 256 + c0) = pack8(v);
        EPI_ROWS_END
    }
};
struct EpiSwiglu {
    static constexpr bool PERM = true, AFTER_DRAIN = false; static constexpr int MIDK = 0;
    bf16_t* act; const int* amap; int avalid; const float* rstd1;
    DI void operator()(const pg8::f32x4 (&acc)[2][2][4][2], const pg8::Unit& u, int wr, int wc, int fr, int fq) const {
        asm volatile("" : "+v"(fr), "+v"(fq));
#pragma unroll
        for (int ai = 0; ai < 2; ++ai)
#pragma unroll
            for (int m = 0; m < 4; ++m) {
                const int rl = ai * 128 + wr * 64 + m * 16 + fr, row = u.pm * 256 + rl; float o[8];
                const float rs = rl < avalid ? rstd1[amap[rl]] : 0.f;
#pragma unroll
                for (int i = 0; i < 4; ++i) { const float g0 = rs * acc[ai][0][m][0][i], g1 = rs * acc[ai][0][m][1][i]; o[i] = g0 * sigmoidf_(g0) * (rs * acc[ai][1][m][0][i]); o[4 + i] = g1 * sigmoidf_(g1) * (rs * acc[ai][1][m][1][i]); }
                *(pg8::u32x4*)(act + (size_t)row * 256 + (u.pn & 1) * 128 + wc * 32 + 8 * fq) = pack8(o);
            }
    }
};
struct EpiPle2 {
    static constexpr bool PERM = true, AFTER_DRAIN = false; static constexpr int MIDK = 0;
    float* x; const bf16_t* PP; const float* rstd;
    DI void operator()(const pg8::f32x4 (&acc)[2][2][4][2], const pg8::Unit& u, int wr, int wc, int fr, int fq) const {
        EPI_ROWS_BEGIN
            const size_t o = (size_t)row * DM + u.pn * 256 + c0; const float rs = rstd[row]; float pp[8];
            unpack8(*(const pg8::u32x4*)(PP + o), pp);
            const float4 b0 = *(const float4*)(x + o), b1 = *(const float4*)(x + o + 4);
            *(float4*)(x + o) = make_float4(b0.x + sigmoidf_(rs * v[0]) * pp[0], b0.y + sigmoidf_(rs * v[1]) * pp[1], b0.z + sigmoidf_(rs * v[2]) * pp[2], b0.w + sigmoidf_(rs * v[3]) * pp[3]);
            *(float4*)(x + o + 4) = make_float4(b1.x + sigmoidf_(rs * v[4]) * pp[4], b1.y + sigmoidf_(rs * v[5]) * pp[5], b1.z + sigmoidf_(rs * v[6]) * pp[6], b1.w + sigmoidf_(rs * v[7]) * pp[7]);
        EPI_ROWS_END
    }
};

struct EpiPleFinal {
    static constexpr bool PERM = true, AFTER_DRAIN = true; static constexpr int MIDK = 0;
    const float* x2; const bf16_t* PP; const float* rstd2; const float* g_final; float* out; float* xbuf; unsigned* pcnt;
    DI void fused(pg8::f32x4 (&acc)[2][2][4][2], const pg8::Unit& u, int wr, int wc, int fr, int fq, PG8_LAS unsigned char* lds, int wid, int lane) const {
        __attribute__((address_space(3))) float* P = (__attribute__((address_space(3))) float*)lds;
        __attribute__((address_space(3))) float* S = P + 1024;
        const int l_ = lane_id_opaque();
#pragma unroll
        for (int ai = 0; ai < 2; ++ai)
#pragma unroll
            for (int m = 0; m < 4; ++m) {
                const int rl = ai * 128 + wr * 64 + m * 16 + fr, row = u.pm * 256 + rl; const float rs = rstd2[row]; float sq = 0.f;
#pragma unroll
                for (int bj = 0; bj < 2; ++bj) {
                    const size_t o = (size_t)row * DM + u.pn * 256 + bj * 128 + wc * 32 + 8 * fq; float pp[8];
                    unpack8(*(const pg8::u32x4*)(PP + o), pp);
                    const float4 b0 = *(const float4*)(x2 + o), b1 = *(const float4*)(x2 + o + 4);
                    const float bx[8] = {b0.x, b0.y, b0.z, b0.w, b1.x, b1.y, b1.z, b1.w};
#pragma unroll
                    for (int i = 0; i < 4; ++i) {
                        const float v0 = bx[i] + sigmoidf_(rs * acc[ai][bj][m][0][i]) * pp[i], v1 = bx[4 + i] + sigmoidf_(rs * acc[ai][bj][m][1][i]) * pp[4 + i];
                        acc[ai][bj][m][0][i] = v0; acc[ai][bj][m][1][i] = v1; sq += v0 * v0 + v1 * v1;
                    }
                }
                sq += lane_xor(sq, 16, l_); sq += lane_xor(sq, 32, l_);
                if (fq == 0) P[rl * 4 + wc] = sq;
                asm volatile("" ::: "memory");
            }
        __syncthreads();
        const int t = wid * 64 + lane;
        if (t < 256) { const float ps = (P[t * 4] + P[t * 4 + 1]) + (P[t * 4 + 2] + P[t * 4 + 3]);
            __hip_atomic_store(xbuf + ((size_t)u.pm * 256 + t) * 4 + u.pn, ps, __ATOMIC_RELAXED, __HIP_MEMORY_SCOPE_AGENT); }
        asm volatile("s_waitcnt vmcnt(0)" ::: "memory");
        __syncthreads();
        if (t == 0) __hip_atomic_fetch_add(pcnt + 64 * u.pm, 1u, __ATOMIC_RELAXED, __HIP_MEMORY_SCOPE_AGENT);
        if (wid == 0) { unsigned spins = 0; while (__hip_atomic_load(pcnt + 64 * u.pm, __ATOMIC_RELAXED, __HIP_MEMORY_SCOPE_AGENT) < 4u && ++spins < (1u << 22)) __builtin_amdgcn_s_sleep(2); }
        __syncthreads();
        if (t < 256) { const float* xb = xbuf + ((size_t)u.pm * 256 + t) * 4;
            const float tot = (__hip_atomic_load(xb, __ATOMIC_RELAXED, __HIP_MEMORY_SCOPE_AGENT) + __hip_atomic_load(xb + 1, __ATOMIC_RELAXED, __HIP_MEMORY_SCOPE_AGENT))
                            + (__hip_atomic_load(xb + 2, __ATOMIC_RELAXED, __HIP_MEMORY_SCOPE_AGENT) + __hip_atomic_load(xb + 3, __ATOMIC_RELAXED, __HIP_MEMORY_SCOPE_AGENT));
            S[t] = rsqrtf(tot * (1.f / DM) + 1e-6f); }
        __syncthreads();
#pragma unroll
        for (int ai = 0; ai < 2; ++ai)
#pragma unroll
            for (int m = 0; m < 4; ++m) {
                const int rl = ai * 128 + wr * 64 + m * 16 + fr, row = u.pm * 256 + rl; const float r3 = S[rl];
#pragma unroll
                for (int bj = 0; bj < 2; ++bj) {
                    const int col = u.pn * 256 + bj * 128 + wc * 32 + 8 * fq; const size_t o = (size_t)row * DM + col;
                    const float4 g0 = *(const float4*)(g_final + col), g1 = *(const float4*)(g_final + col + 4);
                    *(float4*)(out + o) = make_float4(acc[ai][bj][m][0][0] * r3 * g0.x, acc[ai][bj][m][0][1] * r3 * g0.y, acc[ai][bj][m][0][2] * r3 * g0.z, acc[ai][bj][m][0][3] * r3 * g0.w);
                    *(float4*)(out + o + 4) = make_float4(acc[ai][bj][m][1][0] * r3 * g1.x, acc[ai][bj][m][1][1] * r3 * g1.y, acc[ai][bj][m][1][2] * r3 * g1.z, acc[ai][bj][m][1][3] * r3 * g1.w);
                }
            }
    }
};
struct MoeOrder {
    const int* cnt; int NJ, G, c;
    DI bool next(int i, pg8::Unit& u) const {
        int L = i * G + c, tb = 0;
        for (int e = 0; e < 16; ++e) { const int mt = (cnt[e * CNT_STRIDE] + 255) >> 8, n = mt * NJ; if (L < n) { u.pm = tb + L / NJ; u.pn = e * NJ + L % NJ; u.aux = L / NJ; return true; } L -= n; tb += mt; }
        return false;
    }
    DI void a_ready(const pg8::Unit&) const {}
    DI void done(const pg8::Unit&) const {}
};
struct TwoUnits { int pm, pn0, aux; DI bool next(int i, pg8::Unit& o) const { o.pm = pm; o.pn = pn0 + i; o.aux = aux; return i < 2; } DI void a_ready(const pg8::Unit&) const {} DI void done(const pg8::Unit&) const {} };
struct FourUnits { int pm, pn0; DI bool next(int i, pg8::Unit& o) const { o.pm = pm; o.pn = pn0 + i; o.aux = 0; return i < 4; } DI void a_ready(const pg8::Unit&) const {} DI void done(const pg8::Unit&) const {} };
struct OneUnit { pg8::Unit u; DI bool next(int i, pg8::Unit& o) const { o = u; return i == 0; } DI void a_ready(const pg8::Unit&) const {} DI void done(const pg8::Unit&) const {} };
struct PPOrder { int extra, G, c; DI bool next(int i, pg8::Unit& u) const { const int nl = G - extra, li = c - extra; if (li < 0 || nl <= 0) return false; const int id = li + i * nl; if (id >= 256) return false; u.pm = id >> 2; u.pn = id & 3; u.aux = 0; return true; }
    DI void a_ready(const pg8::Unit&) const {} DI void done(const pg8::Unit&) const {} };
DI int moe_base_row(const int* cnt, int e) { int tb = 0; for (int k = 0; k < 16; ++k) { if (k < e) tb += (cnt[k * CNT_STRIDE] + 255) >> 8; } return tb * 256; }
struct MapId { DI int operator()(int n) const { return n; } };
struct MapE13 { DI int operator()(int n) const { return ((n >> 7) & 1) * 256 + (n >> 8) * 128 + (n & 127); } };

DI void router_stage(__attribute__((address_space(3))) float* Wl, const float* __restrict__ g, const float* __restrict__ w_rg, const float* __restrict__ w_re, int tx) {
    for (int e = tx; e < 4096; e += 512) { const int k = e >> 2, c = e & 3; Wl[c * 1024 + k] = w_rg[e] * g[k]; }
    for (int e = tx; e < 16384; e += 512) { const int k = e >> 4, c = e & 15; Wl[(4 + c) * 1024 + k] = w_re[e] * g[k]; }
}
typedef float f4v __attribute__((ext_vector_type(4)));
DI float dpp_row_sum(float v) {
    v += __builtin_bit_cast(float, __builtin_amdgcn_update_dpp(0, __builtin_bit_cast(int, v), 0xB1, 0xf, 0xf, true));
    v += __builtin_bit_cast(float, __builtin_amdgcn_update_dpp(0, __builtin_bit_cast(int, v), 0x4E, 0xf, 0xf, true));
    v += __builtin_bit_cast(float, __builtin_amdgcn_update_dpp(0, __builtin_bit_cast(int, v), 0x141, 0xf, 0xf, true));
    v += __builtin_bit_cast(float, __builtin_amdgcn_update_dpp(0, __builtin_bit_cast(int, v), 0x140, 0xf, 0xf, true));
    return v;
}
DI void router4(const int (&tok)[4], int lane, const f4v (&xv)[16], const __attribute__((address_space(3))) float* Wl, const float* __restrict__ b_rg, const float* __restrict__ b_re,
                float* __restrict__ rstd1, __attribute__((address_space(3))) int* lcnt, __attribute__((address_space(3))) int* lri) {
    const int g = lane >> 4, p = lane & 15;
    float s = 0.f;
#pragma unroll
    for (int j = 0; j < 16; ++j) s += (xv[j].x * xv[j].x + xv[j].y * xv[j].y) + (xv[j].z * xv[j].z + xv[j].w * xv[j].w);
    const float rstd = rsqrtf(dpp_row_sum(s) * (1.f / DM) + 1e-6f);
    float al[20];
#pragma unroll
    for (int c = 0; c < 20; ++c) {
        float a = 0.f;
#pragma unroll
        for (int j = 0; j < 16; ++j) { const f4v w = *(const __attribute__((address_space(3))) f4v*)(Wl + c * 1024 + 4 * (p + 16 * j)); a += (xv[j].x * w.x + xv[j].y * w.y) + (xv[j].z * w.z + xv[j].w * w.w); }
        al[c] = dpp_row_sum(a);
    }
    float gl[4], el[16];
#pragma unroll
    for (int c = 0; c < 4; ++c) gl[c] = al[c] * rstd + b_rg[c];
#pragma unroll
    for (int c = 0; c < 16; ++c) el[c] = al[4 + c] * rstd + b_re[c];
    if (p == 0) {
        int gs = 0; float gm = gl[0];
#pragma unroll
        for (int c = 1; c < 4; ++c) if (gl[c] > gm) { gm = gl[c]; gs = c; }
        float se = 0.f;
#pragma unroll
        for (int c = 0; c < 4; ++c) se += __expf(gl[c] - gm);
        const float pg = 1.f / se;
        float e4[4];
#pragma unroll
        for (int c = 0; c < 4; ++c) e4[c] = gs == 0 ? el[c] : gs == 1 ? el[4 + c] : gs == 2 ? el[8 + c] : el[12 + c];
        int i0 = 0; float v0 = e4[0];
#pragma unroll
        for (int c = 1; c < 4; ++c) if (e4[c] > v0) { v0 = e4[c]; i0 = c; }
        int i1 = -1; float v1 = -3.0e38f;
#pragma unroll
        for (int c = 0; c < 4; ++c) if (c != i0 && e4[c] > v1) { v1 = e4[c]; i1 = c; }
        const float ex = __expf(v1 - v0);
        const float w0 = pg / (1.f + ex), w1 = pg * ex / (1.f + ex);
        const int e0 = gs * 4 + i0, e1 = gs * 4 + i1;
        const int p0 = __hip_atomic_fetch_add(lcnt + e0, 1, __ATOMIC_RELAXED, __HIP_MEMORY_SCOPE_WORKGROUP), p1 = __hip_atomic_fetch_add(lcnt + e1, 1, __ATOMIC_RELAXED, __HIP_MEMORY_SCOPE_WORKGROUP);
        const int tk = g == 0 ? tok[0] : g == 1 ? tok[1] : g == 2 ? tok[2] : tok[3];
        rstd1[tk] = rstd;
        lri[g * 4 + 0] = e0 | (e1 << 8); lri[g * 4 + 1] = p0 | (p1 << 16); lri[g * 4 + 2] = __float_as_int(w0); lri[g * 4 + 3] = __float_as_int(w1);
    }
}

struct BMapId { DI int operator()(int n) const { return n; } };
struct BMapMoe { DI int operator()(int n) const { const int t = n >> 7, c = n & 127, e = t >> 2, jt = t & 3; return e * (1024 * 512) + ((c >> 5) & 1) * 256 + jt * 64 + (c >> 6) * 32 + (c & 31); } };
template <class Epi, class BMap>
DI void gemm_v1(int bx, int by, int tid, char* sm, const bf16_t* __restrict__ A, int lda, const float* __restrict__ B, int ldb, int N, int K, Epi epi, BMap bmap) {
    bf16_t* As = (bf16_t*)sm;
    bf16_t* Bs = (bf16_t*)(sm + 128 * 40 * 2);
    const int lane = tid & 63, w = tid >> 6, wr = w >> 1, wc = w & 1, r32 = lane & 31, hi = lane >> 5;
    const int m0 = by * 128, n0 = bx * 128;
    f32x16 acc[2][2];
#pragma unroll
    for (int i = 0; i < 2; ++i)
#pragma unroll
        for (int j = 0; j < 2; ++j)
#pragma unroll
            for (int r = 0; r < 16; ++r) acc[i][j][r] = 0.f;
    for (int k0 = 0; k0 < K; k0 += 32) {
#pragma unroll
        for (int i = 0; i < 2; ++i) {
            const int c = tid + i * 256, row = c >> 2, col = (c & 3) * 8;
            const uint4 v = *(const uint4*)(A + (size_t)(m0 + row) * lda + k0 + col);
            *(uint4*)(As + row * 40 + col) = v;
        }
#pragma unroll
        for (int i = 0; i < 4; ++i) {
            const int idx = tid + i * 256, k = idx >> 5, n = (idx & 31) * 4;
            float4 v = make_float4(0.f, 0.f, 0.f, 0.f);
            if (n0 + n < N) v = *(const float4*)(B + (size_t)(k0 + k) * ldb + bmap(n0 + n));
            Bs[(n + 0) * 40 + k] = f2bf(v.x); Bs[(n + 1) * 40 + k] = f2bf(v.y); Bs[(n + 2) * 40 + k] = f2bf(v.z); Bs[(n + 3) * 40 + k] = f2bf(v.w);
        }
        __syncthreads();
#pragma unroll
        for (int kk = 0; kk < 32; kk += 16) {
            bf16x8 a[2], b[2];
#pragma unroll
            for (int i = 0; i < 2; ++i) a[i] = *(const bf16x8*)(As + (wr * 64 + i * 32 + r32) * 40 + kk + hi * 8);
#pragma unroll
            for (int j = 0; j < 2; ++j) b[j] = *(const bf16x8*)(Bs + (wc * 64 + j * 32 + r32) * 40 + kk + hi * 8);
#pragma unroll
            for (int i = 0; i < 2; ++i)
#pragma unroll
                for (int j = 0; j < 2; ++j) acc[i][j] = __builtin_amdgcn_mfma_f32_32x32x16_bf16(a[i], b[j], acc[i][j], 0, 0, 0);
        }
        __syncthreads();
    }
#pragma unroll
    for (int i = 0; i < 2; ++i)
#pragma unroll
        for (int j = 0; j < 2; ++j)
#pragma unroll
            for (int r = 0; r < 16; ++r) {
                const int row = m0 + wr * 64 + i * 32 + (r & 3) + 8 * (r >> 2) + 4 * hi;
                const int col = n0 + wc * 64 + j * 32 + r32;
                if constexpr (Epi::PAIR) { if (j == 0) epi.pair(row, col, acc[i][0][r], acc[i][1][r]); }
                else { if (col < N) epi(row, col, acc[i][j][r]); }
            }
}

struct EpiPa { static constexpr bool PAIR = false;
    const bf16_t* MG; float* tmp;
    DI void operator()(int row, int col, float v) const { tmp[(size_t)row * DM + col] = bf2f(MG[(size_t)row * 2048 + col]) * v; }
};
struct EpiPb { static constexpr bool PAIR = false;
    const bf16_t* MG; const float* tmp; bf16_t* mixed;
    DI void operator()(int row, int col, float v) const {
        mixed[(size_t)row * DM + col] = f2bf(tmp[(size_t)row * DM + col] + bf2f(MG[(size_t)row * 2048 + 1024 + col]) * v);
    }
};
struct EpiResid { static constexpr bool PAIR = false;
    const float* base; float* out;
    DI void operator()(int row, int col, float v) const { out[(size_t)row * DM + col] = base[(size_t)row * DM + col] + v; }
};
struct EpiBf { static constexpr bool PAIR = false;
    bf16_t* o; int ld;
    DI void operator()(int row, int col, float v) const { o[(size_t)row * ld + col] = f2bf(v); }
};
struct EpiF32 { static constexpr bool PAIR = false;
    float* o; int ld;
    DI void operator()(int row, int col, float v) const { o[(size_t)row * ld + col] = v; }
};
struct EpiPle { static constexpr bool PAIR = false;
    float* x; const float* pp;
    DI void operator()(int row, int col, float v) const { const size_t i = (size_t)row * DM + col; x[i] = x[i] + sigmoidf_(v) * pp[i]; }
};

DI void rmsnorm_rows(int bx, int tid, const float* x, const float* __restrict__ g, bf16_t* outb, float* outf, int rows) {
    const int row = bx * 4 + (tid >> 6), lane = tid & 63;
    if (row >= rows) return;
    const float4* xr = (const float4*)(x + (size_t)row * DM);
    float4 v[4]; float s = 0.f;
#pragma unroll
    for (int j = 0; j < 4; ++j) { v[j] = xr[lane + 64 * j]; s += v[j].x * v[j].x + v[j].y * v[j].y + v[j].z * v[j].z + v[j].w * v[j].w; }
    const float rstd = rsqrtf(wave_sum(s) * (1.f / DM) + 1e-6f);
#pragma unroll
    for (int j = 0; j < 4; ++j) {
        const float4 gg = ((const float4*)g)[lane + 64 * j];
        const float a = v[j].x * rstd * gg.x, b = v[j].y * rstd * gg.y, c = v[j].z * rstd * gg.z, d = v[j].w * rstd * gg.w;
        if (outf) ((float4*)(outf + (size_t)row * DM))[lane + 64 * j] = make_float4(a, b, c, d);
        else { ushort4 o; o.x = f2bf(a); o.y = f2bf(b); o.z = f2bf(c); o.w = f2bf(d); ((ushort4*)(outb + (size_t)row * DM))[lane + 64 * j] = o; }
    }
}

DI void cvt_bf16(int bx, int nb, int tid, const float* __restrict__ in, bf16_t* __restrict__ out, size_t n) {
    for (size_t i = bx * (size_t)256 + tid; i < n; i += (size_t)nb * 256) out[i] = f2bf(in[i]);
}

DI float gelu_tanh(float x) { const float u = 0.7978845608028654f * (x + 0.044715f * x * x * x); return 0.5f * x * (1.f + tanhf(u)); }

DI void compress_naive(int bx, int by, int bz, int tid, char* sm, const bf16_t* __restrict__ KVb, const float* __restrict__ w1k, const float* __restrict__ w2k, const float* __restrict__ pek,
                                                      const float* __restrict__ w1v, const float* __restrict__ w2v, const float* __restrict__ pev, float* __restrict__ outk, float* __restrict__ outv, bf16_t* __restrict__ kcb, bf16_t* __restrict__ vcT) {
    float* flat = (float*)sm;
    float* h1 = flat + 2048;
    __syncthreads();
    const int j = bx, bg = by, kv = bz, b = bg >> 1, g = bg & 1;
    const float* w1 = kv ? w1v : w1k; const float* w2 = kv ? w2v : w2k; const float* pe = kv ? pev : pek; float* out = kv ? outv : outk;
    const int colbase = (kv ? 128 : 0) + g * 64;
    for (int e = tid; e < 2048; e += 256) {
        const int i = e >> 6, d = e & 63;
        flat[e] = bf2f(KVb[(size_t)(b * SEQ + 16 * j + i) * 512 + colbase + d]) + pe[e];
    }
    __syncthreads();
    float s = 0.f;
    for (int k = 0; k < 2048; ++k) s += flat[k] * w1[(size_t)k * 256 + tid];
    h1[tid] = gelu_tanh(s);
    __syncthreads();
    if (tid < 64) {
        float o = 0.f;
        for (int n = 0; n < 256; ++n) o += h1[n] * w2[n * 64 + tid];
        out[((size_t)bg * 256 + j) * 64 + tid] = o;
        if (kv == 0) { kcb[((size_t)bg * 256 + j) * 64 + tid] = f2bf(o); if (j == 254) kcb[((size_t)bg * 256 + 255) * 64 + tid] = 0; }
        else { vcT[((size_t)bg * 4 + (j >> 6)) * 4096 + tid * 64 + (j & 63)] = f2bf(o); if (j == 254) vcT[((size_t)bg * 4 + 3) * 4096 + tid * 64 + 63] = 0; }
    }
}

DI void softmax_row(float* row, int n, int lane) {
    float m = -3.0e38f;
    for (int j = lane; j < n; j += 64) m = fmaxf(m, row[j]);
    m = wave_max(m);
    float s = 0.f;
    for (int j = lane; j < n; j += 64) { const float e = exp2f(row[j] - m); row[j] = e; s += e; }
    s = wave_sum(s);
    const float inv = 1.f / s;
    for (int j = lane; j < n; j += 64) row[j] *= inv;
}

DI void nsa_naive(int bx, int by, int tid, char* sm, const bf16_t* __restrict__ Qb, const bf16_t* __restrict__ KVb, const bf16_t* __restrict__ VT, const float* __restrict__ kcc, const float* __restrict__ vcc, const float* __restrict__ gates, bf16_t* __restrict__ Y) {
    float (*q)[64] = (float (*)[64])sm;
    float (*sc)[1024] = (float (*)[1024])(sm + 1024);
    float* impv = (float*)(sm + 1024 + 16384);
    int* sellist = (int*)(sm + 1024 + 16384 + 256);
    int* selflag = (int*)(sm + 1024 + 16384 + 256 + 64);
    int& nsel_s = *(int*)(sm + 1024 + 16384 + 256 + 64 + 256);
    __syncthreads();
    const int tok = bx, g = by, b = tok >> 12, t = tok & 4095, hh = tid >> 6, lane = tid & 63, d = lane;
    q[hh][d] = bf2f(Qb[(size_t)tok * 512 + (g * 4 + hh) * 64 + d]);
    __syncthreads();
    const int nv = (t >= 31) ? ((t - 15) >> 4) : 0;
    const float* kcb = kcc + (size_t)(b * 2 + g) * 256 * 64; const float* vcb = vcc + (size_t)(b * 2 + g) * 256 * 64;
    if (tid < nv) {
        float s0 = 0.f, s1 = 0.f, s2 = 0.f, s3 = 0.f;
#pragma unroll 8
        for (int dd = 0; dd < 64; ++dd) { const float kx = kcb[tid * 64 + dd]; s0 += q[0][dd] * kx; s1 += q[1][dd] * kx; s2 += q[2][dd] * kx; s3 += q[3][dd] * kx; }
        sc[0][tid] = s0; sc[1][tid] = s1; sc[2][tid] = s2; sc[3][tid] = s3;
    }
    __syncthreads();
    if (nv > 0) softmax_row(sc[hh], nv, lane);
    for (int j = nv + lane; j < 256; j += 64) sc[hh][j] = 0.f;
    __syncthreads();
    float o_cmp = 0.f;
    for (int j = 0; j < nv; ++j) o_cmp += sc[hh][j] * vcb[j * 64 + d];
    const int cur = t >> 6;
    if (tid < 64) {
        const int s = tid; int lo = 4 * s - 1; if (lo < 0) lo = 0; int hi2 = 4 * s + 3; if (hi2 > 254) hi2 = 254;
        float v = 0.f;
        for (int h2 = 0; h2 < 4; ++h2) for (int j = lo; j <= hi2; ++j) v += sc[h2][j];
        if (s == 0 || s == cur || s == cur - 1) v += 1000.0f;
        if (s > cur) v = -1e30f;
        impv[s] = v;
    }
    __syncthreads();
    if (tid < 64) {
        const float v = impv[tid]; int rank = 0;
        for (int s2 = 0; s2 < 64; ++s2) { const float u = impv[s2]; rank += (u > v || (u == v && s2 < tid)) ? 1 : 0; }
        selflag[tid] = (rank < 16 && tid <= cur) ? 1 : 0;
    }
    __syncthreads();
    if (tid == 0) { int n = 0; for (int s = 0; s < 64; ++s) if (selflag[s]) { if (n < 16) sellist[n] = s; ++n; } nsel_s = n < 16 ? n : 16; }
    __syncthreads();
    const int ns = nsel_s, ne = ns * 64;
    for (int e = tid; e < ne; e += 256) {
        const int kpos = sellist[e >> 6] * 64 + (e & 63);
        if (kpos <= t) {
            const bf16_t* kp = KVb + (size_t)(b * SEQ + kpos) * 512 + 256 + g * 64;
            float s0 = 0.f, s1 = 0.f, s2 = 0.f, s3 = 0.f;
    #pragma unroll 8
        for (int dd = 0; dd < 64; ++dd) { const float kx = bf2f(kp[dd]); s0 += q[0][dd] * kx; s1 += q[1][dd] * kx; s2 += q[2][dd] * kx; s3 += q[3][dd] * kx; }
            sc[0][e] = s0; sc[1][e] = s1; sc[2][e] = s2; sc[3][e] = s3;
        } else { sc[0][e] = -1e30f; sc[1][e] = -1e30f; sc[2][e] = -1e30f; sc[3][e] = -1e30f; }
    }
    __syncthreads();
    softmax_row(sc[hh], ne, lane);
    __syncthreads();
    float o_sel = 0.f;
    for (int e = 0; e < ne; ++e) {
        const int kpos = sellist[e >> 6] * 64 + (e & 63);
        o_sel += sc[hh][e] * bf2f(VT[((size_t)(b * 2 + g) * 64 + (kpos >> 6)) * 4096 + d * 64 + (kpos & 63)]);
    }
    __syncthreads();
    const int nw = (t + 1 < 512) ? (t + 1) : 512, w0 = t - nw + 1;
    for (int e = tid; e < nw; e += 256) {
        const bf16_t* kp = KVb + (size_t)(b * SEQ + w0 + e) * 512 + 384 + g * 64;
        float s0 = 0.f, s1 = 0.f, s2 = 0.f, s3 = 0.f;
#pragma unroll 8
        for (int dd = 0; dd < 64; ++dd) { const float kx = bf2f(kp[dd]); s0 += q[0][dd] * kx; s1 += q[1][dd] * kx; s2 += q[2][dd] * kx; s3 += q[3][dd] * kx; }
        sc[0][e] = s0; sc[1][e] = s1; sc[2][e] = s2; sc[3][e] = s3;
    }
    __syncthreads();
    softmax_row(sc[hh], nw, lane);
    __syncthreads();
    float o_win = 0.f;
    for (int e = 0; e < nw; ++e) { const int kpos = w0 + e; o_win += sc[hh][e] * bf2f(VT[((size_t)(8 + b * 2 + g) * 64 + (kpos >> 6)) * 4096 + d * 64 + (kpos & 63)]); }
    const float* gt = gates + (size_t)tok * 24 + (g * 4 + hh) * 3;
    Y[(size_t)tok * DM + (g * 4 + hh) * 64 + d] = f2bf(gt[0] * o_cmp + gt[1] * o_sel + gt[2] * o_win);
}

DI void conv_silu(int bx, int tid, const bf16_t* __restrict__ MQK, const float* __restrict__ wc, const float* __restrict__ bc, bf16_t* __restrict__ out) {
    const int idx = bx * 256 + tid;
    if (idx >= T_TOK * 1024) return;
    const int c = idx & 1023, tok = idx >> 10, t = tok & 4095;
    float y = bc[c];
#pragma unroll
    for (int j = 0; j < 4; ++j) { const int tt = t - 3 + j; if (tt >= 0) y += wc[j * 1024 + c] * bf2f(MQK[(size_t)(tok - 3 + j) * 1024 + c]); }
    y = y * sigmoidf_(y);
    if (c >= 512) y *= 0.08838834764831845f;
    out[idx] = f2bf(y);
}

DI void mlstm_naive(int bx, int tid, char* sm, const bf16_t* __restrict__ qkc, const bf16_t* __restrict__ MV, const bf16_t* __restrict__ MO, const float* __restrict__ ifp, float* __restrict__ hm) {
    float (*qs)[128] = (float (*)[128])sm;
    float (*ks)[128] = (float (*)[128])(sm + 16384);
    float (*vs)[16] = (float (*)[16])(sm + 32768);
    float (*os)[16] = (float (*)[16])(sm + 32768 + 2048);
    float* gi = (float*)(sm + 32768 + 4096); float* gf = gi + 32;
    const int bh = bx >> 3, vsl = bx & 7, b = bh >> 2, h = bh & 3, v = tid >> 4, kg = tid & 15;
    float C[8], n[8];
#pragma unroll
    for (int j = 0; j < 8; ++j) { C[j] = 0.f; n[j] = 0.f; }
    for (int c0 = 0; c0 < SEQ; c0 += 32) {
        __syncthreads();
        for (int e = tid; e < 32 * 128; e += 256) {
            const int s = e >> 7, k = e & 127; const size_t tok = (size_t)b * SEQ + c0 + s;
            qs[s][k] = bf2f(qkc[tok * 1024 + h * 128 + k]); ks[s][k] = bf2f(qkc[tok * 1024 + 512 + h * 128 + k]);
        }
        for (int e = tid; e < 32 * 16; e += 256) {
            const int s = e >> 4, vv = e & 15; const size_t tok = (size_t)b * SEQ + c0 + s;
            vs[s][vv] = bf2f(MV[tok * 512 + h * 128 + vsl * 16 + vv]);
            os[s][vv] = sigmoidf_(bf2f(MO[tok * 512 + h * 128 + vsl * 16 + vv]));
        }
        if (tid < 32) { const size_t tok = (size_t)b * SEQ + c0 + tid; gi[tid] = __expf(ifp[tok * 8 + h]); gf[tid] = sigmoidf_(ifp[tok * 8 + 4 + h]); }
        __syncthreads();
        for (int s = 0; s < 32; ++s) {
            const float f = gf[s], iv = gi[s] * vs[s][v], ig = gi[s];
            float num = 0.f, den = 0.f;
#pragma unroll
            for (int j = 0; j < 8; ++j) {
                const float kx = ks[s][kg * 8 + j], qx = qs[s][kg * 8 + j];
                C[j] = f * C[j] + iv * kx; n[j] = f * n[j] + ig * kx;
                num += C[j] * qx; den += n[j] * qx;
            }
            const int l_ = lane_id_opaque();
#pragma unroll
            for (int o = 1; o < 16; o <<= 1) { num += lane_xor(num, o, l_); den += lane_xor(den, o, l_); }
            if (kg == 0) hm[((size_t)b * SEQ + c0 + s) * 512 + h * 128 + vsl * 16 + v] = num / fmaxf(fabsf(den), 1.0f) * os[s][v];
        }
    }
}

DI void hnorm(int bx, int tid, const float* __restrict__ hm, const float* __restrict__ g_hn, bf16_t* __restrict__ Y) {
    const int item = bx * 4 + (tid >> 6), lane = tid & 63;
    const int tok = item >> 2, h = item & 3;
    const float a = hm[(size_t)tok * 512 + h * 128 + lane], b = hm[(size_t)tok * 512 + h * 128 + 64 + lane];
    const float rstd = rsqrtf(wave_sum(a * a + b * b) * (1.f / 128.f) + 1e-6f);
    Y[(size_t)tok * DM + 512 + h * 128 + lane] = f2bf(a * rstd * g_hn[h * 128 + lane]);
    Y[(size_t)tok * DM + 512 + h * 128 + 64 + lane] = f2bf(b * rstd * g_hn[h * 128 + 64 + lane]);
}

DI void router(int bx, int tid, const float* __restrict__ x, const float* __restrict__ g, const float* __restrict__ w_rg, const float* __restrict__ b_rg,
                                              const float* __restrict__ w_re, const float* __restrict__ b_re, bf16_t* __restrict__ xn, float* __restrict__ gate) {
    const int tok = bx * 4 + (tid >> 6), lane = tid & 63;
    float xv[16]; float s = 0.f;
#pragma unroll
    for (int j = 0; j < 4; ++j) { const float4 v = ((const float4*)(x + (size_t)tok * DM))[lane + 64 * j]; xv[4 * j] = v.x; xv[4 * j + 1] = v.y; xv[4 * j + 2] = v.z; xv[4 * j + 3] = v.w; s += v.x * v.x + v.y * v.y + v.z * v.z + v.w * v.w; }
    const float rstd = rsqrtf(wave_sum(s) * (1.f / DM) + 1e-6f);
#pragma unroll
    for (int j = 0; j < 4; ++j) { const float4 gg = ((const float4*)g)[lane + 64 * j]; xv[4 * j] *= rstd * gg.x; xv[4 * j + 1] *= rstd * gg.y; xv[4 * j + 2] *= rstd * gg.z; xv[4 * j + 3] *= rstd * gg.w;
        ushort4 o; o.x = f2bf(xv[4 * j]); o.y = f2bf(xv[4 * j + 1]); o.z = f2bf(xv[4 * j + 2]); o.w = f2bf(xv[4 * j + 3]); ((ushort4*)(xn + (size_t)tok * DM))[lane + 64 * j] = o; }
    float mylog = 0.f;
#pragma unroll 1
    for (int c = 0; c < 20; ++c) {
        const float* w = c < 4 ? w_rg + c : w_re + (c - 4); const int ld = c < 4 ? 4 : 16;
        float a = 0.f;
#pragma unroll
        for (int j = 0; j < 4; ++j)
#pragma unroll
            for (int i = 0; i < 4; ++i) a += xv[4 * j + i] * w[(size_t)(4 * (lane + 64 * j) + i) * ld];
        a = wave_sum(a) + (c < 4 ? b_rg[c] : b_re[c - 4]);
        if (lane == c) mylog = a;
    }
    float gl[4], el[16];
#pragma unroll
    for (int c = 0; c < 4; ++c) gl[c] = lane_get(mylog, c);
#pragma unroll
    for (int c = 0; c < 16; ++c) el[c] = lane_get(mylog, 4 + c);
    if (lane == 0) {
        int gs = 0; float gm = gl[0];
#pragma unroll
        for (int c = 1; c < 4; ++c) if (gl[c] > gm) { gm = gl[c]; gs = c; }
        float se = 0.f;
#pragma unroll
        for (int c = 0; c < 4; ++c) se += __expf(gl[c] - gm);
        const float pg = 1.f / se;
        float e4[4];
#pragma unroll
        for (int c = 0; c < 4; ++c) e4[c] = gs == 0 ? el[c] : gs == 1 ? el[4 + c] : gs == 2 ? el[8 + c] : el[12 + c];
        int i0 = 0; float v0 = e4[0];
#pragma unroll
        for (int c = 1; c < 4; ++c) if (e4[c] > v0) { v0 = e4[c]; i0 = c; }
        int i1 = -1; float v1 = -3.0e38f;
#pragma unroll
        for (int c = 0; c < 4; ++c) if (c != i0 && e4[c] > v1) { v1 = e4[c]; i1 = c; }
        const float ex = __expf(v1 - v0);
        const float w0 = pg / (1.f + ex), w1 = pg * ex / (1.f + ex);
#pragma unroll
        for (int c = 0; c < 16; ++c) gate[(size_t)tok * 16 + c] = (c == gs * 4 + i0) ? w0 : (c == gs * 4 + i1) ? w1 : 0.f;
    }
}


struct EpiMoe { static constexpr bool PAIR = true;
    const float* gate; bf16_t* act;
    DI void operator()(int, int, float) const {}
    DI void pair(int row, int col, float gg, float u) const {
        const int t = col >> 7, c = col & 127, e = t >> 2, jt = t & 3, f = jt * 64 + (c >> 6) * 32 + (c & 31);
        act[(size_t)row * 4096 + e * 256 + f] = f2bf(gg * sigmoidf_(gg) * u * gate[(size_t)row * 16 + e]);
    }
};

typedef float f32x2_t __attribute__((ext_vector_type(2))); typedef __bf16 bf16x2_t __attribute__((ext_vector_type(2)));
DI unsigned cvtpk(float lo, float hi) { f32x2_t v = {lo, hi}; bf16x2_t b = __builtin_convertvector(v, bf16x2_t); return __builtin_bit_cast(unsigned, b); }
typedef __attribute__((address_space(3))) char lds_c;
typedef unsigned u32x2v __attribute__((ext_vector_type(2))); typedef unsigned u32x4v __attribute__((ext_vector_type(4)));
constexpr int NSA_KC = 0, NSA_VC = 4 * 9216, NSA_KB = NSA_VC + 4 * 8704, NSA_VB = NSA_KB + 2 * 9216, NSA_IMP = NSA_VB + 2 * 8704, NSA_MASK = NSA_IMP + 64 * 65 * 4, NSA_END = NSA_MASK + 512;
static_assert(NSA_END <= 147456, "NSA LDS map");
DI int crow(int r, int hi) { return (r & 3) + 8 * (r >> 2) + 4 * hi; }
#define MFMA32(a, b, c) __builtin_amdgcn_mfma_f32_32x32x16_bf16((a), (b), (c), 0, 0, 0)

DI void nsa_qk(f32x16& p0, f32x16& p1, const lds_c* K, const bf16x8 (&qf)[4], float cin, int r32, int hi) {
    f32x16 c;
#pragma unroll
    for (int r = 0; r < 16; ++r) c[r] = cin;
#pragma unroll
    for (int ks = 0; ks < 4; ++ks) {
        const bf16x8 a0 = *(const __attribute__((address_space(3))) bf16x8*)(K + r32 * 144 + ks * 32 + hi * 16);
        const bf16x8 a1 = *(const __attribute__((address_space(3))) bf16x8*)(K + (32 + r32) * 144 + ks * 32 + hi * 16);
        if (ks == 0) { p0 = MFMA32(a0, qf[0], c); p1 = MFMA32(a1, qf[0], c); } else { p0 = MFMA32(a0, qf[ks], p0); p1 = MFMA32(a1, qf[ks], p1); }
    }
}
DI void nsa_softmax(f32x16& p0, f32x16& p1, float& mref, float& l, bool& started, f32x16& o0, f32x16& o1) {
    float mx = fmaxf(p0[0], p1[0]);
#pragma unroll
    for (int r = 1; r < 16; ++r) mx = fmaxf(mx, fmaxf(p0[r], p1[r]));
    { auto rr = __builtin_amdgcn_permlane32_swap(__float_as_uint(mx), __float_as_uint(mx), false, false); mx = fmaxf(__uint_as_float(rr[0]), __uint_as_float(rr[1])); }
    const bool need = started ? (mx > 8.f) : (mx > -3.0e38f);
    if (__any(need)) {
        const float delta = need ? mx : 0.f, f = started ? __builtin_amdgcn_exp2f(-delta) : 1.f;
        mref += delta;
#pragma unroll
        for (int r = 0; r < 16; ++r) { p0[r] -= delta; p1[r] -= delta; o0[r] *= f; o1[r] *= f; }
        l *= f; started = started || need;
    }
    float s = 0.f;
#pragma unroll
    for (int r = 0; r < 16; ++r) { p0[r] = __builtin_amdgcn_exp2f(p0[r]); p1[r] = __builtin_amdgcn_exp2f(p1[r]); s += p0[r] + p1[r]; }
    l += s;
}
DI void nsa_pv(f32x16& o0, f32x16& o1, const f32x16& p0, const f32x16& p1, const lds_c* V, int r32, int hi) {
#pragma unroll
    for (int hf = 0; hf < 2; ++hf)
#pragma unroll
        for (int s = 0; s < 2; ++s) {
            unsigned pw[4];
#pragma unroll
            for (int j = 0; j < 4; ++j) pw[j] = hf ? cvtpk(p1[8 * s + 2 * j], p1[8 * s + 2 * j + 1]) : cvtpk(p0[8 * s + 2 * j], p0[8 * s + 2 * j + 1]);
            const u32x4v pbw = {pw[0], pw[1], pw[2], pw[3]};
            const bf16x8 pb = __builtin_bit_cast(bf16x8, pbw);
            const lds_c* vp = V + r32 * 136 + hf * 64 + s * 32 + hi * 8;
            const u32x2v a0l = *(const __attribute__((address_space(3))) u32x2v*)(vp), a0h = *(const __attribute__((address_space(3))) u32x2v*)(vp + 16);
            const u32x2v a1l = *(const __attribute__((address_space(3))) u32x2v*)(vp + 32 * 136), a1h = *(const __attribute__((address_space(3))) u32x2v*)(vp + 32 * 136 + 16);
            const u32x4v A0w = {a0l.x, a0l.y, a0h.x, a0h.y}, A1w = {a1l.x, a1l.y, a1h.x, a1h.y};
            o0 = MFMA32(__builtin_bit_cast(bf16x8, A0w), pb, o0); o1 = MFMA32(__builtin_bit_cast(bf16x8, A1w), pb, o1);
        }
}
DI void nsa_store_k(lds_c* K, const u32x4v v, int tid) { *(__attribute__((address_space(3))) u32x4v*)(K + (tid >> 3) * 144 + (tid & 7) * 16) = v; }
DI void nsa_store_v(lds_c* V, const u32x4v v, int tid) { lds_c* p = V + (tid >> 3) * 136 + (tid & 7) * 16; *(__attribute__((address_space(3))) u32x2v*)p = (u32x2v){v.x, v.y}; *(__attribute__((address_space(3))) u32x2v*)(p + 8) = (u32x2v){v.z, v.w}; }
#define NEG_INF (-__builtin_inff())
DI void nsa_finish(f32x16& y0, f32x16& y1, f32x16& o0, f32x16& o1, float& m, float& l, bool& started, float gate) {
    float lt; { auto rr = __builtin_amdgcn_permlane32_swap(__float_as_uint(l), __float_as_uint(l), false, false); lt = __uint_as_float(rr[0]) + __uint_as_float(rr[1]); }
    const float f = lt > 0.f ? gate / lt : 0.f;
#pragma unroll
    for (int r = 0; r < 16; ++r) { y0[r] += f * o0[r]; y1[r] += f * o1[r]; o0[r] = 0.f; o1[r] = 0.f; }
    m = 0.f; l = 0.f; started = false;
}

DI void nsa_unit(int bg, int qb, int tx, lds_c* lds, const bf16_t* __restrict__ Qb, const bf16_t* __restrict__ KVb, const bf16_t* __restrict__ VT, const bf16_t* __restrict__ kcb, const bf16_t* __restrict__ vcT,
                 const float* __restrict__ gates, bf16_t* __restrict__ Y, unsigned long long& pacc) {
    const int lane = tx & 63, r32 = lane & 31, hi = lane >> 5, wave = __builtin_amdgcn_readfirstlane(tx >> 6), hh = wave >> 1, qs = wave & 1;
    RG_BEGIN(100)
    const int b = bg >> 1, g = bg & 1, ql = 32 * qs + r32, tq = 64 * qb + ql;
    const size_t tok = (size_t)b * SEQ + tq; const int head = g * 4 + hh;
    const int nc = (4 * qb + 66) >> 6;
    const bool need_topk = qb >= 16;
    lds_c* KC = lds + NSA_KC; lds_c* VC = lds + NSA_VC; lds_c* KB = lds + NSA_KB; lds_c* VB = lds + NSA_VB;
    __attribute__((address_space(3))) float* imp = (__attribute__((address_space(3))) float*)(lds + NSA_IMP);
    __attribute__((address_space(3))) unsigned* msk = (__attribute__((address_space(3))) unsigned*)(lds + NSA_MASK);
    const bf16_t* kcsrc = kcb + (size_t)bg * 256 * 64; const bf16_t* vcsrc = vcT + (size_t)bg * 4 * 4096;
    const bf16_t* kssrc = KVb + (size_t)b * SEQ * 512 + 256 + g * 64; const bf16_t* kwsrc = KVb + (size_t)b * SEQ * 512 + 384 + g * 64;
    const bf16_t* vssrc = VT + (size_t)bg * 64 * 4096; const bf16_t* vwsrc = VT + (size_t)(8 + bg) * 64 * 4096;
    const int n_sel = qb + 1, n_win = qb + 1 < 9 ? qb + 1 : 9, ntile = n_sel + n_win;
    __syncthreads();
    for (int c = 0; c < nc; ++c) {
        nsa_store_k(KC + c * 9216, *(const u32x4v*)(kcsrc + (size_t)(c * 64 + (tx >> 3)) * 64 + (tx & 7) * 8), tx);
        nsa_store_v(VC + c * 8704, *(const u32x4v*)(vcsrc + (size_t)c * 4096 + (tx >> 3) * 64 + (tx & 7) * 8), tx);
    }
    nsa_store_k(KB, *(const u32x4v*)(kssrc + (size_t)(tx >> 3) * 512 + (tx & 7) * 8), tx);
    nsa_store_v(VB, *(const u32x4v*)(vssrc + (tx >> 3) * 64 + (tx & 7) * 8), tx);
    for (int i = tx; i < 64 * 65; i += 512) imp[i] = 0.f;
    bf16x8 qf[4];
#pragma unroll
    for (int ks = 0; ks < 4; ++ks) qf[ks] = *(const bf16x8*)(Qb + tok * 512 + head * 64 + ks * 16 + hi * 8);
    const float g_cmp = gates[tok * 24 + head * 3 + 0], g_sel = gates[tok * 24 + head * 3 + 1], g_win = gates[tok * 24 + head * 3 + 2];
    f32x16 y0, y1, o0, o1, p0, p1;
#pragma unroll
    for (int r = 0; r < 16; ++r) { y0[r] = 0.f; y1[r] = 0.f; o0[r] = 0.f; o1[r] = 0.f; }
    float m = 0.f, l = 0.f; bool started = false;
    __syncthreads();
    RG_END(100)
    RG_BEGIN(101)
    const int nvq = tq >= 31 ? ((tq - 15) >> 4) : 0;
    for (int c = 0; c < nc; ++c) {
        nsa_qk(p0, p1, KC + c * 9216, qf, -m, r32, hi);
        const int lim = nvq - 64 * c;
#pragma unroll
        for (int r = 0; r < 16; ++r) { const int kl = crow(r, hi); if (kl >= lim) p0[r] = NEG_INF; if (kl + 32 >= lim) p1[r] = NEG_INF; }
        nsa_softmax(p0, p1, m, l, started, o0, o1);
        nsa_pv(o0, o1, p0, p1, VC + c * 8704, r32, hi);
    }
    const float m_c = m; float l_c; { auto rr = __builtin_amdgcn_permlane32_swap(__float_as_uint(l), __float_as_uint(l), false, false); l_c = __uint_as_float(rr[0]) + __uint_as_float(rr[1]); }
    nsa_finish(y0, y1, o0, o1, m, l, started, g_cmp);
    RG_END(101)
    unsigned mlo = 0xffffffffu, mhi = 0xffffffffu;
    RG_BEGIN(102)
    if (need_topk) {
        const float invl = l_c > 0.f ? 16777216.f / l_c : 0.f;
        __attribute__((address_space(3))) unsigned* impu = (__attribute__((address_space(3))) unsigned*)imp;
        for (int c = 0; c < nc; ++c) {
            nsa_qk(p0, p1, KC + c * 9216, qf, -m_c, r32, hi);
            const int lim = nvq - 64 * c;
#pragma unroll
            for (int r = 0; r < 16; ++r) { const int kl = crow(r, hi);
                p0[r] = kl < lim ? __builtin_amdgcn_exp2f(p0[r]) * invl : 0.f; p1[r] = kl + 32 < lim ? __builtin_amdgcn_exp2f(p1[r]) * invl : 0.f; }
#pragma unroll
            for (int hf = 0; hf < 2; ++hf)
#pragma unroll
                for (int i = 0; i < 4; ++i) {
                    const int a = 16 * c + 8 * hf + 2 * i + hi;
                    const unsigned u0 = (unsigned)__float2uint_rn(hf ? p1[4 * i] : p0[4 * i]), u1 = (unsigned)__float2uint_rn(hf ? p1[4 * i + 1] : p0[4 * i + 1]);
                    const unsigned u2 = (unsigned)__float2uint_rn(hf ? p1[4 * i + 2] : p0[4 * i + 2]), u3 = (unsigned)__float2uint_rn(hf ? p1[4 * i + 3] : p0[4 * i + 3]);
                    __hip_atomic_fetch_add(impu + ql * 65 + a, u0 + u1 + u2 + u3, __ATOMIC_RELAXED, __HIP_MEMORY_SCOPE_WORKGROUP);
                    if (a + 1 < 64) __hip_atomic_fetch_add(impu + ql * 65 + a + 1, u3, __ATOMIC_RELAXED, __HIP_MEMORY_SCOPE_WORKGROUP);
                }
        }
        __syncthreads();
        RG_BEGIN(103)
        {
            const int q = tx >> 3, j8 = tx & 7, smax = qb - 2;
            unsigned key[8];
#pragma unroll
            for (int k = 0; k < 8; ++k) { const int sb = j8 + 8 * k; key[k] = (sb >= 1 && sb <= smax) ? ((impu[q * 65 + sb] & ~63u) | (unsigned)(63 - sb)) + 64u : 0u; }
            unsigned blo = 0u, bhi = 0u;
#pragma unroll 1
            for (int round = 0; round < 13; ++round) {
                unsigned mx = key[0];
#pragma unroll
                for (int k = 1; k < 8; ++k) mx = mx > key[k] ? mx : key[k];
                { const unsigned t = (unsigned)__builtin_amdgcn_update_dpp(0, (int)mx, 0xB1, 0xf, 0xf, true); mx = mx > t ? mx : t; }
                { const unsigned t = (unsigned)__builtin_amdgcn_update_dpp(0, (int)mx, 0x4E, 0xf, 0xf, true); mx = mx > t ? mx : t; }
                { const unsigned t = (unsigned)__builtin_amdgcn_update_dpp(0, (int)mx, 0x141, 0xf, 0xf, true); mx = mx > t ? mx : t; }
#pragma unroll
                for (int k = 0; k < 8; ++k) if (key[k] == mx && mx != 0u) { key[k] = 0u; const int sb = j8 + 8 * k; if (sb < 32) blo |= 1u << sb; else bhi |= 1u << (sb - 32); }
            }
            const int l_ = lane_id_opaque();
#pragma unroll
            for (int o = 1; o < 8; o <<= 1) { blo |= (unsigned)__builtin_amdgcn_ds_bpermute((l_ ^ o) << 2, (int)blo); bhi |= (unsigned)__builtin_amdgcn_ds_bpermute((l_ ^ o) << 2, (int)bhi); }
            unsigned long long mm = ((unsigned long long)bhi << 32) | blo;
            mm |= 1ull | (1ull << qb) | (1ull << (qb - 1));
            if (j8 == 0) { msk[q * 2] = (unsigned)mm; msk[q * 2 + 1] = (unsigned)(mm >> 32); }
        }
        __syncthreads();
        RG_END(103)
        mlo = msk[ql * 2]; mhi = msk[ql * 2 + 1];
    }
    RG_END(102)
    RG_BEGIN(104)
#define NSA_SRC(i_, KP, VP) do { const bool nsel_ = (i_) < n_sel; const int s2_ = nsel_ ? (i_) : qb - n_win + 1 + ((i_) - n_sel); \
        KP = (nsel_ ? kssrc : kwsrc) + (size_t)(s2_ * 64 + (tx >> 3)) * 512 + (tx & 7) * 8; VP = (nsel_ ? vssrc : vwsrc) + (size_t)s2_ * 4096 + (tx >> 3) * 64 + (tx & 7) * 8; } while (0)
#define NSA_TILE(i_, cur_, KLD, VLD, KST, VST) do { \
        const bool is_sel = (i_) < n_sel; const int s = is_sel ? (i_) : qb - n_win + 1 + ((i_) - n_sel); \
        if ((i_) + 2 < ntile) { const bf16_t* kp_; const bf16_t* vp_; NSA_SRC((i_) + 2, kp_, vp_); KLD = *(const u32x4v*)kp_; VLD = *(const u32x4v*)vp_; } \
        const bool on = !is_sel || ((s < 32 ? (mlo >> s) : (mhi >> (s - 32))) & 1u) != 0u; \
        nsa_qk(p0, p1, KB + (cur_) * 9216, qf, on ? -m : NEG_INF, r32, hi); \
        const bool lowb = !is_sel && (qb >= 8) && (s == qb - 8), diag = (s == qb); \
        if (lowb || diag) { \
            _Pragma("unroll") for (int r = 0; r < 16; ++r) { const int kl = crow(r, hi); \
                if ((lowb && kl <= ql) || (diag && kl > ql)) p0[r] = NEG_INF; if ((lowb && kl + 32 <= ql) || (diag && kl + 32 > ql)) p1[r] = NEG_INF; } \
        } \
        nsa_softmax(p0, p1, m, l, started, o0, o1); \
        nsa_pv(o0, o1, p0, p1, VB + (cur_) * 8704, r32, hi); \
        if ((i_) == n_sel - 1) nsa_finish(y0, y1, o0, o1, m, l, started, g_sel); \
        if ((i_) == ntile - 1) nsa_finish(y0, y1, o0, o1, m, l, started, g_win); \
        if ((i_) + 1 < ntile) { nsa_store_k(KB + ((cur_) ^ 1) * 9216, KST, tx); nsa_store_v(VB + ((cur_) ^ 1) * 8704, VST, tx); } \
        __syncthreads(); } while (0)
    u32x4v kA = {0u, 0u, 0u, 0u}, vA = kA, kB2 = kA, vB2 = kA;
    if (ntile > 1) { const bf16_t* kp_; const bf16_t* vp_; NSA_SRC(1, kp_, vp_); kA = *(const u32x4v*)kp_; vA = *(const u32x4v*)vp_; }
    {
        int i = 0;
        for (; i + 1 < ntile; i += 2) {
            NSA_TILE(i, 0, kB2, vB2, kA, vA);
            NSA_TILE(i + 1, 1, kA, vA, kB2, vB2);
        }
        if (i < ntile) NSA_TILE(i, 0, kB2, vB2, kA, vA);
    }
#undef NSA_TILE
#undef NSA_SRC
    RG_END(104)
    bf16_t* yp = Y + tok * DM + head * 64;
#pragma unroll
    for (int i = 0; i < 4; ++i) {
        *(uint2*)(yp + 8 * i + 4 * hi) = make_uint2(cvtpk(y0[4 * i], y0[4 * i + 1]), cvtpk(y0[4 * i + 2], y0[4 * i + 3]));
        *(uint2*)(yp + 32 + 8 * i + 4 * hi) = make_uint2(cvtpk(y1[4 * i], y1[4 * i + 1]), cvtpk(y1[4 * i + 2], y1[4 * i + 3]));
    }
}

DI float log_sigmoid_(float x) { return x >= 0.f ? -__logf(1.f + __expf(-x)) : x - __logf(1.f + __expf(x)); }
DI float lane_shr_add(float v, int l) {
#pragma unroll
    for (int o = 1; o < 64; o <<= 1) { const float t = lane_get(v, l - o); if (l >= o) v += t; }
    return v;
}
DI float lane_shr_max(float v, int l) {
#pragma unroll
    for (int o = 1; o < 64; o <<= 1) { const float t = lane_get(v, l - o); if (l >= o) v = fmaxf(v, t); }
    return v;
}
DI float log_sigmoid_fast(float x) { return -__logf(1.f + __expf(-x)); }
DI void ml_mscan_all(const float* __restrict__ ifp, int bh, int lane, float* __restrict__ mtab, float* __restrict__ wprev, float* __restrict__ wsc) {
    const int b = bh >> 2, h = bh & 3;
    const float* gp = ifp + ((size_t)b * SEQ + 64 * lane) * 8 + h;
    float L = 0.f, mx = -3.0e38f;
#pragma unroll 16
    for (int s = 0; s < 64; ++s) { const float iv = gp[s * 8], fv = gp[s * 8 + 4]; L += log_sigmoid_fast(fv); mx = fmaxf(mx, iv - L); }
    const float G = L + mx;
    float m = 0.f, mine = 0.f, mnext = 0.f;
#pragma unroll
    for (int k = 0; k < 64; ++k) {
        const float Lk = __builtin_bit_cast(float, __builtin_amdgcn_readlane(__builtin_bit_cast(int, L), k)), Gk = __builtin_bit_cast(float, __builtin_amdgcn_readlane(__builtin_bit_cast(int, G), k));
        if (k == lane) mine = m;
        m = fmaxf(Lk + m, Gk);
        if (k == lane) mnext = m;
    }
    mtab[bh * 65 + lane] = mine;
    wprev[bh * 64 + lane] = __expf(L + mine - mnext);
    wsc[bh * 64 + lane] = __expf(G - mnext);
}
DI void ml_conv8(float (&o)[8], const bf16_t* __restrict__ MQK, size_t tok, int t_in_seq, int col, const float* __restrict__ wc, const float* __restrict__ bc, float scale) {
    const float4 b0 = *(const float4*)(bc + col), b1 = *(const float4*)(bc + col + 4);
    o[0] = b0.x; o[1] = b0.y; o[2] = b0.z; o[3] = b0.w; o[4] = b1.x; o[5] = b1.y; o[6] = b1.z; o[7] = b1.w;
#pragma unroll
    for (int j = 0; j < 4; ++j) {
        if (t_in_seq - 3 + j >= 0) {
            float u[8]; unpack8(*(const pg8::u32x4*)(MQK + (tok - 3 + j) * 1024 + col), u);
            const float4 w0 = *(const float4*)(wc + j * 1024 + col), w1 = *(const float4*)(wc + j * 1024 + col + 4);
            o[0] += w0.x * u[0]; o[1] += w0.y * u[1]; o[2] += w0.z * u[2]; o[3] += w0.w * u[3]; o[4] += w1.x * u[4]; o[5] += w1.y * u[5]; o[6] += w1.z * u[6]; o[7] += w1.w * u[7];
        }
    }
#pragma unroll
    for (int i = 0; i < 8; ++i) o[i] = o[i] * sigmoidf_(o[i]) * scale;
}
constexpr float ML_KSCALE = 0.08838834764831845f;
DI void ml_unit_c(int bh, int c, int tx, lds_c* lds, const bf16_t* __restrict__ MQK, const bf16_t* __restrict__ MV, const float* __restrict__ ifp, const float* __restrict__ wc, const float* __restrict__ bc,
                  bf16_t* __restrict__ dC, float* __restrict__ dn, float* __restrict__ wprev, const float* __restrict__ mtab) {
    const int b = bh >> 2, h = bh & 3, lane = tx & 63, r32 = lane & 31, hi = lane >> 5, wave = __builtin_amdgcn_readfirstlane(tx >> 6);
    lds_c* KT = lds; lds_c* VTw = lds + 128 * 144;
    __attribute__((address_space(3))) float* wsm = (__attribute__((address_space(3))) float*)(lds + 2 * 128 * 144);
    const size_t tok0 = (size_t)b * SEQ + 64 * c;
    __syncthreads();
    if (wave == 0) {
        const float iv = ifp[(tok0 + lane) * 8 + h], lf = log_sigmoid_(ifp[(tok0 + lane) * 8 + 4 + h]);
        const int l_ = lane_id_opaque();
        const float bc_ = lane_shr_add(lf, l_), u = iv - bc_, umax = wave_max(u);
        wsm[lane] = __expf(u - umax);
        (void)wprev; (void)mtab;
    }
    __syncthreads();
#pragma unroll 1
    for (int it = tx; it < 1024; it += 512) {
        const int s = it >> 4, d0 = (it & 15) * 8; float kv[8];
        ml_conv8(kv, MQK, tok0 + s, 64 * c + s, 512 + h * 128 + d0, wc, bc, ML_KSCALE);
        float vv[8]; unpack8(*(const pg8::u32x4*)(MV + (tok0 + s) * 512 + h * 128 + d0), vv);
        const float w = wsm[s];
#pragma unroll
        for (int i = 0; i < 8; ++i) {
            *(__attribute__((address_space(3))) bf16_t*)(KT + (d0 + i) * 144 + s * 2) = f2bf(kv[i]);
            *(__attribute__((address_space(3))) bf16_t*)(VTw + (d0 + i) * 144 + s * 2) = f2bf(vv[i] * w);
        }
    }
    __syncthreads();
    if (tx < 128) {
        float a = 0.f;
        for (int s = 0; s < 64; ++s) a += wsm[s] * bf2f(*(const __attribute__((address_space(3))) bf16_t*)(KT + tx * 144 + s * 2));
        dn[((size_t)bh * 64 + c) * 128 + tx] = a;
    }
    {
        const int vb = wave >> 1, kh = wave & 1;
        f32x16 acc0, acc1;
#pragma unroll
        for (int r = 0; r < 16; ++r) { acc0[r] = 0.f; acc1[r] = 0.f; }
#pragma unroll
        for (int ks = 0; ks < 4; ++ks) {
            const bf16x8 a = *(const __attribute__((address_space(3))) bf16x8*)(VTw + (vb * 32 + r32) * 144 + ks * 32 + hi * 16);
            const bf16x8 b0 = *(const __attribute__((address_space(3))) bf16x8*)(KT + (kh * 64 + r32) * 144 + ks * 32 + hi * 16);
            const bf16x8 b1 = *(const __attribute__((address_space(3))) bf16x8*)(KT + (kh * 64 + 32 + r32) * 144 + ks * 32 + hi * 16);
            acc0 = MFMA32(a, b0, acc0); acc1 = MFMA32(a, b1, acc1);
        }
        bf16_t* o = dC + ((size_t)bh * 64 + c) * 16384;
#pragma unroll
        for (int r = 0; r < 16; ++r) { const int v = vb * 32 + crow(r, hi);
            o[v * 128 + kh * 64 + r32] = f2bf(acc0[r]); o[v * 128 + kh * 64 + 32 + r32] = f2bf(acc1[r]); }
    }
}
DI void ml_scan(int gtid, int nthreads, bf16_t* __restrict__ dC, float* __restrict__ dn, const float* __restrict__ wprev, const float* __restrict__ wsc) {
    for (int p = gtid; p < 16 * 8192; p += nthreads) {
        const int bh = p >> 13, e2 = p & 8191;
        unsigned* base = (unsigned*)(dC + (size_t)bh * 64 * 16384) + e2;
        float r0 = 0.f, r1 = 0.f;
#pragma unroll 1
        for (int c0 = 0; c0 < 64; c0 += 16) {
            unsigned v[16];
#pragma unroll
            for (int j = 0; j < 16; ++j) v[j] = base[(size_t)(c0 + j) * 8192];
#pragma unroll
            for (int j = 0; j < 16; ++j) {
                const float w = wprev[bh * 64 + c0 + j], sc = wsc[bh * 64 + c0 + j];
                base[(size_t)(c0 + j) * 8192] = pk2(r0, r1);
                r0 = w * r0 + sc * __uint_as_float(v[j] << 16); r1 = w * r1 + sc * __uint_as_float(v[j] & 0xffff0000u);
            }
        }
    }
    for (int p = gtid; p < 16 * 128; p += nthreads) {
        const int bh = p >> 7, k = p & 127; float r = 0.f; float* q = dn + (size_t)bh * 64 * 128 + k;
#pragma unroll 1
        for (int c0 = 0; c0 < 64; c0 += 16) {
            float v[16];
#pragma unroll
            for (int j = 0; j < 16; ++j) v[j] = q[(c0 + j) * 128];
#pragma unroll
            for (int j = 0; j < 16; ++j) { q[(c0 + j) * 128] = r; r = wprev[bh * 64 + c0 + j] * r + wsc[bh * 64 + c0 + j] * v[j]; }
        }
    }
}
DI void ml_unit_e(int bh, int c, int tx, lds_c* lds, const bf16_t* __restrict__ MQK, const bf16_t* __restrict__ MV, const bf16_t* __restrict__ MO, const float* __restrict__ ifp,
                  const float* __restrict__ wc, const float* __restrict__ bc, const bf16_t* __restrict__ Sst, const float* __restrict__ nst, const float* __restrict__ mtab, const float* __restrict__ g_hn, bf16_t* __restrict__ Y) {
    const int b = bh >> 2, h = bh & 3, lane = tx & 63, r32 = lane & 31, hi = lane >> 5, wave = __builtin_amdgcn_readfirstlane(tx >> 6);
    lds_c* Qi = lds; lds_c* Ki = lds + 64 * 272; lds_c* VTi = lds + 2 * 64 * 272; lds_c* Si = VTi + 128 * 136;
    __attribute__((address_space(3))) float* fsm = (__attribute__((address_space(3))) float*)(Si + 128 * 272);
    const size_t tok0 = (size_t)b * SEQ + 64 * c;
    const float m_c = mtab[bh * 65 + c];
    __syncthreads();
    if (wave == 0) {
        const float iv = ifp[(tok0 + lane) * 8 + h], lf = log_sigmoid_(ifp[(tok0 + lane) * 8 + 4 + h]);
        const int l_ = lane_id_opaque();
        const float bc_ = lane_shr_add(lf, l_), u = iv - bc_, M = fmaxf(lane_shr_max(u, l_), m_c);
        fsm[lane] = u; fsm[64 + lane] = M; fsm[128 + lane] = __expf(-(bc_ + M));
    }
    if (wave == 1) { fsm[192 + lane] = nst[((size_t)bh * 64 + c) * 128 + lane]; fsm[192 + 64 + lane] = nst[((size_t)bh * 64 + c) * 128 + 64 + lane]; }
#pragma unroll 1
    for (int it = tx; it < 1024; it += 512) {
        const int s = it >> 4, d0 = (it & 15) * 8; float qv[8], kv[8];
        ml_conv8(qv, MQK, tok0 + s, 64 * c + s, h * 128 + d0, wc, bc, 1.f);
        ml_conv8(kv, MQK, tok0 + s, 64 * c + s, 512 + h * 128 + d0, wc, bc, ML_KSCALE);
        *(__attribute__((address_space(3))) pg8::u32x4*)(Qi + s * 272 + d0 * 2) = pack8(qv);
        *(__attribute__((address_space(3))) pg8::u32x4*)(Ki + s * 272 + d0 * 2) = pack8(kv);
        const pg8::u32x4 vw = *(const pg8::u32x4*)(MV + (tok0 + s) * 512 + h * 128 + d0);
        __attribute__((address_space(3))) bf16_t* vt = (__attribute__((address_space(3))) bf16_t*)(VTi + d0 * 136 + s * 2);
        vt[0] = (bf16_t)(vw.x & 0xffffu); vt[68] = (bf16_t)(vw.x >> 16); vt[136] = (bf16_t)(vw.y & 0xffffu); vt[204] = (bf16_t)(vw.y >> 16);
        vt[272] = (bf16_t)(vw.z & 0xffffu); vt[340] = (bf16_t)(vw.z >> 16); vt[408] = (bf16_t)(vw.w & 0xffffu); vt[476] = (bf16_t)(vw.w >> 16);
    }
    {
        const bf16_t* src = Sst + ((size_t)bh * 64 + c) * 16384;
#pragma unroll
        for (int j = 0; j < 4; ++j) { const int ch = tx + 512 * j, v = ch >> 4, k8 = (ch & 15) * 8;
            *(__attribute__((address_space(3))) pg8::u32x4*)(Si + v * 272 + k8 * 2) = *(const pg8::u32x4*)(src + v * 128 + k8); }
    }
    __syncthreads();
    const int tb = wave & 1, vb = wave >> 1, t = tb * 32 + r32;
    bf16x8 qf[8];
#pragma unroll
    for (int ks = 0; ks < 8; ++ks) qf[ks] = *(const __attribute__((address_space(3))) bf16x8*)(Qi + t * 272 + ks * 32 + hi * 16);
    f32x16 a0, a1;
#pragma unroll
    for (int r = 0; r < 16; ++r) { a0[r] = 0.f; a1[r] = 0.f; }
#pragma unroll
    for (int ks = 0; ks < 8; ++ks) {
        const bf16x8 k0 = *(const __attribute__((address_space(3))) bf16x8*)(Ki + r32 * 272 + ks * 32 + hi * 16);
        const bf16x8 k1 = *(const __attribute__((address_space(3))) bf16x8*)(Ki + (32 + r32) * 272 + ks * 32 + hi * 16);
        a0 = MFMA32(k0, qf[ks], a0); a1 = MFMA32(k1, qf[ks], a1);
    }
    const float Mt = fsm[64 + t], dec = __expf(m_c - Mt);
    float rs = 0.f;
#pragma unroll
    for (int r = 0; r < 16; ++r) {
        const int s0 = crow(r, hi), s1 = 32 + s0;
        a0[r] = s0 <= t ? __expf(fsm[s0] - Mt) * a0[r] : 0.f; a1[r] = s1 <= t ? __expf(fsm[s1] - Mt) * a1[r] : 0.f;
        rs += a0[r] + a1[r];
    }
    float nq = 0.f;
#pragma unroll
    for (int ks = 0; ks < 8; ++ks) { float qv[8]; unpack8(__builtin_bit_cast(pg8::u32x4, qf[ks]), qv);
#pragma unroll
        for (int j = 0; j < 8; ++j) nq += qv[j] * fsm[192 + ks * 16 + hi * 8 + j]; }
    float den = rs + dec * nq;
    { auto rr = __builtin_amdgcn_permlane32_swap(__float_as_uint(den), __float_as_uint(den), false, false); den = __uint_as_float(rr[0]) + __uint_as_float(rr[1]); }
    f32x16 n1, n2;
#pragma unroll
    for (int r = 0; r < 16; ++r) { n1[r] = 0.f; n2[r] = 0.f; }
#pragma unroll
    for (int hf = 0; hf < 2; ++hf)
#pragma unroll
        for (int ss = 0; ss < 2; ++ss) {
            unsigned pw[4];
#pragma unroll
            for (int j = 0; j < 4; ++j) pw[j] = hf ? cvtpk(a1[8 * ss + 2 * j], a1[8 * ss + 2 * j + 1]) : cvtpk(a0[8 * ss + 2 * j], a0[8 * ss + 2 * j + 1]);
            const u32x4v pbw = {pw[0], pw[1], pw[2], pw[3]};
            const lds_c* vp = VTi + (vb * 32 + r32) * 136 + hf * 64 + ss * 32 + hi * 8;
            const u32x2v lo = *(const __attribute__((address_space(3))) u32x2v*)vp, hi2 = *(const __attribute__((address_space(3))) u32x2v*)(vp + 16);
            const u32x4v aw = {lo.x, lo.y, hi2.x, hi2.y};
            n1 = MFMA32(__builtin_bit_cast(bf16x8, aw), __builtin_bit_cast(bf16x8, pbw), n1);
        }
#pragma unroll
    for (int ks = 0; ks < 8; ++ks) {
        const bf16x8 sa = *(const __attribute__((address_space(3))) bf16x8*)(Si + (vb * 32 + r32) * 272 + ks * 32 + hi * 16);
        n2 = MFMA32(sa, qf[ks], n2);
    }
    const float inv = 1.f / fmaxf(fabsf(den), fsm[128 + t]);
    const bf16_t* op = MO + (tok0 + t) * 512 + h * 128 + vb * 32;
    float hv[16]; float ssq = 0.f;
#pragma unroll
    for (int i = 0; i < 4; ++i) {
        const u32x2v ow = *(const u32x2v*)(op + 8 * i + 4 * hi);
        const float o4[4] = {__uint_as_float(ow.x << 16), __uint_as_float(ow.x & 0xffff0000u), __uint_as_float(ow.y << 16), __uint_as_float(ow.y & 0xffff0000u)};
#pragma unroll
        for (int j = 0; j < 4; ++j) { const float x = (n1[4 * i + j] + dec * n2[4 * i + j]) * inv * sigmoidf_(o4[j]); hv[4 * i + j] = x; ssq += x * x; }
    }
    { auto rr = __builtin_amdgcn_permlane32_swap(__float_as_uint(ssq), __float_as_uint(ssq), false, false); ssq = __uint_as_float(rr[0]) + __uint_as_float(rr[1]); }
    if (hi == 0) fsm[320 + t * 4 + vb] = ssq;
    __syncthreads();
    const float tot = (fsm[320 + t * 4] + fsm[320 + t * 4 + 1]) + (fsm[320 + t * 4 + 2] + fsm[320 + t * 4 + 3]);
    const float rstd = rsqrtf(tot * (1.f / 128.f) + 1e-6f);
    bf16_t* yp = Y + (tok0 + t) * DM + 512 + h * 128 + vb * 32; const float* gp = g_hn + h * 128 + vb * 32;
#pragma unroll
    for (int i = 0; i < 4; ++i) {
        const float4 gg = *(const float4*)(gp + 8 * i + 4 * hi);
        *(u32x2v*)(yp + 8 * i + 4 * hi) = (u32x2v){cvtpk(hv[4 * i] * rstd * gg.x, hv[4 * i + 1] * rstd * gg.y), cvtpk(hv[4 * i + 2] * rstd * gg.z, hv[4 * i + 3] * rstd * gg.w)};
    }
}

DI void cmp_unit(int kv, int bg, int jt, int tx, lds_c* lds, const bf16_t* __restrict__ KVb, const bf16_t* __restrict__ W1t, const bf16_t* __restrict__ W2t, const float* __restrict__ bias1p,
                 float* __restrict__ outf, bf16_t* __restrict__ kcb, bf16_t* __restrict__ vcT) {
    const int b = bg >> 1, g = bg & 1, lane = tx & 63, r32 = lane & 31, hi = lane >> 5, wave = __builtin_amdgcn_readfirstlane(tx >> 6), j0 = jt * 32;
    lds_c* TI = lds; lds_c* H1 = lds + 16 * 34 * 144;
    const bf16_t* src = KVb + ((size_t)b * SEQ + 16 * j0) * 512 + (kv ? 128 : 0) + g * 64;
    __syncthreads();
    for (int ch = tx; ch < 528 * 8; ch += 512) {
        const int t = ch >> 3, c8 = ch & 7;
        *(__attribute__((address_space(3))) pg8::u32x4*)(TI + ((t & 15) * 34 + (t >> 4)) * 144 + c8 * 16) = *(const pg8::u32x4*)(src + (size_t)t * 512 + c8 * 8);
    }
    __syncthreads();
    f32x16 acc;
#pragma unroll
    for (int r = 0; r < 16; ++r) acc[r] = 0.f;
    const bf16_t* wrow = W1t + (size_t)(wave * 32 + r32) * 2048 + hi * 8;
#pragma unroll 4
    for (int i = 0; i < 32; ++i) {
        const lds_c* arow = TI + ((i & 15) * 34 + r32 + (i >> 4)) * 144 + hi * 16;
#pragma unroll
        for (int dk = 0; dk < 4; ++dk) {
            const bf16x8 a = *(const __attribute__((address_space(3))) bf16x8*)(arow + dk * 32);
            const bf16x8 bfr = *(const bf16x8*)(wrow + i * 64 + dk * 16);
            acc = MFMA32(a, bfr, acc);
        }
    }
    {
        const int n = wave * 32 + r32; const float bias = bias1p[kv * 256 + n];
#pragma unroll
        for (int r = 0; r < 16; ++r) *(__attribute__((address_space(3))) bf16_t*)(H1 + crow(r, hi) * 528 + n * 2) = f2bf(gelu_tanh(acc[r] + bias));
    }
    __syncthreads();
    if (wave < 2) {
        f32x16 o;
#pragma unroll
        for (int r = 0; r < 16; ++r) o[r] = 0.f;
        const bf16_t* w2row = W2t + (size_t)(wave * 32 + r32) * 256 + hi * 8;
#pragma unroll
        for (int ks = 0; ks < 16; ++ks) {
            const bf16x8 a = *(const __attribute__((address_space(3))) bf16x8*)(H1 + r32 * 528 + ks * 32 + hi * 16);
            const bf16x8 bfr = *(const bf16x8*)(w2row + ks * 16);
            o = MFMA32(a, bfr, o);
        }
        const int d = wave * 32 + r32;
#pragma unroll
        for (int r = 0; r < 16; ++r) {
            const int j = j0 + crow(r, hi); const float v = j < 255 ? o[r] : 0.f;
            outf[((size_t)bg * 256 + j) * 64 + d] = v;
            if (kv == 0) kcb[((size_t)bg * 256 + j) * 64 + d] = f2bf(v);
            else vcT[((size_t)bg * 4 + (j >> 6)) * 4096 + d * 64 + (j & 63)] = f2bf(v);
        }
    }
}

#define XB_TMO      128
#define XB_XCNT(j)  (256  + 64 * (j))
#define XB_XSUB(j)  (1280 + 64 * (j))
#define XB_XGEN(j)  (2304 + 64 * (j))
#define XB_TOP      3328
#define XB_TOPGEN   3392
#define XCD_BAR_WORDS 3456
#define XB_SPIN_CAP (1u << 23)

__device__ __forceinline__ unsigned xb_ld(unsigned* p)              { return __hip_atomic_load(p, __ATOMIC_RELAXED, __HIP_MEMORY_SCOPE_AGENT); }
__device__ __forceinline__ unsigned xb_add(unsigned* p, unsigned v) { return __hip_atomic_fetch_add(p, v, __ATOMIC_RELAXED, __HIP_MEMORY_SCOPE_AGENT); }
__device__ __forceinline__ unsigned xb_xcc_id() { return (unsigned)__builtin_amdgcn_s_getreg((3 << 11) | 20) & 0xFu; }
#define XB_SPIN(cond, bar) do { unsigned _sp = 0; while (cond) { __builtin_amdgcn_s_sleep(1); \
    if ((++_sp & 255u) == 0u) { if (xb_ld(&(bar)[XB_TMO])) break; if (_sp > XB_SPIN_CAP) { atomicAdd(&(bar)[XB_TMO], 1u); break; } } } } while (0)

struct XcdBarrier {
    unsigned* bar; unsigned x;
    volatile __attribute__((address_space(3))) unsigned* st;
};

__device__ __forceinline__ XcdBarrier xcd_barrier_post(unsigned* bar, volatile __attribute__((address_space(3))) unsigned* st) {
    XcdBarrier b; b.bar = bar; b.x = xb_xcc_id(); b.st = st;
    if (threadIdx.x == 0) (void)xb_add(&bar[XB_XCNT(b.x)], 1u);
    return b;
}
__device__ __forceinline__ void xcd_barrier_complete(unsigned* bar, unsigned x, unsigned& nloc, unsigned& nx) {
    const unsigned G = gridDim.x * gridDim.y * gridDim.z;
    unsigned sum, cnt, mine, sp = 0u;
    for (;;) {
        sum = 0u; cnt = 0u; mine = 0u;
#pragma unroll
        for (unsigned j = 0; j < 16; ++j) { const unsigned c = xb_ld(&bar[XB_XCNT(j)]); sum += c; cnt += (c > 0u) ? 1u : 0u; mine = (j == x) ? c : mine; }
        if (sum == G) break;
        __builtin_amdgcn_s_sleep(1);
        if ((++sp & 255u) == 0u) { if (xb_ld(&bar[XB_TMO])) break; if (sp > XB_SPIN_CAP) { atomicAdd(&bar[XB_TMO], 1u); break; } }
    }
    nloc = mine > 0u ? mine : 1u; nx = cnt > 0u ? cnt : 1u;
}

__device__ __forceinline__ void xcd_barrier(const XcdBarrier& b) {
    asm volatile("s_waitcnt vmcnt(0)" ::: "memory");
    __syncthreads();
    if (threadIdx.x == 0) {
        unsigned* bar = b.bar;
        __builtin_amdgcn_s_waitcnt(0);
        unsigned nloc = b.st[0], nx = b.st[1];
        if (nloc == 0u) { xcd_barrier_complete(bar, b.x, nloc, nx); b.st[0] = nloc; b.st[1] = nx; }
        const unsigned old = xb_add(&bar[XB_XSUB(b.x)], 1u);
        const unsigned gen = old / nloc;
        if (old + 1u == (gen + 1u) * nloc) {
            __builtin_amdgcn_fence(__ATOMIC_RELEASE, "agent");
            asm volatile("s_waitcnt vmcnt(0)" ::: "memory");
            const unsigned og = xb_add(&bar[XB_TOP], 1u);
            const unsigned tg = og / nx;
            if (og + 1u == (tg + 1u) * nx) xb_add(&bar[XB_TOPGEN], 1u);
            else XB_SPIN(xb_ld(&bar[XB_TOPGEN]) == tg, bar);
            __builtin_amdgcn_fence(__ATOMIC_ACQUIRE, "agent");
            xb_add(&bar[XB_XGEN(b.x)], 1u);
            asm volatile("s_waitcnt vmcnt(0)" ::: "memory");
        } else {
            XB_SPIN(xb_ld(&bar[XB_XGEN(b.x)]) == gen, bar);
            __builtin_amdgcn_fence(__ATOMIC_ACQUIRE, "agent");
            asm volatile("s_waitcnt vmcnt(0)" ::: "memory");
        }
    }
    __syncthreads();
}

#ifndef NSA_CHECK
#define NSA_CHECK 0
#endif
#ifndef REP_MASK
#define REP_MASK 0u
#endif
struct Args { const float* in[29]; float* out; char* ws; unsigned rep_mask; unsigned pad; };
constexpr int LDS_BYTES = 147456;

__global__ __launch_bounds__(512, 2) void mk_fwd(Args a) {
    extern __shared__ __attribute__((aligned(16))) char lds_raw[];
    cg::grid_group grid = cg::this_grid();
    const int NB = gridDim.x * 2, NGW = gridDim.x * 8;
    const unsigned repm = a.rep_mask;
    volatile __attribute__((address_space(3))) unsigned* bar_st = (volatile __attribute__((address_space(3))) unsigned*)((lds_c*)lds_raw + (LDS_BYTES - 64));
    if (threadIdx.x < 2) bar_st[threadIdx.x] = 0u;
    __syncthreads();
    const XcdBarrier xbar = xcd_barrier_post((unsigned*)(a.ws + ((size_t)42 << 20) + 65536), bar_st);
#define GRID_BAR() xcd_barrier(xbar)
#ifndef SPIN_PHASE_UNUSED_
#endif
    unsigned long long ts_prev_ = 0ull, ts_probe_ = 0ull; int n_stamp_ = 0;
#define STAMP() do { if (SPIN_PHASE >= 0 && blockIdx.x == 0) { const unsigned long long now_ = __builtin_amdgcn_s_memrealtime(); if (n_stamp_ == SPIN_PHASE) ts_probe_ = now_ - ts_prev_; ts_prev_ = now_; ++n_stamp_; } } while (0)
    if (SPIN_PHASE >= 0 && blockIdx.x == 0) ts_prev_ = __builtin_amdgcn_s_memrealtime();
    const int wave_s_ = __builtin_amdgcn_readfirstlane(threadIdx.x >> 6);
#define KARG(T, off) (*(T const __attribute__((address_space(4)))*)(kargs_ + (off)))
#define PTRS const float* x = KARG(const float*, 8 * 0); const float* p = KARG(const float*, 8 * 1); const int* pos = KARG(const int*, 16); \
    const float* g_mix = KARG(const float*, 8 * 3); const float* w_in = KARG(const float*, 8 * 4); const float* b_if = KARG(const float*, 8 * 5); \
    const float* w_ck1 = KARG(const float*, 8 * 6); const float* w_ck2 = KARG(const float*, 8 * 7); const float* pe_ck = KARG(const float*, 8 * 8); \
    const float* w_cv1 = KARG(const float*, 8 * 9); const float* w_cv2 = KARG(const float*, 8 * 10); const float* pe_cv = KARG(const float*, 8 * 11); \
    const float* w_conv = KARG(const float*, 8 * 12); const float* b_conv = KARG(const float*, 8 * 13); const float* g_hn = KARG(const float*, 8 * 14); \
    const float* w_pa = KARG(const float*, 8 * 15); const float* w_pb = KARG(const float*, 8 * 16); const float* w_out = KARG(const float*, 8 * 17); \
    const float* g_ffn = KARG(const float*, 8 * 18); const float* w_rg = KARG(const float*, 8 * 19); const float* b_rg = KARG(const float*, 8 * 20); \
    const float* w_re = KARG(const float*, 8 * 21); const float* b_re = KARG(const float*, 8 * 22); const float* w_e13 = KARG(const float*, 8 * 23); \
    const float* w_e2 = KARG(const float*, 8 * 24); const float* g_ple = KARG(const float*, 8 * 25); const float* w_pg = KARG(const float*, 8 * 26); \
    const float* w_pp = KARG(const float*, 8 * 27); const float* g_final = KARG(const float*, 8 * 28); \
    float* out = KARG(float*, 232); char* ws = KARG(char*, 240); \
    const size_t MiB = 1u << 20; \
    bf16_t* Wt_in = (bf16_t*)(ws); \
    bf16_t* xb = (bf16_t*)(ws + 48 * MiB); \
    bf16_t* Qb = (bf16_t*)(ws + 80 * MiB); \
    bf16_t* KVb = (bf16_t*)(ws + 96 * MiB); bf16_t* VT = (bf16_t*)(ws + 112 * MiB); bf16_t* kcb = (bf16_t*)(ws + 249 * MiB + 512 * 1024); bf16_t* vcT = (bf16_t*)(ws + 249 * MiB + 768 * 1024); \
    bf16_t* MQK = (bf16_t*)(ws + 120 * MiB); \
    bf16_t* MV = (bf16_t*)(ws + 152 * MiB); \
    bf16_t* MO = (bf16_t*)(ws + 168 * MiB); \
    bf16_t* MG = (bf16_t*)(ws + 184 * MiB); \
    float* gates = (float*)(ws + 248 * MiB); \
    float* ifp = (float*)(ws + 250 * MiB); \
    float* kcc = (float*)(ws + 251 * MiB); \
    float* vcc = (float*)(ws + 252 * MiB); \
    float* gate16 = (float*)(ws + 253 * MiB); \
    float* rstd0 = (float*)(ws + 254 * MiB); \
    float* cosT = (float*)(ws + 254 * MiB + 512 * 1024); \
    float* sinT = (float*)(ws + 255 * MiB); \
    bf16_t* Y = (bf16_t*)(out + (size_t)8 * 1024 * 1024); \
    bf16_t* dC = xb; float* dn = (float*)(ws + 250 * MiB + 512 * 1024); float* wprev = (float*)(ws + 42 * MiB + 4096); float* mtab = (float*)(ws + 42 * MiB + 8192); float* wsc = (float*)(ws + 42 * MiB + 16384); \
    float* tmp = (float*)(ws + 120 * MiB); bf16_t* mixed = xb; \
    bf16_t* Wpa_t = (bf16_t*)(ws + 11 * MiB); bf16_t* Wpb_t = (bf16_t*)(ws + 12 * MiB); bf16_t* Wout_t = (bf16_t*)(ws + 13 * MiB); \
    bf16_t* We13_t = (bf16_t*)(ws + 15 * MiB); bf16_t* We2_t = (bf16_t*)(ws + 31 * MiB); bf16_t* Wpg_t = (bf16_t*)(ws + 39 * MiB); bf16_t* Wpp_t = (bf16_t*)(ws + 41 * MiB); \
    int* cnt = (int*)(ws + 42 * MiB); bf16_t* W1t_k = (bf16_t*)(ws + 43 * MiB); bf16_t* W1t_v = (bf16_t*)(ws + 44 * MiB); bf16_t* W2t_k = (bf16_t*)(ws + 45 * MiB); bf16_t* W2t_v = (bf16_t*)(ws + 45 * MiB + 65536); float* bias1p = (float*)(ws + 45 * MiB + 524288); \
    bf16_t* x1b = (bf16_t*)(ws + 48 * MiB); bf16_t* act = (bf16_t*)(ws + 120 * MiB); bf16_t* y2 = (bf16_t*)(ws + 138 * MiB); bf16_t* x2b = (bf16_t*)(ws + 210 * MiB); int* elist = (int*)(ws + 242 * MiB); \
    bf16_t* pb = (bf16_t*)(ws + 80 * MiB); bf16_t* PP = (bf16_t*)(ws + 88 * MiB); \
    int* rinfo = (int*)(ws + 253 * MiB); float* rstd1 = (float*)(ws + 253 * MiB + 512 * 1024); float* rstd2 = (float*)(ws + 253 * MiB + 768 * 1024); \
    (void)x; (void)p; (void)pos; (void)g_mix; (void)w_in; (void)b_if; (void)w_ck1; (void)w_ck2; (void)pe_ck; (void)w_cv1; (void)w_cv2; (void)pe_cv; (void)w_conv; (void)b_conv; (void)g_hn; (void)w_pa; (void)w_pb; (void)w_out; (void)g_ffn; (void)w_rg; (void)b_rg; (void)w_re; (void)b_re; (void)w_e13; (void)w_e2; (void)g_ple; (void)w_pg; (void)w_pp; (void)g_final;
#define PHASE(k) for (int rep_ = 0; rep_ < 1 + (int)((repm >> (k)) & 1u); ++rep_)
#define PHASE_IDS unsigned tx_ = (unsigned)(wave_s_ * 64); asm volatile("" : "+v"(tx_)); tx_ = (unsigned)__builtin_amdgcn_mbcnt_hi(-1, __builtin_amdgcn_mbcnt_lo(-1, (int)tx_)); const int half = tx_ >> 8, tid = tx_ & 255, lane64 = tx_ & 63, tid512 = (int)tx_; \
    const int wave = __builtin_amdgcn_readfirstlane(tx_ >> 6); char* sm = lds_raw + half * 65536; const int gw = blockIdx.x * 8 + wave; (void)tid; (void)lane64; (void)sm; (void)gw; (void)tid512; \
    const __attribute__((address_space(4))) char* kargs_ = (const __attribute__((address_space(4))) char*)__builtin_amdgcn_kernarg_segment_ptr(); asm volatile("" : "+s"(kargs_)); PTRS
#define VB_LOOP(nvb) for (int vb = blockIdx.x * 2 + half; vb < (nvb); vb += NB)
#define GEMM_PHASE(NT, MT, ...) do { VB_LOOP((NT) * (MT)) { const int bx_ = vb % (NT), by_ = vb / (NT); __syncthreads(); gemm_v1(bx_, by_, tid, sm, __VA_ARGS__); } } while (0)
    PHASE(0) { PHASE_IDS
        float* scr = (float*)(lds_raw + wave * 8448);
        for (int it = gw; it < (DM / 64) * (NIN / 32); it += NGW) prep_wt_item(w_in, DIN, DM, Wt_in, g_mix, MapIn{}, scr, it, NIN / 32, lane64);
        for (int it = gw; it < 2 * 256; it += NGW) { const int kv = it >> 8; prep_wt_item(kv ? w_cv1 : w_ck1, 256, 2048, kv ? W1t_v : W1t_k, (const float*)nullptr, MapId{}, scr, it & 255, 8, lane64); }
        for (int it = gw; it < 2 * 8; it += NGW) { const int kv = it >> 3; prep_wt_item(kv ? w_cv2 : w_ck2, 64, 256, kv ? W2t_v : W2t_k, (const float*)nullptr, MapId{}, scr, it & 7, 2, lane64); }
        if (gw < 512) {
            const int kv = gw >> 8, n = gw & 255; const float* w1 = kv ? w_cv1 : w_ck1; const float* pe = kv ? pe_cv : pe_ck; float a = 0.f;
#pragma unroll
            for (int i = 0; i < 32; ++i) { const int k = lane64 + 64 * i; a += pe[k] * w1[(size_t)k * 256 + n]; }
            a = wave_sum(a);
            if (lane64 == 0) bias1p[gw] = a;
        }
        if (blockIdx.x == 0 && tid512 < 16) cnt[tid512 * CNT_STRIDE] = 0;
        for (int r = gw; r < T_TOK; r += NGW) prep_x_row(x, xb, rstd0, r, lane64);
        for (int i = blockIdx.x * 512 + tid512; i < T_TOK * 8; i += gridDim.x * 512) {
            const float inv = powf(500000.0f, -(float)(2 * (i & 7)) / 16.0f); float sn, cs; sincosf((float)pos[i >> 3] * inv, &sn, &cs); cosT[i] = cs; sinT[i] = sn; }
    }
    if (repm == 0x80000000u) grid.sync();
    GRID_BAR(); STAMP();
    PHASE(1) { PHASE_IDS
        pg8::Gemm g{xb, Wt_in, T_TOK, NIN, DM, DM, DM}; pg8::StaticOrder S; S.init(T_TOK, NIN, (int)gridDim.x, (int)blockIdx.x);
        EpiInProj E{rstd0, cosT, sinT, b_if, Qb, KVb, gates, ifp, MQK, MV, MO, MG, VT};
        pg8::gemm_phase<EpiInProj, pg8::StaticOrder, true, true>((PG8_LAS unsigned char*)lds_raw, g, S, E, tid512);
    }
    {   PHASE_IDS
        const int G_ = (int)gridDim.x, nfull_ = (64 * (NIN / 256)) % G_;
        const int nl_ = G_ - nfull_, lw_ = (int)blockIdx.x - nfull_;
        if (nfull_ == 0 || lw_ >= 0) {
            const int lgw = (nfull_ == 0 ? (int)blockIdx.x : lw_) * 8 + wave, LNGW = (nfull_ == 0 ? G_ : nl_) * 8;
            float* scr = (float*)(lds_raw + wave * 8448); float* scr2 = (float*)(lds_raw + wave * 16896); (void)scr;
            __syncthreads();
            for (int it = lgw; it < 16 * 128; it += LNGW) { const int e = it >> 7, i2 = (it & 127) * 2; const float* w_ = w_e13 + (size_t)e * 1024 * 512; bf16_t* t_ = We13_t + (size_t)e * 512 * 1024;
                prep_wt_item2(w_, w_, 512, DM, t_, t_, g_ffn, MapE13{}, scr2, i2, i2 + 1, 16, lane64); }
            if ((int)gridDim.x != 256) {
                for (int it = lgw; it < 8 * 32; it += LNGW) prep_wt_item(w_pa, DM, DM, Wpa_t, (const float*)nullptr, MapId{}, scr, it, 32, lane64);
                for (int it = lgw; it < 8 * 32; it += LNGW) prep_wt_item(w_pb, DM, DM, Wpa_t + 512, (const float*)nullptr, MapId{}, scr, it, 32, lane64);
                for (int it = lgw; it < 16 * 32; it += LNGW) prep_wt_item(w_out, DM, DM, Wout_t, (const float*)nullptr, MapId{}, scr, it, 32, lane64);
                for (int it = lgw; it < 16 * 32; it += LNGW) prep_wt_item(w_pg, DM, DM, Wpg_t, g_ple, MapId{}, scr, it, 32, lane64);
                for (int it = lgw; it < 4 * 32; it += LNGW) prep_wt_item(w_pp, DM, 256, Wpp_t, (const float*)nullptr, MapId{}, scr, it, 32, lane64);
                for (int it = lgw; it < 16 * 64; it += LNGW) { const int e = it >> 6, i2 = (it & 63) * 2; const float* w_ = w_e2 + (size_t)e * 256 * 1024; bf16_t* t_ = We2_t + (size_t)e * 1024 * 256;
                prep_wt_item2(w_, w_, DM, 256, t_, t_, (const float*)nullptr, MapId{}, scr2, i2, i2 + 1, 32, lane64); }
            }
        }
    }
    GRID_BAR(); STAMP();
    PHASE(2) { PHASE_IDS
        for (int u = blockIdx.x; u < 128; u += gridDim.x) { const int kv = u >> 6, bg = (u >> 3) & 7, jt = u & 7;
            cmp_unit(kv, bg, jt, tid512, (lds_c*)lds_raw, KVb, kv ? W1t_v : W1t_k, kv ? W2t_v : W2t_k, bias1p, kv ? vcc : kcc, kcb, vcT); }
        { const int v_ = (int)blockIdx.x - 128; if (v_ >= 0 && v_ < 16 && wave == 0) ml_mscan_all(ifp, v_, lane64, mtab, wprev, wsc); }
    }
    PHASE(3) { PHASE_IDS
        { const int G_ = (int)gridDim.x, c_ = (int)blockIdx.x;
          if (G_ == 256) { const int n_ = c_ < 128 ? 3 : 5, first_ = c_ < 128 ? 3 * c_ : 384 + 5 * (c_ - 128);
              for (int u = first_; u < first_ + n_; ++u) ml_unit_c(u >> 6, u & 63, tid512, (lds_c*)lds_raw, MQK, MV, ifp, w_conv, b_conv, dC, dn, wprev, mtab); }
          else for (int u = c_; u < 1024; u += G_) ml_unit_c(u >> 6, u & 63, tid512, (lds_c*)lds_raw, MQK, MV, ifp, w_conv, b_conv, dC, dn, wprev, mtab); }
        if ((int)gridDim.x == 256 && (int)blockIdx.x >= 128) {
            const int lgw = ((int)blockIdx.x - 128) * 8 + wave, LNGW = 128 * 8; float* scr = (float*)(lds_raw + wave * 16896); float* scr2 = scr;
            __syncthreads();
            for (int it = lgw; it < 8 * 32; it += LNGW) prep_wt_item(w_pa, DM, DM, Wpa_t, (const float*)nullptr, MapId{}, scr, it, 32, lane64);
            for (int it = lgw; it < 8 * 32; it += LNGW) prep_wt_item(w_pb, DM, DM, Wpa_t + 512, (const float*)nullptr, MapId{}, scr, it, 32, lane64);
            for (int it = lgw; it < 16 * 32; it += LNGW) prep_wt_item(w_out, DM, DM, Wout_t, (const float*)nullptr, MapId{}, scr, it, 32, lane64);
            for (int it = lgw; it < 16 * 32; it += LNGW) prep_wt_item(w_pg, DM, DM, Wpg_t, g_ple, MapId{}, scr, it, 32, lane64);
            for (int it = lgw; it < 4 * 32; it += LNGW) prep_wt_item(w_pp, DM, 256, Wpp_t, (const float*)nullptr, MapId{}, scr, it, 32, lane64);
            for (int it = lgw; it < 16 * 64; it += LNGW) { const int e = it >> 6, i2 = (it & 63) * 2; const float* w_ = w_e2 + (size_t)e * 256 * 1024; bf16_t* t_ = We2_t + (size_t)e * 1024 * 256;
                prep_wt_item2(w_, w_, DM, 256, t_, t_, (const float*)nullptr, MapId{}, scr2, i2, i2 + 1, 32, lane64); }
        }
    }
    GRID_BAR(); STAMP();
    {   PHASE_IDS
        ml_scan(blockIdx.x * 512 + tid512, gridDim.x * 512, dC, dn, wprev, wsc);
    }
    GRID_BAR(); STAMP();
    PHASE(4) { PHASE_IDS
        for (int u = blockIdx.x; u < 1024; u += gridDim.x) ml_unit_e(u >> 6, u & 63, tid512, (lds_c*)lds_raw, MQK, MV, MO, ifp, w_conv, b_conv, dC, dn, mtab, g_hn, Y);
    }
    PHASE(5) { PHASE_IDS
        for (int pr = blockIdx.x; pr < 256; pr += gridDim.x) {
            nsa_unit(pr & 7, 63 - (pr >> 3), tid512, (lds_c*)lds_raw, Qb, KVb, VT, kcb, vcT, gates, Y, ts_probe_);
            nsa_unit(pr & 7, pr >> 3, tid512, (lds_c*)lds_raw, Qb, KVb, VT, kcb, vcT, gates, Y, ts_probe_);
        }
    }
#if NSA_CHECK
    {   PHASE_IDS
        bf16_t* Y2 = (bf16_t*)(ws + 120 * MiB); unsigned* stats = (unsigned*)(ws + 42 * MiB + 32768);
        if (blockIdx.x == 0 && tid512 == 0) { stats[0] = 0u; stats[1] = 0u; }
        grid.sync();
        float* kcc2 = (float*)(ws + 251 * MiB + 512 * 1024); float* vcc2 = (float*)(ws + 252 * MiB + 512 * 1024); bf16_t* dummy = (bf16_t*)(ws + 160 * MiB);
        VB_LOOP(4080) { const int j = vb % 255, r = vb / 255; compress_naive(j, r & 7, r >> 3, tid, sm, KVb, w_ck1, w_ck2, pe_ck, w_cv1, w_cv2, pe_cv, kcc2, vcc2, dummy, dummy + 1048576); }
        grid.sync();
        VB_LOOP(T_TOK * 2) nsa_naive(vb >> 1, vb & 1, tid, sm, Qb, KVb, VT, kcc2, vcc2, gates, Y2);
        grid.sync();
        unsigned c1 = 0, c2 = 0;
        for (size_t i = (size_t)blockIdx.x * 512 + tid512; i < (size_t)T_TOK * 512; i += (size_t)gridDim.x * 512) {
            const size_t o = (i >> 9) * DM + (i & 511); const float d = fabsf(bf2f(Y[o]) - bf2f(Y2[o])); c1 += d > 0.02f ? 1u : 0u; c2 += (d > 0.1f || !(d == d)) ? 1u : 0u; }
        if (c1) atomicAdd(stats, c1); if (c2) atomicAdd(stats + 1, c2);
    }
#endif
    GRID_BAR(); STAMP();
    PHASE(7) { PHASE_IDS
        pg8::StaticOrder S; S.init(T_TOK, DM, (int)gridDim.x, (int)blockIdx.x);
        pg8::Gemm g{Y, Wpa_t, T_TOK, DM, DM, DM, DM}; EpiMerge2 E{MG, mixed}; pg8::gemm_phase<EpiMerge2, pg8::StaticOrder, true, true>((PG8_LAS unsigned char*)lds_raw, g, S, E, tid512);
    }
    GRID_BAR(); STAMP();
    PHASE(9) { PHASE_IDS
        pg8::Gemm g{mixed, Wout_t, T_TOK, DM, DM, DM, DM}; pg8::StaticOrder S; S.init(T_TOK, DM, (int)gridDim.x, (int)blockIdx.x);
        EpiX1 E{x, out, x1b};
        pg8::gemm_phase<EpiX1, pg8::StaticOrder, true, true>((PG8_LAS unsigned char*)lds_raw, g, S, E, tid512);
    }
    GRID_BAR(); STAMP();
    {   PHASE_IDS
        unsigned long long& pacc = ts_probe_;
        RG_BEGIN(110)
        __attribute__((address_space(3))) float* Wl = (__attribute__((address_space(3))) float*)((lds_c*)lds_raw);
        __attribute__((address_space(3))) int* lcnt = (__attribute__((address_space(3))) int*)((lds_c*)lds_raw + 20 * 4096);
        __attribute__((address_space(3))) int* lri = lcnt + 32;
        for (int t = gw * 4; t < T_TOK; t += NGW * 4) {
            float4 pv[4];
#pragma unroll
            for (int j = 0; j < 4; ++j) pv[j] = ((const float4*)(p + (size_t)(t + j) * 256))[lane64];
#pragma unroll
            for (int j = 0; j < 4; ++j) { uint2 o; o.x = pk2(pv[j].x, pv[j].y); o.y = pk2(pv[j].z, pv[j].w); ((uint2*)(pb + (size_t)(t + j) * 256))[lane64] = o; } }
        __syncthreads(); router_stage(Wl, g_ffn, w_rg, w_re, tid512); if (tid512 < 16) lcnt[tid512] = 0; __syncthreads();
        RG_END(110)
        RG_BEGIN(111)
        for (int r_ = 0; r_ < T_TOK / (NGW * 4); ++r_) {
            int tk_[4]; f4v xv_[16];
#pragma unroll
            for (int g_ = 0; g_ < 4; ++g_) tk_[g_] = gw + NGW * (4 * r_ + g_);
            const int mytok_ = gw + NGW * (4 * r_ + (lane64 >> 4));
#pragma unroll
            for (int j = 0; j < 16; ++j) xv_[j] = *(const f4v*)(out + (size_t)mytok_ * DM + 4 * ((lane64 & 15) + 16 * j));
            router4(tk_, lane64, xv_, Wl, b_rg, b_re, rstd1, lcnt, lri + (wave * 8 + r_ * 4) * 4);
        }
        __syncthreads();
        RG_END(111)
        RG_BEGIN(112)
        if (tid512 < 16) lcnt[16 + tid512] = atomicAdd(cnt + tid512 * CNT_STRIDE, lcnt[tid512]);
        __syncthreads();
        { int i = 0; for (int t = gw; t < T_TOK; t += NGW, ++i) if (lane64 == 0) { __attribute__((address_space(3))) int* r = lri + (wave * 8 + i) * 4;
            const int e0 = r[0] & 255, e1 = (r[0] >> 8) & 255, q0 = (r[1] & 0xffff) + lcnt[16 + e0], q1 = (r[1] >> 16) + lcnt[16 + e1]; int4 ri; ri.x = r[0]; ri.y = q0 | (q1 << 16); ri.z = r[2]; ri.w = r[3];
            *(int4*)(rinfo + (size_t)t * 4) = ri; elist[e0 * T_TOK + q0] = t; elist[e1 * T_TOK + q1] = t; } }
        RG_END(112)
    }
    GRID_BAR(); STAMP();
    {
        int ntile_ = 0;
        {   PHASE_IDS
            for (int e = 0; e < 16; ++e) ntile_ += (cnt[e * CNT_STRIDE] + 255) >> 8; }
        const int G_ = (int)gridDim.x, c_ = (int)blockIdx.x, per_ = (G_ % 8 == 0) ? (ntile_ + 7) / 8 : 0;
#pragma unroll 1
        for (int rnd = 0; ; ++rnd) {
            int ti;
            if (per_ > 0 && per_ * 8 <= G_) { if (rnd > 0) break; ti = ((c_ >> 3) < per_) ? (c_ & 7) * per_ + (c_ >> 3) : ntile_; }
            else ti = c_ + rnd * G_;
            if (ti >= ntile_) break;
            {   PHASE_IDS
                MoeOrder S{cnt, 1, 1, ti}; pg8::Unit u; S.next(0, u);
                const int e = u.pn, nv = cnt[e * CNT_STRIDE] - u.aux * 256; const int* amap = elist + (size_t)e * T_TOK + u.aux * 256;
                pg8::Gemm g{x1b, We13_t, 0, 0, DM, DM, DM, amap, nv}; EpiSwiglu E{act, amap, nv, rstd1}; TwoUnits S2{u.pm, e * 2, u.aux};
                __syncthreads();
                pg8::gemm_phase<EpiSwiglu, TwoUnits, false, true, true>((PG8_LAS unsigned char*)lds_raw, g, S2, E, tid512);
                asm volatile("s_waitcnt vmcnt(0)" ::: "memory");
                __syncthreads();
                if (tid512 == 0) { __builtin_amdgcn_fence(__ATOMIC_ACQUIRE, "agent"); asm volatile("s_waitcnt vmcnt(0)" ::: "memory"); }
                __syncthreads();
            }
            {   PHASE_IDS
                MoeOrder S{cnt, 1, 1, ti}; pg8::Unit u; S.next(0, u);
                int k2_ = 256; asm volatile("" : "+s"(k2_));
                pg8::Gemm g{act, We2_t, 0, 0, k2_, k2_, k2_}; FourUnits S4{u.pm, u.pn * 4}; EpiStoreBf E{y2, DM, 3};
                pg8::gemm_phase<EpiStoreBf, FourUnits, true, true>((PG8_LAS unsigned char*)lds_raw, g, S4, E, tid512);
            }
        }
        {   unsigned* mq = (unsigned*)(a.ws + ((size_t)42 << 20) + 36864);
            volatile __attribute__((address_space(3))) unsigned* idw = (volatile __attribute__((address_space(3))) unsigned*)((lds_c*)lds_raw + (LDS_BYTES - 32));
#pragma unroll 1
            for (;;) {
                PHASE_IDS
                __syncthreads();
                if (tid512 == 0) idw[0] = __hip_atomic_fetch_add(mq, 1u, __ATOMIC_RELAXED, __HIP_MEMORY_SCOPE_AGENT);
                __syncthreads();
                const int up = (int)idw[0];
                if (up >= 256) break;
                pg8::Unit uu; uu.pm = up >> 2; uu.pn = up & 3; uu.aux = 0;
                int k2_ = 256; asm volatile("" : "+s"(k2_));
                pg8::Gemm g{pb, Wpp_t, T_TOK, DM, k2_, k2_, k2_}; EpiStoreBf E{PP, DM, 3}; OneUnit S1{uu};
                pg8::gemm_phase<EpiStoreBf, OneUnit, false, true>((PG8_LAS unsigned char*)lds_raw, g, S1, E, tid512);
            }
        }
    }
    GRID_BAR(); STAMP();
    {   PHASE_IDS
        __attribute__((address_space(3))) int* brow = (__attribute__((address_space(3))) int*)((lds_c*)lds_raw);
        __syncthreads();
        if (tid512 < 16) brow[tid512] = moe_base_row(cnt, tid512);
        __syncthreads();
#pragma unroll 1
        for (int t0 = gw * 4; t0 < T_TOK; t0 += NGW * 4) {
            int4 ri[4];
#pragma unroll
            for (int q = 0; q < 4; ++q) ri[q] = *(const int4*)(rinfo + (size_t)(t0 + q) * 4);
            float4 v[4][4]; uint2 ya[4][4], yb[4][4];
#pragma unroll
            for (int q = 0; q < 4; ++q) {
                const int rx = __builtin_amdgcn_readfirstlane(ri[q].x), ry = __builtin_amdgcn_readfirstlane(ri[q].y);
                const int r0 = brow[rx & 255] + (ry & 0xffff), r1 = brow[(rx >> 8) & 255] + ((ry >> 16) & 0xffff);
#pragma unroll
                for (int j = 0; j < 4; ++j) { v[q][j] = ((const float4*)(out + (size_t)(t0 + q) * DM))[lane64 + 64 * j];
                    ya[q][j] = ((const uint2*)(y2 + (size_t)r0 * DM))[lane64 + 64 * j]; yb[q][j] = ((const uint2*)(y2 + (size_t)r1 * DM))[lane64 + 64 * j]; }
            }
#pragma unroll
            for (int q = 0; q < 4; ++q) {
                const float w0 = __int_as_float(__builtin_amdgcn_readfirstlane(ri[q].z)), w1 = __int_as_float(__builtin_amdgcn_readfirstlane(ri[q].w)); float s2 = 0.f;
#pragma unroll
                for (int j = 0; j < 4; ++j) { const uint2 a0 = ya[q][j], a1 = yb[q][j]; float4 x_ = v[q][j];
                    x_.x += w0 * __uint_as_float(a0.x << 16) + w1 * __uint_as_float(a1.x << 16); x_.y += w0 * __uint_as_float(a0.x & 0xffff0000u) + w1 * __uint_as_float(a1.x & 0xffff0000u);
                    x_.z += w0 * __uint_as_float(a0.y << 16) + w1 * __uint_as_float(a1.y << 16); x_.w += w0 * __uint_as_float(a0.y & 0xffff0000u) + w1 * __uint_as_float(a1.y & 0xffff0000u);
                    s2 += x_.x * x_.x + x_.y * x_.y + x_.z * x_.z + x_.w * x_.w;
                    ((float4*)(out + (size_t)(t0 + q) * DM))[lane64 + 64 * j] = x_; uint2 o; o.x = pk2(x_.x, x_.y); o.y = pk2(x_.z, x_.w); ((uint2*)(x2b + (size_t)(t0 + q) * DM))[lane64 + 64 * j] = o; }
                s2 = wave_sum(s2);
                if (lane64 == 0) rstd2[t0 + q] = rsqrtf(s2 * (1.f / DM) + 1e-6f);
            }
        }
    }
    GRID_BAR(); STAMP();
    if ((int)gridDim.x == 256) {
        PHASE_IDS
        __syncthreads();
        pg8::StaticOrder S; S.init(T_TOK, DM, (int)gridDim.x, (int)blockIdx.x);
        pg8::Gemm g{x2b, Wpg_t, T_TOK, DM, DM, DM, DM}; EpiPleFinal E{out, PP, rstd2, g_final, out, (float*)(ws + 251 * MiB), (unsigned*)(ws + 42 * MiB + 40960)};
        pg8::gemm_phase<EpiPleFinal, pg8::StaticOrder, false, true>((PG8_LAS unsigned char*)lds_raw, g, S, E, tid512);
#if NSA_CHECK
        GRID_BAR();
        if (blockIdx.x == 0 && tid512 == 0) { const unsigned* stats = (const unsigned*)(ws + 42 * MiB + 32768); out[0] += sqrtf((float)stats[0]); out[1] += sqrtf((float)stats[1]) * 30.f; }
#endif
        if (SPIN_PHASE >= 0 && blockIdx.x == 0) { __syncthreads(); STAMP(); const unsigned long long t0_ = __builtin_amdgcn_s_memrealtime(); while (__builtin_amdgcn_s_memrealtime() - t0_ < 8ull * ts_probe_) __builtin_amdgcn_s_sleep(4); }
    } else {
        {   PHASE_IDS
            __syncthreads();
            pg8::StaticOrder S; S.init(T_TOK, DM, (int)gridDim.x, (int)blockIdx.x);
            pg8::Gemm g{x2b, Wpg_t, T_TOK, DM, DM, DM, DM}; EpiPle2 E{out, PP, rstd2};
            pg8::gemm_phase<EpiPle2, pg8::StaticOrder, true, true>((PG8_LAS unsigned char*)lds_raw, g, S, E, tid512);
        }
        GRID_BAR();
        {   PHASE_IDS
            VB_LOOP(T_TOK / 4) rmsnorm_rows(vb, tid, out, g_final, (bf16_t*)nullptr, out, T_TOK);
        }
    }
}

extern "C" void kernel_launch(void* const* d_in, const int* in_sizes, int n_in, void* d_out, int out_size, void* d_ws, size_t ws_size, hipStream_t stream) {
    static int grid_blocks = 0;
    if (grid_blocks == 0) {
        int dev = 0, cus = 0, per_cu = 0;
        (void)hipGetDevice(&dev);
        (void)hipDeviceGetAttribute(&cus, hipDeviceAttributeMultiprocessorCount, dev);
        (void)hipFuncSetAttribute((const void*)mk_fwd, hipFuncAttributeMaxDynamicSharedMemorySize, LDS_BYTES);
        (void)hipOccupancyMaxActiveBlocksPerMultiprocessor(&per_cu, (const void*)mk_fwd, 512, LDS_BYTES);
        if (per_cu < 1) { fprintf(stderr, "kernel_launch: occupancy query returned %d\n", per_cu); per_cu = 1; }
        grid_blocks = cus * 1;
        fprintf(stderr, "kernel_launch: cus=%d per_cu=%d grid=%d ws=%zu\n", cus, per_cu, grid_blocks, ws_size);
    }
    (void)hipMemsetAsync((char*)d_ws + ((size_t)42 << 20), 0, 131072, stream);
    Args a{};
    for (int i = 0; i < 29; ++i) a.in[i] = (const float*)d_in[i];
    a.out = (float*)d_out; a.ws = (char*)d_ws; a.rep_mask = REP_MASK; a.pad = 0;
    void* args[] = {&a};
    hipError_t e = hipLaunchCooperativeKernel((const void*)mk_fwd, dim3(grid_blocks), dim3(512), args, LDS_BYTES, stream);
    if (e != hipSuccess) fprintf(stderr, "cooperative launch failed: %s (grid %d)\n", hipGetErrorString(e), grid_blocks);
    (void)in_sizes; (void)n_in; (void)out_size; (void)ws_size;
}
```

```cpp
#include <hip/hip_runtime.h>
#include <cstdint>
#include <cstdio>
#include <hip/hip_cooperative_groups.h>
namespace cg = cooperative_groups;

typedef unsigned short bf16_t;
typedef short bf16x8 __attribute__((ext_vector_type(8)));
typedef float f32x16 __attribute__((ext_vector_type(16)));

#define DI __device__ __forceinline__

constexpr int T_TOK = 16384, SEQ = 4096, DM = 1024, DIN = 5408, NIN = 5632;
#ifndef SPIN_PHASE
#define SPIN_PHASE (-1)
#endif
#define RG_BEGIN(id) unsigned long long rt0_##id = 0ull; if (SPIN_PHASE == (id) && blockIdx.x == 0) rt0_##id = __builtin_amdgcn_s_memrealtime();
#define RG_END(id) if (SPIN_PHASE == (id) && blockIdx.x == 0) pacc += __builtin_amdgcn_s_memrealtime() - rt0_##id;
constexpr int CNT_STRIDE = 64;
constexpr float QSCALE = 0.125f * 1.4426950408889634f;
constexpr int ZC_Q = 0, ZC_KC = 512, ZC_VC = 640, ZC_KS = 768, ZC_VS = 896, ZC_KW = 1024, ZC_VW = 1152, ZC_GATE = 1280,
              ZC_MQK = 1304, ZC_MV = 2328, ZC_MO = 2840, ZC_IF = 3352, ZC_GA = 3360, ZC_GB = 4384;

DI bf16_t f2bf(float f) { unsigned u = __float_as_uint(f); return (bf16_t)((u + 0x7fffu + ((u >> 16) & 1u)) >> 16); }
DI float bf2f(bf16_t h) { return __uint_as_float(((unsigned)h) << 16); }
DI float sigmoidf_(float x) { return 1.f / (1.f + __expf(-x)); }
DI int lane_id_opaque() { int z = 0; asm volatile("" : "+v"(z)); return __builtin_amdgcn_mbcnt_hi(-1, __builtin_amdgcn_mbcnt_lo(-1, z)); }
DI float lane_xor(float v, int o, int lane) { return __int_as_float(__builtin_amdgcn_ds_bpermute((lane ^ o) << 2, __float_as_int(v))); }
DI float lane_get(float v, int src) { return __int_as_float(__builtin_amdgcn_ds_bpermute(src << 2, __float_as_int(v))); }
DI float wave_sum(float v) {
    const int l = lane_id_opaque();
#pragma unroll
    for (int o = 1; o < 64; o <<= 1) v += lane_xor(v, o, l);
    return v;
}
DI float wave_max(float v) {
    const int l = lane_id_opaque();
#pragma unroll
    for (int o = 1; o < 64; o <<= 1) v = fmaxf(v, lane_xor(v, o, l));
    return v;
}

namespace pg8 {
#define PG8_LAS __attribute__((address_space(3)))
typedef unsigned short bf16_t;
typedef short bf16x8 __attribute__((ext_vector_type(8)));
typedef float f32x4 __attribute__((ext_vector_type(4)));
typedef unsigned u32x4 __attribute__((ext_vector_type(4)));
constexpr int BM = 256, BK = 64, HALF = 128, HTB = HALF * BK * 2  , STAGE_BYTES = 8 * HTB, NXCD = 8, WGM = 8;

__host__ __device__ __forceinline__ int lds_byte(int r, int c) { const int st = (r >> 4) * 2 + (c >> 5), rr = r & 15, cc = c & 31, ob = rr * 64 + cc * 2; return st * 1024 + (ob ^ (((ob >> 9) & 1) << 5)); }
__host__ __device__ __forceinline__ void stage_rc(int b, int& R, int& C) { const int st = b / 1024, sb = b % 1024, swz = sb ^ (((sb >> 9) & 1) << 5); R = (st >> 1) * 16 + swz / 64; C = (st & 1) * 32 + (swz % 64) / 2; }
__host__ __device__ __forceinline__ int perm32(int rho) { const int n = rho >> 4, i = rho & 15; return 8 * (i >> 2) + 4 * n + (i & 3); }

struct Unit { int pm, pn, aux; };
struct Gemm { const bf16_t* A; const bf16_t* Bt; int M, N, K, lda, ldb; const int* amap; int avalid; };

struct StaticOrder {
    int nM, nN, nwg, G, c;
    __host__ __device__ __forceinline__ void init(int M, int N, int G_, int c_) { nM = M / BM; nN = N / BM; nwg = nM * nN; G = G_; c = c_; }
    __host__ __device__ __forceinline__ bool next(int i, Unit& u) const {
        const long L = (long)i * G + c; if (L >= nwg) return false;
        int wgid = (int)L; { const int q = nwg / NXCD, r = nwg % NXCD, xcd = wgid % NXCD, off = wgid / NXCD; wgid = (xcd < r ? xcd * (q + 1) : r * (q + 1) + (xcd - r) * q) + off; }
        const int nig = WGM * nN, gid = wgid / nig, fm = gid * WGM, gsz = (nM - fm) < WGM ? (nM - fm) : WGM;
        u.pm = fm + ((wgid % nig) % gsz); u.pn = (wgid % nig) / gsz; u.aux = 0; return true;
    }
    __device__ __forceinline__ void a_ready(const Unit&) const {}
    __device__ __forceinline__ void done(const Unit&) const {}
};

__device__ __forceinline__ unsigned cvt_pk_bf16(float lo, float hi) { unsigned r; asm volatile("v_cvt_pk_bf16_f32 %0, %1, %2" : "=v"(r) : "v"(lo), "v"(hi)); return r; }
typedef float f32x2 __attribute__((ext_vector_type(2)));
__device__ __forceinline__ f32x2 gelu_pk(f32x2 v) {
    const f32x2 av = __builtin_elementwise_abs(v), d = av * 0.2316418882f + 1.0f;
    f32x2 t; t.x = __builtin_amdgcn_rcpf(d.x); t.y = __builtin_amdgcn_rcpf(d.y);
    f32x2 q = t * 0.5307027145f + (-0.7265760135f); q = q * t + 0.7107068705f; q = q * t + (-0.142248368f); q = q * t + 0.127414796f; q = q * t;
    const f32x2 s = (v * v) * (-0.72134752044f);
    f32x2 e; e.x = __builtin_amdgcn_exp2f(s.x); e.y = __builtin_amdgcn_exp2f(s.y);
    const f32x2 m = v * (q * e), r = v - m;
    f32x2 o; o.x = v.x < 0.f ? m.x : r.x; o.y = v.y < 0.f ? m.y : r.y; return o;
}

template <int ACT  > struct EpiBf16 {
    static constexpr bool PERM = true, AFTER_DRAIN = false; static constexpr int MIDK = 0; static_assert(ACT == 0 || ACT == 1, "EpiBf16: ACT is 0 (none) or 1 (gelu_pk)");
    bf16_t* O; int ldc; const float* bias; int split_cols; size_t split_stride; float scale0;
    __device__ __forceinline__ void operator()(const f32x4 (&acc)[2][2][4][2], const Unit& u, int wr, int wc, int fr, int fq) const {
        const int row0 = u.pm * BM + wr * 64 + fr; int colt = u.pn * BM; bf16_t* base = O;
        float sc = 1.f; if (split_cols) { const int t = colt / split_cols; base += (size_t)t * split_stride; colt -= t * split_cols; if (t == 0) sc = scale0; }
        const int col0 = colt + wc * 32 + 8 * fq, bcol0 = u.pn * BM + wc * 32 + 8 * fq;
        f32x4 bv[2][2];
#pragma unroll
        for (int bj = 0; bj < 2; ++bj)
#pragma unroll
            for (int n = 0; n < 2; ++n) bv[bj][n] = bias ? *(const f32x4*)(bias + bcol0 + bj * HALF + 4 * n) : (f32x4){0.f, 0.f, 0.f, 0.f};
#pragma unroll
        for (int ai = 0; ai < 2; ++ai)
#pragma unroll
            for (int m = 0; m < 4; ++m) { bf16_t* rowp = base + (size_t)(row0 + ai * HALF + m * 16) * ldc + col0;
#pragma unroll
                for (int bj = 0; bj < 2; ++bj) { f32x4 v0 = acc[ai][bj][m][0] + bv[bj][0], v1 = acc[ai][bj][m][1] + bv[bj][1];
                    if (ACT == 1) { f32x2 a = gelu_pk((f32x2){v0[0], v0[1]}), b = gelu_pk((f32x2){v0[2], v0[3]}), c = gelu_pk((f32x2){v1[0], v1[1]}), d = gelu_pk((f32x2){v1[2], v1[3]});
                        v0 = (f32x4){a.x, a.y, b.x, b.y}; v1 = (f32x4){c.x, c.y, d.x, d.y}; }
                    v0 = v0 * sc; v1 = v1 * sc; u32x4 w; w.x = cvt_pk_bf16(v0[0], v0[1]); w.y = cvt_pk_bf16(v0[2], v0[3]); w.z = cvt_pk_bf16(v1[0], v1[1]); w.w = cvt_pk_bf16(v1[2], v1[3]);
                    *(u32x4*)(rowp + bj * HALF) = w; } }
    }
};

template <class Epi, class Sched, bool ALIGN_EPI = false, bool SP2 = false, bool GATHER = false>
__device__ __forceinline__ void gemm_phase(PG8_LAS unsigned char* lds, const Gemm g, const Sched& S, const Epi& E, const int tid) {
    const int wid = __builtin_amdgcn_readfirstlane(tid >> 6), lane = tid & 63, wr = wid >> 2, wc = wid & 3, fr = lane & 15, fq = lane >> 4;
    const int K = g.K, nt = K / BK;
    unsigned voffA[2], voffB[2], voffA1[2];
#pragma unroll
    for (int i = 0; i < 2; ++i) { int R, C; stage_rc(tid * 16 + i * 8192, R, C); const int Rb = Epi::PERM ? ((R & ~31) + perm32(R & 31)) : R;
        voffA[i] = (unsigned)(R * g.lda + C) * 2u; voffB[i] = (unsigned)(Rb * g.ldb + C) * 2u; voffA1[i] = voffA[i];
        if constexpr (GATHER) { const int t0_ = R < g.avalid ? g.amap[R] : 0, t1_ = R + HALF < g.avalid ? g.amap[R + HALF] : 0; voffA[i] = (unsigned)(t0_ * g.lda + C) * 2u; voffA1[i] = (unsigned)(t1_ * g.lda + C) * 2u; } }
    const size_t kstep = (size_t)(BK * 2);
    const size_t hstepA = (size_t)HALF * g.lda * 2, hstepB = (size_t)HALF * g.ldb * 2;
    const size_t tstepA = GATHER ? 0 : 2 * hstepA, tstepB = 2 * hstepB, hsA = GATHER ? 0 : hstepA;
    const unsigned ldsw = (unsigned)wid * 1024u;
    const int aoff = lds_byte(wr * 64 + fr, fq * 8), boff = lds_byte(wc * 32 + fr, fq * 8);
#define PG8_SA(b, h) (((b) * 2 + (h)) * HTB)
#define PG8_SB(b, h) ((4 + (b) * 2 + (h)) * HTB)
#define PG8_STAGE(bufoff, gbase, voff) do { _Pragma("unroll") for (int _i = 0; _i < 2; ++_i) \
        __builtin_amdgcn_global_load_lds((const unsigned*)((const char*)(gbase) + (voff)[_i]), (PG8_LAS unsigned*)(lds + (bufoff) + ldsw + _i * 8192), 16, 0, 0); } while (0)
#define PG8_LDA(dst, b, h) do { _Pragma("unroll") for (int m = 0; m < 4; ++m) _Pragma("unroll") for (int k = 0; k < 2; ++k) dst[m][k] = *(const PG8_LAS bf16x8*)(lds + PG8_SA(b, h) + aoff + m * 2048 + k * 1024); } while (0)
#define PG8_LDB(dst, b, h) do { _Pragma("unroll") for (int n = 0; n < 2; ++n) _Pragma("unroll") for (int k = 0; k < 2; ++k) dst[n][k] = *(const PG8_LAS bf16x8*)(lds + PG8_SB(b, h) + boff + n * 2048 + k * 1024); } while (0)
#define PG8_MMA(ai, bj, At, Bt) do { __builtin_amdgcn_s_setprio(1); _Pragma("unroll") for (int m = 0; m < 4; ++m) _Pragma("unroll") for (int n = 0; n < 2; ++n) _Pragma("unroll") for (int k = 0; k < 2; ++k) \
        acc[ai][bj][m][n] = __builtin_amdgcn_mfma_f32_16x16x32_bf16(Bt[n][k], At[m][k], acc[ai][bj][m][n], 0, 0, 0); __builtin_amdgcn_s_setprio(0); } while (0)
#define PG8_WAIT_V(n) asm volatile("s_waitcnt vmcnt(" #n ")" ::: "memory")
#define PG8_WAIT_L(n) asm volatile("s_waitcnt lgkmcnt(" #n ")" ::: "memory")
#define PG8_BAR __builtin_amdgcn_s_barrier()
#define PG8_SCHED __builtin_amdgcn_sched_barrier(0)
    Unit cur, nxt; int ui = 0;
    if (!S.next(0, cur)) return;
    f32x4 acc[2][2][4][2];
#pragma unroll
    for (int a = 0; a < 2; ++a)
#pragma unroll
        for (int b = 0; b < 2; ++b)
#pragma unroll
            for (int m = 0; m < 4; ++m)
#pragma unroll
                for (int n = 0; n < 2; ++n) acc[a][b][m][n] = (f32x4){0.f, 0.f, 0.f, 0.f};
    bf16x8 At[4][2], B0[2][2], B1[2][2];
    const char* cA = (const char*)g.A + (size_t)cur.pm * tstepA; const char* cB = (const char*)g.Bt + (size_t)cur.pn * tstepB;
    S.a_ready(cur);
    if constexpr (SP2) {
        PG8_STAGE(PG8_SB(0, 0), cB, voffB); PG8_STAGE(PG8_SB(0, 1), cB + hstepB, voffB); PG8_STAGE(PG8_SA(0, 0), cA, voffA); PG8_STAGE(PG8_SA(0, 1), cA + hsA, voffA1);
        if (wr == 1) PG8_BAR;
        PG8_WAIT_V(2); PG8_BAR;
        PG8_STAGE(PG8_SB(1, 0), cB + kstep, voffB); PG8_STAGE(PG8_SA(1, 0), cA + kstep, voffA); PG8_STAGE(PG8_SB(1, 1), cB + hstepB + kstep, voffB);
        PG8_WAIT_V(6); PG8_BAR;
    } else {
        PG8_STAGE(PG8_SB(0, 0), cB, voffB); PG8_STAGE(PG8_SA(0, 0), cA, voffA); PG8_STAGE(PG8_SB(0, 1), cB + hstepB, voffB); PG8_STAGE(PG8_SA(0, 1), cA + hsA, voffA1);
        if (wr == 1) PG8_BAR;
        PG8_WAIT_V(4); PG8_BAR;
        PG8_STAGE(PG8_SB(1, 0), cB + kstep, voffB); PG8_STAGE(PG8_SA(1, 0), cA + kstep, voffA); PG8_STAGE(PG8_SB(1, 1), cB + hstepB + kstep, voffB);
        PG8_WAIT_V(6); PG8_BAR;
    }
    for (;;) {
        const bool has_next = S.next(ui + 1, nxt);
        const char* nA = has_next ? (const char*)g.A + (size_t)nxt.pm * tstepA : cA; const char* nB = has_next ? (const char*)g.Bt + (size_t)nxt.pn * tstepB : cB;
        for (int t = 0; t < nt; t += 2) {
            const bool last = (t == nt - 2);
            const char* a1 = cA + (size_t)(t + 1) * kstep;
            const char* a2 = last ? nA : cA + (size_t)(t + 2) * kstep; const char* b2 = last ? nB : cB + (size_t)(t + 2) * kstep;
            const char* a3 = a2 + kstep; const char* b3 = b2 + kstep;
            if (last && has_next) S.a_ready(nxt);
            if constexpr (SP2) {
            PG8_LDB(B0, 0, 0); PG8_LDB(B1, 0, 1); PG8_SCHED; PG8_LDA(At, 0, 0); PG8_STAGE(PG8_SA(1, 1), a1 + hsA, voffA1);
            PG8_WAIT_V(8); PG8_WAIT_L(0); PG8_BAR; PG8_MMA(0, 0, At, B0); PG8_MMA(0, 1, At, B1); PG8_BAR; PG8_SCHED;
            PG8_LDA(At, 0, 1); PG8_STAGE(PG8_SB(0, 0), b2, voffB); PG8_STAGE(PG8_SB(0, 1), b2 + hstepB, voffB); PG8_STAGE(PG8_SA(0, 0), a2, voffA);
            PG8_WAIT_V(8); PG8_WAIT_L(0); PG8_BAR; PG8_MMA(1, 0, At, B0); PG8_MMA(1, 1, At, B1); PG8_BAR; PG8_SCHED;
            PG8_LDB(B0, 1, 0); PG8_LDB(B1, 1, 1); PG8_SCHED; PG8_LDA(At, 1, 0); PG8_STAGE(PG8_SA(0, 1), a2 + hsA, voffA1);
            PG8_WAIT_V(8); PG8_WAIT_L(0); PG8_BAR; PG8_MMA(0, 0, At, B0); PG8_MMA(0, 1, At, B1); PG8_BAR; PG8_SCHED;
            PG8_LDA(At, 1, 1); PG8_STAGE(PG8_SB(1, 0), b3, voffB); PG8_STAGE(PG8_SB(1, 1), b3 + hstepB, voffB); PG8_STAGE(PG8_SA(1, 0), a3, voffA);
            PG8_WAIT_V(8); PG8_WAIT_L(0); PG8_BAR; PG8_MMA(1, 0, At, B0); PG8_MMA(1, 1, At, B1); PG8_BAR; PG8_SCHED;
            if constexpr (Epi::MIDK > 0) { if (t + 2 == Epi::MIDK / BK) { const int l3_ = lane_id_opaque(); E.mid(acc, cur, wr, wc, l3_ & 15, l3_ >> 4); } }
            } else {
            PG8_LDB(B0, 0, 0); PG8_SCHED; PG8_LDA(At, 0, 0); PG8_STAGE(PG8_SA(1, 1), a1 + hsA, voffA1);
            PG8_WAIT_L(8); PG8_BAR; PG8_WAIT_L(0); PG8_MMA(0, 0, At, B0); PG8_BAR; PG8_SCHED;
            PG8_LDB(B1, 0, 1); PG8_STAGE(PG8_SB(0, 0), b2, voffB);
            PG8_BAR; PG8_WAIT_L(0); PG8_MMA(0, 1, At, B1); PG8_BAR;
            PG8_LDA(At, 0, 1); PG8_STAGE(PG8_SA(0, 0), a2, voffA);
            PG8_BAR; PG8_WAIT_L(0); PG8_MMA(1, 0, At, B0); PG8_BAR; PG8_SCHED;
            PG8_STAGE(PG8_SB(0, 1), b2 + hstepB, voffB);
            PG8_WAIT_V(6); PG8_BAR; PG8_MMA(1, 1, At, B1); PG8_BAR;
            PG8_LDB(B0, 1, 0); PG8_SCHED; PG8_LDA(At, 1, 0); PG8_STAGE(PG8_SA(0, 1), a2 + hsA, voffA1);
            PG8_WAIT_L(8); PG8_BAR; PG8_WAIT_L(0); PG8_MMA(0, 0, At, B0); PG8_BAR; PG8_SCHED;
            PG8_LDB(B1, 1, 1); PG8_STAGE(PG8_SB(1, 0), b3, voffB);
            PG8_BAR; PG8_WAIT_L(0); PG8_MMA(0, 1, At, B1); PG8_BAR;
            PG8_LDA(At, 1, 1); PG8_STAGE(PG8_SA(1, 0), a3, voffA);
            PG8_BAR; PG8_WAIT_L(0); PG8_MMA(1, 0, At, B0); PG8_BAR; PG8_SCHED;
            PG8_STAGE(PG8_SB(1, 1), b3 + hstepB, voffB);
            PG8_WAIT_V(6); PG8_BAR; PG8_MMA(1, 1, At, B1); PG8_BAR;
            }
        }
        if constexpr (ALIGN_EPI) { if (wr == 0) PG8_BAR; }
        if constexpr (!Epi::AFTER_DRAIN) { const int l2_ = lane_id_opaque(); E(acc, cur, wr, wc, l2_ & 15, l2_ >> 4); S.done(cur); }
        if (!has_next) break;
#pragma unroll
        for (int a = 0; a < 2; ++a)
#pragma unroll
            for (int b = 0; b < 2; ++b)
#pragma unroll
                for (int m = 0; m < 4; ++m)
#pragma unroll
                    for (int n = 0; n < 2; ++n) acc[a][b][m][n] = (f32x4){0.f, 0.f, 0.f, 0.f};
        cur = nxt; cA = nA; cB = nB; ++ui;
        if constexpr (ALIGN_EPI) { if (wr == 1) PG8_BAR; }
    }
    PG8_WAIT_V(0);
    if constexpr (!ALIGN_EPI) { if (wr == 0) PG8_BAR; }
    PG8_BAR;
    if constexpr (Epi::AFTER_DRAIN) { E.fused(acc, cur, wr, wc, fr, fq, lds, wid, lane); S.done(cur); }
#undef PG8_SA
#undef PG8_SB
#undef PG8_STAGE
#undef PG8_LDA
#undef PG8_LDB
#undef PG8_MMA
#undef PG8_WAIT_V
#undef PG8_WAIT_L
#undef PG8_BAR
#undef PG8_SCHED
}
}


#define LAS __attribute__((address_space(3)))
DI unsigned pk2(float lo, float hi) { return (unsigned)f2bf(lo) | ((unsigned)f2bf(hi) << 16); }
template <class Map>
DI void prep_wt_item(const float* __restrict__ W, int ldw, int K, bf16_t* __restrict__ WT, const float* __restrict__ gain, Map map, float* scr, int item, int nblk, int lane) {
    const int kb = item / nblk, nb = item % nblk, k0 = 64 * kb, n0 = 32 * nb;
    const int srcn = map(n0 + (lane & 31));
    float tv[32];
#pragma unroll
    for (int i = 0; i < 32; ++i) { const int kk = 2 * i + (lane >> 5); tv[i] = srcn >= 0 ? W[(size_t)(k0 + kk) * ldw + srcn] : 0.f; }
#pragma unroll
    for (int i = 0; i < 32; ++i) { const int kk = 2 * i + (lane >> 5); scr[kk * 33 + (lane & 31)] = gain ? tv[i] * gain[k0 + kk] : tv[i]; }
    __builtin_amdgcn_s_waitcnt(0xC07F); asm volatile("" ::: "memory");
    const int c = lane & 7;
#pragma unroll
    for (int j = 0; j < 4; ++j) { const int n = (lane >> 3) + 8 * j; const float* s = scr + (8 * c) * 33 + n;
        uint4 o; o.x = pk2(s[0 * 33], s[1 * 33]); o.y = pk2(s[2 * 33], s[3 * 33]); o.z = pk2(s[4 * 33], s[5 * 33]); o.w = pk2(s[6 * 33], s[7 * 33]);
        *(uint4*)(WT + (size_t)(n0 + n) * K + k0 + 8 * c) = o; }
    __builtin_amdgcn_s_waitcnt(0xC07F); asm volatile("" ::: "memory");
}
template <class Map>
DI void prep_wt_item2(const float* __restrict__ Wa, const float* __restrict__ Wb, int ldw, int K, bf16_t* __restrict__ WTa, bf16_t* __restrict__ WTb, const float* __restrict__ gain, Map map, float* scr, int itemA, int itemB, int nblk, int lane) {
    const int ka = 64 * (itemA / nblk), na = 32 * (itemA % nblk), kb = 64 * (itemB / nblk), nb = 32 * (itemB % nblk);
    const int sa = map(na + (lane & 31)), sb = map(nb + (lane & 31));
    float ta[32], tb[32];
#pragma unroll
    for (int i = 0; i < 32; ++i) { const int kk = 2 * i + (lane >> 5); ta[i] = sa >= 0 ? Wa[(size_t)(ka + kk) * ldw + sa] : 0.f; }
#pragma unroll
    for (int i = 0; i < 32; ++i) { const int kk = 2 * i + (lane >> 5); tb[i] = sb >= 0 ? Wb[(size_t)(kb + kk) * ldw + sb] : 0.f; }
#pragma unroll
    for (int i = 0; i < 32; ++i) { const int kk = 2 * i + (lane >> 5); scr[kk * 33 + (lane & 31)] = gain ? ta[i] * gain[ka + kk] : ta[i]; }
#pragma unroll
    for (int i = 0; i < 32; ++i) { const int kk = 2 * i + (lane >> 5); scr[2112 + kk * 33 + (lane & 31)] = gain ? tb[i] * gain[kb + kk] : tb[i]; }
    __builtin_amdgcn_s_waitcnt(0xC07F); asm volatile("" ::: "memory");
    const int c = lane & 7;
#pragma unroll
    for (int j = 0; j < 4; ++j) { const int n = (lane >> 3) + 8 * j; const float* s = scr + (8 * c) * 33 + n;
        uint4 o; o.x = pk2(s[0 * 33], s[1 * 33]); o.y = pk2(s[2 * 33], s[3 * 33]); o.z = pk2(s[4 * 33], s[5 * 33]); o.w = pk2(s[6 * 33], s[7 * 33]);
        *(uint4*)(WTa + (size_t)(na + n) * K + ka + 8 * c) = o;
        const float* s2 = s + 2112;
        uint4 o2; o2.x = pk2(s2[0 * 33], s2[1 * 33]); o2.y = pk2(s2[2 * 33], s2[3 * 33]); o2.z = pk2(s2[4 * 33], s2[5 * 33]); o2.w = pk2(s2[6 * 33], s2[7 * 33]);
        *(uint4*)(WTb + (size_t)(nb + n) * K + kb + 8 * c) = o2; }
    __builtin_amdgcn_s_waitcnt(0xC07F); asm volatile("" ::: "memory");
}
struct MapIn {
    DI int operator()(int n) const {
        if (n < 1280) return n;
        if (n < 1536) { const int i = n - 1280; return i < 24 ? ZC_GATE + i : (i < 32 ? ZC_IF + (i - 24) : -1); }
        if (n < 2560) return ZC_MQK + (n - 1536);
        if (n < 3072) return ZC_MV + (n - 2560);
        if (n < 3584) return ZC_MO + (n - 3072);
        return ZC_GA + (n - 3584);
    }
};
DI void prep_x_row(const float* __restrict__ x, bf16_t* __restrict__ xb, float* __restrict__ rstd, int row, int lane) {
    const float4* xr = (const float4*)(x + (size_t)row * DM);
    float4 v[4]; float s = 0.f;
#pragma unroll
    for (int j = 0; j < 4; ++j) { v[j] = xr[lane + 64 * j]; s += v[j].x * v[j].x + v[j].y * v[j].y + v[j].z * v[j].z + v[j].w * v[j].w; }
    s = wave_sum(s);
    if (lane == 0) rstd[row] = rsqrtf(s * (1.f / DM) + 1e-6f);
#pragma unroll
    for (int j = 0; j < 4; ++j) { uint2 o; o.x = pk2(v[j].x, v[j].y); o.y = pk2(v[j].z, v[j].w); ((uint2*)(xb + (size_t)row * DM))[lane + 64 * j] = o; }
}

struct EpiInProj {
    static constexpr bool PERM = true, AFTER_DRAIN = false; static constexpr int MIDK = 0;
    const float* rstd; const float* cosT; const float* sinT; const float* b_if;
    bf16_t* Qb; bf16_t* KVb; float* gates; float* ifp; bf16_t* MQK; bf16_t* MV; bf16_t* MO; bf16_t* MG; bf16_t* VT;
    DI void operator()(const pg8::f32x4 (&acc)[2][2][4][2], const pg8::Unit& u, int wr, int wc, int fr, int fq) const {
        const int pn = u.pn;
        asm volatile("" : "+v"(fr), "+v"(fq));
#pragma unroll
        for (int ai = 0; ai < 2; ++ai)
#pragma unroll
            for (int m = 0; m < 4; ++m) {
                const int row = u.pm * 256 + ai * 128 + wr * 64 + m * 16 + fr;
                const float rs = rstd[row];
#pragma unroll
                for (int bj = 0; bj < 2; ++bj) {
                    float v[8];
#pragma unroll
                    for (int i = 0; i < 4; ++i) { v[i] = acc[ai][bj][m][0][i] * rs; v[4 + i] = acc[ai][bj][m][1][i] * rs; }
                    const int c0 = bj * 128 + wc * 32 + 8 * fq;
                    if (pn <= 4) {
                        const bool is_k = (pn < 2) || (bj == 0);
                        if (is_k && (wc & 1) == 0) {
                            const float4 c_lo = *(const float4*)(cosT + (size_t)row * 8), c_hi = *(const float4*)(cosT + (size_t)row * 8 + 4);
                            const float4 s_lo = *(const float4*)(sinT + (size_t)row * 8), s_hi = *(const float4*)(sinT + (size_t)row * 8 + 4);
                            const float cs[8] = {c_lo.x, c_lo.y, c_lo.z, c_lo.w, c_hi.x, c_hi.y, c_hi.z, c_hi.w};
                            const float sn[8] = {s_lo.x, s_lo.y, s_lo.z, s_lo.w, s_hi.x, s_hi.y, s_hi.z, s_hi.w};
                            const int l_ = lane_id_opaque();
#pragma unroll
                            for (int i = 0; i < 8; ++i) {
                                const float other = lane_xor(v[i], 16, l_);
                                if (fq == 0) v[i] = v[i] * cs[i] - other * sn[i];
                                else if (fq == 1) v[i] = v[i] * cs[i] + other * sn[i];
                            }
                        }
                        const float sc = pn < 2 ? QSCALE : 1.f;
                        pg8::u32x4 w; w.x = pg8::cvt_pk_bf16(v[0] * sc, v[1] * sc); w.y = pg8::cvt_pk_bf16(v[2] * sc, v[3] * sc); w.z = pg8::cvt_pk_bf16(v[4] * sc, v[5] * sc); w.w = pg8::cvt_pk_bf16(v[6] * sc, v[7] * sc);
                        if (pn < 2) *(pg8::u32x4*)(Qb + (size_t)row * 512 + pn * 256 + c0) = w;
                        else if (pn == 2) *(pg8::u32x4*)(KVb + (size_t)row * 512 + c0) = w;
                        else if (bj == 0) *(pg8::u32x4*)(KVb + (size_t)row * 512 + (pn - 2) * 128 + 128 + wc * 32 + 8 * fq) = w;
                        else {
                            const int cv = wc * 32 + 8 * fq, gg = cv >> 6, d0 = cv & 63, bb = row >> 12, tt = row & 4095;
                            bf16_t* vt = VT + ((size_t)((pn - 3) * 8 + bb * 2 + gg) * 64 + (tt >> 6)) * 4096 + (size_t)d0 * 64 + (tt & 63);
                            vt[0] = (bf16_t)(w.x & 0xffffu); vt[64] = (bf16_t)(w.x >> 16); vt[128] = (bf16_t)(w.y & 0xffffu); vt[192] = (bf16_t)(w.y >> 16);
                            vt[256] = (bf16_t)(w.z & 0xffffu); vt[320] = (bf16_t)(w.z >> 16); vt[384] = (bf16_t)(w.w & 0xffffu); vt[448] = (bf16_t)(w.w >> 16);
                        }
                    } else if (pn == 5) {
                        if (bj == 0 && wc == 0) {
#pragma unroll
                            for (int i = 0; i < 8; ++i) { const int c = 8 * fq + i;
                                if (c < 24) gates[(size_t)row * 24 + c] = sigmoidf_(v[i]);
                                else if (c < 32) ifp[(size_t)row * 8 + (c - 24)] = v[i] + b_if[c - 24]; }
                        }
                    } else {
                        if (pn >= 14) {
#pragma unroll
                            for (int i = 0; i < 8; ++i) v[i] = sigmoidf_(v[i]);
                        }
                        pg8::u32x4 w; w.x = pg8::cvt_pk_bf16(v[0], v[1]); w.y = pg8::cvt_pk_bf16(v[2], v[3]); w.z = pg8::cvt_pk_bf16(v[4], v[5]); w.w = pg8::cvt_pk_bf16(v[6], v[7]);
                        bf16_t* dst;
                        if (pn < 10) dst = MQK + (size_t)row * 1024 + (pn - 6) * 256 + c0;
                        else if (pn < 12) dst = MV + (size_t)row * 512 + (pn - 10) * 256 + c0;
                        else if (pn < 14) dst = MO + (size_t)row * 512 + (pn - 12) * 256 + c0;
                        else dst = MG + (size_t)row * 2048 + (pn - 14) * 256 + c0;
                        *(pg8::u32x4*)dst = w;
                    }
                }
            }
    }
};


DI pg8::u32x4 pack8(const float (&v)[8]) { pg8::u32x4 w; w.x = pg8::cvt_pk_bf16(v[0], v[1]); w.y = pg8::cvt_pk_bf16(v[2], v[3]); w.z = pg8::cvt_pk_bf16(v[4], v[5]); w.w = pg8::cvt_pk_bf16(v[6], v[7]); return w; }
DI void unpack8(const pg8::u32x4 w, float (&v)[8]) {
    v[0] = __uint_as_float(w.x << 16); v[1] = __uint_as_float(w.x & 0xffff0000u); v[2] = __uint_as_float(w.y << 16); v[3] = __uint_as_float(w.y & 0xffff0000u);
    v[4] = __uint_as_float(w.z << 16); v[5] = __uint_as_float(w.z & 0xffff0000u); v[6] = __uint_as_float(w.w << 16); v[7] = __uint_as_float(w.w & 0xffff0000u);
}
#define EPI_ROWS_BEGIN asm volatile("" : "+v"(fr), "+v"(fq)); _Pragma("unroll") for (int ai = 0; ai < 2; ++ai) _Pragma("unroll") for (int m = 0; m < 4; ++m) { const int row = u.pm * 256 + ai * 128 + wr * 64 + m * 16 + fr; _Pragma("unroll") for (int bj = 0; bj < 2; ++bj) { \
    float v[8]; _Pragma("unroll") for (int i = 0; i < 4; ++i) { v[i] = acc[ai][bj][m][0][i]; v[4 + i] = acc[ai][bj][m][1][i]; } const int c0 = bj * 128 + wc * 32 + 8 * fq; (void)c0; (void)row;
#define EPI_ROWS_END } asm volatile("" ::: "memory"); }
template <int MODE> struct EpiMerge {
    static constexpr bool PERM = true, AFTER_DRAIN = false; static constexpr int MIDK = 0;
    const bf16_t* MG; float* tmp; bf16_t* mixed;
    DI void operator()(const pg8::f32x4 (&acc)[2][2][4][2], const pg8::Unit& u, int wr, int wc, int fr, int fq) const {
        EPI_ROWS_BEGIN
            const int col = u.pn * 256 + c0; float gt[8];
            unpack8(*(const pg8::u32x4*)(MG + (size_t)row * 2048 + MODE * 1024 + col), gt);
            float* tp = tmp + (size_t)row * DM + col;
            if (MODE == 0) {
                *(float4*)tp = make_float4(gt[0] * v[0], gt[1] * v[1], gt[2] * v[2], gt[3] * v[3]); *(float4*)(tp + 4) = make_float4(gt[4] * v[4], gt[5] * v[5], gt[6] * v[6], gt[7] * v[7]);
            } else {
                const float4 t0 = *(const float4*)tp, t1 = *(const float4*)(tp + 4);
                float o[8] = {t0.x + gt[0] * v[0], t0.y + gt[1] * v[1], t0.z + gt[2] * v[2], t0.w + gt[3] * v[3], t1.x + gt[4] * v[4], t1.y + gt[5] * v[5], t1.z + gt[6] * v[6], t1.w + gt[7] * v[7]};
                *(pg8::u32x4*)(mixed + (size_t)row * DM + col) = pack8(o);
            }
        EPI_ROWS_END
    }
};
struct EpiMerge2 {
    static constexpr bool PERM = true, AFTER_DRAIN = false; static constexpr int MIDK = 512;
    const bf16_t* MG; bf16_t* mixed;
    DI void mid(pg8::f32x4 (&acc)[2][2][4][2], const pg8::Unit& u, int wr, int wc, int fr, int fq) const {
#pragma unroll
        for (int ai = 0; ai < 2; ++ai)
#pragma unroll
            for (int m = 0; m < 4; ++m) { const int row = u.pm * 256 + ai * 128 + wr * 64 + m * 16 + fr;
#pragma unroll
                for (int bj = 0; bj < 2; ++bj) {
                    const int col = u.pn * 256 + bj * 128 + wc * 32 + 8 * fq; float ga[8], gb[8];
                    unpack8(*(const pg8::u32x4*)(MG + (size_t)row * 2048 + col), ga); unpack8(*(const pg8::u32x4*)(MG + (size_t)row * 2048 + 1024 + col), gb);
#pragma unroll
                    for (int i = 0; i < 4; ++i) { acc[ai][bj][m][0][i] *= ga[i] * __builtin_amdgcn_rcpf(gb[i]); acc[ai][bj][m][1][i] *= ga[4 + i] * __builtin_amdgcn_rcpf(gb[4 + i]); }
                }
                asm volatile("" ::: "memory"); }
    }
    DI void operator()(const pg8::f32x4 (&acc)[2][2][4][2], const pg8::Unit& u, int wr, int wc, int fr, int fq) const {
        EPI_ROWS_BEGIN
            const int col = u.pn * 256 + c0; float gb[8];
            unpack8(*(const pg8::u32x4*)(MG + (size_t)row * 2048 + 1024 + col), gb);
            float o[8] = {gb[0] * v[0], gb[1] * v[1], gb[2] * v[2], gb[3] * v[3], gb[4] * v[4], gb[5] * v[5], gb[6] * v[6], gb[7] * v[7]};
            *(pg8::u32x4*)(mixed + (size_t)row * DM + col) = pack8(o);
        EPI_ROWS_END
    }
};
struct EpiX1 {
    static constexpr bool PERM = true, AFTER_DRAIN = false; static constexpr int MIDK = 0;
    const float* base; float* out; bf16_t* outb;
    DI void operator()(const pg8::f32x4 (&acc)[2][2][4][2], const pg8::Unit& u, int wr, int wc, int fr, int fq) const {
        EPI_ROWS_BEGIN
            const size_t o = (size_t)row * DM + u.pn * 256 + c0;
            const float4 b0 = *(const float4*)(base + o), b1 = *(const float4*)(base + o + 4);
            const float r[8] = {b0.x + v[0], b0.y + v[1], b0.z + v[2], b0.w + v[3], b1.x + v[4], b1.y + v[5], b1.z + v[6], b1.w + v[7]};
            *(float4*)(out + o) = make_float4(r[0], r[1], r[2], r[3]); *(float4*)(out + o + 4) = make_float4(r[4], r[5], r[6], r[7]);
            *(pg8::u32x4*)(outb + o) = pack8(r);
        EPI_ROWS_END
    }
};
struct EpiStoreBf {
    static constexpr bool PERM = true, AFTER_DRAIN = false; static constexpr int MIDK = 0;
    bf16_t* O; int ld; int pnmask;
    DI void operator()(const pg8::f32x4 (&acc)[2][2][4][2], const pg8::Unit& u, int wr, int wc, int fr, int fq) const {
        EPI_ROWS_BEGIN
            *(pg8::u32x4*)(O + (size_t)row * ld + (u.pn & pnmask) * 256 + c0) = pack8(v);
        EPI_ROWS_END
    }
};
struct EpiSwiglu {
    static constexpr bool PERM = true, AFTER_DRAIN = false; static constexpr int MIDK = 0;
    bf16_t* act; const int* amap; int avalid; const float* rstd1;
    DI void operator()(const pg8::f32x4 (&acc)[2][2][4][2], const pg8::Unit& u, int wr, int wc, int fr, int fq) const {
        asm volatile("" : "+v"(fr), "+v"(fq));
#pragma unroll
        for (int ai = 0; ai < 2; ++ai)
#pragma unroll
            for (int m = 0; m < 4; ++m) {
                const int rl = ai * 128 + wr * 64 + m * 16 + fr, row = u.pm * 256 + rl; float o[8];
                const float rs = rl < avalid ? rstd1[amap[rl]] : 0.f;
#pragma unroll
                for (int i = 0; i < 4; ++i) { const float g0 = rs * acc[ai][0][m][0][i], g1 = rs * acc[ai][0][m][1][i]; o[i] = g0 * sigmoidf_(g0) * (rs * acc[ai][1][m][0][i]); o[4 + i] = g1 * sigmoidf_(g1) * (rs * acc[ai][1][m][1][i]); }
                *(pg8::u32x4*)(act + (size_t)row * 256 + (u.pn & 1) * 128 + wc * 32 + 8 * fq) = pack8(o);
            }
    }
};
struct EpiPle2 {
    static constexpr bool PERM = true, AFTER_DRAIN = false; static constexpr int MIDK = 0;
    float* x; const bf16_t* PP; const float* rstd;
    DI void operator()(const pg8::f32x4 (&acc)[2][2][4][2], const pg8::Unit& u, int wr, int wc, int fr, int fq) const {
        EPI_ROWS_BEGIN
            const size_t o = (size_t)row * DM + u.pn * 256 + c0; const float rs = rstd[row]; float pp[8];
            unpack8(*(const pg8::u32x4*)(PP + o), pp);
            const float4 b0 = *(const float4*)(x + o), b1 = *(const float4*)(x + o + 4);
            *(float4*)(x + o) = make_float4(b0.x + sigmoidf_(rs * v[0]) * pp[0], b0.y + sigmoidf_(rs * v[1]) * pp[1], b0.z + sigmoidf_(rs * v[2]) * pp[2], b0.w + sigmoidf_(rs * v[3]) * pp[3]);
            *(float4*)(x + o + 4) = make_float4(b1.x + sigmoidf_(rs * v[4]) * pp[4], b1.y + sigmoidf_(rs * v[5]) * pp[5], b1.z + sigmoidf_(rs * v[6]) * pp[6], b1.w + sigmoidf_(rs * v[7]) * pp[7]);
        EPI_ROWS_END
    }
};

struct EpiPleFinal {
    static constexpr bool PERM = true, AFTER_DRAIN = true; static constexpr int MIDK = 0;
    const float* x2; const bf16_t* PP; const float* rstd2; const float* g_final; float* out; float* xbuf; unsigned* pcnt;
    DI void fused(pg8::f32x4 (&acc)[2][2][4][2], const pg8::Unit& u, int wr, int wc, int fr, int fq, PG8_LAS unsigned char* lds, int wid, int lane) const {
        __attribute__((address_space(3))) float* P = (__attribute__((address_space(3))) float*)lds;
        __attribute__((address_space(3))) float* S = P + 1024;
        const int l_ = lane_id_opaque();
#pragma unroll
        for (int ai = 0; ai < 2; ++ai)
#pragma unroll
            for (int m = 0; m < 4; ++m) {
                const int rl = ai * 128 + wr * 64 + m * 16 + fr, row = u.pm * 256 + rl; const float rs = rstd2[row]; float sq = 0.f;
#pragma unroll
                for (int bj = 0; bj < 2; ++bj) {
                    const size_t o = (size_t)row * DM + u.pn * 256 + bj * 128 + wc * 32 + 8 * fq; float pp[8];
                    unpack8(*(const pg8::u32x4*)(PP + o), pp);
                    const float4 b0 = *(const float4*)(x2 + o), b1 = *(const float4*)(x2 + o + 4);
                    const float bx[8] = {b0.x, b0.y, b0.z, b0.w, b1.x, b1.y, b1.z, b1.w};
#pragma unroll
                    for (int i = 0; i < 4; ++i) {
                        const float v0 = bx[i] + sigmoidf_(rs * acc[ai][bj][m][0][i]) * pp[i], v1 = bx[4 + i] + sigmoidf_(rs * acc[ai][bj][m][1][i]) * pp[4 + i];
                        acc[ai][bj][m][0][i] = v0; acc[ai][bj][m][1][i] = v1; sq += v0 * v0 + v1 * v1;
                    }
                }
                sq += lane_xor(sq, 16, l_); sq += lane_xor(sq, 32, l_);
                if (fq == 0) P[rl * 4 + wc] = sq;
                asm volatile("" ::: "memory");
            }
        __syncthreads();
        const int t = wid * 64 + lane;
        if (t < 256) { const float ps = (P[t * 4] + P[t * 4 + 1]) + (P[t * 4 + 2] + P[t * 4 + 3]);
            __hip_atomic_store(xbuf + ((size_t)u.pm * 256 + t) * 4 + u.pn, ps, __ATOMIC_RELAXED, __HIP_MEMORY_SCOPE_AGENT); }
        asm volatile("s_waitcnt vmcnt(0)" ::: "memory");
        __syncthreads();
        if (t == 0) __hip_atomic_fetch_add(pcnt + 64 * u.pm, 1u, __ATOMIC_RELAXED, __HIP_MEMORY_SCOPE_AGENT);
        if (wid == 0) { unsigned spins = 0; while (__hip_atomic_load(pcnt + 64 * u.pm, __ATOMIC_RELAXED, __HIP_MEMORY_SCOPE_AGENT) < 4u && ++spins < (1u << 22)) __builtin_amdgcn_s_sleep(2); }
        __syncthreads();
        if (t < 256) { const float* xb = xbuf + ((size_t)u.pm * 256 + t) * 4;
            const float tot = (__hip_atomic_load(xb, __ATOMIC_RELAXED, __HIP_MEMORY_SCOPE_AGENT) + __hip_atomic_load(xb + 1, __ATOMIC_RELAXED, __HIP_MEMORY_SCOPE_AGENT))
                            + (__hip_atomic_load(xb + 2, __ATOMIC_RELAXED, __HIP_MEMORY_SCOPE_AGENT) + __hip_atomic_load(xb + 3, __ATOMIC_RELAXED, __HIP_MEMORY_SCOPE_AGENT));
            S[t] = rsqrtf(tot * (1.f / DM) + 1e-6f); }
        __syncthreads();
#pragma unroll
        for (int ai = 0; ai < 2; ++ai)
#pragma unroll
            for (int m = 0; m < 4; ++m) {
                const int rl = ai * 128 + wr * 64 + m * 16 + fr, row = u.pm * 256 + rl; const float r3 = S[rl];
#pragma unroll
                for (int bj = 0; bj < 2; ++bj) {
                    const int col = u.pn * 256 + bj * 128 + wc * 32 + 8 * fq; const size_t o = (size_t)row * DM + col;
                    const float4 g0 = *(const float4*)(g_final + col), g1 = *(const float4*)(g_final + col + 4);
                    *(float4*)(out + o) = make_float4(acc[ai][bj][m][0][0] * r3 * g0.x, acc[ai][bj][m][0][1] * r3 * g0.y, acc[ai][bj][m][0][2] * r3 * g0.z, acc[ai][bj][m][0][3] * r3 * g0.w);
                    *(float4*)(out + o + 4) = make_float4(acc[ai][bj][m][1][0] * r3 * g1.x, acc[ai][bj][m][1][1] * r3 * g1.y, acc[ai][bj][m][1][2] * r3 * g1.z, acc[ai][bj][m][1][3] * r3 * g1.w);
                }
            }
    }
};
struct MoeOrder {
    const int* cnt; int NJ, G, c;
    DI bool next(int i, pg8::Unit& u) const {
        int L = i * G + c, tb = 0;
        for (int e = 0; e < 16; ++e) { const int mt = (cnt[e * CNT_STRIDE] + 255) >> 8, n = mt * NJ; if (L < n) { u.pm = tb + L / NJ; u.pn = e * NJ + L % NJ; u.aux = L / NJ; return true; } L -= n; tb += mt; }
        return false;
    }
    DI void a_ready(const pg8::Unit&) const {}
    DI void done(const pg8::Unit&) const {}
};
struct TwoUnits { int pm, pn0, aux; DI bool next(int i, pg8::Unit& o) const { o.pm = pm; o.pn = pn0 + i; o.aux = aux; return i < 2; } DI void a_ready(const pg8::Unit&) const {} DI void done(const pg8::Unit&) const {} };
struct FourUnits { int pm, pn0; DI bool next(int i, pg8::Unit& o) const { o.pm = pm; o.pn = pn0 + i; o.aux = 0; return i < 4; } DI void a_ready(const pg8::Unit&) const {} DI void done(const pg8::Unit&) const {} };
struct OneUnit { pg8::Unit u; DI bool next(int i, pg8::Unit& o) const { o = u; return i == 0; } DI void a_ready(const pg8::Unit&) const {} DI void done(const pg8::Unit&) const {} };
struct PPOrder { int extra, G, c; DI bool next(int i, pg8::Unit& u) const { const int nl = G - extra, li = c - extra; if (li < 0 || nl <= 0) return false; const int id = li + i * nl; if (id >= 256) return false; u.pm = id >> 2; u.pn = id & 3; u.aux = 0; return true; }
    DI void a_ready(const pg8::Unit&) const {} DI void done(const pg8::Unit&) const {} };
DI int moe_base_row(const int* cnt, int e) { int tb = 0; for (int k = 0; k < 16; ++k) { if (k < e) tb += (cnt[k * CNT_STRIDE] + 255) >> 8; } return tb * 256; }
struct MapId { DI int operator()(int n) const { return n; } };
struct MapE13 { DI int operator()(int n) const { return ((n >> 7) & 1) * 256 + (n >> 8) * 128 + (n & 127); } };

DI void router_stage(__attribute__((address_space(3))) float* Wl, const float* __restrict__ g, const float* __restrict__ w_rg, const float* __restrict__ w_re, int tx) {
    for (int e = tx; e < 4096; e += 512) { const int k = e >> 2, c = e & 3; Wl[c * 1024 + k] = w_rg[e] * g[k]; }
    for (int e = tx; e < 16384; e += 512) { const int k = e >> 4, c = e & 15; Wl[(4 + c) * 1024 + k] = w_re[e] * g[k]; }
}
typedef float f4v __attribute__((ext_vector_type(4)));
DI float dpp_row_sum(float v) {
    v += __builtin_bit_cast(float, __builtin_amdgcn_update_dpp(0, __builtin_bit_cast(int, v), 0xB1, 0xf, 0xf, true));
    v += __builtin_bit_cast(float, __builtin_amdgcn_update_dpp(0, __builtin_bit_cast(int, v), 0x4E, 0xf, 0xf, true));
    v += __builtin_bit_cast(float, __builtin_amdgcn_update_dpp(0, __builtin_bit_cast(int, v), 0x141, 0xf, 0xf, true));
    v += __builtin_bit_cast(float, __builtin_amdgcn_update_dpp(0, __builtin_bit_cast(int, v), 0x140, 0xf, 0xf, true));
    return v;
}
DI void router4(const int (&tok)[4], int lane, const f4v (&xv)[16], const __attribute__((address_space(3))) float* Wl, const float* __restrict__ b_rg, const float* __restrict__ b_re,
                float* __restrict__ rstd1, __attribute__((address_space(3))) int* lcnt, __attribute__((address_space(3))) int* lri) {
    const int g = lane >> 4, p = lane & 15;
    float s = 0.f;
#pragma unroll
    for (int j = 0; j < 16; ++j) s += (xv[j].x * xv[j].x + xv[j].y * xv[j].y) + (xv[j].z * xv[j].z + xv[j].w * xv[j].w);
    const float rstd = rsqrtf(dpp_row_sum(s) * (1.f / DM) + 1e-6f);
    float al[20];
#pragma unroll
    for (int c = 0; c < 20; ++c) {
        float a = 0.f;
#pragma unroll
        for (int j = 0; j < 16; ++j) { const f4v w = *(const __attribute__((address_space(3))) f4v*)(Wl + c * 1024 + 4 * (p + 16 * j)); a += (xv[j].x * w.x + xv[j].y * w.y) + (xv[j].z * w.z + xv[j].w * w.w); }
        al[c] = dpp_row_sum(a);
    }
    float gl[4], el[16];
#pragma unroll
    for (int c = 0; c < 4; ++c) gl[c] = al[c] * rstd + b_rg[c];
#pragma unroll
    for (int c = 0; c < 16; ++c) el[c] = al[4 + c] * rstd + b_re[c];
    if (p == 0) {
        int gs = 0; float gm = gl[0];
#pragma unroll
        for (int c = 1; c < 4; ++c) if (gl[c] > gm) { gm = gl[c]; gs = c; }
        float se = 0.f;
#pragma unroll
        for (int c = 0; c < 4; ++c) se += __expf(gl[c] - gm);
        const float pg = 1.f / se;
        float e4[4];
#pragma unroll
        for (int c = 0; c < 4; ++c) e4[c] = gs == 0 ? el[c] : gs == 1 ? el[4 + c] : gs == 2 ? el[8 + c] : el[12 + c];
        int i0 = 0; float v0 = e4[0];
#pragma unroll
        for (int c = 1; c < 4; ++c) if (e4[c] > v0) { v0 = e4[c]; i0 = c; }
        int i1 = -1; float v1 = -3.0e38f;
#pragma unroll
        for (int c = 0; c < 4; ++c) if (c != i0 && e4[c] > v1) { v1 = e4[c]; i1 = c; }
        const float ex = __expf(v1 - v0);
        const float w0 = pg / (1.f + ex), w1 = pg * ex / (1.f + ex);
        const int e0 = gs * 4 + i0, e1 = gs * 4 + i1;
        const int p0 = __hip_atomic_fetch_add(lcnt + e0, 1, __ATOMIC_RELAXED, __HIP_MEMORY_SCOPE_WORKGROUP), p1 = __hip_atomic_fetch_add(lcnt + e1, 1, __ATOMIC_RELAXED, __HIP_MEMORY_SCOPE_WORKGROUP);
        const int tk = g == 0 ? tok[0] : g == 1 ? tok[1] : g == 2 ? tok[2] : tok[3];
        rstd1[tk] = rstd;
        lri[g * 4 + 0] = e0 | (e1 << 8); lri[g * 4 + 1] = p0 | (p1 << 16); lri[g * 4 + 2] = __float_as_int(w0); lri[g * 4 + 3] = __float_as_int(w1);
    }
}

struct BMapId { DI int operator()(int n) const { return n; } };
struct BMapMoe { DI int operator()(int n) const { const int t = n >> 7, c = n & 127, e = t >> 2, jt = t & 3; return e * (1024 * 512) + ((c >> 5) & 1) * 256 + jt * 64 + (c >> 6) * 32 + (c & 31); } };
template <class Epi, class BMap>
DI void gemm_v1(int bx, int by, int tid, char* sm, const bf16_t* __restrict__ A, int lda, const float* __restrict__ B, int ldb, int N, int K, Epi epi, BMap bmap) {
    bf16_t* As = (bf16_t*)sm;
    bf16_t* Bs = (bf16_t*)(sm + 128 * 40 * 2);
    const int lane = tid & 63, w = tid >> 6, wr = w >> 1, wc = w & 1, r32 = lane & 31, hi = lane >> 5;
    const int m0 = by * 128, n0 = bx * 128;
    f32x16 acc[2][2];
#pragma unroll
    for (int i = 0; i < 2; ++i)
#pragma unroll
        for (int j = 0; j < 2; ++j)
#pragma unroll
            for (int r = 0; r < 16; ++r) acc[i][j][r] = 0.f;
    for (int k0 = 0; k0 < K; k0 += 32) {
#pragma unroll
        for (int i = 0; i < 2; ++i) {
            const int c = tid + i * 256, row = c >> 2, col = (c & 3) * 8;
            const uint4 v = *(const uint4*)(A + (size_t)(m0 + row) * lda + k0 + col);
            *(uint4*)(As + row * 40 + col) = v;
        }
#pragma unroll
        for (int i = 0; i < 4; ++i) {
            const int idx = tid + i * 256, k = idx >> 5, n = (idx & 31) * 4;
            float4 v = make_float4(0.f, 0.f, 0.f, 0.f);
            if (n0 + n < N) v = *(const float4*)(B + (size_t)(k0 + k) * ldb + bmap(n0 + n));
            Bs[(n + 0) * 40 + k] = f2bf(v.x); Bs[(n + 1) * 40 + k] = f2bf(v.y); Bs[(n + 2) * 40 + k] = f2bf(v.z); Bs[(n + 3) * 40 + k] = f2bf(v.w);
        }
        __syncthreads();
#pragma unroll
        for (int kk = 0; kk < 32; kk += 16) {
            bf16x8 a[2], b[2];
#pragma unroll
            for (int i = 0; i < 2; ++i) a[i] = *(const bf16x8*)(As + (wr * 64 + i * 32 + r32) * 40 + kk + hi * 8);
#pragma unroll
            for (int j = 0; j < 2; ++j) b[j] = *(const bf16x8*)(Bs + (wc * 64 + j * 32 + r32) * 40 + kk + hi * 8);
#pragma unroll
            for (int i = 0; i < 2; ++i)
#pragma unroll
                for (int j = 0; j < 2; ++j) acc[i][j] = __builtin_amdgcn_mfma_f32_32x32x16_bf16(a[i], b[j], acc[i][j], 0, 0, 0);
        }
        __syncthreads();
    }
#pragma unroll
    for (int i = 0; i < 2; ++i)
#pragma unroll
        for (int j = 0; j < 2; ++j)
#pragma unroll
            for (int r = 0; r < 16; ++r) {
                const int row = m0 + wr * 64 + i * 32 + (r & 3) + 8 * (r >> 2) + 4 * hi;
                const int col = n0 + wc * 64 + j * 32 + r32;
                if constexpr (Epi::PAIR) { if (j == 0) epi.pair(row, col, acc[i][0][r], acc[i][1][r]); }
                else { if (col < N) epi(row, col, acc[i][j][r]); }
            }
}

struct EpiPa { static constexpr bool PAIR = false;
    const bf16_t* MG; float* tmp;
    DI void operator()(int row, int col, float v) const { tmp[(size_t)row * DM + col] = bf2f(MG[(size_t)row * 2048 + col]) * v; }
};
struct EpiPb { static constexpr bool PAIR = false;
    const bf16_t* MG; const float* tmp; bf16_t* mixed;
    DI void operator()(int row, int col, float v) const {
        mixed[(size_t)row * DM + col] = f2bf(tmp[(size_t)row * DM + col] + bf2f(MG[(size_t)row * 2048 + 1024 + col]) * v);
    }
};
struct EpiResid { static constexpr bool PAIR = false;
    const float* base; float* out;
    DI void operator()(int row, int col, float v) const { out[(size_t)row * DM + col] = base[(size_t)row * DM + col] + v; }
};
struct EpiBf { static constexpr bool PAIR = false;
    bf16_t* o; int ld;
    DI void operator()(int row, int col, float v) const { o[(size_t)row * ld + col] = f2bf(v); }
};
struct EpiF32 { static constexpr bool PAIR = false;
    float* o; int ld;
    DI void operator()(int row, int col, float v) const { o[(size_t)row * ld + col] = v; }
};
struct EpiPle { static constexpr bool PAIR = false;
    float* x; const float* pp;
    DI void operator()(int row, int col, float v) const { const size_t i = (size_t)row * DM + col; x[i] = x[i] + sigmoidf_(v) * pp[i]; }
};

DI void rmsnorm_rows(int bx, int tid, const float* x, const float* __restrict__ g, bf16_t* outb, float* outf, int rows) {
    const int row = bx * 4 + (tid >> 6), lane = tid & 63;
    if (row >= rows) return;
    const float4* xr = (const float4*)(x + (size_t)row * DM);
    float4 v[4]; float s = 0.f;
#pragma unroll
    for (int j = 0; j < 4; ++j) { v[j] = xr[lane + 64 * j]; s += v[j].x * v[j].x + v[j].y * v[j].y + v[j].z * v[j].z + v[j].w * v[j].w; }
    const float rstd = rsqrtf(wave_sum(s) * (1.f / DM) + 1e-6f);
#pragma unroll
    for (int j = 0; j < 4; ++j) {
        const float4 gg = ((const float4*)g)[lane + 64 * j];
        const float a = v[j].x * rstd * gg.x, b = v[j].y * rstd * gg.y, c = v[j].z * rstd * gg.z, d = v[j].w * rstd * gg.w;
        if (outf) ((float4*)(outf + (size_t)row * DM))[lane + 64 * j] = make_float4(a, b, c, d);
        else { ushort4 o; o.x = f2bf(a); o.y = f2bf(b); o.z = f2bf(c); o.w = f2bf(d); ((ushort4*)(outb + (size_t)row * DM))[lane + 64 * j] = o; }
    }
}

DI void cvt_bf16(int bx, int nb, int tid, const float* __restrict__ in, bf16_t* __restrict__ out, size_t n) {
    for (size_t i = bx * (size_t)256 + tid; i < n; i += (size_t)nb * 256) out[i] = f2bf(in[i]);
}

DI float gelu_tanh(float x) { const float u = 0.7978845608028654f * (x + 0.044715f * x * x * x); return 0.5f * x * (1.f + tanhf(u)); }

DI void compress_naive(int bx, int by, int bz, int tid, char* sm, const bf16_t* __restrict__ KVb, const float* __restrict__ w1k, const float* __restrict__ w2k, const float* __restrict__ pek,
                                                      const float* __restrict__ w1v, const float* __restrict__ w2v, const float* __restrict__ pev, float* __restrict__ outk, float* __restrict__ outv, bf16_t* __restrict__ kcb, bf16_t* __restrict__ vcT) {
    float* flat = (float*)sm;
    float* h1 = flat + 2048;
    __syncthreads();
    const int j = bx, bg = by, kv = bz, b = bg >> 1, g = bg & 1;
    const float* w1 = kv ? w1v : w1k; const float* w2 = kv ? w2v : w2k; const float* pe = kv ? pev : pek; float* out = kv ? outv : outk;
    const int colbase = (kv ? 128 : 0) + g * 64;
    for (int e = tid; e < 2048; e += 256) {
        const int i = e >> 6, d = e & 63;
        flat[e] = bf2f(KVb[(size_t)(b * SEQ + 16 * j + i) * 512 + colbase + d]) + pe[e];
    }
    __syncthreads();
    float s = 0.f;
    for (int k = 0; k < 2048; ++k) s += flat[k] * w1[(size_t)k * 256 + tid];
    h1[tid] = gelu_tanh(s);
    __syncthreads();
    if (tid < 64) {
        float o = 0.f;
        for (int n = 0; n < 256; ++n) o += h1[n] * w2[n * 64 + tid];
        out[((size_t)bg * 256 + j) * 64 + tid] = o;
        if (kv == 0) { kcb[((size_t)bg * 256 + j) * 64 + tid] = f2bf(o); if (j == 254) kcb[((size_t)bg * 256 + 255) * 64 + tid] = 0; }
        else { vcT[((size_t)bg * 4 + (j >> 6)) * 4096 + tid * 64 + (j & 63)] = f2bf(o); if (j == 254) vcT[((size_t)bg * 4 + 3) * 4096 + tid * 64 + 63] = 0; }
    }
}

DI void softmax_row(float* row, int n, int lane) {
    float m = -3.0e38f;
    for (int j = lane; j < n; j += 64) m = fmaxf(m, row[j]);
    m = wave_max(m);
    float s = 0.f;
    for (int j = lane; j < n; j += 64) { const float e = exp2f(row[j] - m); row[j] = e; s += e; }
    s = wave_sum(s);
    const float inv = 1.f / s;
    for (int j = lane; j < n; j += 64) row[j] *= inv;
}

DI void nsa_naive(int bx, int by, int tid, char* sm, const bf16_t* __restrict__ Qb, const bf16_t* __restrict__ KVb, const bf16_t* __restrict__ VT, const float* __restrict__ kcc, const float* __restrict__ vcc, const float* __restrict__ gates, bf16_t* __restrict__ Y) {
    float (*q)[64] = (float (*)[64])sm;
    float (*sc)[1024] = (float (*)[1024])(sm + 1024);
    float* impv = (float*)(sm + 1024 + 16384);
    int* sellist = (int*)(sm + 1024 + 16384 + 256);
    int* selflag = (int*)(sm + 1024 + 16384 + 256 + 64);
    int& nsel_s = *(int*)(sm + 1024 + 16384 + 256 + 64 + 256);
    __syncthreads();
    const int tok = bx, g = by, b = tok >> 12, t = tok & 4095, hh = tid >> 6, lane = tid & 63, d = lane;
    q[hh][d] = bf2f(Qb[(size_t)tok * 512 + (g * 4 + hh) * 64 + d]);
    __syncthreads();
    const int nv = (t >= 31) ? ((t - 15) >> 4) : 0;
    const float* kcb = kcc + (size_t)(b * 2 + g) * 256 * 64; const float* vcb = vcc + (size_t)(b * 2 + g) * 256 * 64;
    if (tid < nv) {
        float s0 = 0.f, s1 = 0.f, s2 = 0.f, s3 = 0.f;
#pragma unroll 8
        for (int dd = 0; dd < 64; ++dd) { const float kx = kcb[tid * 64 + dd]; s0 += q[0][dd] * kx; s1 += q[1][dd] * kx; s2 += q[2][dd] * kx; s3 += q[3][dd] * kx; }
        sc[0][tid] = s0; sc[1][tid] = s1; sc[2][tid] = s2; sc[3][tid] = s3;
    }
    __syncthreads();
    if (nv > 0) softmax_row(sc[hh], nv, lane);
    for (int j = nv + lane; j < 256; j += 64) sc[hh][j] = 0.f;
    __syncthreads();
    float o_cmp = 0.f;
    for (int j = 0; j < nv; ++j) o_cmp += sc[hh][j] * vcb[j * 64 + d];
    const int cur = t >> 6;
    if (tid < 64) {
        const int s = tid; int lo = 4 * s - 1; if (lo < 0) lo = 0; int hi2 = 4 * s + 3; if (hi2 > 254) hi2 = 254;
        float v = 0.f;
        for (int h2 = 0; h2 < 4; ++h2) for (int j = lo; j <= hi2; ++j) v += sc[h2][j];
        if (s == 0 || s == cur || s == cur - 1) v += 1000.0f;
        if (s > cur) v = -1e30f;
        impv[s] = v;
    }
    __syncthreads();
    if (tid < 64) {
        const float v = impv[tid]; int rank = 0;
        for (int s2 = 0; s2 < 64; ++s2) { const float u = impv[s2]; rank += (u > v || (u == v && s2 < tid)) ? 1 : 0; }
        selflag[tid] = (rank < 16 && tid <= cur) ? 1 : 0;
    }
    __syncthreads();
    if (tid == 0) { int n = 0; for (int s = 0; s < 64; ++s) if (selflag[s]) { if (n < 16) sellist[n] = s; ++n; } nsel_s = n < 16 ? n : 16; }
    __syncthreads();
    const int ns = nsel_s, ne = ns * 64;
    for (int e = tid; e < ne; e += 256) {
        const int kpos = sellist[e >> 6] * 64 + (e & 63);
        if (kpos <= t) {
            const bf16_t* kp = KVb + (size_t)(b * SEQ + kpos) * 512 + 256 + g * 64;
            float s0 = 0.f, s1 = 0.f, s2 = 0.f, s3 = 0.f;
    #pragma unroll 8
        for (int dd = 0; dd < 64; ++dd) { const float kx = bf2f(kp[dd]); s0 += q[0][dd] * kx; s1 += q[1][dd] * kx; s2 += q[2][dd] * kx; s3 += q[3][dd] * kx; }
            sc[0][e] = s0; sc[1][e] = s1; sc[2][e] = s2; sc[3][e] = s3;
        } else { sc[0][e] = -1e30f; sc[1][e] = -1e30f; sc[2][e] = -1e30f; sc[3][e] = -1e30f; }
    }
    __syncthreads();
    softmax_row(sc[hh], ne, lane);
    __syncthreads();
    float o_sel = 0.f;
    for (int e = 0; e < ne; ++e) {
        const int kpos = sellist[e >> 6] * 64 + (e & 63);
        o_sel += sc[hh][e] * bf2f(VT[((size_t)(b * 2 + g) * 64 + (kpos >> 6)) * 4096 + d * 64 + (kpos & 63)]);
    }
    __syncthreads();
    const int nw = (t + 1 < 512) ? (t + 1) : 512, w0 = t - nw + 1;
    for (int e = tid; e < nw; e += 256) {
        const bf16_t* kp = KVb + (size_t)(b * SEQ + w0 + e) * 512 + 384 + g * 64;
        float s0 = 0.f, s1 = 0.f, s2 = 0.f, s3 = 0.f;
#pragma unroll 8
        for (int dd = 0; dd < 64; ++dd) { const float kx = bf2f(kp[dd]); s0 += q[0][dd] * kx; s1 += q[1][dd] * kx; s2 += q[2][dd] * kx; s3 += q[3][dd] * kx; }
        sc[0][e] = s0; sc[1][e] = s1; sc[2][e] = s2; sc[3][e] = s3;
    }
    __syncthreads();
    softmax_row(sc[hh], nw, lane);
    __syncthreads();
    float o_win = 0.f;
    for (int e = 0; e < nw; ++e) { const int kpos = w0 + e; o_win += sc[hh][e] * bf2f(VT[((size_t)(8 + b * 2 + g) * 64 + (kpos >> 6)) * 4096 + d * 64 + (kpos & 63)]); }
    const float* gt = gates + (size_t)tok * 24 + (g * 4 + hh) * 3;
    Y[(size_t)tok * DM + (g * 4 + hh) * 64 + d] = f2bf(gt[0] * o_cmp + gt[1] * o_sel + gt[2] * o_win);
}

DI void conv_silu(int bx, int tid, const bf16_t* __restrict__ MQK, const float* __restrict__ wc, const float* __restrict__ bc, bf16_t* __restrict__ out) {
    const int idx = bx * 256 + tid;
    if (idx >= T_TOK * 1024) return;
    const int c = idx & 1023, tok = idx >> 10, t = tok & 4095;
    float y = bc[c];
#pragma unroll
    for (int j = 0; j < 4; ++j) { const int tt = t - 3 + j; if (tt >= 0) y += wc[j * 1024 + c] * bf2f(MQK[(size_t)(tok - 3 + j) * 1024 + c]); }
    y = y * sigmoidf_(y);
    if (c >= 512) y *= 0.08838834764831845f;
    out[idx] = f2bf(y);
}

DI void mlstm_naive(int bx, int tid, char* sm, const bf16_t* __restrict__ qkc, const bf16_t* __restrict__ MV, const bf16_t* __restrict__ MO, const float* __restrict__ ifp, float* __restrict__ hm) {
    float (*qs)[128] = (float (*)[128])sm;
    float (*ks)[128] = (float (*)[128])(sm + 16384);
    float (*vs)[16] = (float (*)[16])(sm + 32768);
    float (*os)[16] = (float (*)[16])(sm + 32768 + 2048);
    float* gi = (float*)(sm + 32768 + 4096); float* gf = gi + 32;
    const int bh = bx >> 3, vsl = bx & 7, b = bh >> 2, h = bh & 3, v = tid >> 4, kg = tid & 15;
    float C[8], n[8];
#pragma unroll
    for (int j = 0; j < 8; ++j) { C[j] = 0.f; n[j] = 0.f; }
    for (int c0 = 0; c0 < SEQ; c0 += 32) {
        __syncthreads();
        for (int e = tid; e < 32 * 128; e += 256) {
            const int s = e >> 7, k = e & 127; const size_t tok = (size_t)b * SEQ + c0 + s;
            qs[s][k] = bf2f(qkc[tok * 1024 + h * 128 + k]); ks[s][k] = bf2f(qkc[tok * 1024 + 512 + h * 128 + k]);
        }
        for (int e = tid; e < 32 * 16; e += 256) {
            const int s = e >> 4, vv = e & 15; const size_t tok = (size_t)b * SEQ + c0 + s;
            vs[s][vv] = bf2f(MV[tok * 512 + h * 128 + vsl * 16 + vv]);
            os[s][vv] = sigmoidf_(bf2f(MO[tok * 512 + h * 128 + vsl * 16 + vv]));
        }
        if (tid < 32) { const size_t tok = (size_t)b * SEQ + c0 + tid; gi[tid] = __expf(ifp[tok * 8 + h]); gf[tid] = sigmoidf_(ifp[tok * 8 + 4 + h]); }
        __syncthreads();
        for (int s = 0; s < 32; ++s) {
            const float f = gf[s], iv = gi[s] * vs[s][v], ig = gi[s];
            float num = 0.f, den = 0.f;
#pragma unroll
            for (int j = 0; j < 8; ++j) {
                const float kx = ks[s][kg * 8 + j], qx = qs[s][kg * 8 + j];
                C[j] = f * C[j] + iv * kx; n[j] = f * n[j] + ig * kx;
                num += C[j] * qx; den += n[j] * qx;
            }
            const int l_ = lane_id_opaque();
#pragma unroll
            for (int o = 1; o < 16; o <<= 1) { num += lane_xor(num, o, l_); den += lane_xor(den, o, l_); }
            if (kg == 0) hm[((size_t)b * SEQ + c0 + s) * 512 + h * 128 + vsl * 16 + v] = num / fmaxf(fabsf(den), 1.0f) * os[s][v];
        }
    }
}

DI void hnorm(int bx, int tid, const float* __restrict__ hm, const float* __restrict__ g_hn, bf16_t* __restrict__ Y) {
    const int item = bx * 4 + (tid >> 6), lane = tid & 63;
    const int tok = item >> 2, h = item & 3;
    const float a = hm[(size_t)tok * 512 + h * 128 + lane], b = hm[(size_t)tok * 512 + h * 128 + 64 + lane];
    const float rstd = rsqrtf(wave_sum(a * a + b * b) * (1.f / 128.f) + 1e-6f);
    Y[(size_t)tok * DM + 512 + h * 128 + lane] = f2bf(a * rstd * g_hn[h * 128 + lane]);
    Y[(size_t)tok * DM + 512 + h * 128 + 64 + lane] = f2bf(b * rstd * g_hn[h * 128 + 64 + lane]);
}

DI void router(int bx, int tid, const float* __restrict__ x, const float* __restrict__ g, const float* __restrict__ w_rg, const float* __restrict__ b_rg,
                                              const float* __restrict__ w_re, const float* __restrict__ b_re, bf16_t* __restrict__ xn, float* __restrict__ gate) {
    const int tok = bx * 4 + (tid >> 6), lane = tid & 63;
    float xv[16]; float s = 0.f;
#pragma unroll
    for (int j = 0; j < 4; ++j) { const float4 v = ((const float4*)(x + (size_t)tok * DM))[lane + 64 * j]; xv[4 * j] = v.x; xv[4 * j + 1] = v.y; xv[4 * j + 2] = v.z; xv[4 * j + 3] = v.w; s += v.x * v.x + v.y * v.y + v.z * v.z + v.w * v.w; }
    const float rstd = rsqrtf(wave_sum(s) * (1.f / DM) + 1e-6f);
#pragma unroll
    for (int j = 0; j < 4; ++j) { const float4 gg = ((const float4*)g)[lane + 64 * j]; xv[4 * j] *= rstd * gg.x; xv[4 * j + 1] *= rstd * gg.y; xv[4 * j + 2] *= rstd * gg.z; xv[4 * j + 3] *= rstd * gg.w;
        ushort4 o; o.x = f2bf(xv[4 * j]); o.y = f2bf(xv[4 * j + 1]); o.z = f2bf(xv[4 * j + 2]); o.w = f2bf(xv[4 * j + 3]); ((ushort4*)(xn + (size_t)tok * DM))[lane + 64 * j] = o; }
    float mylog = 0.f;
#pragma unroll 1
    for (int c = 0; c < 20; ++c) {
        const float* w = c < 4 ? w_rg + c : w_re + (c - 4); const int ld = c < 4 ? 4 : 16;
        float a = 0.f;
#pragma unroll
        for (int j = 0; j < 4; ++j)
#pragma unroll
            for (int i = 0; i < 4; ++i) a += xv[4 * j + i] * w[(size_t)(4 * (lane + 64 * j) + i) * ld];
        a = wave_sum(a) + (c < 4 ? b_rg[c] : b_re[c - 4]);
        if (lane == c) mylog = a;
    }
    float gl[4], el[16];
#pragma unroll
    for (int c = 0; c < 4; ++c) gl[c] = lane_get(mylog, c);
#pragma unroll
    for (int c = 0; c < 16; ++c) el[c] = lane_get(mylog, 4 + c);
    if (lane == 0) {
        int gs = 0; float gm = gl[0];
#pragma unroll
        for (int c = 1; c < 4; ++c) if (gl[c] > gm) { gm = gl[c]; gs = c; }
        float se = 0.f;
#pragma unroll
        for (int c = 0; c < 4; ++c) se += __expf(gl[c] - gm);
        const float pg = 1.f / se;
        float e4[4];
#pragma unroll
        for (int c = 0; c < 4; ++c) e4[c] = gs == 0 ? el[c] : gs == 1 ? el[4 + c] : gs == 2 ? el[8 + c] : el[12 + c];
        int i0 = 0; float v0 = e4[0];
#pragma unroll
        for (int c = 1; c < 4; ++c) if (e4[c] > v0) { v0 = e4[c]; i0 = c; }
        int i1 = -1; float v1 = -3.0e38f;
#pragma unroll
        for (int c = 0; c < 4; ++c) if (c != i0 && e4[c] > v1) { v1 = e4[c]; i1 = c; }
        const float ex = __expf(v1 - v0);
        const float w0 = pg / (1.f + ex), w1 = pg * ex / (1.f + ex);
#pragma unroll
        for (int c = 0; c < 16; ++c) gate[(size_t)tok * 16 + c] = (c == gs * 4 + i0) ? w0 : (c == gs * 4 + i1) ? w1 : 0.f;
    }
}


struct EpiMoe { static constexpr bool PAIR = true;
    const float* gate; bf16_t* act;
    DI void operator()(int, int, float) const {}
    DI void pair(int row, int col, float gg, float u) const {
        const int t = col >> 7, c = col & 127, e = t >> 2, jt = t & 3, f = jt * 64 + (c >> 6) * 32 + (c & 31);
        act[(size_t)row * 4096 + e * 256 + f] = f2bf(gg * sigmoidf_(gg) * u * gate[(size_t)row * 16 + e]);
    }
};

typedef float f32x2_t __attribute__((ext_vector_type(2))); typedef __bf16 bf16x2_t __attribute__((ext_vector_type(2)));
DI unsigned cvtpk(float lo, float hi) { f32x2_t v = {lo, hi}; bf16x2_t b = __builtin_convertvector(v, bf16x2_t); return __builtin_bit_cast(unsigned, b); }
typedef __attribute__((address_space(3))) char lds_c;
typedef unsigned u32x2v __attribute__((ext_vector_type(2))); typedef unsigned u32x4v __attribute__((ext_vector_type(4)));
constexpr int NSA_KC = 0, NSA_VC = 4 * 9216, NSA_KB = NSA_VC + 4 * 8704, NSA_VB = NSA_KB + 2 * 9216, NSA_IMP = NSA_VB + 2 * 8704, NSA_MASK = NSA_IMP + 64 * 65 * 4, NSA_END = NSA_MASK + 512;
static_assert(NSA_END <= 147456, "NSA LDS map");
DI int crow(int r, int hi) { return (r & 3) + 8 * (r >> 2) + 4 * hi; }
#define MFMA32(a, b, c) __builtin_amdgcn_mfma_f32_32x32x16_bf16((a), (b), (c), 0, 0, 0)

DI void nsa_qk(f32x16& p0, f32x16& p1, const lds_c* K, const bf16x8 (&qf)[4], float cin, int r32, int hi) {
    f32x16 c;
#pragma unroll
    for (int r = 0; r < 16; ++r) c[r] = cin;
#pragma unroll
    for (int ks = 0; ks < 4; ++ks) {
        const bf16x8 a0 = *(const __attribute__((address_space(3))) bf16x8*)(K + r32 * 144 + ks * 32 + hi * 16);
        const bf16x8 a1 = *(const __attribute__((address_space(3))) bf16x8*)(K + (32 + r32) * 144 + ks * 32 + hi * 16);
        if (ks == 0) { p0 = MFMA32(a0, qf[0], c); p1 = MFMA32(a1, qf[0], c); } else { p0 = MFMA32(a0, qf[ks], p0); p1 = MFMA32(a1, qf[ks], p1); }
    }
}
DI float max3f_(float a, float b, float c) { float r; asm("v_max3_f32 %0, %1, %2, %3" : "=v"(r) : "v"(a), "v"(b), "v"(c)); return r; }
DI float max2f_(float a, float b) { float r; asm("v_max_f32_e32 %0, %1, %2" : "=v"(r) : "v"(a), "v"(b)); return r; }
DI void nsa_softmax(f32x16& p0, f32x16& p1, float& mref, float& l, bool& started, f32x16& o0, f32x16& o1) {
    float ma = max3f_(p0[0], p0[1], p1[0]), mb = max3f_(p0[2], p0[3], p1[1]); ma = max3f_(ma, p1[2], p1[3]);
#pragma unroll
    for (int r = 4; r < 16; r += 4) { ma = max3f_(ma, p0[r], p0[r + 1]); mb = max3f_(mb, p0[r + 2], p0[r + 3]); ma = max3f_(ma, p1[r], p1[r + 1]); mb = max3f_(mb, p1[r + 2], p1[r + 3]); }
    float mx = max2f_(ma, mb);
    { auto rr = __builtin_amdgcn_permlane32_swap(__float_as_uint(mx), __float_as_uint(mx), false, false); mx = max2f_(__uint_as_float(rr[0]), __uint_as_float(rr[1])); }
    const bool need = started ? (mx > 8.f) : (mx > -3.0e38f);
    if (__any(need)) {
        const float delta = need ? mx : 0.f, f = started ? __builtin_amdgcn_exp2f(-delta) : 1.f;
        mref += delta;
#pragma unroll
        for (int r = 0; r < 16; ++r) { p0[r] -= delta; p1[r] -= delta; o0[r] *= f; o1[r] *= f; }
        l *= f; started = started || need;
    }
    float s = 0.f;
#pragma unroll
    for (int r = 0; r < 16; ++r) { p0[r] = __builtin_amdgcn_exp2f(p0[r]); p1[r] = __builtin_amdgcn_exp2f(p1[r]); s += p0[r] + p1[r]; }
    l += s;
}
DI void nsa_pv(f32x16& o0, f32x16& o1, const f32x16& p0, const f32x16& p1, const lds_c* V, int r32, int hi) {
#pragma unroll
    for (int hf = 0; hf < 2; ++hf)
#pragma unroll
        for (int s = 0; s < 2; ++s) {
            unsigned pw[4];
#pragma unroll
            for (int j = 0; j < 4; ++j) pw[j] = hf ? cvtpk(p1[8 * s + 2 * j], p1[8 * s + 2 * j + 1]) : cvtpk(p0[8 * s + 2 * j], p0[8 * s + 2 * j + 1]);
            const u32x4v pbw = {pw[0], pw[1], pw[2], pw[3]};
            const bf16x8 pb = __builtin_bit_cast(bf16x8, pbw);
            const lds_c* vp = V + r32 * 136 + hf * 64 + s * 32 + hi * 8;
            const u32x2v a0l = *(const __attribute__((address_space(3))) u32x2v*)(vp), a0h = *(const __attribute__((address_space(3))) u32x2v*)(vp + 16);
            const u32x2v a1l = *(const __attribute__((address_space(3))) u32x2v*)(vp + 32 * 136), a1h = *(const __attribute__((address_space(3))) u32x2v*)(vp + 32 * 136 + 16);
            const u32x4v A0w = {a0l.x, a0l.y, a0h.x, a0h.y}, A1w = {a1l.x, a1l.y, a1h.x, a1h.y};
            o0 = MFMA32(__builtin_bit_cast(bf16x8, A0w), pb, o0); o1 = MFMA32(__builtin_bit_cast(bf16x8, A1w), pb, o1);
        }
}
DI void nsa_store_k(lds_c* K, const u32x4v v, int tid) { *(__attribute__((address_space(3))) u32x4v*)(K + (tid >> 3) * 144 + (tid & 7) * 16) = v; }
DI void nsa_store_v(lds_c* V, const u32x4v v, int tid) { lds_c* p = V + (tid >> 3) * 136 + (tid & 7) * 16; *(__attribute__((address_space(3))) u32x2v*)p = (u32x2v){v.x, v.y}; *(__attribute__((address_space(3))) u32x2v*)(p + 8) = (u32x2v){v.z, v.w}; }
#define NEG_INF (-__builtin_inff())
DI void nsa_finish(f32x16& y0, f32x16& y1, f32x16& o0, f32x16& o1, float& m, float& l, bool& started, float gate) {
    float lt; { auto rr = __builtin_amdgcn_permlane32_swap(__float_as_uint(l), __float_as_uint(l), false, false); lt = __uint_as_float(rr[0]) + __uint_as_float(rr[1]); }
    const float f = lt > 0.f ? gate / lt : 0.f;
#pragma unroll
    for (int r = 0; r < 16; ++r) { y0[r] += f * o0[r]; y1[r] += f * o1[r]; o0[r] = 0.f; o1[r] = 0.f; }
    m = 0.f; l = 0.f; started = false;
}

DI void nsa_unit(int bg, int qb, int tx, lds_c* lds, const bf16_t* __restrict__ Qb, const bf16_t* __restrict__ KVb, const bf16_t* __restrict__ VT, const bf16_t* __restrict__ kcb, const bf16_t* __restrict__ vcT,
                 const float* __restrict__ gates, bf16_t* __restrict__ Y, unsigned long long& pacc) {
    const int lane = tx & 63, r32 = lane & 31, hi = lane >> 5, wave = __builtin_amdgcn_readfirstlane(tx >> 6), hh = wave >> 1, qs = wave & 1;
    RG_BEGIN(100)
    const int b = bg >> 1, g = bg & 1, ql = 32 * qs + r32, tq = 64 * qb + ql;
    const size_t tok = (size_t)b * SEQ + tq; const int head = g * 4 + hh;
    const int nc = (4 * qb + 66) >> 6;
    const bool need_topk = qb >= 16;
    lds_c* KC = lds + NSA_KC; lds_c* VC = lds + NSA_VC; lds_c* KB = lds + NSA_KB; lds_c* VB = lds + NSA_VB;
    __attribute__((address_space(3))) float* imp = (__attribute__((address_space(3))) float*)(lds + NSA_IMP);
    __attribute__((address_space(3))) unsigned* msk = (__attribute__((address_space(3))) unsigned*)(lds + NSA_MASK);
    const bf16_t* kcsrc = kcb + (size_t)bg * 256 * 64; const bf16_t* vcsrc = vcT + (size_t)bg * 4 * 4096;
    const bf16_t* kssrc = KVb + (size_t)b * SEQ * 512 + 256 + g * 64; const bf16_t* kwsrc = KVb + (size_t)b * SEQ * 512 + 384 + g * 64;
    const bf16_t* vssrc = VT + (size_t)bg * 64 * 4096; const bf16_t* vwsrc = VT + (size_t)(8 + bg) * 64 * 4096;
    const int n_sel = qb + 1, n_win = qb + 1 < 9 ? qb + 1 : 9, ntile = n_sel + n_win;
    __syncthreads();
    for (int c = 0; c < nc; ++c) {
        nsa_store_k(KC + c * 9216, *(const u32x4v*)(kcsrc + (size_t)(c * 64 + (tx >> 3)) * 64 + (tx & 7) * 8), tx);
        nsa_store_v(VC + c * 8704, *(const u32x4v*)(vcsrc + (size_t)c * 4096 + (tx >> 3) * 64 + (tx & 7) * 8), tx);
    }
    nsa_store_k(KB, *(const u32x4v*)(kssrc + (size_t)(tx >> 3) * 512 + (tx & 7) * 8), tx);
    nsa_store_v(VB, *(const u32x4v*)(vssrc + (tx >> 3) * 64 + (tx & 7) * 8), tx);
    for (int i = tx; i < 64 * 65; i += 512) imp[i] = 0.f;
    bf16x8 qf[4];
#pragma unroll
    for (int ks = 0; ks < 4; ++ks) qf[ks] = *(const bf16x8*)(Qb + tok * 512 + head * 64 + ks * 16 + hi * 8);
    const float g_cmp = gates[tok * 24 + head * 3 + 0], g_sel = gates[tok * 24 + head * 3 + 1], g_win = gates[tok * 24 + head * 3 + 2];
    f32x16 y0, y1, o0, o1, p0, p1;
#pragma unroll
    for (int r = 0; r < 16; ++r) { y0[r] = 0.f; y1[r] = 0.f; o0[r] = 0.f; o1[r] = 0.f; }
    float m = 0.f, l = 0.f; bool started = false;
    __syncthreads();
    RG_END(100)
    RG_BEGIN(101)
    const int nvq = tq >= 31 ? ((tq - 15) >> 4) : 0;
    for (int c = 0; c < nc; ++c) {
        nsa_qk(p0, p1, KC + c * 9216, qf, -m, r32, hi);
        const int lim = nvq - 64 * c;
#pragma unroll
        for (int r = 0; r < 16; ++r) { const int kl = crow(r, hi); if (kl >= lim) p0[r] = NEG_INF; if (kl + 32 >= lim) p1[r] = NEG_INF; }
        nsa_softmax(p0, p1, m, l, started, o0, o1);
        nsa_pv(o0, o1, p0, p1, VC + c * 8704, r32, hi);
    }
    const float m_c = m; float l_c; { auto rr = __builtin_amdgcn_permlane32_swap(__float_as_uint(l), __float_as_uint(l), false, false); l_c = __uint_as_float(rr[0]) + __uint_as_float(rr[1]); }
    nsa_finish(y0, y1, o0, o1, m, l, started, g_cmp);
    RG_END(101)
    unsigned mlo = 0xffffffffu, mhi = 0xffffffffu;
    RG_BEGIN(102)
    if (need_topk) {
        const float invl = l_c > 0.f ? 16777216.f / l_c : 0.f;
        __attribute__((address_space(3))) unsigned* impu = (__attribute__((address_space(3))) unsigned*)imp;
        for (int c = 0; c < nc; ++c) {
            nsa_qk(p0, p1, KC + c * 9216, qf, -m_c, r32, hi);
            const int lim = nvq - 64 * c;
#pragma unroll
            for (int r = 0; r < 16; ++r) { const int kl = crow(r, hi);
                p0[r] = kl < lim ? __builtin_amdgcn_exp2f(p0[r]) * invl : 0.f; p1[r] = kl + 32 < lim ? __builtin_amdgcn_exp2f(p1[r]) * invl : 0.f; }
#pragma unroll
            for (int hf = 0; hf < 2; ++hf)
#pragma unroll
                for (int i = 0; i < 4; ++i) {
                    const int a = 16 * c + 8 * hf + 2 * i + hi;
                    const unsigned u0 = (unsigned)__float2uint_rn(hf ? p1[4 * i] : p0[4 * i]), u1 = (unsigned)__float2uint_rn(hf ? p1[4 * i + 1] : p0[4 * i + 1]);
                    const unsigned u2 = (unsigned)__float2uint_rn(hf ? p1[4 * i + 2] : p0[4 * i + 2]), u3 = (unsigned)__float2uint_rn(hf ? p1[4 * i + 3] : p0[4 * i + 3]);
                    __hip_atomic_fetch_add(impu + ql * 65 + a, u0 + u1 + u2 + u3, __ATOMIC_RELAXED, __HIP_MEMORY_SCOPE_WORKGROUP);
                    if (a + 1 < 64) __hip_atomic_fetch_add(impu + ql * 65 + a + 1, u3, __ATOMIC_RELAXED, __HIP_MEMORY_SCOPE_WORKGROUP);
                }
        }
        __syncthreads();
        RG_BEGIN(103)
        {
            const int q = tx >> 3, j8 = tx & 7, smax = qb - 2;
            unsigned key[8];
#pragma unroll
            for (int k = 0; k < 8; ++k) { const int sb = j8 + 8 * k; key[k] = (sb >= 1 && sb <= smax) ? ((impu[q * 65 + sb] & ~63u) | (unsigned)(63 - sb)) + 64u : 0u; }
            unsigned blo = 0u, bhi = 0u;
#pragma unroll 1
            for (int round = 0; round < 13; ++round) {
                unsigned mx = key[0];
#pragma unroll
                for (int k = 1; k < 8; ++k) mx = mx > key[k] ? mx : key[k];
                { const unsigned t = (unsigned)__builtin_amdgcn_update_dpp(0, (int)mx, 0xB1, 0xf, 0xf, true); mx = mx > t ? mx : t; }
                { const unsigned t = (unsigned)__builtin_amdgcn_update_dpp(0, (int)mx, 0x4E, 0xf, 0xf, true); mx = mx > t ? mx : t; }
                { const unsigned t = (unsigned)__builtin_amdgcn_update_dpp(0, (int)mx, 0x141, 0xf, 0xf, true); mx = mx > t ? mx : t; }
#pragma unroll
                for (int k = 0; k < 8; ++k) if (key[k] == mx && mx != 0u) { key[k] = 0u; const int sb = j8 + 8 * k; if (sb < 32) blo |= 1u << sb; else bhi |= 1u << (sb - 32); }
            }
            const int l_ = lane_id_opaque();
#pragma unroll
            for (int o = 1; o < 8; o <<= 1) { blo |= (unsigned)__builtin_amdgcn_ds_bpermute((l_ ^ o) << 2, (int)blo); bhi |= (unsigned)__builtin_amdgcn_ds_bpermute((l_ ^ o) << 2, (int)bhi); }
            unsigned long long mm = ((unsigned long long)bhi << 32) | blo;
            mm |= 1ull | (1ull << qb) | (1ull << (qb - 1));
            if (j8 == 0) { msk[q * 2] = (unsigned)mm; msk[q * 2 + 1] = (unsigned)(mm >> 32); }
        }
        __syncthreads();
        RG_END(103)
        mlo = msk[ql * 2]; mhi = msk[ql * 2 + 1];
    }
    RG_END(102)
    RG_BEGIN(104)
#define NSA_SRC(i_, KP, VP) do { const bool nsel_ = (i_) < n_sel; const int s2_ = nsel_ ? (i_) : qb - n_win + 1 + ((i_) - n_sel); \
        KP = (nsel_ ? kssrc : kwsrc) + (size_t)(s2_ * 64 + (tx >> 3)) * 512 + (tx & 7) * 8; VP = (nsel_ ? vssrc : vwsrc) + (size_t)s2_ * 4096 + (tx >> 3) * 64 + (tx & 7) * 8; } while (0)
#define NSA_TILE(i_, cur_, KLD, VLD, KST, VST) do { \
        const bool is_sel = (i_) < n_sel; const int s = is_sel ? (i_) : qb - n_win + 1 + ((i_) - n_sel); \
        if ((i_) + 2 < ntile) { const bf16_t* kp_; const bf16_t* vp_; NSA_SRC((i_) + 2, kp_, vp_); KLD = *(const u32x4v*)kp_; VLD = *(const u32x4v*)vp_; } \
        const bool on = !is_sel || ((s < 32 ? (mlo >> s) : (mhi >> (s - 32))) & 1u) != 0u; \
        nsa_qk(p0, p1, KB + (cur_) * 9216, qf, on ? -m : NEG_INF, r32, hi); \
        const bool lowb = !is_sel && (qb >= 8) && (s == qb - 8), diag = (s == qb); \
        if (lowb || diag) { \
            asm volatile("; boundary tile" ::: "memory");        \
            _Pragma("unroll") for (int r = 0; r < 16; ++r) { const int kl = crow(r, hi); \
                if ((lowb && kl <= ql) || (diag && kl > ql)) p0[r] = NEG_INF; if ((lowb && kl + 32 <= ql) || (diag && kl + 32 > ql)) p1[r] = NEG_INF; } \
        } \
        nsa_softmax(p0, p1, m, l, started, o0, o1); \
        nsa_pv(o0, o1, p0, p1, VB + (cur_) * 8704, r32, hi); \
        if ((i_) == n_sel - 1) nsa_finish(y0, y1, o0, o1, m, l, started, g_sel); \
        if ((i_) == ntile - 1) nsa_finish(y0, y1, o0, o1, m, l, started, g_win); \
        if ((i_) + 1 < ntile) { nsa_store_k(KB + ((cur_) ^ 1) * 9216, KST, tx); nsa_store_v(VB + ((cur_) ^ 1) * 8704, VST, tx); } \
        __syncthreads(); } while (0)
    u32x4v kA = {0u, 0u, 0u, 0u}, vA = kA, kB2 = kA, vB2 = kA;
    if (ntile > 1) { const bf16_t* kp_; const bf16_t* vp_; NSA_SRC(1, kp_, vp_); kA = *(const u32x4v*)kp_; vA = *(const u32x4v*)vp_; }
    {
        int i = 0;
        for (; i + 1 < ntile; i += 2) {
            NSA_TILE(i, 0, kB2, vB2, kA, vA);
            NSA_TILE(i + 1, 1, kA, vA, kB2, vB2);
        }
        if (i < ntile) NSA_TILE(i, 0, kB2, vB2, kA, vA);
    }
#undef NSA_TILE
#undef NSA_SRC
    RG_END(104)
    bf16_t* yp = Y + tok * DM + head * 64;
#pragma unroll
    for (int i = 0; i < 4; ++i) {
        *(uint2*)(yp + 8 * i + 4 * hi) = make_uint2(cvtpk(y0[4 * i], y0[4 * i + 1]), cvtpk(y0[4 * i + 2], y0[4 * i + 3]));
        *(uint2*)(yp + 32 + 8 * i + 4 * hi) = make_uint2(cvtpk(y1[4 * i], y1[4 * i + 1]), cvtpk(y1[4 * i + 2], y1[4 * i + 3]));
    }
}

DI float log_sigmoid_(float x) { return x >= 0.f ? -__logf(1.f + __expf(-x)) : x - __logf(1.f + __expf(x)); }
DI float lane_shr_add(float v, int l) {
#pragma unroll
    for (int o = 1; o < 64; o <<= 1) { const float t = lane_get(v, l - o); if (l >= o) v += t; }
    return v;
}
DI float lane_shr_max(float v, int l) {
#pragma unroll
    for (int o = 1; o < 64; o <<= 1) { const float t = lane_get(v, l - o); if (l >= o) v = fmaxf(v, t); }
    return v;
}
DI float log_sigmoid_fast(float x) { return -__logf(1.f + __expf(-x)); }
DI void ml_mscan_all(const float* __restrict__ ifp, int bh, int lane, float* __restrict__ mtab, float* __restrict__ wprev, float* __restrict__ wsc) {
    const int b = bh >> 2, h = bh & 3;
    const float* gp = ifp + ((size_t)b * SEQ + 64 * lane) * 8 + h;
    float L = 0.f, mx = -3.0e38f;
#pragma unroll 16
    for (int s = 0; s < 64; ++s) { const float iv = gp[s * 8], fv = gp[s * 8 + 4]; L += log_sigmoid_fast(fv); mx = fmaxf(mx, iv - L); }
    const float G = L + mx;
    float m = 0.f, mine = 0.f, mnext = 0.f;
#pragma unroll
    for (int k = 0; k < 64; ++k) {
        const float Lk = __builtin_bit_cast(float, __builtin_amdgcn_readlane(__builtin_bit_cast(int, L), k)), Gk = __builtin_bit_cast(float, __builtin_amdgcn_readlane(__builtin_bit_cast(int, G), k));
        if (k == lane) mine = m;
        m = fmaxf(Lk + m, Gk);
        if (k == lane) mnext = m;
    }
    mtab[bh * 65 + lane] = mine;
    wprev[bh * 64 + lane] = __expf(L + mine - mnext);
    wsc[bh * 64 + lane] = __expf(G - mnext);
}
DI void ml_conv8(float (&o)[8], const bf16_t* __restrict__ MQK, size_t tok, int t_in_seq, int col, const float* __restrict__ wc, const float* __restrict__ bc, float scale) {
    const float4 b0 = *(const float4*)(bc + col), b1 = *(const float4*)(bc + col + 4);
    o[0] = b0.x; o[1] = b0.y; o[2] = b0.z; o[3] = b0.w; o[4] = b1.x; o[5] = b1.y; o[6] = b1.z; o[7] = b1.w;
#pragma unroll
    for (int j = 0; j < 4; ++j) {
        if (t_in_seq - 3 + j >= 0) {
            float u[8]; unpack8(*(const pg8::u32x4*)(MQK + (tok - 3 + j) * 1024 + col), u);
            const float4 w0 = *(const float4*)(wc + j * 1024 + col), w1 = *(const float4*)(wc + j * 1024 + col + 4);
            o[0] += w0.x * u[0]; o[1] += w0.y * u[1]; o[2] += w0.z * u[2]; o[3] += w0.w * u[3]; o[4] += w1.x * u[4]; o[5] += w1.y * u[5]; o[6] += w1.z * u[6]; o[7] += w1.w * u[7];
        }
    }
#pragma unroll
    for (int i = 0; i < 8; ++i) o[i] = o[i] * sigmoidf_(o[i]) * scale;
}
constexpr float ML_KSCALE = 0.08838834764831845f;
DI void ml_unit_c(int bh, int c, int tx, lds_c* lds, const bf16_t* __restrict__ MQK, const bf16_t* __restrict__ MV, const float* __restrict__ ifp, const float* __restrict__ wc, const float* __restrict__ bc,
                  bf16_t* __restrict__ dC, float* __restrict__ dn, float* __restrict__ wprev, const float* __restrict__ mtab) {
    const int b = bh >> 2, h = bh & 3, lane = tx & 63, r32 = lane & 31, hi = lane >> 5, wave = __builtin_amdgcn_readfirstlane(tx >> 6);
    lds_c* KT = lds; lds_c* VTw = lds + 128 * 144;
    __attribute__((address_space(3))) float* wsm = (__attribute__((address_space(3))) float*)(lds + 2 * 128 * 144);
    const size_t tok0 = (size_t)b * SEQ + 64 * c;
    __syncthreads();
    if (wave == 0) {
        const float iv = ifp[(tok0 + lane) * 8 + h], lf = log_sigmoid_(ifp[(tok0 + lane) * 8 + 4 + h]);
        const int l_ = lane_id_opaque();
        const float bc_ = lane_shr_add(lf, l_), u = iv - bc_, umax = wave_max(u);
        wsm[lane] = __expf(u - umax);
        (void)wprev; (void)mtab;
    }
    __syncthreads();
#pragma unroll 1
    for (int it = tx; it < 1024; it += 512) {
        const int s = it >> 4, d0 = (it & 15) * 8; float kv[8];
        ml_conv8(kv, MQK, tok0 + s, 64 * c + s, 512 + h * 128 + d0, wc, bc, ML_KSCALE);
        float vv[8]; unpack8(*(const pg8::u32x4*)(MV + (tok0 + s) * 512 + h * 128 + d0), vv);
        const float w = wsm[s];
#pragma unroll
        for (int i = 0; i < 8; ++i) {
            *(__attribute__((address_space(3))) bf16_t*)(KT + (d0 + i) * 144 + s * 2) = f2bf(kv[i]);
            *(__attribute__((address_space(3))) bf16_t*)(VTw + (d0 + i) * 144 + s * 2) = f2bf(vv[i] * w);
        }
    }
    __syncthreads();
    if (tx < 128) {
        float a = 0.f;
        for (int s = 0; s < 64; ++s) a += wsm[s] * bf2f(*(const __attribute__((address_space(3))) bf16_t*)(KT + tx * 144 + s * 2));
        dn[((size_t)bh * 64 + c) * 128 + tx] = a;
    }
    {
        const int vb = wave >> 1, kh = wave & 1;
        f32x16 acc0, acc1;
#pragma unroll
        for (int r = 0; r < 16; ++r) { acc0[r] = 0.f; acc1[r] = 0.f; }
#pragma unroll
        for (int ks = 0; ks < 4; ++ks) {
            const bf16x8 a = *(const __attribute__((address_space(3))) bf16x8*)(VTw + (vb * 32 + r32) * 144 + ks * 32 + hi * 16);
            const bf16x8 b0 = *(const __attribute__((address_space(3))) bf16x8*)(KT + (kh * 64 + r32) * 144 + ks * 32 + hi * 16);
            const bf16x8 b1 = *(const __attribute__((address_space(3))) bf16x8*)(KT + (kh * 64 + 32 + r32) * 144 + ks * 32 + hi * 16);
            acc0 = MFMA32(a, b0, acc0); acc1 = MFMA32(a, b1, acc1);
        }
        bf16_t* o = dC + ((size_t)bh * 64 + c) * 16384;
#pragma unroll
        for (int r = 0; r < 16; ++r) { const int v = vb * 32 + crow(r, hi);
            o[v * 128 + kh * 64 + r32] = f2bf(acc0[r]); o[v * 128 + kh * 64 + 32 + r32] = f2bf(acc1[r]); }
    }
}
DI void ml_scan(int gtid, int nthreads, bf16_t* __restrict__ dC, float* __restrict__ dn, const float* __restrict__ wprev, const float* __restrict__ wsc) {
    for (int p = gtid; p < 16 * 8192; p += nthreads) {
        const int bh = p >> 13, e2 = p & 8191;
        unsigned* base = (unsigned*)(dC + (size_t)bh * 64 * 16384) + e2;
        float r0 = 0.f, r1 = 0.f;
#pragma unroll 1
        for (int c0 = 0; c0 < 64; c0 += 16) {
            unsigned v[16];
#pragma unroll
            for (int j = 0; j < 16; ++j) v[j] = base[(size_t)(c0 + j) * 8192];
#pragma unroll
            for (int j = 0; j < 16; ++j) {
                const float w = wprev[bh * 64 + c0 + j], sc = wsc[bh * 64 + c0 + j];
                base[(size_t)(c0 + j) * 8192] = pk2(r0, r1);
                r0 = w * r0 + sc * __uint_as_float(v[j] << 16); r1 = w * r1 + sc * __uint_as_float(v[j] & 0xffff0000u);
            }
        }
    }
    for (int p = gtid; p < 16 * 128; p += nthreads) {
        const int bh = p >> 7, k = p & 127; float r = 0.f; float* q = dn + (size_t)bh * 64 * 128 + k;
#pragma unroll 1
        for (int c0 = 0; c0 < 64; c0 += 16) {
            float v[16];
#pragma unroll
            for (int j = 0; j < 16; ++j) v[j] = q[(c0 + j) * 128];
#pragma unroll
            for (int j = 0; j < 16; ++j) { q[(c0 + j) * 128] = r; r = wprev[bh * 64 + c0 + j] * r + wsc[bh * 64 + c0 + j] * v[j]; }
        }
    }
}
DI void ml_unit_e(int bh, int c, int tx, lds_c* lds, const bf16_t* __restrict__ MQK, const bf16_t* __restrict__ MV, const bf16_t* __restrict__ MO, const float* __restrict__ ifp,
                  const float* __restrict__ wc, const float* __restrict__ bc, const bf16_t* __restrict__ Sst, const float* __restrict__ nst, const float* __restrict__ mtab, const float* __restrict__ g_hn, bf16_t* __restrict__ Y) {
    const int b = bh >> 2, h = bh & 3, lane = tx & 63, r32 = lane & 31, hi = lane >> 5, wave = __builtin_amdgcn_readfirstlane(tx >> 6);
    lds_c* Qi = lds; lds_c* Ki = lds + 64 * 272; lds_c* VTi = lds + 2 * 64 * 272; lds_c* Si = VTi + 128 * 136;
    __attribute__((address_space(3))) float* fsm = (__attribute__((address_space(3))) float*)(Si + 128 * 272);
    const size_t tok0 = (size_t)b * SEQ + 64 * c;
    const float m_c = mtab[bh * 65 + c];
    __syncthreads();
    if (wave == 0) {
        const float iv = ifp[(tok0 + lane) * 8 + h], lf = log_sigmoid_(ifp[(tok0 + lane) * 8 + 4 + h]);
        const int l_ = lane_id_opaque();
        const float bc_ = lane_shr_add(lf, l_), u = iv - bc_, M = fmaxf(lane_shr_max(u, l_), m_c);
        fsm[lane] = u; fsm[64 + lane] = M; fsm[128 + lane] = __expf(-(bc_ + M));
    }
    if (wave == 1) { fsm[192 + lane] = nst[((size_t)bh * 64 + c) * 128 + lane]; fsm[192 + 64 + lane] = nst[((size_t)bh * 64 + c) * 128 + 64 + lane]; }
#pragma unroll 1
    for (int it = tx; it < 1024; it += 512) {
        const int s = it >> 4, d0 = (it & 15) * 8; float qv[8], kv[8];
        ml_conv8(qv, MQK, tok0 + s, 64 * c + s, h * 128 + d0, wc, bc, 1.f);
        ml_conv8(kv, MQK, tok0 + s, 64 * c + s, 512 + h * 128 + d0, wc, bc, ML_KSCALE);
        *(__attribute__((address_space(3))) pg8::u32x4*)(Qi + s * 272 + d0 * 2) = pack8(qv);
        *(__attribute__((address_space(3))) pg8::u32x4*)(Ki + s * 272 + d0 * 2) = pack8(kv);
        const pg8::u32x4 vw = *(const pg8::u32x4*)(MV + (tok0 + s) * 512 + h * 128 + d0);
        __attribute__((address_space(3))) bf16_t* vt = (__attribute__((address_space(3))) bf16_t*)(VTi + d0 * 136 + s * 2);
        vt[0] = (bf16_t)(vw.x & 0xffffu); vt[68] = (bf16_t)(vw.x >> 16); vt[136] = (bf16_t)(vw.y & 0xffffu); vt[204] = (bf16_t)(vw.y >> 16);
        vt[272] = (bf16_t)(vw.z & 0xffffu); vt[340] = (bf16_t)(vw.z >> 16); vt[408] = (bf16_t)(vw.w & 0xffffu); vt[476] = (bf16_t)(vw.w >> 16);
    }
    {
        const bf16_t* src = Sst + ((size_t)bh * 64 + c) * 16384;
#pragma unroll
        for (int j = 0; j < 4; ++j) { const int ch = tx + 512 * j, v = ch >> 4, k8 = (ch & 15) * 8;
            *(__attribute__((address_space(3))) pg8::u32x4*)(Si + v * 272 + k8 * 2) = *(const pg8::u32x4*)(src + v * 128 + k8); }
    }
    __syncthreads();
    const int tb = wave & 1, vb = wave >> 1, t = tb * 32 + r32;
    bf16x8 qf[8];
#pragma unroll
    for (int ks = 0; ks < 8; ++ks) qf[ks] = *(const __attribute__((address_space(3))) bf16x8*)(Qi + t * 272 + ks * 32 + hi * 16);
    f32x16 a0, a1;
#pragma unroll
    for (int r = 0; r < 16; ++r) { a0[r] = 0.f; a1[r] = 0.f; }
#pragma unroll
    for (int ks = 0; ks < 8; ++ks) {
        const bf16x8 k0 = *(const __attribute__((address_space(3))) bf16x8*)(Ki + r32 * 272 + ks * 32 + hi * 16);
        const bf16x8 k1 = *(const __attribute__((address_space(3))) bf16x8*)(Ki + (32 + r32) * 272 + ks * 32 + hi * 16);
        a0 = MFMA32(k0, qf[ks], a0); a1 = MFMA32(k1, qf[ks], a1);
    }
    const float Mt = fsm[64 + t], dec = __expf(m_c - Mt);
    float rs = 0.f;
#pragma unroll
    for (int r = 0; r < 16; ++r) {
        const int s0 = crow(r, hi), s1 = 32 + s0;
        a0[r] = s0 <= t ? __expf(fsm[s0] - Mt) * a0[r] : 0.f; a1[r] = s1 <= t ? __expf(fsm[s1] - Mt) * a1[r] : 0.f;
        rs += a0[r] + a1[r];
    }
    float nq = 0.f;
#pragma unroll
    for (int ks = 0; ks < 8; ++ks) { float qv[8]; unpack8(__builtin_bit_cast(pg8::u32x4, qf[ks]), qv);
#pragma unroll
        for (int j = 0; j < 8; ++j) nq += qv[j] * fsm[192 + ks * 16 + hi * 8 + j]; }
    float den = rs + dec * nq;
    { auto rr = __builtin_amdgcn_permlane32_swap(__float_as_uint(den), __float_as_uint(den), false, false); den = __uint_as_float(rr[0]) + __uint_as_float(rr[1]); }
    f32x16 n1, n2;
#pragma unroll
    for (int r = 0; r < 16; ++r) { n1[r] = 0.f; n2[r] = 0.f; }
#pragma unroll
    for (int hf = 0; hf < 2; ++hf)
#pragma unroll
        for (int ss = 0; ss < 2; ++ss) {
            unsigned pw[4];
#pragma unroll
            for (int j = 0; j < 4; ++j) pw[j] = hf ? cvtpk(a1[8 * ss + 2 * j], a1[8 * ss + 2 * j + 1]) : cvtpk(a0[8 * ss + 2 * j], a0[8 * ss + 2 * j + 1]);
            const u32x4v pbw = {pw[0], pw[1], pw[2], pw[3]};
            const lds_c* vp = VTi + (vb * 32 + r32) * 136 + hf * 64 + ss * 32 + hi * 8;
            const u32x2v lo = *(const __attribute__((address_space(3))) u32x2v*)vp, hi2 = *(const __attribute__((address_space(3))) u32x2v*)(vp + 16);
            const u32x4v aw = {lo.x, lo.y, hi2.x, hi2.y};
            n1 = MFMA32(__builtin_bit_cast(bf16x8, aw), __builtin_bit_cast(bf16x8, pbw), n1);
        }
#pragma unroll
    for (int ks = 0; ks < 8; ++ks) {
        const bf16x8 sa = *(const __attribute__((address_space(3))) bf16x8*)(Si + (vb * 32 + r32) * 272 + ks * 32 + hi * 16);
        n2 = MFMA32(sa, qf[ks], n2);
    }
    const float inv = 1.f / fmaxf(fabsf(den), fsm[128 + t]);
    const bf16_t* op = MO + (tok0 + t) * 512 + h * 128 + vb * 32;
    float hv[16]; float ssq = 0.f;
#pragma unroll
    for (int i = 0; i < 4; ++i) {
        const u32x2v ow = *(const u32x2v*)(op + 8 * i + 4 * hi);
        const float o4[4] = {__uint_as_float(ow.x << 16), __uint_as_float(ow.x & 0xffff0000u), __uint_as_float(ow.y << 16), __uint_as_float(ow.y & 0xffff0000u)};
#pragma unroll
        for (int j = 0; j < 4; ++j) { const float x = (n1[4 * i + j] + dec * n2[4 * i + j]) * inv * sigmoidf_(o4[j]); hv[4 * i + j] = x; ssq += x * x; }
    }
    { auto rr = __builtin_amdgcn_permlane32_swap(__float_as_uint(ssq), __float_as_uint(ssq), false, false); ssq = __uint_as_float(rr[0]) + __uint_as_float(rr[1]); }
    if (hi == 0) fsm[320 + t * 4 + vb] = ssq;
    __syncthreads();
    const float tot = (fsm[320 + t * 4] + fsm[320 + t * 4 + 1]) + (fsm[320 + t * 4 + 2] + fsm[320 + t * 4 + 3]);
    const float rstd = rsqrtf(tot * (1.f / 128.f) + 1e-6f);
    bf16_t* yp = Y + (tok0 + t) * DM + 512 + h * 128 + vb * 32; const float* gp = g_hn + h * 128 + vb * 32;
#pragma unroll
    for (int i = 0; i < 4; ++i) {
        const float4 gg = *(const float4*)(gp + 8 * i + 4 * hi);
        *(u32x2v*)(yp + 8 * i + 4 * hi) = (u32x2v){cvtpk(hv[4 * i] * rstd * gg.x, hv[4 * i + 1] * rstd * gg.y), cvtpk(hv[4 * i + 2] * rstd * gg.z, hv[4 * i + 3] * rstd * gg.w)};
    }
}

DI void cmp_unit(int kv, int bg, int jt, int tx, lds_c* lds, const bf16_t* __restrict__ KVb, const bf16_t* __restrict__ W1t, const bf16_t* __restrict__ W2t, const float* __restrict__ bias1p,
                 float* __restrict__ outf, bf16_t* __restrict__ kcb, bf16_t* __restrict__ vcT) {
    const int b = bg >> 1, g = bg & 1, lane = tx & 63, r32 = lane & 31, hi = lane >> 5, wave = __builtin_amdgcn_readfirstlane(tx >> 6), j0 = jt * 32;
    lds_c* TI = lds; lds_c* H1 = lds + 16 * 34 * 144;
    const bf16_t* src = KVb + ((size_t)b * SEQ + 16 * j0) * 512 + (kv ? 128 : 0) + g * 64;
    __syncthreads();
    for (int ch = tx; ch < 528 * 8; ch += 512) {
        const int t = ch >> 3, c8 = ch & 7;
        *(__attribute__((address_space(3))) pg8::u32x4*)(TI + ((t & 15) * 34 + (t >> 4)) * 144 + c8 * 16) = *(const pg8::u32x4*)(src + (size_t)t * 512 + c8 * 8);
    }
    __syncthreads();
    f32x16 acc;
#pragma unroll
    for (int r = 0; r < 16; ++r) acc[r] = 0.f;
    const bf16_t* wrow = W1t + (size_t)(wave * 32 + r32) * 2048 + hi * 8;
#pragma unroll 4
    for (int i = 0; i < 32; ++i) {
        const lds_c* arow = TI + ((i & 15) * 34 + r32 + (i >> 4)) * 144 + hi * 16;
#pragma unroll
        for (int dk = 0; dk < 4; ++dk) {
            const bf16x8 a = *(const __attribute__((address_space(3))) bf16x8*)(arow + dk * 32);
            const bf16x8 bfr = *(const bf16x8*)(wrow + i * 64 + dk * 16);
            acc = MFMA32(a, bfr, acc);
        }
    }
    {
        const int n = wave * 32 + r32; const float bias = bias1p[kv * 256 + n];
#pragma unroll
        for (int r = 0; r < 16; ++r) *(__attribute__((address_space(3))) bf16_t*)(H1 + crow(r, hi) * 528 + n * 2) = f2bf(gelu_tanh(acc[r] + bias));
    }
    __syncthreads();
    if (wave < 2) {
        f32x16 o;
#pragma unroll
        for (int r = 0; r < 16; ++r) o[r] = 0.f;
        const bf16_t* w2row = W2t + (size_t)(wave * 32 + r32) * 256 + hi * 8;
#pragma unroll
        for (int ks = 0; ks < 16; ++ks) {
            const bf16x8 a = *(const __attribute__((address_space(3))) bf16x8*)(H1 + r32 * 528 + ks * 32 + hi * 16);
            const bf16x8 bfr = *(const bf16x8*)(w2row + ks * 16);
            o = MFMA32(a, bfr, o);
        }
        const int d = wave * 32 + r32;
#pragma unroll
        for (int r = 0; r < 16; ++r) {
            const int j = j0 + crow(r, hi); const float v = j < 255 ? o[r] : 0.f;
            outf[((size_t)bg * 256 + j) * 64 + d] = v;
            if (kv == 0) kcb[((size_t)bg * 256 + j) * 64 + d] = f2bf(v);
            else vcT[((size_t)bg * 4 + (j >> 6)) * 4096 + d * 64 + (j & 63)] = f2bf(v);
        }
    }
}

#define XB_TMO      128
#define XB_XCNT(j)  (256  + 64 * (j))
#define XB_XSUB(j)  (1280 + 64 * (j))
#define XB_XGEN(j)  (2304 + 64 * (j))
#define XB_TOP      3328
#define XB_TOPGEN   3392
#define XCD_BAR_WORDS 3456
#define XB_SPIN_CAP (1u << 23)

__device__ __forceinline__ unsigned xb_ld(unsigned* p)              { return __hip_atomic_load(p, __ATOMIC_RELAXED, __HIP_MEMORY_SCOPE_AGENT); }
__device__ __forceinline__ unsigned xb_add(unsigned* p, unsigned v) { return __hip_atomic_fetch_add(p, v, __ATOMIC_RELAXED, __HIP_MEMORY_SCOPE_AGENT); }
__device__ __forceinline__ unsigned xb_xcc_id() { return (unsigned)__builtin_amdgcn_s_getreg((3 << 11) | 20) & 0xFu; }
#define XB_SPIN(cond, bar) do { unsigned _sp = 0; while (cond) { __builtin_amdgcn_s_sleep(1); \
    if ((++_sp & 255u) == 0u) { if (xb_ld(&(bar)[XB_TMO])) break; if (_sp > XB_SPIN_CAP) { atomicAdd(&(bar)[XB_TMO], 1u); break; } } } } while (0)

struct XcdBarrier {
    unsigned* bar; unsigned x;
    volatile __attribute__((address_space(3))) unsigned* st;
};

__device__ __forceinline__ XcdBarrier xcd_barrier_post(unsigned* bar, volatile __attribute__((address_space(3))) unsigned* st) {
    XcdBarrier b; b.bar = bar; b.x = xb_xcc_id(); b.st = st;
    if (threadIdx.x == 0) (void)xb_add(&bar[XB_XCNT(b.x)], 1u);
    return b;
}
__device__ __forceinline__ void xcd_barrier_complete(unsigned* bar, unsigned x, unsigned& nloc, unsigned& nx) {
    const unsigned G = gridDim.x * gridDim.y * gridDim.z;
    unsigned sum, cnt, mine, sp = 0u;
    for (;;) {
        sum = 0u; cnt = 0u; mine = 0u;
#pragma unroll
        for (unsigned j = 0; j < 16; ++j) { const unsigned c = xb_ld(&bar[XB_XCNT(j)]); sum += c; cnt += (c > 0u) ? 1u : 0u; mine = (j == x) ? c : mine; }
        if (sum == G) break;
        __builtin_amdgcn_s_sleep(1);
        if ((++sp & 255u) == 0u) { if (xb_ld(&bar[XB_TMO])) break; if (sp > XB_SPIN_CAP) { atomicAdd(&bar[XB_TMO], 1u); break; } }
    }
    nloc = mine > 0u ? mine : 1u; nx = cnt > 0u ? cnt : 1u;
}

__device__ __forceinline__ void xcd_barrier(const XcdBarrier& b) {
    asm volatile("s_waitcnt vmcnt(0)" ::: "memory");
    __syncthreads();
    if (threadIdx.x == 0) {
        unsigned* bar = b.bar;
        __builtin_amdgcn_s_waitcnt(0);
        unsigned nloc = b.st[0], nx = b.st[1];
        if (nloc == 0u) { xcd_barrier_complete(bar, b.x, nloc, nx); b.st[0] = nloc; b.st[1] = nx; }
        const unsigned old = xb_add(&bar[XB_XSUB(b.x)], 1u);
        const unsigned gen = old / nloc;
        if (old + 1u == (gen + 1u) * nloc) {
            __builtin_amdgcn_fence(__ATOMIC_RELEASE, "agent");
            asm volatile("s_waitcnt vmcnt(0)" ::: "memory");
            const unsigned og = xb_add(&bar[XB_TOP], 1u);
            const unsigned tg = og / nx;
            if (og + 1u == (tg + 1u) * nx) xb_add(&bar[XB_TOPGEN], 1u);
            else XB_SPIN(xb_ld(&bar[XB_TOPGEN]) == tg, bar);
            __builtin_amdgcn_fence(__ATOMIC_ACQUIRE, "agent");
            xb_add(&bar[XB_XGEN(b.x)], 1u);
            asm volatile("s_waitcnt vmcnt(0)" ::: "memory");
        } else {
            XB_SPIN(xb_ld(&bar[XB_XGEN(b.x)]) == gen, bar);
            __builtin_amdgcn_fence(__ATOMIC_ACQUIRE, "agent");
            asm volatile("s_waitcnt vmcnt(0)" ::: "memory");
        }
    }
    __syncthreads();
}

#ifndef NSA_CHECK
#define NSA_CHECK 0
#endif
#ifndef REP_MASK
#define REP_MASK 0u
#endif
struct Args { const float* in[29]; float* out; char* ws; unsigned rep_mask; unsigned pad; };
constexpr int LDS_BYTES = 147456;

__global__ __launch_bounds__(512, 2) void mk_fwd(Args a) {
    extern __shared__ __attribute__((aligned(16))) char lds_raw[];
    cg::grid_group grid = cg::this_grid();
    const int NB = gridDim.x * 2, NGW = gridDim.x * 8;
    const unsigned repm = a.rep_mask;
    volatile __attribute__((address_space(3))) unsigned* bar_st = (volatile __attribute__((address_space(3))) unsigned*)((lds_c*)lds_raw + (LDS_BYTES - 64));
    if (threadIdx.x < 2) bar_st[threadIdx.x] = 0u;
    __syncthreads();
    const XcdBarrier xbar = xcd_barrier_post((unsigned*)(a.ws + ((size_t)42 << 20) + 65536), bar_st);
#define GRID_BAR() xcd_barrier(xbar)
#ifndef SPIN_PHASE_UNUSED_
#endif
    unsigned long long ts_prev_ = 0ull, ts_probe_ = 0ull; int n_stamp_ = 0;
#define STAMP() do { if (SPIN_PHASE >= 0 && blockIdx.x == 0) { const unsigned long long now_ = __builtin_amdgcn_s_memrealtime(); if (n_stamp_ == SPIN_PHASE) ts_probe_ = now_ - ts_prev_; ts_prev_ = now_; ++n_stamp_; } } while (0)
    if (SPIN_PHASE >= 0 && blockIdx.x == 0) ts_prev_ = __builtin_amdgcn_s_memrealtime();
    const int wave_s_ = __builtin_amdgcn_readfirstlane(threadIdx.x >> 6);
#define KARG(T, off) (*(T const __attribute__((address_space(4)))*)(kargs_ + (off)))
#define PTRS const float* x = KARG(const float*, 8 * 0); const float* p = KARG(const float*, 8 * 1); const int* pos = KARG(const int*, 16); \
    const float* g_mix = KARG(const float*, 8 * 3); const float* w_in = KARG(const float*, 8 * 4); const float* b_if = KARG(const float*, 8 * 5); \
    const float* w_ck1 = KARG(const float*, 8 * 6); const float* w_ck2 = KARG(const float*, 8 * 7); const float* pe_ck = KARG(const float*, 8 * 8); \
    const float* w_cv1 = KARG(const float*, 8 * 9); const float* w_cv2 = KARG(const float*, 8 * 10); const float* pe_cv = KARG(const float*, 8 * 11); \
    const float* w_conv = KARG(const float*, 8 * 12); const float* b_conv = KARG(const float*, 8 * 13); const float* g_hn = KARG(const float*, 8 * 14); \
    const float* w_pa = KARG(const float*, 8 * 15); const float* w_pb = KARG(const float*, 8 * 16); const float* w_out = KARG(const float*, 8 * 17); \
    const float* g_ffn = KARG(const float*, 8 * 18); const float* w_rg = KARG(const float*, 8 * 19); const float* b_rg = KARG(const float*, 8 * 20); \
    const float* w_re = KARG(const float*, 8 * 21); const float* b_re = KARG(const float*, 8 * 22); const float* w_e13 = KARG(const float*, 8 * 23); \
    const float* w_e2 = KARG(const float*, 8 * 24); const float* g_ple = KARG(const float*, 8 * 25); const float* w_pg = KARG(const float*, 8 * 26); \
    const float* w_pp = KARG(const float*, 8 * 27); const float* g_final = KARG(const float*, 8 * 28); \
    float* out = KARG(float*, 232); char* ws = KARG(char*, 240); \
    const size_t MiB = 1u << 20; \
    bf16_t* Wt_in = (bf16_t*)(ws); \
    bf16_t* xb = (bf16_t*)(ws + 48 * MiB); \
    bf16_t* Qb = (bf16_t*)(ws + 80 * MiB); \
    bf16_t* KVb = (bf16_t*)(ws + 96 * MiB); bf16_t* VT = (bf16_t*)(ws + 112 * MiB); bf16_t* kcb = (bf16_t*)(ws + 249 * MiB + 512 * 1024); bf16_t* vcT = (bf16_t*)(ws + 249 * MiB + 768 * 1024); \
    bf16_t* MQK = (bf16_t*)(ws + 120 * MiB); \
    bf16_t* MV = (bf16_t*)(ws + 152 * MiB); \
    bf16_t* MO = (bf16_t*)(ws + 168 * MiB); \
    bf16_t* MG = (bf16_t*)(ws + 184 * MiB); \
    float* gates = (float*)(ws + 248 * MiB); \
    float* ifp = (float*)(ws + 250 * MiB); \
    float* kcc = (float*)(ws + 251 * MiB); \
    float* vcc = (float*)(ws + 252 * MiB); \
    float* gate16 = (float*)(ws + 253 * MiB); \
    float* rstd0 = (float*)(ws + 254 * MiB); \
    float* cosT = (float*)(ws + 254 * MiB + 512 * 1024); \
    float* sinT = (float*)(ws + 255 * MiB); \
    bf16_t* Y = (bf16_t*)(out + (size_t)8 * 1024 * 1024); \
    bf16_t* dC = xb; float* dn = (float*)(ws + 250 * MiB + 512 * 1024); float* wprev = (float*)(ws + 42 * MiB + 4096); float* mtab = (float*)(ws + 42 * MiB + 8192); float* wsc = (float*)(ws + 42 * MiB + 16384); \
    float* tmp = (float*)(ws + 120 * MiB); bf16_t* mixed = xb; \
    bf16_t* Wpa_t = (bf16_t*)(ws + 11 * MiB); bf16_t* Wpb_t = (bf16_t*)(ws + 12 * MiB); bf16_t* Wout_t = (bf16_t*)(ws + 13 * MiB); \
    bf16_t* We13_t = (bf16_t*)(ws + 15 * MiB); bf16_t* We2_t = (bf16_t*)(ws + 31 * MiB); bf16_t* Wpg_t = (bf16_t*)(ws + 39 * MiB); bf16_t* Wpp_t = (bf16_t*)(ws + 41 * MiB); \
    int* cnt = (int*)(ws + 42 * MiB); bf16_t* W1t_k = (bf16_t*)(ws + 43 * MiB); bf16_t* W1t_v = (bf16_t*)(ws + 44 * MiB); bf16_t* W2t_k = (bf16_t*)(ws + 45 * MiB); bf16_t* W2t_v = (bf16_t*)(ws + 45 * MiB + 65536); float* bias1p = (float*)(ws + 45 * MiB + 524288); \
    bf16_t* x1b = (bf16_t*)(ws + 48 * MiB); bf16_t* act = (bf16_t*)(ws + 120 * MiB); bf16_t* y2 = (bf16_t*)(ws + 138 * MiB); bf16_t* x2b = (bf16_t*)(ws + 210 * MiB); int* elist = (int*)(ws + 242 * MiB); \
    bf16_t* pb = (bf16_t*)(ws + 80 * MiB); bf16_t* PP = (bf16_t*)(ws + 88 * MiB); \
    int* rinfo = (int*)(ws + 253 * MiB); float* rstd1 = (float*)(ws + 253 * MiB + 512 * 1024); float* rstd2 = (float*)(ws + 253 * MiB + 768 * 1024); \
    (void)x; (void)p; (void)pos; (void)g_mix; (void)w_in; (void)b_if; (void)w_ck1; (void)w_ck2; (void)pe_ck; (void)w_cv1; (void)w_cv2; (void)pe_cv; (void)w_conv; (void)b_conv; (void)g_hn; (void)w_pa; (void)w_pb; (void)w_out; (void)g_ffn; (void)w_rg; (void)b_rg; (void)w_re; (void)b_re; (void)w_e13; (void)w_e2; (void)g_ple; (void)w_pg; (void)w_pp; (void)g_final;
#define PHASE(k) for (int rep_ = 0; rep_ < 1 + (int)((repm >> (k)) & 1u); ++rep_)
#define PHASE_IDS unsigned tx_ = (unsigned)(wave_s_ * 64); asm volatile("" : "+v"(tx_)); tx_ = (unsigned)__builtin_amdgcn_mbcnt_hi(-1, __builtin_amdgcn_mbcnt_lo(-1, (int)tx_)); const int half = tx_ >> 8, tid = tx_ & 255, lane64 = tx_ & 63, tid512 = (int)tx_; \
    const int wave = __builtin_amdgcn_readfirstlane(tx_ >> 6); char* sm = lds_raw + half * 65536; const int gw = blockIdx.x * 8 + wave; (void)tid; (void)lane64; (void)sm; (void)gw; (void)tid512; \
    const __attribute__((address_space(4))) char* kargs_ = (const __attribute__((address_space(4))) char*)__builtin_amdgcn_kernarg_segment_ptr(); asm volatile("" : "+s"(kargs_)); PTRS
#define VB_LOOP(nvb) for (int vb = blockIdx.x * 2 + half; vb < (nvb); vb += NB)
#define GEMM_PHASE(NT, MT, ...) do { VB_LOOP((NT) * (MT)) { const int bx_ = vb % (NT), by_ = vb / (NT); __syncthreads(); gemm_v1(bx_, by_, tid, sm, __VA_ARGS__); } } while (0)
    PHASE(0) { PHASE_IDS
        float* scr = (float*)(lds_raw + wave * 8448);
        for (int it = gw; it < (DM / 64) * (NIN / 32); it += NGW) prep_wt_item(w_in, DIN, DM, Wt_in, g_mix, MapIn{}, scr, it, NIN / 32, lane64);
        for (int it = gw; it < 2 * 256; it += NGW) { const int kv = it >> 8; prep_wt_item(kv ? w_cv1 : w_ck1, 256, 2048, kv ? W1t_v : W1t_k, (const float*)nullptr, MapId{}, scr, it & 255, 8, lane64); }
        for (int it = gw; it < 2 * 8; it += NGW) { const int kv = it >> 3; prep_wt_item(kv ? w_cv2 : w_ck2, 64, 256, kv ? W2t_v : W2t_k, (const float*)nullptr, MapId{}, scr, it & 7, 2, lane64); }
        if (gw < 512) {
            const int kv = gw >> 8, n = gw & 255; const float* w1 = kv ? w_cv1 : w_ck1; const float* pe = kv ? pe_cv : pe_ck; float a = 0.f;
#pragma unroll
            for (int i = 0; i < 32; ++i) { const int k = lane64 + 64 * i; a += pe[k] * w1[(size_t)k * 256 + n]; }
            a = wave_sum(a);
            if (lane64 == 0) bias1p[gw] = a;
        }
        if (blockIdx.x == 0 && tid512 < 16) cnt[tid512 * CNT_STRIDE] = 0;
        for (int r = gw; r < T_TOK; r += NGW) prep_x_row(x, xb, rstd0, r, lane64);
        for (int i = blockIdx.x * 512 + tid512; i < T_TOK * 8; i += gridDim.x * 512) {
            const float inv = powf(500000.0f, -(float)(2 * (i & 7)) / 16.0f); float sn, cs; sincosf((float)pos[i >> 3] * inv, &sn, &cs); cosT[i] = cs; sinT[i] = sn; }
    }
    if (repm == 0x80000000u) grid.sync();
    GRID_BAR(); STAMP();
    PHASE(1) { PHASE_IDS
        pg8::Gemm g{xb, Wt_in, T_TOK, NIN, DM, DM, DM}; pg8::StaticOrder S; S.init(T_TOK, NIN, (int)gridDim.x, (int)blockIdx.x);
        EpiInProj E{rstd0, cosT, sinT, b_if, Qb, KVb, gates, ifp, MQK, MV, MO, MG, VT};
        pg8::gemm_phase<EpiInProj, pg8::StaticOrder, true, true>((PG8_LAS unsigned char*)lds_raw, g, S, E, tid512);
    }
    {   PHASE_IDS
        const int G_ = (int)gridDim.x, nfull_ = (64 * (NIN / 256)) % G_;
        const int nl_ = G_ - nfull_, lw_ = (int)blockIdx.x - nfull_;
        if (nfull_ == 0 || lw_ >= 0) {
            const int lgw = (nfull_ == 0 ? (int)blockIdx.x : lw_) * 8 + wave, LNGW = (nfull_ == 0 ? G_ : nl_) * 8;
            float* scr = (float*)(lds_raw + wave * 8448); float* scr2 = (float*)(lds_raw + wave * 16896); (void)scr;
            __syncthreads();
            for (int it = lgw; it < 16 * 128; it += LNGW) { const int e = it >> 7, i2 = (it & 127) * 2; const float* w_ = w_e13 + (size_t)e * 1024 * 512; bf16_t* t_ = We13_t + (size_t)e * 512 * 1024;
                prep_wt_item2(w_, w_, 512, DM, t_, t_, g_ffn, MapE13{}, scr2, i2, i2 + 1, 16, lane64); }
            if ((int)gridDim.x != 256) {
                for (int it = lgw; it < 8 * 32; it += LNGW) prep_wt_item(w_pa, DM, DM, Wpa_t, (const float*)nullptr, MapId{}, scr, it, 32, lane64);
                for (int it = lgw; it < 8 * 32; it += LNGW) prep_wt_item(w_pb, DM, DM, Wpa_t + 512, (const float*)nullptr, MapId{}, scr, it, 32, lane64);
                for (int it = lgw; it < 16 * 32; it += LNGW) prep_wt_item(w_out, DM, DM, Wout_t, (const float*)nullptr, MapId{}, scr, it, 32, lane64);
                for (int it = lgw; it < 16 * 32; it += LNGW) prep_wt_item(w_pg, DM, DM, Wpg_t, g_ple, MapId{}, scr, it, 32, lane64);
                for (int it = lgw; it < 4 * 32; it += LNGW) prep_wt_item(w_pp, DM, 256, Wpp_t, (const float*)nullptr, MapId{}, scr, it, 32, lane64);
                for (int it = lgw; it < 16 * 64; it += LNGW) { const int e = it >> 6, i2 = (it & 63) * 2; const float* w_ = w_e2 + (size_t)e * 256 * 1024; bf16_t* t_ = We2_t + (size_t)e * 1024 * 256;
                prep_wt_item2(w_, w_, DM, 256, t_, t_, (const float*)nullptr, MapId{}, scr2, i2, i2 + 1, 32, lane64); }
            }
        }
    }
    GRID_BAR(); STAMP();
    PHASE(2) { PHASE_IDS
        for (int u = blockIdx.x; u < 128; u += gridDim.x) { const int kv = u >> 6, bg = (u >> 3) & 7, jt = u & 7;
            cmp_unit(kv, bg, jt, tid512, (lds_c*)lds_raw, KVb, kv ? W1t_v : W1t_k, kv ? W2t_v : W2t_k, bias1p, kv ? vcc : kcc, kcb, vcT); }
        { const int v_ = (int)blockIdx.x - 128; if (v_ >= 0 && v_ < 16 && wave == 0) ml_mscan_all(ifp, v_, lane64, mtab, wprev, wsc); }
    }
    PHASE(3) { PHASE_IDS
        { const int G_ = (int)gridDim.x, c_ = (int)blockIdx.x;
          if (G_ == 256) { const int n_ = c_ < 128 ? 3 : 5, first_ = c_ < 128 ? 3 * c_ : 384 + 5 * (c_ - 128);
              for (int u = first_; u < first_ + n_; ++u) ml_unit_c(u >> 6, u & 63, tid512, (lds_c*)lds_raw, MQK, MV, ifp, w_conv, b_conv, dC, dn, wprev, mtab); }
          else for (int u = c_; u < 1024; u += G_) ml_unit_c(u >> 6, u & 63, tid512, (lds_c*)lds_raw, MQK, MV, ifp, w_conv, b_conv, dC, dn, wprev, mtab); }
        if ((int)gridDim.x == 256 && (int)blockIdx.x >= 128) {
            const int lgw = ((int)blockIdx.x - 128) * 8 + wave, LNGW = 128 * 8; float* scr = (float*)(lds_raw + wave * 16896); float* scr2 = scr;
            __syncthreads();
            for (int it = lgw; it < 8 * 32; it += LNGW) prep_wt_item(w_pa, DM, DM, Wpa_t, (const float*)nullptr, MapId{}, scr, it, 32, lane64);
            for (int it = lgw; it < 8 * 32; it += LNGW) prep_wt_item(w_pb, DM, DM, Wpa_t + 512, (const float*)nullptr, MapId{}, scr, it, 32, lane64);
            for (int it = lgw; it < 16 * 32; it += LNGW) prep_wt_item(w_out, DM, DM, Wout_t, (const float*)nullptr, MapId{}, scr, it, 32, lane64);
            for (int it = lgw; it < 16 * 32; it += LNGW) prep_wt_item(w_pg, DM, DM, Wpg_t, g_ple, MapId{}, scr, it, 32, lane64);
            for (int it = lgw; it < 4 * 32; it += LNGW) prep_wt_item(w_pp, DM, 256, Wpp_t, (const float*)nullptr, MapId{}, scr, it, 32, lane64);
            for (int it = lgw; it < 16 * 64; it += LNGW) { const int e = it >> 6, i2 = (it & 63) * 2; const float* w_ = w_e2 + (size_t)e * 256 * 1024; bf16_t* t_ = We2_t + (size_t)e * 1024 * 256;
                prep_wt_item2(w_, w_, DM, 256, t_, t_, (const float*)nullptr, MapId{}, scr2, i2, i2 + 1, 32, lane64); }
        }
    }
    GRID_BAR(); STAMP();
    {   PHASE_IDS
        ml_scan(blockIdx.x * 512 + tid512, gridDim.x * 512, dC, dn, wprev, wsc);
    }
    GRID_BAR(); STAMP();
    PHASE(4) { PHASE_IDS
        for (int u = blockIdx.x; u < 1024; u += gridDim.x) ml_unit_e(u >> 6, u & 63, tid512, (lds_c*)lds_raw, MQK, MV, MO, ifp, w_conv, b_conv, dC, dn, mtab, g_hn, Y);
    }
    PHASE(5) { PHASE_IDS
        for (int pr = blockIdx.x; pr < 256; pr += gridDim.x) {
            nsa_unit(pr & 7, 63 - (pr >> 3), tid512, (lds_c*)lds_raw, Qb, KVb, VT, kcb, vcT, gates, Y, ts_probe_);
            nsa_unit(pr & 7, pr >> 3, tid512, (lds_c*)lds_raw, Qb, KVb, VT, kcb, vcT, gates, Y, ts_probe_);
        }
    }
#if NSA_CHECK
    {   PHASE_IDS
        bf16_t* Y2 = (bf16_t*)(ws + 120 * MiB); unsigned* stats = (unsigned*)(ws + 42 * MiB + 32768);
        if (blockIdx.x == 0 && tid512 == 0) { stats[0] = 0u; stats[1] = 0u; }
        grid.sync();
        float* kcc2 = (float*)(ws + 251 * MiB + 512 * 1024); float* vcc2 = (float*)(ws + 252 * MiB + 512 * 1024); bf16_t* dummy = (bf16_t*)(ws + 160 * MiB);
        VB_LOOP(4080) { const int j = vb % 255, r = vb / 255; compress_naive(j, r & 7, r >> 3, tid, sm, KVb, w_ck1, w_ck2, pe_ck, w_cv1, w_cv2, pe_cv, kcc2, vcc2, dummy, dummy + 1048576); }
        grid.sync();
        VB_LOOP(T_TOK * 2) nsa_naive(vb >> 1, vb & 1, tid, sm, Qb, KVb, VT, kcc2, vcc2, gates, Y2);
        grid.sync();
        unsigned c1 = 0, c2 = 0;
        for (size_t i = (size_t)blockIdx.x * 512 + tid512; i < (size_t)T_TOK * 512; i += (size_t)gridDim.x * 512) {
            const size_t o = (i >> 9) * DM + (i & 511); const float d = fabsf(bf2f(Y[o]) - bf2f(Y2[o])); c1 += d > 0.02f ? 1u : 0u; c2 += (d > 0.1f || !(d == d)) ? 1u : 0u; }
        if (c1) atomicAdd(stats, c1); if (c2) atomicAdd(stats + 1, c2);
    }
#endif
    GRID_BAR(); STAMP();
    PHASE(7) { PHASE_IDS
        pg8::StaticOrder S; S.init(T_TOK, DM, (int)gridDim.x, (int)blockIdx.x);
        pg8::Gemm g{Y, Wpa_t, T_TOK, DM, DM, DM, DM}; EpiMerge2 E{MG, mixed}; pg8::gemm_phase<EpiMerge2, pg8::StaticOrder, true, true>((PG8_LAS unsigned char*)lds_raw, g, S, E, tid512);
    }
    GRID_BAR(); STAMP();
    PHASE(9) { PHASE_IDS
        pg8::Gemm g{mixed, Wout_t, T_TOK, DM, DM, DM, DM}; pg8::StaticOrder S; S.init(T_TOK, DM, (int)gridDim.x, (int)blockIdx.x);
        EpiX1 E{x, out, x1b};
        pg8::gemm_phase<EpiX1, pg8::StaticOrder, true, true>((PG8_LAS unsigned char*)lds_raw, g, S, E, tid512);
    }
    GRID_BAR(); STAMP();
    {   PHASE_IDS
        unsigned long long& pacc = ts_probe_;
        RG_BEGIN(110)
        __attribute__((address_space(3))) float* Wl = (__attribute__((address_space(3))) float*)((lds_c*)lds_raw);
        __attribute__((address_space(3))) int* lcnt = (__attribute__((address_space(3))) int*)((lds_c*)lds_raw + 20 * 4096);
        __attribute__((address_space(3))) int* lri = lcnt + 32;
        for (int t = gw * 4; t < T_TOK; t += NGW * 4) {
            float4 pv[4];
#pragma unroll
            for (int j = 0; j < 4; ++j) pv[j] = ((const float4*)(p + (size_t)(t + j) * 256))[lane64];
#pragma unroll
            for (int j = 0; j < 4; ++j) { uint2 o; o.x = pk2(pv[j].x, pv[j].y); o.y = pk2(pv[j].z, pv[j].w); ((uint2*)(pb + (size_t)(t + j) * 256))[lane64] = o; } }
        __syncthreads(); router_stage(Wl, g_ffn, w_rg, w_re, tid512); if (tid512 < 16) lcnt[tid512] = 0; __syncthreads();
        RG_END(110)
        RG_BEGIN(111)
        for (int r_ = 0; r_ < T_TOK / (NGW * 4); ++r_) {
            int tk_[4]; f4v xv_[16];
#pragma unroll
            for (int g_ = 0; g_ < 4; ++g_) tk_[g_] = gw + NGW * (4 * r_ + g_);
            const int mytok_ = gw + NGW * (4 * r_ + (lane64 >> 4));
#pragma unroll
            for (int j = 0; j < 16; ++j) xv_[j] = *(const f4v*)(out + (size_t)mytok_ * DM + 4 * ((lane64 & 15) + 16 * j));
            router4(tk_, lane64, xv_, Wl, b_rg, b_re, rstd1, lcnt, lri + (wave * 8 + r_ * 4) * 4);
        }
        __syncthreads();
        RG_END(111)
        RG_BEGIN(112)
        if (tid512 < 16) lcnt[16 + tid512] = atomicAdd(cnt + tid512 * CNT_STRIDE, lcnt[tid512]);
        __syncthreads();
        { int i = 0; for (int t = gw; t < T_TOK; t += NGW, ++i) if (lane64 == 0) { __attribute__((address_space(3))) int* r = lri + (wave * 8 + i) * 4;
            const int e0 = r[0] & 255, e1 = (r[0] >> 8) & 255, q0 = (r[1] & 0xffff) + lcnt[16 + e0], q1 = (r[1] >> 16) + lcnt[16 + e1]; int4 ri; ri.x = r[0]; ri.y = q0 | (q1 << 16); ri.z = r[2]; ri.w = r[3];
            *(int4*)(rinfo + (size_t)t * 4) = ri; elist[e0 * T_TOK + q0] = t; elist[e1 * T_TOK + q1] = t; } }
        RG_END(112)
    }
    GRID_BAR(); STAMP();
    {
        int ntile_ = 0;
        {   PHASE_IDS
            for (int e = 0; e < 16; ++e) ntile_ += (cnt[e * CNT_STRIDE] + 255) >> 8; }
        const int G_ = (int)gridDim.x, c_ = (int)blockIdx.x, per_ = (G_ % 8 == 0) ? (ntile_ + 7) / 8 : 0;
#pragma unroll 1
        for (int rnd = 0; ; ++rnd) {
            int ti;
            if (per_ > 0 && per_ * 8 <= G_) { if (rnd > 0) break; ti = ((c_ >> 3) < per_) ? (c_ & 7) * per_ + (c_ >> 3) : ntile_; }
            else ti = c_ + rnd * G_;
            if (ti >= ntile_) break;
            {   PHASE_IDS
                MoeOrder S{cnt, 1, 1, ti}; pg8::Unit u; S.next(0, u);
                const int e = u.pn, nv = cnt[e * CNT_STRIDE] - u.aux * 256; const int* amap = elist + (size_t)e * T_TOK + u.aux * 256;
                pg8::Gemm g{x1b, We13_t, 0, 0, DM, DM, DM, amap, nv}; EpiSwiglu E{act, amap, nv, rstd1}; TwoUnits S2{u.pm, e * 2, u.aux};
                __syncthreads();
                pg8::gemm_phase<EpiSwiglu, TwoUnits, false, true, true>((PG8_LAS unsigned char*)lds_raw, g, S2, E, tid512);
                asm volatile("s_waitcnt vmcnt(0)" ::: "memory");
                __syncthreads();
                if (tid512 == 0) { __builtin_amdgcn_fence(__ATOMIC_ACQUIRE, "agent"); asm volatile("s_waitcnt vmcnt(0)" ::: "memory"); }
                __syncthreads();
            }
            {   PHASE_IDS
                MoeOrder S{cnt, 1, 1, ti}; pg8::Unit u; S.next(0, u);
                int k2_ = 256; asm volatile("" : "+s"(k2_));
                pg8::Gemm g{act, We2_t, 0, 0, k2_, k2_, k2_}; FourUnits S4{u.pm, u.pn * 4}; EpiStoreBf E{y2, DM, 3};
                pg8::gemm_phase<EpiStoreBf, FourUnits, true, true>((PG8_LAS unsigned char*)lds_raw, g, S4, E, tid512);
            }
        }
        {   unsigned* mq = (unsigned*)(a.ws + ((size_t)42 << 20) + 36864);
            volatile __attribute__((address_space(3))) unsigned* idw = (volatile __attribute__((address_space(3))) unsigned*)((lds_c*)lds_raw + (LDS_BYTES - 32));
#pragma unroll 1
            for (;;) {
                PHASE_IDS
                __syncthreads();
                if (tid512 == 0) idw[0] = __hip_atomic_fetch_add(mq, 1u, __ATOMIC_RELAXED, __HIP_MEMORY_SCOPE_AGENT);
                __syncthreads();
                const int up = (int)idw[0];
                if (up >= 256) break;
                pg8::Unit uu; uu.pm = up >> 2; uu.pn = up & 3; uu.aux = 0;
                int k2_ = 256; asm volatile("" : "+s"(k2_));
                pg8::Gemm g{pb, Wpp_t, T_TOK, DM, k2_, k2_, k2_}; EpiStoreBf E{PP, DM, 3}; OneUnit S1{uu};
                pg8::gemm_phase<EpiStoreBf, OneUnit, false, true>((PG8_LAS unsigned char*)lds_raw, g, S1, E, tid512);
            }
        }
    }
    GRID_BAR(); STAMP();
    {   PHASE_IDS
        __attribute__((address_space(3))) int* brow = (__attribute__((address_space(3))) int*)((lds_c*)lds_raw);
        __syncthreads();
        if (tid512 < 16) brow[tid512] = moe_base_row(cnt, tid512);
        __syncthreads();
#pragma unroll 1
        for (int t0 = gw * 4; t0 < T_TOK; t0 += NGW * 4) {
            int4 ri[4];
#pragma unroll
            for (int q = 0; q < 4; ++q) ri[q] = *(const int4*)(rinfo + (size_t)(t0 + q) * 4);
            float4 v[4][4]; uint2 ya[4][4], yb[4][4];
#pragma unroll
            for (int q = 0; q < 4; ++q) {
                const int rx = __builtin_amdgcn_readfirstlane(ri[q].x), ry = __builtin_amdgcn_readfirstlane(ri[q].y);
                const int r0 = brow[rx & 255] + (ry & 0xffff), r1 = brow[(rx >> 8) & 255] + ((ry >> 16) & 0xffff);
#pragma unroll
                for (int j = 0; j < 4; ++j) { v[q][j] = ((const float4*)(out + (size_t)(t0 + q) * DM))[lane64 + 64 * j];
                    ya[q][j] = ((const uint2*)(y2 + (size_t)r0 * DM))[lane64 + 64 * j]; yb[q][j] = ((const uint2*)(y2 + (size_t)r1 * DM))[lane64 + 64 * j]; }
            }
#pragma unroll
            for (int q = 0; q < 4; ++q) {
                const float w0 = __int_as_float(__builtin_amdgcn_readfirstlane(ri[q].z)), w1 = __int_as_float(__builtin_amdgcn_readfirstlane(ri[q].w)); float s2 = 0.f;
#pragma unroll
                for (int j = 0; j < 4; ++j) { const uint2 a0 = ya[q][j], a1 = yb[q][j]; float4 x_ = v[q][j];
                    x_.x += w0 * __uint_as_float(a0.x << 16) + w1 * __uint_as_float(a1.x << 16); x_.y += w0 * __uint_as_float(a0.x & 0xffff0000u) + w1 * __uint_as_float(a1.x & 0xffff0000u);
                    x_.z += w0 * __uint_as_float(a0.y << 16) + w1 * __uint_as_float(a1.y << 16); x_.w += w0 * __uint_as_float(a0.y & 0xffff0000u) + w1 * __uint_as_float(a1.y & 0xffff0000u);
                    s2 += x_.x * x_.x + x_.y * x_.y + x_.z * x_.z + x_.w * x_.w;
                    ((float4*)(out + (size_t)(t0 + q) * DM))[lane64 + 64 * j] = x_; uint2 o; o.x = pk2(x_.x, x_.y); o.y = pk2(x_.z, x_.w); ((uint2*)(x2b + (size_t)(t0 + q) * DM))[lane64 + 64 * j] = o; }
                s2 = wave_sum(s2);
                if (lane64 == 0) rstd2[t0 + q] = rsqrtf(s2 * (1.f / DM) + 1e-6f);
            }
        }
    }
    GRID_BAR(); STAMP();
    if ((int)gridDim.x == 256) {
        PHASE_IDS
        __syncthreads();
        pg8::StaticOrder S; S.init(T_TOK, DM, (int)gridDim.x, (int)blockIdx.x);
        pg8::Gemm g{x2b, Wpg_t, T_TOK, DM, DM, DM, DM}; EpiPleFinal E{out, PP, rstd2, g_final, out, (float*)(ws + 251 * MiB), (unsigned*)(ws + 42 * MiB + 40960)};
        pg8::gemm_phase<EpiPleFinal, pg8::StaticOrder, false, true>((PG8_LAS unsigned char*)lds_raw, g, S, E, tid512);
#if NSA_CHECK
        GRID_BAR();
        if (blockIdx.x == 0 && tid512 == 0) { const unsigned* stats = (const unsigned*)(ws + 42 * MiB + 32768); out[0] += sqrtf((float)stats[0]); out[1] += sqrtf((float)stats[1]) * 30.f; }
#endif
        if (SPIN_PHASE >= 0 && blockIdx.x == 0) { __syncthreads(); STAMP(); const unsigned long long t0_ = __builtin_amdgcn_s_memrealtime(); while (__builtin_amdgcn_s_memrealtime() - t0_ < 8ull * ts_probe_) __builtin_amdgcn_s_sleep(4); }
    } else {
        {   PHASE_IDS
            __syncthreads();
            pg8::StaticOrder S; S.init(T_TOK, DM, (int)gridDim.x, (int)blockIdx.x);
            pg8::Gemm g{x2b, Wpg_t, T_TOK, DM, DM, DM, DM}; EpiPle2 E{out, PP, rstd2};
            pg8::gemm_phase<EpiPle2, pg8::StaticOrder, true, true>((PG8_LAS unsigned char*)lds_raw, g, S, E, tid512);
        }
        GRID_BAR();
        {   PHASE_IDS
            VB_LOOP(T_TOK / 4) rmsnorm_rows(vb, tid, out, g_final, (bf16_t*)nullptr, out, T_TOK);
        }
    }
}

extern "C" void kernel_launch(void* const* d_in, const int* in_sizes, int n_in, void* d_out, int out_size, void* d_ws, size_t ws_size, hipStream_t stream) {
    static int grid_blocks = 0;
    if (grid_blocks == 0) {
        int dev = 0, cus = 0, per_cu = 0;
        (void)hipGetDevice(&dev);
        (void)hipDeviceGetAttribute(&cus, hipDeviceAttributeMultiprocessorCount, dev);
        (void)hipFuncSetAttribute((const void*)mk_fwd, hipFuncAttributeMaxDynamicSharedMemorySize, LDS_BYTES);
        (void)hipOccupancyMaxActiveBlocksPerMultiprocessor(&per_cu, (const void*)mk_fwd, 512, LDS_BYTES);
        if (per_cu < 1) { fprintf(stderr, "kernel_launch: occupancy query returned %d\n", per_cu); per_cu = 1; }
        grid_blocks = cus * 1;
        fprintf(stderr, "kernel_launch: cus=%d per_cu=%d grid=%d ws=%zu\n", cus, per_cu, grid_blocks, ws_size);
    }
    (void)hipMemsetAsync((char*)d_ws + ((size_t)42 << 20), 0, 131072, stream);
    Args a{};
    for (int i = 0; i < 29; ++i) a.in[i] = (const float*)d_in[i];
    a.out = (float*)d_out; a.ws = (char*)d_ws; a.rep_mask = REP_MASK; a.pad = 0;
    void* args[] = {&a};
    hipError_t e = hipLaunchCooperativeKernel((const void*)mk_fwd, dim3(grid_blocks), dim3(512), args, LDS_BYTES, stream);
    if (e != hipSuccess) fprintf(stderr, "cooperative launch failed: %s (grid %d)\n", hipGetErrorString(e), grid_blocks);
    (void)in_sizes; (void)n_in; (void)out_size; (void)ws_size;
}
```

```cpp
#include <hip/hip_runtime.h>
#include <cstdint>
#include <cstdio>
#include <hip/hip_cooperative_groups.h>
namespace cg = cooperative_groups;

typedef unsigned short bf16_t;
typedef short bf16x8 __attribute__((ext_vector_type(8)));
typedef float f32x16 __attribute__((ext_vector_type(16)));

#define DI __device__ __forceinline__

constexpr int T_TOK = 16384, SEQ = 4096, DM = 1024, DIN = 5408, NIN = 5632;
#ifndef SPIN_PHASE
#define SPIN_PHASE (-1)
#endif
#define RG_BEGIN(id) unsigned long long rt0_##id = 0ull; if (SPIN_PHASE == (id) && blockIdx.x == 0) rt0_##id = __builtin_amdgcn_s_memrealtime();
#define RG_END(id) if (SPIN_PHASE == (id) && blockIdx.x == 0) pacc += __builtin_amdgcn_s_memrealtime() - rt0_##id;
constexpr int CNT_STRIDE = 64;
constexpr float QSCALE = 0.125f * 1.4426950408889634f;
constexpr int ZC_Q = 0, ZC_KC = 512, ZC_VC = 640, ZC_KS = 768, ZC_VS = 896, ZC_KW = 1024, ZC_VW = 1152, ZC_GATE = 1280,
              ZC_MQK = 1304, ZC_MV = 2328, ZC_MO = 2840, ZC_IF = 3352, ZC_GA = 3360, ZC_GB = 4384;

DI bf16_t f2bf(float f) { unsigned u = __float_as_uint(f); return (bf16_t)((u + 0x7fffu + ((u >> 16) & 1u)) >> 16); }
DI float bf2f(bf16_t h) { return __uint_as_float(((unsigned)h) << 16); }
DI float sigmoidf_(float x) { return __builtin_amdgcn_rcpf(1.f + __builtin_amdgcn_exp2f(-1.4426950408889634f * x)); }
DI int lane_id_opaque() { int z = 0; asm volatile("" : "+v"(z)); return __builtin_amdgcn_mbcnt_hi(-1, __builtin_amdgcn_mbcnt_lo(-1, z)); }
DI float lane_xor(float v, int o, int lane) { return __int_as_float(__builtin_amdgcn_ds_bpermute((lane ^ o) << 2, __float_as_int(v))); }
DI float lane_get(float v, int src) { return __int_as_float(__builtin_amdgcn_ds_bpermute(src << 2, __float_as_int(v))); }
DI float wave_sum(float v) {
    const int l = lane_id_opaque();
#pragma unroll
    for (int o = 1; o < 64; o <<= 1) v += lane_xor(v, o, l);
    return v;
}
DI float wave_max(float v) {
    const int l = lane_id_opaque();
#pragma unroll
    for (int o = 1; o < 64; o <<= 1) v = fmaxf(v, lane_xor(v, o, l));
    return v;
}

namespace pg8 {
#define PG8_LAS __attribute__((address_space(3)))
typedef unsigned short bf16_t;
typedef short bf16x8 __attribute__((ext_vector_type(8)));
typedef float f32x4 __attribute__((ext_vector_type(4)));
typedef unsigned u32x4 __attribute__((ext_vector_type(4)));
constexpr int BM = 256, BK = 64, HALF = 128, HTB = HALF * BK * 2  , STAGE_BYTES = 8 * HTB, NXCD = 8, WGM = 8;

__host__ __device__ __forceinline__ int lds_byte(int r, int c) { const int st = (r >> 4) * 2 + (c >> 5), rr = r & 15, cc = c & 31, ob = rr * 64 + cc * 2; return st * 1024 + (ob ^ (((ob >> 9) & 1) << 5)); }
__host__ __device__ __forceinline__ void stage_rc(int b, int& R, int& C) { const int st = b / 1024, sb = b % 1024, swz = sb ^ (((sb >> 9) & 1) << 5); R = (st >> 1) * 16 + swz / 64; C = (st & 1) * 32 + (swz % 64) / 2; }
__host__ __device__ __forceinline__ int perm32(int rho) { const int n = rho >> 4, i = rho & 15; return 8 * (i >> 2) + 4 * n + (i & 3); }

struct Unit { int pm, pn, aux; };
struct Gemm { const bf16_t* A; const bf16_t* Bt; int M, N, K, lda, ldb; const int* amap; int avalid; };

struct StaticOrder {
    int nM, nN, nwg, G, c;
    __host__ __device__ __forceinline__ void init(int M, int N, int G_, int c_) { nM = M / BM; nN = N / BM; nwg = nM * nN; G = G_; c = c_; }
    __host__ __device__ __forceinline__ bool next(int i, Unit& u) const {
        const long L = (long)i * G + c; if (L >= nwg) return false;
        int wgid = (int)L; { const int q = nwg / NXCD, r = nwg % NXCD, xcd = wgid % NXCD, off = wgid / NXCD; wgid = (xcd < r ? xcd * (q + 1) : r * (q + 1) + (xcd - r) * q) + off; }
        const int nig = WGM * nN, gid = wgid / nig, fm = gid * WGM, gsz = (nM - fm) < WGM ? (nM - fm) : WGM;
        u.pm = fm + ((wgid % nig) % gsz); u.pn = (wgid % nig) / gsz; u.aux = 0; return true;
    }
    __device__ __forceinline__ void a_ready(const Unit&) const {}
    __device__ __forceinline__ void done(const Unit&) const {}
};

__device__ __forceinline__ unsigned cvt_pk_bf16(float lo, float hi) { unsigned r; asm volatile("v_cvt_pk_bf16_f32 %0, %1, %2" : "=v"(r) : "v"(lo), "v"(hi)); return r; }
typedef float f32x2 __attribute__((ext_vector_type(2)));
__device__ __forceinline__ f32x2 gelu_pk(f32x2 v) {
    const f32x2 av = __builtin_elementwise_abs(v), d = av * 0.2316418882f + 1.0f;
    f32x2 t; t.x = __builtin_amdgcn_rcpf(d.x); t.y = __builtin_amdgcn_rcpf(d.y);
    f32x2 q = t * 0.5307027145f + (-0.7265760135f); q = q * t + 0.7107068705f; q = q * t + (-0.142248368f); q = q * t + 0.127414796f; q = q * t;
    const f32x2 s = (v * v) * (-0.72134752044f);
    f32x2 e; e.x = __builtin_amdgcn_exp2f(s.x); e.y = __builtin_amdgcn_exp2f(s.y);
    const f32x2 m = v * (q * e), r = v - m;
    f32x2 o; o.x = v.x < 0.f ? m.x : r.x; o.y = v.y < 0.f ? m.y : r.y; return o;
}

template <int ACT  > struct EpiBf16 {
    static constexpr bool PERM = true, AFTER_DRAIN = false; static constexpr int MIDK = 0; static_assert(ACT == 0 || ACT == 1, "EpiBf16: ACT is 0 (none) or 1 (gelu_pk)");
    bf16_t* O; int ldc; const float* bias; int split_cols; size_t split_stride; float scale0;
    __device__ __forceinline__ void operator()(const f32x4 (&acc)[2][2][4][2], const Unit& u, int wr, int wc, int fr, int fq) const {
        const int row0 = u.pm * BM + wr * 64 + fr; int colt = u.pn * BM; bf16_t* base = O;
        float sc = 1.f; if (split_cols) { const int t = colt / split_cols; base += (size_t)t * split_stride; colt -= t * split_cols; if (t == 0) sc = scale0; }
        const int col0 = colt + wc * 32 + 8 * fq, bcol0 = u.pn * BM + wc * 32 + 8 * fq;
        f32x4 bv[2][2];
#pragma unroll
        for (int bj = 0; bj < 2; ++bj)
#pragma unroll
            for (int n = 0; n < 2; ++n) bv[bj][n] = bias ? *(const f32x4*)(bias + bcol0 + bj * HALF + 4 * n) : (f32x4){0.f, 0.f, 0.f, 0.f};
#pragma unroll
        for (int ai = 0; ai < 2; ++ai)
#pragma unroll
            for (int m = 0; m < 4; ++m) { bf16_t* rowp = base + (size_t)(row0 + ai * HALF + m * 16) * ldc + col0;
#pragma unroll
                for (int bj = 0; bj < 2; ++bj) { f32x4 v0 = acc[ai][bj][m][0] + bv[bj][0], v1 = acc[ai][bj][m][1] + bv[bj][1];
                    if (ACT == 1) { f32x2 a = gelu_pk((f32x2){v0[0], v0[1]}), b = gelu_pk((f32x2){v0[2], v0[3]}), c = gelu_pk((f32x2){v1[0], v1[1]}), d = gelu_pk((f32x2){v1[2], v1[3]});
                        v0 = (f32x4){a.x, a.y, b.x, b.y}; v1 = (f32x4){c.x, c.y, d.x, d.y}; }
                    v0 = v0 * sc; v1 = v1 * sc; u32x4 w; w.x = cvt_pk_bf16(v0[0], v0[1]); w.y = cvt_pk_bf16(v0[2], v0[3]); w.z = cvt_pk_bf16(v1[0], v1[1]); w.w = cvt_pk_bf16(v1[2], v1[3]);
                    *(u32x4*)(rowp + bj * HALF) = w; } }
    }
};

template <class Epi, class Sched, bool ALIGN_EPI = false, bool SP2 = false, bool GATHER = false>
__device__ __forceinline__ void gemm_phase(PG8_LAS unsigned char* lds, const Gemm g, const Sched& S, const Epi& E, const int tid, unsigned long long* pr = nullptr) {
#define PRB(id) (SPIN_PHASE == (id) && pr != nullptr && blockIdx.x == 0)
    unsigned long long pt0_ = 0ull; if (PRB(102)) pt0_ = __builtin_amdgcn_s_memrealtime();
    const int wid = __builtin_amdgcn_readfirstlane(tid >> 6), lane = tid & 63, wr = wid >> 2, wc = wid & 3, fr = lane & 15, fq = lane >> 4;
    const int K = g.K, nt = K / BK;
    unsigned voffA[2], voffB[2], voffA1[2];
#pragma unroll
    for (int i = 0; i < 2; ++i) { int R, C; stage_rc(tid * 16 + i * 8192, R, C); const int Rb = Epi::PERM ? ((R & ~31) + perm32(R & 31)) : R;
        voffA[i] = (unsigned)(R * g.lda + C) * 2u; voffB[i] = (unsigned)(Rb * g.ldb + C) * 2u; voffA1[i] = voffA[i];
        if constexpr (GATHER) { const int t0_ = R < g.avalid ? g.amap[R] : 0, t1_ = R + HALF < g.avalid ? g.amap[R + HALF] : 0; voffA[i] = (unsigned)(t0_ * g.lda + C) * 2u; voffA1[i] = (unsigned)(t1_ * g.lda + C) * 2u; } }
    const size_t kstep = (size_t)(BK * 2);
    const size_t hstepA = (size_t)HALF * g.lda * 2, hstepB = (size_t)HALF * g.ldb * 2;
    const size_t tstepA = GATHER ? 0 : 2 * hstepA, tstepB = 2 * hstepB, hsA = GATHER ? 0 : hstepA;
    const unsigned ldsw = (unsigned)wid * 1024u;
    const int aoff = lds_byte(wr * 64 + fr, fq * 8), boff = lds_byte(wc * 32 + fr, fq * 8);
#define PG8_SA(b, h) (((b) * 2 + (h)) * HTB)
#define PG8_SB(b, h) ((4 + (b) * 2 + (h)) * HTB)
#define PG8_STAGE(bufoff, gbase, voff) do { _Pragma("unroll") for (int _i = 0; _i < 2; ++_i) \
        __builtin_amdgcn_global_load_lds((const unsigned*)((const char*)(gbase) + (voff)[_i]), (PG8_LAS unsigned*)(lds + (bufoff) + ldsw + _i * 8192), 16, 0, 0); } while (0)
#define PG8_LDA(dst, b, h) do { _Pragma("unroll") for (int m = 0; m < 4; ++m) _Pragma("unroll") for (int k = 0; k < 2; ++k) dst[m][k] = *(const PG8_LAS bf16x8*)(lds + PG8_SA(b, h) + aoff + m * 2048 + k * 1024); } while (0)
#define PG8_LDB(dst, b, h) do { _Pragma("unroll") for (int n = 0; n < 2; ++n) _Pragma("unroll") for (int k = 0; k < 2; ++k) dst[n][k] = *(const PG8_LAS bf16x8*)(lds + PG8_SB(b, h) + boff + n * 2048 + k * 1024); } while (0)
#define PG8_MMA(ai, bj, At, Bt) do { __builtin_amdgcn_s_setprio(1); _Pragma("unroll") for (int m = 0; m < 4; ++m) _Pragma("unroll") for (int n = 0; n < 2; ++n) _Pragma("unroll") for (int k = 0; k < 2; ++k) \
        acc[ai][bj][m][n] = __builtin_amdgcn_mfma_f32_16x16x32_bf16(Bt[n][k], At[m][k], acc[ai][bj][m][n], 0, 0, 0); __builtin_amdgcn_s_setprio(0); } while (0)
#define PG8_WAIT_V(n) asm volatile("s_waitcnt vmcnt(" #n ")" ::: "memory")
#define PG8_WAIT_L(n) asm volatile("s_waitcnt lgkmcnt(" #n ")" ::: "memory")
#define PG8_BAR __builtin_amdgcn_s_barrier()
#define PG8_SCHED __builtin_amdgcn_sched_barrier(0)
    Unit cur, nxt; int ui = 0;
    if (!S.next(0, cur)) return;
    f32x4 acc[2][2][4][2];
#pragma unroll
    for (int a = 0; a < 2; ++a)
#pragma unroll
        for (int b = 0; b < 2; ++b)
#pragma unroll
            for (int m = 0; m < 4; ++m)
#pragma unroll
                for (int n = 0; n < 2; ++n) acc[a][b][m][n] = (f32x4){0.f, 0.f, 0.f, 0.f};
    bf16x8 At[4][2], B0[2][2], B1[2][2];
    const char* cA = (const char*)g.A + (size_t)cur.pm * tstepA; const char* cB = (const char*)g.Bt + (size_t)cur.pn * tstepB;
    S.a_ready(cur);
    if constexpr (SP2) {
        PG8_STAGE(PG8_SB(0, 0), cB, voffB); PG8_STAGE(PG8_SB(0, 1), cB + hstepB, voffB); PG8_STAGE(PG8_SA(0, 0), cA, voffA); PG8_STAGE(PG8_SA(0, 1), cA + hsA, voffA1);
        if (wr == 1) PG8_BAR;
        PG8_WAIT_V(2); PG8_BAR;
        PG8_STAGE(PG8_SB(1, 0), cB + kstep, voffB); PG8_STAGE(PG8_SA(1, 0), cA + kstep, voffA); PG8_STAGE(PG8_SB(1, 1), cB + hstepB + kstep, voffB);
        PG8_WAIT_V(6); PG8_BAR;
    } else {
        PG8_STAGE(PG8_SB(0, 0), cB, voffB); PG8_STAGE(PG8_SA(0, 0), cA, voffA); PG8_STAGE(PG8_SB(0, 1), cB + hstepB, voffB); PG8_STAGE(PG8_SA(0, 1), cA + hsA, voffA1);
        if (wr == 1) PG8_BAR;
        PG8_WAIT_V(4); PG8_BAR;
        PG8_STAGE(PG8_SB(1, 0), cB + kstep, voffB); PG8_STAGE(PG8_SA(1, 0), cA + kstep, voffA); PG8_STAGE(PG8_SB(1, 1), cB + hstepB + kstep, voffB);
        PG8_WAIT_V(6); PG8_BAR;
    }
    for (;;) {
        const bool has_next = S.next(ui + 1, nxt);
        const char* nA = has_next ? (const char*)g.A + (size_t)nxt.pm * tstepA : cA; const char* nB = has_next ? (const char*)g.Bt + (size_t)nxt.pn * tstepB : cB;
        for (int t = 0; t < nt; t += 2) {
            const bool last = (t == nt - 2);
            const char* a1 = cA + (size_t)(t + 1) * kstep;
            const char* a2 = last ? nA : cA + (size_t)(t + 2) * kstep; const char* b2 = last ? nB : cB + (size_t)(t + 2) * kstep;
            const char* a3 = a2 + kstep; const char* b3 = b2 + kstep;
            if (last && has_next) S.a_ready(nxt);
            if constexpr (SP2) {
            PG8_LDB(B0, 0, 0); PG8_LDB(B1, 0, 1); PG8_SCHED; PG8_LDA(At, 0, 0); PG8_STAGE(PG8_SA(1, 1), a1 + hsA, voffA1);
            PG8_WAIT_V(8); PG8_WAIT_L(0); PG8_BAR; PG8_MMA(0, 0, At, B0); PG8_MMA(0, 1, At, B1); PG8_BAR; PG8_SCHED;
            PG8_LDA(At, 0, 1); PG8_STAGE(PG8_SB(0, 0), b2, voffB); PG8_STAGE(PG8_SB(0, 1), b2 + hstepB, voffB); PG8_STAGE(PG8_SA(0, 0), a2, voffA);
            PG8_WAIT_V(8); PG8_WAIT_L(0); PG8_BAR; PG8_MMA(1, 0, At, B0); PG8_MMA(1, 1, At, B1); PG8_BAR; PG8_SCHED;
            PG8_LDB(B0, 1, 0); PG8_LDB(B1, 1, 1); PG8_SCHED; PG8_LDA(At, 1, 0); PG8_STAGE(PG8_SA(0, 1), a2 + hsA, voffA1);
            PG8_WAIT_V(8); PG8_WAIT_L(0); PG8_BAR; PG8_MMA(0, 0, At, B0); PG8_MMA(0, 1, At, B1); PG8_BAR; PG8_SCHED;
            PG8_LDA(At, 1, 1); PG8_STAGE(PG8_SB(1, 0), b3, voffB); PG8_STAGE(PG8_SB(1, 1), b3 + hstepB, voffB); PG8_STAGE(PG8_SA(1, 0), a3, voffA);
            PG8_WAIT_V(8); PG8_WAIT_L(0); PG8_BAR; PG8_MMA(1, 0, At, B0); PG8_MMA(1, 1, At, B1); PG8_BAR; PG8_SCHED;
            if (PRB(104) && t == 0) pt0_ = __builtin_amdgcn_s_memrealtime();
            if constexpr (Epi::MIDK > 0) { if (t + 2 == Epi::MIDK / BK) { const int l3_ = lane_id_opaque(); E.mid(acc, cur, wr, wc, l3_ & 15, l3_ >> 4); } }
            } else {
            PG8_LDB(B0, 0, 0); PG8_SCHED; PG8_LDA(At, 0, 0); PG8_STAGE(PG8_SA(1, 1), a1 + hsA, voffA1);
            PG8_WAIT_L(8); PG8_BAR; PG8_WAIT_L(0); PG8_MMA(0, 0, At, B0); PG8_BAR; PG8_SCHED;
            PG8_LDB(B1, 0, 1); PG8_STAGE(PG8_SB(0, 0), b2, voffB);
            PG8_BAR; PG8_WAIT_L(0); PG8_MMA(0, 1, At, B1); PG8_BAR;
            PG8_LDA(At, 0, 1); PG8_STAGE(PG8_SA(0, 0), a2, voffA);
            PG8_BAR; PG8_WAIT_L(0); PG8_MMA(1, 0, At, B0); PG8_BAR; PG8_SCHED;
            PG8_STAGE(PG8_SB(0, 1), b2 + hstepB, voffB);
            PG8_WAIT_V(6); PG8_BAR; PG8_MMA(1, 1, At, B1); PG8_BAR;
            PG8_LDB(B0, 1, 0); PG8_SCHED; PG8_LDA(At, 1, 0); PG8_STAGE(PG8_SA(0, 1), a2 + hsA, voffA1);
            PG8_WAIT_L(8); PG8_BAR; PG8_WAIT_L(0); PG8_MMA(0, 0, At, B0); PG8_BAR; PG8_SCHED;
            PG8_LDB(B1, 1, 1); PG8_STAGE(PG8_SB(1, 0), b3, voffB);
            PG8_BAR; PG8_WAIT_L(0); PG8_MMA(0, 1, At, B1); PG8_BAR;
            PG8_LDA(At, 1, 1); PG8_STAGE(PG8_SA(1, 0), a3, voffA);
            PG8_BAR; PG8_WAIT_L(0); PG8_MMA(1, 0, At, B0); PG8_BAR; PG8_SCHED;
            PG8_STAGE(PG8_SB(1, 1), b3 + hstepB, voffB);
            PG8_WAIT_V(6); PG8_BAR; PG8_MMA(1, 1, At, B1); PG8_BAR;
            }
        }
        if constexpr (ALIGN_EPI) { if (wr == 0) PG8_BAR; }
        if (PRB(104)) *pr += __builtin_amdgcn_s_memrealtime() - pt0_;
        if (PRB(101)) pt0_ = __builtin_amdgcn_s_memrealtime();
        if constexpr (!Epi::AFTER_DRAIN) { const int l2_ = lane_id_opaque(); E(acc, cur, wr, wc, l2_ & 15, l2_ >> 4); S.done(cur); }
        if (PRB(101)) *pr += __builtin_amdgcn_s_memrealtime() - pt0_;
        if (!has_next) break;
#pragma unroll
        for (int a = 0; a < 2; ++a)
#pragma unroll
            for (int b = 0; b < 2; ++b)
#pragma unroll
                for (int m = 0; m < 4; ++m)
#pragma unroll
                    for (int n = 0; n < 2; ++n) acc[a][b][m][n] = (f32x4){0.f, 0.f, 0.f, 0.f};
        cur = nxt; cA = nA; cB = nB; ++ui;
        if constexpr (ALIGN_EPI) { if (wr == 1) PG8_BAR; }
    }
    PG8_WAIT_V(0);
    if constexpr (!ALIGN_EPI) { if (wr == 0) PG8_BAR; }
    PG8_BAR;
    if constexpr (Epi::AFTER_DRAIN) { E.fused(acc, cur, wr, wc, fr, fq, lds, wid, lane); S.done(cur); }
    if (PRB(102)) *pr += __builtin_amdgcn_s_memrealtime() - pt0_;
#undef PRB
#undef PG8_SA
#undef PG8_SB
#undef PG8_STAGE
#undef PG8_LDA
#undef PG8_LDB
#undef PG8_MMA
#undef PG8_WAIT_V
#undef PG8_WAIT_L
#undef PG8_BAR
#undef PG8_SCHED
}
}


#define LAS __attribute__((address_space(3)))
DI unsigned pk2(float lo, float hi) { return (unsigned)f2bf(lo) | ((unsigned)f2bf(hi) << 16); }
template <class Map>
DI void prep_wt_item(const float* __restrict__ W, int ldw, int K, bf16_t* __restrict__ WT, const float* __restrict__ gain, Map map, float* scr, int item, int nblk, int lane) {
    const int kb = item / nblk, nb = item % nblk, k0 = 64 * kb, n0 = 32 * nb;
    const int srcn = map(n0 + (lane & 31));
    float tv[32];
#pragma unroll
    for (int i = 0; i < 32; ++i) { const int kk = 2 * i + (lane >> 5); tv[i] = srcn >= 0 ? W[(size_t)(k0 + kk) * ldw + srcn] : 0.f; }
#pragma unroll
    for (int i = 0; i < 32; ++i) { const int kk = 2 * i + (lane >> 5); scr[kk * 33 + (lane & 31)] = gain ? tv[i] * gain[k0 + kk] : tv[i]; }
    __builtin_amdgcn_s_waitcnt(0xC07F); asm volatile("" ::: "memory");
    const int c = lane & 7;
#pragma unroll
    for (int j = 0; j < 4; ++j) { const int n = (lane >> 3) + 8 * j; const float* s = scr + (8 * c) * 33 + n;
        uint4 o; o.x = pk2(s[0 * 33], s[1 * 33]); o.y = pk2(s[2 * 33], s[3 * 33]); o.z = pk2(s[4 * 33], s[5 * 33]); o.w = pk2(s[6 * 33], s[7 * 33]);
        *(uint4*)(WT + (size_t)(n0 + n) * K + k0 + 8 * c) = o; }
    __builtin_amdgcn_s_waitcnt(0xC07F); asm volatile("" ::: "memory");
}
template <class Map>
DI void prep_wt_item2(const float* __restrict__ Wa, const float* __restrict__ Wb, int ldw, int K, bf16_t* __restrict__ WTa, bf16_t* __restrict__ WTb, const float* __restrict__ gain, Map map, float* scr, int itemA, int itemB, int nblk, int lane) {
    const int ka = 64 * (itemA / nblk), na = 32 * (itemA % nblk), kb = 64 * (itemB / nblk), nb = 32 * (itemB % nblk);
    const int sa = map(na + (lane & 31)), sb = map(nb + (lane & 31));
    float ta[32], tb[32];
#pragma unroll
    for (int i = 0; i < 32; ++i) { const int kk = 2 * i + (lane >> 5); ta[i] = sa >= 0 ? Wa[(size_t)(ka + kk) * ldw + sa] : 0.f; }
#pragma unroll
    for (int i = 0; i < 32; ++i) { const int kk = 2 * i + (lane >> 5); tb[i] = sb >= 0 ? Wb[(size_t)(kb + kk) * ldw + sb] : 0.f; }
#pragma unroll
    for (int i = 0; i < 32; ++i) { const int kk = 2 * i + (lane >> 5); scr[kk * 33 + (lane & 31)] = gain ? ta[i] * gain[ka + kk] : ta[i]; }
#pragma unroll
    for (int i = 0; i < 32; ++i) { const int kk = 2 * i + (lane >> 5); scr[2112 + kk * 33 + (lane & 31)] = gain ? tb[i] * gain[kb + kk] : tb[i]; }
    __builtin_amdgcn_s_waitcnt(0xC07F); asm volatile("" ::: "memory");
    const int c = lane & 7;
#pragma unroll
    for (int j = 0; j < 4; ++j) { const int n = (lane >> 3) + 8 * j; const float* s = scr + (8 * c) * 33 + n;
        uint4 o; o.x = pk2(s[0 * 33], s[1 * 33]); o.y = pk2(s[2 * 33], s[3 * 33]); o.z = pk2(s[4 * 33], s[5 * 33]); o.w = pk2(s[6 * 33], s[7 * 33]);
        *(uint4*)(WTa + (size_t)(na + n) * K + ka + 8 * c) = o;
        const float* s2 = s + 2112;
        uint4 o2; o2.x = pk2(s2[0 * 33], s2[1 * 33]); o2.y = pk2(s2[2 * 33], s2[3 * 33]); o2.z = pk2(s2[4 * 33], s2[5 * 33]); o2.w = pk2(s2[6 * 33], s2[7 * 33]);
        *(uint4*)(WTb + (size_t)(nb + n) * K + kb + 8 * c) = o2; }
    __builtin_amdgcn_s_waitcnt(0xC07F); asm volatile("" ::: "memory");
}
struct MapIn {
    DI int operator()(int n) const {
        if (n < 1280) return n;
        if (n < 1536) { const int i = n - 1280; return i < 24 ? ZC_GATE + i : (i < 32 ? ZC_IF + (i - 24) : -1); }
        if (n < 2560) return ZC_MQK + (n - 1536);
        if (n < 3072) return ZC_MV + (n - 2560);
        if (n < 3584) return ZC_MO + (n - 3072);
        return ZC_GA + (n - 3584);
    }
};
DI void prep_x_row(const float* __restrict__ x, bf16_t* __restrict__ xb, float* __restrict__ rstd, int row, int lane) {
    const float4* xr = (const float4*)(x + (size_t)row * DM);
    float4 v[4]; float s = 0.f;
#pragma unroll
    for (int j = 0; j < 4; ++j) { v[j] = xr[lane + 64 * j]; s += v[j].x * v[j].x + v[j].y * v[j].y + v[j].z * v[j].z + v[j].w * v[j].w; }
    s = wave_sum(s);
    if (lane == 0) rstd[row] = rsqrtf(s * (1.f / DM) + 1e-6f);
#pragma unroll
    for (int j = 0; j < 4; ++j) { uint2 o; o.x = pk2(v[j].x, v[j].y); o.y = pk2(v[j].z, v[j].w); ((uint2*)(xb + (size_t)row * DM))[lane + 64 * j] = o; }
}

template <int VAR> struct EpiInProjT {
    static constexpr bool PERM = true, AFTER_DRAIN = false; static constexpr int MIDK = 0;
    const float* rstd; const float* cosT; const float* sinT; const float* b_if;
    bf16_t* Qb; bf16_t* KVb; float* gates; float* ifp; bf16_t* MQK; bf16_t* MV; bf16_t* MO; bf16_t* MG; bf16_t* VT;
    DI void operator()(const pg8::f32x4 (&acc)[2][2][4][2], const pg8::Unit& u, int wr, int wc, int fr, int fq) const {
        const int pn = u.pn;
        asm volatile("" : "+v"(fr), "+v"(fq));
#pragma unroll
        for (int ai = 0; ai < 2; ++ai)
#pragma unroll
            for (int m = 0; m < 4; ++m) {
                const int row = u.pm * 256 + ai * 128 + wr * 64 + m * 16 + fr;
                const float rs = VAR == 2 ? 1.f : rstd[row];
                const bool st_ok = (VAR != 1) || (rs == 123456.f);
#pragma unroll
                for (int bj = 0; bj < 2; ++bj) {
                    float v[8];
#pragma unroll
                    for (int i = 0; i < 4; ++i) { v[i] = acc[ai][bj][m][0][i] * rs; v[4 + i] = acc[ai][bj][m][1][i] * rs; }
                    const int c0 = bj * 128 + wc * 32 + 8 * fq;
                    if (pn <= 4) {
                        const bool is_k = (pn < 2) || (bj == 0);
                        if (is_k && (wc & 1) == 0) {
                            const float4 one4_ = make_float4(1.f, 1.f, 1.f, 1.f); const float4 c_lo = VAR == 2 ? one4_ : *(const float4*)(cosT + (size_t)row * 8), c_hi = VAR == 2 ? one4_ : *(const float4*)(cosT + (size_t)row * 8 + 4);
                            const float4 s_lo = VAR == 2 ? one4_ : *(const float4*)(sinT + (size_t)row * 8), s_hi = VAR == 2 ? one4_ : *(const float4*)(sinT + (size_t)row * 8 + 4);
                            const float cs[8] = {c_lo.x, c_lo.y, c_lo.z, c_lo.w, c_hi.x, c_hi.y, c_hi.z, c_hi.w};
                            const float sn[8] = {s_lo.x, s_lo.y, s_lo.z, s_lo.w, s_hi.x, s_hi.y, s_hi.z, s_hi.w};
                            const int l_ = lane_id_opaque();
#pragma unroll
                            for (int i = 0; i < 8; ++i) {
                                const float other = lane_xor(v[i], 16, l_);
                                if (fq == 0) v[i] = v[i] * cs[i] - other * sn[i];
                                else if (fq == 1) v[i] = v[i] * cs[i] + other * sn[i];
                            }
                        }
                        const float sc = pn < 2 ? QSCALE : 1.f;
                        pg8::u32x4 w; w.x = pg8::cvt_pk_bf16(v[0] * sc, v[1] * sc); w.y = pg8::cvt_pk_bf16(v[2] * sc, v[3] * sc); w.z = pg8::cvt_pk_bf16(v[4] * sc, v[5] * sc); w.w = pg8::cvt_pk_bf16(v[6] * sc, v[7] * sc);
                        if (!st_ok) {} else if (pn < 2) *(pg8::u32x4*)(Qb + (size_t)row * 512 + pn * 256 + c0) = w;
                        else if (pn == 2) *(pg8::u32x4*)(KVb + (size_t)row * 512 + c0) = w;
                        else if (bj == 0) *(pg8::u32x4*)(KVb + (size_t)row * 512 + (pn - 2) * 128 + 128 + wc * 32 + 8 * fq) = w;
                        else {
                            const int cv = wc * 32 + 8 * fq, gg = cv >> 6, d0 = cv & 63, bb = row >> 12, tt = row & 4095;
                            bf16_t* vt = VT + ((size_t)((pn - 3) * 8 + bb * 2 + gg) * 64 + (tt >> 6)) * 4096 + (size_t)d0 * 64 + (tt & 63);
                            vt[0] = (bf16_t)(w.x & 0xffffu); vt[64] = (bf16_t)(w.x >> 16); vt[128] = (bf16_t)(w.y & 0xffffu); vt[192] = (bf16_t)(w.y >> 16);
                            vt[256] = (bf16_t)(w.z & 0xffffu); vt[320] = (bf16_t)(w.z >> 16); vt[384] = (bf16_t)(w.w & 0xffffu); vt[448] = (bf16_t)(w.w >> 16);
                        }
                    } else if (pn == 5) {
                        if (bj == 0 && wc == 0 && st_ok) {
#pragma unroll
                            for (int i = 0; i < 8; ++i) { const int c = 8 * fq + i;
                                if (c < 24) gates[(size_t)row * 24 + c] = sigmoidf_(v[i]);
                                else if (c < 32) ifp[(size_t)row * 8 + (c - 24)] = v[i] + b_if[c - 24]; }
                        }
                    } else {
                        if (pn >= 14) {
#pragma unroll
                            for (int i = 0; i < 8; ++i) v[i] = sigmoidf_(v[i]);
                        }
                        pg8::u32x4 w; w.x = pg8::cvt_pk_bf16(v[0], v[1]); w.y = pg8::cvt_pk_bf16(v[2], v[3]); w.z = pg8::cvt_pk_bf16(v[4], v[5]); w.w = pg8::cvt_pk_bf16(v[6], v[7]);
                        bf16_t* dst;
                        if (pn < 10) dst = MQK + (size_t)row * 1024 + (pn - 6) * 256 + c0;
                        else if (pn < 12) dst = MV + (size_t)row * 512 + (pn - 10) * 256 + c0;
                        else if (pn < 14) dst = MO + (size_t)row * 512 + (pn - 12) * 256 + c0;
                        else dst = MG + (size_t)row * 2048 + (pn - 14) * 256 + c0;
                        if (st_ok) *(pg8::u32x4*)dst = w;
                    }
                }
            }
    }
};
typedef EpiInProjT<0> EpiInProj;


DI pg8::u32x4 pack8(const float (&v)[8]) { pg8::u32x4 w; w.x = pg8::cvt_pk_bf16(v[0], v[1]); w.y = pg8::cvt_pk_bf16(v[2], v[3]); w.z = pg8::cvt_pk_bf16(v[4], v[5]); w.w = pg8::cvt_pk_bf16(v[6], v[7]); return w; }
DI void unpack8(const pg8::u32x4 w, float (&v)[8]) {
    v[0] = __uint_as_float(w.x << 16); v[1] = __uint_as_float(w.x & 0xffff0000u); v[2] = __uint_as_float(w.y << 16); v[3] = __uint_as_float(w.y & 0xffff0000u);
    v[4] = __uint_as_float(w.z << 16); v[5] = __uint_as_float(w.z & 0xffff0000u); v[6] = __uint_as_float(w.w << 16); v[7] = __uint_as_float(w.w & 0xffff0000u);
}
#define EPI_ROWS_BEGIN asm volatile("" : "+v"(fr), "+v"(fq)); _Pragma("unroll") for (int ai = 0; ai < 2; ++ai) _Pragma("unroll") for (int m = 0; m < 4; ++m) { const int row = u.pm * 256 + ai * 128 + wr * 64 + m * 16 + fr; _Pragma("unroll") for (int bj = 0; bj < 2; ++bj) { \
    float v[8]; _Pragma("unroll") for (int i = 0; i < 4; ++i) { v[i] = acc[ai][bj][m][0][i]; v[4 + i] = acc[ai][bj][m][1][i]; } const int c0 = bj * 128 + wc * 32 + 8 * fq; (void)c0; (void)row;
#define EPI_ROWS_END } asm volatile("" ::: "memory"); }
template <int MODE> struct EpiMerge {
    static constexpr bool PERM = true, AFTER_DRAIN = false; static constexpr int MIDK = 0;
    const bf16_t* MG; float* tmp; bf16_t* mixed;
    DI void operator()(const pg8::f32x4 (&acc)[2][2][4][2], const pg8::Unit& u, int wr, int wc, int fr, int fq) const {
        EPI_ROWS_BEGIN
            const int col = u.pn * 256 + c0; float gt[8];
            unpack8(*(const pg8::u32x4*)(MG + (size_t)row * 2048 + MODE * 1024 + col), gt);
            float* tp = tmp + (size_t)row * DM + col;
            if (MODE == 0) {
                *(float4*)tp = make_float4(gt[0] * v[0], gt[1] * v[1], gt[2] * v[2], gt[3] * v[3]); *(float4*)(tp + 4) = make_float4(gt[4] * v[4], gt[5] * v[5], gt[6] * v[6], gt[7] * v[7]);
            } else {
                const float4 t0 = *(const float4*)tp, t1 = *(const float4*)(tp + 4);
                float o[8] = {t0.x + gt[0] * v[0], t0.y + gt[1] * v[1], t0.z + gt[2] * v[2], t0.w + gt[3] * v[3], t1.x + gt[4] * v[4], t1.y + gt[5] * v[5], t1.z + gt[6] * v[6], t1.w + gt[7] * v[7]};
                *(pg8::u32x4*)(mixed + (size_t)row * DM + col) = pack8(o);
            }
        EPI_ROWS_END
    }
};
struct EpiMerge2 {
    static constexpr bool PERM = true, AFTER_DRAIN = false; static constexpr int MIDK = 512;
    const bf16_t* MG; bf16_t* mixed;
    DI void mid(pg8::f32x4 (&acc)[2][2][4][2], const pg8::Unit& u, int wr, int wc, int fr, int fq) const {
#pragma unroll
        for (int ai = 0; ai < 2; ++ai)
#pragma unroll
            for (int m = 0; m < 4; ++m) { const int row = u.pm * 256 + ai * 128 + wr * 64 + m * 16 + fr;
#pragma unroll
                for (int bj = 0; bj < 2; ++bj) {
                    const int col = u.pn * 256 + bj * 128 + wc * 32 + 8 * fq; float ga[8], gb[8];
                    unpack8(*(const pg8::u32x4*)(MG + (size_t)row * 2048 + col), ga); unpack8(*(const pg8::u32x4*)(MG + (size_t)row * 2048 + 1024 + col), gb);
#pragma unroll
                    for (int i = 0; i < 4; ++i) { acc[ai][bj][m][0][i] *= ga[i] * __builtin_amdgcn_rcpf(gb[i]); acc[ai][bj][m][1][i] *= ga[4 + i] * __builtin_amdgcn_rcpf(gb[4 + i]); }
                }
                asm volatile("" ::: "memory"); }
    }
    DI void operator()(const pg8::f32x4 (&acc)[2][2][4][2], const pg8::Unit& u, int wr, int wc, int fr, int fq) const {
        EPI_ROWS_BEGIN
            const int col = u.pn * 256 + c0; float gb[8];
            unpack8(*(const pg8::u32x4*)(MG + (size_t)row * 2048 + 1024 + col), gb);
            float o[8] = {gb[0] * v[0], gb[1] * v[1], gb[2] * v[2], gb[3] * v[3], gb[4] * v[4], gb[5] * v[5], gb[6] * v[6], gb[7] * v[7]};
            *(pg8::u32x4*)(mixed + (size_t)row * DM + col) = pack8(o);
        EPI_ROWS_END
    }
};
struct EpiX1 {
    static constexpr bool PERM = true, AFTER_DRAIN = false; static constexpr int MIDK = 0;
    const float* base; float* out; bf16_t* outb;
    DI void operator()(const pg8::f32x4 (&acc)[2][2][4][2], const pg8::Unit& u, int wr, int wc, int fr, int fq) const {
        EPI_ROWS_BEGIN
            const size_t o = (size_t)row * DM + u.pn * 256 + c0;
            const float4 b0 = *(const float4*)(base + o), b1 = *(const float4*)(base + o + 4);
            const float r[8] = {b0.x + v[0], b0.y + v[1], b0.z + v[2], b0.w + v[3], b1.x + v[4], b1.y + v[5], b1.z + v[6], b1.w + v[7]};
            *(float4*)(out + o) = make_float4(r[0], r[1], r[2], r[3]); *(float4*)(out + o + 4) = make_float4(r[4], r[5], r[6], r[7]);
            *(pg8::u32x4*)(outb + o) = pack8(r);
        EPI_ROWS_END
    }
};
struct EpiStoreBf {
    static constexpr bool PERM = true, AFTER_DRAIN = false; static constexpr int MIDK = 0;
    bf16_t* O; int ld; int pnmask;
    DI void operator()(const pg8::f32x4 (&acc)[2][2][4][2], const pg8::Unit& u, int wr, int wc, int fr, int fq) const {
        EPI_ROWS_BEGIN
            *(pg8::u32x4*)(O + (size_t)row * ld + (u.pn & pnmask) * 256 + c0) = pack8(v);
        EPI_ROWS_END
    }
};
struct EpiSwiglu {
    static constexpr bool PERM = true, AFTER_DRAIN = false; static constexpr int MIDK = 0;
    bf16_t* act; const int* amap; int avalid; const float* rstd1;
    DI void operator()(const pg8::f32x4 (&acc)[2][2][4][2], const pg8::Unit& u, int wr, int wc, int fr, int fq) const {
        asm volatile("" : "+v"(fr), "+v"(fq));
#pragma unroll
        for (int ai = 0; ai < 2; ++ai)
#pragma unroll
            for (int m = 0; m < 4; ++m) {
                const int rl = ai * 128 + wr * 64 + m * 16 + fr, row = u.pm * 256 + rl; float o[8];
                const float rs = rl < avalid ? rstd1[amap[rl]] : 0.f;
#pragma unroll
                for (int i = 0; i < 4; ++i) { const float g0 = rs * acc[ai][0][m][0][i], g1 = rs * acc[ai][0][m][1][i]; o[i] = g0 * sigmoidf_(g0) * (rs * acc[ai][1][m][0][i]); o[4 + i] = g1 * sigmoidf_(g1) * (rs * acc[ai][1][m][1][i]); }
                *(pg8::u32x4*)(act + (size_t)row * 256 + (u.pn & 1) * 128 + wc * 32 + 8 * fq) = pack8(o);
            }
    }
};
struct EpiPle2 {
    static constexpr bool PERM = true, AFTER_DRAIN = false; static constexpr int MIDK = 0;
    float* x; const bf16_t* PP; const float* rstd;
    DI void operator()(const pg8::f32x4 (&acc)[2][2][4][2], const pg8::Unit& u, int wr, int wc, int fr, int fq) const {
        EPI_ROWS_BEGIN
            const size_t o = (size_t)row * DM + u.pn * 256 + c0; const float rs = rstd[row]; float pp[8];
            unpack8(*(const pg8::u32x4*)(PP + o), pp);
            const float4 b0 = *(const float4*)(x + o), b1 = *(const float4*)(x + o + 4);
            *(float4*)(x + o) = make_float4(b0.x + sigmoidf_(rs * v[0]) * pp[0], b0.y + sigmoidf_(rs * v[1]) * pp[1], b0.z + sigmoidf_(rs * v[2]) * pp[2], b0.w + sigmoidf_(rs * v[3]) * pp[3]);
            *(float4*)(x + o + 4) = make_float4(b1.x + sigmoidf_(rs * v[4]) * pp[4], b1.y + sigmoidf_(rs * v[5]) * pp[5], b1.z + sigmoidf_(rs * v[6]) * pp[6], b1.w + sigmoidf_(rs * v[7]) * pp[7]);
        EPI_ROWS_END
    }
};

struct EpiPleFinal {
    static constexpr bool PERM = true, AFTER_DRAIN = true; static constexpr int MIDK = 0;
    const float* x2; const bf16_t* PP; const float* rstd2; const float* g_final; float* out; float* xbuf; unsigned* pcnt;
    DI void fused(pg8::f32x4 (&acc)[2][2][4][2], const pg8::Unit& u, int wr, int wc, int fr, int fq, PG8_LAS unsigned char* lds, int wid, int lane) const {
        __attribute__((address_space(3))) float* P = (__attribute__((address_space(3))) float*)lds;
        __attribute__((address_space(3))) float* S = P + 1024;
        const int l_ = lane_id_opaque();
#pragma unroll
        for (int ai = 0; ai < 2; ++ai)
#pragma unroll
            for (int m = 0; m < 4; ++m) {
                const int rl = ai * 128 + wr * 64 + m * 16 + fr, row = u.pm * 256 + rl; const float rs = rstd2[row]; float sq = 0.f;
#pragma unroll
                for (int bj = 0; bj < 2; ++bj) {
                    const size_t o = (size_t)row * DM + u.pn * 256 + bj * 128 + wc * 32 + 8 * fq; float pp[8];
                    unpack8(*(const pg8::u32x4*)(PP + o), pp);
                    const float4 b0 = *(const float4*)(x2 + o), b1 = *(const float4*)(x2 + o + 4);
                    const float bx[8] = {b0.x, b0.y, b0.z, b0.w, b1.x, b1.y, b1.z, b1.w};
#pragma unroll
                    for (int i = 0; i < 4; ++i) {
                        const float v0 = bx[i] + sigmoidf_(rs * acc[ai][bj][m][0][i]) * pp[i], v1 = bx[4 + i] + sigmoidf_(rs * acc[ai][bj][m][1][i]) * pp[4 + i];
                        acc[ai][bj][m][0][i] = v0; acc[ai][bj][m][1][i] = v1; sq += v0 * v0 + v1 * v1;
                    }
                }
                sq += lane_xor(sq, 16, l_); sq += lane_xor(sq, 32, l_);
                if (fq == 0) P[rl * 4 + wc] = sq;
                asm volatile("" ::: "memory");
            }
        __syncthreads();
        const int t = wid * 64 + lane;
        if (t < 256) { const float ps = (P[t * 4] + P[t * 4 + 1]) + (P[t * 4 + 2] + P[t * 4 + 3]);
            __hip_atomic_store(xbuf + ((size_t)u.pm * 256 + t) * 4 + u.pn, ps, __ATOMIC_RELAXED, __HIP_MEMORY_SCOPE_AGENT); }
        asm volatile("s_waitcnt vmcnt(0)" ::: "memory");
        __syncthreads();
        if (t == 0) __hip_atomic_fetch_add(pcnt + 64 * u.pm, 1u, __ATOMIC_RELAXED, __HIP_MEMORY_SCOPE_AGENT);
        if (wid == 0) { unsigned spins = 0; while (__hip_atomic_load(pcnt + 64 * u.pm, __ATOMIC_RELAXED, __HIP_MEMORY_SCOPE_AGENT) < 4u && ++spins < (1u << 22)) __builtin_amdgcn_s_sleep(2); }
        __syncthreads();
        if (t < 256) { const float* xb = xbuf + ((size_t)u.pm * 256 + t) * 4;
            const float tot = (__hip_atomic_load(xb, __ATOMIC_RELAXED, __HIP_MEMORY_SCOPE_AGENT) + __hip_atomic_load(xb + 1, __ATOMIC_RELAXED, __HIP_MEMORY_SCOPE_AGENT))
                            + (__hip_atomic_load(xb + 2, __ATOMIC_RELAXED, __HIP_MEMORY_SCOPE_AGENT) + __hip_atomic_load(xb + 3, __ATOMIC_RELAXED, __HIP_MEMORY_SCOPE_AGENT));
            S[t] = rsqrtf(tot * (1.f / DM) + 1e-6f); }
        __syncthreads();
#pragma unroll
        for (int ai = 0; ai < 2; ++ai)
#pragma unroll
            for (int m = 0; m < 4; ++m) {
                const int rl = ai * 128 + wr * 64 + m * 16 + fr, row = u.pm * 256 + rl; const float r3 = S[rl];
#pragma unroll
                for (int bj = 0; bj < 2; ++bj) {
                    const int col = u.pn * 256 + bj * 128 + wc * 32 + 8 * fq; const size_t o = (size_t)row * DM + col;
                    const float4 g0 = *(const float4*)(g_final + col), g1 = *(const float4*)(g_final + col + 4);
                    *(float4*)(out + o) = make_float4(acc[ai][bj][m][0][0] * r3 * g0.x, acc[ai][bj][m][0][1] * r3 * g0.y, acc[ai][bj][m][0][2] * r3 * g0.z, acc[ai][bj][m][0][3] * r3 * g0.w);
                    *(float4*)(out + o + 4) = make_float4(acc[ai][bj][m][1][0] * r3 * g1.x, acc[ai][bj][m][1][1] * r3 * g1.y, acc[ai][bj][m][1][2] * r3 * g1.z, acc[ai][bj][m][1][3] * r3 * g1.w);
                }
            }
    }
};
struct MoeOrder {
    const int* cnt; int NJ, G, c;
    DI bool next(int i, pg8::Unit& u) const {
        int L = i * G + c, tb = 0;
        for (int e = 0; e < 16; ++e) { const int mt = (cnt[e * CNT_STRIDE] + 255) >> 8, n = mt * NJ; if (L < n) { u.pm = tb + L / NJ; u.pn = e * NJ + L % NJ; u.aux = L / NJ; return true; } L -= n; tb += mt; }
        return false;
    }
    DI void a_ready(const pg8::Unit&) const {}
    DI void done(const pg8::Unit&) const {}
};
struct TwoUnits { int pm, pn0, aux; DI bool next(int i, pg8::Unit& o) const { o.pm = pm; o.pn = pn0 + i; o.aux = aux; return i < 2; } DI void a_ready(const pg8::Unit&) const {} DI void done(const pg8::Unit&) const {} };
struct FourUnits { int pm, pn0; DI bool next(int i, pg8::Unit& o) const { o.pm = pm; o.pn = pn0 + i; o.aux = 0; return i < 4; } DI void a_ready(const pg8::Unit&) const {} DI void done(const pg8::Unit&) const {} };
struct OneUnit { pg8::Unit u; DI bool next(int i, pg8::Unit& o) const { o = u; return i == 0; } DI void a_ready(const pg8::Unit&) const {} DI void done(const pg8::Unit&) const {} };
struct PPOrder { int extra, G, c; DI bool next(int i, pg8::Unit& u) const { const int nl = G - extra, li = c - extra; if (li < 0 || nl <= 0) return false; const int id = li + i * nl; if (id >= 256) return false; u.pm = id >> 2; u.pn = id & 3; u.aux = 0; return true; }
    DI void a_ready(const pg8::Unit&) const {} DI void done(const pg8::Unit&) const {} };
DI int moe_base_row(const int* cnt, int e) { int tb = 0; for (int k = 0; k < 16; ++k) { if (k < e) tb += (cnt[k * CNT_STRIDE] + 255) >> 8; } return tb * 256; }
struct MapId { DI int operator()(int n) const { return n; } };
struct MapE13 { DI int operator()(int n) const { return ((n >> 7) & 1) * 256 + (n >> 8) * 128 + (n & 127); } };

DI void router_stage(__attribute__((address_space(3))) float* Wl, const float* __restrict__ g, const float* __restrict__ w_rg, const float* __restrict__ w_re, int tx) {
    for (int e = tx; e < 4096; e += 512) { const int k = e >> 2, c = e & 3; Wl[c * 1024 + k] = w_rg[e] * g[k]; }
    for (int e = tx; e < 16384; e += 512) { const int k = e >> 4, c = e & 15; Wl[(4 + c) * 1024 + k] = w_re[e] * g[k]; }
}
typedef float f4v __attribute__((ext_vector_type(4)));
DI float dpp_row_sum(float v) {
    v += __builtin_bit_cast(float, __builtin_amdgcn_update_dpp(0, __builtin_bit_cast(int, v), 0xB1, 0xf, 0xf, true));
    v += __builtin_bit_cast(float, __builtin_amdgcn_update_dpp(0, __builtin_bit_cast(int, v), 0x4E, 0xf, 0xf, true));
    v += __builtin_bit_cast(float, __builtin_amdgcn_update_dpp(0, __builtin_bit_cast(int, v), 0x141, 0xf, 0xf, true));
    v += __builtin_bit_cast(float, __builtin_amdgcn_update_dpp(0, __builtin_bit_cast(int, v), 0x140, 0xf, 0xf, true));
    return v;
}
DI void router4(const int (&tok)[4], int lane, const f4v (&xv)[16], const __attribute__((address_space(3))) float* Wl, const float* __restrict__ b_rg, const float* __restrict__ b_re,
                float* __restrict__ rstd1, __attribute__((address_space(3))) int* lcnt, __attribute__((address_space(3))) int* lri) {
    const int g = lane >> 4, p = lane & 15;
    float s = 0.f;
#pragma unroll
    for (int j = 0; j < 16; ++j) s += (xv[j].x * xv[j].x + xv[j].y * xv[j].y) + (xv[j].z * xv[j].z + xv[j].w * xv[j].w);
    const float rstd = rsqrtf(dpp_row_sum(s) * (1.f / DM) + 1e-6f);
    float al[20];
#pragma unroll
    for (int c = 0; c < 20; ++c) {
        float a = 0.f;
#pragma unroll
        for (int j = 0; j < 16; ++j) { const f4v w = *(const __attribute__((address_space(3))) f4v*)(Wl + c * 1024 + 4 * (p + 16 * j)); a += (xv[j].x * w.x + xv[j].y * w.y) + (xv[j].z * w.z + xv[j].w * w.w); }
        al[c] = dpp_row_sum(a);
    }
    float gl[4], el[16];
#pragma unroll
    for (int c = 0; c < 4; ++c) gl[c] = al[c] * rstd + b_rg[c];
#pragma unroll
    for (int c = 0; c < 16; ++c) el[c] = al[4 + c] * rstd + b_re[c];
    if (p == 0) {
        int gs = 0; float gm = gl[0];
#pragma unroll
        for (int c = 1; c < 4; ++c) if (gl[c] > gm) { gm = gl[c]; gs = c; }
        float se = 0.f;
#pragma unroll
        for (int c = 0; c < 4; ++c) se += __expf(gl[c] - gm);
        const float pg = 1.f / se;
        float e4[4];
#pragma unroll
        for (int c = 0; c < 4; ++c) e4[c] = gs == 0 ? el[c] : gs == 1 ? el[4 + c] : gs == 2 ? el[8 + c] : el[12 + c];
        int i0 = 0; float v0 = e4[0];
#pragma unroll
        for (int c = 1; c < 4; ++c) if (e4[c] > v0) { v0 = e4[c]; i0 = c; }
        int i1 = -1; float v1 = -3.0e38f;
#pragma unroll
        for (int c = 0; c < 4; ++c) if (c != i0 && e4[c] > v1) { v1 = e4[c]; i1 = c; }
        const float ex = __expf(v1 - v0);
        const float w0 = pg / (1.f + ex), w1 = pg * ex / (1.f + ex);
        const int e0 = gs * 4 + i0, e1 = gs * 4 + i1;
        const int p0 = __hip_atomic_fetch_add(lcnt + e0, 1, __ATOMIC_RELAXED, __HIP_MEMORY_SCOPE_WORKGROUP), p1 = __hip_atomic_fetch_add(lcnt + e1, 1, __ATOMIC_RELAXED, __HIP_MEMORY_SCOPE_WORKGROUP);
        const int tk = g == 0 ? tok[0] : g == 1 ? tok[1] : g == 2 ? tok[2] : tok[3];
        rstd1[tk] = rstd;
        lri[g * 4 + 0] = e0 | (e1 << 8); lri[g * 4 + 1] = p0 | (p1 << 16); lri[g * 4 + 2] = __float_as_int(w0); lri[g * 4 + 3] = __float_as_int(w1);
    }
}

struct BMapId { DI int operator()(int n) const { return n; } };
struct BMapMoe { DI int operator()(int n) const { const int t = n >> 7, c = n & 127, e = t >> 2, jt = t & 3; return e * (1024 * 512) + ((c >> 5) & 1) * 256 + jt * 64 + (c >> 6) * 32 + (c & 31); } };
template <class Epi, class BMap>
DI void gemm_v1(int bx, int by, int tid, char* sm, const bf16_t* __restrict__ A, int lda, const float* __restrict__ B, int ldb, int N, int K, Epi epi, BMap bmap) {
    bf16_t* As = (bf16_t*)sm;
    bf16_t* Bs = (bf16_t*)(sm + 128 * 40 * 2);
    const int lane = tid & 63, w = tid >> 6, wr = w >> 1, wc = w & 1, r32 = lane & 31, hi = lane >> 5;
    const int m0 = by * 128, n0 = bx * 128;
    f32x16 acc[2][2];
#pragma unroll
    for (int i = 0; i < 2; ++i)
#pragma unroll
        for (int j = 0; j < 2; ++j)
#pragma unroll
            for (int r = 0; r < 16; ++r) acc[i][j][r] = 0.f;
    for (int k0 = 0; k0 < K; k0 += 32) {
#pragma unroll
        for (int i = 0; i < 2; ++i) {
            const int c = tid + i * 256, row = c >> 2, col = (c & 3) * 8;
            const uint4 v = *(const uint4*)(A + (size_t)(m0 + row) * lda + k0 + col);
            *(uint4*)(As + row * 40 + col) = v;
        }
#pragma unroll
        for (int i = 0; i < 4; ++i) {
            const int idx = tid + i * 256, k = idx >> 5, n = (idx & 31) * 4;
            float4 v = make_float4(0.f, 0.f, 0.f, 0.f);
            if (n0 + n < N) v = *(const float4*)(B + (size_t)(k0 + k) * ldb + bmap(n0 + n));
            Bs[(n + 0) * 40 + k] = f2bf(v.x); Bs[(n + 1) * 40 + k] = f2bf(v.y); Bs[(n + 2) * 40 + k] = f2bf(v.z); Bs[(n + 3) * 40 + k] = f2bf(v.w);
        }
        __syncthreads();
#pragma unroll
        for (int kk = 0; kk < 32; kk += 16) {
            bf16x8 a[2], b[2];
#pragma unroll
            for (int i = 0; i < 2; ++i) a[i] = *(const bf16x8*)(As + (wr * 64 + i * 32 + r32) * 40 + kk + hi * 8);
#pragma unroll
            for (int j = 0; j < 2; ++j) b[j] = *(const bf16x8*)(Bs + (wc * 64 + j * 32 + r32) * 40 + kk + hi * 8);
#pragma unroll
            for (int i = 0; i < 2; ++i)
#pragma unroll
                for (int j = 0; j < 2; ++j) acc[i][j] = __builtin_amdgcn_mfma_f32_32x32x16_bf16(a[i], b[j], acc[i][j], 0, 0, 0);
        }
        __syncthreads();
    }
#pragma unroll
    for (int i = 0; i < 2; ++i)
#pragma unroll
        for (int j = 0; j < 2; ++j)
#pragma unroll
            for (int r = 0; r < 16; ++r) {
                const int row = m0 + wr * 64 + i * 32 + (r & 3) + 8 * (r >> 2) + 4 * hi;
                const int col = n0 + wc * 64 + j * 32 + r32;
                if constexpr (Epi::PAIR) { if (j == 0) epi.pair(row, col, acc[i][0][r], acc[i][1][r]); }
                else { if (col < N) epi(row, col, acc[i][j][r]); }
            }
}

struct EpiPa { static constexpr bool PAIR = false;
    const bf16_t* MG; float* tmp;
    DI void operator()(int row, int col, float v) const { tmp[(size_t)row * DM + col] = bf2f(MG[(size_t)row * 2048 + col]) * v; }
};
struct EpiPb { static constexpr bool PAIR = false;
    const bf16_t* MG; const float* tmp; bf16_t* mixed;
    DI void operator()(int row, int col, float v) const {
        mixed[(size_t)row * DM + col] = f2bf(tmp[(size_t)row * DM + col] + bf2f(MG[(size_t)row * 2048 + 1024 + col]) * v);
    }
};
struct EpiResid { static constexpr bool PAIR = false;
    const float* base; float* out;
    DI void operator()(int row, int col, float v) const { out[(size_t)row * DM + col] = base[(size_t)row * DM + col] + v; }
};
struct EpiBf { static constexpr bool PAIR = false;
    bf16_t* o; int ld;
    DI void operator()(int row, int col, float v) const { o[(size_t)row * ld + col] = f2bf(v); }
};
struct EpiF32 { static constexpr bool PAIR = false;
    float* o; int ld;
    DI void operator()(int row, int col, float v) const { o[(size_t)row * ld + col] = v; }
};
struct EpiPle { static constexpr bool PAIR = false;
    float* x; const float* pp;
    DI void operator()(int row, int col, float v) const { const size_t i = (size_t)row * DM + col; x[i] = x[i] + sigmoidf_(v) * pp[i]; }
};

DI void rmsnorm_rows(int bx, int tid, const float* x, const float* __restrict__ g, bf16_t* outb, float* outf, int rows) {
    const int row = bx * 4 + (tid >> 6), lane = tid & 63;
    if (row >= rows) return;
    const float4* xr = (const float4*)(x + (size_t)row * DM);
    float4 v[4]; float s = 0.f;
#pragma unroll
    for (int j = 0; j < 4; ++j) { v[j] = xr[lane + 64 * j]; s += v[j].x * v[j].x + v[j].y * v[j].y + v[j].z * v[j].z + v[j].w * v[j].w; }
    const float rstd = rsqrtf(wave_sum(s) * (1.f / DM) + 1e-6f);
#pragma unroll
    for (int j = 0; j < 4; ++j) {
        const float4 gg = ((const float4*)g)[lane + 64 * j];
        const float a = v[j].x * rstd * gg.x, b = v[j].y * rstd * gg.y, c = v[j].z * rstd * gg.z, d = v[j].w * rstd * gg.w;
        if (outf) ((float4*)(outf + (size_t)row * DM))[lane + 64 * j] = make_float4(a, b, c, d);
        else { ushort4 o; o.x = f2bf(a); o.y = f2bf(b); o.z = f2bf(c); o.w = f2bf(d); ((ushort4*)(outb + (size_t)row * DM))[lane + 64 * j] = o; }
    }
}

DI void cvt_bf16(int bx, int nb, int tid, const float* __restrict__ in, bf16_t* __restrict__ out, size_t n) {
    for (size_t i = bx * (size_t)256 + tid; i < n; i += (size_t)nb * 256) out[i] = f2bf(in[i]);
}

DI float gelu_tanh(float x) { const float u = 0.7978845608028654f * (x + 0.044715f * x * x * x); return 0.5f * x * (1.f + tanhf(u)); }

DI void compress_naive(int bx, int by, int bz, int tid, char* sm, const bf16_t* __restrict__ KVb, const float* __restrict__ w1k, const float* __restrict__ w2k, const float* __restrict__ pek,
                                                      const float* __restrict__ w1v, const float* __restrict__ w2v, const float* __restrict__ pev, float* __restrict__ outk, float* __restrict__ outv, bf16_t* __restrict__ kcb, bf16_t* __restrict__ vcT) {
    float* flat = (float*)sm;
    float* h1 = flat + 2048;
    __syncthreads();
    const int j = bx, bg = by, kv = bz, b = bg >> 1, g = bg & 1;
    const float* w1 = kv ? w1v : w1k; const float* w2 = kv ? w2v : w2k; const float* pe = kv ? pev : pek; float* out = kv ? outv : outk;
    const int colbase = (kv ? 128 : 0) + g * 64;
    for (int e = tid; e < 2048; e += 256) {
        const int i = e >> 6, d = e & 63;
        flat[e] = bf2f(KVb[(size_t)(b * SEQ + 16 * j + i) * 512 + colbase + d]) + pe[e];
    }
    __syncthreads();
    float s = 0.f;
    for (int k = 0; k < 2048; ++k) s += flat[k] * w1[(size_t)k * 256 + tid];
    h1[tid] = gelu_tanh(s);
    __syncthreads();
    if (tid < 64) {
        float o = 0.f;
        for (int n = 0; n < 256; ++n) o += h1[n] * w2[n * 64 + tid];
        out[((size_t)bg * 256 + j) * 64 + tid] = o;
        if (kv == 0) { kcb[((size_t)bg * 256 + j) * 64 + tid] = f2bf(o); if (j == 254) kcb[((size_t)bg * 256 + 255) * 64 + tid] = 0; }
        else { vcT[((size_t)bg * 4 + (j >> 6)) * 4096 + tid * 64 + (j & 63)] = f2bf(o); if (j == 254) vcT[((size_t)bg * 4 + 3) * 4096 + tid * 64 + 63] = 0; }
    }
}

DI void softmax_row(float* row, int n, int lane) {
    float m = -3.0e38f;
    for (int j = lane; j < n; j += 64) m = fmaxf(m, row[j]);
    m = wave_max(m);
    float s = 0.f;
    for (int j = lane; j < n; j += 64) { const float e = exp2f(row[j] - m); row[j] = e; s += e; }
    s = wave_sum(s);
    const float inv = 1.f / s;
    for (int j = lane; j < n; j += 64) row[j] *= inv;
}

DI void nsa_naive(int bx, int by, int tid, char* sm, const bf16_t* __restrict__ Qb, const bf16_t* __restrict__ KVb, const bf16_t* __restrict__ VT, const float* __restrict__ kcc, const float* __restrict__ vcc, const float* __restrict__ gates, bf16_t* __restrict__ Y) {
    float (*q)[64] = (float (*)[64])sm;
    float (*sc)[1024] = (float (*)[1024])(sm + 1024);
    float* impv = (float*)(sm + 1024 + 16384);
    int* sellist = (int*)(sm + 1024 + 16384 + 256);
    int* selflag = (int*)(sm + 1024 + 16384 + 256 + 64);
    int& nsel_s = *(int*)(sm + 1024 + 16384 + 256 + 64 + 256);
    __syncthreads();
    const int tok = bx, g = by, b = tok >> 12, t = tok & 4095, hh = tid >> 6, lane = tid & 63, d = lane;
    q[hh][d] = bf2f(Qb[(size_t)tok * 512 + (g * 4 + hh) * 64 + d]);
    __syncthreads();
    const int nv = (t >= 31) ? ((t - 15) >> 4) : 0;
    const float* kcb = kcc + (size_t)(b * 2 + g) * 256 * 64; const float* vcb = vcc + (size_t)(b * 2 + g) * 256 * 64;
    if (tid < nv) {
        float s0 = 0.f, s1 = 0.f, s2 = 0.f, s3 = 0.f;
#pragma unroll 8
        for (int dd = 0; dd < 64; ++dd) { const float kx = kcb[tid * 64 + dd]; s0 += q[0][dd] * kx; s1 += q[1][dd] * kx; s2 += q[2][dd] * kx; s3 += q[3][dd] * kx; }
        sc[0][tid] = s0; sc[1][tid] = s1; sc[2][tid] = s2; sc[3][tid] = s3;
    }
    __syncthreads();
    if (nv > 0) softmax_row(sc[hh], nv, lane);
    for (int j = nv + lane; j < 256; j += 64) sc[hh][j] = 0.f;
    __syncthreads();
    float o_cmp = 0.f;
    for (int j = 0; j < nv; ++j) o_cmp += sc[hh][j] * vcb[j * 64 + d];
    const int cur = t >> 6;
    if (tid < 64) {
        const int s = tid; int lo = 4 * s - 1; if (lo < 0) lo = 0; int hi2 = 4 * s + 3; if (hi2 > 254) hi2 = 254;
        float v = 0.f;
        for (int h2 = 0; h2 < 4; ++h2) for (int j = lo; j <= hi2; ++j) v += sc[h2][j];
        if (s == 0 || s == cur || s == cur - 1) v += 1000.0f;
        if (s > cur) v = -1e30f;
        impv[s] = v;
    }
    __syncthreads();
    if (tid < 64) {
        const float v = impv[tid]; int rank = 0;
        for (int s2 = 0; s2 < 64; ++s2) { const float u = impv[s2]; rank += (u > v || (u == v && s2 < tid)) ? 1 : 0; }
        selflag[tid] = (rank < 16 && tid <= cur) ? 1 : 0;
    }
    __syncthreads();
    if (tid == 0) { int n = 0; for (int s = 0; s < 64; ++s) if (selflag[s]) { if (n < 16) sellist[n] = s; ++n; } nsel_s = n < 16 ? n : 16; }
    __syncthreads();
    const int ns = nsel_s, ne = ns * 64;
    for (int e = tid; e < ne; e += 256) {
        const int kpos = sellist[e >> 6] * 64 + (e & 63);
        if (kpos <= t) {
            const bf16_t* kp = KVb + (size_t)(b * SEQ + kpos) * 512 + 256 + g * 64;
            float s0 = 0.f, s1 = 0.f, s2 = 0.f, s3 = 0.f;
    #pragma unroll 8
        for (int dd = 0; dd < 64; ++dd) { const float kx = bf2f(kp[dd]); s0 += q[0][dd] * kx; s1 += q[1][dd] * kx; s2 += q[2][dd] * kx; s3 += q[3][dd] * kx; }
            sc[0][e] = s0; sc[1][e] = s1; sc[2][e] = s2; sc[3][e] = s3;
        } else { sc[0][e] = -1e30f; sc[1][e] = -1e30f; sc[2][e] = -1e30f; sc[3][e] = -1e30f; }
    }
    __syncthreads();
    softmax_row(sc[hh], ne, lane);
    __syncthreads();
    float o_sel = 0.f;
    for (int e = 0; e < ne; ++e) {
        const int kpos = sellist[e >> 6] * 64 + (e & 63);
        o_sel += sc[hh][e] * bf2f(VT[((size_t)(b * 2 + g) * 64 + (kpos >> 6)) * 4096 + d * 64 + (kpos & 63)]);
    }
    __syncthreads();
    const int nw = (t + 1 < 512) ? (t + 1) : 512, w0 = t - nw + 1;
    for (int e = tid; e < nw; e += 256) {
        const bf16_t* kp = KVb + (size_t)(b * SEQ + w0 + e) * 512 + 384 + g * 64;
        float s0 = 0.f, s1 = 0.f, s2 = 0.f, s3 = 0.f;
#pragma unroll 8
        for (int dd = 0; dd < 64; ++dd) { const float kx = bf2f(kp[dd]); s0 += q[0][dd] * kx; s1 += q[1][dd] * kx; s2 += q[2][dd] * kx; s3 += q[3][dd] * kx; }
        sc[0][e] = s0; sc[1][e] = s1; sc[2][e] = s2; sc[3][e] = s3;
    }
    __syncthreads();
    softmax_row(sc[hh], nw, lane);
    __syncthreads();
    float o_win = 0.f;
    for (int e = 0; e < nw; ++e) { const int kpos = w0 + e; o_win += sc[hh][e] * bf2f(VT[((size_t)(8 + b * 2 + g) * 64 + (kpos >> 6)) * 4096 + d * 64 + (kpos & 63)]); }
    const float* gt = gates + (size_t)tok * 24 + (g * 4 + hh) * 3;
    Y[(size_t)tok * DM + (g * 4 + hh) * 64 + d] = f2bf(gt[0] * o_cmp + gt[1] * o_sel + gt[2] * o_win);
}

DI void conv_silu(int bx, int tid, const bf16_t* __restrict__ MQK, const float* __restrict__ wc, const float* __restrict__ bc, bf16_t* __restrict__ out) {
    const int idx = bx * 256 + tid;
    if (idx >= T_TOK * 1024) return;
    const int c = idx & 1023, tok = idx >> 10, t = tok & 4095;
    float y = bc[c];
#pragma unroll
    for (int j = 0; j < 4; ++j) { const int tt = t - 3 + j; if (tt >= 0) y += wc[j * 1024 + c] * bf2f(MQK[(size_t)(tok - 3 + j) * 1024 + c]); }
    y = y * sigmoidf_(y);
    if (c >= 512) y *= 0.08838834764831845f;
    out[idx] = f2bf(y);
}

DI void mlstm_naive(int bx, int tid, char* sm, const bf16_t* __restrict__ qkc, const bf16_t* __restrict__ MV, const bf16_t* __restrict__ MO, const float* __restrict__ ifp, float* __restrict__ hm) {
    float (*qs)[128] = (float (*)[128])sm;
    float (*ks)[128] = (float (*)[128])(sm + 16384);
    float (*vs)[16] = (float (*)[16])(sm + 32768);
    float (*os)[16] = (float (*)[16])(sm + 32768 + 2048);
    float* gi = (float*)(sm + 32768 + 4096); float* gf = gi + 32;
    const int bh = bx >> 3, vsl = bx & 7, b = bh >> 2, h = bh & 3, v = tid >> 4, kg = tid & 15;
    float C[8], n[8];
#pragma unroll
    for (int j = 0; j < 8; ++j) { C[j] = 0.f; n[j] = 0.f; }
    for (int c0 = 0; c0 < SEQ; c0 += 32) {
        __syncthreads();
        for (int e = tid; e < 32 * 128; e += 256) {
            const int s = e >> 7, k = e & 127; const size_t tok = (size_t)b * SEQ + c0 + s;
            qs[s][k] = bf2f(qkc[tok * 1024 + h * 128 + k]); ks[s][k] = bf2f(qkc[tok * 1024 + 512 + h * 128 + k]);
        }
        for (int e = tid; e < 32 * 16; e += 256) {
            const int s = e >> 4, vv = e & 15; const size_t tok = (size_t)b * SEQ + c0 + s;
            vs[s][vv] = bf2f(MV[tok * 512 + h * 128 + vsl * 16 + vv]);
            os[s][vv] = sigmoidf_(bf2f(MO[tok * 512 + h * 128 + vsl * 16 + vv]));
        }
        if (tid < 32) { const size_t tok = (size_t)b * SEQ + c0 + tid; gi[tid] = __expf(ifp[tok * 8 + h]); gf[tid] = sigmoidf_(ifp[tok * 8 + 4 + h]); }
        __syncthreads();
        for (int s = 0; s < 32; ++s) {
            const float f = gf[s], iv = gi[s] * vs[s][v], ig = gi[s];
            float num = 0.f, den = 0.f;
#pragma unroll
            for (int j = 0; j < 8; ++j) {
                const float kx = ks[s][kg * 8 + j], qx = qs[s][kg * 8 + j];
                C[j] = f * C[j] + iv * kx; n[j] = f * n[j] + ig * kx;
                num += C[j] * qx; den += n[j] * qx;
            }
            const int l_ = lane_id_opaque();
#pragma unroll
            for (int o = 1; o < 16; o <<= 1) { num += lane_xor(num, o, l_); den += lane_xor(den, o, l_); }
            if (kg == 0) hm[((size_t)b * SEQ + c0 + s) * 512 + h * 128 + vsl * 16 + v] = num / fmaxf(fabsf(den), 1.0f) * os[s][v];
        }
    }
}

DI void hnorm(int bx, int tid, const float* __restrict__ hm, const float* __restrict__ g_hn, bf16_t* __restrict__ Y) {
    const int item = bx * 4 + (tid >> 6), lane = tid & 63;
    const int tok = item >> 2, h = item & 3;
    const float a = hm[(size_t)tok * 512 + h * 128 + lane], b = hm[(size_t)tok * 512 + h * 128 + 64 + lane];
    const float rstd = rsqrtf(wave_sum(a * a + b * b) * (1.f / 128.f) + 1e-6f);
    Y[(size_t)tok * DM + 512 + h * 128 + lane] = f2bf(a * rstd * g_hn[h * 128 + lane]);
    Y[(size_t)tok * DM + 512 + h * 128 + 64 + lane] = f2bf(b * rstd * g_hn[h * 128 + 64 + lane]);
}

DI void router(int bx, int tid, const float* __restrict__ x, const float* __restrict__ g, const float* __restrict__ w_rg, const float* __restrict__ b_rg,
                                              const float* __restrict__ w_re, const float* __restrict__ b_re, bf16_t* __restrict__ xn, float* __restrict__ gate) {
    const int tok = bx * 4 + (tid >> 6), lane = tid & 63;
    float xv[16]; float s = 0.f;
#pragma unroll
    for (int j = 0; j < 4; ++j) { const float4 v = ((const float4*)(x + (size_t)tok * DM))[lane + 64 * j]; xv[4 * j] = v.x; xv[4 * j + 1] = v.y; xv[4 * j + 2] = v.z; xv[4 * j + 3] = v.w; s += v.x * v.x + v.y * v.y + v.z * v.z + v.w * v.w; }
    const float rstd = rsqrtf(wave_sum(s) * (1.f / DM) + 1e-6f);
#pragma unroll
    for (int j = 0; j < 4; ++j) { const float4 gg = ((const float4*)g)[lane + 64 * j]; xv[4 * j] *= rstd * gg.x; xv[4 * j + 1] *= rstd * gg.y; xv[4 * j + 2] *= rstd * gg.z; xv[4 * j + 3] *= rstd * gg.w;
        ushort4 o; o.x = f2bf(xv[4 * j]); o.y = f2bf(xv[4 * j + 1]); o.z = f2bf(xv[4 * j + 2]); o.w = f2bf(xv[4 * j + 3]); ((ushort4*)(xn + (size_t)tok * DM))[lane + 64 * j] = o; }
    float mylog = 0.f;
#pragma unroll 1
    for (int c = 0; c < 20; ++c) {
        const float* w = c < 4 ? w_rg + c : w_re + (c - 4); const int ld = c < 4 ? 4 : 16;
        float a = 0.f;
#pragma unroll
        for (int j = 0; j < 4; ++j)
#pragma unroll
            for (int i = 0; i < 4; ++i) a += xv[4 * j + i] * w[(size_t)(4 * (lane + 64 * j) + i) * ld];
        a = wave_sum(a) + (c < 4 ? b_rg[c] : b_re[c - 4]);
        if (lane == c) mylog = a;
    }
    float gl[4], el[16];
#pragma unroll
    for (int c = 0; c < 4; ++c) gl[c] = lane_get(mylog, c);
#pragma unroll
    for (int c = 0; c < 16; ++c) el[c] = lane_get(mylog, 4 + c);
    if (lane == 0) {
        int gs = 0; float gm = gl[0];
#pragma unroll
        for (int c = 1; c < 4; ++c) if (gl[c] > gm) { gm = gl[c]; gs = c; }
        float se = 0.f;
#pragma unroll
        for (int c = 0; c < 4; ++c) se += __expf(gl[c] - gm);
        const float pg = 1.f / se;
        float e4[4];
#pragma unroll
        for (int c = 0; c < 4; ++c) e4[c] = gs == 0 ? el[c] : gs == 1 ? el[4 + c] : gs == 2 ? el[8 + c] : el[12 + c];
        int i0 = 0; float v0 = e4[0];
#pragma unroll
        for (int c = 1; c < 4; ++c) if (e4[c] > v0) { v0 = e4[c]; i0 = c; }
        int i1 = -1; float v1 = -3.0e38f;
#pragma unroll
        for (int c = 0; c < 4; ++c) if (c != i0 && e4[c] > v1) { v1 = e4[c]; i1 = c; }
        const float ex = __expf(v1 - v0);
        const float w0 = pg / (1.f + ex), w1 = pg * ex / (1.f + ex);
#pragma unroll
        for (int c = 0; c < 16; ++c) gate[(size_t)tok * 16 + c] = (c == gs * 4 + i0) ? w0 : (c == gs * 4 + i1) ? w1 : 0.f;
    }
}


struct EpiMoe { static constexpr bool PAIR = true;
    const float* gate; bf16_t* act;
    DI void operator()(int, int, float) const {}
    DI void pair(int row, int col, float gg, float u) const {
        const int t = col >> 7, c = col & 127, e = t >> 2, jt = t & 3, f = jt * 64 + (c >> 6) * 32 + (c & 31);
        act[(size_t)row * 4096 + e * 256 + f] = f2bf(gg * sigmoidf_(gg) * u * gate[(size_t)row * 16 + e]);
    }
};

typedef float f32x2_t __attribute__((ext_vector_type(2))); typedef __bf16 bf16x2_t __attribute__((ext_vector_type(2)));
DI unsigned cvtpk(float lo, float hi) { f32x2_t v = {lo, hi}; bf16x2_t b = __builtin_convertvector(v, bf16x2_t); return __builtin_bit_cast(unsigned, b); }
typedef __attribute__((address_space(3))) char lds_c;
typedef unsigned u32x2v __attribute__((ext_vector_type(2))); typedef unsigned u32x4v __attribute__((ext_vector_type(4)));
constexpr int NSA_KC = 0, NSA_VC = 4 * 9216, NSA_KB = NSA_VC + 4 * 8704, NSA_VB = NSA_KB + 2 * 9216, NSA_IMP = NSA_VB + 2 * 8704, NSA_MASK = NSA_IMP + 64 * 65 * 4, NSA_END = NSA_MASK + 512;
static_assert(NSA_END <= 147456, "NSA LDS map");
DI int crow(int r, int hi) { return (r & 3) + 8 * (r >> 2) + 4 * hi; }
#define MFMA32(a, b, c) __builtin_amdgcn_mfma_f32_32x32x16_bf16((a), (b), (c), 0, 0, 0)

DI void nsa_qk(f32x16& p0, f32x16& p1, const lds_c* K, const bf16x8 (&qf)[4], float cin, int r32, int hi) {
    f32x16 c;
#pragma unroll
    for (int r = 0; r < 16; ++r) c[r] = cin;
#pragma unroll
    for (int ks = 0; ks < 4; ++ks) {
        const bf16x8 a0 = *(const __attribute__((address_space(3))) bf16x8*)(K + r32 * 144 + ks * 32 + hi * 16);
        const bf16x8 a1 = *(const __attribute__((address_space(3))) bf16x8*)(K + (32 + r32) * 144 + ks * 32 + hi * 16);
        if (ks == 0) { p0 = MFMA32(a0, qf[0], c); p1 = MFMA32(a1, qf[0], c); } else { p0 = MFMA32(a0, qf[ks], p0); p1 = MFMA32(a1, qf[ks], p1); }
    }
}
DI float max3f_(float a, float b, float c) { float r; asm("v_max3_f32 %0, %1, %2, %3" : "=v"(r) : "v"(a), "v"(b), "v"(c)); return r; }
DI float max2f_(float a, float b) { float r; asm("v_max_f32_e32 %0, %1, %2" : "=v"(r) : "v"(a), "v"(b)); return r; }
DI void nsa_softmax(f32x16& p0, f32x16& p1, float& mref, float& l, bool& started, f32x16& o0, f32x16& o1) {
    float ma = max3f_(p0[0], p0[1], p1[0]), mb = max3f_(p0[2], p0[3], p1[1]); ma = max3f_(ma, p1[2], p1[3]);
#pragma unroll
    for (int r = 4; r < 16; r += 4) { ma = max3f_(ma, p0[r], p0[r + 1]); mb = max3f_(mb, p0[r + 2], p0[r + 3]); ma = max3f_(ma, p1[r], p1[r + 1]); mb = max3f_(mb, p1[r + 2], p1[r + 3]); }
    float mx = max2f_(ma, mb);
    { auto rr = __builtin_amdgcn_permlane32_swap(__float_as_uint(mx), __float_as_uint(mx), false, false); mx = max2f_(__uint_as_float(rr[0]), __uint_as_float(rr[1])); }
    const bool need = started ? (mx > 8.f) : (mx > -3.0e38f);
    if (__any(need)) {
        const float delta = need ? mx : 0.f, f = started ? __builtin_amdgcn_exp2f(-delta) : 1.f;
        mref += delta;
#pragma unroll
        for (int r = 0; r < 16; ++r) { p0[r] -= delta; p1[r] -= delta; o0[r] *= f; o1[r] *= f; }
        l *= f; started = started || need;
    }
    float s = 0.f;
#pragma unroll
    for (int r = 0; r < 16; ++r) { p0[r] = __builtin_amdgcn_exp2f(p0[r]); p1[r] = __builtin_amdgcn_exp2f(p1[r]); s += p0[r] + p1[r]; }
    l += s;
}
DI void nsa_pv(f32x16& o0, f32x16& o1, const f32x16& p0, const f32x16& p1, const lds_c* V, int r32, int hi) {
#pragma unroll
    for (int hf = 0; hf < 2; ++hf)
#pragma unroll
        for (int s = 0; s < 2; ++s) {
            unsigned pw[4];
#pragma unroll
            for (int j = 0; j < 4; ++j) pw[j] = hf ? cvtpk(p1[8 * s + 2 * j], p1[8 * s + 2 * j + 1]) : cvtpk(p0[8 * s + 2 * j], p0[8 * s + 2 * j + 1]);
            const u32x4v pbw = {pw[0], pw[1], pw[2], pw[3]};
            const bf16x8 pb = __builtin_bit_cast(bf16x8, pbw);
            const lds_c* vp = V + r32 * 136 + hf * 64 + s * 32 + hi * 8;
            const u32x2v a0l = *(const __attribute__((address_space(3))) u32x2v*)(vp), a0h = *(const __attribute__((address_space(3))) u32x2v*)(vp + 16);
            const u32x2v a1l = *(const __attribute__((address_space(3))) u32x2v*)(vp + 32 * 136), a1h = *(const __attribute__((address_space(3))) u32x2v*)(vp + 32 * 136 + 16);
            const u32x4v A0w = {a0l.x, a0l.y, a0h.x, a0h.y}, A1w = {a1l.x, a1l.y, a1h.x, a1h.y};
            o0 = MFMA32(__builtin_bit_cast(bf16x8, A0w), pb, o0); o1 = MFMA32(__builtin_bit_cast(bf16x8, A1w), pb, o1);
        }
}
DI void nsa_store_k(lds_c* K, const u32x4v v, int tid) { *(__attribute__((address_space(3))) u32x4v*)(K + (tid >> 3) * 144 + (tid & 7) * 16) = v; }
DI void nsa_store_v(lds_c* V, const u32x4v v, int tid) { lds_c* p = V + (tid >> 3) * 136 + (tid & 7) * 16; *(__attribute__((address_space(3))) u32x2v*)p = (u32x2v){v.x, v.y}; *(__attribute__((address_space(3))) u32x2v*)(p + 8) = (u32x2v){v.z, v.w}; }
#define NEG_INF (-__builtin_inff())
DI void nsa_finish(f32x16& y0, f32x16& y1, f32x16& o0, f32x16& o1, float& m, float& l, bool& started, float gate) {
    float lt; { auto rr = __builtin_amdgcn_permlane32_swap(__float_as_uint(l), __float_as_uint(l), false, false); lt = __uint_as_float(rr[0]) + __uint_as_float(rr[1]); }
    const float f = lt > 0.f ? gate / lt : 0.f;
#pragma unroll
    for (int r = 0; r < 16; ++r) { y0[r] += f * o0[r]; y1[r] += f * o1[r]; o0[r] = 0.f; o1[r] = 0.f; }
    m = 0.f; l = 0.f; started = false;
}

DI void nsa_unit(int bg, int qb, int tx, lds_c* lds, const bf16_t* __restrict__ Qb, const bf16_t* __restrict__ KVb, const bf16_t* __restrict__ VT, const bf16_t* __restrict__ kcb, const bf16_t* __restrict__ vcT,
                 const float* __restrict__ gates, bf16_t* __restrict__ Y, unsigned long long& pacc) {
    const int lane = tx & 63, r32 = lane & 31, hi = lane >> 5, wave = __builtin_amdgcn_readfirstlane(tx >> 6), hh = wave >> 1, qs = wave & 1;
    RG_BEGIN(100)
    const int b = bg >> 1, g = bg & 1, ql = 32 * qs + r32, tq = 64 * qb + ql;
    const size_t tok = (size_t)b * SEQ + tq; const int head = g * 4 + hh;
    const int nc = (4 * qb + 66) >> 6;
    const bool need_topk = qb >= 16;
    lds_c* KC = lds + NSA_KC; lds_c* VC = lds + NSA_VC; lds_c* KB = lds + NSA_KB; lds_c* VB = lds + NSA_VB;
    __attribute__((address_space(3))) float* imp = (__attribute__((address_space(3))) float*)(lds + NSA_IMP);
    __attribute__((address_space(3))) unsigned* msk = (__attribute__((address_space(3))) unsigned*)(lds + NSA_MASK);
    const bf16_t* kcsrc = kcb + (size_t)bg * 256 * 64; const bf16_t* vcsrc = vcT + (size_t)bg * 4 * 4096;
    const bf16_t* kssrc = KVb + (size_t)b * SEQ * 512 + 256 + g * 64; const bf16_t* kwsrc = KVb + (size_t)b * SEQ * 512 + 384 + g * 64;
    const bf16_t* vssrc = VT + (size_t)bg * 64 * 4096; const bf16_t* vwsrc = VT + (size_t)(8 + bg) * 64 * 4096;
    const int n_sel = qb + 1, n_win = qb + 1 < 9 ? qb + 1 : 9, ntile = n_sel + n_win;
    __syncthreads();
    for (int c = 0; c < nc; ++c) {
        nsa_store_k(KC + c * 9216, *(const u32x4v*)(kcsrc + (size_t)(c * 64 + (tx >> 3)) * 64 + (tx & 7) * 8), tx);
        nsa_store_v(VC + c * 8704, *(const u32x4v*)(vcsrc + (size_t)c * 4096 + (tx >> 3) * 64 + (tx & 7) * 8), tx);
    }
    nsa_store_k(KB, *(const u32x4v*)(kssrc + (size_t)(tx >> 3) * 512 + (tx & 7) * 8), tx);
    nsa_store_v(VB, *(const u32x4v*)(vssrc + (tx >> 3) * 64 + (tx & 7) * 8), tx);
    for (int i = tx; i < 64 * 65; i += 512) imp[i] = 0.f;
    bf16x8 qf[4];
#pragma unroll
    for (int ks = 0; ks < 4; ++ks) qf[ks] = *(const bf16x8*)(Qb + tok * 512 + head * 64 + ks * 16 + hi * 8);
    const float g_cmp = gates[tok * 24 + head * 3 + 0], g_sel = gates[tok * 24 + head * 3 + 1], g_win = gates[tok * 24 + head * 3 + 2];
    f32x16 y0, y1, o0, o1, p0, p1;
#pragma unroll
    for (int r = 0; r < 16; ++r) { y0[r] = 0.f; y1[r] = 0.f; o0[r] = 0.f; o1[r] = 0.f; }
    float m = 0.f, l = 0.f; bool started = false;
    __syncthreads();
    RG_END(100)
    RG_BEGIN(101)
    const int nvq = tq >= 31 ? ((tq - 15) >> 4) : 0;
    for (int c = 0; c < nc; ++c) {
        nsa_qk(p0, p1, KC + c * 9216, qf, -m, r32, hi);
        const int lim = nvq - 64 * c;
#pragma unroll
        for (int r = 0; r < 16; ++r) { const int kl = crow(r, hi); if (kl >= lim) p0[r] = NEG_INF; if (kl + 32 >= lim) p1[r] = NEG_INF; }
        nsa_softmax(p0, p1, m, l, started, o0, o1);
        nsa_pv(o0, o1, p0, p1, VC + c * 8704, r32, hi);
    }
    const float m_c = m; float l_c; { auto rr = __builtin_amdgcn_permlane32_swap(__float_as_uint(l), __float_as_uint(l), false, false); l_c = __uint_as_float(rr[0]) + __uint_as_float(rr[1]); }
    nsa_finish(y0, y1, o0, o1, m, l, started, g_cmp);
    RG_END(101)
    unsigned mlo = 0xffffffffu, mhi = 0xffffffffu;
    RG_BEGIN(102)
    if (need_topk) {
        const float invl = l_c > 0.f ? 16777216.f / l_c : 0.f;
        __attribute__((address_space(3))) unsigned* impu = (__attribute__((address_space(3))) unsigned*)imp;
        for (int c = 0; c < nc; ++c) {
            nsa_qk(p0, p1, KC + c * 9216, qf, -m_c, r32, hi);
            const int lim = nvq - 64 * c;
#pragma unroll
            for (int r = 0; r < 16; ++r) { const int kl = crow(r, hi);
                p0[r] = kl < lim ? __builtin_amdgcn_exp2f(p0[r]) * invl : 0.f; p1[r] = kl + 32 < lim ? __builtin_amdgcn_exp2f(p1[r]) * invl : 0.f; }
#pragma unroll
            for (int hf = 0; hf < 2; ++hf)
#pragma unroll
                for (int i = 0; i < 4; ++i) {
                    const int a = 16 * c + 8 * hf + 2 * i + hi;
                    const unsigned u0 = (unsigned)__float2uint_rn(hf ? p1[4 * i] : p0[4 * i]), u1 = (unsigned)__float2uint_rn(hf ? p1[4 * i + 1] : p0[4 * i + 1]);
                    const unsigned u2 = (unsigned)__float2uint_rn(hf ? p1[4 * i + 2] : p0[4 * i + 2]), u3 = (unsigned)__float2uint_rn(hf ? p1[4 * i + 3] : p0[4 * i + 3]);
                    __hip_atomic_fetch_add(impu + ql * 65 + a, u0 + u1 + u2 + u3, __ATOMIC_RELAXED, __HIP_MEMORY_SCOPE_WORKGROUP);
                    if (a + 1 < 64) __hip_atomic_fetch_add(impu + ql * 65 + a + 1, u3, __ATOMIC_RELAXED, __HIP_MEMORY_SCOPE_WORKGROUP);
                }
        }
        __syncthreads();
        RG_BEGIN(103)
        {
            const int q = tx >> 3, j8 = tx & 7, smax = qb - 2;
            unsigned key[8];
#pragma unroll
            for (int k = 0; k < 8; ++k) { const int sb = j8 + 8 * k; key[k] = (sb >= 1 && sb <= smax) ? ((impu[q * 65 + sb] & ~63u) | (unsigned)(63 - sb)) + 64u : 0u; }
            unsigned blo = 0u, bhi = 0u;
#pragma unroll 1
            for (int round = 0; round < 13; ++round) {
                unsigned mx = key[0];
#pragma unroll
                for (int k = 1; k < 8; ++k) mx = mx > key[k] ? mx : key[k];
                { const unsigned t = (unsigned)__builtin_amdgcn_update_dpp(0, (int)mx, 0xB1, 0xf, 0xf, true); mx = mx > t ? mx : t; }
                { const unsigned t = (unsigned)__builtin_amdgcn_update_dpp(0, (int)mx, 0x4E, 0xf, 0xf, true); mx = mx > t ? mx : t; }
                { const unsigned t = (unsigned)__builtin_amdgcn_update_dpp(0, (int)mx, 0x141, 0xf, 0xf, true); mx = mx > t ? mx : t; }
#pragma unroll
                for (int k = 0; k < 8; ++k) if (key[k] == mx && mx != 0u) { key[k] = 0u; const int sb = j8 + 8 * k; if (sb < 32) blo |= 1u << sb; else bhi |= 1u << (sb - 32); }
            }
            const int l_ = lane_id_opaque();
#pragma unroll
            for (int o = 1; o < 8; o <<= 1) { blo |= (unsigned)__builtin_amdgcn_ds_bpermute((l_ ^ o) << 2, (int)blo); bhi |= (unsigned)__builtin_amdgcn_ds_bpermute((l_ ^ o) << 2, (int)bhi); }
            unsigned long long mm = ((unsigned long long)bhi << 32) | blo;
            mm |= 1ull | (1ull << qb) | (1ull << (qb - 1));
            if (j8 == 0) { msk[q * 2] = (unsigned)mm; msk[q * 2 + 1] = (unsigned)(mm >> 32); }
        }
        __syncthreads();
        RG_END(103)
        mlo = msk[ql * 2]; mhi = msk[ql * 2 + 1];
    }
    RG_END(102)
    RG_BEGIN(104)
#define NSA_SRC(i_, KP, VP) do { const bool nsel_ = (i_) < n_sel; const int s2_ = nsel_ ? (i_) : qb - n_win + 1 + ((i_) - n_sel); \
        KP = (nsel_ ? kssrc : kwsrc) + (size_t)(s2_ * 64 + (tx >> 3)) * 512 + (tx & 7) * 8; VP = (nsel_ ? vssrc : vwsrc) + (size_t)s2_ * 4096 + (tx >> 3) * 64 + (tx & 7) * 8; } while (0)
#define NSA_TILE(i_, cur_, KLD, VLD, KST, VST) do { \
        const bool is_sel = (i_) < n_sel; const int s = is_sel ? (i_) : qb - n_win + 1 + ((i_) - n_sel); \
        if ((i_) + 2 < ntile) { const bf16_t* kp_; const bf16_t* vp_; NSA_SRC((i_) + 2, kp_, vp_); KLD = *(const u32x4v*)kp_; VLD = *(const u32x4v*)vp_; } \
        const bool on = !is_sel || ((s < 32 ? (mlo >> s) : (mhi >> (s - 32))) & 1u) != 0u; \
        nsa_qk(p0, p1, KB + (cur_) * 9216, qf, on ? -m : NEG_INF, r32, hi); \
        const bool lowb = !is_sel && (qb >= 8) && (s == qb - 8), diag = (s == qb); \
        if (lowb || diag) { \
            asm volatile("; boundary tile" ::: "memory");        \
            _Pragma("unroll") for (int r = 0; r < 16; ++r) { const int kl = crow(r, hi); \
                if ((lowb && kl <= ql) || (diag && kl > ql)) p0[r] = NEG_INF; if ((lowb && kl + 32 <= ql) || (diag && kl + 32 > ql)) p1[r] = NEG_INF; } \
        } \
        nsa_softmax(p0, p1, m, l, started, o0, o1); \
        nsa_pv(o0, o1, p0, p1, VB + (cur_) * 8704, r32, hi); \
        if ((i_) == n_sel - 1) nsa_finish(y0, y1, o0, o1, m, l, started, g_sel); \
        if ((i_) == ntile - 1) nsa_finish(y0, y1, o0, o1, m, l, started, g_win); \
        if ((i_) + 1 < ntile) { nsa_store_k(KB + ((cur_) ^ 1) * 9216, KST, tx); nsa_store_v(VB + ((cur_) ^ 1) * 8704, VST, tx); } \
        __syncthreads(); } while (0)
    u32x4v kA = {0u, 0u, 0u, 0u}, vA = kA, kB2 = kA, vB2 = kA;
    if (ntile > 1) { const bf16_t* kp_; const bf16_t* vp_; NSA_SRC(1, kp_, vp_); kA = *(const u32x4v*)kp_; vA = *(const u32x4v*)vp_; }
    {
        int i = 0;
        for (; i + 1 < ntile; i += 2) {
            NSA_TILE(i, 0, kB2, vB2, kA, vA);
            NSA_TILE(i + 1, 1, kA, vA, kB2, vB2);
        }
        if (i < ntile) NSA_TILE(i, 0, kB2, vB2, kA, vA);
    }
#undef NSA_TILE
#undef NSA_SRC
    RG_END(104)
    bf16_t* yp = Y + tok * DM + head * 64;
#pragma unroll
    for (int i = 0; i < 4; ++i) {
        *(uint2*)(yp + 8 * i + 4 * hi) = make_uint2(cvtpk(y0[4 * i], y0[4 * i + 1]), cvtpk(y0[4 * i + 2], y0[4 * i + 3]));
        *(uint2*)(yp + 32 + 8 * i + 4 * hi) = make_uint2(cvtpk(y1[4 * i], y1[4 * i + 1]), cvtpk(y1[4 * i + 2], y1[4 * i + 3]));
    }
}

DI float log_sigmoid_(float x) { return x >= 0.f ? -__logf(1.f + __expf(-x)) : x - __logf(1.f + __expf(x)); }
DI float lane_shr_add(float v, int l) {
#pragma unroll
    for (int o = 1; o < 64; o <<= 1) { const float t = lane_get(v, l - o); if (l >= o) v += t; }
    return v;
}
DI float lane_shr_max(float v, int l) {
#pragma unroll
    for (int o = 1; o < 64; o <<= 1) { const float t = lane_get(v, l - o); if (l >= o) v = fmaxf(v, t); }
    return v;
}
DI float log_sigmoid_fast(float x) { return -__logf(1.f + __expf(-x)); }
DI void ml_mscan_all(const float* __restrict__ ifp, int bh, int lane, float* __restrict__ mtab, float* __restrict__ wprev, float* __restrict__ wsc) {
    const int b = bh >> 2, h = bh & 3;
    const float* gp = ifp + ((size_t)b * SEQ + 64 * lane) * 8 + h;
    float L = 0.f, mx = -3.0e38f;
#pragma unroll 16
    for (int s = 0; s < 64; ++s) { const float iv = gp[s * 8], fv = gp[s * 8 + 4]; L += log_sigmoid_fast(fv); mx = fmaxf(mx, iv - L); }
    const float G = L + mx;
    float m = 0.f, mine = 0.f, mnext = 0.f;
#pragma unroll
    for (int k = 0; k < 64; ++k) {
        const float Lk = __builtin_bit_cast(float, __builtin_amdgcn_readlane(__builtin_bit_cast(int, L), k)), Gk = __builtin_bit_cast(float, __builtin_amdgcn_readlane(__builtin_bit_cast(int, G), k));
        if (k == lane) mine = m;
        m = fmaxf(Lk + m, Gk);
        if (k == lane) mnext = m;
    }
    mtab[bh * 65 + lane] = mine;
    wprev[bh * 64 + lane] = __expf(L + mine - mnext);
    wsc[bh * 64 + lane] = __expf(G - mnext);
}
DI void ml_conv8(float (&o)[8], const bf16_t* __restrict__ MQK, size_t tok, int t_in_seq, int col, const float* __restrict__ wc, const float* __restrict__ bc, float scale) {
    const float4 b0 = *(const float4*)(bc + col), b1 = *(const float4*)(bc + col + 4);
    o[0] = b0.x; o[1] = b0.y; o[2] = b0.z; o[3] = b0.w; o[4] = b1.x; o[5] = b1.y; o[6] = b1.z; o[7] = b1.w;
#pragma unroll
    for (int j = 0; j < 4; ++j) {
        if (t_in_seq - 3 + j >= 0) {
            float u[8]; unpack8(*(const pg8::u32x4*)(MQK + (tok - 3 + j) * 1024 + col), u);
            const float4 w0 = *(const float4*)(wc + j * 1024 + col), w1 = *(const float4*)(wc + j * 1024 + col + 4);
            o[0] += w0.x * u[0]; o[1] += w0.y * u[1]; o[2] += w0.z * u[2]; o[3] += w0.w * u[3]; o[4] += w1.x * u[4]; o[5] += w1.y * u[5]; o[6] += w1.z * u[6]; o[7] += w1.w * u[7];
        }
    }
#pragma unroll
    for (int i = 0; i < 8; ++i) o[i] = o[i] * sigmoidf_(o[i]) * scale;
}
constexpr float ML_KSCALE = 0.08838834764831845f;
DI void ml_unit_c(int bh, int c, int tx, lds_c* lds, const bf16_t* __restrict__ MQK, const bf16_t* __restrict__ MV, const float* __restrict__ ifp, const float* __restrict__ wc, const float* __restrict__ bc,
                  bf16_t* __restrict__ dC, float* __restrict__ dn, float* __restrict__ wprev, const float* __restrict__ mtab) {
    const int b = bh >> 2, h = bh & 3, lane = tx & 63, r32 = lane & 31, hi = lane >> 5, wave = __builtin_amdgcn_readfirstlane(tx >> 6);
    lds_c* KT = lds; lds_c* VTw = lds + 128 * 144;
    __attribute__((address_space(3))) float* wsm = (__attribute__((address_space(3))) float*)(lds + 2 * 128 * 144);
    const size_t tok0 = (size_t)b * SEQ + 64 * c;
    __syncthreads();
    if (wave == 0) {
        const float iv = ifp[(tok0 + lane) * 8 + h], lf = log_sigmoid_(ifp[(tok0 + lane) * 8 + 4 + h]);
        const int l_ = lane_id_opaque();
        const float bc_ = lane_shr_add(lf, l_), u = iv - bc_, umax = wave_max(u);
        wsm[lane] = __expf(u - umax);
        (void)wprev; (void)mtab;
    }
    __syncthreads();
#pragma unroll 1
    for (int it = tx; it < 1024; it += 512) {
        const int s = it >> 4, d0 = (it & 15) * 8; float kv[8];
        ml_conv8(kv, MQK, tok0 + s, 64 * c + s, 512 + h * 128 + d0, wc, bc, ML_KSCALE);
        float vv[8]; unpack8(*(const pg8::u32x4*)(MV + (tok0 + s) * 512 + h * 128 + d0), vv);
        const float w = wsm[s];
#pragma unroll
        for (int i = 0; i < 8; ++i) {
            *(__attribute__((address_space(3))) bf16_t*)(KT + (d0 + i) * 144 + s * 2) = f2bf(kv[i]);
            *(__attribute__((address_space(3))) bf16_t*)(VTw + (d0 + i) * 144 + s * 2) = f2bf(vv[i] * w);
        }
    }
    __syncthreads();
    if (tx < 128) {
        float a = 0.f;
        for (int s = 0; s < 64; ++s) a += wsm[s] * bf2f(*(const __attribute__((address_space(3))) bf16_t*)(KT + tx * 144 + s * 2));
        dn[((size_t)bh * 64 + c) * 128 + tx] = a;
    }
    {
        const int vb = wave >> 1, kh = wave & 1;
        f32x16 acc0, acc1;
#pragma unroll
        for (int r = 0; r < 16; ++r) { acc0[r] = 0.f; acc1[r] = 0.f; }
#pragma unroll
        for (int ks = 0; ks < 4; ++ks) {
            const bf16x8 a = *(const __attribute__((address_space(3))) bf16x8*)(VTw + (vb * 32 + r32) * 144 + ks * 32 + hi * 16);
            const bf16x8 b0 = *(const __attribute__((address_space(3))) bf16x8*)(KT + (kh * 64 + r32) * 144 + ks * 32 + hi * 16);
            const bf16x8 b1 = *(const __attribute__((address_space(3))) bf16x8*)(KT + (kh * 64 + 32 + r32) * 144 + ks * 32 + hi * 16);
            acc0 = MFMA32(a, b0, acc0); acc1 = MFMA32(a, b1, acc1);
        }
        bf16_t* o = dC + ((size_t)bh * 64 + c) * 16384;
#pragma unroll
        for (int r = 0; r < 16; ++r) { const int v = vb * 32 + crow(r, hi);
            o[v * 128 + kh * 64 + r32] = f2bf(acc0[r]); o[v * 128 + kh * 64 + 32 + r32] = f2bf(acc1[r]); }
    }
}
DI void ml_scan(int gtid, int nthreads, bf16_t* __restrict__ dC, float* __restrict__ dn, const float* __restrict__ wprev, const float* __restrict__ wsc) {
    for (int p = gtid; p < 16 * 8192; p += nthreads) {
        const int bh = p >> 13, e2 = p & 8191;
        unsigned* base = (unsigned*)(dC + (size_t)bh * 64 * 16384) + e2;
        float r0 = 0.f, r1 = 0.f;
#pragma unroll 1
        for (int c0 = 0; c0 < 64; c0 += 16) {
            unsigned v[16];
#pragma unroll
            for (int j = 0; j < 16; ++j) v[j] = base[(size_t)(c0 + j) * 8192];
#pragma unroll
            for (int j = 0; j < 16; ++j) {
                const float w = wprev[bh * 64 + c0 + j], sc = wsc[bh * 64 + c0 + j];
                base[(size_t)(c0 + j) * 8192] = pk2(r0, r1);
                r0 = w * r0 + sc * __uint_as_float(v[j] << 16); r1 = w * r1 + sc * __uint_as_float(v[j] & 0xffff0000u);
            }
        }
    }
    for (int p = gtid; p < 16 * 128; p += nthreads) {
        const int bh = p >> 7, k = p & 127; float r = 0.f; float* q = dn + (size_t)bh * 64 * 128 + k;
#pragma unroll 1
        for (int c0 = 0; c0 < 64; c0 += 16) {
            float v[16];
#pragma unroll
            for (int j = 0; j < 16; ++j) v[j] = q[(c0 + j) * 128];
#pragma unroll
            for (int j = 0; j < 16; ++j) { q[(c0 + j) * 128] = r; r = wprev[bh * 64 + c0 + j] * r + wsc[bh * 64 + c0 + j] * v[j]; }
        }
    }
}
DI void ml_unit_e(int bh, int c, int tx, lds_c* lds, const bf16_t* __restrict__ MQK, const bf16_t* __restrict__ MV, const bf16_t* __restrict__ MO, const float* __restrict__ ifp,
                  const float* __restrict__ wc, const float* __restrict__ bc, const bf16_t* __restrict__ Sst, const float* __restrict__ nst, const float* __restrict__ mtab, const float* __restrict__ g_hn, bf16_t* __restrict__ Y) {
    const int b = bh >> 2, h = bh & 3, lane = tx & 63, r32 = lane & 31, hi = lane >> 5, wave = __builtin_amdgcn_readfirstlane(tx >> 6);
    lds_c* Qi = lds; lds_c* Ki = lds + 64 * 272; lds_c* VTi = lds + 2 * 64 * 272; lds_c* Si = VTi + 128 * 136;
    __attribute__((address_space(3))) float* fsm = (__attribute__((address_space(3))) float*)(Si + 128 * 272);
    const size_t tok0 = (size_t)b * SEQ + 64 * c;
    const float m_c = mtab[bh * 65 + c];
    __syncthreads();
    if (wave == 0) {
        const float iv = ifp[(tok0 + lane) * 8 + h], lf = log_sigmoid_(ifp[(tok0 + lane) * 8 + 4 + h]);
        const int l_ = lane_id_opaque();
        const float bc_ = lane_shr_add(lf, l_), u = iv - bc_, M = fmaxf(lane_shr_max(u, l_), m_c);
        fsm[lane] = u; fsm[64 + lane] = M; fsm[128 + lane] = __expf(-(bc_ + M));
    }
    if (wave == 1) { fsm[192 + lane] = nst[((size_t)bh * 64 + c) * 128 + lane]; fsm[192 + 64 + lane] = nst[((size_t)bh * 64 + c) * 128 + 64 + lane]; }
#pragma unroll 1
    for (int it = tx; it < 1024; it += 512) {
        const int s = it >> 4, d0 = (it & 15) * 8; float qv[8], kv[8];
        ml_conv8(qv, MQK, tok0 + s, 64 * c + s, h * 128 + d0, wc, bc, 1.f);
        ml_conv8(kv, MQK, tok0 + s, 64 * c + s, 512 + h * 128 + d0, wc, bc, ML_KSCALE);
        *(__attribute__((address_space(3))) pg8::u32x4*)(Qi + s * 272 + d0 * 2) = pack8(qv);
        *(__attribute__((address_space(3))) pg8::u32x4*)(Ki + s * 272 + d0 * 2) = pack8(kv);
        const pg8::u32x4 vw = *(const pg8::u32x4*)(MV + (tok0 + s) * 512 + h * 128 + d0);
        __attribute__((address_space(3))) bf16_t* vt = (__attribute__((address_space(3))) bf16_t*)(VTi + d0 * 136 + s * 2);
        vt[0] = (bf16_t)(vw.x & 0xffffu); vt[68] = (bf16_t)(vw.x >> 16); vt[136] = (bf16_t)(vw.y & 0xffffu); vt[204] = (bf16_t)(vw.y >> 16);
        vt[272] = (bf16_t)(vw.z & 0xffffu); vt[340] = (bf16_t)(vw.z >> 16); vt[408] = (bf16_t)(vw.w & 0xffffu); vt[476] = (bf16_t)(vw.w >> 16);
    }
    {
        const bf16_t* src = Sst + ((size_t)bh * 64 + c) * 16384;
#pragma unroll
        for (int j = 0; j < 4; ++j) { const int ch = tx + 512 * j, v = ch >> 4, k8 = (ch & 15) * 8;
            *(__attribute__((address_space(3))) pg8::u32x4*)(Si + v * 272 + k8 * 2) = *(const pg8::u32x4*)(src + v * 128 + k8); }
    }
    __syncthreads();
    const int tb = wave & 1, vb = wave >> 1, t = tb * 32 + r32;
    bf16x8 qf[8];
#pragma unroll
    for (int ks = 0; ks < 8; ++ks) qf[ks] = *(const __attribute__((address_space(3))) bf16x8*)(Qi + t * 272 + ks * 32 + hi * 16);
    f32x16 a0, a1;
#pragma unroll
    for (int r = 0; r < 16; ++r) { a0[r] = 0.f; a1[r] = 0.f; }
#pragma unroll
    for (int ks = 0; ks < 8; ++ks) {
        const bf16x8 k0 = *(const __attribute__((address_space(3))) bf16x8*)(Ki + r32 * 272 + ks * 32 + hi * 16);
        const bf16x8 k1 = *(const __attribute__((address_space(3))) bf16x8*)(Ki + (32 + r32) * 272 + ks * 32 + hi * 16);
        a0 = MFMA32(k0, qf[ks], a0); a1 = MFMA32(k1, qf[ks], a1);
    }
    const float Mt = fsm[64 + t], dec = __expf(m_c - Mt);
    float rs = 0.f;
#pragma unroll
    for (int r = 0; r < 16; ++r) {
        const int s0 = crow(r, hi), s1 = 32 + s0;
        a0[r] = s0 <= t ? __expf(fsm[s0] - Mt) * a0[r] : 0.f; a1[r] = s1 <= t ? __expf(fsm[s1] - Mt) * a1[r] : 0.f;
        rs += a0[r] + a1[r];
    }
    float nq = 0.f;
#pragma unroll
    for (int ks = 0; ks < 8; ++ks) { float qv[8]; unpack8(__builtin_bit_cast(pg8::u32x4, qf[ks]), qv);
#pragma unroll
        for (int j = 0; j < 8; ++j) nq += qv[j] * fsm[192 + ks * 16 + hi * 8 + j]; }
    float den = rs + dec * nq;
    { auto rr = __builtin_amdgcn_permlane32_swap(__float_as_uint(den), __float_as_uint(den), false, false); den = __uint_as_float(rr[0]) + __uint_as_float(rr[1]); }
    f32x16 n1, n2;
#pragma unroll
    for (int r = 0; r < 16; ++r) { n1[r] = 0.f; n2[r] = 0.f; }
#pragma unroll
    for (int hf = 0; hf < 2; ++hf)
#pragma unroll
        for (int ss = 0; ss < 2; ++ss) {
            unsigned pw[4];
#pragma unroll
            for (int j = 0; j < 4; ++j) pw[j] = hf ? cvtpk(a1[8 * ss + 2 * j], a1[8 * ss + 2 * j + 1]) : cvtpk(a0[8 * ss + 2 * j], a0[8 * ss + 2 * j + 1]);
            const u32x4v pbw = {pw[0], pw[1], pw[2], pw[3]};
            const lds_c* vp = VTi + (vb * 32 + r32) * 136 + hf * 64 + ss * 32 + hi * 8;
            const u32x2v lo = *(const __attribute__((address_space(3))) u32x2v*)vp, hi2 = *(const __attribute__((address_space(3))) u32x2v*)(vp + 16);
            const u32x4v aw = {lo.x, lo.y, hi2.x, hi2.y};
            n1 = MFMA32(__builtin_bit_cast(bf16x8, aw), __builtin_bit_cast(bf16x8, pbw), n1);
        }
#pragma unroll
    for (int ks = 0; ks < 8; ++ks) {
        const bf16x8 sa = *(const __attribute__((address_space(3))) bf16x8*)(Si + (vb * 32 + r32) * 272 + ks * 32 + hi * 16);
        n2 = MFMA32(sa, qf[ks], n2);
    }
    const float inv = 1.f / fmaxf(fabsf(den), fsm[128 + t]);
    const bf16_t* op = MO + (tok0 + t) * 512 + h * 128 + vb * 32;
    float hv[16]; float ssq = 0.f;
#pragma unroll
    for (int i = 0; i < 4; ++i) {
        const u32x2v ow = *(const u32x2v*)(op + 8 * i + 4 * hi);
        const float o4[4] = {__uint_as_float(ow.x << 16), __uint_as_float(ow.x & 0xffff0000u), __uint_as_float(ow.y << 16), __uint_as_float(ow.y & 0xffff0000u)};
#pragma unroll
        for (int j = 0; j < 4; ++j) { const float x = (n1[4 * i + j] + dec * n2[4 * i + j]) * inv * sigmoidf_(o4[j]); hv[4 * i + j] = x; ssq += x * x; }
    }
    { auto rr = __builtin_amdgcn_permlane32_swap(__float_as_uint(ssq), __float_as_uint(ssq), false, false); ssq = __uint_as_float(rr[0]) + __uint_as_float(rr[1]); }
    if (hi == 0) fsm[320 + t * 4 + vb] = ssq;
    __syncthreads();
    const float tot = (fsm[320 + t * 4] + fsm[320 + t * 4 + 1]) + (fsm[320 + t * 4 + 2] + fsm[320 + t * 4 + 3]);
    const float rstd = rsqrtf(tot * (1.f / 128.f) + 1e-6f);
    bf16_t* yp = Y + (tok0 + t) * DM + 512 + h * 128 + vb * 32; const float* gp = g_hn + h * 128 + vb * 32;
#pragma unroll
    for (int i = 0; i < 4; ++i) {
        const float4 gg = *(const float4*)(gp + 8 * i + 4 * hi);
        *(u32x2v*)(yp + 8 * i + 4 * hi) = (u32x2v){cvtpk(hv[4 * i] * rstd * gg.x, hv[4 * i + 1] * rstd * gg.y), cvtpk(hv[4 * i + 2] * rstd * gg.z, hv[4 * i + 3] * rstd * gg.w)};
    }
}

DI void cmp_unit(int kv, int bg, int jt, int tx, lds_c* lds, const bf16_t* __restrict__ KVb, const bf16_t* __restrict__ W1t, const bf16_t* __restrict__ W2t, const float* __restrict__ bias1p,
                 float* __restrict__ outf, bf16_t* __restrict__ kcb, bf16_t* __restrict__ vcT) {
    const int b = bg >> 1, g = bg & 1, lane = tx & 63, r32 = lane & 31, hi = lane >> 5, wave = __builtin_amdgcn_readfirstlane(tx >> 6), j0 = jt * 32;
    lds_c* TI = lds; lds_c* H1 = lds + 16 * 34 * 144;
    const bf16_t* src = KVb + ((size_t)b * SEQ + 16 * j0) * 512 + (kv ? 128 : 0) + g * 64;
    __syncthreads();
    for (int ch = tx; ch < 528 * 8; ch += 512) {
        const int t = ch >> 3, c8 = ch & 7;
        *(__attribute__((address_space(3))) pg8::u32x4*)(TI + ((t & 15) * 34 + (t >> 4)) * 144 + c8 * 16) = *(const pg8::u32x4*)(src + (size_t)t * 512 + c8 * 8);
    }
    __syncthreads();
    f32x16 acc;
#pragma unroll
    for (int r = 0; r < 16; ++r) acc[r] = 0.f;
    const bf16_t* wrow = W1t + (size_t)(wave * 32 + r32) * 2048 + hi * 8;
#pragma unroll 4
    for (int i = 0; i < 32; ++i) {
        const lds_c* arow = TI + ((i & 15) * 34 + r32 + (i >> 4)) * 144 + hi * 16;
#pragma unroll
        for (int dk = 0; dk < 4; ++dk) {
            const bf16x8 a = *(const __attribute__((address_space(3))) bf16x8*)(arow + dk * 32);
            const bf16x8 bfr = *(const bf16x8*)(wrow + i * 64 + dk * 16);
            acc = MFMA32(a, bfr, acc);
        }
    }
    {
        const int n = wave * 32 + r32; const float bias = bias1p[kv * 256 + n];
#pragma unroll
        for (int r = 0; r < 16; ++r) *(__attribute__((address_space(3))) bf16_t*)(H1 + crow(r, hi) * 528 + n * 2) = f2bf(gelu_tanh(acc[r] + bias));
    }
    __syncthreads();
    if (wave < 2) {
        f32x16 o;
#pragma unroll
        for (int r = 0; r < 16; ++r) o[r] = 0.f;
        const bf16_t* w2row = W2t + (size_t)(wave * 32 + r32) * 256 + hi * 8;
#pragma unroll
        for (int ks = 0; ks < 16; ++ks) {
            const bf16x8 a = *(const __attribute__((address_space(3))) bf16x8*)(H1 + r32 * 528 + ks * 32 + hi * 16);
            const bf16x8 bfr = *(const bf16x8*)(w2row + ks * 16);
            o = MFMA32(a, bfr, o);
        }
        const int d = wave * 32 + r32;
#pragma unroll
        for (int r = 0; r < 16; ++r) {
            const int j = j0 + crow(r, hi); const float v = j < 255 ? o[r] : 0.f;
            outf[((size_t)bg * 256 + j) * 64 + d] = v;
            if (kv == 0) kcb[((size_t)bg * 256 + j) * 64 + d] = f2bf(v);
            else vcT[((size_t)bg * 4 + (j >> 6)) * 4096 + d * 64 + (j & 63)] = f2bf(v);
        }
    }
}

#define XB_TMO      128
#define XB_XCNT(j)  (256  + 64 * (j))
#define XB_XSUB(j)  (1280 + 64 * (j))
#define XB_XGEN(j)  (2304 + 64 * (j))
#define XB_TOP      3328
#define XB_TOPGEN   3392
#define XCD_BAR_WORDS 3456
#define XB_SPIN_CAP (1u << 23)

__device__ __forceinline__ unsigned xb_ld(unsigned* p)              { return __hip_atomic_load(p, __ATOMIC_RELAXED, __HIP_MEMORY_SCOPE_AGENT); }
__device__ __forceinline__ unsigned xb_add(unsigned* p, unsigned v) { return __hip_atomic_fetch_add(p, v, __ATOMIC_RELAXED, __HIP_MEMORY_SCOPE_AGENT); }
__device__ __forceinline__ unsigned xb_xcc_id() { return (unsigned)__builtin_amdgcn_s_getreg((3 << 11) | 20) & 0xFu; }
#define XB_SPIN(cond, bar) do { unsigned _sp = 0; while (cond) { __builtin_amdgcn_s_sleep(1); \
    if ((++_sp & 255u) == 0u) { if (xb_ld(&(bar)[XB_TMO])) break; if (_sp > XB_SPIN_CAP) { atomicAdd(&(bar)[XB_TMO], 1u); break; } } } } while (0)

struct XcdBarrier {
    unsigned* bar; unsigned x;
    volatile __attribute__((address_space(3))) unsigned* st;
};

__device__ __forceinline__ XcdBarrier xcd_barrier_post(unsigned* bar, volatile __attribute__((address_space(3))) unsigned* st) {
    XcdBarrier b; b.bar = bar; b.x = xb_xcc_id(); b.st = st;
    if (threadIdx.x == 0) (void)xb_add(&bar[XB_XCNT(b.x)], 1u);
    return b;
}
__device__ __forceinline__ void xcd_barrier_complete(unsigned* bar, unsigned x, unsigned& nloc, unsigned& nx) {
    const unsigned G = gridDim.x * gridDim.y * gridDim.z;
    unsigned sum, cnt, mine, sp = 0u;
    for (;;) {
        sum = 0u; cnt = 0u; mine = 0u;
#pragma unroll
        for (unsigned j = 0; j < 16; ++j) { const unsigned c = xb_ld(&bar[XB_XCNT(j)]); sum += c; cnt += (c > 0u) ? 1u : 0u; mine = (j == x) ? c : mine; }
        if (sum == G) break;
        __builtin_amdgcn_s_sleep(1);
        if ((++sp & 255u) == 0u) { if (xb_ld(&bar[XB_TMO])) break; if (sp > XB_SPIN_CAP) { atomicAdd(&bar[XB_TMO], 1u); break; } }
    }
    nloc = mine > 0u ? mine : 1u; nx = cnt > 0u ? cnt : 1u;
}

__device__ __forceinline__ void xcd_barrier(const XcdBarrier& b) {
    asm volatile("s_waitcnt vmcnt(0)" ::: "memory");
    __syncthreads();
    if (threadIdx.x == 0) {
        unsigned* bar = b.bar;
        __builtin_amdgcn_s_waitcnt(0);
        unsigned nloc = b.st[0], nx = b.st[1];
        if (nloc == 0u) { xcd_barrier_complete(bar, b.x, nloc, nx); b.st[0] = nloc; b.st[1] = nx; }
        const unsigned old = xb_add(&bar[XB_XSUB(b.x)], 1u);
        const unsigned gen = old / nloc;
        if (old + 1u == (gen + 1u) * nloc) {
            __builtin_amdgcn_fence(__ATOMIC_RELEASE, "agent");
            asm volatile("s_waitcnt vmcnt(0)" ::: "memory");
            const unsigned og = xb_add(&bar[XB_TOP], 1u);
            const unsigned tg = og / nx;
            if (og + 1u == (tg + 1u) * nx) xb_add(&bar[XB_TOPGEN], 1u);
            else XB_SPIN(xb_ld(&bar[XB_TOPGEN]) == tg, bar);
            __builtin_amdgcn_fence(__ATOMIC_ACQUIRE, "agent");
            xb_add(&bar[XB_XGEN(b.x)], 1u);
            asm volatile("s_waitcnt vmcnt(0)" ::: "memory");
        } else {
            XB_SPIN(xb_ld(&bar[XB_XGEN(b.x)]) == gen, bar);
            __builtin_amdgcn_fence(__ATOMIC_ACQUIRE, "agent");
            asm volatile("s_waitcnt vmcnt(0)" ::: "memory");
        }
    }
    __syncthreads();
}

#ifndef NSA_CHECK
#define NSA_CHECK 0
#endif
#ifndef REP_MASK
#define REP_MASK 0u
#endif
struct Args { const float* in[29]; float* out; char* ws; unsigned rep_mask; unsigned pad; };
constexpr int LDS_BYTES = 147456;

__global__ __launch_bounds__(512, 2) void mk_fwd(Args a) {
    extern __shared__ __attribute__((aligned(16))) char lds_raw[];
    cg::grid_group grid = cg::this_grid();
    const int NB = gridDim.x * 2, NGW = gridDim.x * 8;
    const unsigned repm = a.rep_mask;
    volatile __attribute__((address_space(3))) unsigned* bar_st = (volatile __attribute__((address_space(3))) unsigned*)((lds_c*)lds_raw + (LDS_BYTES - 64));
    if (threadIdx.x < 2) bar_st[threadIdx.x] = 0u;
    __syncthreads();
    const XcdBarrier xbar = xcd_barrier_post((unsigned*)(a.ws + ((size_t)42 << 20) + 65536), bar_st);
#define GRID_BAR() xcd_barrier(xbar)
#ifndef SPIN_PHASE_UNUSED_
#endif
    unsigned long long ts_prev_ = 0ull, ts_probe_ = 0ull; int n_stamp_ = 0;
#define STAMP() do { if (SPIN_PHASE >= 0 && blockIdx.x == 0) { const unsigned long long now_ = __builtin_amdgcn_s_memrealtime(); if (n_stamp_ == SPIN_PHASE) ts_probe_ = now_ - ts_prev_; ts_prev_ = now_; ++n_stamp_; } } while (0)
    if (SPIN_PHASE >= 0 && blockIdx.x == 0) ts_prev_ = __builtin_amdgcn_s_memrealtime();
    const int wave_s_ = __builtin_amdgcn_readfirstlane(threadIdx.x >> 6);
#define KARG(T, off) (*(T const __attribute__((address_space(4)))*)(kargs_ + (off)))
#define PTRS const float* x = KARG(const float*, 8 * 0); const float* p = KARG(const float*, 8 * 1); const int* pos = KARG(const int*, 16); \
    const float* g_mix = KARG(const float*, 8 * 3); const float* w_in = KARG(const float*, 8 * 4); const float* b_if = KARG(const float*, 8 * 5); \
    const float* w_ck1 = KARG(const float*, 8 * 6); const float* w_ck2 = KARG(const float*, 8 * 7); const float* pe_ck = KARG(const float*, 8 * 8); \
    const float* w_cv1 = KARG(const float*, 8 * 9); const float* w_cv2 = KARG(const float*, 8 * 10); const float* pe_cv = KARG(const float*, 8 * 11); \
    const float* w_conv = KARG(const float*, 8 * 12); const float* b_conv = KARG(const float*, 8 * 13); const float* g_hn = KARG(const float*, 8 * 14); \
    const float* w_pa = KARG(const float*, 8 * 15); const float* w_pb = KARG(const float*, 8 * 16); const float* w_out = KARG(const float*, 8 * 17); \
    const float* g_ffn = KARG(const float*, 8 * 18); const float* w_rg = KARG(const float*, 8 * 19); const float* b_rg = KARG(const float*, 8 * 20); \
    const float* w_re = KARG(const float*, 8 * 21); const float* b_re = KARG(const float*, 8 * 22); const float* w_e13 = KARG(const float*, 8 * 23); \
    const float* w_e2 = KARG(const float*, 8 * 24); const float* g_ple = KARG(const float*, 8 * 25); const float* w_pg = KARG(const float*, 8 * 26); \
    const float* w_pp = KARG(const float*, 8 * 27); const float* g_final = KARG(const float*, 8 * 28); \
    float* out = KARG(float*, 232); char* ws = KARG(char*, 240); \
    const size_t MiB = 1u << 20; \
    bf16_t* Wt_in = (bf16_t*)(ws); \
    bf16_t* xb = (bf16_t*)(ws + 48 * MiB); \
    bf16_t* Qb = (bf16_t*)(ws + 80 * MiB); \
    bf16_t* KVb = (bf16_t*)(ws + 96 * MiB); bf16_t* VT = (bf16_t*)(ws + 112 * MiB); bf16_t* kcb = (bf16_t*)(ws + 249 * MiB + 512 * 1024); bf16_t* vcT = (bf16_t*)(ws + 249 * MiB + 768 * 1024); \
    bf16_t* MQK = (bf16_t*)(ws + 120 * MiB); \
    bf16_t* MV = (bf16_t*)(ws + 152 * MiB); \
    bf16_t* MO = (bf16_t*)(ws + 168 * MiB); \
    bf16_t* MG = (bf16_t*)(ws + 184 * MiB); \
    float* gates = (float*)(ws + 248 * MiB); \
    float* ifp = (float*)(ws + 250 * MiB); \
    float* kcc = (float*)(ws + 251 * MiB); \
    float* vcc = (float*)(ws + 252 * MiB); \
    float* gate16 = (float*)(ws + 253 * MiB); \
    float* rstd0 = (float*)(ws + 254 * MiB); \
    float* cosT = (float*)(ws + 254 * MiB + 512 * 1024); \
    float* sinT = (float*)(ws + 255 * MiB); \
    bf16_t* Y = (bf16_t*)(out + (size_t)8 * 1024 * 1024); \
    bf16_t* dC = xb; float* dn = (float*)(ws + 250 * MiB + 512 * 1024); float* wprev = (float*)(ws + 42 * MiB + 4096); float* mtab = (float*)(ws + 42 * MiB + 8192); float* wsc = (float*)(ws + 42 * MiB + 16384); \
    float* tmp = (float*)(ws + 120 * MiB); bf16_t* mixed = xb; \
    bf16_t* Wpa_t = (bf16_t*)(ws + 11 * MiB); bf16_t* Wpb_t = (bf16_t*)(ws + 12 * MiB); bf16_t* Wout_t = (bf16_t*)(ws + 13 * MiB); \
    bf16_t* We13_t = (bf16_t*)(ws + 15 * MiB); bf16_t* We2_t = (bf16_t*)(ws + 31 * MiB); bf16_t* Wpg_t = (bf16_t*)(ws + 39 * MiB); bf16_t* Wpp_t = (bf16_t*)(ws + 41 * MiB); \
    int* cnt = (int*)(ws + 42 * MiB); bf16_t* W1t_k = (bf16_t*)(ws + 43 * MiB); bf16_t* W1t_v = (bf16_t*)(ws + 44 * MiB); bf16_t* W2t_k = (bf16_t*)(ws + 45 * MiB); bf16_t* W2t_v = (bf16_t*)(ws + 45 * MiB + 65536); float* bias1p = (float*)(ws + 45 * MiB + 524288); \
    bf16_t* x1b = (bf16_t*)(ws + 48 * MiB); bf16_t* act = (bf16_t*)(ws + 120 * MiB); bf16_t* y2 = (bf16_t*)(ws + 138 * MiB); bf16_t* x2b = (bf16_t*)(ws + 210 * MiB); int* elist = (int*)(ws + 242 * MiB); \
    bf16_t* pb = (bf16_t*)(ws + 80 * MiB); bf16_t* PP = (bf16_t*)(ws + 88 * MiB); \
    int* rinfo = (int*)(ws + 253 * MiB); float* rstd1 = (float*)(ws + 253 * MiB + 512 * 1024); float* rstd2 = (float*)(ws + 253 * MiB + 768 * 1024); \
    (void)x; (void)p; (void)pos; (void)g_mix; (void)w_in; (void)b_if; (void)w_ck1; (void)w_ck2; (void)pe_ck; (void)w_cv1; (void)w_cv2; (void)pe_cv; (void)w_conv; (void)b_conv; (void)g_hn; (void)w_pa; (void)w_pb; (void)w_out; (void)g_ffn; (void)w_rg; (void)b_rg; (void)w_re; (void)b_re; (void)w_e13; (void)w_e2; (void)g_ple; (void)w_pg; (void)w_pp; (void)g_final;
#define PHASE(k) for (int rep_ = 0; rep_ < 1 + (int)((repm >> (k)) & 1u); ++rep_)
#define PHASE_IDS unsigned tx_ = (unsigned)(wave_s_ * 64); asm volatile("" : "+v"(tx_)); tx_ = (unsigned)__builtin_amdgcn_mbcnt_hi(-1, __builtin_amdgcn_mbcnt_lo(-1, (int)tx_)); const int half = tx_ >> 8, tid = tx_ & 255, lane64 = tx_ & 63, tid512 = (int)tx_; \
    const int wave = __builtin_amdgcn_readfirstlane(tx_ >> 6); char* sm = lds_raw + half * 65536; const int gw = blockIdx.x * 8 + wave; (void)tid; (void)lane64; (void)sm; (void)gw; (void)tid512; \
    const __attribute__((address_space(4))) char* kargs_ = (const __attribute__((address_space(4))) char*)__builtin_amdgcn_kernarg_segment_ptr(); asm volatile("" : "+s"(kargs_)); PTRS
#define VB_LOOP(nvb) for (int vb = blockIdx.x * 2 + half; vb < (nvb); vb += NB)
#define GEMM_PHASE(NT, MT, ...) do { VB_LOOP((NT) * (MT)) { const int bx_ = vb % (NT), by_ = vb / (NT); __syncthreads(); gemm_v1(bx_, by_, tid, sm, __VA_ARGS__); } } while (0)
    PHASE(0) { PHASE_IDS
        float* scr = (float*)(lds_raw + wave * 8448);
        for (int it = gw; it < (DM / 64) * (NIN / 32); it += NGW) prep_wt_item(w_in, DIN, DM, Wt_in, g_mix, MapIn{}, scr, it, NIN / 32, lane64);
        for (int it = gw; it < 2 * 256; it += NGW) { const int kv = it >> 8; prep_wt_item(kv ? w_cv1 : w_ck1, 256, 2048, kv ? W1t_v : W1t_k, (const float*)nullptr, MapId{}, scr, it & 255, 8, lane64); }
        for (int it = gw; it < 2 * 8; it += NGW) { const int kv = it >> 3; prep_wt_item(kv ? w_cv2 : w_ck2, 64, 256, kv ? W2t_v : W2t_k, (const float*)nullptr, MapId{}, scr, it & 7, 2, lane64); }
        if (gw < 512) {
            const int kv = gw >> 8, n = gw & 255; const float* w1 = kv ? w_cv1 : w_ck1; const float* pe = kv ? pe_cv : pe_ck; float a = 0.f;
#pragma unroll
            for (int i = 0; i < 32; ++i) { const int k = lane64 + 64 * i; a += pe[k] * w1[(size_t)k * 256 + n]; }
            a = wave_sum(a);
            if (lane64 == 0) bias1p[gw] = a;
        }
        if (blockIdx.x == 0 && tid512 < 16) cnt[tid512 * CNT_STRIDE] = 0;
        for (int r = gw; r < T_TOK; r += NGW) prep_x_row(x, xb, rstd0, r, lane64);
        for (int i = blockIdx.x * 512 + tid512; i < T_TOK * 8; i += gridDim.x * 512) {
            const float inv = powf(500000.0f, -(float)(2 * (i & 7)) / 16.0f); float sn, cs; sincosf((float)pos[i >> 3] * inv, &sn, &cs); cosT[i] = cs; sinT[i] = sn; }
    }
    if (repm == 0x80000000u) grid.sync();
    GRID_BAR(); STAMP();
#ifdef PROBE_VAR
    {   PHASE_IDS
        pg8::Gemm g{xb, Wt_in, T_TOK, NIN, DM, DM, DM}; pg8::StaticOrder S; S.init(T_TOK, NIN, (int)gridDim.x, (int)blockIdx.x);
        EpiInProjT<PROBE_VAR> E{rstd0, cosT, sinT, b_if, Qb, KVb, gates, ifp, MQK, MV, MO, MG, VT};
        pg8::gemm_phase<EpiInProjT<PROBE_VAR>, pg8::StaticOrder, true, true>((PG8_LAS unsigned char*)lds_raw, g, S, E, tid512, &ts_probe_);
    }
    GRID_BAR();
#endif
    PHASE(1) { PHASE_IDS
        pg8::Gemm g{xb, Wt_in, T_TOK, NIN, DM, DM, DM}; pg8::StaticOrder S; S.init(T_TOK, NIN, (int)gridDim.x, (int)blockIdx.x);
        EpiInProj E{rstd0, cosT, sinT, b_if, Qb, KVb, gates, ifp, MQK, MV, MO, MG, VT};
        #ifdef PROBE_VAR
        pg8::gemm_phase<EpiInProj, pg8::StaticOrder, true, true>((PG8_LAS unsigned char*)lds_raw, g, S, E, tid512);
#else
        pg8::gemm_phase<EpiInProj, pg8::StaticOrder, true, true>((PG8_LAS unsigned char*)lds_raw, g, S, E, tid512, &ts_probe_);
#endif
    }
    {   PHASE_IDS
        const int G_ = (int)gridDim.x, nfull_ = (64 * (NIN / 256)) % G_;
        const int nl_ = G_ - nfull_, lw_ = (int)blockIdx.x - nfull_;
        if (nfull_ == 0 || lw_ >= 0) {
            const int lgw = (nfull_ == 0 ? (int)blockIdx.x : lw_) * 8 + wave, LNGW = (nfull_ == 0 ? G_ : nl_) * 8;
            float* scr = (float*)(lds_raw + wave * 8448); float* scr2 = (float*)(lds_raw + wave * 16896); (void)scr;
            __syncthreads();
            for (int it = lgw; it < 16 * 128; it += LNGW) { const int e = it >> 7, i2 = (it & 127) * 2; const float* w_ = w_e13 + (size_t)e * 1024 * 512; bf16_t* t_ = We13_t + (size_t)e * 512 * 1024;
                prep_wt_item2(w_, w_, 512, DM, t_, t_, g_ffn, MapE13{}, scr2, i2, i2 + 1, 16, lane64); }
            if ((int)gridDim.x != 256) {
                for (int it = lgw; it < 8 * 32; it += LNGW) prep_wt_item(w_pa, DM, DM, Wpa_t, (const float*)nullptr, MapId{}, scr, it, 32, lane64);
                for (int it = lgw; it < 8 * 32; it += LNGW) prep_wt_item(w_pb, DM, DM, Wpa_t + 512, (const float*)nullptr, MapId{}, scr, it, 32, lane64);
                for (int it = lgw; it < 16 * 32; it += LNGW) prep_wt_item(w_out, DM, DM, Wout_t, (const float*)nullptr, MapId{}, scr, it, 32, lane64);
                for (int it = lgw; it < 16 * 32; it += LNGW) prep_wt_item(w_pg, DM, DM, Wpg_t, g_ple, MapId{}, scr, it, 32, lane64);
                for (int it = lgw; it < 4 * 32; it += LNGW) prep_wt_item(w_pp, DM, 256, Wpp_t, (const float*)nullptr, MapId{}, scr, it, 32, lane64);
                for (int it = lgw; it < 16 * 64; it += LNGW) { const int e = it >> 6, i2 = (it & 63) * 2; const float* w_ = w_e2 + (size_t)e * 256 * 1024; bf16_t* t_ = We2_t + (size_t)e * 1024 * 256;
                prep_wt_item2(w_, w_, DM, 256, t_, t_, (const float*)nullptr, MapId{}, scr2, i2, i2 + 1, 32, lane64); }
            }
        }
    }
    GRID_BAR(); STAMP();
    PHASE(2) { PHASE_IDS
        for (int u = blockIdx.x; u < 128; u += gridDim.x) { const int kv = u >> 6, bg = (u >> 3) & 7, jt = u & 7;
            cmp_unit(kv, bg, jt, tid512, (lds_c*)lds_raw, KVb, kv ? W1t_v : W1t_k, kv ? W2t_v : W2t_k, bias1p, kv ? vcc : kcc, kcb, vcT); }
        { const int v_ = (int)blockIdx.x - 128; if (v_ >= 0 && v_ < 16 && wave == 0) ml_mscan_all(ifp, v_, lane64, mtab, wprev, wsc); }
    }
    PHASE(3) { PHASE_IDS
        { const int G_ = (int)gridDim.x, c_ = (int)blockIdx.x;
          if (G_ == 256) { const int n_ = c_ < 128 ? 3 : 5, first_ = c_ < 128 ? 3 * c_ : 384 + 5 * (c_ - 128);
              for (int u = first_; u < first_ + n_; ++u) ml_unit_c(u >> 6, u & 63, tid512, (lds_c*)lds_raw, MQK, MV, ifp, w_conv, b_conv, dC, dn, wprev, mtab); }
          else for (int u = c_; u < 1024; u += G_) ml_unit_c(u >> 6, u & 63, tid512, (lds_c*)lds_raw, MQK, MV, ifp, w_conv, b_conv, dC, dn, wprev, mtab); }
        if ((int)gridDim.x == 256 && (int)blockIdx.x >= 128) {
            const int lgw = ((int)blockIdx.x - 128) * 8 + wave, LNGW = 128 * 8; float* scr = (float*)(lds_raw + wave * 16896); float* scr2 = scr;
            __syncthreads();
            for (int it = lgw; it < 8 * 32; it += LNGW) prep_wt_item(w_pa, DM, DM, Wpa_t, (const float*)nullptr, MapId{}, scr, it, 32, lane64);
            for (int it = lgw; it < 8 * 32; it += LNGW) prep_wt_item(w_pb, DM, DM, Wpa_t + 512, (const float*)nullptr, MapId{}, scr, it, 32, lane64);
            for (int it = lgw; it < 16 * 32; it += LNGW) prep_wt_item(w_out, DM, DM, Wout_t, (const float*)nullptr, MapId{}, scr, it, 32, lane64);
            for (int it = lgw; it < 16 * 32; it += LNGW) prep_wt_item(w_pg, DM, DM, Wpg_t, g_ple, MapId{}, scr, it, 32, lane64);
            for (int it = lgw; it < 4 * 32; it += LNGW) prep_wt_item(w_pp, DM, 256, Wpp_t, (const float*)nullptr, MapId{}, scr, it, 32, lane64);
            for (int it = lgw; it < 16 * 64; it += LNGW) { const int e = it >> 6, i2 = (it & 63) * 2; const float* w_ = w_e2 + (size_t)e * 256 * 1024; bf16_t* t_ = We2_t + (size_t)e * 1024 * 256;
                prep_wt_item2(w_, w_, DM, 256, t_, t_, (const float*)nullptr, MapId{}, scr2, i2, i2 + 1, 32, lane64); }
        }
    }
    GRID_BAR(); STAMP();
    {   PHASE_IDS
        ml_scan(blockIdx.x * 512 + tid512, gridDim.x * 512, dC, dn, wprev, wsc);
    }
    GRID_BAR(); STAMP();
    PHASE(4) { PHASE_IDS
        for (int u = blockIdx.x; u < 1024; u += gridDim.x) ml_unit_e(u >> 6, u & 63, tid512, (lds_c*)lds_raw, MQK, MV, MO, ifp, w_conv, b_conv, dC, dn, mtab, g_hn, Y);
    }
    PHASE(5) { PHASE_IDS
        for (int pr = blockIdx.x; pr < 256; pr += gridDim.x) {
            nsa_unit(pr & 7, 63 - (pr >> 3), tid512, (lds_c*)lds_raw, Qb, KVb, VT, kcb, vcT, gates, Y, ts_probe_);
            nsa_unit(pr & 7, pr >> 3, tid512, (lds_c*)lds_raw, Qb, KVb, VT, kcb, vcT, gates, Y, ts_probe_);
        }
    }
#if NSA_CHECK
    {   PHASE_IDS
        bf16_t* Y2 = (bf16_t*)(ws + 120 * MiB); unsigned* stats = (unsigned*)(ws + 42 * MiB + 32768);
        if (blockIdx.x == 0 && tid512 == 0) { stats[0] = 0u; stats[1] = 0u; }
        grid.sync();
        float* kcc2 = (float*)(ws + 251 * MiB + 512 * 1024); float* vcc2 = (float*)(ws + 252 * MiB + 512 * 1024); bf16_t* dummy = (bf16_t*)(ws + 160 * MiB);
        VB_LOOP(4080) { const int j = vb % 255, r = vb / 255; compress_naive(j, r & 7, r >> 3, tid, sm, KVb, w_ck1, w_ck2, pe_ck, w_cv1, w_cv2, pe_cv, kcc2, vcc2, dummy, dummy + 1048576); }
        grid.sync();
        VB_LOOP(T_TOK * 2) nsa_naive(vb >> 1, vb & 1, tid, sm, Qb, KVb, VT, kcc2, vcc2, gates, Y2);
        grid.sync();
        unsigned c1 = 0, c2 = 0;
        for (size_t i = (size_t)blockIdx.x * 512 + tid512; i < (size_t)T_TOK * 512; i += (size_t)gridDim.x * 512) {
            const size_t o = (i >> 9) * DM + (i & 511); const float d = fabsf(bf2f(Y[o]) - bf2f(Y2[o])); c1 += d > 0.02f ? 1u : 0u; c2 += (d > 0.1f || !(d == d)) ? 1u : 0u; }
        if (c1) atomicAdd(stats, c1); if (c2) atomicAdd(stats + 1, c2);
    }
#endif
    GRID_BAR(); STAMP();
    PHASE(7) { PHASE_IDS
        pg8::StaticOrder S; S.init(T_TOK, DM, (int)gridDim.x, (int)blockIdx.x);
        pg8::Gemm g{Y, Wpa_t, T_TOK, DM, DM, DM, DM}; EpiMerge2 E{MG, mixed}; pg8::gemm_phase<EpiMerge2, pg8::StaticOrder, true, true>((PG8_LAS unsigned char*)lds_raw, g, S, E, tid512);
    }
    GRID_BAR(); STAMP();
    PHASE(9) { PHASE_IDS
        pg8::Gemm g{mixed, Wout_t, T_TOK, DM, DM, DM, DM}; pg8::StaticOrder S; S.init(T_TOK, DM, (int)gridDim.x, (int)blockIdx.x);
        EpiX1 E{x, out, x1b};
        pg8::gemm_phase<EpiX1, pg8::StaticOrder, true, true>((PG8_LAS unsigned char*)lds_raw, g, S, E, tid512);
    }
    GRID_BAR(); STAMP();
    {   PHASE_IDS
        unsigned long long& pacc = ts_probe_;
        RG_BEGIN(110)
        __attribute__((address_space(3))) float* Wl = (__attribute__((address_space(3))) float*)((lds_c*)lds_raw);
        __attribute__((address_space(3))) int* lcnt = (__attribute__((address_space(3))) int*)((lds_c*)lds_raw + 20 * 4096);
        __attribute__((address_space(3))) int* lri = lcnt + 32;
        for (int t = gw * 4; t < T_TOK; t += NGW * 4) {
            float4 pv[4];
#pragma unroll
            for (int j = 0; j < 4; ++j) pv[j] = ((const float4*)(p + (size_t)(t + j) * 256))[lane64];
#pragma unroll
            for (int j = 0; j < 4; ++j) { uint2 o; o.x = pk2(pv[j].x, pv[j].y); o.y = pk2(pv[j].z, pv[j].w); ((uint2*)(pb + (size_t)(t + j) * 256))[lane64] = o; } }
        __syncthreads(); router_stage(Wl, g_ffn, w_rg, w_re, tid512); if (tid512 < 16) lcnt[tid512] = 0; __syncthreads();
        RG_END(110)
        RG_BEGIN(111)
        for (int r_ = 0; r_ < T_TOK / (NGW * 4); ++r_) {
            int tk_[4]; f4v xv_[16];
#pragma unroll
            for (int g_ = 0; g_ < 4; ++g_) tk_[g_] = gw + NGW * (4 * r_ + g_);
            const int mytok_ = gw + NGW * (4 * r_ + (lane64 >> 4));
#pragma unroll
            for (int j = 0; j < 16; ++j) xv_[j] = *(const f4v*)(out + (size_t)mytok_ * DM + 4 * ((lane64 & 15) + 16 * j));
            router4(tk_, lane64, xv_, Wl, b_rg, b_re, rstd1, lcnt, lri + (wave * 8 + r_ * 4) * 4);
        }
        __syncthreads();
        RG_END(111)
        RG_BEGIN(112)
        if (tid512 < 16) lcnt[16 + tid512] = atomicAdd(cnt + tid512 * CNT_STRIDE, lcnt[tid512]);
        __syncthreads();
        { int i = 0; for (int t = gw; t < T_TOK; t += NGW, ++i) if (lane64 == 0) { __attribute__((address_space(3))) int* r = lri + (wave * 8 + i) * 4;
            const int e0 = r[0] & 255, e1 = (r[0] >> 8) & 255, q0 = (r[1] & 0xffff) + lcnt[16 + e0], q1 = (r[1] >> 16) + lcnt[16 + e1]; int4 ri; ri.x = r[0]; ri.y = q0 | (q1 << 16); ri.z = r[2]; ri.w = r[3];
            *(int4*)(rinfo + (size_t)t * 4) = ri; elist[e0 * T_TOK + q0] = t; elist[e1 * T_TOK + q1] = t; } }
        RG_END(112)
    }
    GRID_BAR(); STAMP();
    {
        int ntile_ = 0;
        {   PHASE_IDS
            for (int e = 0; e < 16; ++e) ntile_ += (cnt[e * CNT_STRIDE] + 255) >> 8; }
        const int G_ = (int)gridDim.x, c_ = (int)blockIdx.x, per_ = (G_ % 8 == 0) ? (ntile_ + 7) / 8 : 0;
#pragma unroll 1
        for (int rnd = 0; ; ++rnd) {
            int ti;
            if (per_ > 0 && per_ * 8 <= G_) { if (rnd > 0) break; ti = ((c_ >> 3) < per_) ? (c_ & 7) * per_ + (c_ >> 3) : ntile_; }
            else ti = c_ + rnd * G_;
            if (ti >= ntile_) break;
            {   PHASE_IDS
                MoeOrder S{cnt, 1, 1, ti}; pg8::Unit u; S.next(0, u);
                const int e = u.pn, nv = cnt[e * CNT_STRIDE] - u.aux * 256; const int* amap = elist + (size_t)e * T_TOK + u.aux * 256;
                pg8::Gemm g{x1b, We13_t, 0, 0, DM, DM, DM, amap, nv}; EpiSwiglu E{act, amap, nv, rstd1}; TwoUnits S2{u.pm, e * 2, u.aux};
                __syncthreads();
                pg8::gemm_phase<EpiSwiglu, TwoUnits, false, true, true>((PG8_LAS unsigned char*)lds_raw, g, S2, E, tid512);
                asm volatile("s_waitcnt vmcnt(0)" ::: "memory");
                __syncthreads();
                if (tid512 == 0) { __builtin_amdgcn_fence(__ATOMIC_ACQUIRE, "agent"); asm volatile("s_waitcnt vmcnt(0)" ::: "memory"); }
                __syncthreads();
            }
            {   PHASE_IDS
                MoeOrder S{cnt, 1, 1, ti}; pg8::Unit u; S.next(0, u);
                int k2_ = 256; asm volatile("" : "+s"(k2_));
                pg8::Gemm g{act, We2_t, 0, 0, k2_, k2_, k2_}; FourUnits S4{u.pm, u.pn * 4}; EpiStoreBf E{y2, DM, 3};
                pg8::gemm_phase<EpiStoreBf, FourUnits, true, true>((PG8_LAS unsigned char*)lds_raw, g, S4, E, tid512);
            }
        }
        {   unsigned* mq = (unsigned*)(a.ws + ((size_t)42 << 20) + 36864);
            volatile __attribute__((address_space(3))) unsigned* idw = (volatile __attribute__((address_space(3))) unsigned*)((lds_c*)lds_raw + (LDS_BYTES - 32));
#pragma unroll 1
            for (;;) {
                PHASE_IDS
                __syncthreads();
                if (tid512 == 0) idw[0] = __hip_atomic_fetch_add(mq, 1u, __ATOMIC_RELAXED, __HIP_MEMORY_SCOPE_AGENT);
                __syncthreads();
                const int up = (int)idw[0];
                if (up >= 256) break;
                pg8::Unit uu; uu.pm = up >> 2; uu.pn = up & 3; uu.aux = 0;
                int k2_ = 256; asm volatile("" : "+s"(k2_));
                pg8::Gemm g{pb, Wpp_t, T_TOK, DM, k2_, k2_, k2_}; EpiStoreBf E{PP, DM, 3}; OneUnit S1{uu};
                pg8::gemm_phase<EpiStoreBf, OneUnit, false, true>((PG8_LAS unsigned char*)lds_raw, g, S1, E, tid512);
            }
        }
    }
    GRID_BAR(); STAMP();
    {   PHASE_IDS
        __attribute__((address_space(3))) int* brow = (__attribute__((address_space(3))) int*)((lds_c*)lds_raw);
        __syncthreads();
        if (tid512 < 16) brow[tid512] = moe_base_row(cnt, tid512);
        __syncthreads();
#pragma unroll 1
        for (int t0 = gw * 4; t0 < T_TOK; t0 += NGW * 4) {
            int4 ri[4];
#pragma unroll
            for (int q = 0; q < 4; ++q) ri[q] = *(const int4*)(rinfo + (size_t)(t0 + q) * 4);
            float4 v[4][4]; uint2 ya[4][4], yb[4][4];
#pragma unroll
            for (int q = 0; q < 4; ++q) {
                const int rx = __builtin_amdgcn_readfirstlane(ri[q].x), ry = __builtin_amdgcn_readfirstlane(ri[q].y);
                const int r0 = brow[rx & 255] + (ry & 0xffff), r1 = brow[(rx >> 8) & 255] + ((ry >> 16) & 0xffff);
#pragma unroll
                for (int j = 0; j < 4; ++j) { v[q][j] = ((const float4*)(out + (size_t)(t0 + q) * DM))[lane64 + 64 * j];
                    ya[q][j] = ((const uint2*)(y2 + (size_t)r0 * DM))[lane64 + 64 * j]; yb[q][j] = ((const uint2*)(y2 + (size_t)r1 * DM))[lane64 + 64 * j]; }
            }
#pragma unroll
            for (int q = 0; q < 4; ++q) {
                const float w0 = __int_as_float(__builtin_amdgcn_readfirstlane(ri[q].z)), w1 = __int_as_float(__builtin_amdgcn_readfirstlane(ri[q].w)); float s2 = 0.f;
#pragma unroll
                for (int j = 0; j < 4; ++j) { const uint2 a0 = ya[q][j], a1 = yb[q][j]; float4 x_ = v[q][j];
                    x_.x += w0 * __uint_as_float(a0.x << 16) + w1 * __uint_as_float(a1.x << 16); x_.y += w0 * __uint_as_float(a0.x & 0xffff0000u) + w1 * __uint_as_float(a1.x & 0xffff0000u);
                    x_.z += w0 * __uint_as_float(a0.y << 16) + w1 * __uint_as_float(a1.y << 16); x_.w += w0 * __uint_as_float(a0.y & 0xffff0000u) + w1 * __uint_as_float(a1.y & 0xffff0000u);
                    s2 += x_.x * x_.x + x_.y * x_.y + x_.z * x_.z + x_.w * x_.w;
                    ((float4*)(out + (size_t)(t0 + q) * DM))[lane64 + 64 * j] = x_; uint2 o; o.x = pk2(x_.x, x_.y); o.y = pk2(x_.z, x_.w); ((uint2*)(x2b + (size_t)(t0 + q) * DM))[lane64 + 64 * j] = o; }
                s2 = wave_sum(s2);
                if (lane64 == 0) rstd2[t0 + q] = rsqrtf(s2 * (1.f / DM) + 1e-6f);
            }
        }
    }
    GRID_BAR(); STAMP();
    if ((int)gridDim.x == 256) {
        PHASE_IDS
        __syncthreads();
        pg8::StaticOrder S; S.init(T_TOK, DM, (int)gridDim.x, (int)blockIdx.x);
        pg8::Gemm g{x2b, Wpg_t, T_TOK, DM, DM, DM, DM}; EpiPleFinal E{out, PP, rstd2, g_final, out, (float*)(ws + 251 * MiB), (unsigned*)(ws + 42 * MiB + 40960)};
        pg8::gemm_phase<EpiPleFinal, pg8::StaticOrder, false, true>((PG8_LAS unsigned char*)lds_raw, g, S, E, tid512);
#if NSA_CHECK
        GRID_BAR();
        if (blockIdx.x == 0 && tid512 == 0) { const unsigned* stats = (const unsigned*)(ws + 42 * MiB + 32768); out[0] += sqrtf((float)stats[0]); out[1] += sqrtf((float)stats[1]) * 30.f; }
#endif
        if (SPIN_PHASE >= 0 && blockIdx.x == 0) { __syncthreads(); STAMP(); const unsigned long long t0_ = __builtin_amdgcn_s_memrealtime(); while (__builtin_amdgcn_s_memrealtime() - t0_ < 8ull * ts_probe_) __builtin_amdgcn_s_sleep(4); }
    } else {
        {   PHASE_IDS
            __syncthreads();
            pg8::StaticOrder S; S.init(T_TOK, DM, (int)gridDim.x, (int)blockIdx.x);
            pg8::Gemm g{x2b, Wpg_t, T_TOK, DM, DM, DM, DM}; EpiPle2 E{out, PP, rstd2};
            pg8::gemm_phase<EpiPle2, pg8::StaticOrder, true, true>((PG8_LAS unsigned char*)lds_raw, g, S, E, tid512);
        }
        GRID_BAR();
        {   PHASE_IDS
            VB_LOOP(T_TOK / 4) rmsnorm_rows(vb, tid, out, g_final, (bf16_t*)nullptr, out, T_TOK);
        }
    }
}

extern "C" void kernel_launch(void* const* d_in, const int* in_sizes, int n_in, void* d_out, int out_size, void* d_ws, size_t ws_size, hipStream_t stream) {
    static int grid_blocks = 0;
    if (grid_blocks == 0) {
        int dev = 0, cus = 0, per_cu = 0;
        (void)hipGetDevice(&dev);
        (void)hipDeviceGetAttribute(&cus, hipDeviceAttributeMultiprocessorCount, dev);
        (void)hipFuncSetAttribute((const void*)mk_fwd, hipFuncAttributeMaxDynamicSharedMemorySize, LDS_BYTES);
        (void)hipOccupancyMaxActiveBlocksPerMultiprocessor(&per_cu, (const void*)mk_fwd, 512, LDS_BYTES);
        if (per_cu < 1) { fprintf(stderr, "kernel_launch: occupancy query returned %d\n", per_cu); per_cu = 1; }
        grid_blocks = cus * 1;
        fprintf(stderr, "kernel_launch: cus=%d per_cu=%d grid=%d ws=%zu\n", cus, per_cu, grid_blocks, ws_size);
    }
    (void)hipMemsetAsync((char*)d_ws + ((size_t)42 << 20), 0, 131072, stream);
    Args a{};
    for (int i = 0; i < 29; ++i) a.in[i] = (const float*)d_in[i];
    a.out = (float*)d_out; a.ws = (char*)d_ws; a.rep_mask = REP_MASK; a.pad = 0;
    void* args[] = {&a};
    hipError_t e = hipLaunchCooperativeKernel((const void*)mk_fwd, dim3(grid_blocks), dim3(512), args, LDS_BYTES, stream);
    if (e != hipSuccess) fprintf(stderr, "cooperative launch failed: %s (grid %d)\n", hipGetErrorString(e), grid_blocks);
    (void)in_sizes; (void)n_in; (void)out_size; (void)ws_size;
}
```
